# Optimizing an MI355X kernel written in HIP

```python
import math
import jax, jax.numpy as jnp
from jax import lax
import numpy as np

D_MODEL = 1024
BATCH = 8
SEQ = 2048
DEPTH = 1

CHUNK = 64
Q_BLOCK = 128
MEM_LEN = 256
HEAD_DIM = 64
N_DIFF_HEADS = 4
DIFF_V_DIM = 2 * HEAD_DIM
DIFF_QK_WIDTH = N_DIFF_HEADS * 2 * HEAD_DIM
DIFF_WIDTH = N_DIFF_HEADS * DIFF_V_DIM
N_FOX_HEADS = 8
FOX_WIDTH = N_FOX_HEADS * HEAD_DIM
MIX_WIDTH = DIFF_WIDTH + FOX_WIDTH
ROPE_DIM = HEAD_DIM // 4
ROPE_THETA = 500000.0
N_MEM_HEADS = 4
MEM_HEAD_DIM = D_MODEL // N_MEM_HEADS
D_FF = 4 * D_MODEL
EPS = 1e-6
NEG_INF = -1e30

IN_SIZES = [DIFF_QK_WIDTH, DIFF_QK_WIDTH, DIFF_WIDTH, FOX_WIDTH, FOX_WIDTH, FOX_WIDTH, N_FOX_HEADS]
IN_OFFSETS = [int(o) for o in np.cumsum(IN_SIZES)[:-1]]
IN_COLS = int(sum(IN_SIZES))

kernel_name = "hybrid_diffattn_fox_memxattn_block"


def rms_norm(t, w):
    tf = t.astype(jnp.float32)
    tf = tf * lax.rsqrt(jnp.mean(tf * tf, axis=-1, keepdims=True) + EPS)
    return (tf * w.astype(jnp.float32)).astype(t.dtype)


def to_heads(t, n_heads):
    b, s, w = t.shape
    return t.reshape(b, s, n_heads, w // n_heads).transpose(0, 2, 1, 3)


def from_heads(t):
    b, n, s, d = t.shape
    return t.transpose(0, 2, 1, 3).reshape(b, s, n * d)


def rope_tables(positions):
    inv_freq = ROPE_THETA ** (-jnp.arange(0, ROPE_DIM, 2, dtype=jnp.float32) / ROPE_DIM)
    ang = positions.astype(jnp.float32)[..., None] * inv_freq
    return jnp.cos(ang)[:, None], jnp.sin(ang)[:, None]


def apply_partial_rope(t, cos, sin):
    tf = t.astype(jnp.float32)
    half = ROPE_DIM // 2
    t1, t2, rest = tf[..., :half], tf[..., half:ROPE_DIM], tf[..., ROPE_DIM:]
    out = jnp.concatenate([t1 * cos - t2 * sin, t2 * cos + t1 * sin, rest], axis=-1)
    return out.astype(t.dtype)


def chunk_causal_mask(q0, n_q, n_k):
    q_chunk = (q0 + jnp.arange(n_q)) // CHUNK
    k_chunk = jnp.arange(n_k) // CHUNK
    return k_chunk[None, :] <= q_chunk[:, None]


def frame_causal_mask(q0, n_q, n_k):
    return jnp.arange(n_k)[None, :] <= (q0 + jnp.arange(n_q))[:, None]


def masked_softmax(scores, mask):
    return jax.nn.softmax(jnp.where(mask, scores, NEG_INF), axis=-1)


def differential_attention(q1, q2, k1, k2, v, lam):
    seq = q1.shape[2]
    scale = HEAD_DIM ** -0.5
    outs = []
    for q0 in range(0, seq, Q_BLOCK):
        q_end = q0 + Q_BLOCK
        mask = chunk_causal_mask(q0, Q_BLOCK, q_end)
        s1 = jnp.einsum('bhqd,bhkd->bhqk', q1[:, :, q0:q_end], k1[:, :, :q_end]).astype(jnp.float32) * scale
        s2 = jnp.einsum('bhqd,bhkd->bhqk', q2[:, :, q0:q_end], k2[:, :, :q_end]).astype(jnp.float32) * scale
        a = masked_softmax(s1, mask) - lam * masked_softmax(s2, mask)
        outs.append(jnp.einsum('bhqk,bhkd->bhqd', a.astype(v.dtype), v[:, :, :q_end]))
    return jnp.concatenate(outs, axis=2)


def forgetting_attention(q, k, v, cum_logf):
    seq = q.shape[2]
    scale = HEAD_DIM ** -0.5
    outs = []
    for q0 in range(0, seq, Q_BLOCK):
        q_end = q0 + Q_BLOCK
        mask = frame_causal_mask(q0, Q_BLOCK, q_end)
        s = jnp.einsum('bhqd,bhkd->bhqk', q[:, :, q0:q_end], k[:, :, :q_end]).astype(jnp.float32) * scale
        s = s + (cum_logf[:, :, q0:q_end, None] - cum_logf[:, :, None, :q_end])
        p = masked_softmax(s, mask)
        outs.append(jnp.einsum('bhqk,bhkd->bhqd', p.astype(v.dtype), v[:, :, :q_end]))
    return jnp.concatenate(outs, axis=2)


def setup_inputs(seed: int = 0) -> dict:
    key = jax.random.key(seed)
    ks = jax.random.split(key, 32)
    f32 = jnp.float32

    def normal(k, shape, scale):
        return jax.random.normal(k, shape, f32) * scale

    def gain(k, shape):
        return 1.0 + 0.02 * jax.random.normal(k, shape, f32)

    D = D_MODEL
    return {
        "x": normal(ks[0], (BATCH, SEQ, D), 1.0),
        "mem": normal(ks[1], (BATCH, MEM_LEN, D), 1.0),
        "positions": jnp.arange(SEQ, dtype=jnp.int32)[None, :]
        + CHUNK * jax.random.randint(ks[2], (BATCH, 1), 0, 512, dtype=jnp.int32),
        "norm_mix_w": gain(ks[3], (DEPTH, D)),
        "w_in": normal(ks[4], (DEPTH, D, IN_COLS), D ** -0.5),
        "b_forget": jax.random.uniform(ks[5], (DEPTH, N_FOX_HEADS), f32, 2.0, 4.0),
        "diff_q_norm_w": gain(ks[6], (DEPTH, HEAD_DIM)),
        "diff_k_norm_w": gain(ks[7], (DEPTH, HEAD_DIM)),
        "lambda_q1": normal(ks[8], (DEPTH, HEAD_DIM), 0.1),
        "lambda_k1": normal(ks[9], (DEPTH, HEAD_DIM), 0.1),
        "lambda_q2": normal(ks[10], (DEPTH, HEAD_DIM), 0.1),
        "lambda_k2": normal(ks[11], (DEPTH, HEAD_DIM), 0.1),
        "diff_subln_w": gain(ks[12], (DEPTH, DIFF_V_DIM)),
        "fox_q_norm_w": gain(ks[13], (DEPTH, HEAD_DIM)),
        "fox_k_norm_w": gain(ks[14], (DEPTH, HEAD_DIM)),
        "w_out": normal(ks[15], (DEPTH, MIX_WIDTH, D), MIX_WIDTH ** -0.5),
        "norm_mem_q_w": gain(ks[16], (DEPTH, D)),
        "norm_mem_kv_w": gain(ks[17], (DEPTH, D)),
        "w_mem_q": normal(ks[18], (DEPTH, D, N_MEM_HEADS * MEM_HEAD_DIM), D ** -0.5),
        "w_mem_kv": normal(ks[19], (DEPTH, D, 2 * N_MEM_HEADS * MEM_HEAD_DIM), D ** -0.5),
        "mem_q_norm_w": gain(ks[20], (DEPTH, MEM_HEAD_DIM)),
        "mem_k_norm_w": gain(ks[21], (DEPTH, MEM_HEAD_DIM)),
        "w_mem_o": normal(ks[22], (DEPTH, N_MEM_HEADS * MEM_HEAD_DIM, D), (N_MEM_HEADS * MEM_HEAD_DIM) ** -0.5),
        "norm_mlp_w": gain(ks[23], (DEPTH, D)),
        "w_up": normal(ks[24], (DEPTH, D, D_FF), D ** -0.5),
        "w_down": normal(ks[25], (DEPTH, D_FF, D), D_FF ** -0.5),
    }


def reference(x, mem, positions, norm_mix_w, w_in, b_forget, diff_q_norm_w, diff_k_norm_w,
              lambda_q1, lambda_k1, lambda_q2, lambda_k2, diff_subln_w, fox_q_norm_w, fox_k_norm_w,
              w_out, norm_mem_q_w, norm_mem_kv_w, w_mem_q, w_mem_kv, mem_q_norm_w, mem_k_norm_w,
              w_mem_o, norm_mlp_w, w_up, w_down):
    cos, sin = rope_tables(positions)
    for l in range(DEPTH):
        lam_init = 0.8 - 0.6 * math.exp(-0.3 * l)

        h = rms_norm(x, norm_mix_w[l])
        proj = h @ w_in[l]
        dq, dk, dv, fq, fk, fv, f_logit = jnp.split(proj, IN_OFFSETS, axis=-1)

        dq = to_heads(dq, N_DIFF_HEADS)
        dk = to_heads(dk, N_DIFF_HEADS)
        dv = to_heads(dv, N_DIFF_HEADS)
        q1 = apply_partial_rope(rms_norm(dq[..., :HEAD_DIM], diff_q_norm_w[l]), cos, sin)
        q2 = apply_partial_rope(rms_norm(dq[..., HEAD_DIM:], diff_q_norm_w[l]), cos, sin)
        k1 = apply_partial_rope(rms_norm(dk[..., :HEAD_DIM], diff_k_norm_w[l]), cos, sin)
        k2 = apply_partial_rope(rms_norm(dk[..., HEAD_DIM:], diff_k_norm_w[l]), cos, sin)
        lam = (jnp.exp(jnp.sum(lambda_q1[l].astype(jnp.float32) * lambda_k1[l].astype(jnp.float32)))
               - jnp.exp(jnp.sum(lambda_q2[l].astype(jnp.float32) * lambda_k2[l].astype(jnp.float32)))
               + lam_init)
        o_diff = differential_attention(q1, q2, k1, k2, dv, lam)
        o_diff = rms_norm(o_diff, diff_subln_w[l]) * (1.0 - lam_init)

        log_f = jax.nn.log_sigmoid((f_logit + b_forget[l]).astype(jnp.float32))
        cum_logf = jnp.cumsum(log_f, axis=1).transpose(0, 2, 1)
        fq = rms_norm(to_heads(fq, N_FOX_HEADS), fox_q_norm_w[l])
        fk = rms_norm(to_heads(fk, N_FOX_HEADS), fox_k_norm_w[l])
        fv = to_heads(fv, N_FOX_HEADS)
        o_fox = forgetting_attention(fq, fk, fv, cum_logf)

        mixed = jnp.concatenate([from_heads(o_diff), from_heads(o_fox)], axis=-1)
        x = x + mixed @ w_out[l]

        hq = rms_norm(x, norm_mem_q_w[l])
        hm = rms_norm(mem, norm_mem_kv_w[l])
        mq = rms_norm(to_heads(hq @ w_mem_q[l], N_MEM_HEADS), mem_q_norm_w[l])
        mk, mv = jnp.split(hm @ w_mem_kv[l], 2, axis=-1)
        mk = rms_norm(to_heads(mk, N_MEM_HEADS), mem_k_norm_w[l])
        mv = to_heads(mv, N_MEM_HEADS)
        ms = jnp.einsum('bhqd,bhkd->bhqk', mq, mk).astype(jnp.float32) * (MEM_HEAD_DIM ** -0.5)
        mp = jax.nn.softmax(ms, axis=-1)
        mo = jnp.einsum('bhqk,bhkd->bhqd', mp.astype(mv.dtype), mv)
        x = x + from_heads(mo) @ w_mem_o[l]

        h = rms_norm(x, norm_mlp_w[l])
        x = x + jnp.square(jax.nn.relu(h @ w_up[l])) @ w_down[l]
    return x
```

```cpp
#include <hip/hip_runtime.h>
#include <cstdint>
#include <cstdio>

typedef unsigned short bf16_t;
__device__ __forceinline__ float bf2f(bf16_t v) { return __uint_as_float(((unsigned)v) << 16); }
__device__ __forceinline__ bf16_t f2bf(float f) { unsigned u = __float_as_uint(f); return (bf16_t)((u + 0x7fffu + ((u >> 16) & 1u)) >> 16); }

constexpr int NB = 8, SEQ = 2048, DM = 1024, MTOK = NB * SEQ, MEML = 256, MMEM = NB * MEML;
constexpr int NPROJ = 3072, INCOLS = 3080, DFF = 4096;
constexpr float EPS = 1e-6f;
constexpr float LOG2E = 1.4426950408889634f;
constexpr float C2 = 0.125f * LOG2E;
constexpr float CM = 0.0625f * LOG2E;
constexpr int C_DQ = 0, C_DK = 512, C_DV = 1024, C_FQ = 1536, C_FK = 2048, C_FV = 2560;

constexpr size_t MiB = 1u << 20;
constexpr size_t WS_CTL = 0;
constexpr size_t WS_FLOG = 1 * MiB;
constexpr size_t WS_CUMB = 2 * MiB;
constexpr size_t WS_ROPE = 3 * MiB;
constexpr size_t WS_SS = 4 * MiB;
constexpr size_t WS_WIN = 8 * MiB, WS_WOUT = 14 * MiB, WS_WQ = 16 * MiB, WS_WKV = 18 * MiB, WS_WO = 22 * MiB, WS_WUP = 24 * MiB, WS_WDN = 32 * MiB;
constexpr size_t WS_XB = 40 * MiB;
constexpr size_t WS_HM = 72 * MiB;
constexpr size_t WS_MKV = 76 * MiB;
constexpr size_t WS_MKN = 84 * MiB;
constexpr size_t WS_MVT = 88 * MiB;
constexpr size_t WS_PROJ = 96 * MiB;
constexpr size_t WS_ATT = 192 * MiB;
constexpr size_t WS_MQ = 96 * MiB;
constexpr size_t WS_MO = 128 * MiB;
constexpr size_t WS_H = 96 * MiB;
constexpr size_t WS_OF = 96 * MiB + 0;
constexpr size_t WS_END = 224 * MiB;

__global__ void k_transpose_w(const float* __restrict__ W, int ldw, int n0, int K, int N, const float* __restrict__ g, bf16_t* __restrict__ Wt) {
    __shared__ float t[32][33];
    const int kb = blockIdx.y * 32, nb = blockIdx.x * 32, tx = threadIdx.x, ty = threadIdx.y;
    for (int i = ty; i < 32; i += 8) { const int k = kb + i; t[i][tx] = W[(size_t)k * ldw + n0 + nb + tx] * (g ? g[k] : 1.f); }
    __syncthreads();
    for (int i = ty; i < 32; i += 8) Wt[(size_t)(nb + i) * K + kb + tx] = f2bf(t[tx][i]);
}
__device__ __forceinline__ float wave_sum(float v) {
#pragma unroll
    for (int o = 1; o < 64; o <<= 1) v += __shfl_xor(v, o);
    return v;
}
__global__ void __launch_bounds__(256) k_rownorm(const float* __restrict__ X, int rows, bf16_t* __restrict__ XN, const float* __restrict__ g, const float* __restrict__ win, float* __restrict__ flog) {
    const int row = blockIdx.x * 4 + (threadIdx.x >> 6), lane = threadIdx.x & 63;
    if (row >= rows) return;
    const float* xr = X + (size_t)row * DM;
    float v[16]; float ss = 0.f;
#pragma unroll
    for (int j = 0; j < 16; ++j) { v[j] = xr[j * 64 + lane]; ss += v[j] * v[j]; }
    ss = wave_sum(ss);
    const float rstd = rsqrtf(ss * (1.f / DM) + EPS);
#pragma unroll
    for (int j = 0; j < 16; ++j) XN[(size_t)row * DM + j * 64 + lane] = f2bf(v[j] * rstd);
    if (flog) {
        float a[8];
#pragma unroll
        for (int c = 0; c < 8; ++c) a[c] = 0.f;
#pragma unroll
        for (int j = 0; j < 16; ++j) { const int k = j * 64 + lane; const float h = v[j] * rstd * g[k];
#pragma unroll
            for (int c = 0; c < 8; ++c) a[c] += h * win[(size_t)k * INCOLS + NPROJ + c]; }
#pragma unroll
        for (int c = 0; c < 8; ++c) { const float s = wave_sum(a[c]); if (lane == 0) flog[(size_t)row * 8 + c] = s; }
    }
}
__constant__ float INV_FREQ[8] = {1.0f, 0.1939227432012558f, 0.03760603070259094f, 0.007292664609849453f, 0.0014142135623842478f, 0.00027424818836152554f, 5.318296098266728e-05f, 1.0313386155758053e-05f};
__global__ void k_rope_table(const int* __restrict__ pos, float* __restrict__ tab) {
    const int id = blockIdx.x * blockDim.x + threadIdx.x; if (id >= MTOK * 8) return;
    const int row = id >> 3, i = id & 7;
    const float ang = (float)pos[row] * INV_FREQ[i];
    const double a = (double)ang; const double k = rint(a * 0.15915494309189535); const float r = (float)fma(-k, 6.283185307179586, a);
    tab[(size_t)row * 16 + i] = cosf(r); tab[(size_t)row * 16 + 8 + i] = sinf(r);
}
__global__ void __launch_bounds__(64) k_post_qk(bf16_t* __restrict__ P, const float* __restrict__ dqw, const float* __restrict__ dkw, const float* __restrict__ fqw, const float* __restrict__ fkw, const float* __restrict__ tab) {
    const int id = blockIdx.x * blockDim.x + threadIdx.x; if (id >= MTOK * 32) return;
    const int row = id >> 5, sg = id & 31;
    const int col = sg < 16 ? sg * 64 : 1536 + (sg - 16) * 64;
    const float* w = sg < 8 ? dqw : sg < 16 ? dkw : sg < 24 ? fqw : fkw;
    const bool rope = sg < 16, isq = (sg < 8) || (sg >= 16 && sg < 24);
    bf16_t* p = P + (size_t)row * NPROJ + col;
    float v[64]; float ss = 0.f;
#pragma unroll
    for (int d = 0; d < 64; ++d) { v[d] = bf2f(p[d]); ss += v[d] * v[d]; }
    const float rstd = rsqrtf(ss * (1.f / 64.f) + EPS);
#pragma unroll
    for (int d = 0; d < 64; ++d) v[d] = v[d] * rstd * w[d];
    if (rope) {
#pragma unroll
        for (int i = 0; i < 8; ++i) { const float c = tab[(size_t)row * 16 + i], s = tab[(size_t)row * 16 + 8 + i]; const float t1 = v[i], t2 = v[i + 8]; v[i] = t1 * c - t2 * s; v[i + 8] = t2 * c + t1 * s; }
    }
    const float sc = isq ? C2 : 1.f;
#pragma unroll
    for (int d = 0; d < 64; ++d) p[d] = f2bf(v[d] * sc);
}
__global__ void k_cumsum(const float* __restrict__ flog, const float* __restrict__ bfg, float* __restrict__ cumb) {
    const int id = blockIdx.x * blockDim.x + threadIdx.x; if (id >= 64) return;
    const int b = id >> 3, h = id & 7; double c = 0.0;
    for (int s = 0; s < SEQ; ++s) { const float z = flog[(size_t)(b * SEQ + s) * 8 + h] + bfg[h];
        const float lf = z > 0.f ? -log1pf(expf(-z)) : z - log1pf(expf(z)); c += (double)lf; cumb[(size_t)id * SEQ + s] = (float)(-c * (double)LOG2E); }
}
__global__ void k_post_mk(const bf16_t* __restrict__ MKV, const float* __restrict__ kw, const float* __restrict__ qw, bf16_t* __restrict__ MKn) {
    const int wv = blockIdx.x * 4 + (threadIdx.x >> 6), lane = threadIdx.x & 63; if (wv >= MMEM * 4) return;
    const int mrow = wv >> 2, h = wv & 3, b = mrow / MEML, k = mrow % MEML;
    float v[4]; float ss = 0.f;
#pragma unroll
    for (int j = 0; j < 4; ++j) { v[j] = bf2f(MKV[(size_t)mrow * 2048 + h * 256 + j * 64 + lane]); ss += v[j] * v[j]; }
    ss = wave_sum(ss); const float rstd = rsqrtf(ss * (1.f / 256.f) + EPS);
#pragma unroll
    for (int j = 0; j < 4; ++j) { const int d = j * 64 + lane; MKn[((size_t)(b * 4 + h) * 256 + k) * 256 + d] = f2bf(v[j] * rstd * kw[d] * qw[d] * CM); }
}
__global__ void k_post_mv(const bf16_t* __restrict__ MKV, bf16_t* __restrict__ MVt) {
    const size_t id = (size_t)blockIdx.x * blockDim.x + threadIdx.x; if (id >= (size_t)32 * 256 * 256) return;
    const int k = id & 255, d = (id >> 8) & 255, bh = (int)(id >> 16), b = bh >> 2, h = bh & 3;
    MVt[id] = MKV[(size_t)(b * MEML + k) * 2048 + 1024 + h * 256 + d];
}
__global__ void k_ss(const float* __restrict__ X, float* __restrict__ SS) {
    const int row = blockIdx.x * 4 + (threadIdx.x >> 6), lane = threadIdx.x & 63; if (row >= MTOK) return;
#pragma unroll
    for (int j = 0; j < 4; ++j) { const float4 v = *(const float4*)(X + (size_t)row * DM + j * 256 + lane * 4); float s = v.x * v.x + v.y * v.y + v.z * v.z + v.w * v.w; s = wave_sum(s); if (lane == 0) SS[(size_t)row * 4 + j] = s; }
}

struct GemmP { const bf16_t* A; int lda; const bf16_t* Bt; int ldb; int M, N, K; int mode;
    bf16_t* Ob; int ldo; const float* base; float* outf; const float* SS; };
__global__ void __launch_bounds__(256) k_gemm(GemmP p) {
    __shared__ float As[16][65], Bs[16][65];
    const int tx = threadIdx.x & 15, ty = threadIdx.x >> 4, m0 = blockIdx.y * 64, n0 = blockIdx.x * 64;
    float acc[4][4];
#pragma unroll
    for (int i = 0; i < 4; ++i)
#pragma unroll
        for (int j = 0; j < 4; ++j) acc[i][j] = 0.f;
    const int lr = threadIdx.x >> 2, lc = (threadIdx.x & 3) * 4;
    for (int k0 = 0; k0 < p.K; k0 += 16) {
        const bf16_t* ap = p.A + (size_t)(m0 + lr) * p.lda + k0 + lc; const bf16_t* bp = p.Bt + (size_t)(n0 + lr) * p.ldb + k0 + lc;
#pragma unroll
        for (int j = 0; j < 4; ++j) { As[lc + j][lr] = bf2f(ap[j]); Bs[lc + j][lr] = bf2f(bp[j]); }
        __syncthreads();
#pragma unroll
        for (int kk = 0; kk < 16; ++kk) { float a[4], b[4];
#pragma unroll
            for (int i = 0; i < 4; ++i) { a[i] = As[kk][ty * 4 + i]; b[i] = Bs[kk][tx * 4 + i]; }
#pragma unroll
            for (int i = 0; i < 4; ++i)
#pragma unroll
                for (int j = 0; j < 4; ++j) acc[i][j] += a[i] * b[j]; }
        __syncthreads();
    }
#pragma unroll
    for (int i = 0; i < 4; ++i) { const int row = m0 + ty * 4 + i; float rs = 1.f;
        if (p.mode == 2 || p.mode == 3) { const float4 s = *(const float4*)(p.SS + (size_t)row * 4); rs = rsqrtf((s.x + s.y + s.z + s.w) * (1.f / DM) + EPS); }
#pragma unroll
        for (int j = 0; j < 4; ++j) { const int col = n0 + tx * 4 + j; const float a = acc[i][j];
            if (p.mode == 0) p.Ob[(size_t)row * p.ldo + col] = f2bf(a);
            else if (p.mode == 1) { const float o = p.base[(size_t)row * DM + col] + a; p.outf[(size_t)row * DM + col] = o; p.Ob[(size_t)row * p.ldo + col] = f2bf(o); }
            else if (p.mode == 2) p.Ob[(size_t)row * p.ldo + col] = f2bf(a * rs);
            else if (p.mode == 3) { const float r = fmaxf(a * rs, 0.f); p.Ob[(size_t)row * p.ldo + col] = f2bf(r * r); }
            else { p.outf[(size_t)row * DM + col] = p.base[(size_t)row * DM + col] + a; } } }
}

__global__ void __launch_bounds__(64) k_attn(const bf16_t* __restrict__ P, const float* __restrict__ cumb, int fox, float* __restrict__ OF, int nslot) {
    const int row = blockIdx.x * 64 + threadIdx.x, slot = blockIdx.y, b = row / SEQ, s = row % SEQ;
    int qc, kc, vc; const float* bias = nullptr; int last;
    if (fox) { qc = C_FQ + 64 * slot; kc = C_FK + 64 * slot; vc = C_FV + 64 * slot; bias = cumb + (size_t)(b * 8 + slot) * SEQ; last = s; }
    else { const int h = slot >> 2, mp = (slot >> 1) & 1, hf = slot & 1; qc = C_DQ + 128 * h + 64 * mp; kc = C_DK + 128 * h + 64 * mp; vc = C_DV + 128 * h + 64 * hf; last = (s | 63); }
    float q[64], o[64];
#pragma unroll
    for (int d = 0; d < 64; ++d) { q[d] = bf2f(P[(size_t)row * NPROJ + qc + d]); o[d] = 0.f; }
    float m = -1e30f, l = 0.f;
    const int wlast = __builtin_amdgcn_readfirstlane(((blockIdx.x * 64 + 63) % SEQ) | (fox ? 0 : 63));
    for (int t = 0; t <= wlast; ++t) {
        const bf16_t* kr = P + (size_t)(b * SEQ + t) * NPROJ + kc; const bf16_t* vr = P + (size_t)(b * SEQ + t) * NPROJ + vc;
        float sc = 0.f;
#pragma unroll
        for (int d = 0; d < 64; ++d) sc += q[d] * bf2f(kr[d]);
        if (bias) sc += bias[t];
        if (t <= last) {
            const float mn = fmaxf(m, sc), al = exp2f(m - mn), pp = exp2f(sc - mn);
            l = l * al + pp;
#pragma unroll
            for (int d = 0; d < 64; ++d) o[d] = o[d] * al + pp * bf2f(vr[d]);
            m = mn;
        }
    }
    const float il = 1.f / l;
#pragma unroll
    for (int d = 0; d < 64; ++d) OF[(size_t)row * (nslot * 64) + slot * 64 + d] = o[d] * il;
}
__global__ void k_fox_fin(const float* __restrict__ OF, bf16_t* __restrict__ ATT) {
    const size_t id = (size_t)blockIdx.x * blockDim.x + threadIdx.x; if (id >= (size_t)MTOK * 512) return;
    const int row = (int)(id >> 9), c = (int)(id & 511); ATT[(size_t)row * DM + 512 + c] = f2bf(OF[id]);
}
__global__ void k_diff_fin(const float* __restrict__ OF, const float* __restrict__ lq1, const float* __restrict__ lk1, const float* __restrict__ lq2, const float* __restrict__ lk2, const float* __restrict__ sw, bf16_t* __restrict__ ATT) {
    const int wv = blockIdx.x * 4 + (threadIdx.x >> 6), lane = threadIdx.x & 63; if (wv >= MTOK * 4) return;
    const int row = wv >> 2, h = wv & 3;
    float s1 = lq1[lane] * lk1[lane], s2 = lq2[lane] * lk2[lane]; s1 = wave_sum(s1); s2 = wave_sum(s2);
    const float lam = expf(s1) - expf(s2) + 0.2f;
    float v[2]; float ss = 0.f;
#pragma unroll
    for (int j = 0; j < 2; ++j) { const int d = j * 64 + lane;
        const float o1 = OF[(size_t)row * 1024 + (h * 4 + 0 * 2 + j) * 64 + lane], o2 = OF[(size_t)row * 1024 + (h * 4 + 1 * 2 + j) * 64 + lane];
        v[j] = o1 - lam * o2; ss += v[j] * v[j]; (void)d; }
    ss = wave_sum(ss); const float rstd = rsqrtf(ss * (1.f / 128.f) + EPS);
#pragma unroll
    for (int j = 0; j < 2; ++j) { const int d = j * 64 + lane; ATT[(size_t)row * DM + h * 128 + d] = f2bf(v[j] * rstd * sw[d] * 0.8f); }
}
__global__ void __launch_bounds__(256) k_xattn(const bf16_t* __restrict__ MQ, const bf16_t* __restrict__ MKn, const bf16_t* __restrict__ MVt, bf16_t* __restrict__ MO) {
    __shared__ float qs[4][256], ps[4][256];
    const int w = threadIdx.x >> 6, lane = threadIdx.x & 63, wv = blockIdx.x * 4 + w;
    const int row = wv >> 2, h = wv & 3, b = row / SEQ, bh = b * 4 + h;
    float ss = 0.f;
#pragma unroll
    for (int j = 0; j < 4; ++j) { const float v = bf2f(MQ[(size_t)row * DM + h * 256 + j * 64 + lane]); qs[w][j * 64 + lane] = v; ss += v * v; }
    ss = wave_sum(ss); const float rq = rsqrtf(ss * (1.f / 256.f) + EPS);
    __syncthreads();
    float l = 0.f;
#pragma unroll
    for (int j = 0; j < 4; ++j) { const int k = j * 64 + lane; const bf16_t* kr = MKn + ((size_t)bh * 256 + k) * 256; float sc = 0.f;
        for (int d = 0; d < 256; ++d) sc += qs[w][d] * bf2f(kr[d]);
        const float pp = exp2f(sc * rq); ps[w][k] = pp; l += pp; }
    l = wave_sum(l);
    __syncthreads();
    const float il = 1.f / l;
#pragma unroll
    for (int j = 0; j < 4; ++j) { const int d = j * 64 + lane; const bf16_t* vr = MVt + ((size_t)bh * 256 + d) * 256; float o = 0.f;
        for (int k = 0; k < 256; ++k) o += ps[w][k] * bf2f(vr[k]);
        MO[(size_t)row * DM + h * 256 + d] = f2bf(o * il); }
}

static void gemm(hipStream_t st, const bf16_t* A, int lda, const bf16_t* Bt, int ldb, int M, int N, int K, int mode, bf16_t* Ob, int ldo, const float* base, float* outf, const float* SS) {
    GemmP p{}; p.A = A; p.lda = lda; p.Bt = Bt; p.ldb = ldb; p.M = M; p.N = N; p.K = K; p.mode = mode; p.Ob = Ob; p.ldo = ldo; p.base = base; p.outf = outf; p.SS = SS;
    hipLaunchKernelGGL(k_gemm, dim3(N / 64, M / 64), dim3(256), 0, st, p);
}
static void transpose_w(hipStream_t st, const float* W, int ldw, int n0, int K, int N, const float* g, bf16_t* Wt) {
    hipLaunchKernelGGL(k_transpose_w, dim3(N / 32, K / 32), dim3(32, 8), 0, st, W, ldw, n0, K, N, g, Wt);
}

extern "C" void kernel_launch(void* const* d_in, const int* in_sizes, int n_in, void* d_out, int out_size, void* d_ws, size_t ws_size, hipStream_t stream) {
    (void)in_sizes; (void)n_in; (void)out_size; (void)ws_size;
    const float* x = (const float*)d_in[0]; const float* mem = (const float*)d_in[1]; const int* pos = (const int*)d_in[2];
    const float* norm_mix_w = (const float*)d_in[3]; const float* w_in = (const float*)d_in[4]; const float* b_forget = (const float*)d_in[5];
    const float* dqw = (const float*)d_in[6]; const float* dkw = (const float*)d_in[7];
    const float* lq1 = (const float*)d_in[8]; const float* lk1 = (const float*)d_in[9]; const float* lq2 = (const float*)d_in[10]; const float* lk2 = (const float*)d_in[11];
    const float* subw = (const float*)d_in[12]; const float* fqw = (const float*)d_in[13]; const float* fkw = (const float*)d_in[14];
    const float* w_out = (const float*)d_in[15]; const float* nmq = (const float*)d_in[16]; const float* nmkv = (const float*)d_in[17];
    const float* w_mq = (const float*)d_in[18]; const float* w_mkv = (const float*)d_in[19]; const float* mqw = (const float*)d_in[20]; const float* mkw = (const float*)d_in[21];
    const float* w_mo = (const float*)d_in[22]; const float* nmlp = (const float*)d_in[23]; const float* w_up = (const float*)d_in[24]; const float* w_dn = (const float*)d_in[25];
    float* out = (float*)d_out; unsigned char* ws = (unsigned char*)d_ws;
    float* FLOG = (float*)(ws + WS_FLOG); float* CUMB = (float*)(ws + WS_CUMB); float* ROPE = (float*)(ws + WS_ROPE); float* SS = (float*)(ws + WS_SS);
    bf16_t* WIN = (bf16_t*)(ws + WS_WIN); bf16_t* WOUT = (bf16_t*)(ws + WS_WOUT); bf16_t* WQ = (bf16_t*)(ws + WS_WQ); bf16_t* WKV = (bf16_t*)(ws + WS_WKV);
    bf16_t* WO = (bf16_t*)(ws + WS_WO); bf16_t* WUP = (bf16_t*)(ws + WS_WUP); bf16_t* WDN = (bf16_t*)(ws + WS_WDN);
    bf16_t* XB = (bf16_t*)(ws + WS_XB); bf16_t* HM = (bf16_t*)(ws + WS_HM); bf16_t* MKV = (bf16_t*)(ws + WS_MKV); bf16_t* MKN = (bf16_t*)(ws + WS_MKN); bf16_t* MVT = (bf16_t*)(ws + WS_MVT);
    bf16_t* PROJ = (bf16_t*)(ws + WS_PROJ); bf16_t* ATT = (bf16_t*)(ws + WS_ATT); bf16_t* MQ = (bf16_t*)(ws + WS_MQ); bf16_t* MO = (bf16_t*)(ws + WS_MO); bf16_t* H = (bf16_t*)(ws + WS_H);
    float* OF = out;

    transpose_w(stream, w_in, INCOLS, 0, DM, NPROJ, norm_mix_w, WIN);
    transpose_w(stream, w_out, DM, 0, DM, DM, nullptr, WOUT);
    transpose_w(stream, w_mq, DM, 0, DM, DM, nmq, WQ);
    transpose_w(stream, w_mkv, 2048, 0, DM, 2048, nmkv, WKV);
    transpose_w(stream, w_mo, DM, 0, DM, DM, nullptr, WO);
    transpose_w(stream, w_up, DFF, 0, DM, DFF, nmlp, WUP);
    transpose_w(stream, w_dn, DM, 0, DFF, DM, nullptr, WDN);
    hipLaunchKernelGGL(k_rownorm, dim3(MTOK / 4), dim3(256), 0, stream, x, MTOK, XB, norm_mix_w, w_in, FLOG);
    hipLaunchKernelGGL(k_rownorm, dim3(MMEM / 4), dim3(256), 0, stream, mem, MMEM, HM, (const float*)nullptr, (const float*)nullptr, (float*)nullptr);
    hipLaunchKernelGGL(k_rope_table, dim3(MTOK * 8 / 256), dim3(256), 0, stream, pos, ROPE);
    gemm(stream, XB, DM, WIN, DM, MTOK, NPROJ, DM, 0, PROJ, NPROJ, nullptr, nullptr, nullptr);
    gemm(stream, HM, DM, WKV, DM, MMEM, 2048, DM, 0, MKV, 2048, nullptr, nullptr, nullptr);
    hipLaunchKernelGGL(k_post_qk, dim3(MTOK * 32 / 64), dim3(64), 0, stream, PROJ, dqw, dkw, fqw, fkw, ROPE);
    hipLaunchKernelGGL(k_cumsum, dim3(1), dim3(64), 0, stream, FLOG, b_forget, CUMB);
    hipLaunchKernelGGL(k_post_mk, dim3(MMEM), dim3(256), 0, stream, MKV, mkw, mqw, MKN);
    hipLaunchKernelGGL(k_post_mv, dim3(32 * 256 * 256 / 256), dim3(256), 0, stream, MKV, MVT);
    hipLaunchKernelGGL(k_attn, dim3(MTOK / 64, 8), dim3(64), 0, stream, PROJ, CUMB, 1, OF, 8);
    hipLaunchKernelGGL(k_fox_fin, dim3(MTOK * 512 / 256), dim3(256), 0, stream, OF, ATT);
    hipLaunchKernelGGL(k_attn, dim3(MTOK / 64, 16), dim3(64), 0, stream, PROJ, CUMB, 0, OF, 16);
    hipLaunchKernelGGL(k_diff_fin, dim3(MTOK), dim3(256), 0, stream, OF, lq1, lk1, lq2, lk2, subw, ATT);
    gemm(stream, ATT, DM, WOUT, DM, MTOK, DM, DM, 1, XB, DM, x, out, nullptr);
    hipLaunchKernelGGL(k_ss, dim3(MTOK / 4), dim3(256), 0, stream, out, SS);
    gemm(stream, XB, DM, WQ, DM, MTOK, DM, DM, 2, MQ, DM, nullptr, nullptr, SS);
    hipLaunchKernelGGL(k_xattn, dim3(MTOK), dim3(256), 0, stream, MQ, MKN, MVT, MO);
    gemm(stream, MO, DM, WO, DM, MTOK, DM, DM, 1, XB, DM, out, out, nullptr);
    hipLaunchKernelGGL(k_ss, dim3(MTOK / 4), dim3(256), 0, stream, out, SS);
    gemm(stream, XB, DM, WUP, DM, MTOK, DFF, DM, 3, H, DFF, nullptr, nullptr, SS);
    gemm(stream, H, DFF, WDN, DFF, MTOK, DM, DFF, 4, nullptr, 0, out, out, nullptr);
}
```

```cpp
#include <hip/hip_runtime.h>
#include <cstdint>
#include <cstdio>

typedef unsigned short bf16_t;
__device__ __forceinline__ float bf2f(bf16_t v) { return __uint_as_float(((unsigned)v) << 16); }
__device__ __forceinline__ bf16_t f2bf(float f) { unsigned u = __float_as_uint(f); return (bf16_t)((u + 0x7fffu + ((u >> 16) & 1u)) >> 16); }

constexpr int NB = 8, SEQ = 2048, DM = 1024, MTOK = NB * SEQ, MEML = 256, MMEM = NB * MEML;
constexpr int NPROJ = 3072, INCOLS = 3080, DFF = 4096;
constexpr float EPS = 1e-6f;
constexpr float LOG2E = 1.4426950408889634f;
constexpr float C2 = 0.125f * LOG2E;
constexpr float CM = 0.0625f * LOG2E;
constexpr int C_DQ = 0, C_DK = 512, C_DV = 1024, C_FQ = 1536, C_FK = 2048, C_FV = 2560;

constexpr size_t MiB = 1u << 20;
constexpr size_t WS_CTL = 0, CTL_ZERO_BYTES = 1 * MiB;
constexpr size_t WS_FLOG = 1 * MiB;
constexpr size_t WS_CUMB = 2 * MiB;
constexpr size_t WS_ROPE = 3 * MiB;
constexpr size_t WS_SS = 4 * MiB;
constexpr size_t WS_WIN = 8 * MiB, WS_WOUT = 14 * MiB, WS_WQ = 16 * MiB, WS_WKV = 18 * MiB, WS_WO = 22 * MiB, WS_WUP = 24 * MiB, WS_WDN = 32 * MiB;
constexpr size_t WS_XB = 40 * MiB;
constexpr size_t WS_HM = 72 * MiB;
constexpr size_t WS_MK = 76 * MiB;
constexpr size_t WS_VT = 80 * MiB;
constexpr size_t WS_MKN = 84 * MiB;
constexpr size_t WS_PROJ = 96 * MiB;
constexpr size_t WS_ATT = 192 * MiB;
constexpr size_t WS_MQ = 96 * MiB;
constexpr size_t WS_MO = 128 * MiB;
constexpr size_t WS_H = 96 * MiB;
constexpr size_t WS_END = 224 * MiB;
#define MK_HYBRID 0
namespace pg8 {
#define PG8_LAS __attribute__((address_space(3)))
typedef short bf16x8 __attribute__((ext_vector_type(8)));
typedef float f32x4 __attribute__((ext_vector_type(4)));
typedef unsigned u32x4 __attribute__((ext_vector_type(4)));
typedef unsigned u32x2 __attribute__((ext_vector_type(2)));
constexpr int BM = 256, BK = 64, HALF = 128, HTB = HALF * BK * 2  , STAGE_BYTES = 8 * HTB, NXCD = 8, WGM = 8;

__host__ __device__ __forceinline__ int lds_byte(int r, int c) { const int st = (r >> 4) * 2 + (c >> 5), rr = r & 15, cc = c & 31, ob = rr * 64 + cc * 2; return st * 1024 + (ob ^ (((ob >> 9) & 1) << 5)); }
__host__ __device__ __forceinline__ void stage_rc(int b, int& R, int& C) { const int st = b / 1024, sb = b % 1024, swz = sb ^ (((sb >> 9) & 1) << 5); R = (st >> 1) * 16 + swz / 64; C = (st & 1) * 32 + (swz % 64) / 2; }
__host__ __device__ __forceinline__ int perm32(int rho) { const int n = rho >> 4, i = rho & 15; return 8 * (i >> 2) + 4 * n + (i & 3); }

struct Unit { int pm, pn; };
struct Gemm { const bf16_t* A; const bf16_t* Bt; int lda, ldb, K; };

struct StaticOrder {
    int nM, nN, nwg, G, c;
    __host__ __device__ void init(int M, int N, int G_, int c_) { nM = M / BM; nN = N / BM; nwg = nM * nN; G = G_; c = c_; }
    __host__ __device__ bool next(int i, Unit& u) const {
        const long L = (long)i * G + c; if (L >= nwg) return false;
        int wgid = (int)L; { const int q = nwg / NXCD, r = nwg % NXCD, xcd = wgid % NXCD, off = wgid / NXCD; wgid = (xcd < r ? xcd * (q + 1) : r * (q + 1) + (xcd - r) * q) + off; }
        const int nig = WGM * nN, gid = wgid / nig, fm = gid * WGM, gsz = (nM - fm) < WGM ? (nM - fm) : WGM;
        u.pm = fm + ((wgid % nig) % gsz); u.pn = (wgid % nig) / gsz; return true;
    }
    __device__ __forceinline__ void a_ready(const Unit&) const {}
    __device__ __forceinline__ void done(const Unit&) const {}
};
struct OneUnit {
    int pm, pn; bool has;
    __device__ __forceinline__ bool next(int i, Unit& u) const { if (i != 0 || !has) return false; u.pm = pm; u.pn = pn; return true; }
    __device__ __forceinline__ void a_ready(const Unit&) const {}
    __device__ __forceinline__ void done(const Unit&) const {}
};

__device__ __forceinline__ unsigned cvt_pk_bf16(float lo, float hi) { unsigned r; asm volatile("v_cvt_pk_bf16_f32 %0, %1, %2" : "=v"(r) : "v"(lo), "v"(hi)); return r; }
#define PG8_LBAR() do { asm volatile("s_waitcnt lgkmcnt(0)" ::: "memory"); __builtin_amdgcn_s_barrier(); asm volatile("" ::: "memory"); } while (0)

template <int MODE> struct EpiStore {
    static constexpr bool PERM = true, AFTER_DRAIN = false;
    bf16_t* O; int ldc; const float* SS;
    __device__ __forceinline__ void operator()(const f32x4 (&acc)[2][2][4][2], const Unit& u, int wr, int wc, int fr, int fq) const {
        const int row0 = u.pm * BM + wr * 64 + fr, col0 = u.pn * BM + wc * 32 + 8 * fq;
#pragma unroll
        for (int ai = 0; ai < 2; ++ai)
#pragma unroll
            for (int m = 0; m < 4; ++m) { const int row = row0 + ai * HALF + m * 16; float rs = 1.f;
                if (MODE != 0) { const f32x4 s = *(const f32x4*)(SS + (size_t)row * 4); rs = rsqrtf(((s[0] + s[1]) + (s[2] + s[3])) * (1.f / DM) + EPS); }
                bf16_t* rowp = O + (size_t)row * ldc + col0;
#pragma unroll
                for (int bj = 0; bj < 2; ++bj) { f32x4 v0 = acc[ai][bj][m][0] * rs, v1 = acc[ai][bj][m][1] * rs;
                    if (MODE == 3) {
#pragma unroll
                        for (int e = 0; e < 4; ++e) { const float a = fmaxf(v0[e], 0.f), b = fmaxf(v1[e], 0.f); v0[e] = a * a; v1[e] = b * b; } }
                    u32x4 w; w.x = cvt_pk_bf16(v0[0], v0[1]); w.y = cvt_pk_bf16(v0[2], v0[3]); w.z = cvt_pk_bf16(v1[0], v1[1]); w.w = cvt_pk_bf16(v1[2], v1[3]);
                    *(u32x4*)(rowp + bj * HALF) = w; } }
    }
};
template <bool WITH_XB> struct EpiResid {
    static constexpr bool PERM = false, AFTER_DRAIN = true;
    const float* base; float* out; bf16_t* xb; float* SS;
    __device__ __forceinline__ void fused(f32x4 (&acc)[2][2][4][2], const Unit& u, int wr, int wc, int fr, int fq, PG8_LAS unsigned char* lds, int wid, int lane) const {
        PG8_LAS float* P = (PG8_LAS float*)lds;
        const int col0 = u.pn * BM + wc * 32 + 4 * fq;
#pragma unroll
        for (int ai = 0; ai < 2; ++ai)
#pragma unroll
            for (int m = 0; m < 4; ++m) { const int r = ai * HALF + wr * 64 + m * 16 + fr; const size_t off = (size_t)(u.pm * BM + r) * DM + col0; float s = 0.f;
#pragma unroll
                for (int bj = 0; bj < 2; ++bj)
#pragma unroll
                    for (int n = 0; n < 2; ++n) { const f32x4 bs = *(const f32x4*)(base + off + bj * HALF + n * 16); const f32x4 o = bs + acc[ai][bj][m][n];
                        *(f32x4*)(out + off + bj * HALF + n * 16) = o;
                        if (WITH_XB) { u32x2 w; w.x = cvt_pk_bf16(o[0], o[1]); w.y = cvt_pk_bf16(o[2], o[3]); *(u32x2*)(xb + off + bj * HALF + n * 16) = w; s += (o[0] * o[0] + o[1] * o[1]) + (o[2] * o[2] + o[3] * o[3]); } }
                if (WITH_XB) { s += __shfl_xor(s, 16); s += __shfl_xor(s, 32); if (fq == 0) P[r * 4 + wc] = s; }
                if (m & 1) asm volatile("" ::: "memory"); }
        if (WITH_XB) { PG8_LBAR();
            const int t = wid * 64 + lane; if (t < 256) { const f32x4 p = *(const PG8_LAS f32x4*)(P + t * 4); SS[(size_t)(u.pm * BM + t) * 4 + u.pn] = (p[0] + p[1]) + (p[2] + p[3]); } }
    }
};
struct EpiHeadNormK {
    static constexpr bool PERM = true, AFTER_DRAIN = true;
    bf16_t* MKn; const float* kw; const float* qw;
    __device__ __forceinline__ void fused(f32x4 (&acc)[2][2][4][2], const Unit& u, int wr, int wc, int fr, int fq, PG8_LAS unsigned char* lds, int wid, int lane) const {
        PG8_LAS float* P = (PG8_LAS float*)lds; PG8_LAS float* R = (PG8_LAS float*)(lds + 4096);
#pragma unroll
        for (int ai = 0; ai < 2; ++ai)
#pragma unroll
            for (int m = 0; m < 4; ++m) { float s = 0.f;
#pragma unroll
                for (int bj = 0; bj < 2; ++bj)
#pragma unroll
                    for (int n = 0; n < 2; ++n) { const f32x4 v = acc[ai][bj][m][n]; s += (v[0] * v[0] + v[1] * v[1]) + (v[2] * v[2] + v[3] * v[3]); }
                s += __shfl_xor(s, 16); s += __shfl_xor(s, 32); if (fq == 0) P[(ai * HALF + wr * 64 + m * 16 + fr) * 4 + wc] = s; }
        PG8_LBAR();
        { const int t = wid * 64 + lane; if (t < 256) { const f32x4 p = *(const PG8_LAS f32x4*)(P + t * 4); R[t] = rsqrtf(((p[0] + p[1]) + (p[2] + p[3])) * (1.f / 256.f) + EPS); } }
        PG8_LBAR();
        const int c0 = wc * 32 + 8 * fq; f32x4 g[2][2];
#pragma unroll
        for (int bj = 0; bj < 2; ++bj)
#pragma unroll
            for (int n = 0; n < 2; ++n) { const f32x4 a = *(const f32x4*)(kw + c0 + bj * HALF + 4 * n), b = *(const f32x4*)(qw + c0 + bj * HALF + 4 * n); g[bj][n] = a * b * CM; }
        bf16_t* basep = MKn + (size_t)(u.pm * 4 + u.pn) * 65536;
#pragma unroll
        for (int ai = 0; ai < 2; ++ai)
#pragma unroll
            for (int m = 0; m < 4; ++m) { const int r = ai * HALF + wr * 64 + m * 16 + fr; const float rk = R[r];
#pragma unroll
                for (int bj = 0; bj < 2; ++bj) { const f32x4 v0 = acc[ai][bj][m][0] * rk * g[bj][0], v1 = acc[ai][bj][m][1] * rk * g[bj][1];
                    u32x4 w; w.x = cvt_pk_bf16(v0[0], v0[1]); w.y = cvt_pk_bf16(v0[2], v0[3]); w.z = cvt_pk_bf16(v1[0], v1[1]); w.w = cvt_pk_bf16(v1[2], v1[3]);
                    *(u32x4*)(basep + (size_t)r * 256 + c0 + bj * HALF) = w; } }
    }
};
struct EpiMemQ {
    static constexpr bool PERM = true, AFTER_DRAIN = true;
    bf16_t* MQ; const float* SS; PG8_LAS float* RQ;
    __device__ __forceinline__ void fused(f32x4 (&acc)[2][2][4][2], const Unit& u, int wr, int wc, int fr, int fq, PG8_LAS unsigned char* lds, int wid, int lane) const {
        PG8_LAS float* P = (PG8_LAS float*)lds;
        const int col0 = u.pn * BM + wc * 32 + 8 * fq;
#pragma unroll
        for (int ai = 0; ai < 2; ++ai)
#pragma unroll
            for (int m = 0; m < 4; ++m) { const int r = ai * HALF + wr * 64 + m * 16 + fr; const int row = u.pm * BM + r;
                const f32x4 ss = *(const f32x4*)(SS + (size_t)row * 4); const float rs = rsqrtf(((ss[0] + ss[1]) + (ss[2] + ss[3])) * (1.f / DM) + EPS); float s = 0.f;
#pragma unroll
                for (int bj = 0; bj < 2; ++bj) { const f32x4 v0 = acc[ai][bj][m][0] * rs, v1 = acc[ai][bj][m][1] * rs;
                    s += (v0[0] * v0[0] + v0[1] * v0[1]) + (v0[2] * v0[2] + v0[3] * v0[3]) + (v1[0] * v1[0] + v1[1] * v1[1]) + (v1[2] * v1[2] + v1[3] * v1[3]);
                    u32x4 w; w.x = cvt_pk_bf16(v0[0], v0[1]); w.y = cvt_pk_bf16(v0[2], v0[3]); w.z = cvt_pk_bf16(v1[0], v1[1]); w.w = cvt_pk_bf16(v1[2], v1[3]);
                    *(u32x4*)(MQ + (size_t)row * DM + col0 + bj * HALF) = w; }
                s += __shfl_xor(s, 16); s += __shfl_xor(s, 32); if (fq == 0) P[r * 4 + wc] = s; }
        PG8_LBAR();
        { const int t = wid * 64 + lane; if (t < 256) { const f32x4 p = *(const PG8_LAS f32x4*)(P + t * 4); RQ[t] = rsqrtf(((p[0] + p[1]) + (p[2] + p[3])) * (1.f / 256.f) + EPS); } }
        PG8_LBAR();
    }
};
struct EpiMemS {
    static constexpr bool PERM = true, AFTER_DRAIN = true;
    bf16_t* Pt; int head; const PG8_LAS float* RQ; PG8_LAS float* IL;
    __device__ __forceinline__ void fused(f32x4 (&acc)[2][2][4][2], const Unit& u, int wr, int wc, int fr, int fq, PG8_LAS unsigned char* lds, int wid, int lane) const {
        PG8_LAS float* P = (PG8_LAS float*)lds;
        const int col0 = head * BM + wc * 32 + 8 * fq;
#pragma unroll
        for (int ai = 0; ai < 2; ++ai)
#pragma unroll
            for (int m = 0; m < 4; ++m) { const int r = ai * HALF + wr * 64 + m * 16 + fr; const int row = u.pm * BM + r; const float rq = RQ[r]; float s = 0.f;
#pragma unroll
                for (int bj = 0; bj < 2; ++bj) { f32x4 v0 = acc[ai][bj][m][0] * rq, v1 = acc[ai][bj][m][1] * rq;
#pragma unroll
                    for (int e = 0; e < 4; ++e) { v0[e] = __builtin_amdgcn_exp2f(v0[e]); v1[e] = __builtin_amdgcn_exp2f(v1[e]); }
                    s += (v0[0] + v0[1]) + (v0[2] + v0[3]) + (v1[0] + v1[1]) + (v1[2] + v1[3]);
                    u32x4 w; w.x = cvt_pk_bf16(v0[0], v0[1]); w.y = cvt_pk_bf16(v0[2], v0[3]); w.z = cvt_pk_bf16(v1[0], v1[1]); w.w = cvt_pk_bf16(v1[2], v1[3]);
                    *(u32x4*)(Pt + (size_t)row * DM + col0 + bj * HALF) = w; }
                s += __shfl_xor(s, 16); s += __shfl_xor(s, 32); if (fq == 0) P[r * 4 + wc] = s; }
        PG8_LBAR();
        { const int t = wid * 64 + lane; if (t < 256) { const f32x4 p = *(const PG8_LAS f32x4*)(P + t * 4); IL[t] = 1.0f / ((p[0] + p[1]) + (p[2] + p[3])); } }
        PG8_LBAR();
    }
};
struct EpiMemPV {
    static constexpr bool PERM = true, AFTER_DRAIN = false;
    bf16_t* MO; int head; const PG8_LAS float* IL;
    __device__ __forceinline__ void operator()(const f32x4 (&acc)[2][2][4][2], const Unit& u, int wr, int wc, int fr, int fq) const {
        const int col0 = head * BM + wc * 32 + 8 * fq;
#pragma unroll
        for (int ai = 0; ai < 2; ++ai)
#pragma unroll
            for (int m = 0; m < 4; ++m) { const int r = ai * HALF + wr * 64 + m * 16 + fr; const int row = u.pm * BM + r; const float il = IL[r];
#pragma unroll
                for (int bj = 0; bj < 2; ++bj) { const f32x4 v0 = acc[ai][bj][m][0] * il, v1 = acc[ai][bj][m][1] * il;
                    u32x4 w; w.x = cvt_pk_bf16(v0[0], v0[1]); w.y = cvt_pk_bf16(v0[2], v0[3]); w.z = cvt_pk_bf16(v1[0], v1[1]); w.w = cvt_pk_bf16(v1[2], v1[3]);
                    *(u32x4*)(MO + (size_t)row * DM + col0 + bj * HALF) = w; } }
    }
};

template <class Epi, class Sched, bool ALIGN_EPI = false, bool SP2 = false>
__device__ __forceinline__ void gemm_phase(PG8_LAS unsigned char* lds, const Gemm g, const Sched& S, const Epi& E) {
    const int tid = threadIdx.x, wid = __builtin_amdgcn_readfirstlane(tid >> 6), lane = tid & 63, wr = wid >> 2, wc = wid & 3, fr = lane & 15, fq = lane >> 4;
    const int K = g.K, nt = K / BK;
    unsigned voffA[2], voffB[2];
#pragma unroll
    for (int i = 0; i < 2; ++i) { int R, C; stage_rc(tid * 16 + i * 8192, R, C); const int Rb = Epi::PERM ? ((R & ~31) + perm32(R & 31)) : R;
        voffA[i] = (unsigned)(R * g.lda + C) * 2u; voffB[i] = (unsigned)(Rb * g.ldb + C) * 2u; }
    const size_t kstep = (size_t)(BK * 2);
    const size_t hsA = (size_t)HALF * g.lda * 2, hsB = (size_t)HALF * g.ldb * 2;
    const size_t tsA = 2 * hsA, tsB = 2 * hsB;
    const unsigned ldsw = (unsigned)wid * 1024u;
    const int aoff = lds_byte(wr * 64 + fr, fq * 8), boff = lds_byte(wc * 32 + fr, fq * 8);
#define PG8_SA(b, h) (((b) * 2 + (h)) * HTB)
#define PG8_SB(b, h) ((4 + (b) * 2 + (h)) * HTB)
#define PG8_STAGE(bufoff, gbase, voff) do { _Pragma("unroll") for (int _i = 0; _i < 2; ++_i) \
        __builtin_amdgcn_global_load_lds((const unsigned*)((const char*)(gbase) + (voff)[_i]), (PG8_LAS unsigned*)(lds + (bufoff) + ldsw + _i * 8192), 16, 0, 0); } while (0)
#define PG8_LDA(dst, b, h) do { _Pragma("unroll") for (int m = 0; m < 4; ++m) _Pragma("unroll") for (int k = 0; k < 2; ++k) dst[m][k] = *(const PG8_LAS bf16x8*)(lds + PG8_SA(b, h) + aoff + m * 2048 + k * 1024); } while (0)
#define PG8_LDB(dst, b, h) do { _Pragma("unroll") for (int n = 0; n < 2; ++n) _Pragma("unroll") for (int k = 0; k < 2; ++k) dst[n][k] = *(const PG8_LAS bf16x8*)(lds + PG8_SB(b, h) + boff + n * 2048 + k * 1024); } while (0)
#define PG8_MMA(ai, bj, At, Bt) do { __builtin_amdgcn_s_setprio(1); _Pragma("unroll") for (int m = 0; m < 4; ++m) _Pragma("unroll") for (int n = 0; n < 2; ++n) _Pragma("unroll") for (int k = 0; k < 2; ++k) \
        acc[ai][bj][m][n] = __builtin_amdgcn_mfma_f32_16x16x32_bf16(Bt[n][k], At[m][k], acc[ai][bj][m][n], 0, 0, 0); __builtin_amdgcn_s_setprio(0); } while (0)
#define PG8_WAIT_V(n) asm volatile("s_waitcnt vmcnt(" #n ")" ::: "memory")
#define PG8_WAIT_L(n) asm volatile("s_waitcnt lgkmcnt(" #n ")" ::: "memory")
#define PG8_BAR __builtin_amdgcn_s_barrier()
#define PG8_SCHED __builtin_amdgcn_sched_barrier(0)
    Unit cur, nxt; int ui = 0;
    if (!S.next(0, cur)) return;
    f32x4 acc[2][2][4][2];
#pragma unroll
    for (int a = 0; a < 2; ++a)
#pragma unroll
        for (int b = 0; b < 2; ++b)
#pragma unroll
            for (int m = 0; m < 4; ++m)
#pragma unroll
                for (int n = 0; n < 2; ++n) acc[a][b][m][n] = (f32x4){0.f, 0.f, 0.f, 0.f};
    bf16x8 At[4][2], B0[2][2], B1[2][2];
    const char* cA = (const char*)g.A + (size_t)cur.pm * tsA; const char* cB = (const char*)g.Bt + (size_t)cur.pn * tsB;
    S.a_ready(cur);
    if constexpr (SP2) {
        PG8_STAGE(PG8_SB(0, 0), cB, voffB); PG8_STAGE(PG8_SB(0, 1), cB + hsB, voffB); PG8_STAGE(PG8_SA(0, 0), cA, voffA); PG8_STAGE(PG8_SA(0, 1), cA + hsA, voffA);
        if (wr == 1) PG8_BAR;
        PG8_WAIT_V(2); PG8_BAR;
        PG8_STAGE(PG8_SB(1, 0), cB + kstep, voffB); PG8_STAGE(PG8_SA(1, 0), cA + kstep, voffA); PG8_STAGE(PG8_SB(1, 1), cB + hsB + kstep, voffB);
        PG8_WAIT_V(6); PG8_BAR;
    } else {
        PG8_STAGE(PG8_SB(0, 0), cB, voffB); PG8_STAGE(PG8_SA(0, 0), cA, voffA); PG8_STAGE(PG8_SB(0, 1), cB + hsB, voffB); PG8_STAGE(PG8_SA(0, 1), cA + hsA, voffA);
        if (wr == 1) PG8_BAR;
        PG8_WAIT_V(4); PG8_BAR;
        PG8_STAGE(PG8_SB(1, 0), cB + kstep, voffB); PG8_STAGE(PG8_SA(1, 0), cA + kstep, voffA); PG8_STAGE(PG8_SB(1, 1), cB + hsB + kstep, voffB);
        PG8_WAIT_V(6); PG8_BAR;
    }
    for (;;) {
        const bool has_next = S.next(ui + 1, nxt);
        const char* nA = has_next ? (const char*)g.A + (size_t)nxt.pm * tsA : cA; const char* nB = has_next ? (const char*)g.Bt + (size_t)nxt.pn * tsB : cB;
        for (int t = 0; t < nt; t += 2) {
            const bool last = (t == nt - 2);
            const char* a1 = cA + (size_t)(t + 1) * kstep;
            const char* a2 = last ? nA : cA + (size_t)(t + 2) * kstep; const char* b2 = last ? nB : cB + (size_t)(t + 2) * kstep;
            const char* a3 = a2 + kstep; const char* b3 = b2 + kstep;
            if (last && has_next) S.a_ready(nxt);
            if constexpr (SP2) {
            PG8_LDB(B0, 0, 0); PG8_LDB(B1, 0, 1); PG8_SCHED; PG8_LDA(At, 0, 0); PG8_STAGE(PG8_SA(1, 1), a1 + hsA, voffA);
            PG8_WAIT_V(8); PG8_WAIT_L(0); PG8_BAR; PG8_MMA(0, 0, At, B0); PG8_MMA(0, 1, At, B1); PG8_BAR; PG8_SCHED;
            PG8_LDA(At, 0, 1); PG8_STAGE(PG8_SB(0, 0), b2, voffB); PG8_STAGE(PG8_SB(0, 1), b2 + hsB, voffB); PG8_STAGE(PG8_SA(0, 0), a2, voffA);
            PG8_WAIT_V(8); PG8_WAIT_L(0); PG8_BAR; PG8_MMA(1, 0, At, B0); PG8_MMA(1, 1, At, B1); PG8_BAR; PG8_SCHED;
            PG8_LDB(B0, 1, 0); PG8_LDB(B1, 1, 1); PG8_SCHED; PG8_LDA(At, 1, 0); PG8_STAGE(PG8_SA(0, 1), a2 + hsA, voffA);
            PG8_WAIT_V(8); PG8_WAIT_L(0); PG8_BAR; PG8_MMA(0, 0, At, B0); PG8_MMA(0, 1, At, B1); PG8_BAR; PG8_SCHED;
            PG8_LDA(At, 1, 1); PG8_STAGE(PG8_SB(1, 0), b3, voffB); PG8_STAGE(PG8_SB(1, 1), b3 + hsB, voffB); PG8_STAGE(PG8_SA(1, 0), a3, voffA);
            PG8_WAIT_V(8); PG8_WAIT_L(0); PG8_BAR; PG8_MMA(1, 0, At, B0); PG8_MMA(1, 1, At, B1); PG8_BAR; PG8_SCHED;
            } else {
            PG8_LDB(B0, 0, 0); PG8_SCHED; PG8_LDA(At, 0, 0); PG8_STAGE(PG8_SA(1, 1), a1 + hsA, voffA);
            PG8_WAIT_L(8); PG8_BAR; PG8_WAIT_L(0); PG8_MMA(0, 0, At, B0); PG8_BAR; PG8_SCHED;
            PG8_LDB(B1, 0, 1); PG8_STAGE(PG8_SB(0, 0), b2, voffB);
            PG8_BAR; PG8_WAIT_L(0); PG8_MMA(0, 1, At, B1); PG8_BAR;
            PG8_LDA(At, 0, 1); PG8_STAGE(PG8_SA(0, 0), a2, voffA);
            PG8_BAR; PG8_WAIT_L(0); PG8_MMA(1, 0, At, B0); PG8_BAR; PG8_SCHED;
            PG8_STAGE(PG8_SB(0, 1), b2 + hsB, voffB);
            PG8_WAIT_V(6); PG8_BAR; PG8_MMA(1, 1, At, B1); PG8_BAR;
            PG8_LDB(B0, 1, 0); PG8_SCHED; PG8_LDA(At, 1, 0); PG8_STAGE(PG8_SA(0, 1), a2 + hsA, voffA);
            PG8_WAIT_L(8); PG8_BAR; PG8_WAIT_L(0); PG8_MMA(0, 0, At, B0); PG8_BAR; PG8_SCHED;
            PG8_LDB(B1, 1, 1); PG8_STAGE(PG8_SB(1, 0), b3, voffB);
            PG8_BAR; PG8_WAIT_L(0); PG8_MMA(0, 1, At, B1); PG8_BAR;
            PG8_LDA(At, 1, 1); PG8_STAGE(PG8_SA(1, 0), a3, voffA);
            PG8_BAR; PG8_WAIT_L(0); PG8_MMA(1, 0, At, B0); PG8_BAR; PG8_SCHED;
            PG8_STAGE(PG8_SB(1, 1), b3 + hsB, voffB);
            PG8_WAIT_V(6); PG8_BAR; PG8_MMA(1, 1, At, B1); PG8_BAR;
            }
        }
        if constexpr (ALIGN_EPI) { if (wr == 0) PG8_BAR; }
        if constexpr (!Epi::AFTER_DRAIN) { int fr2 = fr, fq2 = fq; asm volatile("" : "+v"(fr2), "+v"(fq2)); E(acc, cur, wr, wc, fr2, fq2); S.done(cur); }
        if (!has_next) break;
#pragma unroll
        for (int a = 0; a < 2; ++a)
#pragma unroll
            for (int b = 0; b < 2; ++b)
#pragma unroll
                for (int m = 0; m < 4; ++m)
#pragma unroll
                    for (int n = 0; n < 2; ++n) acc[a][b][m][n] = (f32x4){0.f, 0.f, 0.f, 0.f};
        cur = nxt; cA = nA; cB = nB; ++ui;
        if constexpr (ALIGN_EPI) { if (wr == 1) PG8_BAR; }
    }
    PG8_WAIT_V(0);
    if constexpr (!ALIGN_EPI) { if (wr == 0) PG8_BAR; }
    PG8_BAR;
    if constexpr (Epi::AFTER_DRAIN) { int fr2 = fr, fq2 = fq, lane2 = lane; asm volatile("" : "+v"(fr2), "+v"(fq2), "+v"(lane2)); E.fused(acc, cur, wr, wc, fr2, fq2, lds, wid, lane2); S.done(cur); }
#undef PG8_SA
#undef PG8_SB
#undef PG8_STAGE
#undef PG8_LDA
#undef PG8_LDB
#undef PG8_MMA
#undef PG8_WAIT_V
#undef PG8_WAIT_L
#undef PG8_BAR
#undef PG8_SCHED
}}

#define GAS __attribute__((address_space(1)))
#define LAS __attribute__((address_space(3)))
typedef unsigned v4u __attribute__((ext_vector_type(4)));
typedef float f32x4 __attribute__((ext_vector_type(4)));
typedef short bf16x8 __attribute__((ext_vector_type(8)));
typedef GAS unsigned gu32;
typedef GAS unsigned long long gu64;
#define RLX_AGENT __ATOMIC_RELAXED, __HIP_MEMORY_SCOPE_AGENT
#define LDS_WAIT() asm volatile("s_waitcnt lgkmcnt(0)" ::: "memory")
#define VM_WAIT() asm volatile("s_waitcnt vmcnt(0)" ::: "memory")
__device__ __forceinline__ unsigned long long rt() { return __builtin_amdgcn_s_memrealtime(); }
__device__ __forceinline__ unsigned pk2(float lo, float hi) { return (unsigned)f2bf(lo) | ((unsigned)f2bf(hi) << 16); }

#define XB_TMO      128
#define XB_XCNT(j)  (256  + 64 * (j))
#define XB_XSUB(j)  (1280 + 64 * (j))
#define XB_XGEN(j)  (2304 + 64 * (j))
#define XB_TOP      3328
#define XB_TOPGEN   3392
#define XCD_BAR_WORDS 3456
#define XB_SPIN_CAP (1u << 18)

__device__ __forceinline__ unsigned xb_ld(unsigned* p)              { return __hip_atomic_load(p, __ATOMIC_RELAXED, __HIP_MEMORY_SCOPE_AGENT); }
__device__ __forceinline__ unsigned xb_add(unsigned* p, unsigned v) { return __hip_atomic_fetch_add(p, v, __ATOMIC_RELAXED, __HIP_MEMORY_SCOPE_AGENT); }
__device__ __forceinline__ unsigned xb_xcc_id() { return (unsigned)__builtin_amdgcn_s_getreg((3 << 11) | 20) & 0xFu; }
#define XB_SPIN(cond, bar) do { unsigned _sp = 0; while (cond) { __builtin_amdgcn_s_sleep(1); \
    if ((++_sp & 255u) == 0u) { if (xb_ld(&(bar)[XB_TMO])) break; if (_sp > XB_SPIN_CAP) { atomicAdd(&(bar)[XB_TMO], 1u); break; } } } } while (0)

struct XcdBarrier {
    unsigned* bar; unsigned x;
    volatile LAS unsigned* st;
};

__device__ __forceinline__ XcdBarrier xcd_barrier_post(unsigned* bar, volatile LAS unsigned* st) {
    XcdBarrier b; b.bar = bar; b.x = xb_xcc_id(); b.st = st;
    if (threadIdx.x == 0) (void)xb_add(&bar[XB_XCNT(b.x)], 1u);
    return b;
}
__device__ __forceinline__ void xcd_barrier_complete(unsigned* bar, unsigned x, unsigned& nloc, unsigned& nx) {
    const unsigned G = gridDim.x * gridDim.y * gridDim.z;
    unsigned sum, cnt, mine, sp = 0u;
    for (;;) {
        sum = 0u; cnt = 0u; mine = 0u;
#pragma unroll
        for (unsigned j = 0; j < 16; ++j) { const unsigned c = xb_ld(&bar[XB_XCNT(j)]); sum += c; cnt += (c > 0u) ? 1u : 0u; mine = (j == x) ? c : mine; }
        if (sum == G) break;
        __builtin_amdgcn_s_sleep(1);
        if ((++sp & 255u) == 0u) { if (xb_ld(&bar[XB_TMO])) break; if (sp > XB_SPIN_CAP) { atomicAdd(&bar[XB_TMO], 1u); break; } }
    }
    nloc = mine > 0u ? mine : 1u; nx = cnt > 0u ? cnt : 1u;
}

__device__ __forceinline__ void xcd_barrier(const XcdBarrier& b) {
    asm volatile("s_waitcnt vmcnt(0)" ::: "memory");
    __syncthreads();
    if (threadIdx.x == 0) {
        unsigned* bar = b.bar;
        __builtin_amdgcn_s_waitcnt(0);
        unsigned nloc = b.st[0], nx = b.st[1];
        if (nloc == 0u) { xcd_barrier_complete(bar, b.x, nloc, nx); b.st[0] = nloc; b.st[1] = nx; }
        const unsigned old = xb_add(&bar[XB_XSUB(b.x)], 1u);
        const unsigned gen = old / nloc;
        if (old + 1u == (gen + 1u) * nloc) {
            __builtin_amdgcn_fence(__ATOMIC_RELEASE, "agent");
            asm volatile("s_waitcnt vmcnt(0)" ::: "memory");
            const unsigned og = xb_add(&bar[XB_TOP], 1u);
            const unsigned tg = og / nx;
            if (og + 1u == (tg + 1u) * nx) xb_add(&bar[XB_TOPGEN], 1u);
            else XB_SPIN(xb_ld(&bar[XB_TOPGEN]) == tg, bar);
            __builtin_amdgcn_fence(__ATOMIC_ACQUIRE, "agent");
            xb_add(&bar[XB_XGEN(b.x)], 1u);
            asm volatile("s_waitcnt vmcnt(0)" ::: "memory");
        } else {
            XB_SPIN(xb_ld(&bar[XB_XGEN(b.x)]) == gen, bar);
            __builtin_amdgcn_fence(__ATOMIC_ACQUIRE, "agent");
            asm volatile("s_waitcnt vmcnt(0)" ::: "memory");
        }
    }
    __syncthreads();
}
constexpr int NWAVES = 8;
constexpr int RING_OFF = 0, RING_BYTES = 131072;
constexpr int LDSCTL_OFF = RING_BYTES, MISC_OFF = LDSCTL_OFF + 320;
constexpr int LDS_RQ = RING_BYTES + 1024, LDS_IL = RING_BYTES + 2048;
constexpr int LDS_BYTES = 147456;
constexpr int CW_TMO = 0, CW_BAR = 4096;

struct Frame {
    LAS unsigned char* lds; volatile LAS unsigned* MISC; gu32* ctl;
    int tid, lane, wave, vcu, G;
};
struct Args { const void* in[26]; float* out; unsigned char* ws; int ph_lo, ph_hi; };

__device__ __forceinline__ float wave_sum(float v) {
#pragma unroll
    for (int o = 1; o < 64; o <<= 1) v += __shfl_xor(v, o);
    return v;
}
__device__ __forceinline__ void p0_transpose_item(const float* W, int ldw, int K, int N, const float* g, bf16_t* WT, LAS float* scr, int item, int lane) {
    const int nblk = N / 32, kb = item / nblk, nb = item % nblk, k0 = 64 * kb, n0 = 32 * nb;
#pragma unroll 8
    for (int i = 0; i < 32; ++i) { const int kk = 2 * i + (lane >> 5); const float gg = g ? g[k0 + kk] : 1.f; scr[kk * 33 + (lane & 31)] = W[(size_t)(k0 + kk) * ldw + n0 + (lane & 31)] * gg; }
    LDS_WAIT(); asm volatile("" ::: "memory");
    const int c = lane & 7;
#pragma unroll
    for (int j = 0; j < 4; ++j) { const int n = (lane >> 3) + 8 * j; const LAS float* s = scr + (8 * c) * 33 + n;
        v4u o; o.x = pk2(s[0 * 33], s[1 * 33]); o.y = pk2(s[2 * 33], s[3 * 33]); o.z = pk2(s[4 * 33], s[5 * 33]); o.w = pk2(s[6 * 33], s[7 * 33]);
        *(GAS v4u*)(WT + (size_t)(n0 + n) * K + k0 + 8 * c) = o; }
    LDS_WAIT(); asm volatile("" ::: "memory");
}
template <bool FLOG> __device__ __forceinline__ void rms_row_to_bf16(int lane, const float* xrow, bf16_t* orow, const float* g, const float* win, float* flog) {
    const GAS f32x4* xr = (const GAS f32x4*)xrow + lane;
    f32x4 v[4]; float s2 = 0.f;
#pragma unroll
    for (int j = 0; j < 4; ++j) { v[j] = xr[64 * j]; s2 += (v[j].x * v[j].x + v[j].y * v[j].y) + (v[j].z * v[j].z + v[j].w * v[j].w); }
    const float rstd = rsqrtf(wave_sum(s2) * (1.f / DM) + EPS);
    GAS unsigned long long* o8 = (GAS unsigned long long*)orow + lane;
#pragma unroll
    for (int j = 0; j < 4; ++j) { v[j] = v[j] * rstd; o8[64 * j] = (unsigned long long)pk2(v[j].x, v[j].y) | ((unsigned long long)pk2(v[j].z, v[j].w) << 32); }
    if (FLOG) {
        f32x4 a0 = {0.f, 0.f, 0.f, 0.f}, a1 = {0.f, 0.f, 0.f, 0.f};
#pragma unroll
        for (int j = 0; j < 4; ++j) { const f32x4 gg = *(const GAS f32x4*)(g + 256 * j + 4 * lane);
#pragma unroll
            for (int e = 0; e < 4; ++e) { const int k = 256 * j + 4 * lane + e; const float h = v[j][e] * gg[e];
                const f32x4 w0 = *(const GAS f32x4*)(win + (size_t)k * INCOLS + NPROJ), w1 = *(const GAS f32x4*)(win + (size_t)k * INCOLS + NPROJ + 4);
                a0 += w0 * h; a1 += w1 * h; } }
#pragma unroll
        for (int e = 0; e < 4; ++e) { a0[e] = wave_sum(a0[e]); a1[e] = wave_sum(a1[e]); }
        if (lane == 0) { *(GAS f32x4*)(flog) = a0; *(GAS f32x4*)(flog + 4) = a1; }
    }
}
__constant__ float INV_FREQ[8] = {1.0f, 0.1939227432012558f, 0.03760603070259094f, 0.007292664609849453f, 0.0014142135623842478f, 0.00027424818836152554f, 5.318296098266728e-05f, 1.0313386155758053e-05f};

struct Ptrs {
    const float *x, *mem; const int* pos; const float *norm_mix_w, *w_in, *b_forget, *dqw, *dkw, *lq1, *lk1, *lq2, *lk2, *subw, *fqw, *fkw, *w_out, *nmq, *nmkv, *w_mq, *w_mkv, *mqw, *mkw, *w_mo, *nmlp, *w_up, *w_dn;
    float* out; float *FLOG, *CUMB, *ROPE, *SS;
    bf16_t *WIN, *WOUT, *WQ, *WKV, *WO, *WUP, *WDN, *XB, *HM, *MK, *VT, *MKN, *PROJ, *ATT, *MQ, *MO, *H;
};
__host__ __device__ __forceinline__ Ptrs make_ptrs(const void* const* in, float* out, unsigned char* ws) {
    Ptrs p;
    p.x = (const float*)in[0]; p.mem = (const float*)in[1]; p.pos = (const int*)in[2]; p.norm_mix_w = (const float*)in[3]; p.w_in = (const float*)in[4]; p.b_forget = (const float*)in[5];
    p.dqw = (const float*)in[6]; p.dkw = (const float*)in[7]; p.lq1 = (const float*)in[8]; p.lk1 = (const float*)in[9]; p.lq2 = (const float*)in[10]; p.lk2 = (const float*)in[11];
    p.subw = (const float*)in[12]; p.fqw = (const float*)in[13]; p.fkw = (const float*)in[14]; p.w_out = (const float*)in[15]; p.nmq = (const float*)in[16]; p.nmkv = (const float*)in[17];
    p.w_mq = (const float*)in[18]; p.w_mkv = (const float*)in[19]; p.mqw = (const float*)in[20]; p.mkw = (const float*)in[21]; p.w_mo = (const float*)in[22]; p.nmlp = (const float*)in[23];
    p.w_up = (const float*)in[24]; p.w_dn = (const float*)in[25]; p.out = out;
    p.FLOG = (float*)(ws + WS_FLOG); p.CUMB = (float*)(ws + WS_CUMB); p.ROPE = (float*)(ws + WS_ROPE); p.SS = (float*)(ws + WS_SS);
    p.WIN = (bf16_t*)(ws + WS_WIN); p.WOUT = (bf16_t*)(ws + WS_WOUT); p.WQ = (bf16_t*)(ws + WS_WQ); p.WKV = (bf16_t*)(ws + WS_WKV); p.WO = (bf16_t*)(ws + WS_WO); p.WUP = (bf16_t*)(ws + WS_WUP); p.WDN = (bf16_t*)(ws + WS_WDN);
    p.XB = (bf16_t*)(ws + WS_XB); p.HM = (bf16_t*)(ws + WS_HM); p.MK = (bf16_t*)(ws + WS_MK); p.VT = (bf16_t*)(ws + WS_VT); p.MKN = (bf16_t*)(ws + WS_MKN);
    p.PROJ = (bf16_t*)(ws + WS_PROJ); p.ATT = (bf16_t*)(ws + WS_ATT); p.MQ = (bf16_t*)(ws + WS_MQ); p.MO = (bf16_t*)(ws + WS_MO); p.H = (bf16_t*)(ws + WS_H);
    return p;
}

__device__ __forceinline__ void p0_prologue(Frame& F, const Ptrs& P) {
    LAS float* scr = (LAS float*)(F.lds + RING_OFF + F.wave * 16384);
    const int gw = F.vcu * NWAVES + F.wave, NGW = F.G * NWAVES;
    constexpr int I_IN = 16 * 96, I_SQ = 16 * 32, I_KV = 16 * 64, I_UP = 16 * 128, I_DN = 64 * 32;
    constexpr int NITEMS = I_IN + 3 * I_SQ + I_KV + I_UP + I_DN;
    for (int it = gw; it < NITEMS; it += NGW) {
        int r = it;
        if (r < I_IN) { p0_transpose_item(P.w_in, INCOLS, DM, NPROJ, P.norm_mix_w, P.WIN, scr, r, F.lane); continue; } r -= I_IN;
        if (r < I_SQ) { p0_transpose_item(P.w_out, DM, DM, DM, nullptr, P.WOUT, scr, r, F.lane); continue; } r -= I_SQ;
        if (r < I_SQ) { p0_transpose_item(P.w_mq, DM, DM, DM, P.nmq, P.WQ, scr, r, F.lane); continue; } r -= I_SQ;
        if (r < I_KV) { p0_transpose_item(P.w_mkv, 2048, DM, 2048, P.nmkv, P.WKV, scr, r, F.lane); continue; } r -= I_KV;
        if (r < I_SQ) { p0_transpose_item(P.w_mo, DM, DM, DM, nullptr, P.WO, scr, r, F.lane); continue; } r -= I_SQ;
        if (r < I_UP) { p0_transpose_item(P.w_up, DFF, DM, DFF, P.nmlp, P.WUP, scr, r, F.lane); continue; } r -= I_UP;
        p0_transpose_item(P.w_dn, DM, DFF, DM, nullptr, P.WDN, scr, r, F.lane);
    }
    for (int m = gw; m < MTOK; m += NGW) rms_row_to_bf16<true>(F.lane, P.x + (size_t)m * DM, P.XB + (size_t)m * DM, P.norm_mix_w, P.w_in, P.FLOG + (size_t)m * 8);
    for (int m = gw; m < MMEM; m += NGW) rms_row_to_bf16<false>(F.lane, P.mem + (size_t)m * DM, P.HM + (size_t)m * DM, nullptr, nullptr, nullptr);
    for (int id = (F.vcu * NWAVES * 64) + F.tid; id < MTOK * 8; id += F.G * NWAVES * 64) {
        const int row = id >> 3, i = id & 7;
        const float ang = (float)P.pos[row] * INV_FREQ[i];
        const double a = (double)ang; const double k = rint(a * 0.15915494309189535); const float r = (float)fma(-k, 6.283185307179586, a);
        P.ROPE[(size_t)row * 16 + i] = cosf(r); P.ROPE[(size_t)row * 16 + 8 + i] = sinf(r);
    }
}
__device__ __forceinline__ void p1b_row(bf16_t* PROJ, const float* dqw, const float* dkw, const float* fqw, const float* fkw, const float* ROPE, int row, int lane) {
    const int sg = lane >> 1, hf = lane & 1;
    const int col = (sg < 16 ? sg * 64 : 1536 + (sg - 16) * 64) + hf * 32;
    const float* w = (sg < 8 ? dqw : sg < 16 ? dkw : sg < 24 ? fqw : fkw) + hf * 32;
    const bool rope = (sg < 16) && (hf == 0), isq = (sg < 8) || (sg >= 16 && sg < 24);
    GAS v4u* p = (GAS v4u*)(PROJ + (size_t)row * NPROJ + col);
    const v4u u0 = p[0], u1 = p[1], u2 = p[2], u3 = p[3];
#define UNP_LO(u) (f32x4){__uint_as_float(u.x << 16), __uint_as_float(u.x & 0xffff0000u), __uint_as_float(u.y << 16), __uint_as_float(u.y & 0xffff0000u)}
#define UNP_HI(u) (f32x4){__uint_as_float(u.z << 16), __uint_as_float(u.z & 0xffff0000u), __uint_as_float(u.w << 16), __uint_as_float(u.w & 0xffff0000u)}
    f32x4 v0 = UNP_LO(u0), v1 = UNP_HI(u0), v2 = UNP_LO(u1), v3 = UNP_HI(u1), v4 = UNP_LO(u2), v5 = UNP_HI(u2), v6 = UNP_LO(u3), v7 = UNP_HI(u3);
#undef UNP_LO
#undef UNP_HI
#define SQ4(v) ((v.x * v.x + v.y * v.y) + (v.z * v.z + v.w * v.w))
    float ss = (SQ4(v0) + SQ4(v1)) + (SQ4(v2) + SQ4(v3)) + (SQ4(v4) + SQ4(v5)) + (SQ4(v6) + SQ4(v7));
#undef SQ4
    ss += __shfl_xor(ss, 1);
    const float rstd = rsqrtf(ss * (1.f / 64.f) + EPS);
    const GAS f32x4* wg = (const GAS f32x4*)w;
    v0 = v0 * rstd * wg[0]; v1 = v1 * rstd * wg[1]; v2 = v2 * rstd * wg[2]; v3 = v3 * rstd * wg[3]; v4 = v4 * rstd * wg[4]; v5 = v5 * rstd * wg[5]; v6 = v6 * rstd * wg[6]; v7 = v7 * rstd * wg[7];
    if (rope) {
        const GAS f32x4* rt = (const GAS f32x4*)(ROPE + (size_t)row * 16);
        const f32x4 c0 = rt[0], c1 = rt[1], s0 = rt[2], s1 = rt[3];
        const f32x4 a0 = v0 * c0 - v2 * s0, b0 = v2 * c0 + v0 * s0, a1 = v1 * c1 - v3 * s1, b1 = v3 * c1 + v1 * s1;
        v0 = a0; v2 = b0; v1 = a1; v3 = b1;
    }
    const float sc = isq ? C2 : 1.f;
#define PK4(a, b) (v4u){pk2(a.x * sc, a.y * sc), pk2(a.z * sc, a.w * sc), pk2(b.x * sc, b.y * sc), pk2(b.z * sc, b.w * sc)}
    p[0] = PK4(v0, v1); p[1] = PK4(v2, v3); p[2] = PK4(v4, v5); p[3] = PK4(v6, v7);
#undef PK4
}
__device__ __forceinline__ void p1b_cumsum(const Ptrs& P, int seq, int lane) {
    const int b = seq >> 3, h = seq & 7; const float bf = P.b_forget[h];
    float lf[32]; float run = 0.f;
#pragma unroll
    for (int i = 0; i < 32; ++i) { const float z = P.FLOG[(size_t)(b * SEQ + lane * 32 + i) * 8 + h] + bf;
        const float e = __expf(-fabsf(z)); lf[i] = fminf(z, 0.f) - log1pf(e); run += lf[i]; }
    float inc = run;
#pragma unroll
    for (int o = 1; o < 64; o <<= 1) { const float t = __shfl_up(inc, o); if (lane >= o) inc += t; }
    float c = inc - run;
#pragma unroll
    for (int i = 0; i < 32; ++i) { c += lf[i]; P.CUMB[(size_t)seq * SEQ + lane * 32 + i] = -c * LOG2E; }
}
namespace att {
typedef short bf16x8 __attribute__((ext_vector_type(8)));
typedef short s16x4 __attribute__((ext_vector_type(4)));
typedef float f32x16 __attribute__((ext_vector_type(16)));
typedef float f32x4 __attribute__((ext_vector_type(4)));
typedef unsigned u32x4 __attribute__((ext_vector_type(4)));
typedef unsigned u32x2 __attribute__((ext_vector_type(2)));
typedef __attribute__((address_space(3))) unsigned char* ldsp;
__device__ __forceinline__ int crow(int r, int hi) { return (r & 3) + 8 * (r >> 2) + 4 * hi; }
__device__ __forceinline__ unsigned cvtpk(float lo, float hi) { unsigned r; asm volatile("v_cvt_pk_bf16_f32 %0, %1, %2" : "=v"(r) : "v"(lo), "v"(hi)); return r; }
__device__ __forceinline__ s16x4 vtr(ldsp p) { typedef short v4i16_t __attribute__((ext_vector_type(4))); return __builtin_bit_cast(s16x4, __builtin_amdgcn_ds_read_tr16_b64_v4i16((__attribute__((address_space(3))) v4i16_t*)p)); }
#define ATT_MFMA(a, b, c) __builtin_amdgcn_mfma_f32_32x32x16_bf16(a, b, c, 0, 0, 0)

template <int DVB, bool FOX>
__device__ __forceinline__ void flash_pass(ldsp lds, const bf16_t* Qp, const bf16_t* Kp, const bf16_t* Vp, const float* bias, int qb, int wid, int tid, f32x16 (&o)[DVB], float& l_out) {
    constexpr int SLOT = 8192 + DVB * 4096, VOFF = 8192, CPR = DVB * 4  , NVP = DVB / 2;
    const int lane = tid & 63, r32 = lane & 31, hi = lane >> 5;
    const int NT = 4 * qb + 4, my_last = 4 * qb + (wid >> 1);
    bf16x8 qr[4];
    { const bf16_t* qrow = Qp + (size_t)(256 * qb + 32 * wid + r32) * NPROJ + 8 * hi;
#pragma unroll
      for (int d0 = 0; d0 < 4; ++d0) qr[d0] = *(const bf16x8*)(qrow + 16 * d0); }
#pragma unroll
    for (int i = 0; i < DVB; ++i)
#pragma unroll
        for (int r = 0; r < 16; ++r) o[i][r] = 0.f;
    float m = -1e30f, l = 0.f;
    const int krow = tid >> 3, kc = tid & 7;
    const bf16_t* ksrc = Kp + (size_t)krow * NPROJ + kc * 8;
    const int kdst = kc * 1024 + ((krow ^ kc) * 16);
    u32x4 kreg, vreg[NVP];
    const bf16_t* vsrc[NVP]; int vdst[NVP];
#pragma unroll
    for (int pp = 0; pp < NVP; ++pp) { const int i = tid + 512 * pp, row = i / CPR, c16 = i % CPR; vsrc[pp] = Vp + (size_t)row * NPROJ + c16 * 8; vdst[pp] = VOFF + (c16 >> 2) * 4096 + row * 64 + (c16 & 3) * 16; }
#define ATT_LOAD(t) do { kreg = *(const u32x4*)(ksrc + (size_t)(t) * 64 * NPROJ); _Pragma("unroll") for (int pp = 0; pp < NVP; ++pp) vreg[pp] = *(const u32x4*)(vsrc[pp] + (size_t)(t) * 64 * NPROJ); } while (0)
#define ATT_STORE(buf) do { *(__attribute__((address_space(3))) u32x4*)(lds + (buf) * SLOT + kdst) = kreg; _Pragma("unroll") for (int pp = 0; pp < NVP; ++pp) *(__attribute__((address_space(3))) u32x4*)(lds + (buf) * SLOT + vdst[pp]) = vreg[pp]; } while (0)
    const int vb0 = VOFF + ((lane >> 4) & 1) * 32 + (lane & 3) * 8 + (4 * hi + ((lane & 15) >> 2)) * 64;
    ATT_LOAD(0); ATT_STORE(0); __syncthreads();
    for (int t = 0; t < NT; ++t) {
        const int cur = t & 1;
        if (t + 1 < NT) ATT_LOAD(t + 1);
        if (t <= my_last) {
            const ldsp sl = lds + cur * SLOT;
            f32x16 p0, p1;
            if (FOX) {
                const float* bp = bias + 64 * t + 4 * hi;
#pragma unroll
                for (int g = 0; g < 4; ++g) { const f32x4 a = *(const f32x4*)(bp + 8 * g), b = *(const f32x4*)(bp + 32 + 8 * g);
#pragma unroll
                    for (int e = 0; e < 4; ++e) { p0[4 * g + e] = a[e]; p1[4 * g + e] = b[e]; } }
            } else {
#pragma unroll
                for (int r = 0; r < 16; ++r) { p0[r] = 0.f; p1[r] = 0.f; }
            }
#pragma unroll
            for (int d0 = 0; d0 < 4; ++d0) { const int c = 2 * d0 + hi; const ldsp ka = sl + c * 1024 + ((r32 ^ c) * 16);
                const bf16x8 b0 = *(const __attribute__((address_space(3))) bf16x8*)(ka), b1 = *(const __attribute__((address_space(3))) bf16x8*)(ka + 512);
                p0 = ATT_MFMA(b0, qr[d0], p0); p1 = ATT_MFMA(b1, qr[d0], p1); }
            if (FOX && t == my_last) {
                const int qrel = 32 * (wid & 1) + r32;
#pragma unroll
                for (int r = 0; r < 16; ++r) { const int kv = crow(r, hi); if (kv > qrel) p0[r] = -1e30f; if (kv + 32 > qrel) p1[r] = -1e30f; }
            }
            float mx = fmaxf(p0[0], p1[0]);
#pragma unroll
            for (int r = 1; r < 16; ++r) mx = fmaxf(mx, fmaxf(p0[r], p1[r]));
            mx = fmaxf(mx, __shfl_xor(mx, 32));
            const float mn = fmaxf(m, mx);
            if (__any(mn > m)) { const float al = __builtin_amdgcn_exp2f(m - mn); l *= al;
#pragma unroll
                for (int i = 0; i < DVB; ++i)
#pragma unroll
                    for (int r = 0; r < 16; ++r) o[i][r] *= al; }
            m = mn;
            float rs = 0.f;
#pragma unroll
            for (int r = 0; r < 16; ++r) { p0[r] = __builtin_amdgcn_exp2f(p0[r] - m); p1[r] = __builtin_amdgcn_exp2f(p1[r] - m); rs += p0[r] + p1[r]; }
            l += rs;
            u32x4 pw[4];
#pragma unroll
            for (int s = 0; s < 2; ++s) { pw[s] = (u32x4){cvtpk(p0[8 * s], p0[8 * s + 1]), cvtpk(p0[8 * s + 2], p0[8 * s + 3]), cvtpk(p0[8 * s + 4], p0[8 * s + 5]), cvtpk(p0[8 * s + 6], p0[8 * s + 7])};
                pw[2 + s] = (u32x4){cvtpk(p1[8 * s], p1[8 * s + 1]), cvtpk(p1[8 * s + 2], p1[8 * s + 3]), cvtpk(p1[8 * s + 4], p1[8 * s + 5]), cvtpk(p1[8 * s + 6], p1[8 * s + 7])}; }
            const ldsp vb = sl + vb0;
#pragma unroll
            for (int i = 0; i < DVB; ++i)
#pragma unroll
                for (int s = 0; s < 4; ++s) { const s16x4 lo = vtr(vb + i * 4096 + s * 1024), hh = vtr(vb + i * 4096 + s * 1024 + 512);
                    const bf16x8 vf = (bf16x8){lo[0], lo[1], lo[2], lo[3], hh[0], hh[1], hh[2], hh[3]};
                    o[i] = ATT_MFMA(vf, __builtin_bit_cast(bf16x8, pw[s]), o[i]); }
        }
        if (t + 1 < NT) ATT_STORE(cur ^ 1);
        __syncthreads();
    }
    l_out = l + __shfl_xor(l, 32);
#undef ATT_LOAD
#undef ATT_STORE
}

__device__ __forceinline__ void fox_unit(ldsp lds, const bf16_t* PROJ, const float* CUMB, bf16_t* ATT, int bh, int qb, int wid, int tid) {
    const int b = bh >> 3, h = bh & 7, lane = tid & 63, r32 = lane & 31, hi = lane >> 5;
    const bf16_t* base = PROJ + (size_t)b * SEQ * NPROJ;
    f32x16 o[2]; float l;
    flash_pass<2, true>(lds, base + C_FQ + 64 * h, base + C_FK + 64 * h, base + C_FV + 64 * h, CUMB + (size_t)bh * SEQ, qb, wid, tid, o, l);
    const float il = 1.0f / l;
    bf16_t* orow = ATT + (size_t)(b * SEQ + 256 * qb + 32 * wid + r32) * DM + 512 + 64 * h + 4 * hi;
#pragma unroll
    for (int i = 0; i < 2; ++i)
#pragma unroll
        for (int g = 0; g < 4; ++g) { u32x2 w; w.x = cvtpk(o[i][4 * g] * il, o[i][4 * g + 1] * il); w.y = cvtpk(o[i][4 * g + 2] * il, o[i][4 * g + 3] * il); *(u32x2*)(orow + 32 * i + 8 * g) = w; }
}
__device__ __forceinline__ void diff_unit(ldsp lds, const bf16_t* PROJ, bf16_t* ATT, const float* subw, float lam, int bh, int qb, int wid, int tid) {
    const int b = bh >> 2, h = bh & 3, lane = tid & 63, r32 = lane & 31, hi = lane >> 5;
    const bf16_t* base = PROJ + (size_t)b * SEQ * NPROJ;
    f32x16 o[4]; float l; unsigned park[4][8];
    flash_pass<4, false>(lds, base + C_DQ + 128 * h, base + C_DK + 128 * h, base + C_DV + 128 * h, nullptr, qb, wid, tid, o, l);
    { const float il = 1.0f / l;
#pragma unroll
      for (int i = 0; i < 4; ++i)
#pragma unroll
          for (int j = 0; j < 8; ++j) park[i][j] = cvtpk(o[i][2 * j] * il, o[i][2 * j + 1] * il); }
    flash_pass<4, false>(lds, base + C_DQ + 128 * h + 64, base + C_DK + 128 * h + 64, base + C_DV + 128 * h, nullptr, qb, wid, tid, o, l);
    const float il2 = lam / l; float ss = 0.f;
#pragma unroll
    for (int i = 0; i < 4; ++i)
#pragma unroll
        for (int j = 0; j < 8; ++j) { const float a0 = __uint_as_float(park[i][j] << 16), a1 = __uint_as_float(park[i][j] & 0xffff0000u);
            const float v0 = a0 - o[i][2 * j] * il2, v1 = a1 - o[i][2 * j + 1] * il2; o[i][2 * j] = v0; o[i][2 * j + 1] = v1; ss += v0 * v0 + v1 * v1; }
    ss += __shfl_xor(ss, 32);
    const float rstd = rsqrtf(ss * (1.f / 128.f) + EPS) * 0.8f;
    bf16_t* orow = ATT + (size_t)(b * SEQ + 256 * qb + 32 * wid + r32) * DM + 128 * h + 4 * hi;
#pragma unroll
    for (int i = 0; i < 4; ++i)
#pragma unroll
        for (int g = 0; g < 4; ++g) { const f32x4 sw = *(const f32x4*)(subw + 32 * i + 8 * g + 4 * hi);
            u32x2 w; w.x = cvtpk(o[i][4 * g] * rstd * sw[0], o[i][4 * g + 1] * rstd * sw[1]); w.y = cvtpk(o[i][4 * g + 2] * rstd * sw[2], o[i][4 * g + 3] * rstd * sw[3]); *(u32x2*)(orow + 32 * i + 8 * g) = w; }
}
#undef ATT_MFMA
}
__constant__ unsigned short UNIT_TAB[256][8] = {
  {0x8007,0xffff,0xffff,0xffff,0xffff,0xffff,0xffff,0xffff},
  {0x8027,0xffff,0xffff,0xffff,0xffff,0xffff,0xffff,0xffff},
  {0x8047,0xffff,0xffff,0xffff,0xffff,0xffff,0xffff,0xffff},
  {0x8067,0xffff,0xffff,0xffff,0xffff,0xffff,0xffff,0xffff},
  {0x8087,0xffff,0xffff,0xffff,0xffff,0xffff,0xffff,0xffff},
  {0x80a7,0xffff,0xffff,0xffff,0xffff,0xffff,0xffff,0xffff},
  {0x80c7,0xffff,0xffff,0xffff,0xffff,0xffff,0xffff,0xffff},
  {0x80e7,0xffff,0xffff,0xffff,0xffff,0xffff,0xffff,0xffff},
  {0x800f,0xffff,0xffff,0xffff,0xffff,0xffff,0xffff,0xffff},
  {0x802f,0xffff,0xffff,0xffff,0xffff,0xffff,0xffff,0xffff},
  {0x804f,0xffff,0xffff,0xffff,0xffff,0xffff,0xffff,0xffff},
  {0x806f,0xffff,0xffff,0xffff,0xffff,0xffff,0xffff,0xffff},
  {0x808f,0xffff,0xffff,0xffff,0xffff,0xffff,0xffff,0xffff},
  {0x80af,0xffff,0xffff,0xffff,0xffff,0xffff,0xffff,0xffff},
  {0x80cf,0xffff,0xffff,0xffff,0xffff,0xffff,0xffff,0xffff},
  {0x80ef,0xffff,0xffff,0xffff,0xffff,0xffff,0xffff,0xffff},
  {0x8017,0xffff,0xffff,0xffff,0xffff,0xffff,0xffff,0xffff},
  {0x8037,0xffff,0xffff,0xffff,0xffff,0xffff,0xffff,0xffff},
  {0x8057,0xffff,0xffff,0xffff,0xffff,0xffff,0xffff,0xffff},
  {0x8077,0xffff,0xffff,0xffff,0xffff,0xffff,0xffff,0xffff},
  {0x8097,0xffff,0xffff,0xffff,0xffff,0xffff,0xffff,0xffff},
  {0x80b7,0xffff,0xffff,0xffff,0xffff,0xffff,0xffff,0xffff},
  {0x80d7,0xffff,0xffff,0xffff,0xffff,0xffff,0xffff,0xffff},
  {0x80f7,0xffff,0xffff,0xffff,0xffff,0xffff,0xffff,0xffff},
  {0x801f,0xffff,0xffff,0xffff,0xffff,0xffff,0xffff,0xffff},
  {0x803f,0xffff,0xffff,0xffff,0xffff,0xffff,0xffff,0xffff},
  {0x805f,0xffff,0xffff,0xffff,0xffff,0xffff,0xffff,0xffff},
  {0x807f,0xffff,0xffff,0xffff,0xffff,0xffff,0xffff,0xffff},
  {0x809f,0xffff,0xffff,0xffff,0xffff,0xffff,0xffff,0xffff},
  {0x80bf,0xffff,0xffff,0xffff,0xffff,0xffff,0xffff,0xffff},
  {0x80df,0xffff,0xffff,0xffff,0xffff,0xffff,0xffff,0xffff},
  {0x80ff,0xffff,0xffff,0xffff,0xffff,0xffff,0xffff,0xffff},
  {0x8006,0x0000,0xffff,0xffff,0xffff,0xffff,0xffff,0xffff},
  {0x8026,0x0040,0xffff,0xffff,0xffff,0xffff,0xffff,0xffff},
  {0x8046,0x0080,0xffff,0xffff,0xffff,0xffff,0xffff,0xffff},
  {0x8066,0x00c0,0xffff,0xffff,0xffff,0xffff,0xffff,0xffff},
  {0x8086,0x0100,0xffff,0xffff,0xffff,0xffff,0xffff,0xffff},
  {0x80a6,0x0140,0xffff,0xffff,0xffff,0xffff,0xffff,0xffff},
  {0x80c6,0x0180,0xffff,0xffff,0xffff,0xffff,0xffff,0xffff},
  {0x80e6,0x01c0,0xffff,0xffff,0xffff,0xffff,0xffff,0xffff},
  {0x800e,0x0008,0xffff,0xffff,0xffff,0xffff,0xffff,0xffff},
  {0x802e,0x0048,0xffff,0xffff,0xffff,0xffff,0xffff,0xffff},
  {0x804e,0x0088,0xffff,0xffff,0xffff,0xffff,0xffff,0xffff},
  {0x806e,0x00c8,0xffff,0xffff,0xffff,0xffff,0xffff,0xffff},
  {0x808e,0x0108,0xffff,0xffff,0xffff,0xffff,0xffff,0xffff},
  {0x80ae,0x0148,0xffff,0xffff,0xffff,0xffff,0xffff,0xffff},
  {0x80ce,0x0188,0xffff,0xffff,0xffff,0xffff,0xffff,0xffff},
  {0x80ee,0x01c8,0xffff,0xffff,0xffff,0xffff,0xffff,0xffff},
  {0x8016,0x0010,0xffff,0xffff,0xffff,0xffff,0xffff,0xffff},
  {0x8036,0x0050,0xffff,0xffff,0xffff,0xffff,0xffff,0xffff},
  {0x8056,0x0090,0xffff,0xffff,0xffff,0xffff,0xffff,0xffff},
  {0x8076,0x00d0,0xffff,0xffff,0xffff,0xffff,0xffff,0xffff},
  {0x8096,0x0110,0xffff,0xffff,0xffff,0xffff,0xffff,0xffff},
  {0x80b6,0x0150,0xffff,0xffff,0xffff,0xffff,0xffff,0xffff},
  {0x80d6,0x0190,0xffff,0xffff,0xffff,0xffff,0xffff,0xffff},
  {0x80f6,0x01d0,0xffff,0xffff,0xffff,0xffff,0xffff,0xffff},
  {0x801e,0x0018,0xffff,0xffff,0xffff,0xffff,0xffff,0xffff},
  {0x803e,0x0058,0xffff,0xffff,0xffff,0xffff,0xffff,0xffff},
  {0x805e,0x0098,0xffff,0xffff,0xffff,0xffff,0xffff,0xffff},
  {0x807e,0x00d8,0xffff,0xffff,0xffff,0xffff,0xffff,0xffff},
  {0x809e,0x0118,0xffff,0xffff,0xffff,0xffff,0xffff,0xffff},
  {0x80be,0x0158,0xffff,0xffff,0xffff,0xffff,0xffff,0xffff},
  {0x80de,0x0198,0xffff,0xffff,0xffff,0xffff,0xffff,0xffff},
  {0x80fe,0x01d8,0xffff,0xffff,0xffff,0xffff,0xffff,0xffff},
  {0x8005,0x8000,0x0020,0xffff,0xffff,0xffff,0xffff,0xffff},
  {0x8025,0x8020,0x0060,0xffff,0xffff,0xffff,0xffff,0xffff},
  {0x8045,0x8040,0x00a0,0xffff,0xffff,0xffff,0xffff,0xffff},
  {0x8065,0x8060,0x00e0,0xffff,0xffff,0xffff,0xffff,0xffff},
  {0x8085,0x8080,0x0120,0xffff,0xffff,0xffff,0xffff,0xffff},
  {0x80a5,0x80a0,0x0160,0xffff,0xffff,0xffff,0xffff,0xffff},
  {0x80c5,0x80c0,0x01a0,0xffff,0xffff,0xffff,0xffff,0xffff},
  {0x80e5,0x80e0,0x01e0,0xffff,0xffff,0xffff,0xffff,0xffff},
  {0x800d,0x8008,0x0028,0xffff,0xffff,0xffff,0xffff,0xffff},
  {0x802d,0x8028,0x0068,0xffff,0xffff,0xffff,0xffff,0xffff},
  {0x804d,0x8048,0x00a8,0xffff,0xffff,0xffff,0xffff,0xffff},
  {0x806d,0x8068,0x00e8,0xffff,0xffff,0xffff,0xffff,0xffff},
  {0x808d,0x8088,0x0128,0xffff,0xffff,0xffff,0xffff,0xffff},
  {0x80ad,0x80a8,0x0168,0xffff,0xffff,0xffff,0xffff,0xffff},
  {0x80cd,0x80c8,0x01a8,0xffff,0xffff,0xffff,0xffff,0xffff},
  {0x80ed,0x80e8,0x01e8,0xffff,0xffff,0xffff,0xffff,0xffff},
  {0x8015,0x8010,0x0030,0xffff,0xffff,0xffff,0xffff,0xffff},
  {0x8035,0x8030,0x0070,0xffff,0xffff,0xffff,0xffff,0xffff},
  {0x8055,0x8050,0x00b0,0xffff,0xffff,0xffff,0xffff,0xffff},
  {0x8075,0x8070,0x00f0,0xffff,0xffff,0xffff,0xffff,0xffff},
  {0x8095,0x8090,0x0130,0xffff,0xffff,0xffff,0xffff,0xffff},
  {0x80b5,0x80b0,0x0170,0xffff,0xffff,0xffff,0xffff,0xffff},
  {0x80d5,0x80d0,0x01b0,0xffff,0xffff,0xffff,0xffff,0xffff},
  {0x80f5,0x80f0,0x01f0,0xffff,0xffff,0xffff,0xffff,0xffff},
  {0x801d,0x8018,0x0038,0xffff,0xffff,0xffff,0xffff,0xffff},
  {0x803d,0x8038,0x0078,0xffff,0xffff,0xffff,0xffff,0xffff},
  {0x805d,0x8058,0x00b8,0xffff,0xffff,0xffff,0xffff,0xffff},
  {0x807d,0x8078,0x00f8,0xffff,0xffff,0xffff,0xffff,0xffff},
  {0x809d,0x8098,0x0138,0xffff,0xffff,0xffff,0xffff,0xffff},
  {0x80bd,0x80b8,0x0178,0xffff,0xffff,0xffff,0xffff,0xffff},
  {0x80dd,0x80d8,0x01b8,0xffff,0xffff,0xffff,0xffff,0xffff},
  {0x80fd,0x80f8,0x01f8,0xffff,0xffff,0xffff,0xffff,0xffff},
  {0x8004,0x0024,0x0001,0xffff,0xffff,0xffff,0xffff,0xffff},
  {0x8024,0x0064,0x0041,0xffff,0xffff,0xffff,0xffff,0xffff},
  {0x8044,0x00a4,0x0081,0xffff,0xffff,0xffff,0xffff,0xffff},
  {0x8064,0x00e4,0x00c1,0xffff,0xffff,0xffff,0xffff,0xffff},
  {0x8084,0x0124,0x0101,0xffff,0xffff,0xffff,0xffff,0xffff},
  {0x80a4,0x0164,0x0141,0xffff,0xffff,0xffff,0xffff,0xffff},
  {0x80c4,0x01a4,0x0181,0xffff,0xffff,0xffff,0xffff,0xffff},
  {0x80e4,0x01e4,0x01c1,0xffff,0xffff,0xffff,0xffff,0xffff},
  {0x800c,0x002c,0x0009,0xffff,0xffff,0xffff,0xffff,0xffff},
  {0x802c,0x006c,0x0049,0xffff,0xffff,0xffff,0xffff,0xffff},
  {0x804c,0x00ac,0x0089,0xffff,0xffff,0xffff,0xffff,0xffff},
  {0x806c,0x00ec,0x00c9,0xffff,0xffff,0xffff,0xffff,0xffff},
  {0x808c,0x012c,0x0109,0xffff,0xffff,0xffff,0xffff,0xffff},
  {0x80ac,0x016c,0x0149,0xffff,0xffff,0xffff,0xffff,0xffff},
  {0x80cc,0x01ac,0x0189,0xffff,0xffff,0xffff,0xffff,0xffff},
  {0x80ec,0x01ec,0x01c9,0xffff,0xffff,0xffff,0xffff,0xffff},
  {0x8014,0x0034,0x0011,0xffff,0xffff,0xffff,0xffff,0xffff},
  {0x8034,0x0074,0x0051,0xffff,0xffff,0xffff,0xffff,0xffff},
  {0x8054,0x00b4,0x0091,0xffff,0xffff,0xffff,0xffff,0xffff},
  {0x8074,0x00f4,0x00d1,0xffff,0xffff,0xffff,0xffff,0xffff},
  {0x8094,0x0134,0x0111,0xffff,0xffff,0xffff,0xffff,0xffff},
  {0x80b4,0x0174,0x0151,0xffff,0xffff,0xffff,0xffff,0xffff},
  {0x80d4,0x01b4,0x0191,0xffff,0xffff,0xffff,0xffff,0xffff},
  {0x80f4,0x01f4,0x01d1,0xffff,0xffff,0xffff,0xffff,0xffff},
  {0x801c,0x003c,0x0019,0xffff,0xffff,0xffff,0xffff,0xffff},
  {0x803c,0x007c,0x0059,0xffff,0xffff,0xffff,0xffff,0xffff},
  {0x805c,0x00bc,0x0099,0xffff,0xffff,0xffff,0xffff,0xffff},
  {0x807c,0x00fc,0x00d9,0xffff,0xffff,0xffff,0xffff,0xffff},
  {0x809c,0x013c,0x0119,0xffff,0xffff,0xffff,0xffff,0xffff},
  {0x80bc,0x017c,0x0159,0xffff,0xffff,0xffff,0xffff,0xffff},
  {0x80dc,0x01bc,0x0199,0xffff,0xffff,0xffff,0xffff,0xffff},
  {0x80fc,0x01fc,0x01d9,0xffff,0xffff,0xffff,0xffff,0xffff},
  {0x8003,0x0005,0x0023,0xffff,0xffff,0xffff,0xffff,0xffff},
  {0x8023,0x0045,0x0063,0xffff,0xffff,0xffff,0xffff,0xffff},
  {0x8043,0x0085,0x00a3,0xffff,0xffff,0xffff,0xffff,0xffff},
  {0x8063,0x00c5,0x00e3,0xffff,0xffff,0xffff,0xffff,0xffff},
  {0x8083,0x0105,0x0123,0xffff,0xffff,0xffff,0xffff,0xffff},
  {0x80a3,0x0145,0x0163,0xffff,0xffff,0xffff,0xffff,0xffff},
  {0x80c3,0x0185,0x01a3,0xffff,0xffff,0xffff,0xffff,0xffff},
  {0x80e3,0x01c5,0x01e3,0xffff,0xffff,0xffff,0xffff,0xffff},
  {0x800b,0x000d,0x002b,0xffff,0xffff,0xffff,0xffff,0xffff},
  {0x802b,0x004d,0x006b,0xffff,0xffff,0xffff,0xffff,0xffff},
  {0x804b,0x008d,0x00ab,0xffff,0xffff,0xffff,0xffff,0xffff},
  {0x806b,0x00cd,0x00eb,0xffff,0xffff,0xffff,0xffff,0xffff},
  {0x808b,0x010d,0x012b,0xffff,0xffff,0xffff,0xffff,0xffff},
  {0x80ab,0x014d,0x016b,0xffff,0xffff,0xffff,0xffff,0xffff},
  {0x80cb,0x018d,0x01ab,0xffff,0xffff,0xffff,0xffff,0xffff},
  {0x80eb,0x01cd,0x01eb,0xffff,0xffff,0xffff,0xffff,0xffff},
  {0x8013,0x0015,0x0033,0xffff,0xffff,0xffff,0xffff,0xffff},
  {0x8033,0x0055,0x0073,0xffff,0xffff,0xffff,0xffff,0xffff},
  {0x8053,0x0095,0x00b3,0xffff,0xffff,0xffff,0xffff,0xffff},
  {0x8073,0x00d5,0x00f3,0xffff,0xffff,0xffff,0xffff,0xffff},
  {0x8093,0x0115,0x0133,0xffff,0xffff,0xffff,0xffff,0xffff},
  {0x80b3,0x0155,0x0173,0xffff,0xffff,0xffff,0xffff,0xffff},
  {0x80d3,0x0195,0x01b3,0xffff,0xffff,0xffff,0xffff,0xffff},
  {0x80f3,0x01d5,0x01f3,0xffff,0xffff,0xffff,0xffff,0xffff},
  {0x801b,0x001d,0x003b,0xffff,0xffff,0xffff,0xffff,0xffff},
  {0x803b,0x005d,0x007b,0xffff,0xffff,0xffff,0xffff,0xffff},
  {0x805b,0x009d,0x00bb,0xffff,0xffff,0xffff,0xffff,0xffff},
  {0x807b,0x00dd,0x00fb,0xffff,0xffff,0xffff,0xffff,0xffff},
  {0x809b,0x011d,0x013b,0xffff,0xffff,0xffff,0xffff,0xffff},
  {0x80bb,0x015d,0x017b,0xffff,0xffff,0xffff,0xffff,0xffff},
  {0x80db,0x019d,0x01bb,0xffff,0xffff,0xffff,0xffff,0xffff},
  {0x80fb,0x01dd,0x01fb,0xffff,0xffff,0xffff,0xffff,0xffff},
  {0x8002,0x8001,0x0003,0x0002,0xffff,0xffff,0xffff,0xffff},
  {0x8022,0x8021,0x0043,0x0042,0xffff,0xffff,0xffff,0xffff},
  {0x8042,0x8041,0x0083,0x0082,0xffff,0xffff,0xffff,0xffff},
  {0x8062,0x8061,0x00c3,0x00c2,0xffff,0xffff,0xffff,0xffff},
  {0x8082,0x8081,0x0103,0x0102,0xffff,0xffff,0xffff,0xffff},
  {0x80a2,0x80a1,0x0143,0x0142,0xffff,0xffff,0xffff,0xffff},
  {0x80c2,0x80c1,0x0183,0x0182,0xffff,0xffff,0xffff,0xffff},
  {0x80e2,0x80e1,0x01c3,0x01c2,0xffff,0xffff,0xffff,0xffff},
  {0x800a,0x8009,0x000b,0x000a,0xffff,0xffff,0xffff,0xffff},
  {0x802a,0x8029,0x004b,0x004a,0xffff,0xffff,0xffff,0xffff},
  {0x804a,0x8049,0x008b,0x008a,0xffff,0xffff,0xffff,0xffff},
  {0x806a,0x8069,0x00cb,0x00ca,0xffff,0xffff,0xffff,0xffff},
  {0x808a,0x8089,0x010b,0x010a,0xffff,0xffff,0xffff,0xffff},
  {0x80aa,0x80a9,0x014b,0x014a,0xffff,0xffff,0xffff,0xffff},
  {0x80ca,0x80c9,0x018b,0x018a,0xffff,0xffff,0xffff,0xffff},
  {0x80ea,0x80e9,0x01cb,0x01ca,0xffff,0xffff,0xffff,0xffff},
  {0x8012,0x8011,0x0013,0x0012,0xffff,0xffff,0xffff,0xffff},
  {0x8032,0x8031,0x0053,0x0052,0xffff,0xffff,0xffff,0xffff},
  {0x8052,0x8051,0x0093,0x0092,0xffff,0xffff,0xffff,0xffff},
  {0x8072,0x8071,0x00d3,0x00d2,0xffff,0xffff,0xffff,0xffff},
  {0x8092,0x8091,0x0113,0x0112,0xffff,0xffff,0xffff,0xffff},
  {0x80b2,0x80b1,0x0153,0x0152,0xffff,0xffff,0xffff,0xffff},
  {0x80d2,0x80d1,0x0193,0x0192,0xffff,0xffff,0xffff,0xffff},
  {0x80f2,0x80f1,0x01d3,0x01d2,0xffff,0xffff,0xffff,0xffff},
  {0x801a,0x8019,0x001b,0x001a,0xffff,0xffff,0xffff,0xffff},
  {0x803a,0x8039,0x005b,0x005a,0xffff,0xffff,0xffff,0xffff},
  {0x805a,0x8059,0x009b,0x009a,0xffff,0xffff,0xffff,0xffff},
  {0x807a,0x8079,0x00db,0x00da,0xffff,0xffff,0xffff,0xffff},
  {0x809a,0x8099,0x011b,0x011a,0xffff,0xffff,0xffff,0xffff},
  {0x80ba,0x80b9,0x015b,0x015a,0xffff,0xffff,0xffff,0xffff},
  {0x80da,0x80d9,0x019b,0x019a,0xffff,0xffff,0xffff,0xffff},
  {0x80fa,0x80f9,0x01db,0x01da,0xffff,0xffff,0xffff,0xffff},
  {0x0007,0x0006,0x0025,0x0021,0xffff,0xffff,0xffff,0xffff},
  {0x0047,0x0046,0x0065,0x0061,0xffff,0xffff,0xffff,0xffff},
  {0x0087,0x0086,0x00a5,0x00a1,0xffff,0xffff,0xffff,0xffff},
  {0x00c7,0x00c6,0x00e5,0x00e1,0xffff,0xffff,0xffff,0xffff},
  {0x0107,0x0106,0x0125,0x0121,0xffff,0xffff,0xffff,0xffff},
  {0x0147,0x0146,0x0165,0x0161,0xffff,0xffff,0xffff,0xffff},
  {0x0187,0x0186,0x01a5,0x01a1,0xffff,0xffff,0xffff,0xffff},
  {0x01c7,0x01c6,0x01e5,0x01e1,0xffff,0xffff,0xffff,0xffff},
  {0x000f,0x000e,0x002d,0x0029,0xffff,0xffff,0xffff,0xffff},
  {0x004f,0x004e,0x006d,0x0069,0xffff,0xffff,0xffff,0xffff},
  {0x008f,0x008e,0x00ad,0x00a9,0xffff,0xffff,0xffff,0xffff},
  {0x00cf,0x00ce,0x00ed,0x00e9,0xffff,0xffff,0xffff,0xffff},
  {0x010f,0x010e,0x012d,0x0129,0xffff,0xffff,0xffff,0xffff},
  {0x014f,0x014e,0x016d,0x0169,0xffff,0xffff,0xffff,0xffff},
  {0x018f,0x018e,0x01ad,0x01a9,0xffff,0xffff,0xffff,0xffff},
  {0x01cf,0x01ce,0x01ed,0x01e9,0xffff,0xffff,0xffff,0xffff},
  {0x0017,0x0016,0x0035,0x0031,0xffff,0xffff,0xffff,0xffff},
  {0x0057,0x0056,0x0075,0x0071,0xffff,0xffff,0xffff,0xffff},
  {0x0097,0x0096,0x00b5,0x00b1,0xffff,0xffff,0xffff,0xffff},
  {0x00d7,0x00d6,0x00f5,0x00f1,0xffff,0xffff,0xffff,0xffff},
  {0x0117,0x0116,0x0135,0x0131,0xffff,0xffff,0xffff,0xffff},
  {0x0157,0x0156,0x0175,0x0171,0xffff,0xffff,0xffff,0xffff},
  {0x0197,0x0196,0x01b5,0x01b1,0xffff,0xffff,0xffff,0xffff},
  {0x01d7,0x01d6,0x01f5,0x01f1,0xffff,0xffff,0xffff,0xffff},
  {0x001f,0x001e,0x003d,0x0039,0xffff,0xffff,0xffff,0xffff},
  {0x005f,0x005e,0x007d,0x0079,0xffff,0xffff,0xffff,0xffff},
  {0x009f,0x009e,0x00bd,0x00b9,0xffff,0xffff,0xffff,0xffff},
  {0x00df,0x00de,0x00fd,0x00f9,0xffff,0xffff,0xffff,0xffff},
  {0x011f,0x011e,0x013d,0x0139,0xffff,0xffff,0xffff,0xffff},
  {0x015f,0x015e,0x017d,0x0179,0xffff,0xffff,0xffff,0xffff},
  {0x019f,0x019e,0x01bd,0x01b9,0xffff,0xffff,0xffff,0xffff},
  {0x01df,0x01de,0x01fd,0x01f9,0xffff,0xffff,0xffff,0xffff},
  {0x0027,0x0026,0x0004,0x0022,0xffff,0xffff,0xffff,0xffff},
  {0x0067,0x0066,0x0044,0x0062,0xffff,0xffff,0xffff,0xffff},
  {0x00a7,0x00a6,0x0084,0x00a2,0xffff,0xffff,0xffff,0xffff},
  {0x00e7,0x00e6,0x00c4,0x00e2,0xffff,0xffff,0xffff,0xffff},
  {0x0127,0x0126,0x0104,0x0122,0xffff,0xffff,0xffff,0xffff},
  {0x0167,0x0166,0x0144,0x0162,0xffff,0xffff,0xffff,0xffff},
  {0x01a7,0x01a6,0x0184,0x01a2,0xffff,0xffff,0xffff,0xffff},
  {0x01e7,0x01e6,0x01c4,0x01e2,0xffff,0xffff,0xffff,0xffff},
  {0x002f,0x002e,0x000c,0x002a,0xffff,0xffff,0xffff,0xffff},
  {0x006f,0x006e,0x004c,0x006a,0xffff,0xffff,0xffff,0xffff},
  {0x00af,0x00ae,0x008c,0x00aa,0xffff,0xffff,0xffff,0xffff},
  {0x00ef,0x00ee,0x00cc,0x00ea,0xffff,0xffff,0xffff,0xffff},
  {0x012f,0x012e,0x010c,0x012a,0xffff,0xffff,0xffff,0xffff},
  {0x016f,0x016e,0x014c,0x016a,0xffff,0xffff,0xffff,0xffff},
  {0x01af,0x01ae,0x018c,0x01aa,0xffff,0xffff,0xffff,0xffff},
  {0x01ef,0x01ee,0x01cc,0x01ea,0xffff,0xffff,0xffff,0xffff},
  {0x0037,0x0036,0x0014,0x0032,0xffff,0xffff,0xffff,0xffff},
  {0x0077,0x0076,0x0054,0x0072,0xffff,0xffff,0xffff,0xffff},
  {0x00b7,0x00b6,0x0094,0x00b2,0xffff,0xffff,0xffff,0xffff},
  {0x00f7,0x00f6,0x00d4,0x00f2,0xffff,0xffff,0xffff,0xffff},
  {0x0137,0x0136,0x0114,0x0132,0xffff,0xffff,0xffff,0xffff},
  {0x0177,0x0176,0x0154,0x0172,0xffff,0xffff,0xffff,0xffff},
  {0x01b7,0x01b6,0x0194,0x01b2,0xffff,0xffff,0xffff,0xffff},
  {0x01f7,0x01f6,0x01d4,0x01f2,0xffff,0xffff,0xffff,0xffff},
  {0x003f,0x003e,0x001c,0x003a,0xffff,0xffff,0xffff,0xffff},
  {0x007f,0x007e,0x005c,0x007a,0xffff,0xffff,0xffff,0xffff},
  {0x00bf,0x00be,0x009c,0x00ba,0xffff,0xffff,0xffff,0xffff},
  {0x00ff,0x00fe,0x00dc,0x00fa,0xffff,0xffff,0xffff,0xffff},
  {0x013f,0x013e,0x011c,0x013a,0xffff,0xffff,0xffff,0xffff},
  {0x017f,0x017e,0x015c,0x017a,0xffff,0xffff,0xffff,0xffff},
  {0x01bf,0x01be,0x019c,0x01ba,0xffff,0xffff,0xffff,0xffff},
  {0x01ff,0x01fe,0x01dc,0x01fa,0xffff,0xffff,0xffff,0xffff},
};
__device__ __forceinline__ void attn_phase(Frame& F, const bf16_t* PROJ, const float* CUMB, bf16_t* ATT, const float* subw, const float* lq1, const float* lk1, const float* lq2, const float* lk2) {
    const float s1 = wave_sum(lq1[F.lane] * lk1[F.lane]), s2 = wave_sum(lq2[F.lane] * lk2[F.lane]);
    const float lam = __expf(s1) - __expf(s2) + 0.2f;
    const int bx = (int)blockIdx.x & 255;
    for (int k = 0; k < 8; ++k) {
        const unsigned u = UNIT_TAB[bx][k]; if (u == 0xFFFFu) break;
        const int qb = u & 7, bh = (u >> 3) & 0xFFF;
        if (u & 0x8000u) att::diff_unit((att::ldsp)(F.lds + RING_OFF), PROJ, ATT, subw, lam, bh & 31, qb, F.wave, F.tid);
        else att::fox_unit((att::ldsp)(F.lds + RING_OFF), PROJ, CUMB, ATT, bh & 63, qb, F.wave, F.tid);
    }
}
#define ATTN_PHASE_HOOK if (IN(3)) { PP; attn_phase(F, P.PROJ, P.CUMB, P.ATT, P.subw, P.lq1, P.lk1, P.lq2, P.lk2); }
struct Sched {
    pg8::StaticOrder so; int mode, pm, pn; bool has;
    __device__ __forceinline__ bool next(int i, pg8::Unit& u) const { if (mode == 0) return so.next(i, u); if (i != 0 || !has) return false; u.pm = pm; u.pn = pn; return true; }
    __device__ __forceinline__ void a_ready(const pg8::Unit&) const {}
    __device__ __forceinline__ void done(const pg8::Unit&) const {}
};
__device__ __forceinline__ Sched sched_static(int M, int N, int G, int c) { Sched s; s.so.init(M, N, G, c); s.mode = 0; s.pm = 0; s.pn = 0; s.has = true; return s; }
__device__ __forceinline__ Sched sched_one(int pm, int pn, bool has) { Sched s; s.so.init(256, 256, 1, 0); s.mode = 1; s.pm = pm; s.pn = pn; s.has = has; return s; }

constexpr int NPHASE = 9;

__global__ void __launch_bounds__(NWAVES * 64, 2) mega_fwd(Args args) {
    extern __shared__ __attribute__((aligned(16))) unsigned char lds[];
    Frame F;
    F.lds = (LAS unsigned char*)lds; F.MISC = (volatile LAS unsigned*)(F.lds + MISC_OFF);
    F.tid = threadIdx.x; F.lane = F.tid & 63; F.wave = __builtin_amdgcn_readfirstlane(F.tid >> 6);
    F.G = gridDim.x; { const int bx = blockIdx.x; F.vcu = (F.G % 8 == 0) ? (bx % 8) * (F.G / 8) + bx / 8 : bx; }
    F.ctl = (gu32*)(args.ws + WS_CTL);
    for (int u = F.tid; u < (LDS_BYTES - LDSCTL_OFF) / 4; u += NWAVES * 64) ((LAS unsigned*)(F.lds + LDSCTL_OFF))[u] = 0u;
    __syncthreads();
    XcdBarrier bar = xcd_barrier_post((unsigned*)(F.ctl + CW_BAR) + args.ph_lo * XCD_BAR_WORDS, F.MISC + 8);
    const int lo = args.ph_lo, hi = args.ph_hi;
#define IN(k) (lo <= (k) && (k) < hi)
#define PP const Ptrs P = make_ptrs(args.in, args.out, args.ws)
#define SEAM(k) do { if (IN(k) && IN((k) + 1)) xcd_barrier(bar); } while (0)
    const int bx = (int)blockIdx.x;

    if (IN(0)) { PP; p0_prologue(F, P); } SEAM(0);

    if (IN(1)) {
        PP;
        pg8::Gemm g{P.XB, P.WIN, DM, DM, DM}; const Sched S = sched_static(MTOK, NPROJ, F.G, bx);
        pg8::EpiStore<0> E{P.PROJ, NPROJ, nullptr};
        pg8::gemm_phase<pg8::EpiStore<0>, Sched, true, true>(F.lds + RING_OFF, g, S, E);
    } SEAM(1);

    if (IN(2)) {
        PP;
        if (bx < 32) {
            pg8::Gemm g{P.HM, P.WKV, DM, DM, DM}; const Sched S = sched_one(bx >> 2, bx & 3, true);
            pg8::EpiHeadNormK E{P.MKN, P.mkw, P.mqw};
            pg8::gemm_phase<pg8::EpiHeadNormK, Sched, false, true>(F.lds + RING_OFF, g, S, E);
        } else if (bx < 64) {
            pg8::Gemm g{P.WKV + (size_t)1024 * DM, P.HM, DM, DM, DM}; const Sched S = sched_one((bx - 32) >> 3, (bx - 32) & 7, true);
            pg8::EpiStore<0> E{P.VT, MMEM, nullptr};
            pg8::gemm_phase<pg8::EpiStore<0>, Sched, true, true>(F.lds + RING_OFF, g, S, E);
        } else {
            const int gw = (bx - 64) * NWAVES + F.wave, NGW = (F.G - 64) * NWAVES;
            if (gw < 64) p1b_cumsum(P, gw, F.lane);
            for (int m = gw; m < MTOK; m += NGW) p1b_row(P.PROJ, P.dqw, P.dkw, P.fqw, P.fkw, P.ROPE, m, F.lane);
        }
    } SEAM(2);

    ATTN_PHASE_HOOK
    SEAM(3);

    if (IN(4)) {
        PP;
        pg8::Gemm g{P.ATT, P.WOUT, DM, DM, DM}; const Sched S = sched_static(MTOK, DM, F.G, bx);
        pg8::EpiResid<true> E{P.x, P.out, P.XB, P.SS};
        pg8::gemm_phase<pg8::EpiResid<true>, Sched, false, true>(F.lds + RING_OFF, g, S, E);
    } SEAM(4);

    if (IN(5)) {
        PP;
        const Sched S0 = sched_static(MTOK, DM, F.G, bx); pg8::Unit u{0, 0}; const bool has = S0.next(0, u);
        PG8_LAS float* RQ = (PG8_LAS float*)(F.lds + LDS_RQ); PG8_LAS float* IL = (PG8_LAS float*)(F.lds + LDS_IL);
        {   pg8::Gemm g{P.XB, P.WQ, DM, DM, DM}; const Sched S = sched_one(u.pm, u.pn, has);
            pg8::EpiMemQ E{P.MQ, P.SS, RQ};
            pg8::gemm_phase<pg8::EpiMemQ, Sched, false, true>(F.lds + RING_OFF, g, S, E); }
        VM_WAIT(); __syncthreads(); if (F.tid == 0) { __builtin_amdgcn_fence(__ATOMIC_ACQUIRE, "agent"); VM_WAIT(); } __syncthreads();
        const int head = u.pn, bh = (u.pm >> 3) * 4 + head;
        {   pg8::Gemm g{P.MQ + head * 256, P.MKN + (size_t)bh * 65536, DM, 256, 256}; const Sched S = sched_one(u.pm, 0, has);
            pg8::EpiMemS E{P.MQ, head, RQ, IL};
            pg8::gemm_phase<pg8::EpiMemS, Sched, false, true>(F.lds + RING_OFF, g, S, E); }
        VM_WAIT(); __syncthreads(); if (F.tid == 0) { __builtin_amdgcn_fence(__ATOMIC_ACQUIRE, "agent"); VM_WAIT(); } __syncthreads();
        {   pg8::Gemm g{P.MQ + head * 256, P.VT + (size_t)(head * 256) * MMEM + (u.pm >> 3) * 256, DM, MMEM, 256}; const Sched S = sched_one(u.pm, 0, has);
            pg8::EpiMemPV E{P.MO, head, IL};
            pg8::gemm_phase<pg8::EpiMemPV, Sched, true, true>(F.lds + RING_OFF, g, S, E); }
    } SEAM(5);

    if (IN(6)) {
        PP;
        pg8::Gemm g{P.MO, P.WO, DM, DM, DM}; const Sched S = sched_static(MTOK, DM, F.G, bx);
        pg8::EpiResid<true> E{P.out, P.out, P.XB, P.SS};
        pg8::gemm_phase<pg8::EpiResid<true>, Sched, false, true>(F.lds + RING_OFF, g, S, E);
    } SEAM(6);

    if (IN(7)) {
        PP;
        pg8::Gemm g{P.XB, P.WUP, DM, DM, DM}; const Sched S = sched_static(MTOK, DFF, F.G, bx);
        pg8::EpiStore<3> E{P.H, DFF, P.SS};
        pg8::gemm_phase<pg8::EpiStore<3>, Sched, true, true>(F.lds + RING_OFF, g, S, E);
    } SEAM(7);

    if (IN(8)) {
        PP;
        pg8::Gemm g{P.H, P.WDN, DFF, DFF, DFF}; const Sched S = sched_static(MTOK, DM, F.G, bx);
        pg8::EpiResid<false> E{P.out, P.out, nullptr, nullptr};
        pg8::gemm_phase<pg8::EpiResid<false>, Sched, false, true>(F.lds + RING_OFF, g, S, E);
    }
#undef IN
#undef SEAM
}
extern "C" void kernel_launch(void* const* d_in, const int* in_sizes, int n_in, void* d_out, int out_size, void* d_ws, size_t ws_size, hipStream_t stream) {
    static int grid = 0;
    if (grid == 0) {
        if (n_in != 26 || in_sizes[0] != MTOK * DM || out_size != MTOK * DM || ws_size < WS_END) { fprintf(stderr, "kernel_launch: unexpected shapes (n_in %d, in0 %d, out %d, ws %zu)\n", n_in, n_in > 0 ? in_sizes[0] : -1, out_size, ws_size); grid = -1; return; }
        int dev = 0, cus = 0, per_cu = 0;
        if (hipGetDevice(&dev) != hipSuccess || hipDeviceGetAttribute(&cus, hipDeviceAttributeMultiprocessorCount, dev) != hipSuccess) { grid = -1; return; }
        if (hipFuncSetAttribute((const void*)mega_fwd, hipFuncAttributeMaxDynamicSharedMemorySize, LDS_BYTES) != hipSuccess) { fprintf(stderr, "kernel_launch: hipFuncSetAttribute failed\n"); grid = -1; return; }
        if (hipOccupancyMaxActiveBlocksPerMultiprocessor(&per_cu, (const void*)mega_fwd, NWAVES * 64, LDS_BYTES) != hipSuccess || per_cu < 1) { fprintf(stderr, "kernel_launch: occupancy query says %d blocks per CU\n", per_cu); (void)hipGetLastError(); grid = -1; return; }
        grid = cus;
        if (grid != 256) fprintf(stderr, "kernel_launch: %d CUs; the one-unit-per-workgroup phases assume 256\n", grid);
    }
    if (grid < 0) return;
    (void)hipMemsetAsync((char*)d_ws + WS_CTL, 0, CTL_ZERO_BYTES, stream);
    Args a{};
    for (int i = 0; i < 26; ++i) a.in[i] = d_in[i];
    a.out = (float*)d_out; a.ws = (unsigned char*)d_ws;
#if MK_HYBRID
    const Ptrs P = make_ptrs(a.in, a.out, a.ws);
    a.ph_lo = 0; a.ph_hi = 3; hipLaunchKernelGGL(mega_fwd, dim3(grid), dim3(NWAVES * 64), LDS_BYTES, stream, a);
    float* OF = a.out;
    hipLaunchKernelGGL(k_attn, dim3(MTOK / 64, 8), dim3(64), 0, stream, P.PROJ, P.CUMB, 1, OF, 8);
    hipLaunchKernelGGL(k_fox_fin, dim3(MTOK * 512 / 256), dim3(256), 0, stream, OF, P.ATT);
    hipLaunchKernelGGL(k_attn, dim3(MTOK / 64, 16), dim3(64), 0, stream, P.PROJ, P.CUMB, 0, OF, 16);
    hipLaunchKernelGGL(k_diff_fin, dim3(MTOK), dim3(256), 0, stream, OF, P.lq1, P.lk1, P.lq2, P.lk2, P.subw, P.ATT);
    a.ph_lo = 4; a.ph_hi = 9; hipLaunchKernelGGL(mega_fwd, dim3(grid), dim3(NWAVES * 64), LDS_BYTES, stream, a);
#else
    a.ph_lo = 0; a.ph_hi = NPHASE; hipLaunchKernelGGL(mega_fwd, dim3(grid), dim3(NWAVES * 64), LDS_BYTES, stream, a);
#endif
}
```

```cpp
#include <hip/hip_runtime.h>
#include <cstdint>
#include <cstdio>

typedef unsigned short bf16_t;
__device__ __forceinline__ float bf2f(bf16_t v) { return __uint_as_float(((unsigned)v) << 16); }
__device__ __forceinline__ bf16_t f2bf(float f) { unsigned u = __float_as_uint(f); return (bf16_t)((u + 0x7fffu + ((u >> 16) & 1u)) >> 16); }

constexpr int NB = 8, SEQ = 2048, DM = 1024, MTOK = NB * SEQ, MEML = 256, MMEM = NB * MEML;
constexpr int NPROJ = 3072, INCOLS = 3080, DFF = 4096;
constexpr float EPS = 1e-6f;
constexpr float LOG2E = 1.4426950408889634f;
constexpr float C2 = 0.125f * LOG2E;
constexpr float CM = 0.0625f * LOG2E;
constexpr int C_DQ = 0, C_DK = 512, C_DV = 1024, C_FQ = 1536, C_FK = 2048, C_FV = 2560;

constexpr size_t MiB = 1u << 20;
constexpr size_t WS_CTL = 0, CTL_ZERO_BYTES = 1 * MiB;
constexpr size_t WS_FLOG = 1 * MiB;
constexpr size_t WS_CUMB = 2 * MiB;
constexpr size_t WS_ROPE = 3 * MiB;
constexpr size_t WS_SS = 4 * MiB;
constexpr size_t WS_WIN = 8 * MiB, WS_WOUT = 14 * MiB, WS_WQ = 16 * MiB, WS_WKV = 18 * MiB, WS_WO = 22 * MiB, WS_WUP = 24 * MiB, WS_WDN = 32 * MiB;
constexpr size_t WS_XB = 40 * MiB;
constexpr size_t WS_HM = 72 * MiB;
constexpr size_t WS_MK = 76 * MiB;
constexpr size_t WS_VT = 80 * MiB;
constexpr size_t WS_MKN = 84 * MiB;
constexpr size_t WS_PROJ = 96 * MiB;
constexpr size_t WS_ATT = 192 * MiB;
constexpr size_t WS_MQ = 96 * MiB;
constexpr size_t WS_MO = 128 * MiB;
constexpr size_t WS_H = 96 * MiB;
constexpr size_t WS_END = 224 * MiB;
#define MK_HYBRID 0
namespace pg8 {
#define PG8_LAS __attribute__((address_space(3)))
typedef short bf16x8 __attribute__((ext_vector_type(8)));
typedef float f32x4 __attribute__((ext_vector_type(4)));
typedef unsigned u32x4 __attribute__((ext_vector_type(4)));
typedef unsigned u32x2 __attribute__((ext_vector_type(2)));
constexpr int BM = 256, BK = 64, HALF = 128, HTB = HALF * BK * 2  , STAGE_BYTES = 8 * HTB, NXCD = 8, WGM = 8;

__host__ __device__ __forceinline__ int lds_byte(int r, int c) { const int st = (r >> 4) * 2 + (c >> 5), rr = r & 15, cc = c & 31, ob = rr * 64 + cc * 2; return st * 1024 + (ob ^ (((ob >> 9) & 1) << 5)); }
__host__ __device__ __forceinline__ void stage_rc(int b, int& R, int& C) { const int st = b / 1024, sb = b % 1024, swz = sb ^ (((sb >> 9) & 1) << 5); R = (st >> 1) * 16 + swz / 64; C = (st & 1) * 32 + (swz % 64) / 2; }
__host__ __device__ __forceinline__ int perm32(int rho) { const int n = rho >> 4, i = rho & 15; return 8 * (i >> 2) + 4 * n + (i & 3); }

struct Unit { int pm, pn; };
struct Gemm { const bf16_t* A; const bf16_t* Bt; int lda, ldb, K; };

struct StaticOrder {
    int nM, nN, nwg, G, c;
    __host__ __device__ void init(int M, int N, int G_, int c_) { nM = M / BM; nN = N / BM; nwg = nM * nN; G = G_; c = c_; }
    __host__ __device__ bool next(int i, Unit& u) const {
        const long L = (long)i * G + c; if (L >= nwg) return false;
        int wgid = (int)L; { const int q = nwg / NXCD, r = nwg % NXCD, xcd = wgid % NXCD, off = wgid / NXCD; wgid = (xcd < r ? xcd * (q + 1) : r * (q + 1) + (xcd - r) * q) + off; }
        const int nig = WGM * nN, gid = wgid / nig, fm = gid * WGM, gsz = (nM - fm) < WGM ? (nM - fm) : WGM;
        u.pm = fm + ((wgid % nig) % gsz); u.pn = (wgid % nig) / gsz; return true;
    }
    __device__ __forceinline__ void a_ready(const Unit&) const {}
    __device__ __forceinline__ void done(const Unit&) const {}
};
struct OneUnit {
    int pm, pn; bool has;
    __device__ __forceinline__ bool next(int i, Unit& u) const { if (i != 0 || !has) return false; u.pm = pm; u.pn = pn; return true; }
    __device__ __forceinline__ void a_ready(const Unit&) const {}
    __device__ __forceinline__ void done(const Unit&) const {}
};

__device__ __forceinline__ unsigned cvt_pk_bf16(float lo, float hi) { unsigned r; asm volatile("v_cvt_pk_bf16_f32 %0, %1, %2" : "=v"(r) : "v"(lo), "v"(hi)); return r; }
#define PG8_LBAR() do { asm volatile("s_waitcnt lgkmcnt(0)" ::: "memory"); __builtin_amdgcn_s_barrier(); asm volatile("" ::: "memory"); } while (0)

template <int MODE> struct EpiStore {
    static constexpr bool PERM = true, AFTER_DRAIN = false;
    bf16_t* O; int ldc; const float* SS;
    __device__ __forceinline__ void operator()(const f32x4 (&acc)[2][2][4][2], const Unit& u, int wr, int wc, int fr, int fq) const {
        const int row0 = u.pm * BM + wr * 64 + fr, col0 = u.pn * BM + wc * 32 + 8 * fq;
#pragma unroll
        for (int ai = 0; ai < 2; ++ai)
#pragma unroll
            for (int m = 0; m < 4; ++m) { const int row = row0 + ai * HALF + m * 16; float rs = 1.f;
                if (MODE != 0) { const f32x4 s = *(const f32x4*)(SS + (size_t)row * 4); rs = rsqrtf(((s[0] + s[1]) + (s[2] + s[3])) * (1.f / DM) + EPS); }
                bf16_t* rowp = O + (size_t)row * ldc + col0;
#pragma unroll
                for (int bj = 0; bj < 2; ++bj) { f32x4 v0 = acc[ai][bj][m][0] * rs, v1 = acc[ai][bj][m][1] * rs;
                    if (MODE == 3) {
#pragma unroll
                        for (int e = 0; e < 4; ++e) { const float a = fmaxf(v0[e], 0.f), b = fmaxf(v1[e], 0.f); v0[e] = a * a; v1[e] = b * b; } }
                    u32x4 w; w.x = cvt_pk_bf16(v0[0], v0[1]); w.y = cvt_pk_bf16(v0[2], v0[3]); w.z = cvt_pk_bf16(v1[0], v1[1]); w.w = cvt_pk_bf16(v1[2], v1[3]);
                    *(u32x4*)(rowp + bj * HALF) = w; } }
    }
};
template <int MODE> struct EpiResid {
    static constexpr bool PERM = true, AFTER_DRAIN = true;
    const float* xf; bf16_t* xb; float* outf; float* SS;
    __device__ __forceinline__ void fused(f32x4 (&acc)[2][2][4][2], const Unit& u, int wr, int wc, int fr, int fq, PG8_LAS unsigned char* lds, int wid, int lane) const {
        PG8_LAS float* P = (PG8_LAS float*)lds;
        const int col0 = u.pn * BM + wc * 32 + 8 * fq;
#pragma unroll
        for (int ai = 0; ai < 2; ++ai)
#pragma unroll
            for (int m = 0; m < 4; ++m) { const int r = ai * HALF + wr * 64 + m * 16 + fr; const size_t off = (size_t)(u.pm * BM + r) * DM + col0; float s = 0.f;
#pragma unroll
                for (int bj = 0; bj < 2; ++bj) { f32x4 b0, b1;
                    if (MODE == 0) { b0 = *(const f32x4*)(xf + off + bj * HALF); b1 = *(const f32x4*)(xf + off + bj * HALF + 4); }
                    else { const u32x4 w = *(const u32x4*)(xb + off + bj * HALF);
                        b0 = (f32x4){__uint_as_float(w.x << 16), __uint_as_float(w.x & 0xffff0000u), __uint_as_float(w.y << 16), __uint_as_float(w.y & 0xffff0000u)};
                        b1 = (f32x4){__uint_as_float(w.z << 16), __uint_as_float(w.z & 0xffff0000u), __uint_as_float(w.w << 16), __uint_as_float(w.w & 0xffff0000u)}; }
                    const f32x4 o0 = b0 + acc[ai][bj][m][0], o1 = b1 + acc[ai][bj][m][1];
                    if (MODE == 2) { *(f32x4*)(outf + off + bj * HALF) = o0; *(f32x4*)(outf + off + bj * HALF + 4) = o1; }
                    else { u32x4 w; w.x = cvt_pk_bf16(o0[0], o0[1]); w.y = cvt_pk_bf16(o0[2], o0[3]); w.z = cvt_pk_bf16(o1[0], o1[1]); w.w = cvt_pk_bf16(o1[2], o1[3]); *(u32x4*)(xb + off + bj * HALF) = w;
                        s += ((o0[0] * o0[0] + o0[1] * o0[1]) + (o0[2] * o0[2] + o0[3] * o0[3])) + ((o1[0] * o1[0] + o1[1] * o1[1]) + (o1[2] * o1[2] + o1[3] * o1[3])); } }
                if (MODE != 2) { s += __shfl_xor(s, 16); s += __shfl_xor(s, 32); if (fq == 0) P[r * 4 + wc] = s; }
                if (m & 1) asm volatile("" ::: "memory"); }
        if (MODE != 2) { PG8_LBAR();
            const int t = wid * 64 + lane; if (t < 256) { const f32x4 p = *(const PG8_LAS f32x4*)(P + t * 4); SS[(size_t)(u.pm * BM + t) * 4 + u.pn] = (p[0] + p[1]) + (p[2] + p[3]); } }
    }
};
struct EpiHeadNormK {
    static constexpr bool PERM = true, AFTER_DRAIN = true;
    bf16_t* MKn; const float* kw; const float* qw;
    __device__ __forceinline__ void fused(f32x4 (&acc)[2][2][4][2], const Unit& u, int wr, int wc, int fr, int fq, PG8_LAS unsigned char* lds, int wid, int lane) const {
        PG8_LAS float* P = (PG8_LAS float*)lds; PG8_LAS float* R = (PG8_LAS float*)(lds + 4096);
#pragma unroll
        for (int ai = 0; ai < 2; ++ai)
#pragma unroll
            for (int m = 0; m < 4; ++m) { float s = 0.f;
#pragma unroll
                for (int bj = 0; bj < 2; ++bj)
#pragma unroll
                    for (int n = 0; n < 2; ++n) { const f32x4 v = acc[ai][bj][m][n]; s += (v[0] * v[0] + v[1] * v[1]) + (v[2] * v[2] + v[3] * v[3]); }
                s += __shfl_xor(s, 16); s += __shfl_xor(s, 32); if (fq == 0) P[(ai * HALF + wr * 64 + m * 16 + fr) * 4 + wc] = s; }
        PG8_LBAR();
        { const int t = wid * 64 + lane; if (t < 256) { const f32x4 p = *(const PG8_LAS f32x4*)(P + t * 4); R[t] = rsqrtf(((p[0] + p[1]) + (p[2] + p[3])) * (1.f / 256.f) + EPS); } }
        PG8_LBAR();
        const int c0 = wc * 32 + 8 * fq; f32x4 g[2][2];
#pragma unroll
        for (int bj = 0; bj < 2; ++bj)
#pragma unroll
            for (int n = 0; n < 2; ++n) { const f32x4 a = *(const f32x4*)(kw + c0 + bj * HALF + 4 * n), b = *(const f32x4*)(qw + c0 + bj * HALF + 4 * n); g[bj][n] = a * b * CM; }
        bf16_t* basep = MKn + (size_t)(u.pm * 4 + u.pn) * 65536;
#pragma unroll
        for (int ai = 0; ai < 2; ++ai)
#pragma unroll
            for (int m = 0; m < 4; ++m) { const int r = ai * HALF + wr * 64 + m * 16 + fr; const float rk = R[r];
#pragma unroll
                for (int bj = 0; bj < 2; ++bj) { const f32x4 v0 = acc[ai][bj][m][0] * rk * g[bj][0], v1 = acc[ai][bj][m][1] * rk * g[bj][1];
                    u32x4 w; w.x = cvt_pk_bf16(v0[0], v0[1]); w.y = cvt_pk_bf16(v0[2], v0[3]); w.z = cvt_pk_bf16(v1[0], v1[1]); w.w = cvt_pk_bf16(v1[2], v1[3]);
                    *(u32x4*)(basep + (size_t)r * 256 + c0 + bj * HALF) = w; } }
    }
};
struct EpiMemQ {
    static constexpr bool PERM = true, AFTER_DRAIN = true;
    bf16_t* MQ; const float* SS; PG8_LAS float* RQ;
    __device__ __forceinline__ void fused(f32x4 (&acc)[2][2][4][2], const Unit& u, int wr, int wc, int fr, int fq, PG8_LAS unsigned char* lds, int wid, int lane) const {
        PG8_LAS float* P = (PG8_LAS float*)lds;
        const int col0 = u.pn * BM + wc * 32 + 8 * fq;
#pragma unroll
        for (int ai = 0; ai < 2; ++ai)
#pragma unroll
            for (int m = 0; m < 4; ++m) { const int r = ai * HALF + wr * 64 + m * 16 + fr; const int row = u.pm * BM + r;
                const f32x4 ss = *(const f32x4*)(SS + (size_t)row * 4); const float rs = rsqrtf(((ss[0] + ss[1]) + (ss[2] + ss[3])) * (1.f / DM) + EPS); float s = 0.f;
#pragma unroll
                for (int bj = 0; bj < 2; ++bj) { const f32x4 v0 = acc[ai][bj][m][0] * rs, v1 = acc[ai][bj][m][1] * rs;
                    s += (v0[0] * v0[0] + v0[1] * v0[1]) + (v0[2] * v0[2] + v0[3] * v0[3]) + (v1[0] * v1[0] + v1[1] * v1[1]) + (v1[2] * v1[2] + v1[3] * v1[3]);
                    u32x4 w; w.x = cvt_pk_bf16(v0[0], v0[1]); w.y = cvt_pk_bf16(v0[2], v0[3]); w.z = cvt_pk_bf16(v1[0], v1[1]); w.w = cvt_pk_bf16(v1[2], v1[3]);
                    *(u32x4*)(MQ + (size_t)row * DM + col0 + bj * HALF) = w; }
                s += __shfl_xor(s, 16); s += __shfl_xor(s, 32); if (fq == 0) P[r * 4 + wc] = s; }
        PG8_LBAR();
        { const int t = wid * 64 + lane; if (t < 256) { const f32x4 p = *(const PG8_LAS f32x4*)(P + t * 4); RQ[t] = rsqrtf(((p[0] + p[1]) + (p[2] + p[3])) * (1.f / 256.f) + EPS); } }
        PG8_LBAR();
    }
};
struct EpiMemS {
    static constexpr bool PERM = true, AFTER_DRAIN = true;
    bf16_t* Pt; int head; const PG8_LAS float* RQ; PG8_LAS float* IL;
    __device__ __forceinline__ void fused(f32x4 (&acc)[2][2][4][2], const Unit& u, int wr, int wc, int fr, int fq, PG8_LAS unsigned char* lds, int wid, int lane) const {
        PG8_LAS float* P = (PG8_LAS float*)lds;
        const int col0 = head * BM + wc * 32 + 8 * fq;
#pragma unroll
        for (int ai = 0; ai < 2; ++ai)
#pragma unroll
            for (int m = 0; m < 4; ++m) { const int r = ai * HALF + wr * 64 + m * 16 + fr; const int row = u.pm * BM + r; const float rq = RQ[r]; float s = 0.f;
#pragma unroll
                for (int bj = 0; bj < 2; ++bj) { f32x4 v0 = acc[ai][bj][m][0] * rq, v1 = acc[ai][bj][m][1] * rq;
#pragma unroll
                    for (int e = 0; e < 4; ++e) { v0[e] = __builtin_amdgcn_exp2f(v0[e]); v1[e] = __builtin_amdgcn_exp2f(v1[e]); }
                    s += (v0[0] + v0[1]) + (v0[2] + v0[3]) + (v1[0] + v1[1]) + (v1[2] + v1[3]);
                    u32x4 w; w.x = cvt_pk_bf16(v0[0], v0[1]); w.y = cvt_pk_bf16(v0[2], v0[3]); w.z = cvt_pk_bf16(v1[0], v1[1]); w.w = cvt_pk_bf16(v1[2], v1[3]);
                    *(u32x4*)(Pt + (size_t)row * DM + col0 + bj * HALF) = w; }
                s += __shfl_xor(s, 16); s += __shfl_xor(s, 32); if (fq == 0) P[r * 4 + wc] = s; }
        PG8_LBAR();
        { const int t = wid * 64 + lane; if (t < 256) { const f32x4 p = *(const PG8_LAS f32x4*)(P + t * 4); IL[t] = 1.0f / ((p[0] + p[1]) + (p[2] + p[3])); } }
        PG8_LBAR();
    }
};
struct EpiMemPV {
    static constexpr bool PERM = true, AFTER_DRAIN = false;
    bf16_t* MO; int head; const PG8_LAS float* IL;
    __device__ __forceinline__ void operator()(const f32x4 (&acc)[2][2][4][2], const Unit& u, int wr, int wc, int fr, int fq) const {
        const int col0 = head * BM + wc * 32 + 8 * fq;
#pragma unroll
        for (int ai = 0; ai < 2; ++ai)
#pragma unroll
            for (int m = 0; m < 4; ++m) { const int r = ai * HALF + wr * 64 + m * 16 + fr; const int row = u.pm * BM + r; const float il = IL[r];
#pragma unroll
                for (int bj = 0; bj < 2; ++bj) { const f32x4 v0 = acc[ai][bj][m][0] * il, v1 = acc[ai][bj][m][1] * il;
                    u32x4 w; w.x = cvt_pk_bf16(v0[0], v0[1]); w.y = cvt_pk_bf16(v0[2], v0[3]); w.z = cvt_pk_bf16(v1[0], v1[1]); w.w = cvt_pk_bf16(v1[2], v1[3]);
                    *(u32x4*)(MO + (size_t)row * DM + col0 + bj * HALF) = w; } }
    }
};

template <class Epi, class Sched, bool ALIGN_EPI = false, bool SP2 = false>
__device__ __forceinline__ void gemm_phase(PG8_LAS unsigned char* lds, const Gemm g, const Sched& S, const Epi& E) {
    const int tid = threadIdx.x, wid = __builtin_amdgcn_readfirstlane(tid >> 6), lane = tid & 63, wr = wid >> 2, wc = wid & 3, fr = lane & 15, fq = lane >> 4;
    const int K = g.K, nt = K / BK;
    unsigned voffA[2], voffB[2];
#pragma unroll
    for (int i = 0; i < 2; ++i) { int R, C; stage_rc(tid * 16 + i * 8192, R, C); const int Rb = Epi::PERM ? ((R & ~31) + perm32(R & 31)) : R;
        voffA[i] = (unsigned)(R * g.lda + C) * 2u; voffB[i] = (unsigned)(Rb * g.ldb + C) * 2u; }
    const size_t kstep = (size_t)(BK * 2);
    const size_t hsA = (size_t)HALF * g.lda * 2, hsB = (size_t)HALF * g.ldb * 2;
    const size_t tsA = 2 * hsA, tsB = 2 * hsB;
    const unsigned ldsw = (unsigned)wid * 1024u;
    const int aoff = lds_byte(wr * 64 + fr, fq * 8), boff = lds_byte(wc * 32 + fr, fq * 8);
#define PG8_SA(b, h) (((b) * 2 + (h)) * HTB)
#define PG8_SB(b, h) ((4 + (b) * 2 + (h)) * HTB)
#define PG8_STAGE(bufoff, gbase, voff) do { _Pragma("unroll") for (int _i = 0; _i < 2; ++_i) \
        __builtin_amdgcn_global_load_lds((const unsigned*)((const char*)(gbase) + (voff)[_i]), (PG8_LAS unsigned*)(lds + (bufoff) + ldsw + _i * 8192), 16, 0, 0); } while (0)
#define PG8_LDA(dst, b, h) do { _Pragma("unroll") for (int m = 0; m < 4; ++m) _Pragma("unroll") for (int k = 0; k < 2; ++k) dst[m][k] = *(const PG8_LAS bf16x8*)(lds + PG8_SA(b, h) + aoff + m * 2048 + k * 1024); } while (0)
#define PG8_LDB(dst, b, h) do { _Pragma("unroll") for (int n = 0; n < 2; ++n) _Pragma("unroll") for (int k = 0; k < 2; ++k) dst[n][k] = *(const PG8_LAS bf16x8*)(lds + PG8_SB(b, h) + boff + n * 2048 + k * 1024); } while (0)
#define PG8_MMA(ai, bj, At, Bt) do { __builtin_amdgcn_s_setprio(1); _Pragma("unroll") for (int m = 0; m < 4; ++m) _Pragma("unroll") for (int n = 0; n < 2; ++n) _Pragma("unroll") for (int k = 0; k < 2; ++k) \
        acc[ai][bj][m][n] = __builtin_amdgcn_mfma_f32_16x16x32_bf16(Bt[n][k], At[m][k], acc[ai][bj][m][n], 0, 0, 0); __builtin_amdgcn_s_setprio(0); } while (0)
#define PG8_WAIT_V(n) asm volatile("s_waitcnt vmcnt(" #n ")" ::: "memory")
#define PG8_WAIT_L(n) asm volatile("s_waitcnt lgkmcnt(" #n ")" ::: "memory")
#define PG8_BAR __builtin_amdgcn_s_barrier()
#define PG8_SCHED __builtin_amdgcn_sched_barrier(0)
    Unit cur, nxt; int ui = 0;
    if (!S.next(0, cur)) return;
    f32x4 acc[2][2][4][2];
#pragma unroll
    for (int a = 0; a < 2; ++a)
#pragma unroll
        for (int b = 0; b < 2; ++b)
#pragma unroll
            for (int m = 0; m < 4; ++m)
#pragma unroll
                for (int n = 0; n < 2; ++n) acc[a][b][m][n] = (f32x4){0.f, 0.f, 0.f, 0.f};
    bf16x8 At[4][2], B0[2][2], B1[2][2];
    const char* cA = (const char*)g.A + (size_t)cur.pm * tsA; const char* cB = (const char*)g.Bt + (size_t)cur.pn * tsB;
    S.a_ready(cur);
    if constexpr (SP2) {
        PG8_STAGE(PG8_SB(0, 0), cB, voffB); PG8_STAGE(PG8_SB(0, 1), cB + hsB, voffB); PG8_STAGE(PG8_SA(0, 0), cA, voffA); PG8_STAGE(PG8_SA(0, 1), cA + hsA, voffA);
        if (wr == 1) PG8_BAR;
        PG8_WAIT_V(2); PG8_BAR;
        PG8_STAGE(PG8_SB(1, 0), cB + kstep, voffB); PG8_STAGE(PG8_SA(1, 0), cA + kstep, voffA); PG8_STAGE(PG8_SB(1, 1), cB + hsB + kstep, voffB);
        PG8_WAIT_V(6); PG8_BAR;
    } else {
        PG8_STAGE(PG8_SB(0, 0), cB, voffB); PG8_STAGE(PG8_SA(0, 0), cA, voffA); PG8_STAGE(PG8_SB(0, 1), cB + hsB, voffB); PG8_STAGE(PG8_SA(0, 1), cA + hsA, voffA);
        if (wr == 1) PG8_BAR;
        PG8_WAIT_V(4); PG8_BAR;
        PG8_STAGE(PG8_SB(1, 0), cB + kstep, voffB); PG8_STAGE(PG8_SA(1, 0), cA + kstep, voffA); PG8_STAGE(PG8_SB(1, 1), cB + hsB + kstep, voffB);
        PG8_WAIT_V(6); PG8_BAR;
    }
    for (;;) {
        const bool has_next = S.next(ui + 1, nxt);
        const char* nA = has_next ? (const char*)g.A + (size_t)nxt.pm * tsA : cA; const char* nB = has_next ? (const char*)g.Bt + (size_t)nxt.pn * tsB : cB;
        for (int t = 0; t < nt; t += 2) {
            const bool last = (t == nt - 2);
            const char* a1 = cA + (size_t)(t + 1) * kstep;
            const char* a2 = last ? nA : cA + (size_t)(t + 2) * kstep; const char* b2 = last ? nB : cB + (size_t)(t + 2) * kstep;
            const char* a3 = a2 + kstep; const char* b3 = b2 + kstep;
            if (last && has_next) S.a_ready(nxt);
            if constexpr (SP2) {
            PG8_LDB(B0, 0, 0); PG8_LDB(B1, 0, 1); PG8_SCHED; PG8_LDA(At, 0, 0); PG8_STAGE(PG8_SA(1, 1), a1 + hsA, voffA);
            PG8_WAIT_V(8); PG8_WAIT_L(0); PG8_BAR; PG8_MMA(0, 0, At, B0); PG8_MMA(0, 1, At, B1); PG8_BAR; PG8_SCHED;
            PG8_LDA(At, 0, 1); PG8_STAGE(PG8_SB(0, 0), b2, voffB); PG8_STAGE(PG8_SB(0, 1), b2 + hsB, voffB); PG8_STAGE(PG8_SA(0, 0), a2, voffA);
            PG8_WAIT_V(8); PG8_WAIT_L(0); PG8_BAR; PG8_MMA(1, 0, At, B0); PG8_MMA(1, 1, At, B1); PG8_BAR; PG8_SCHED;
            PG8_LDB(B0, 1, 0); PG8_LDB(B1, 1, 1); PG8_SCHED; PG8_LDA(At, 1, 0); PG8_STAGE(PG8_SA(0, 1), a2 + hsA, voffA);
            PG8_WAIT_V(8); PG8_WAIT_L(0); PG8_BAR; PG8_MMA(0, 0, At, B0); PG8_MMA(0, 1, At, B1); PG8_BAR; PG8_SCHED;
            PG8_LDA(At, 1, 1); PG8_STAGE(PG8_SB(1, 0), b3, voffB); PG8_STAGE(PG8_SB(1, 1), b3 + hsB, voffB); PG8_STAGE(PG8_SA(1, 0), a3, voffA);
            PG8_WAIT_V(8); PG8_WAIT_L(0); PG8_BAR; PG8_MMA(1, 0, At, B0); PG8_MMA(1, 1, At, B1); PG8_BAR; PG8_SCHED;
            } else {
            PG8_LDB(B0, 0, 0); PG8_SCHED; PG8_LDA(At, 0, 0); PG8_STAGE(PG8_SA(1, 1), a1 + hsA, voffA);
            PG8_WAIT_L(8); PG8_BAR; PG8_WAIT_L(0); PG8_MMA(0, 0, At, B0); PG8_BAR; PG8_SCHED;
            PG8_LDB(B1, 0, 1); PG8_STAGE(PG8_SB(0, 0), b2, voffB);
            PG8_BAR; PG8_WAIT_L(0); PG8_MMA(0, 1, At, B1); PG8_BAR;
            PG8_LDA(At, 0, 1); PG8_STAGE(PG8_SA(0, 0), a2, voffA);
            PG8_BAR; PG8_WAIT_L(0); PG8_MMA(1, 0, At, B0); PG8_BAR; PG8_SCHED;
            PG8_STAGE(PG8_SB(0, 1), b2 + hsB, voffB);
            PG8_WAIT_V(6); PG8_BAR; PG8_MMA(1, 1, At, B1); PG8_BAR;
            PG8_LDB(B0, 1, 0); PG8_SCHED; PG8_LDA(At, 1, 0); PG8_STAGE(PG8_SA(0, 1), a2 + hsA, voffA);
            PG8_WAIT_L(8); PG8_BAR; PG8_WAIT_L(0); PG8_MMA(0, 0, At, B0); PG8_BAR; PG8_SCHED;
            PG8_LDB(B1, 1, 1); PG8_STAGE(PG8_SB(1, 0), b3, voffB);
            PG8_BAR; PG8_WAIT_L(0); PG8_MMA(0, 1, At, B1); PG8_BAR;
            PG8_LDA(At, 1, 1); PG8_STAGE(PG8_SA(1, 0), a3, voffA);
            PG8_BAR; PG8_WAIT_L(0); PG8_MMA(1, 0, At, B0); PG8_BAR; PG8_SCHED;
            PG8_STAGE(PG8_SB(1, 1), b3 + hsB, voffB);
            PG8_WAIT_V(6); PG8_BAR; PG8_MMA(1, 1, At, B1); PG8_BAR;
            }
        }
        if constexpr (ALIGN_EPI) { if (wr == 0) PG8_BAR; }
        if constexpr (!Epi::AFTER_DRAIN) { int fr2 = fr, fq2 = fq; asm volatile("" : "+v"(fr2), "+v"(fq2)); E(acc, cur, wr, wc, fr2, fq2); S.done(cur); }
        if (!has_next) break;
#pragma unroll
        for (int a = 0; a < 2; ++a)
#pragma unroll
            for (int b = 0; b < 2; ++b)
#pragma unroll
                for (int m = 0; m < 4; ++m)
#pragma unroll
                    for (int n = 0; n < 2; ++n) acc[a][b][m][n] = (f32x4){0.f, 0.f, 0.f, 0.f};
        cur = nxt; cA = nA; cB = nB; ++ui;
        if constexpr (ALIGN_EPI) { if (wr == 1) PG8_BAR; }
    }
    PG8_WAIT_V(0);
    if constexpr (!ALIGN_EPI) { if (wr == 0) PG8_BAR; }
    PG8_BAR;
    if constexpr (Epi::AFTER_DRAIN) { int fr2 = fr, fq2 = fq, lane2 = lane; asm volatile("" : "+v"(fr2), "+v"(fq2), "+v"(lane2)); E.fused(acc, cur, wr, wc, fr2, fq2, lds, wid, lane2); S.done(cur); }
#undef PG8_SA
#undef PG8_SB
#undef PG8_STAGE
#undef PG8_LDA
#undef PG8_LDB
#undef PG8_MMA
#undef PG8_WAIT_V
#undef PG8_WAIT_L
#undef PG8_BAR
#undef PG8_SCHED
}}

#define GAS __attribute__((address_space(1)))
#define LAS __attribute__((address_space(3)))
typedef unsigned v4u __attribute__((ext_vector_type(4)));
typedef float f32x4 __attribute__((ext_vector_type(4)));
typedef short bf16x8 __attribute__((ext_vector_type(8)));
typedef GAS unsigned gu32;
typedef GAS unsigned long long gu64;
#define RLX_AGENT __ATOMIC_RELAXED, __HIP_MEMORY_SCOPE_AGENT
#define LDS_WAIT() asm volatile("s_waitcnt lgkmcnt(0)" ::: "memory")
#define VM_WAIT() asm volatile("s_waitcnt vmcnt(0)" ::: "memory")
__device__ __forceinline__ unsigned long long rt() { return __builtin_amdgcn_s_memrealtime(); }
__device__ __forceinline__ unsigned pk2(float lo, float hi) { return (unsigned)f2bf(lo) | ((unsigned)f2bf(hi) << 16); }

#define XB_TMO      128
#define XB_XCNT(j)  (256  + 64 * (j))
#define XB_XSUB(j)  (1280 + 64 * (j))
#define XB_XGEN(j)  (2304 + 64 * (j))
#define XB_TOP      3328
#define XB_TOPGEN   3392
#define XCD_BAR_WORDS 3456
#define XB_SPIN_CAP (1u << 18)

__device__ __forceinline__ unsigned xb_ld(unsigned* p)              { return __hip_atomic_load(p, __ATOMIC_RELAXED, __HIP_MEMORY_SCOPE_AGENT); }
__device__ __forceinline__ unsigned xb_add(unsigned* p, unsigned v) { return __hip_atomic_fetch_add(p, v, __ATOMIC_RELAXED, __HIP_MEMORY_SCOPE_AGENT); }
__device__ __forceinline__ unsigned xb_xcc_id() { return (unsigned)__builtin_amdgcn_s_getreg((3 << 11) | 20) & 0xFu; }
#define XB_SPIN(cond, bar) do { unsigned _sp = 0; while (cond) { __builtin_amdgcn_s_sleep(1); \
    if ((++_sp & 255u) == 0u) { if (xb_ld(&(bar)[XB_TMO])) break; if (_sp > XB_SPIN_CAP) { atomicAdd(&(bar)[XB_TMO], 1u); break; } } } } while (0)

struct XcdBarrier {
    unsigned* bar; unsigned x;
    volatile LAS unsigned* st;
};

__device__ __forceinline__ XcdBarrier xcd_barrier_post(unsigned* bar, volatile LAS unsigned* st) {
    XcdBarrier b; b.bar = bar; b.x = xb_xcc_id(); b.st = st;
    if (threadIdx.x == 0) (void)xb_add(&bar[XB_XCNT(b.x)], 1u);
    return b;
}
__device__ __forceinline__ void xcd_barrier_complete(unsigned* bar, unsigned x, unsigned& nloc, unsigned& nx) {
    const unsigned G = gridDim.x * gridDim.y * gridDim.z;
    unsigned sum, cnt, mine, sp = 0u;
    for (;;) {
        sum = 0u; cnt = 0u; mine = 0u;
#pragma unroll
        for (unsigned j = 0; j < 16; ++j) { const unsigned c = xb_ld(&bar[XB_XCNT(j)]); sum += c; cnt += (c > 0u) ? 1u : 0u; mine = (j == x) ? c : mine; }
        if (sum == G) break;
        __builtin_amdgcn_s_sleep(1);
        if ((++sp & 255u) == 0u) { if (xb_ld(&bar[XB_TMO])) break; if (sp > XB_SPIN_CAP) { atomicAdd(&bar[XB_TMO], 1u); break; } }
    }
    nloc = mine > 0u ? mine : 1u; nx = cnt > 0u ? cnt : 1u;
}

__device__ __forceinline__ void xcd_barrier(const XcdBarrier& b) {
    asm volatile("s_waitcnt vmcnt(0)" ::: "memory");
    __syncthreads();
    if (threadIdx.x == 0) {
        unsigned* bar = b.bar;
        __builtin_amdgcn_s_waitcnt(0);
        unsigned nloc = b.st[0], nx = b.st[1];
        if (nloc == 0u) { xcd_barrier_complete(bar, b.x, nloc, nx); b.st[0] = nloc; b.st[1] = nx; }
        const unsigned old = xb_add(&bar[XB_XSUB(b.x)], 1u);
        const unsigned gen = old / nloc;
        if (old + 1u == (gen + 1u) * nloc) {
            __builtin_amdgcn_fence(__ATOMIC_RELEASE, "agent");
            asm volatile("s_waitcnt vmcnt(0)" ::: "memory");
            const unsigned og = xb_add(&bar[XB_TOP], 1u);
            const unsigned tg = og / nx;
            if (og + 1u == (tg + 1u) * nx) xb_add(&bar[XB_TOPGEN], 1u);
            else XB_SPIN(xb_ld(&bar[XB_TOPGEN]) == tg, bar);
            __builtin_amdgcn_fence(__ATOMIC_ACQUIRE, "agent");
            xb_add(&bar[XB_XGEN(b.x)], 1u);
            asm volatile("s_waitcnt vmcnt(0)" ::: "memory");
        } else {
            XB_SPIN(xb_ld(&bar[XB_XGEN(b.x)]) == gen, bar);
            __builtin_amdgcn_fence(__ATOMIC_ACQUIRE, "agent");
            asm volatile("s_waitcnt vmcnt(0)" ::: "memory");
        }
    }
    __syncthreads();
}
constexpr int NWAVES = 8;
constexpr int RING_OFF = 0, RING_BYTES = 131072;
constexpr int LDSCTL_OFF = RING_BYTES, MISC_OFF = LDSCTL_OFF + 320;
constexpr int LDS_RQ = RING_BYTES + 1024, LDS_IL = RING_BYTES + 2048;
constexpr int LDS_BYTES = 147456;
constexpr int CW_TMO = 0, CW_BAR = 4096;

struct Frame {
    LAS unsigned char* lds; volatile LAS unsigned* MISC; gu32* ctl;
    int tid, lane, wave, vcu, G;
};
struct Args { const void* in[26]; float* out; unsigned char* ws; int ph_lo, ph_hi; };

__device__ __forceinline__ float wave_sum(float v) {
#pragma unroll
    for (int o = 1; o < 64; o <<= 1) v += __shfl_xor(v, o);
    return v;
}
__device__ __forceinline__ void p0_transpose_item(const float* W, int ldw, int K, int N, const float* g, bf16_t* WT, LAS float* scr, int item, int lane) {
    const int nblk = N / 32, kb = item / nblk, nb = item % nblk, k0 = 64 * kb, n0 = 32 * nb;
#pragma unroll 8
    for (int i = 0; i < 32; ++i) { const int kk = 2 * i + (lane >> 5); const float gg = g ? g[k0 + kk] : 1.f; scr[kk * 33 + (lane & 31)] = W[(size_t)(k0 + kk) * ldw + n0 + (lane & 31)] * gg; }
    LDS_WAIT(); asm volatile("" ::: "memory");
    const int c = lane & 7;
#pragma unroll
    for (int j = 0; j < 4; ++j) { const int n = (lane >> 3) + 8 * j; const LAS float* s = scr + (8 * c) * 33 + n;
        v4u o; o.x = pk2(s[0 * 33], s[1 * 33]); o.y = pk2(s[2 * 33], s[3 * 33]); o.z = pk2(s[4 * 33], s[5 * 33]); o.w = pk2(s[6 * 33], s[7 * 33]);
        *(GAS v4u*)(WT + (size_t)(n0 + n) * K + k0 + 8 * c) = o; }
    LDS_WAIT(); asm volatile("" ::: "memory");
}
template <bool FLOG> __device__ __forceinline__ void rms_rows_to_bf16(int lane, const float* X, bf16_t* O, int m0, int step, int rows, const float* g, const float* win, float* flog) {
    if (m0 >= rows) return;
    f32x4 wf[4][4][2];
    if (FLOG) {
#pragma unroll
        for (int j = 0; j < 4; ++j) { const f32x4 gg = *(const GAS f32x4*)(g + 256 * j + 4 * lane);
#pragma unroll
            for (int e = 0; e < 4; ++e) { const int k = 256 * j + 4 * lane + e; wf[j][e][0] = *(const GAS f32x4*)(win + (size_t)k * INCOLS + NPROJ) * gg[e]; wf[j][e][1] = *(const GAS f32x4*)(win + (size_t)k * INCOLS + NPROJ + 4) * gg[e]; } }
    }
    f32x4 nx[4];
    { const GAS f32x4* xr = (const GAS f32x4*)(X + (size_t)m0 * DM) + lane;
#pragma unroll
      for (int j = 0; j < 4; ++j) nx[j] = xr[64 * j]; }
    for (int m = m0; m < rows; m += step) {
        f32x4 v[4];
#pragma unroll
        for (int j = 0; j < 4; ++j) v[j] = nx[j];
        if (m + step < rows) { const GAS f32x4* xr = (const GAS f32x4*)(X + (size_t)(m + step) * DM) + lane;
#pragma unroll
            for (int j = 0; j < 4; ++j) nx[j] = xr[64 * j]; }
        float s2 = 0.f;
#pragma unroll
        for (int j = 0; j < 4; ++j) s2 += (v[j].x * v[j].x + v[j].y * v[j].y) + (v[j].z * v[j].z + v[j].w * v[j].w);
        const float rstd = rsqrtf(wave_sum(s2) * (1.f / DM) + EPS);
        GAS unsigned long long* o8 = (GAS unsigned long long*)(O + (size_t)m * DM) + lane;
#pragma unroll
        for (int j = 0; j < 4; ++j) { v[j] = v[j] * rstd; o8[64 * j] = (unsigned long long)pk2(v[j].x, v[j].y) | ((unsigned long long)pk2(v[j].z, v[j].w) << 32); }
        if (FLOG) {
            f32x4 a0 = {0.f, 0.f, 0.f, 0.f}, a1 = {0.f, 0.f, 0.f, 0.f};
#pragma unroll
            for (int j = 0; j < 4; ++j)
#pragma unroll
                for (int e = 0; e < 4; ++e) { a0 += wf[j][e][0] * v[j][e]; a1 += wf[j][e][1] * v[j][e]; }
#pragma unroll
            for (int e = 0; e < 4; ++e) { a0[e] = wave_sum(a0[e]); a1[e] = wave_sum(a1[e]); }
            if (lane == 0) { *(GAS f32x4*)(flog + (size_t)m * 8) = a0; *(GAS f32x4*)(flog + (size_t)m * 8 + 4) = a1; }
        }
    }
}
__constant__ float INV_FREQ[8] = {1.0f, 0.1939227432012558f, 0.03760603070259094f, 0.007292664609849453f, 0.0014142135623842478f, 0.00027424818836152554f, 5.318296098266728e-05f, 1.0313386155758053e-05f};

struct Ptrs {
    const float *x, *mem; const int* pos; const float *norm_mix_w, *w_in, *b_forget, *dqw, *dkw, *lq1, *lk1, *lq2, *lk2, *subw, *fqw, *fkw, *w_out, *nmq, *nmkv, *w_mq, *w_mkv, *mqw, *mkw, *w_mo, *nmlp, *w_up, *w_dn;
    float* out; float *FLOG, *CUMB, *ROPE, *SS;
    bf16_t *WIN, *WOUT, *WQ, *WKV, *WO, *WUP, *WDN, *XB, *HM, *MK, *VT, *MKN, *PROJ, *ATT, *MQ, *MO, *H;
};
__host__ __device__ __forceinline__ Ptrs make_ptrs(const void* const* in, float* out, unsigned char* ws) {
    Ptrs p;
    p.x = (const float*)in[0]; p.mem = (const float*)in[1]; p.pos = (const int*)in[2]; p.norm_mix_w = (const float*)in[3]; p.w_in = (const float*)in[4]; p.b_forget = (const float*)in[5];
    p.dqw = (const float*)in[6]; p.dkw = (const float*)in[7]; p.lq1 = (const float*)in[8]; p.lk1 = (const float*)in[9]; p.lq2 = (const float*)in[10]; p.lk2 = (const float*)in[11];
    p.subw = (const float*)in[12]; p.fqw = (const float*)in[13]; p.fkw = (const float*)in[14]; p.w_out = (const float*)in[15]; p.nmq = (const float*)in[16]; p.nmkv = (const float*)in[17];
    p.w_mq = (const float*)in[18]; p.w_mkv = (const float*)in[19]; p.mqw = (const float*)in[20]; p.mkw = (const float*)in[21]; p.w_mo = (const float*)in[22]; p.nmlp = (const float*)in[23];
    p.w_up = (const float*)in[24]; p.w_dn = (const float*)in[25]; p.out = out;
    p.FLOG = (float*)(ws + WS_FLOG); p.CUMB = (float*)(ws + WS_CUMB); p.ROPE = (float*)(ws + WS_ROPE); p.SS = (float*)(ws + WS_SS);
    p.WIN = (bf16_t*)(ws + WS_WIN); p.WOUT = (bf16_t*)(ws + WS_WOUT); p.WQ = (bf16_t*)(ws + WS_WQ); p.WKV = (bf16_t*)(ws + WS_WKV); p.WO = (bf16_t*)(ws + WS_WO); p.WUP = (bf16_t*)(ws + WS_WUP); p.WDN = (bf16_t*)(ws + WS_WDN);
    p.XB = (bf16_t*)(ws + WS_XB); p.HM = (bf16_t*)(ws + WS_HM); p.MK = (bf16_t*)(ws + WS_MK); p.VT = (bf16_t*)(ws + WS_VT); p.MKN = (bf16_t*)(ws + WS_MKN);
    p.PROJ = (bf16_t*)(ws + WS_PROJ); p.ATT = (bf16_t*)(ws + WS_ATT); p.MQ = (bf16_t*)(ws + WS_MQ); p.MO = (bf16_t*)(ws + WS_MO); p.H = (bf16_t*)(ws + WS_H);
    return p;
}

__device__ __forceinline__ void p0_prologue(Frame& F, const Ptrs& P) {
    LAS float* scr = (LAS float*)(F.lds + RING_OFF + F.wave * 16384);
    const int gw = F.vcu * NWAVES + F.wave, NGW = F.G * NWAVES;
    constexpr int I_IN = 16 * 96, I_SQ = 16 * 32, I_KV = 16 * 64, I_UP = 16 * 128, I_DN = 64 * 32;
    constexpr int NITEMS = I_IN + 3 * I_SQ + I_KV + I_UP + I_DN;
    for (int it = gw; it < NITEMS; it += NGW) {
        int r = it;
        if (r < I_IN) { p0_transpose_item(P.w_in, INCOLS, DM, NPROJ, P.norm_mix_w, P.WIN, scr, r, F.lane); continue; } r -= I_IN;
        if (r < I_SQ) { p0_transpose_item(P.w_out, DM, DM, DM, nullptr, P.WOUT, scr, r, F.lane); continue; } r -= I_SQ;
        if (r < I_SQ) { p0_transpose_item(P.w_mq, DM, DM, DM, P.nmq, P.WQ, scr, r, F.lane); continue; } r -= I_SQ;
        if (r < I_KV) { p0_transpose_item(P.w_mkv, 2048, DM, 2048, P.nmkv, P.WKV, scr, r, F.lane); continue; } r -= I_KV;
        if (r < I_SQ) { p0_transpose_item(P.w_mo, DM, DM, DM, nullptr, P.WO, scr, r, F.lane); continue; } r -= I_SQ;
        if (r < I_UP) { p0_transpose_item(P.w_up, DFF, DM, DFF, P.nmlp, P.WUP, scr, r, F.lane); continue; } r -= I_UP;
        p0_transpose_item(P.w_dn, DM, DFF, DM, nullptr, P.WDN, scr, r, F.lane);
    }
    rms_rows_to_bf16<true>(F.lane, P.x, P.XB, gw, NGW, MTOK, P.norm_mix_w, P.w_in, P.FLOG);
    rms_rows_to_bf16<false>(F.lane, P.mem, P.HM, gw, NGW, MMEM, nullptr, nullptr, nullptr);
    for (int id = (F.vcu * NWAVES * 64) + F.tid; id < MTOK * 8; id += F.G * NWAVES * 64) {
        const int row = id >> 3, i = id & 7;
        const float ang = (float)P.pos[row] * INV_FREQ[i];
        const double a = (double)ang; const double k = rint(a * 0.15915494309189535); const float r = (float)fma(-k, 6.283185307179586, a);
        P.ROPE[(size_t)row * 16 + i] = cosf(r); P.ROPE[(size_t)row * 16 + 8 + i] = sinf(r);
    }
}
__device__ __forceinline__ void p1b_row(bf16_t* PROJ, const float* dqw, const float* dkw, const float* fqw, const float* fkw, const float* ROPE, int row, int lane) {
    const int sg = lane >> 1, hf = lane & 1;
    const int col = (sg < 16 ? sg * 64 : 1536 + (sg - 16) * 64) + hf * 32;
    const float* w = (sg < 8 ? dqw : sg < 16 ? dkw : sg < 24 ? fqw : fkw) + hf * 32;
    const bool rope = (sg < 16) && (hf == 0), isq = (sg < 8) || (sg >= 16 && sg < 24);
    GAS v4u* p = (GAS v4u*)(PROJ + (size_t)row * NPROJ + col);
    const v4u u0 = p[0], u1 = p[1], u2 = p[2], u3 = p[3];
#define UNP_LO(u) (f32x4){__uint_as_float(u.x << 16), __uint_as_float(u.x & 0xffff0000u), __uint_as_float(u.y << 16), __uint_as_float(u.y & 0xffff0000u)}
#define UNP_HI(u) (f32x4){__uint_as_float(u.z << 16), __uint_as_float(u.z & 0xffff0000u), __uint_as_float(u.w << 16), __uint_as_float(u.w & 0xffff0000u)}
    f32x4 v0 = UNP_LO(u0), v1 = UNP_HI(u0), v2 = UNP_LO(u1), v3 = UNP_HI(u1), v4 = UNP_LO(u2), v5 = UNP_HI(u2), v6 = UNP_LO(u3), v7 = UNP_HI(u3);
#undef UNP_LO
#undef UNP_HI
#define SQ4(v) ((v.x * v.x + v.y * v.y) + (v.z * v.z + v.w * v.w))
    float ss = (SQ4(v0) + SQ4(v1)) + (SQ4(v2) + SQ4(v3)) + (SQ4(v4) + SQ4(v5)) + (SQ4(v6) + SQ4(v7));
#undef SQ4
    ss += __shfl_xor(ss, 1);
    const float rstd = rsqrtf(ss * (1.f / 64.f) + EPS);
    const GAS f32x4* wg = (const GAS f32x4*)w;
    v0 = v0 * rstd * wg[0]; v1 = v1 * rstd * wg[1]; v2 = v2 * rstd * wg[2]; v3 = v3 * rstd * wg[3]; v4 = v4 * rstd * wg[4]; v5 = v5 * rstd * wg[5]; v6 = v6 * rstd * wg[6]; v7 = v7 * rstd * wg[7];
    if (rope) {
        const GAS f32x4* rt = (const GAS f32x4*)(ROPE + (size_t)row * 16);
        const f32x4 c0 = rt[0], c1 = rt[1], s0 = rt[2], s1 = rt[3];
        const f32x4 a0 = v0 * c0 - v2 * s0, b0 = v2 * c0 + v0 * s0, a1 = v1 * c1 - v3 * s1, b1 = v3 * c1 + v1 * s1;
        v0 = a0; v2 = b0; v1 = a1; v3 = b1;
    }
    const float sc = isq ? C2 : 1.f;
#define PK4(a, b) (v4u){pk2(a.x * sc, a.y * sc), pk2(a.z * sc, a.w * sc), pk2(b.x * sc, b.y * sc), pk2(b.z * sc, b.w * sc)}
    p[0] = PK4(v0, v1); p[1] = PK4(v2, v3); p[2] = PK4(v4, v5); p[3] = PK4(v6, v7);
#undef PK4
}
__device__ __forceinline__ void p1b_cumsum(const Ptrs& P, int seq, int lane) {
    const int b = seq >> 3, h = seq & 7; const float bf = P.b_forget[h];
    float lf[32]; float run = 0.f;
#pragma unroll
    for (int i = 0; i < 32; ++i) { const float z = P.FLOG[(size_t)(b * SEQ + lane * 32 + i) * 8 + h] + bf;
        const float e = __expf(-fabsf(z)); lf[i] = fminf(z, 0.f) - log1pf(e); run += lf[i]; }
    float inc = run;
#pragma unroll
    for (int o = 1; o < 64; o <<= 1) { const float t = __shfl_up(inc, o); if (lane >= o) inc += t; }
    float c = inc - run;
#pragma unroll
    for (int i = 0; i < 32; ++i) { c += lf[i]; P.CUMB[(size_t)seq * SEQ + lane * 32 + i] = -c * LOG2E; }
}
namespace att {
typedef short bf16x8 __attribute__((ext_vector_type(8)));
typedef short s16x4 __attribute__((ext_vector_type(4)));
typedef float f32x16 __attribute__((ext_vector_type(16)));
typedef float f32x4 __attribute__((ext_vector_type(4)));
typedef unsigned u32x4 __attribute__((ext_vector_type(4)));
typedef unsigned u32x2 __attribute__((ext_vector_type(2)));
typedef __attribute__((address_space(3))) unsigned char* ldsp;
__device__ __forceinline__ int crow(int r, int hi) { return (r & 3) + 8 * (r >> 2) + 4 * hi; }
__device__ __forceinline__ unsigned cvtpk(float lo, float hi) { unsigned r; asm volatile("v_cvt_pk_bf16_f32 %0, %1, %2" : "=v"(r) : "v"(lo), "v"(hi)); return r; }
__device__ __forceinline__ s16x4 vtr(ldsp p) { typedef short v4i16_t __attribute__((ext_vector_type(4))); return __builtin_bit_cast(s16x4, __builtin_amdgcn_ds_read_tr16_b64_v4i16((__attribute__((address_space(3))) v4i16_t*)p)); }
#define ATT_MFMA(a, b, c) __builtin_amdgcn_mfma_f32_32x32x16_bf16(a, b, c, 0, 0, 0)

template <int DVB, bool FOX>
__device__ __forceinline__ void flash_pass(ldsp lds, const bf16_t* Qp, const bf16_t* Kp, const bf16_t* Vp, const float* bias, int qb, int wid, int tid, f32x16 (&o)[DVB], float& l_out) {
    constexpr int SLOT = 8192 + DVB * 4096, VOFF = 8192, CPR = DVB * 4  , NVP = DVB / 2;
    const int lane = tid & 63, r32 = lane & 31, hi = lane >> 5;
    const int NT = 4 * qb + 4, my_last = 4 * qb + (wid >> 1);
    bf16x8 qr[4];
    { const bf16_t* qrow = Qp + (size_t)(256 * qb + 32 * wid + r32) * NPROJ + 8 * hi;
#pragma unroll
      for (int d0 = 0; d0 < 4; ++d0) qr[d0] = *(const bf16x8*)(qrow + 16 * d0); }
#pragma unroll
    for (int i = 0; i < DVB; ++i)
#pragma unroll
        for (int r = 0; r < 16; ++r) o[i][r] = 0.f;
    float m = -1e30f, l = 0.f;
    const int krow = tid >> 3, kc = tid & 7;
    const bf16_t* ksrc = Kp + (size_t)krow * NPROJ + kc * 8;
    const int kdst = kc * 1024 + ((krow ^ kc) * 16);
    u32x4 kreg, vreg[NVP];
    const bf16_t* vsrc[NVP]; int vdst[NVP];
#pragma unroll
    for (int pp = 0; pp < NVP; ++pp) { const int i = tid + 512 * pp, row = i / CPR, c16 = i % CPR; vsrc[pp] = Vp + (size_t)row * NPROJ + c16 * 8; vdst[pp] = VOFF + (c16 >> 2) * 4096 + row * 64 + (c16 & 3) * 16; }
#define ATT_LOAD(t) do { kreg = *(const u32x4*)(ksrc + (size_t)(t) * 64 * NPROJ); _Pragma("unroll") for (int pp = 0; pp < NVP; ++pp) vreg[pp] = *(const u32x4*)(vsrc[pp] + (size_t)(t) * 64 * NPROJ); } while (0)
#define ATT_STORE(buf) do { *(__attribute__((address_space(3))) u32x4*)(lds + (buf) * SLOT + kdst) = kreg; _Pragma("unroll") for (int pp = 0; pp < NVP; ++pp) *(__attribute__((address_space(3))) u32x4*)(lds + (buf) * SLOT + vdst[pp]) = vreg[pp]; } while (0)
    const int vb0 = VOFF + ((lane >> 4) & 1) * 32 + (lane & 3) * 8 + (4 * hi + ((lane & 15) >> 2)) * 64;
    ATT_LOAD(0); ATT_STORE(0); __syncthreads();
    for (int t = 0; t < NT; ++t) {
        const int cur = t & 1;
        if (t + 1 < NT) ATT_LOAD(t + 1);
        if (t <= my_last) {
            const ldsp sl = lds + cur * SLOT;
            f32x16 p0, p1;
            if (FOX) {
                const float* bp = bias + 64 * t + 4 * hi;
#pragma unroll
                for (int g = 0; g < 4; ++g) { const f32x4 a = *(const f32x4*)(bp + 8 * g), b = *(const f32x4*)(bp + 32 + 8 * g);
#pragma unroll
                    for (int e = 0; e < 4; ++e) { p0[4 * g + e] = a[e]; p1[4 * g + e] = b[e]; } }
            } else {
#pragma unroll
                for (int r = 0; r < 16; ++r) { p0[r] = 0.f; p1[r] = 0.f; }
            }
#pragma unroll
            for (int d0 = 0; d0 < 4; ++d0) { const int c = 2 * d0 + hi; const ldsp ka = sl + c * 1024 + ((r32 ^ c) * 16);
                const bf16x8 b0 = *(const __attribute__((address_space(3))) bf16x8*)(ka), b1 = *(const __attribute__((address_space(3))) bf16x8*)(ka + 512);
                p0 = ATT_MFMA(b0, qr[d0], p0); p1 = ATT_MFMA(b1, qr[d0], p1); }
            if (FOX && t == my_last) {
                const int qrel = 32 * (wid & 1) + r32;
#pragma unroll
                for (int r = 0; r < 16; ++r) { const int kv = crow(r, hi); if (kv > qrel) p0[r] = -1e30f; if (kv + 32 > qrel) p1[r] = -1e30f; }
            }
            float mx = fmaxf(p0[0], p1[0]);
#pragma unroll
            for (int r = 1; r < 16; ++r) mx = fmaxf(mx, fmaxf(p0[r], p1[r]));
            mx = fmaxf(mx, __shfl_xor(mx, 32));
            const float mn = fmaxf(m, mx);
            if (__any(mn > m)) { const float al = __builtin_amdgcn_exp2f(m - mn); l *= al;
#pragma unroll
                for (int i = 0; i < DVB; ++i)
#pragma unroll
                    for (int r = 0; r < 16; ++r) o[i][r] *= al; }
            m = mn;
            float rs = 0.f;
#pragma unroll
            for (int r = 0; r < 16; ++r) { p0[r] = __builtin_amdgcn_exp2f(p0[r] - m); p1[r] = __builtin_amdgcn_exp2f(p1[r] - m); rs += p0[r] + p1[r]; }
            l += rs;
            u32x4 pw[4];
#pragma unroll
            for (int s = 0; s < 2; ++s) { pw[s] = (u32x4){cvtpk(p0[8 * s], p0[8 * s + 1]), cvtpk(p0[8 * s + 2], p0[8 * s + 3]), cvtpk(p0[8 * s + 4], p0[8 * s + 5]), cvtpk(p0[8 * s + 6], p0[8 * s + 7])};
                pw[2 + s] = (u32x4){cvtpk(p1[8 * s], p1[8 * s + 1]), cvtpk(p1[8 * s + 2], p1[8 * s + 3]), cvtpk(p1[8 * s + 4], p1[8 * s + 5]), cvtpk(p1[8 * s + 6], p1[8 * s + 7])}; }
            const ldsp vb = sl + vb0;
#pragma unroll
            for (int i = 0; i < DVB; ++i)
#pragma unroll
                for (int s = 0; s < 4; ++s) { const s16x4 lo = vtr(vb + i * 4096 + s * 1024), hh = vtr(vb + i * 4096 + s * 1024 + 512);
                    const bf16x8 vf = (bf16x8){lo[0], lo[1], lo[2], lo[3], hh[0], hh[1], hh[2], hh[3]};
                    o[i] = ATT_MFMA(vf, __builtin_bit_cast(bf16x8, pw[s]), o[i]); }
        }
        if (t + 1 < NT) ATT_STORE(cur ^ 1);
        __syncthreads();
    }
    l_out = l + __shfl_xor(l, 32);
#undef ATT_LOAD
#undef ATT_STORE
}

__device__ __forceinline__ void fox_unit(ldsp lds, const bf16_t* PROJ, const float* CUMB, bf16_t* ATT, int bh, int qb, int wid, int tid) {
    const int b = bh >> 3, h = bh & 7, lane = tid & 63, r32 = lane & 31, hi = lane >> 5;
    const bf16_t* base = PROJ + (size_t)b * SEQ * NPROJ;
    f32x16 o[2]; float l;
    flash_pass<2, true>(lds, base + C_FQ + 64 * h, base + C_FK + 64 * h, base + C_FV + 64 * h, CUMB + (size_t)bh * SEQ, qb, wid, tid, o, l);
    const float il = 1.0f / l;
    bf16_t* orow = ATT + (size_t)(b * SEQ + 256 * qb + 32 * wid + r32) * DM + 512 + 64 * h + 4 * hi;
#pragma unroll
    for (int i = 0; i < 2; ++i)
#pragma unroll
        for (int g = 0; g < 4; ++g) { u32x2 w; w.x = cvtpk(o[i][4 * g] * il, o[i][4 * g + 1] * il); w.y = cvtpk(o[i][4 * g + 2] * il, o[i][4 * g + 3] * il); *(u32x2*)(orow + 32 * i + 8 * g) = w; }
}
__device__ __forceinline__ void diff_unit(ldsp lds, const bf16_t* PROJ, bf16_t* ATT, const float* subw, float lam, int bh, int qb, int wid, int tid) {
    const int b = bh >> 2, h = bh & 3, lane = tid & 63, r32 = lane & 31, hi = lane >> 5;
    const bf16_t* base = PROJ + (size_t)b * SEQ * NPROJ;
    f32x16 o[4]; float l; unsigned park[4][8];
    flash_pass<4, false>(lds, base + C_DQ + 128 * h, base + C_DK + 128 * h, base + C_DV + 128 * h, nullptr, qb, wid, tid, o, l);
    { const float il = 1.0f / l;
#pragma unroll
      for (int i = 0; i < 4; ++i)
#pragma unroll
          for (int j = 0; j < 8; ++j) park[i][j] = cvtpk(o[i][2 * j] * il, o[i][2 * j + 1] * il); }
    flash_pass<4, false>(lds, base + C_DQ + 128 * h + 64, base + C_DK + 128 * h + 64, base + C_DV + 128 * h, nullptr, qb, wid, tid, o, l);
    const float il2 = lam / l; float ss = 0.f;
#pragma unroll
    for (int i = 0; i < 4; ++i)
#pragma unroll
        for (int j = 0; j < 8; ++j) { const float a0 = __uint_as_float(park[i][j] << 16), a1 = __uint_as_float(park[i][j] & 0xffff0000u);
            const float v0 = a0 - o[i][2 * j] * il2, v1 = a1 - o[i][2 * j + 1] * il2; o[i][2 * j] = v0; o[i][2 * j + 1] = v1; ss += v0 * v0 + v1 * v1; }
    ss += __shfl_xor(ss, 32);
    const float rstd = rsqrtf(ss * (1.f / 128.f) + EPS) * 0.8f;
    bf16_t* orow = ATT + (size_t)(b * SEQ + 256 * qb + 32 * wid + r32) * DM + 128 * h + 4 * hi;
#pragma unroll
    for (int i = 0; i < 4; ++i)
#pragma unroll
        for (int g = 0; g < 4; ++g) { const f32x4 sw = *(const f32x4*)(subw + 32 * i + 8 * g + 4 * hi);
            u32x2 w; w.x = cvtpk(o[i][4 * g] * rstd * sw[0], o[i][4 * g + 1] * rstd * sw[1]); w.y = cvtpk(o[i][4 * g + 2] * rstd * sw[2], o[i][4 * g + 3] * rstd * sw[3]); *(u32x2*)(orow + 32 * i + 8 * g) = w; }
}
#undef ATT_MFMA
}
__constant__ unsigned short UNIT_TAB[256][8] = {
  {0x8007,0xffff,0xffff,0xffff,0xffff,0xffff,0xffff,0xffff},
  {0x8027,0xffff,0xffff,0xffff,0xffff,0xffff,0xffff,0xffff},
  {0x8047,0xffff,0xffff,0xffff,0xffff,0xffff,0xffff,0xffff},
  {0x8067,0xffff,0xffff,0xffff,0xffff,0xffff,0xffff,0xffff},
  {0x8087,0xffff,0xffff,0xffff,0xffff,0xffff,0xffff,0xffff},
  {0x80a7,0xffff,0xffff,0xffff,0xffff,0xffff,0xffff,0xffff},
  {0x80c7,0xffff,0xffff,0xffff,0xffff,0xffff,0xffff,0xffff},
  {0x80e7,0xffff,0xffff,0xffff,0xffff,0xffff,0xffff,0xffff},
  {0x800f,0xffff,0xffff,0xffff,0xffff,0xffff,0xffff,0xffff},
  {0x802f,0xffff,0xffff,0xffff,0xffff,0xffff,0xffff,0xffff},
  {0x804f,0xffff,0xffff,0xffff,0xffff,0xffff,0xffff,0xffff},
  {0x806f,0xffff,0xffff,0xffff,0xffff,0xffff,0xffff,0xffff},
  {0x808f,0xffff,0xffff,0xffff,0xffff,0xffff,0xffff,0xffff},
  {0x80af,0xffff,0xffff,0xffff,0xffff,0xffff,0xffff,0xffff},
  {0x80cf,0xffff,0xffff,0xffff,0xffff,0xffff,0xffff,0xffff},
  {0x80ef,0xffff,0xffff,0xffff,0xffff,0xffff,0xffff,0xffff},
  {0x8017,0xffff,0xffff,0xffff,0xffff,0xffff,0xffff,0xffff},
  {0x8037,0xffff,0xffff,0xffff,0xffff,0xffff,0xffff,0xffff},
  {0x8057,0xffff,0xffff,0xffff,0xffff,0xffff,0xffff,0xffff},
  {0x8077,0xffff,0xffff,0xffff,0xffff,0xffff,0xffff,0xffff},
  {0x8097,0xffff,0xffff,0xffff,0xffff,0xffff,0xffff,0xffff},
  {0x80b7,0xffff,0xffff,0xffff,0xffff,0xffff,0xffff,0xffff},
  {0x80d7,0xffff,0xffff,0xffff,0xffff,0xffff,0xffff,0xffff},
  {0x80f7,0xffff,0xffff,0xffff,0xffff,0xffff,0xffff,0xffff},
  {0x801f,0xffff,0xffff,0xffff,0xffff,0xffff,0xffff,0xffff},
  {0x803f,0xffff,0xffff,0xffff,0xffff,0xffff,0xffff,0xffff},
  {0x805f,0xffff,0xffff,0xffff,0xffff,0xffff,0xffff,0xffff},
  {0x807f,0xffff,0xffff,0xffff,0xffff,0xffff,0xffff,0xffff},
  {0x809f,0xffff,0xffff,0xffff,0xffff,0xffff,0xffff,0xffff},
  {0x80bf,0xffff,0xffff,0xffff,0xffff,0xffff,0xffff,0xffff},
  {0x80df,0xffff,0xffff,0xffff,0xffff,0xffff,0xffff,0xffff},
  {0x80ff,0xffff,0xffff,0xffff,0xffff,0xffff,0xffff,0xffff},
  {0x8006,0x0000,0xffff,0xffff,0xffff,0xffff,0xffff,0xffff},
  {0x8026,0x0040,0xffff,0xffff,0xffff,0xffff,0xffff,0xffff},
  {0x8046,0x0080,0xffff,0xffff,0xffff,0xffff,0xffff,0xffff},
  {0x8066,0x00c0,0xffff,0xffff,0xffff,0xffff,0xffff,0xffff},
  {0x8086,0x0100,0xffff,0xffff,0xffff,0xffff,0xffff,0xffff},
  {0x80a6,0x0140,0xffff,0xffff,0xffff,0xffff,0xffff,0xffff},
  {0x80c6,0x0180,0xffff,0xffff,0xffff,0xffff,0xffff,0xffff},
  {0x80e6,0x01c0,0xffff,0xffff,0xffff,0xffff,0xffff,0xffff},
  {0x800e,0x0008,0xffff,0xffff,0xffff,0xffff,0xffff,0xffff},
  {0x802e,0x0048,0xffff,0xffff,0xffff,0xffff,0xffff,0xffff},
  {0x804e,0x0088,0xffff,0xffff,0xffff,0xffff,0xffff,0xffff},
  {0x806e,0x00c8,0xffff,0xffff,0xffff,0xffff,0xffff,0xffff},
  {0x808e,0x0108,0xffff,0xffff,0xffff,0xffff,0xffff,0xffff},
  {0x80ae,0x0148,0xffff,0xffff,0xffff,0xffff,0xffff,0xffff},
  {0x80ce,0x0188,0xffff,0xffff,0xffff,0xffff,0xffff,0xffff},
  {0x80ee,0x01c8,0xffff,0xffff,0xffff,0xffff,0xffff,0xffff},
  {0x8016,0x0010,0xffff,0xffff,0xffff,0xffff,0xffff,0xffff},
  {0x8036,0x0050,0xffff,0xffff,0xffff,0xffff,0xffff,0xffff},
  {0x8056,0x0090,0xffff,0xffff,0xffff,0xffff,0xffff,0xffff},
  {0x8076,0x00d0,0xffff,0xffff,0xffff,0xffff,0xffff,0xffff},
  {0x8096,0x0110,0xffff,0xffff,0xffff,0xffff,0xffff,0xffff},
  {0x80b6,0x0150,0xffff,0xffff,0xffff,0xffff,0xffff,0xffff},
  {0x80d6,0x0190,0xffff,0xffff,0xffff,0xffff,0xffff,0xffff},
  {0x80f6,0x01d0,0xffff,0xffff,0xffff,0xffff,0xffff,0xffff},
  {0x801e,0x0018,0xffff,0xffff,0xffff,0xffff,0xffff,0xffff},
  {0x803e,0x0058,0xffff,0xffff,0xffff,0xffff,0xffff,0xffff},
  {0x805e,0x0098,0xffff,0xffff,0xffff,0xffff,0xffff,0xffff},
  {0x807e,0x00d8,0xffff,0xffff,0xffff,0xffff,0xffff,0xffff},
  {0x809e,0x0118,0xffff,0xffff,0xffff,0xffff,0xffff,0xffff},
  {0x80be,0x0158,0xffff,0xffff,0xffff,0xffff,0xffff,0xffff},
  {0x80de,0x0198,0xffff,0xffff,0xffff,0xffff,0xffff,0xffff},
  {0x80fe,0x01d8,0xffff,0xffff,0xffff,0xffff,0xffff,0xffff},
  {0x8005,0x8000,0x0020,0xffff,0xffff,0xffff,0xffff,0xffff},
  {0x8025,0x8020,0x0060,0xffff,0xffff,0xffff,0xffff,0xffff},
  {0x8045,0x8040,0x00a0,0xffff,0xffff,0xffff,0xffff,0xffff},
  {0x8065,0x8060,0x00e0,0xffff,0xffff,0xffff,0xffff,0xffff},
  {0x8085,0x8080,0x0120,0xffff,0xffff,0xffff,0xffff,0xffff},
  {0x80a5,0x80a0,0x0160,0xffff,0xffff,0xffff,0xffff,0xffff},
  {0x80c5,0x80c0,0x01a0,0xffff,0xffff,0xffff,0xffff,0xffff},
  {0x80e5,0x80e0,0x01e0,0xffff,0xffff,0xffff,0xffff,0xffff},
  {0x800d,0x8008,0x0028,0xffff,0xffff,0xffff,0xffff,0xffff},
  {0x802d,0x8028,0x0068,0xffff,0xffff,0xffff,0xffff,0xffff},
  {0x804d,0x8048,0x00a8,0xffff,0xffff,0xffff,0xffff,0xffff},
  {0x806d,0x8068,0x00e8,0xffff,0xffff,0xffff,0xffff,0xffff},
  {0x808d,0x8088,0x0128,0xffff,0xffff,0xffff,0xffff,0xffff},
  {0x80ad,0x80a8,0x0168,0xffff,0xffff,0xffff,0xffff,0xffff},
  {0x80cd,0x80c8,0x01a8,0xffff,0xffff,0xffff,0xffff,0xffff},
  {0x80ed,0x80e8,0x01e8,0xffff,0xffff,0xffff,0xffff,0xffff},
  {0x8015,0x8010,0x0030,0xffff,0xffff,0xffff,0xffff,0xffff},
  {0x8035,0x8030,0x0070,0xffff,0xffff,0xffff,0xffff,0xffff},
  {0x8055,0x8050,0x00b0,0xffff,0xffff,0xffff,0xffff,0xffff},
  {0x8075,0x8070,0x00f0,0xffff,0xffff,0xffff,0xffff,0xffff},
  {0x8095,0x8090,0x0130,0xffff,0xffff,0xffff,0xffff,0xffff},
  {0x80b5,0x80b0,0x0170,0xffff,0xffff,0xffff,0xffff,0xffff},
  {0x80d5,0x80d0,0x01b0,0xffff,0xffff,0xffff,0xffff,0xffff},
  {0x80f5,0x80f0,0x01f0,0xffff,0xffff,0xffff,0xffff,0xffff},
  {0x801d,0x8018,0x0038,0xffff,0xffff,0xffff,0xffff,0xffff},
  {0x803d,0x8038,0x0078,0xffff,0xffff,0xffff,0xffff,0xffff},
  {0x805d,0x8058,0x00b8,0xffff,0xffff,0xffff,0xffff,0xffff},
  {0x807d,0x8078,0x00f8,0xffff,0xffff,0xffff,0xffff,0xffff},
  {0x809d,0x8098,0x0138,0xffff,0xffff,0xffff,0xffff,0xffff},
  {0x80bd,0x80b8,0x0178,0xffff,0xffff,0xffff,0xffff,0xffff},
  {0x80dd,0x80d8,0x01b8,0xffff,0xffff,0xffff,0xffff,0xffff},
  {0x80fd,0x80f8,0x01f8,0xffff,0xffff,0xffff,0xffff,0xffff},
  {0x8004,0x0024,0x0001,0xffff,0xffff,0xffff,0xffff,0xffff},
  {0x8024,0x0064,0x0041,0xffff,0xffff,0xffff,0xffff,0xffff},
  {0x8044,0x00a4,0x0081,0xffff,0xffff,0xffff,0xffff,0xffff},
  {0x8064,0x00e4,0x00c1,0xffff,0xffff,0xffff,0xffff,0xffff},
  {0x8084,0x0124,0x0101,0xffff,0xffff,0xffff,0xffff,0xffff},
  {0x80a4,0x0164,0x0141,0xffff,0xffff,0xffff,0xffff,0xffff},
  {0x80c4,0x01a4,0x0181,0xffff,0xffff,0xffff,0xffff,0xffff},
  {0x80e4,0x01e4,0x01c1,0xffff,0xffff,0xffff,0xffff,0xffff},
  {0x800c,0x002c,0x0009,0xffff,0xffff,0xffff,0xffff,0xffff},
  {0x802c,0x006c,0x0049,0xffff,0xffff,0xffff,0xffff,0xffff},
  {0x804c,0x00ac,0x0089,0xffff,0xffff,0xffff,0xffff,0xffff},
  {0x806c,0x00ec,0x00c9,0xffff,0xffff,0xffff,0xffff,0xffff},
  {0x808c,0x012c,0x0109,0xffff,0xffff,0xffff,0xffff,0xffff},
  {0x80ac,0x016c,0x0149,0xffff,0xffff,0xffff,0xffff,0xffff},
  {0x80cc,0x01ac,0x0189,0xffff,0xffff,0xffff,0xffff,0xffff},
  {0x80ec,0x01ec,0x01c9,0xffff,0xffff,0xffff,0xffff,0xffff},
  {0x8014,0x0034,0x0011,0xffff,0xffff,0xffff,0xffff,0xffff},
  {0x8034,0x0074,0x0051,0xffff,0xffff,0xffff,0xffff,0xffff},
  {0x8054,0x00b4,0x0091,0xffff,0xffff,0xffff,0xffff,0xffff},
  {0x8074,0x00f4,0x00d1,0xffff,0xffff,0xffff,0xffff,0xffff},
  {0x8094,0x0134,0x0111,0xffff,0xffff,0xffff,0xffff,0xffff},
  {0x80b4,0x0174,0x0151,0xffff,0xffff,0xffff,0xffff,0xffff},
  {0x80d4,0x01b4,0x0191,0xffff,0xffff,0xffff,0xffff,0xffff},
  {0x80f4,0x01f4,0x01d1,0xffff,0xffff,0xffff,0xffff,0xffff},
  {0x801c,0x003c,0x0019,0xffff,0xffff,0xffff,0xffff,0xffff},
  {0x803c,0x007c,0x0059,0xffff,0xffff,0xffff,0xffff,0xffff},
  {0x805c,0x00bc,0x0099,0xffff,0xffff,0xffff,0xffff,0xffff},
  {0x807c,0x00fc,0x00d9,0xffff,0xffff,0xffff,0xffff,0xffff},
  {0x809c,0x013c,0x0119,0xffff,0xffff,0xffff,0xffff,0xffff},
  {0x80bc,0x017c,0x0159,0xffff,0xffff,0xffff,0xffff,0xffff},
  {0x80dc,0x01bc,0x0199,0xffff,0xffff,0xffff,0xffff,0xffff},
  {0x80fc,0x01fc,0x01d9,0xffff,0xffff,0xffff,0xffff,0xffff},
  {0x8003,0x0005,0x0023,0xffff,0xffff,0xffff,0xffff,0xffff},
  {0x8023,0x0045,0x0063,0xffff,0xffff,0xffff,0xffff,0xffff},
  {0x8043,0x0085,0x00a3,0xffff,0xffff,0xffff,0xffff,0xffff},
  {0x8063,0x00c5,0x00e3,0xffff,0xffff,0xffff,0xffff,0xffff},
  {0x8083,0x0105,0x0123,0xffff,0xffff,0xffff,0xffff,0xffff},
  {0x80a3,0x0145,0x0163,0xffff,0xffff,0xffff,0xffff,0xffff},
  {0x80c3,0x0185,0x01a3,0xffff,0xffff,0xffff,0xffff,0xffff},
  {0x80e3,0x01c5,0x01e3,0xffff,0xffff,0xffff,0xffff,0xffff},
  {0x800b,0x000d,0x002b,0xffff,0xffff,0xffff,0xffff,0xffff},
  {0x802b,0x004d,0x006b,0xffff,0xffff,0xffff,0xffff,0xffff},
  {0x804b,0x008d,0x00ab,0xffff,0xffff,0xffff,0xffff,0xffff},
  {0x806b,0x00cd,0x00eb,0xffff,0xffff,0xffff,0xffff,0xffff},
  {0x808b,0x010d,0x012b,0xffff,0xffff,0xffff,0xffff,0xffff},
  {0x80ab,0x014d,0x016b,0xffff,0xffff,0xffff,0xffff,0xffff},
  {0x80cb,0x018d,0x01ab,0xffff,0xffff,0xffff,0xffff,0xffff},
  {0x80eb,0x01cd,0x01eb,0xffff,0xffff,0xffff,0xffff,0xffff},
  {0x8013,0x0015,0x0033,0xffff,0xffff,0xffff,0xffff,0xffff},
  {0x8033,0x0055,0x0073,0xffff,0xffff,0xffff,0xffff,0xffff},
  {0x8053,0x0095,0x00b3,0xffff,0xffff,0xffff,0xffff,0xffff},
  {0x8073,0x00d5,0x00f3,0xffff,0xffff,0xffff,0xffff,0xffff},
  {0x8093,0x0115,0x0133,0xffff,0xffff,0xffff,0xffff,0xffff},
  {0x80b3,0x0155,0x0173,0xffff,0xffff,0xffff,0xffff,0xffff},
  {0x80d3,0x0195,0x01b3,0xffff,0xffff,0xffff,0xffff,0xffff},
  {0x80f3,0x01d5,0x01f3,0xffff,0xffff,0xffff,0xffff,0xffff},
  {0x801b,0x001d,0x003b,0xffff,0xffff,0xffff,0xffff,0xffff},
  {0x803b,0x005d,0x007b,0xffff,0xffff,0xffff,0xffff,0xffff},
  {0x805b,0x009d,0x00bb,0xffff,0xffff,0xffff,0xffff,0xffff},
  {0x807b,0x00dd,0x00fb,0xffff,0xffff,0xffff,0xffff,0xffff},
  {0x809b,0x011d,0x013b,0xffff,0xffff,0xffff,0xffff,0xffff},
  {0x80bb,0x015d,0x017b,0xffff,0xffff,0xffff,0xffff,0xffff},
  {0x80db,0x019d,0x01bb,0xffff,0xffff,0xffff,0xffff,0xffff},
  {0x80fb,0x01dd,0x01fb,0xffff,0xffff,0xffff,0xffff,0xffff},
  {0x8002,0x8001,0x0003,0x0002,0xffff,0xffff,0xffff,0xffff},
  {0x8022,0x8021,0x0043,0x0042,0xffff,0xffff,0xffff,0xffff},
  {0x8042,0x8041,0x0083,0x0082,0xffff,0xffff,0xffff,0xffff},
  {0x8062,0x8061,0x00c3,0x00c2,0xffff,0xffff,0xffff,0xffff},
  {0x8082,0x8081,0x0103,0x0102,0xffff,0xffff,0xffff,0xffff},
  {0x80a2,0x80a1,0x0143,0x0142,0xffff,0xffff,0xffff,0xffff},
  {0x80c2,0x80c1,0x0183,0x0182,0xffff,0xffff,0xffff,0xffff},
  {0x80e2,0x80e1,0x01c3,0x01c2,0xffff,0xffff,0xffff,0xffff},
  {0x800a,0x8009,0x000b,0x000a,0xffff,0xffff,0xffff,0xffff},
  {0x802a,0x8029,0x004b,0x004a,0xffff,0xffff,0xffff,0xffff},
  {0x804a,0x8049,0x008b,0x008a,0xffff,0xffff,0xffff,0xffff},
  {0x806a,0x8069,0x00cb,0x00ca,0xffff,0xffff,0xffff,0xffff},
  {0x808a,0x8089,0x010b,0x010a,0xffff,0xffff,0xffff,0xffff},
  {0x80aa,0x80a9,0x014b,0x014a,0xffff,0xffff,0xffff,0xffff},
  {0x80ca,0x80c9,0x018b,0x018a,0xffff,0xffff,0xffff,0xffff},
  {0x80ea,0x80e9,0x01cb,0x01ca,0xffff,0xffff,0xffff,0xffff},
  {0x8012,0x8011,0x0013,0x0012,0xffff,0xffff,0xffff,0xffff},
  {0x8032,0x8031,0x0053,0x0052,0xffff,0xffff,0xffff,0xffff},
  {0x8052,0x8051,0x0093,0x0092,0xffff,0xffff,0xffff,0xffff},
  {0x8072,0x8071,0x00d3,0x00d2,0xffff,0xffff,0xffff,0xffff},
  {0x8092,0x8091,0x0113,0x0112,0xffff,0xffff,0xffff,0xffff},
  {0x80b2,0x80b1,0x0153,0x0152,0xffff,0xffff,0xffff,0xffff},
  {0x80d2,0x80d1,0x0193,0x0192,0xffff,0xffff,0xffff,0xffff},
  {0x80f2,0x80f1,0x01d3,0x01d2,0xffff,0xffff,0xffff,0xffff},
  {0x801a,0x8019,0x001b,0x001a,0xffff,0xffff,0xffff,0xffff},
  {0x803a,0x8039,0x005b,0x005a,0xffff,0xffff,0xffff,0xffff},
  {0x805a,0x8059,0x009b,0x009a,0xffff,0xffff,0xffff,0xffff},
  {0x807a,0x8079,0x00db,0x00da,0xffff,0xffff,0xffff,0xffff},
  {0x809a,0x8099,0x011b,0x011a,0xffff,0xffff,0xffff,0xffff},
  {0x80ba,0x80b9,0x015b,0x015a,0xffff,0xffff,0xffff,0xffff},
  {0x80da,0x80d9,0x019b,0x019a,0xffff,0xffff,0xffff,0xffff},
  {0x80fa,0x80f9,0x01db,0x01da,0xffff,0xffff,0xffff,0xffff},
  {0x0007,0x0006,0x0025,0x0021,0xffff,0xffff,0xffff,0xffff},
  {0x0047,0x0046,0x0065,0x0061,0xffff,0xffff,0xffff,0xffff},
  {0x0087,0x0086,0x00a5,0x00a1,0xffff,0xffff,0xffff,0xffff},
  {0x00c7,0x00c6,0x00e5,0x00e1,0xffff,0xffff,0xffff,0xffff},
  {0x0107,0x0106,0x0125,0x0121,0xffff,0xffff,0xffff,0xffff},
  {0x0147,0x0146,0x0165,0x0161,0xffff,0xffff,0xffff,0xffff},
  {0x0187,0x0186,0x01a5,0x01a1,0xffff,0xffff,0xffff,0xffff},
  {0x01c7,0x01c6,0x01e5,0x01e1,0xffff,0xffff,0xffff,0xffff},
  {0x000f,0x000e,0x002d,0x0029,0xffff,0xffff,0xffff,0xffff},
  {0x004f,0x004e,0x006d,0x0069,0xffff,0xffff,0xffff,0xffff},
  {0x008f,0x008e,0x00ad,0x00a9,0xffff,0xffff,0xffff,0xffff},
  {0x00cf,0x00ce,0x00ed,0x00e9,0xffff,0xffff,0xffff,0xffff},
  {0x010f,0x010e,0x012d,0x0129,0xffff,0xffff,0xffff,0xffff},
  {0x014f,0x014e,0x016d,0x0169,0xffff,0xffff,0xffff,0xffff},
  {0x018f,0x018e,0x01ad,0x01a9,0xffff,0xffff,0xffff,0xffff},
  {0x01cf,0x01ce,0x01ed,0x01e9,0xffff,0xffff,0xffff,0xffff},
  {0x0017,0x0016,0x0035,0x0031,0xffff,0xffff,0xffff,0xffff},
  {0x0057,0x0056,0x0075,0x0071,0xffff,0xffff,0xffff,0xffff},
  {0x0097,0x0096,0x00b5,0x00b1,0xffff,0xffff,0xffff,0xffff},
  {0x00d7,0x00d6,0x00f5,0x00f1,0xffff,0xffff,0xffff,0xffff},
  {0x0117,0x0116,0x0135,0x0131,0xffff,0xffff,0xffff,0xffff},
  {0x0157,0x0156,0x0175,0x0171,0xffff,0xffff,0xffff,0xffff},
  {0x0197,0x0196,0x01b5,0x01b1,0xffff,0xffff,0xffff,0xffff},
  {0x01d7,0x01d6,0x01f5,0x01f1,0xffff,0xffff,0xffff,0xffff},
  {0x001f,0x001e,0x003d,0x0039,0xffff,0xffff,0xffff,0xffff},
  {0x005f,0x005e,0x007d,0x0079,0xffff,0xffff,0xffff,0xffff},
  {0x009f,0x009e,0x00bd,0x00b9,0xffff,0xffff,0xffff,0xffff},
  {0x00df,0x00de,0x00fd,0x00f9,0xffff,0xffff,0xffff,0xffff},
  {0x011f,0x011e,0x013d,0x0139,0xffff,0xffff,0xffff,0xffff},
  {0x015f,0x015e,0x017d,0x0179,0xffff,0xffff,0xffff,0xffff},
  {0x019f,0x019e,0x01bd,0x01b9,0xffff,0xffff,0xffff,0xffff},
  {0x01df,0x01de,0x01fd,0x01f9,0xffff,0xffff,0xffff,0xffff},
  {0x0027,0x0026,0x0004,0x0022,0xffff,0xffff,0xffff,0xffff},
  {0x0067,0x0066,0x0044,0x0062,0xffff,0xffff,0xffff,0xffff},
  {0x00a7,0x00a6,0x0084,0x00a2,0xffff,0xffff,0xffff,0xffff},
  {0x00e7,0x00e6,0x00c4,0x00e2,0xffff,0xffff,0xffff,0xffff},
  {0x0127,0x0126,0x0104,0x0122,0xffff,0xffff,0xffff,0xffff},
  {0x0167,0x0166,0x0144,0x0162,0xffff,0xffff,0xffff,0xffff},
  {0x01a7,0x01a6,0x0184,0x01a2,0xffff,0xffff,0xffff,0xffff},
  {0x01e7,0x01e6,0x01c4,0x01e2,0xffff,0xffff,0xffff,0xffff},
  {0x002f,0x002e,0x000c,0x002a,0xffff,0xffff,0xffff,0xffff},
  {0x006f,0x006e,0x004c,0x006a,0xffff,0xffff,0xffff,0xffff},
  {0x00af,0x00ae,0x008c,0x00aa,0xffff,0xffff,0xffff,0xffff},
  {0x00ef,0x00ee,0x00cc,0x00ea,0xffff,0xffff,0xffff,0xffff},
  {0x012f,0x012e,0x010c,0x012a,0xffff,0xffff,0xffff,0xffff},
  {0x016f,0x016e,0x014c,0x016a,0xffff,0xffff,0xffff,0xffff},
  {0x01af,0x01ae,0x018c,0x01aa,0xffff,0xffff,0xffff,0xffff},
  {0x01ef,0x01ee,0x01cc,0x01ea,0xffff,0xffff,0xffff,0xffff},
  {0x0037,0x0036,0x0014,0x0032,0xffff,0xffff,0xffff,0xffff},
  {0x0077,0x0076,0x0054,0x0072,0xffff,0xffff,0xffff,0xffff},
  {0x00b7,0x00b6,0x0094,0x00b2,0xffff,0xffff,0xffff,0xffff},
  {0x00f7,0x00f6,0x00d4,0x00f2,0xffff,0xffff,0xffff,0xffff},
  {0x0137,0x0136,0x0114,0x0132,0xffff,0xffff,0xffff,0xffff},
  {0x0177,0x0176,0x0154,0x0172,0xffff,0xffff,0xffff,0xffff},
  {0x01b7,0x01b6,0x0194,0x01b2,0xffff,0xffff,0xffff,0xffff},
  {0x01f7,0x01f6,0x01d4,0x01f2,0xffff,0xffff,0xffff,0xffff},
  {0x003f,0x003e,0x001c,0x003a,0xffff,0xffff,0xffff,0xffff},
  {0x007f,0x007e,0x005c,0x007a,0xffff,0xffff,0xffff,0xffff},
  {0x00bf,0x00be,0x009c,0x00ba,0xffff,0xffff,0xffff,0xffff},
  {0x00ff,0x00fe,0x00dc,0x00fa,0xffff,0xffff,0xffff,0xffff},
  {0x013f,0x013e,0x011c,0x013a,0xffff,0xffff,0xffff,0xffff},
  {0x017f,0x017e,0x015c,0x017a,0xffff,0xffff,0xffff,0xffff},
  {0x01bf,0x01be,0x019c,0x01ba,0xffff,0xffff,0xffff,0xffff},
  {0x01ff,0x01fe,0x01dc,0x01fa,0xffff,0xffff,0xffff,0xffff},
};
__device__ __forceinline__ void attn_phase(Frame& F, const bf16_t* PROJ, const float* CUMB, bf16_t* ATT, const float* subw, const float* lq1, const float* lk1, const float* lq2, const float* lk2) {
    const float s1 = wave_sum(lq1[F.lane] * lk1[F.lane]), s2 = wave_sum(lq2[F.lane] * lk2[F.lane]);
    const float lam = __expf(s1) - __expf(s2) + 0.2f;
    const int bx = (int)blockIdx.x & 255;
    for (int k = 0; k < 8; ++k) {
        const unsigned u = UNIT_TAB[bx][k]; if (u == 0xFFFFu) break;
        const int qb = u & 7, bh = (u >> 3) & 0xFFF;
        if (u & 0x8000u) att::diff_unit((att::ldsp)(F.lds + RING_OFF), PROJ, ATT, subw, lam, bh & 31, qb, F.wave, F.tid);
        else att::fox_unit((att::ldsp)(F.lds + RING_OFF), PROJ, CUMB, ATT, bh & 63, qb, F.wave, F.tid);
    }
}
#ifndef REP3
#define REP3 1
#endif
#define ATTN_PHASE_HOOK if (IN(3)) { PP; for (int rep_ = 0; rep_ < REP3; ++rep_) attn_phase(F, P.PROJ, P.CUMB, P.ATT, P.subw, P.lq1, P.lk1, P.lq2, P.lk2); }
#ifndef REP0
#define REP0 1
#endif
#ifndef REP1
#define REP1 1
#endif
#ifndef REP2
#define REP2 1
#endif
#ifndef REP3
#define REP3 1
#endif
#ifndef REP4
#define REP4 1
#endif
#ifndef REP5
#define REP5 1
#endif
#ifndef REP6
#define REP6 1
#endif
#ifndef REP7
#define REP7 1
#endif
#ifndef REP8
#define REP8 1
#endif
struct Sched {
    pg8::StaticOrder so; int mode, pm, pn; bool has;
    __device__ __forceinline__ bool next(int i, pg8::Unit& u) const { if (mode == 0) return so.next(i, u); if (i != 0 || !has) return false; u.pm = pm; u.pn = pn; return true; }
    __device__ __forceinline__ void a_ready(const pg8::Unit&) const {}
    __device__ __forceinline__ void done(const pg8::Unit&) const {}
};
__device__ __forceinline__ Sched sched_static(int M, int N, int G, int c) { Sched s; s.so.init(M, N, G, c); s.mode = 0; s.pm = 0; s.pn = 0; s.has = true; return s; }
__device__ __forceinline__ Sched sched_one(int pm, int pn, bool has) { Sched s; s.so.init(256, 256, 1, 0); s.mode = 1; s.pm = pm; s.pn = pn; s.has = has; return s; }

constexpr int NPHASE = 9;

__global__ void __launch_bounds__(NWAVES * 64, 2) mega_fwd(Args args) {
    extern __shared__ __attribute__((aligned(16))) unsigned char lds[];
    Frame F;
    F.lds = (LAS unsigned char*)lds; F.MISC = (volatile LAS unsigned*)(F.lds + MISC_OFF);
    F.tid = threadIdx.x; F.lane = F.tid & 63; F.wave = __builtin_amdgcn_readfirstlane(F.tid >> 6);
    F.G = gridDim.x; { const int bx = blockIdx.x; F.vcu = (F.G % 8 == 0) ? (bx % 8) * (F.G / 8) + bx / 8 : bx; }
    F.ctl = (gu32*)(args.ws + WS_CTL);
    for (int u = F.tid; u < (LDS_BYTES - LDSCTL_OFF) / 4; u += NWAVES * 64) ((LAS unsigned*)(F.lds + LDSCTL_OFF))[u] = 0u;
    __syncthreads();
    XcdBarrier bar = xcd_barrier_post((unsigned*)(F.ctl + CW_BAR) + args.ph_lo * XCD_BAR_WORDS, F.MISC + 8);
    const int lo = args.ph_lo, hi = args.ph_hi;
#define IN(k) (lo <= (k) && (k) < hi)
#define PP const Ptrs P = make_ptrs(args.in, args.out, args.ws)
#define SEAM(k) do { if (IN(k) && IN((k) + 1)) xcd_barrier(bar); } while (0)
    const int bx = (int)blockIdx.x;

    if (IN(0)) { PP; for (int rep_ = 0; rep_ < REP0; ++rep_) p0_prologue(F, P); } SEAM(0);

    if (IN(1)) {
        PP; for (int rep_ = 0; rep_ < REP1; ++rep_) {
        pg8::Gemm g{P.XB, P.WIN, DM, DM, DM}; const Sched S = sched_static(MTOK, NPROJ, F.G, bx);
        pg8::EpiStore<0> E{P.PROJ, NPROJ, nullptr};
        pg8::gemm_phase<pg8::EpiStore<0>, Sched, true, true>(F.lds + RING_OFF, g, S, E);
    }} SEAM(1);

    if (IN(2)) {
        PP; for (int rep_ = 0; rep_ < REP2; ++rep_) {
        if (bx < 32) {
            pg8::Gemm g{P.HM, P.WKV, DM, DM, DM}; const Sched S = sched_one(bx >> 2, bx & 3, true);
            pg8::EpiHeadNormK E{P.MKN, P.mkw, P.mqw};
            pg8::gemm_phase<pg8::EpiHeadNormK, Sched, false, true>(F.lds + RING_OFF, g, S, E);
        } else if (bx < 64) {
            pg8::Gemm g{P.WKV + (size_t)1024 * DM, P.HM, DM, DM, DM}; const Sched S = sched_one((bx - 32) >> 3, (bx - 32) & 7, true);
            pg8::EpiStore<0> E{P.VT, MMEM, nullptr};
            pg8::gemm_phase<pg8::EpiStore<0>, Sched, true, true>(F.lds + RING_OFF, g, S, E);
        } else {
            const int gw = (bx - 64) * NWAVES + F.wave, NGW = (F.G - 64) * NWAVES;
            if (gw < 64) p1b_cumsum(P, gw, F.lane);
            for (int m = gw; m < MTOK; m += NGW) p1b_row(P.PROJ, P.dqw, P.dkw, P.fqw, P.fkw, P.ROPE, m, F.lane);
        }
    }} SEAM(2);

    ATTN_PHASE_HOOK
    SEAM(3);

    if (IN(4)) {
        PP; for (int rep_ = 0; rep_ < REP4; ++rep_) {
        pg8::Gemm g{P.ATT, P.WOUT, DM, DM, DM}; const Sched S = sched_static(MTOK, DM, F.G, bx);
        pg8::EpiResid<0> E{P.x, P.XB, nullptr, P.SS};
        pg8::gemm_phase<pg8::EpiResid<0>, Sched, false, true>(F.lds + RING_OFF, g, S, E);
    }} SEAM(4);

    if (IN(5)) {
        PP; for (int rep_ = 0; rep_ < REP5; ++rep_) {
        const Sched S0 = sched_static(MTOK, DM, F.G, bx); pg8::Unit u{0, 0}; const bool has = S0.next(0, u);
        PG8_LAS float* RQ = (PG8_LAS float*)(F.lds + LDS_RQ); PG8_LAS float* IL = (PG8_LAS float*)(F.lds + LDS_IL);
        {   pg8::Gemm g{P.XB, P.WQ, DM, DM, DM}; const Sched S = sched_one(u.pm, u.pn, has);
            pg8::EpiMemQ E{P.MQ, P.SS, RQ};
            pg8::gemm_phase<pg8::EpiMemQ, Sched, false, true>(F.lds + RING_OFF, g, S, E); }
        VM_WAIT(); __syncthreads(); if (F.tid == 0) { __builtin_amdgcn_fence(__ATOMIC_ACQUIRE, "agent"); VM_WAIT(); } __syncthreads();
        const int head = u.pn, bh = (u.pm >> 3) * 4 + head;
        {   pg8::Gemm g{P.MQ + head * 256, P.MKN + (size_t)bh * 65536, DM, 256, 256}; const Sched S = sched_one(u.pm, 0, has);
            pg8::EpiMemS E{P.MQ, head, RQ, IL};
            pg8::gemm_phase<pg8::EpiMemS, Sched, false, true>(F.lds + RING_OFF, g, S, E); }
        VM_WAIT(); __syncthreads(); if (F.tid == 0) { __builtin_amdgcn_fence(__ATOMIC_ACQUIRE, "agent"); VM_WAIT(); } __syncthreads();
        {   pg8::Gemm g{P.MQ + head * 256, P.VT + (size_t)(head * 256) * MMEM + (u.pm >> 3) * 256, DM, MMEM, 256}; const Sched S = sched_one(u.pm, 0, has);
            pg8::EpiMemPV E{P.MO, head, IL};
            pg8::gemm_phase<pg8::EpiMemPV, Sched, true, true>(F.lds + RING_OFF, g, S, E); }
    }} SEAM(5);

    if (IN(6)) {
        PP; for (int rep_ = 0; rep_ < REP6; ++rep_) {
        pg8::Gemm g{P.MO, P.WO, DM, DM, DM}; const Sched S = sched_static(MTOK, DM, F.G, bx);
        pg8::EpiResid<1> E{nullptr, P.XB, nullptr, P.SS};
        pg8::gemm_phase<pg8::EpiResid<1>, Sched, false, true>(F.lds + RING_OFF, g, S, E);
    }} SEAM(6);

    if (IN(7)) {
        PP; for (int rep_ = 0; rep_ < REP7; ++rep_) {
        pg8::Gemm g{P.XB, P.WUP, DM, DM, DM}; const Sched S = sched_static(MTOK, DFF, F.G, bx);
        pg8::EpiStore<3> E{P.H, DFF, P.SS};
        pg8::gemm_phase<pg8::EpiStore<3>, Sched, true, true>(F.lds + RING_OFF, g, S, E);
    }} SEAM(7);

    if (IN(8)) {
        PP; for (int rep_ = 0; rep_ < REP8; ++rep_) {
        pg8::Gemm g{P.H, P.WDN, DFF, DFF, DFF}; const Sched S = sched_static(MTOK, DM, F.G, bx);
        pg8::EpiResid<2> E{nullptr, P.XB, P.out, nullptr};
        pg8::gemm_phase<pg8::EpiResid<2>, Sched, false, true>(F.lds + RING_OFF, g, S, E);
    }}
#undef IN
#undef SEAM
}
extern "C" void kernel_launch(void* const* d_in, const int* in_sizes, int n_in, void* d_out, int out_size, void* d_ws, size_t ws_size, hipStream_t stream) {
    static int grid = 0;
    if (grid == 0) {
        if (n_in != 26 || in_sizes[0] != MTOK * DM || out_size != MTOK * DM || ws_size < WS_END) { fprintf(stderr, "kernel_launch: unexpected shapes (n_in %d, in0 %d, out %d, ws %zu)\n", n_in, n_in > 0 ? in_sizes[0] : -1, out_size, ws_size); grid = -1; return; }
        int dev = 0, cus = 0, per_cu = 0;
        if (hipGetDevice(&dev) != hipSuccess || hipDeviceGetAttribute(&cus, hipDeviceAttributeMultiprocessorCount, dev) != hipSuccess) { grid = -1; return; }
        if (hipFuncSetAttribute((const void*)mega_fwd, hipFuncAttributeMaxDynamicSharedMemorySize, LDS_BYTES) != hipSuccess) { fprintf(stderr, "kernel_launch: hipFuncSetAttribute failed\n"); grid = -1; return; }
        if (hipOccupancyMaxActiveBlocksPerMultiprocessor(&per_cu, (const void*)mega_fwd, NWAVES * 64, LDS_BYTES) != hipSuccess || per_cu < 1) { fprintf(stderr, "kernel_launch: occupancy query says %d blocks per CU\n", per_cu); (void)hipGetLastError(); grid = -1; return; }
        grid = cus;
        if (grid != 256) fprintf(stderr, "kernel_launch: %d CUs; the one-unit-per-workgroup phases assume 256\n", grid);
    }
    if (grid < 0) return;
    (void)hipMemsetAsync((char*)d_ws + WS_CTL, 0, CTL_ZERO_BYTES, stream);
    Args a{};
    for (int i = 0; i < 26; ++i) a.in[i] = d_in[i];
    a.out = (float*)d_out; a.ws = (unsigned char*)d_ws;
#if MK_HYBRID
    const Ptrs P = make_ptrs(a.in, a.out, a.ws);
    a.ph_lo = 0; a.ph_hi = 3; hipLaunchKernelGGL(mega_fwd, dim3(grid), dim3(NWAVES * 64), LDS_BYTES, stream, a);
    float* OF = a.out;
    hipLaunchKernelGGL(k_attn, dim3(MTOK / 64, 8), dim3(64), 0, stream, P.PROJ, P.CUMB, 1, OF, 8);
    hipLaunchKernelGGL(k_fox_fin, dim3(MTOK * 512 / 256), dim3(256), 0, stream, OF, P.ATT);
    hipLaunchKernelGGL(k_attn, dim3(MTOK / 64, 16), dim3(64), 0, stream, P.PROJ, P.CUMB, 0, OF, 16);
    hipLaunchKernelGGL(k_diff_fin, dim3(MTOK), dim3(256), 0, stream, OF, P.lq1, P.lk1, P.lq2, P.lk2, P.subw, P.ATT);
    a.ph_lo = 4; a.ph_hi = 9; hipLaunchKernelGGL(mega_fwd, dim3(grid), dim3(NWAVES * 64), LDS_BYTES, stream, a);
#else
    a.ph_lo = 0; a.ph_hi = NPHASE; hipLaunchKernelGGL(mega_fwd, dim3(grid), dim3(NWAVES * 64), LDS_BYTES, stream, a);
#endif
}
```

```cpp
#include <hip/hip_runtime.h>
#include <cstdint>
#include <cstdio>

typedef unsigned short bf16_t;
__device__ __forceinline__ float bf2f(bf16_t v) { return __uint_as_float(((unsigned)v) << 16); }
__device__ __forceinline__ bf16_t f2bf(float f) { unsigned u = __float_as_uint(f); return (bf16_t)((u + 0x7fffu + ((u >> 16) & 1u)) >> 16); }

constexpr int NB = 8, SEQ = 2048, DM = 1024, MTOK = NB * SEQ, MEML = 256, MMEM = NB * MEML;
constexpr int NPROJ = 3072, INCOLS = 3080, DFF = 4096;
constexpr float EPS = 1e-6f;
constexpr float LOG2E = 1.4426950408889634f;
constexpr float C2 = 0.125f * LOG2E;
constexpr float CM = 0.0625f * LOG2E;
constexpr int C_DQ = 0, C_DK = 512, C_DV = 1024, C_FQ = 1536, C_FK = 2048, C_FV = 2560;

constexpr size_t MiB = 1u << 20;
constexpr size_t WS_CTL = 0, CTL_ZERO_BYTES = 1 * MiB;
constexpr size_t WS_FLOG = 1 * MiB;
constexpr size_t WS_CUMB = 2 * MiB;
constexpr size_t WS_ROPE = 3 * MiB;
constexpr size_t WS_QKW = 4 * MiB + 512 * 1024;
constexpr size_t WS_SS = 4 * MiB;
constexpr size_t WS_WIN = 8 * MiB, WS_WOUT = 14 * MiB, WS_WQ = 16 * MiB, WS_WKV = 18 * MiB, WS_WO = 22 * MiB, WS_WUP = 24 * MiB, WS_WDN = 32 * MiB;
constexpr size_t WS_XB = 40 * MiB;
constexpr size_t WS_HM = 72 * MiB;
constexpr size_t WS_MK = 76 * MiB;
constexpr size_t WS_VT = 80 * MiB;
constexpr size_t WS_MKN = 84 * MiB;
constexpr size_t WS_PROJ = 96 * MiB;
constexpr size_t WS_ATT = 192 * MiB;
constexpr size_t WS_MQ = 96 * MiB;
constexpr size_t WS_MO = 128 * MiB;
constexpr size_t WS_H = 96 * MiB;
constexpr size_t WS_END = 224 * MiB;
#define MK_HYBRID 0
namespace pg8 {
#define PG8_LAS __attribute__((address_space(3)))
typedef short bf16x8 __attribute__((ext_vector_type(8)));
typedef float f32x4 __attribute__((ext_vector_type(4)));
typedef unsigned u32x4 __attribute__((ext_vector_type(4)));
typedef unsigned u32x2 __attribute__((ext_vector_type(2)));
constexpr int BM = 256, BK = 64, HALF = 128, HTB = HALF * BK * 2  , STAGE_BYTES = 8 * HTB, NXCD = 8, WGM = 8;

__host__ __device__ __forceinline__ int lds_byte(int r, int c) { const int st = (r >> 4) * 2 + (c >> 5), rr = r & 15, cc = c & 31, ob = rr * 64 + cc * 2; return st * 1024 + (ob ^ (((ob >> 9) & 1) << 5)); }
__host__ __device__ __forceinline__ void stage_rc(int b, int& R, int& C) { const int st = b / 1024, sb = b % 1024, swz = sb ^ (((sb >> 9) & 1) << 5); R = (st >> 1) * 16 + swz / 64; C = (st & 1) * 32 + (swz % 64) / 2; }
__host__ __device__ __forceinline__ int perm32(int rho) { const int n = rho >> 4, i = rho & 15; return 8 * (i >> 2) + 4 * n + (i & 3); }

struct Unit { int pm, pn; };
struct Gemm { const bf16_t* A; const bf16_t* Bt; int lda, ldb, K; };

struct StaticOrder {
    int nM, nN, nwg, G, c;
    __host__ __device__ void init(int M, int N, int G_, int c_) { nM = M / BM; nN = N / BM; nwg = nM * nN; G = G_; c = c_; }
    __host__ __device__ bool next(int i, Unit& u) const {
        const long L = (long)i * G + c; if (L >= nwg) return false;
        int wgid = (int)L; { const int q = nwg / NXCD, r = nwg % NXCD, xcd = wgid % NXCD, off = wgid / NXCD; wgid = (xcd < r ? xcd * (q + 1) : r * (q + 1) + (xcd - r) * q) + off; }
        const int nig = WGM * nN, gid = wgid / nig, fm = gid * WGM, gsz = (nM - fm) < WGM ? (nM - fm) : WGM;
        u.pm = fm + ((wgid % nig) % gsz); u.pn = (wgid % nig) / gsz; return true;
    }
    __device__ __forceinline__ void a_ready(const Unit&) const {}
    __device__ __forceinline__ void done(const Unit&) const {}
};
struct OneUnit {
    int pm, pn; bool has;
    __device__ __forceinline__ bool next(int i, Unit& u) const { if (i != 0 || !has) return false; u.pm = pm; u.pn = pn; return true; }
    __device__ __forceinline__ void a_ready(const Unit&) const {}
    __device__ __forceinline__ void done(const Unit&) const {}
};

__device__ __forceinline__ unsigned cvt_pk_bf16(float lo, float hi) { unsigned r; asm volatile("v_cvt_pk_bf16_f32 %0, %1, %2" : "=v"(r) : "v"(lo), "v"(hi)); return r; }
#define PG8_LBAR() do { asm volatile("s_waitcnt lgkmcnt(0)" ::: "memory"); __builtin_amdgcn_s_barrier(); asm volatile("" ::: "memory"); } while (0)

template <int MODE> struct EpiStore {
    static constexpr bool PERM = true, AFTER_DRAIN = false;
    bf16_t* O; int ldc; const float* SS;
    __device__ __forceinline__ void operator()(const f32x4 (&acc)[2][2][4][2], const Unit& u, int wr, int wc, int fr, int fq) const {
        const int row0 = u.pm * BM + wr * 64 + fr, col0 = u.pn * BM + wc * 32 + 8 * fq;
#pragma unroll
        for (int ai = 0; ai < 2; ++ai)
#pragma unroll
            for (int m = 0; m < 4; ++m) { const int row = row0 + ai * HALF + m * 16; float rs = 1.f;
                if (MODE != 0) { const f32x4 s = *(const f32x4*)(SS + (size_t)row * 4); rs = rsqrtf(((s[0] + s[1]) + (s[2] + s[3])) * (1.f / DM) + EPS); }
                bf16_t* rowp = O + (size_t)row * ldc + col0;
#pragma unroll
                for (int bj = 0; bj < 2; ++bj) { f32x4 v0 = acc[ai][bj][m][0] * rs, v1 = acc[ai][bj][m][1] * rs;
                    if (MODE == 3) {
#pragma unroll
                        for (int e = 0; e < 4; ++e) { const float a = fmaxf(v0[e], 0.f), b = fmaxf(v1[e], 0.f); v0[e] = a * a; v1[e] = b * b; } }
                    u32x4 w; w.x = cvt_pk_bf16(v0[0], v0[1]); w.y = cvt_pk_bf16(v0[2], v0[3]); w.z = cvt_pk_bf16(v1[0], v1[1]); w.w = cvt_pk_bf16(v1[2], v1[3]);
                    *(u32x4*)(rowp + bj * HALF) = w; } }
    }
};
struct EpiProj {
    static constexpr bool PERM = true, AFTER_DRAIN = false;
    bf16_t* O; const float* QKW; const float* ROPE;
    __device__ __forceinline__ void operator()(const f32x4 (&acc)[2][2][4][2], const Unit& u, int wr, int wc, int fr, int fq) const {
        const int sec = u.pn >> 1, row0 = u.pm * BM + wr * 64 + fr, col0 = u.pn * BM + wc * 64 + 8 * fq;
        if (sec == 2 || sec == 5) {
#pragma unroll
            for (int ai = 0; ai < 2; ++ai)
#pragma unroll
                for (int m = 0; m < 4; ++m) { bf16_t* rowp = O + (size_t)(row0 + ai * HALF + m * 16) * NPROJ + col0;
#pragma unroll
                    for (int bj = 0; bj < 2; ++bj) { const f32x4 v0 = acc[ai][bj][m][0], v1 = acc[ai][bj][m][1];
                        u32x4 w; w.x = cvt_pk_bf16(v0[0], v0[1]); w.y = cvt_pk_bf16(v0[2], v0[3]); w.z = cvt_pk_bf16(v1[0], v1[1]); w.w = cvt_pk_bf16(v1[2], v1[3]);
                        *(u32x4*)(rowp + bj * 32) = w; } }
            return;
        }
        const float* w = QKW + 64 * (sec < 2 ? sec : sec - 1);
        const float sc = (sec == 0 || sec == 3) ? C2 : 1.f; const bool rope = sec < 2;
        f32x4 g[2][2];
#pragma unroll
        for (int bj = 0; bj < 2; ++bj)
#pragma unroll
            for (int n = 0; n < 2; ++n) g[bj][n] = *(const f32x4*)(w + 32 * bj + 8 * fq + 4 * n);
        const float sgn = fq == 0 ? -1.f : 1.f; const bool rl = fq < 2;
#pragma unroll
        for (int ai = 0; ai < 2; ++ai)
#pragma unroll
            for (int m = 0; m < 4; ++m) { const int row = row0 + ai * HALF + m * 16; float ss = 0.f;
#pragma unroll
                for (int bj = 0; bj < 2; ++bj)
#pragma unroll
                    for (int n = 0; n < 2; ++n) { const f32x4 a = acc[ai][bj][m][n]; ss += (a[0] * a[0] + a[1] * a[1]) + (a[2] * a[2] + a[3] * a[3]); }
                ss += __shfl_xor(ss, 16); ss += __shfl_xor(ss, 32);
                const float rstd = rsqrtf(ss * (1.f / 64.f) + EPS) * sc;
                f32x4 v[2][2];
#pragma unroll
                for (int bj = 0; bj < 2; ++bj)
#pragma unroll
                    for (int n = 0; n < 2; ++n) v[bj][n] = acc[ai][bj][m][n] * rstd * g[bj][n];
                if (rope) {
#pragma unroll
                    for (int n = 0; n < 2; ++n) { f32x4 pr;
#pragma unroll
                        for (int e = 0; e < 4; ++e) pr[e] = __shfl_xor(v[0][n][e], 16);
                        const f32x4 c = *(const f32x4*)(ROPE + (size_t)row * 16 + 4 * n), s = *(const f32x4*)(ROPE + (size_t)row * 16 + 8 + 4 * n);
                        const f32x4 r = v[0][n] * c + pr * s * sgn;
                        if (rl) v[0][n] = r; }
                }
                bf16_t* rowp = O + (size_t)row * NPROJ + col0;
#pragma unroll
                for (int bj = 0; bj < 2; ++bj) { u32x4 wv; wv.x = cvt_pk_bf16(v[bj][0][0], v[bj][0][1]); wv.y = cvt_pk_bf16(v[bj][0][2], v[bj][0][3]); wv.z = cvt_pk_bf16(v[bj][1][0], v[bj][1][1]); wv.w = cvt_pk_bf16(v[bj][1][2], v[bj][1][3]);
                    *(u32x4*)(rowp + bj * 32) = wv; } }
    }
};
template <int MODE> struct EpiResid {
    static constexpr bool PERM = true, AFTER_DRAIN = true;
    const float* xf; bf16_t* xb; float* outf; float* SS;
    __device__ __forceinline__ void fused(f32x4 (&acc)[2][2][4][2], const Unit& u, int wr, int wc, int fr, int fq, PG8_LAS unsigned char* lds, int wid, int lane) const {
        PG8_LAS float* P = (PG8_LAS float*)lds;
        const int col0 = u.pn * BM + wc * 32 + 8 * fq;
#pragma unroll
        for (int ai = 0; ai < 2; ++ai)
#pragma unroll
            for (int m = 0; m < 4; ++m) { const int r = ai * HALF + wr * 64 + m * 16 + fr; const size_t off = (size_t)(u.pm * BM + r) * DM + col0; float s = 0.f;
#pragma unroll
                for (int bj = 0; bj < 2; ++bj) { f32x4 b0, b1;
                    if (MODE == 0) { b0 = *(const f32x4*)(xf + off + bj * HALF); b1 = *(const f32x4*)(xf + off + bj * HALF + 4); }
                    else { const u32x4 w = *(const u32x4*)(xb + off + bj * HALF);
                        b0 = (f32x4){__uint_as_float(w.x << 16), __uint_as_float(w.x & 0xffff0000u), __uint_as_float(w.y << 16), __uint_as_float(w.y & 0xffff0000u)};
                        b1 = (f32x4){__uint_as_float(w.z << 16), __uint_as_float(w.z & 0xffff0000u), __uint_as_float(w.w << 16), __uint_as_float(w.w & 0xffff0000u)}; }
                    const f32x4 o0 = b0 + acc[ai][bj][m][0], o1 = b1 + acc[ai][bj][m][1];
                    if (MODE == 2) { *(f32x4*)(outf + off + bj * HALF) = o0; *(f32x4*)(outf + off + bj * HALF + 4) = o1; }
                    else { u32x4 w; w.x = cvt_pk_bf16(o0[0], o0[1]); w.y = cvt_pk_bf16(o0[2], o0[3]); w.z = cvt_pk_bf16(o1[0], o1[1]); w.w = cvt_pk_bf16(o1[2], o1[3]); *(u32x4*)(xb + off + bj * HALF) = w;
                        s += ((o0[0] * o0[0] + o0[1] * o0[1]) + (o0[2] * o0[2] + o0[3] * o0[3])) + ((o1[0] * o1[0] + o1[1] * o1[1]) + (o1[2] * o1[2] + o1[3] * o1[3])); } }
                if (MODE != 2) { s += __shfl_xor(s, 16); s += __shfl_xor(s, 32); if (fq == 0) P[r * 4 + wc] = s; }
                if (m & 1) asm volatile("" ::: "memory"); }
        if (MODE != 2) { PG8_LBAR();
            const int t = wid * 64 + lane; if (t < 256) { const f32x4 p = *(const PG8_LAS f32x4*)(P + t * 4); SS[(size_t)(u.pm * BM + t) * 4 + u.pn] = (p[0] + p[1]) + (p[2] + p[3]); } }
    }
};
struct EpiHeadNormK {
    static constexpr bool PERM = true, AFTER_DRAIN = true;
    bf16_t* MKn; const float* kw; const float* qw;
    __device__ __forceinline__ void fused(f32x4 (&acc)[2][2][4][2], const Unit& u, int wr, int wc, int fr, int fq, PG8_LAS unsigned char* lds, int wid, int lane) const {
        PG8_LAS float* P = (PG8_LAS float*)lds; PG8_LAS float* R = (PG8_LAS float*)(lds + 4096);
#pragma unroll
        for (int ai = 0; ai < 2; ++ai)
#pragma unroll
            for (int m = 0; m < 4; ++m) { float s = 0.f;
#pragma unroll
                for (int bj = 0; bj < 2; ++bj)
#pragma unroll
                    for (int n = 0; n < 2; ++n) { const f32x4 v = acc[ai][bj][m][n]; s += (v[0] * v[0] + v[1] * v[1]) + (v[2] * v[2] + v[3] * v[3]); }
                s += __shfl_xor(s, 16); s += __shfl_xor(s, 32); if (fq == 0) P[(ai * HALF + wr * 64 + m * 16 + fr) * 4 + wc] = s; }
        PG8_LBAR();
        { const int t = wid * 64 + lane; if (t < 256) { const f32x4 p = *(const PG8_LAS f32x4*)(P + t * 4); R[t] = rsqrtf(((p[0] + p[1]) + (p[2] + p[3])) * (1.f / 256.f) + EPS); } }
        PG8_LBAR();
        const int c0 = wc * 32 + 8 * fq; f32x4 g[2][2];
#pragma unroll
        for (int bj = 0; bj < 2; ++bj)
#pragma unroll
            for (int n = 0; n < 2; ++n) { const f32x4 a = *(const f32x4*)(kw + c0 + bj * HALF + 4 * n), b = *(const f32x4*)(qw + c0 + bj * HALF + 4 * n); g[bj][n] = a * b * CM; }
        bf16_t* basep = MKn + (size_t)(u.pm * 4 + u.pn) * 65536;
#pragma unroll
        for (int ai = 0; ai < 2; ++ai)
#pragma unroll
            for (int m = 0; m < 4; ++m) { const int r = ai * HALF + wr * 64 + m * 16 + fr; const float rk = R[r];
#pragma unroll
                for (int bj = 0; bj < 2; ++bj) { const f32x4 v0 = acc[ai][bj][m][0] * rk * g[bj][0], v1 = acc[ai][bj][m][1] * rk * g[bj][1];
                    u32x4 w; w.x = cvt_pk_bf16(v0[0], v0[1]); w.y = cvt_pk_bf16(v0[2], v0[3]); w.z = cvt_pk_bf16(v1[0], v1[1]); w.w = cvt_pk_bf16(v1[2], v1[3]);
                    *(u32x4*)(basep + (size_t)r * 256 + c0 + bj * HALF) = w; } }
    }
};
struct EpiMemQ {
    static constexpr bool PERM = true, AFTER_DRAIN = true;
    bf16_t* MQ; const float* SS; PG8_LAS float* RQ;
    __device__ __forceinline__ void fused(f32x4 (&acc)[2][2][4][2], const Unit& u, int wr, int wc, int fr, int fq, PG8_LAS unsigned char* lds, int wid, int lane) const {
        PG8_LAS float* P = (PG8_LAS float*)lds;
        const int col0 = u.pn * BM + wc * 32 + 8 * fq;
#pragma unroll
        for (int ai = 0; ai < 2; ++ai)
#pragma unroll
            for (int m = 0; m < 4; ++m) { const int r = ai * HALF + wr * 64 + m * 16 + fr; const int row = u.pm * BM + r;
                const f32x4 ss = *(const f32x4*)(SS + (size_t)row * 4); const float rs = rsqrtf(((ss[0] + ss[1]) + (ss[2] + ss[3])) * (1.f / DM) + EPS); float s = 0.f;
#pragma unroll
                for (int bj = 0; bj < 2; ++bj) { const f32x4 v0 = acc[ai][bj][m][0] * rs, v1 = acc[ai][bj][m][1] * rs;
                    s += (v0[0] * v0[0] + v0[1] * v0[1]) + (v0[2] * v0[2] + v0[3] * v0[3]) + (v1[0] * v1[0] + v1[1] * v1[1]) + (v1[2] * v1[2] + v1[3] * v1[3]);
                    u32x4 w; w.x = cvt_pk_bf16(v0[0], v0[1]); w.y = cvt_pk_bf16(v0[2], v0[3]); w.z = cvt_pk_bf16(v1[0], v1[1]); w.w = cvt_pk_bf16(v1[2], v1[3]);
                    *(u32x4*)(MQ + (size_t)row * DM + col0 + bj * HALF) = w; }
                s += __shfl_xor(s, 16); s += __shfl_xor(s, 32); if (fq == 0) P[r * 4 + wc] = s; }
        PG8_LBAR();
        { const int t = wid * 64 + lane; if (t < 256) { const f32x4 p = *(const PG8_LAS f32x4*)(P + t * 4); RQ[t] = rsqrtf(((p[0] + p[1]) + (p[2] + p[3])) * (1.f / 256.f) + EPS); } }
        PG8_LBAR();
    }
};
struct EpiMemS {
    static constexpr bool PERM = true, AFTER_DRAIN = true;
    bf16_t* Pt; int head; const PG8_LAS float* RQ; PG8_LAS float* IL;
    __device__ __forceinline__ void fused(f32x4 (&acc)[2][2][4][2], const Unit& u, int wr, int wc, int fr, int fq, PG8_LAS unsigned char* lds, int wid, int lane) const {
        PG8_LAS float* P = (PG8_LAS float*)lds;
        const int col0 = head * BM + wc * 32 + 8 * fq;
#pragma unroll
        for (int ai = 0; ai < 2; ++ai)
#pragma unroll
            for (int m = 0; m < 4; ++m) { const int r = ai * HALF + wr * 64 + m * 16 + fr; const int row = u.pm * BM + r; const float rq = RQ[r]; float s = 0.f;
#pragma unroll
                for (int bj = 0; bj < 2; ++bj) { f32x4 v0 = acc[ai][bj][m][0] * rq, v1 = acc[ai][bj][m][1] * rq;
#pragma unroll
                    for (int e = 0; e < 4; ++e) { v0[e] = __builtin_amdgcn_exp2f(v0[e]); v1[e] = __builtin_amdgcn_exp2f(v1[e]); }
                    s += (v0[0] + v0[1]) + (v0[2] + v0[3]) + (v1[0] + v1[1]) + (v1[2] + v1[3]);
                    u32x4 w; w.x = cvt_pk_bf16(v0[0], v0[1]); w.y = cvt_pk_bf16(v0[2], v0[3]); w.z = cvt_pk_bf16(v1[0], v1[1]); w.w = cvt_pk_bf16(v1[2], v1[3]);
                    *(u32x4*)(Pt + (size_t)row * DM + col0 + bj * HALF) = w; }
                s += __shfl_xor(s, 16); s += __shfl_xor(s, 32); if (fq == 0) P[r * 4 + wc] = s; }
        PG8_LBAR();
        { const int t = wid * 64 + lane; if (t < 256) { const f32x4 p = *(const PG8_LAS f32x4*)(P + t * 4); IL[t] = 1.0f / ((p[0] + p[1]) + (p[2] + p[3])); } }
        PG8_LBAR();
    }
};
struct EpiMemPV {
    static constexpr bool PERM = true, AFTER_DRAIN = false;
    bf16_t* MO; int head; const PG8_LAS float* IL;
    __device__ __forceinline__ void operator()(const f32x4 (&acc)[2][2][4][2], const Unit& u, int wr, int wc, int fr, int fq) const {
        const int col0 = head * BM + wc * 32 + 8 * fq;
#pragma unroll
        for (int ai = 0; ai < 2; ++ai)
#pragma unroll
            for (int m = 0; m < 4; ++m) { const int r = ai * HALF + wr * 64 + m * 16 + fr; const int row = u.pm * BM + r; const float il = IL[r];
#pragma unroll
                for (int bj = 0; bj < 2; ++bj) { const f32x4 v0 = acc[ai][bj][m][0] * il, v1 = acc[ai][bj][m][1] * il;
                    u32x4 w; w.x = cvt_pk_bf16(v0[0], v0[1]); w.y = cvt_pk_bf16(v0[2], v0[3]); w.z = cvt_pk_bf16(v1[0], v1[1]); w.w = cvt_pk_bf16(v1[2], v1[3]);
                    *(u32x4*)(MO + (size_t)row * DM + col0 + bj * HALF) = w; } }
    }
};

template <class Epi, class Sched, bool ALIGN_EPI = false, bool SP2 = false>
__device__ __forceinline__ void gemm_phase(PG8_LAS unsigned char* lds, const Gemm g, const Sched& S, const Epi& E) {
    const int tid = threadIdx.x, wid = __builtin_amdgcn_readfirstlane(tid >> 6), lane = tid & 63, wr = wid >> 2, wc = wid & 3, fr = lane & 15, fq = lane >> 4;
    const int K = g.K, nt = K / BK;
    unsigned voffA[2], voffB[2];
#pragma unroll
    for (int i = 0; i < 2; ++i) { int R, C; stage_rc(tid * 16 + i * 8192, R, C); const int Rb = Epi::PERM ? ((R & ~31) + perm32(R & 31)) : R;
        voffA[i] = (unsigned)(R * g.lda + C) * 2u; voffB[i] = (unsigned)(Rb * g.ldb + C) * 2u; }
    const size_t kstep = (size_t)(BK * 2);
    const size_t hsA = (size_t)HALF * g.lda * 2, hsB = (size_t)HALF * g.ldb * 2;
    const size_t tsA = 2 * hsA, tsB = 2 * hsB;
    const unsigned ldsw = (unsigned)wid * 1024u;
    const int aoff = lds_byte(wr * 64 + fr, fq * 8), boff = lds_byte(wc * 32 + fr, fq * 8);
#define PG8_SA(b, h) (((b) * 2 + (h)) * HTB)
#define PG8_SB(b, h) ((4 + (b) * 2 + (h)) * HTB)
#define PG8_STAGE(bufoff, gbase, voff) do { _Pragma("unroll") for (int _i = 0; _i < 2; ++_i) \
        __builtin_amdgcn_global_load_lds((const unsigned*)((const char*)(gbase) + (voff)[_i]), (PG8_LAS unsigned*)(lds + (bufoff) + ldsw + _i * 8192), 16, 0, 0); } while (0)
#define PG8_LDA(dst, b, h) do { _Pragma("unroll") for (int m = 0; m < 4; ++m) _Pragma("unroll") for (int k = 0; k < 2; ++k) dst[m][k] = *(const PG8_LAS bf16x8*)(lds + PG8_SA(b, h) + aoff + m * 2048 + k * 1024); } while (0)
#define PG8_LDB(dst, b, h) do { _Pragma("unroll") for (int n = 0; n < 2; ++n) _Pragma("unroll") for (int k = 0; k < 2; ++k) dst[n][k] = *(const PG8_LAS bf16x8*)(lds + PG8_SB(b, h) + boff + n * 2048 + k * 1024); } while (0)
#define PG8_MMA(ai, bj, At, Bt) do { __builtin_amdgcn_s_setprio(1); _Pragma("unroll") for (int m = 0; m < 4; ++m) _Pragma("unroll") for (int n = 0; n < 2; ++n) _Pragma("unroll") for (int k = 0; k < 2; ++k) \
        acc[ai][bj][m][n] = __builtin_amdgcn_mfma_f32_16x16x32_bf16(Bt[n][k], At[m][k], acc[ai][bj][m][n], 0, 0, 0); __builtin_amdgcn_s_setprio(0); } while (0)
#define PG8_WAIT_V(n) asm volatile("s_waitcnt vmcnt(" #n ")" ::: "memory")
#define PG8_WAIT_L(n) asm volatile("s_waitcnt lgkmcnt(" #n ")" ::: "memory")
#define PG8_BAR __builtin_amdgcn_s_barrier()
#define PG8_SCHED __builtin_amdgcn_sched_barrier(0)
    Unit cur, nxt; int ui = 0;
    if (!S.next(0, cur)) return;
    f32x4 acc[2][2][4][2];
#pragma unroll
    for (int a = 0; a < 2; ++a)
#pragma unroll
        for (int b = 0; b < 2; ++b)
#pragma unroll
            for (int m = 0; m < 4; ++m)
#pragma unroll
                for (int n = 0; n < 2; ++n) acc[a][b][m][n] = (f32x4){0.f, 0.f, 0.f, 0.f};
    bf16x8 At[4][2], B0[2][2], B1[2][2];
    const char* cA = (const char*)g.A + (size_t)cur.pm * tsA; const char* cB = (const char*)g.Bt + (size_t)cur.pn * tsB;
    S.a_ready(cur);
    if constexpr (SP2) {
        PG8_STAGE(PG8_SB(0, 0), cB, voffB); PG8_STAGE(PG8_SB(0, 1), cB + hsB, voffB); PG8_STAGE(PG8_SA(0, 0), cA, voffA); PG8_STAGE(PG8_SA(0, 1), cA + hsA, voffA);
        if (wr == 1) PG8_BAR;
        PG8_WAIT_V(2); PG8_BAR;
        PG8_STAGE(PG8_SB(1, 0), cB + kstep, voffB); PG8_STAGE(PG8_SA(1, 0), cA + kstep, voffA); PG8_STAGE(PG8_SB(1, 1), cB + hsB + kstep, voffB);
        PG8_WAIT_V(6); PG8_BAR;
    } else {
        PG8_STAGE(PG8_SB(0, 0), cB, voffB); PG8_STAGE(PG8_SA(0, 0), cA, voffA); PG8_STAGE(PG8_SB(0, 1), cB + hsB, voffB); PG8_STAGE(PG8_SA(0, 1), cA + hsA, voffA);
        if (wr == 1) PG8_BAR;
        PG8_WAIT_V(4); PG8_BAR;
        PG8_STAGE(PG8_SB(1, 0), cB + kstep, voffB); PG8_STAGE(PG8_SA(1, 0), cA + kstep, voffA); PG8_STAGE(PG8_SB(1, 1), cB + hsB + kstep, voffB);
        PG8_WAIT_V(6); PG8_BAR;
    }
    for (;;) {
        const bool has_next = S.next(ui + 1, nxt);
        const char* nA = has_next ? (const char*)g.A + (size_t)nxt.pm * tsA : cA; const char* nB = has_next ? (const char*)g.Bt + (size_t)nxt.pn * tsB : cB;
        for (int t = 0; t < nt; t += 2) {
            const bool last = (t == nt - 2);
            const char* a1 = cA + (size_t)(t + 1) * kstep;
            const char* a2 = last ? nA : cA + (size_t)(t + 2) * kstep; const char* b2 = last ? nB : cB + (size_t)(t + 2) * kstep;
            const char* a3 = a2 + kstep; const char* b3 = b2 + kstep;
            if (last && has_next) S.a_ready(nxt);
            if constexpr (SP2) {
            PG8_LDB(B0, 0, 0); PG8_LDB(B1, 0, 1); PG8_SCHED; PG8_LDA(At, 0, 0); PG8_STAGE(PG8_SA(1, 1), a1 + hsA, voffA);
            PG8_WAIT_V(8); PG8_WAIT_L(0); PG8_BAR; PG8_MMA(0, 0, At, B0); PG8_MMA(0, 1, At, B1); PG8_BAR; PG8_SCHED;
            PG8_LDA(At, 0, 1); PG8_STAGE(PG8_SB(0, 0), b2, voffB); PG8_STAGE(PG8_SB(0, 1), b2 + hsB, voffB); PG8_STAGE(PG8_SA(0, 0), a2, voffA);
            PG8_WAIT_V(8); PG8_WAIT_L(0); PG8_BAR; PG8_MMA(1, 0, At, B0); PG8_MMA(1, 1, At, B1); PG8_BAR; PG8_SCHED;
            PG8_LDB(B0, 1, 0); PG8_LDB(B1, 1, 1); PG8_SCHED; PG8_LDA(At, 1, 0); PG8_STAGE(PG8_SA(0, 1), a2 + hsA, voffA);
            PG8_WAIT_V(8); PG8_WAIT_L(0); PG8_BAR; PG8_MMA(0, 0, At, B0); PG8_MMA(0, 1, At, B1); PG8_BAR; PG8_SCHED;
            PG8_LDA(At, 1, 1); PG8_STAGE(PG8_SB(1, 0), b3, voffB); PG8_STAGE(PG8_SB(1, 1), b3 + hsB, voffB); PG8_STAGE(PG8_SA(1, 0), a3, voffA);
            PG8_WAIT_V(8); PG8_WAIT_L(0); PG8_BAR; PG8_MMA(1, 0, At, B0); PG8_MMA(1, 1, At, B1); PG8_BAR; PG8_SCHED;
            } else {
            PG8_LDB(B0, 0, 0); PG8_SCHED; PG8_LDA(At, 0, 0); PG8_STAGE(PG8_SA(1, 1), a1 + hsA, voffA);
            PG8_WAIT_L(8); PG8_BAR; PG8_WAIT_L(0); PG8_MMA(0, 0, At, B0); PG8_BAR; PG8_SCHED;
            PG8_LDB(B1, 0, 1); PG8_STAGE(PG8_SB(0, 0), b2, voffB);
            PG8_BAR; PG8_WAIT_L(0); PG8_MMA(0, 1, At, B1); PG8_BAR;
            PG8_LDA(At, 0, 1); PG8_STAGE(PG8_SA(0, 0), a2, voffA);
            PG8_BAR; PG8_WAIT_L(0); PG8_MMA(1, 0, At, B0); PG8_BAR; PG8_SCHED;
            PG8_STAGE(PG8_SB(0, 1), b2 + hsB, voffB);
            PG8_WAIT_V(6); PG8_BAR; PG8_MMA(1, 1, At, B1); PG8_BAR;
            PG8_LDB(B0, 1, 0); PG8_SCHED; PG8_LDA(At, 1, 0); PG8_STAGE(PG8_SA(0, 1), a2 + hsA, voffA);
            PG8_WAIT_L(8); PG8_BAR; PG8_WAIT_L(0); PG8_MMA(0, 0, At, B0); PG8_BAR; PG8_SCHED;
            PG8_LDB(B1, 1, 1); PG8_STAGE(PG8_SB(1, 0), b3, voffB);
            PG8_BAR; PG8_WAIT_L(0); PG8_MMA(0, 1, At, B1); PG8_BAR;
            PG8_LDA(At, 1, 1); PG8_STAGE(PG8_SA(1, 0), a3, voffA);
            PG8_BAR; PG8_WAIT_L(0); PG8_MMA(1, 0, At, B0); PG8_BAR; PG8_SCHED;
            PG8_STAGE(PG8_SB(1, 1), b3 + hsB, voffB);
            PG8_WAIT_V(6); PG8_BAR; PG8_MMA(1, 1, At, B1); PG8_BAR;
            }
        }
        if constexpr (ALIGN_EPI) { if (wr == 0) PG8_BAR; }
        if constexpr (!Epi::AFTER_DRAIN) { int fr2 = fr, fq2 = fq; asm volatile("" : "+v"(fr2), "+v"(fq2)); E(acc, cur, wr, wc, fr2, fq2); S.done(cur); }
        if (!has_next) break;
#pragma unroll
        for (int a = 0; a < 2; ++a)
#pragma unroll
            for (int b = 0; b < 2; ++b)
#pragma unroll
                for (int m = 0; m < 4; ++m)
#pragma unroll
                    for (int n = 0; n < 2; ++n) acc[a][b][m][n] = (f32x4){0.f, 0.f, 0.f, 0.f};
        cur = nxt; cA = nA; cB = nB; ++ui;
        if constexpr (ALIGN_EPI) { if (wr == 1) PG8_BAR; }
    }
    PG8_WAIT_V(0);
    if constexpr (!ALIGN_EPI) { if (wr == 0) PG8_BAR; }
    PG8_BAR;
    if constexpr (Epi::AFTER_DRAIN) { int fr2 = fr, fq2 = fq, lane2 = lane; asm volatile("" : "+v"(fr2), "+v"(fq2), "+v"(lane2)); E.fused(acc, cur, wr, wc, fr2, fq2, lds, wid, lane2); S.done(cur); }
#undef PG8_SA
#undef PG8_SB
#undef PG8_STAGE
#undef PG8_LDA
#undef PG8_LDB
#undef PG8_MMA
#undef PG8_WAIT_V
#undef PG8_WAIT_L
#undef PG8_BAR
#undef PG8_SCHED
}}

#define GAS __attribute__((address_space(1)))
#define LAS __attribute__((address_space(3)))
typedef unsigned v4u __attribute__((ext_vector_type(4)));
typedef float f32x4 __attribute__((ext_vector_type(4)));
typedef short bf16x8 __attribute__((ext_vector_type(8)));
typedef GAS unsigned gu32;
typedef GAS unsigned long long gu64;
#define RLX_AGENT __ATOMIC_RELAXED, __HIP_MEMORY_SCOPE_AGENT
#define LDS_WAIT() asm volatile("s_waitcnt lgkmcnt(0)" ::: "memory")
#define VM_WAIT() asm volatile("s_waitcnt vmcnt(0)" ::: "memory")
__device__ __forceinline__ unsigned long long rt() { return __builtin_amdgcn_s_memrealtime(); }
__device__ __forceinline__ unsigned pk2(float lo, float hi) { return (unsigned)f2bf(lo) | ((unsigned)f2bf(hi) << 16); }

#define XB_TMO      128
#define XB_XCNT(j)  (256  + 64 * (j))
#define XB_XSUB(j)  (1280 + 64 * (j))
#define XB_XGEN(j)  (2304 + 64 * (j))
#define XB_TOP      3328
#define XB_TOPGEN   3392
#define XCD_BAR_WORDS 3456
#define XB_SPIN_CAP (1u << 18)

__device__ __forceinline__ unsigned xb_ld(unsigned* p)              { return __hip_atomic_load(p, __ATOMIC_RELAXED, __HIP_MEMORY_SCOPE_AGENT); }
__device__ __forceinline__ unsigned xb_add(unsigned* p, unsigned v) { return __hip_atomic_fetch_add(p, v, __ATOMIC_RELAXED, __HIP_MEMORY_SCOPE_AGENT); }
__device__ __forceinline__ unsigned xb_xcc_id() { return (unsigned)__builtin_amdgcn_s_getreg((3 << 11) | 20) & 0xFu; }
#define XB_SPIN(cond, bar) do { unsigned _sp = 0; while (cond) { __builtin_amdgcn_s_sleep(1); \
    if ((++_sp & 255u) == 0u) { if (xb_ld(&(bar)[XB_TMO])) break; if (_sp > XB_SPIN_CAP) { atomicAdd(&(bar)[XB_TMO], 1u); break; } } } } while (0)

struct XcdBarrier {
    unsigned* bar; unsigned x;
    volatile LAS unsigned* st;
};

__device__ __forceinline__ XcdBarrier xcd_barrier_post(unsigned* bar, volatile LAS unsigned* st) {
    XcdBarrier b; b.bar = bar; b.x = xb_xcc_id(); b.st = st;
    if (threadIdx.x == 0) (void)xb_add(&bar[XB_XCNT(b.x)], 1u);
    return b;
}
__device__ __forceinline__ void xcd_barrier_complete(unsigned* bar, unsigned x, unsigned& nloc, unsigned& nx) {
    const unsigned G = gridDim.x * gridDim.y * gridDim.z;
    unsigned sum, cnt, mine, sp = 0u;
    for (;;) {
        sum = 0u; cnt = 0u; mine = 0u;
#pragma unroll
        for (unsigned j = 0; j < 16; ++j) { const unsigned c = xb_ld(&bar[XB_XCNT(j)]); sum += c; cnt += (c > 0u) ? 1u : 0u; mine = (j == x) ? c : mine; }
        if (sum == G) break;
        __builtin_amdgcn_s_sleep(1);
        if ((++sp & 255u) == 0u) { if (xb_ld(&bar[XB_TMO])) break; if (sp > XB_SPIN_CAP) { atomicAdd(&bar[XB_TMO], 1u); break; } }
    }
    nloc = mine > 0u ? mine : 1u; nx = cnt > 0u ? cnt : 1u;
}

__device__ __forceinline__ void xcd_barrier(const XcdBarrier& b) {
    asm volatile("s_waitcnt vmcnt(0)" ::: "memory");
    __syncthreads();
    if (threadIdx.x == 0) {
        unsigned* bar = b.bar;
        __builtin_amdgcn_s_waitcnt(0);
        unsigned nloc = b.st[0], nx = b.st[1];
        if (nloc == 0u) { xcd_barrier_complete(bar, b.x, nloc, nx); b.st[0] = nloc; b.st[1] = nx; }
        const unsigned old = xb_add(&bar[XB_XSUB(b.x)], 1u);
        const unsigned gen = old / nloc;
        if (old + 1u == (gen + 1u) * nloc) {
            __builtin_amdgcn_fence(__ATOMIC_RELEASE, "agent");
            asm volatile("s_waitcnt vmcnt(0)" ::: "memory");
            const unsigned og = xb_add(&bar[XB_TOP], 1u);
            const unsigned tg = og / nx;
            if (og + 1u == (tg + 1u) * nx) xb_add(&bar[XB_TOPGEN], 1u);
            else XB_SPIN(xb_ld(&bar[XB_TOPGEN]) == tg, bar);
            __builtin_amdgcn_fence(__ATOMIC_ACQUIRE, "agent");
            xb_add(&bar[XB_XGEN(b.x)], 1u);
            asm volatile("s_waitcnt vmcnt(0)" ::: "memory");
        } else {
            XB_SPIN(xb_ld(&bar[XB_XGEN(b.x)]) == gen, bar);
            __builtin_amdgcn_fence(__ATOMIC_ACQUIRE, "agent");
            asm volatile("s_waitcnt vmcnt(0)" ::: "memory");
        }
    }
    __syncthreads();
}
constexpr int NWAVES = 8;
constexpr int RING_OFF = 0, RING_BYTES = 131072;
constexpr int LDSCTL_OFF = RING_BYTES, MISC_OFF = LDSCTL_OFF + 320;
constexpr int LDS_RQ = RING_BYTES + 1024, LDS_IL = RING_BYTES + 2048;
constexpr int LDS_BYTES = 147456;
constexpr int CW_TMO = 0, CW_BAR = 4096;

struct Frame {
    LAS unsigned char* lds; volatile LAS unsigned* MISC; gu32* ctl;
    int tid, lane, wave, vcu, G;
};
struct Args { const void* in[26]; float* out; unsigned char* ws; int ph_lo, ph_hi; };

__device__ __forceinline__ float wave_sum(float v) {
#pragma unroll
    for (int o = 1; o < 64; o <<= 1) v += __shfl_xor(v, o);
    return v;
}
template <bool HEADPERM> __device__ __forceinline__ void p0_transpose_item(const float* W, int ldw, int K, int N, const float* g, bf16_t* WT, LAS float* scr, int item, int lane) {
    const int nblk = N / 32, kb = item / nblk, nb = item % nblk, k0 = 64 * kb, n0 = 32 * nb;
#pragma unroll 8
    for (int i = 0; i < 32; ++i) { const int kk = 2 * i + (lane >> 5); const float gg = g ? g[k0 + kk] : 1.f; scr[kk * 33 + (lane & 31)] = W[(size_t)(k0 + kk) * ldw + n0 + (lane & 31)] * gg; }
    LDS_WAIT(); asm volatile("" ::: "memory");
    const int c = lane & 7;
#pragma unroll
    for (int j = 0; j < 4; ++j) { const int n = (lane >> 3) + 8 * j; const LAS float* s = scr + (8 * c) * 33 + n;
        v4u o; o.x = pk2(s[0 * 33], s[1 * 33]); o.y = pk2(s[2 * 33], s[3 * 33]); o.z = pk2(s[4 * 33], s[5 * 33]); o.w = pk2(s[6 * 33], s[7 * 33]);
        int nr = n0 + n; if (HEADPERM) { const int l = nr & 255; nr = (nr & ~255) | (((l >> 5) & 1) * 128 + (l >> 6) * 32 + (l & 31)); }
        *(GAS v4u*)(WT + (size_t)nr * K + k0 + 8 * c) = o; }
    LDS_WAIT(); asm volatile("" ::: "memory");
}
template <bool FLOG> __device__ __forceinline__ void rms_rows_to_bf16(int lane, const float* X, bf16_t* O, int m0, int step, int rows, const float* g, const float* win, float* flog) {
    if (m0 >= rows) return;
    f32x4 wf[4][4][2];
    if (FLOG) {
#pragma unroll
        for (int j = 0; j < 4; ++j) { const f32x4 gg = *(const GAS f32x4*)(g + 256 * j + 4 * lane);
#pragma unroll
            for (int e = 0; e < 4; ++e) { const int k = 256 * j + 4 * lane + e; wf[j][e][0] = *(const GAS f32x4*)(win + (size_t)k * INCOLS + NPROJ) * gg[e]; wf[j][e][1] = *(const GAS f32x4*)(win + (size_t)k * INCOLS + NPROJ + 4) * gg[e]; } }
    }
    f32x4 nx[4];
    { const GAS f32x4* xr = (const GAS f32x4*)(X + (size_t)m0 * DM) + lane;
#pragma unroll
      for (int j = 0; j < 4; ++j) nx[j] = xr[64 * j]; }
    for (int m = m0; m < rows; m += step) {
        f32x4 v[4];
#pragma unroll
        for (int j = 0; j < 4; ++j) v[j] = nx[j];
        if (m + step < rows) { const GAS f32x4* xr = (const GAS f32x4*)(X + (size_t)(m + step) * DM) + lane;
#pragma unroll
            for (int j = 0; j < 4; ++j) nx[j] = xr[64 * j]; }
        float s2 = 0.f;
#pragma unroll
        for (int j = 0; j < 4; ++j) s2 += (v[j].x * v[j].x + v[j].y * v[j].y) + (v[j].z * v[j].z + v[j].w * v[j].w);
        const float rstd = rsqrtf(wave_sum(s2) * (1.f / DM) + EPS);
        GAS unsigned long long* o8 = (GAS unsigned long long*)(O + (size_t)m * DM) + lane;
#pragma unroll
        for (int j = 0; j < 4; ++j) { v[j] = v[j] * rstd; o8[64 * j] = (unsigned long long)pk2(v[j].x, v[j].y) | ((unsigned long long)pk2(v[j].z, v[j].w) << 32); }
        if (FLOG) {
            f32x4 a0 = {0.f, 0.f, 0.f, 0.f}, a1 = {0.f, 0.f, 0.f, 0.f};
#pragma unroll
            for (int j = 0; j < 4; ++j)
#pragma unroll
                for (int e = 0; e < 4; ++e) { a0 += wf[j][e][0] * v[j][e]; a1 += wf[j][e][1] * v[j][e]; }
#pragma unroll
            for (int e = 0; e < 4; ++e) { a0[e] = wave_sum(a0[e]); a1[e] = wave_sum(a1[e]); }
            if (lane == 0) { *(GAS f32x4*)(flog + (size_t)m * 8) = a0; *(GAS f32x4*)(flog + (size_t)m * 8 + 4) = a1; }
        }
    }
}
__constant__ float INV_FREQ[8] = {1.0f, 0.1939227432012558f, 0.03760603070259094f, 0.007292664609849453f, 0.0014142135623842478f, 0.00027424818836152554f, 5.318296098266728e-05f, 1.0313386155758053e-05f};

struct Ptrs {
    const float *x, *mem; const int* pos; const float *norm_mix_w, *w_in, *b_forget, *dqw, *dkw, *lq1, *lk1, *lq2, *lk2, *subw, *fqw, *fkw, *w_out, *nmq, *nmkv, *w_mq, *w_mkv, *mqw, *mkw, *w_mo, *nmlp, *w_up, *w_dn;
    float* out; float *FLOG, *CUMB, *ROPE, *SS, *QKW;
    bf16_t *WIN, *WOUT, *WQ, *WKV, *WO, *WUP, *WDN, *XB, *HM, *MK, *VT, *MKN, *PROJ, *ATT, *MQ, *MO, *H;
};
__host__ __device__ __forceinline__ Ptrs make_ptrs(const void* const* in, float* out, unsigned char* ws) {
    Ptrs p;
    p.x = (const float*)in[0]; p.mem = (const float*)in[1]; p.pos = (const int*)in[2]; p.norm_mix_w = (const float*)in[3]; p.w_in = (const float*)in[4]; p.b_forget = (const float*)in[5];
    p.dqw = (const float*)in[6]; p.dkw = (const float*)in[7]; p.lq1 = (const float*)in[8]; p.lk1 = (const float*)in[9]; p.lq2 = (const float*)in[10]; p.lk2 = (const float*)in[11];
    p.subw = (const float*)in[12]; p.fqw = (const float*)in[13]; p.fkw = (const float*)in[14]; p.w_out = (const float*)in[15]; p.nmq = (const float*)in[16]; p.nmkv = (const float*)in[17];
    p.w_mq = (const float*)in[18]; p.w_mkv = (const float*)in[19]; p.mqw = (const float*)in[20]; p.mkw = (const float*)in[21]; p.w_mo = (const float*)in[22]; p.nmlp = (const float*)in[23];
    p.w_up = (const float*)in[24]; p.w_dn = (const float*)in[25]; p.out = out;
    p.FLOG = (float*)(ws + WS_FLOG); p.CUMB = (float*)(ws + WS_CUMB); p.ROPE = (float*)(ws + WS_ROPE); p.SS = (float*)(ws + WS_SS); p.QKW = (float*)(ws + WS_QKW);
    p.WIN = (bf16_t*)(ws + WS_WIN); p.WOUT = (bf16_t*)(ws + WS_WOUT); p.WQ = (bf16_t*)(ws + WS_WQ); p.WKV = (bf16_t*)(ws + WS_WKV); p.WO = (bf16_t*)(ws + WS_WO); p.WUP = (bf16_t*)(ws + WS_WUP); p.WDN = (bf16_t*)(ws + WS_WDN);
    p.XB = (bf16_t*)(ws + WS_XB); p.HM = (bf16_t*)(ws + WS_HM); p.MK = (bf16_t*)(ws + WS_MK); p.VT = (bf16_t*)(ws + WS_VT); p.MKN = (bf16_t*)(ws + WS_MKN);
    p.PROJ = (bf16_t*)(ws + WS_PROJ); p.ATT = (bf16_t*)(ws + WS_ATT); p.MQ = (bf16_t*)(ws + WS_MQ); p.MO = (bf16_t*)(ws + WS_MO); p.H = (bf16_t*)(ws + WS_H);
    return p;
}

__device__ __forceinline__ void p0_prologue(Frame& F, const Ptrs& P) {
    LAS float* scr = (LAS float*)(F.lds + RING_OFF + F.wave * 16384);
    const int gw = F.vcu * NWAVES + F.wave, NGW = F.G * NWAVES;
    constexpr int I_IN = 16 * 96, I_SQ = 16 * 32, I_KV = 16 * 64, I_UP = 16 * 128, I_DN = 64 * 32;
    constexpr int NITEMS = I_IN + 3 * I_SQ + I_KV + I_UP + I_DN;
    for (int it = gw; it < NITEMS; it += NGW) {
        int r = it;
        if (r < I_IN) { p0_transpose_item<true>(P.w_in, INCOLS, DM, NPROJ, P.norm_mix_w, P.WIN, scr, r, F.lane); continue; } r -= I_IN;
        if (r < I_SQ) { p0_transpose_item<false>(P.w_out, DM, DM, DM, nullptr, P.WOUT, scr, r, F.lane); continue; } r -= I_SQ;
        if (r < I_SQ) { p0_transpose_item<false>(P.w_mq, DM, DM, DM, P.nmq, P.WQ, scr, r, F.lane); continue; } r -= I_SQ;
        if (r < I_KV) { p0_transpose_item<false>(P.w_mkv, 2048, DM, 2048, P.nmkv, P.WKV, scr, r, F.lane); continue; } r -= I_KV;
        if (r < I_SQ) { p0_transpose_item<false>(P.w_mo, DM, DM, DM, nullptr, P.WO, scr, r, F.lane); continue; } r -= I_SQ;
        if (r < I_UP) { p0_transpose_item<false>(P.w_up, DFF, DM, DFF, P.nmlp, P.WUP, scr, r, F.lane); continue; } r -= I_UP;
        p0_transpose_item<false>(P.w_dn, DM, DFF, DM, nullptr, P.WDN, scr, r, F.lane);
    }
    rms_rows_to_bf16<true>(F.lane, P.x, P.XB, gw, NGW, MTOK, P.norm_mix_w, P.w_in, P.FLOG);
    rms_rows_to_bf16<false>(F.lane, P.mem, P.HM, gw, NGW, MMEM, nullptr, nullptr, nullptr);
    if (blockIdx.x == 0 && F.tid < 64) { const int t = F.tid; P.QKW[t] = P.dqw[t]; P.QKW[64 + t] = P.dkw[t]; P.QKW[128 + t] = P.fqw[t]; P.QKW[192 + t] = P.fkw[t]; }
    for (int id = (F.vcu * NWAVES * 64) + F.tid; id < MTOK * 8; id += F.G * NWAVES * 64) {
        const int row = id >> 3, i = id & 7;
        const float ang = (float)P.pos[row] * INV_FREQ[i];
        const double a = (double)ang; const double k = rint(a * 0.15915494309189535); const float r = (float)fma(-k, 6.283185307179586, a);
        P.ROPE[(size_t)row * 16 + i] = cosf(r); P.ROPE[(size_t)row * 16 + 8 + i] = sinf(r);
    }
}
__device__ __forceinline__ void p1b_row(bf16_t* PROJ, const float* dqw, const float* dkw, const float* fqw, const float* fkw, const float* ROPE, int row, int lane) {
    const int sg = lane >> 1, hf = lane & 1;
    const int col = (sg < 16 ? sg * 64 : 1536 + (sg - 16) * 64) + hf * 32;
    const float* w = (sg < 8 ? dqw : sg < 16 ? dkw : sg < 24 ? fqw : fkw) + hf * 32;
    const bool rope = (sg < 16) && (hf == 0), isq = (sg < 8) || (sg >= 16 && sg < 24);
    GAS v4u* p = (GAS v4u*)(PROJ + (size_t)row * NPROJ + col);
    const v4u u0 = p[0], u1 = p[1], u2 = p[2], u3 = p[3];
#define UNP_LO(u) (f32x4){__uint_as_float(u.x << 16), __uint_as_float(u.x & 0xffff0000u), __uint_as_float(u.y << 16), __uint_as_float(u.y & 0xffff0000u)}
#define UNP_HI(u) (f32x4){__uint_as_float(u.z << 16), __uint_as_float(u.z & 0xffff0000u), __uint_as_float(u.w << 16), __uint_as_float(u.w & 0xffff0000u)}
    f32x4 v0 = UNP_LO(u0), v1 = UNP_HI(u0), v2 = UNP_LO(u1), v3 = UNP_HI(u1), v4 = UNP_LO(u2), v5 = UNP_HI(u2), v6 = UNP_LO(u3), v7 = UNP_HI(u3);
#undef UNP_LO
#undef UNP_HI
#define SQ4(v) ((v.x * v.x + v.y * v.y) + (v.z * v.z + v.w * v.w))
    float ss = (SQ4(v0) + SQ4(v1)) + (SQ4(v2) + SQ4(v3)) + (SQ4(v4) + SQ4(v5)) + (SQ4(v6) + SQ4(v7));
#undef SQ4
    ss += __shfl_xor(ss, 1);
    const float rstd = rsqrtf(ss * (1.f / 64.f) + EPS);
    const GAS f32x4* wg = (const GAS f32x4*)w;
    v0 = v0 * rstd * wg[0]; v1 = v1 * rstd * wg[1]; v2 = v2 * rstd * wg[2]; v3 = v3 * rstd * wg[3]; v4 = v4 * rstd * wg[4]; v5 = v5 * rstd * wg[5]; v6 = v6 * rstd * wg[6]; v7 = v7 * rstd * wg[7];
    if (rope) {
        const GAS f32x4* rt = (const GAS f32x4*)(ROPE + (size_t)row * 16);
        const f32x4 c0 = rt[0], c1 = rt[1], s0 = rt[2], s1 = rt[3];
        const f32x4 a0 = v0 * c0 - v2 * s0, b0 = v2 * c0 + v0 * s0, a1 = v1 * c1 - v3 * s1, b1 = v3 * c1 + v1 * s1;
        v0 = a0; v2 = b0; v1 = a1; v3 = b1;
    }
    const float sc = isq ? C2 : 1.f;
#define PK4(a, b) (v4u){pk2(a.x * sc, a.y * sc), pk2(a.z * sc, a.w * sc), pk2(b.x * sc, b.y * sc), pk2(b.z * sc, b.w * sc)}
    p[0] = PK4(v0, v1); p[1] = PK4(v2, v3); p[2] = PK4(v4, v5); p[3] = PK4(v6, v7);
#undef PK4
}
__device__ __forceinline__ void p1b_cumsum(const Ptrs& P, int seq, int lane) {
    const int b = seq >> 3, h = seq & 7; const float bf = P.b_forget[h];
    float lf[32]; float run = 0.f;
#pragma unroll
    for (int i = 0; i < 32; ++i) { const float z = P.FLOG[(size_t)(b * SEQ + lane * 32 + i) * 8 + h] + bf;
        const float e = __expf(-fabsf(z)); lf[i] = fminf(z, 0.f) - log1pf(e); run += lf[i]; }
    float inc = run;
#pragma unroll
    for (int o = 1; o < 64; o <<= 1) { const float t = __shfl_up(inc, o); if (lane >= o) inc += t; }
    float c = inc - run;
#pragma unroll
    for (int i = 0; i < 32; ++i) { c += lf[i]; P.CUMB[(size_t)seq * SEQ + lane * 32 + i] = -c * LOG2E; }
}
struct Sched {
    pg8::StaticOrder so; int mode, pm, pn; bool has;
    __device__ __forceinline__ bool next(int i, pg8::Unit& u) const { if (mode == 0) return so.next(i, u); if (i != 0 || !has) return false; u.pm = pm; u.pn = pn; return true; }
    __device__ __forceinline__ void a_ready(const pg8::Unit&) const {}
    __device__ __forceinline__ void done(const pg8::Unit&) const {}
};
__device__ __forceinline__ Sched sched_static(int M, int N, int G, int c) { Sched s; s.so.init(M, N, G, c); s.mode = 0; s.pm = 0; s.pn = 0; s.has = true; return s; }
__device__ __forceinline__ Sched sched_one(int pm, int pn, bool has) { Sched s; s.so.init(256, 256, 1, 0); s.mode = 1; s.pm = pm; s.pn = pn; s.has = has; return s; }

#include <hip/hip_bf16.h>
#include <cmath>
namespace ab {
using bf16=__hip_bfloat16;
using bf16x8=__attribute__((ext_vector_type(8)))short;
using s16x4=__attribute__((ext_vector_type(4)))short;
using f32x16=__attribute__((ext_vector_type(16)))float;
using u32x4=__attribute__((ext_vector_type(4)))unsigned;
using f32x4v=__attribute__((ext_vector_type(4)))float;
constexpr int D=64,PIN=NPROJ;
constexpr int NW=8,QBLK=32,QB=QBLK*NW,KVBLK=64;
__device__ __forceinline__ int crow(int r,int hi){return (r&3)+8*(r>>2)+4*hi;}
#define SBAR() __builtin_amdgcn_sched_barrier(0)
__device__ __forceinline__ void cmask(f32x16&p0,f32x16&p1,int jb,int qrel,int hi){
  const float NEG=-INFINITY; int kb=64*jb+4*hi;
  #pragma unroll
  for(int r=0;r<16;++r){int kv=kb+(r&3)+8*(r>>2); if(kv>qrel)p0[r]=NEG; if(kv+32>qrel)p1[r]=NEG;}
}

__device__ __forceinline__ void kmask(f32x16&p0,f32x16&p1,int jb,int wid){
  if(jb>(wid>>1)){const float NEG=-INFINITY;
  #pragma unroll
  for(int r=0;r<16;++r){p0[r]=NEG;p1[r]=NEG;}}
}

constexpr int NSLOT=3, SLOTB=8192;
constexpr int LDS_K=0, LDS_V=NSLOT*SLOTB, LDS_WS=2*NSLOT*SLOTB, LDS_OST=LDS_WS+NW*64*4, LDS_BIAS=LDS_OST+NW*4096, LDS_BYTES=LDS_BIAS+8192;
__device__ __forceinline__ void glds16(const void*gsrc,unsigned lds_dst){unsigned keep;
  asm volatile("s_mov_b32 %0, m0\n\ts_mov_b32 m0, %2\n\ts_nop 0\n\tglobal_load_lds_dwordx4 %1, off\n\ts_mov_b32 m0, %0":"=&s"(keep):"v"(gsrc),"s"(lds_dst):"memory");}
__device__ __forceinline__ float max3f(float a,float b,float c){float r;asm("v_max3_f32 %0, %1, %2, %3":"=v"(r):"v"(a),"v"(b),"v"(c));return r;}
__device__ __forceinline__ float max2f(float a,float b){float r;asm("v_max_f32_e32 %0, %1, %2":"=v"(r):"v"(a),"v"(b));return r;}
__device__ __forceinline__ float fadd_s(float a,float b){float r;asm("v_add_f32_e32 %0, %1, %2":"=v"(r):"v"(a),"v"(b));return r;}
__device__ __forceinline__ float fsub_s(float a,float b){float r;asm("v_sub_f32_e32 %0, %1, %2":"=v"(r):"v"(a),"v"(b));return r;}
typedef float f32x2_t __attribute__((ext_vector_type(2))); typedef __bf16 bf16x2_t __attribute__((ext_vector_type(2)));
__device__ __forceinline__ unsigned cvtpk_s(float lo,float hi){f32x2_t v={lo,hi};bf16x2_t b=__builtin_convertvector(v,bf16x2_t);return __builtin_bit_cast(unsigned,b);}
#define WAIT_BAR(N) asm volatile("s_waitcnt vmcnt(" #N ") lgkmcnt(0)\n\ts_barrier":::"memory")

__device__ __forceinline__ void qkt(f32x16&p0,f32x16&p1,const char*Kslot,const bf16x8*qr,const f32x16&negm,int r32,int hi){
  const char*kb=Kslot+hi*1024+r32*16;
  #pragma unroll
  for(int d0=0;d0<4;++d0){
    const bf16x8 b0=*reinterpret_cast<const bf16x8*>(kb+d0*2048);
    const bf16x8 b1=*reinterpret_cast<const bf16x8*>(kb+d0*2048+512);
    if(d0==0){p0=__builtin_amdgcn_mfma_f32_32x32x16_bf16(b0,qr[0],negm,0,0,0);p1=__builtin_amdgcn_mfma_f32_32x32x16_bf16(b1,qr[0],negm,0,0,0);}
    else{p0=__builtin_amdgcn_mfma_f32_32x32x16_bf16(b0,qr[d0],p0,0,0,0);p1=__builtin_amdgcn_mfma_f32_32x32x16_bf16(b1,qr[d0],p1,0,0,0);}}
}
typedef __attribute__((address_space(3))) const char* lds_cptr;
typedef short v4i16_t __attribute__((ext_vector_type(4)));
__device__ __forceinline__ void kload8(bf16x8*kf,lds_cptr kp){
  kf[0]=*(const __attribute__((address_space(3))) bf16x8*)(kp);      kf[1]=*(const __attribute__((address_space(3))) bf16x8*)(kp+512);
  kf[2]=*(const __attribute__((address_space(3))) bf16x8*)(kp+2048); kf[3]=*(const __attribute__((address_space(3))) bf16x8*)(kp+2560);
  kf[4]=*(const __attribute__((address_space(3))) bf16x8*)(kp+4096); kf[5]=*(const __attribute__((address_space(3))) bf16x8*)(kp+4608);
  kf[6]=*(const __attribute__((address_space(3))) bf16x8*)(kp+6144); kf[7]=*(const __attribute__((address_space(3))) bf16x8*)(kp+6656);
}
__device__ __forceinline__ void kload2(bf16x8*kf,lds_cptr kp,int j){ kf[2*j]=*(const __attribute__((address_space(3))) bf16x8*)(kp+j*2048); kf[2*j+1]=*(const __attribute__((address_space(3))) bf16x8*)(kp+j*2048+512); }
__device__ __forceinline__ s16x4 vtr(lds_cptr p){ return __builtin_bit_cast(s16x4,__builtin_amdgcn_ds_read_tr16_b64_v4i16((__attribute__((address_space(3))) v4i16_t*)p)); }
__device__ __forceinline__ float rowmax(const f32x16&p0,const f32x16&p1){
  float a=max3f(p0[0],p0[1],p1[0]),b=max3f(p0[2],p0[3],p1[1]);a=max3f(a,p1[2],p1[3]);
  #pragma unroll
  for(int r=4;r<16;r+=4){a=max3f(a,p0[r],p0[r+1]);b=max3f(b,p0[r+2],p0[r+3]);a=max3f(a,p1[r],p1[r+1]);b=max3f(b,p1[r+2],p1[r+3]);}
  const float m=max2f(a,b);
  auto rr=__builtin_amdgcn_permlane32_swap(__float_as_uint(m),__float_as_uint(m),false,false);
  return max2f(__uint_as_float(rr[0]),__uint_as_float(rr[1]));
}
__device__ __forceinline__ void pv(f32x16*o,int vb,bf16x8 pa0,bf16x8 pa1,bf16x8 pa2,bf16x8 pa3){
  #pragma unroll
  for(int d0=0;d0<2;++d0){s16x4 lo[4],hi[4];
    #pragma unroll
    for(int ks=0;ks<4;++ks){
      asm volatile("ds_read_b64_tr_b16 %0,%1 offset:%c2":"=&v"(lo[ks]):"v"(vb),"i"(d0*4096+ks*1024):"memory");
      asm volatile("ds_read_b64_tr_b16 %0,%1 offset:%c2":"=&v"(hi[ks]):"v"(vb),"i"(d0*4096+ks*1024+512):"memory");}
    asm volatile("s_waitcnt lgkmcnt(0)":::"memory");SBAR();
    #define PK(k) (bf16x8){lo[k][0],lo[k][1],lo[k][2],lo[k][3],hi[k][0],hi[k][1],hi[k][2],hi[k][3]}
    o[d0]=__builtin_amdgcn_mfma_f32_32x32x16_bf16(pa0,PK(0),o[d0],0,0,0);
    o[d0]=__builtin_amdgcn_mfma_f32_32x32x16_bf16(pa1,PK(1),o[d0],0,0,0);
    o[d0]=__builtin_amdgcn_mfma_f32_32x32x16_bf16(pa2,PK(2),o[d0],0,0,0);
    o[d0]=__builtin_amdgcn_mfma_f32_32x32x16_bf16(pa3,PK(3),o[d0],0,0,0);
    #undef PK
  }
}

#ifndef ATTN_STORE16
#define ATTN_STORE16(p,v) (*(u32x4*)(p)=(v))
#endif
template<int THRL,int MASK,bool BIAS> __device__ __forceinline__ void attn_unit(int qb,const bf16*Qh,const bf16*__restrict__ Kh,const bf16*__restrict__ Vh,bf16*Oh,int opitch,const float*__restrict__ biasg,char*shm){
  int tid_=threadIdx.x; asm volatile("":"+v"(tid_));
  const int tid=tid_,lane=tid&63,r32=lane&31,hi=lane>>5; const int wid=__builtin_amdgcn_readfirstlane(tid>>6);
  const int q0=qb*QB;
  const bf16*Qw=Qh+(long)(q0+wid*QBLK)*PIN;
  const unsigned lds0=(unsigned)(uintptr_t)shm;
  float*wsf=(float*)(shm+LDS_WS)+wid*64;
  const bf16*ksrc=Kh+(long)lane*PIN+wid*8;
  const bf16*vsrc=Vh+(long)(16*(wid&3)+(lane>>2))*PIN+(wid>>2)*32+(lane&3)*8;
  const unsigned kdst=lds0+LDS_K+wid*1024, vdst=lds0+LDS_V+wid*1024;
  #define DMA_K(t,slot) glds16(ksrc+(long)(t)*KVBLK*PIN,(unsigned)__builtin_amdgcn_readfirstlane(kdst+(slot)))
  #define DMA_V(t,slot) glds16(vsrc+(long)(t)*KVBLK*PIN,(unsigned)__builtin_amdgcn_readfirstlane(vdst+(slot)))
  const int vb0=(int)(lds0+LDS_V)+((lane>>4)&1)*32+(lane&3)*8+(4*hi+((lane&15)>>2))*64;
  const char*Kbase=shm+LDS_K; bf16x8 kf[8];
  const lds_cptr shm3=(lds_cptr)shm; const lds_cptr kp0=shm3+LDS_K+hi*1024+r32*16; const lds_cptr vp0=shm3+LDS_V+((lane>>4)&1)*32+(lane&3)*8+(4*hi+((lane&15)>>2))*64;
  const int NT=(q0+QB)/KVBLK;
  DMA_K(0,0);DMA_V(0,0);DMA_K(1,SLOTB);
  const float*biasl=(const float*)(shm+LDS_BIAS);
  if(BIAS){ int t2=tid; asm volatile("":"+v"(t2)); if(t2<NT*16){ const f32x4v bv=*reinterpret_cast<const f32x4v*>(biasg+t2*4); *reinterpret_cast<f32x4v*>(shm+LDS_BIAS+t2*16)=bv; } }
  bf16x8 qr[4];
  #pragma unroll
  for(int d0=0;d0<4;++d0)qr[d0]=*reinterpret_cast<const bf16x8*>(&Qw[(long)r32*PIN+d0*16+hi*8]);
  float mhat=0.f,l_reg=0.f;f32x16 o[2];o[0]=f32x16{};o[1]=f32x16{};f32x16 negm=f32x16{}; if(!BIAS){asm volatile("":"+v"(negm));}
  #define CIN (BIAS?f32x16{}:negm)
  const int qrel=wid*QBLK+r32;
  #define CMASK(P0,P1,t) do{int jb_=(t)-(NT-4); if(jb_>=0){ if(MASK==0)cmask(P0,P1,jb_,qrel,hi); else kmask(P0,P1,jb_,wid); } }while(0)
  #define BIASADD(P0,P1,t) do{ if(BIAS){ const float*bp_=biasl+64*(t)+4*hi; \
    _Pragma("unroll") for(int g_=0;g_<4;++g_){ const f32x4v a_=*reinterpret_cast<const f32x4v*>(bp_+8*g_)-mhat, b_=*reinterpret_cast<const f32x4v*>(bp_+32+8*g_)-mhat; \
      _Pragma("unroll") for(int e_=0;e_<4;++e_){ P0[4*g_+e_]+=a_[e_]; P1[4*g_+e_]+=b_[e_]; } if(g_&1){SBAR();} } } }while(0)
  bool resc=false;
  #define START(P0,P1) do{ const float rm=rowmax(P0,P1); resc=false; \
    { const float dl=rm; mhat=fadd_s(mhat,dl); \
      _Pragma("unroll") for(int r=0;r<16;++r){P0[r]=fsub_s(P0[r],dl);P1[r]=fsub_s(P1[r],dl);} \
      if(!BIAS){ _Pragma("unroll") for(int r=0;r<16;++r)negm[r]=-mhat; asm volatile("":"+v"(negm)); } } \
    _Pragma("unroll") for(int r=0;r<16;++r)P0[r]=__builtin_amdgcn_exp2f(P0[r]); }while(0)
  #define RESC() do{ if(resc){ asm volatile("s_waitcnt lgkmcnt(0)":::"memory"); \
      _Pragma("unroll") for(int d_=0;d_<2;++d_) _Pragma("unroll") for(int r=0;r<16;++r)o[d_][r]*=wsf[crow(r,hi)]; } }while(0)
  f32x16 pA0,pA1,pB0,pB1;
  int sl_prev=0,sl_cur=0,sl_next=SLOTB;
  #define ROT() do{sl_prev=sl_cur;sl_cur=sl_next;sl_next=(sl_next==(NSLOT-1)*SLOTB)?0:sl_next+SLOTB;}while(0)
  DMA_K(2,2*SLOTB);
  WAIT_BAR(3);
  qkt(pA0,pA1,Kbase,qr,CIN,r32,hi);asm volatile("s_nop 15\n\ts_nop 7":"+v"(pA0),"+v"(pA1));BIASADD(pA0,pA1,0);CMASK(pA0,pA1,0);
  START(pA0,pA1);
  _Pragma("unroll") for(int r=0;r<16;++r)pA1[r]=__builtin_amdgcn_exp2f(pA1[r]);
  WAIT_BAR(0);
  DMA_K(3,0);DMA_V(1,SLOTB);
  ROT();
  kload8(kf,kp0+sl_cur);
  WAIT_BAR(2);
  s16x4 vlo[8],vhi[8]; u32x4 pw0,pw1,pw2,pw3;
  #define PKW(P,B) cvtpk_s(P[B],P[B+1])
  #define PAF(k) __builtin_bit_cast(bf16x8,pw##k)
  #define VFR(i) (bf16x8){vlo[i][0],vlo[i][1],vlo[i][2],vlo[i][3],vhi[i][0],vhi[i][1],vhi[i][2],vhi[i][3]}
  #define PIN(x) asm volatile("":"+v"(x))
  #define MX3(a,b,c) __builtin_fmaxf(__builtin_fmaxf((a),(b)),(c))
  #define GAPA(MF,A0,A1,A2,A3,W0,W1,PW) do{ MF; sacc+=A0; sacc+=A1; sacc+=A2; sacc+=A3; PIN(sacc); W0; W1; PIN(PW); SBAR(); }while(0)
  #define EX(v) __builtin_amdgcn_exp2f(v)
  #define GAPB(MF,X,B) do{ MF; X[B]=EX(X[B]); X[B+1]=EX(X[B+1]); X[B+2]=EX(X[B+2]); X[B+3]=EX(X[B+3]); PIN(X); SBAR(); }while(0)
  #define VRD(i) do{ vlo[i]=vtr(vp_+(((i)>>2)*4096+((i)&3)*1024)); vhi[i]=vtr(vp_+(((i)>>2)*4096+((i)&3)*1024+512)); }while(0)
  #define KRD(G,j) do{ if(G){ kload2(kf,kp0+sl_next,j); SBAR(); } }while(0)
  #define STEP(C0,C1,P0,P1,t,GK,GV,GL) do{ SBAR(); \
    const lds_cptr vp_=vp0+sl_prev; \
    VRD(0); SBAR(); float sacc=(P0[0]+P0[1]); \
    GAPA(C0=__builtin_amdgcn_mfma_f32_32x32x16_bf16(kf[0],qr[0],CIN,0,0,0), P0[2],P0[3],P0[4],P0[5],     pw0[0]=PKW(P0,0), pw0[1]=PKW(P0,2), pw0); \
    VRD(4); SBAR(); GAPA(C1=__builtin_amdgcn_mfma_f32_32x32x16_bf16(kf[1],qr[0],CIN,0,0,0), P0[6],P0[7],P0[8],P0[9],     pw0[2]=PKW(P0,4), pw0[3]=PKW(P0,6), pw0); \
    VRD(1); SBAR(); GAPA(C0=__builtin_amdgcn_mfma_f32_32x32x16_bf16(kf[2],qr[1],C0,0,0,0),   P0[10],P0[11],P0[12],P0[13], pw1[0]=PKW(P0,8), pw1[1]=PKW(P0,10), pw1); \
    VRD(5); SBAR(); GAPA(C1=__builtin_amdgcn_mfma_f32_32x32x16_bf16(kf[3],qr[1],C1,0,0,0),   P0[14],P0[15],P1[0],P1[1],   pw1[2]=PKW(P0,12),pw1[3]=PKW(P0,14), pw1); \
    VRD(2); SBAR(); GAPA(C0=__builtin_amdgcn_mfma_f32_32x32x16_bf16(kf[4],qr[2],C0,0,0,0),   P1[2],P1[3],P1[4],P1[5],     pw2[0]=PKW(P1,0), pw2[1]=PKW(P1,2), pw2); \
    VRD(6); SBAR(); GAPA(C1=__builtin_amdgcn_mfma_f32_32x32x16_bf16(kf[5],qr[2],C1,0,0,0),   P1[6],P1[7],P1[8],P1[9],     pw2[2]=PKW(P1,4), pw2[3]=PKW(P1,6), pw2); \
    VRD(3); SBAR(); GAPA(C0=__builtin_amdgcn_mfma_f32_32x32x16_bf16(kf[6],qr[3],C0,0,0,0),   P1[10],P1[11],P1[12],P1[13], pw3[0]=PKW(P1,8), pw3[1]=PKW(P1,10), pw3); \
    VRD(7); SBAR(); GAPA(C1=__builtin_amdgcn_mfma_f32_32x32x16_bf16(kf[7],qr[3],C1,0,0,0),   P1[14],P1[15],0.f,0.f,       pw3[2]=PKW(P1,12),pw3[3]=PKW(P1,14), pw3); \
    l_reg+=sacc; \
    if(GK){DMA_K((t)+3,sl_cur);} if(GV){DMA_V((t)+1,sl_next);} \
    BIASADD(C0,C1,t); CMASK(C0,C1,t); \
    { float a=MX3(C0[0],C0[1],C1[0]),b=MX3(C0[2],C0[3],C1[1]); a=MX3(a,C1[2],C1[3]); \
      _Pragma("unroll") for(int r=4;r<16;r+=4){a=MX3(a,C0[r],C0[r+1]);b=MX3(b,C0[r+2],C0[r+3]);a=MX3(a,C1[r],C1[r+1]);b=MX3(b,C1[r+2],C1[r+3]);} \
      float rm=__builtin_fmaxf(a,b); { auto rr=__builtin_amdgcn_permlane32_swap(__float_as_uint(rm),__float_as_uint(rm),false,false); rm=__builtin_fmaxf(__uint_as_float(rr[0]),__uint_as_float(rr[1])); } \
      resc=false; \
      if(__builtin_expect(__any(rm>(float)THRL),0)){ const float dl=__builtin_fmaxf(rm,0.f); mhat+=dl; \
        _Pragma("unroll") for(int r=0;r<16;++r){C0[r]-=dl;C1[r]-=dl;} \
        if(!BIAS){ _Pragma("unroll") for(int r=0;r<16;++r)negm[r]=-mhat; asm volatile("":"+v"(negm)); } \
        const float f=__builtin_amdgcn_exp2f(-dl); l_reg*=f; if(hi==0)wsf[r32]=f; resc=true; } } \
    SBAR(); \
    GAPB(o[0]=__builtin_amdgcn_mfma_f32_32x32x16_bf16(PAF(0),VFR(0),o[0],0,0,0), C0,0); \
    GAPB(o[1]=__builtin_amdgcn_mfma_f32_32x32x16_bf16(PAF(0),VFR(4),o[1],0,0,0), C0,4); \
    KRD(GL,0); GAPB(o[0]=__builtin_amdgcn_mfma_f32_32x32x16_bf16(PAF(1),VFR(1),o[0],0,0,0), C0,8); \
    KRD(GL,1); GAPB(o[1]=__builtin_amdgcn_mfma_f32_32x32x16_bf16(PAF(1),VFR(5),o[1],0,0,0), C0,12); \
    KRD(GL,2); GAPB(o[0]=__builtin_amdgcn_mfma_f32_32x32x16_bf16(PAF(2),VFR(2),o[0],0,0,0), C1,0); \
    KRD(GL,3); GAPB(o[1]=__builtin_amdgcn_mfma_f32_32x32x16_bf16(PAF(2),VFR(6),o[1],0,0,0), C1,4); \
    GAPB(o[0]=__builtin_amdgcn_mfma_f32_32x32x16_bf16(PAF(3),VFR(3),o[0],0,0,0), C1,8); \
    GAPB(o[1]=__builtin_amdgcn_mfma_f32_32x32x16_bf16(PAF(3),VFR(7),o[1],0,0,0), C1,12); \
    }while(0)
  int t=1;
  #undef CMASK
  #define CMASK(P0,P1,t) do{}while(0)
  for(;t+5<NT;t+=2){
    STEP(pB0,pB1,pA0,pA1,t,true,true,true);     WAIT_BAR(2); RESC(); ROT();
    STEP(pA0,pA1,pB0,pB1,t+1,true,true,true);   WAIT_BAR(2); RESC(); ROT();
  }
  #undef CMASK
  #define CMASK(P0,P1,t) do{int jb_=(t)-(NT-4); if(jb_>=0){ if(MASK==0)cmask(P0,P1,jb_,qrel,hi); else kmask(P0,P1,jb_,wid); } }while(0)
  #define ENDW(tt) do{ if((tt)+3<NT){WAIT_BAR(2);} else if((tt)+2<NT){WAIT_BAR(1);} else {WAIT_BAR(0);} }while(0)
  for(;t+1<NT;t+=2){
    STEP(pB0,pB1,pA0,pA1,t,(t+3<NT),(t+1<NT),(t+1<NT));       ENDW(t);   RESC(); ROT();
    STEP(pA0,pA1,pB0,pB1,t+1,(t+4<NT),(t+2<NT),(t+2<NT));     ENDW(t+1); RESC(); ROT();
  }
  STEP(pB0,pB1,pA0,pA1,NT-1,false,false,false); RESC();
  { float sacc=pB0[0]+pB0[1]; _Pragma("unroll") for(int r=2;r<16;++r)sacc+=pB0[r]; _Pragma("unroll") for(int r=0;r<16;++r)sacc+=pB1[r]; l_reg+=sacc;
    pw0=(u32x4){PKW(pB0,0),PKW(pB0,2),PKW(pB0,4),PKW(pB0,6)};pw1=(u32x4){PKW(pB0,8),PKW(pB0,10),PKW(pB0,12),PKW(pB0,14)};pw2=(u32x4){PKW(pB1,0),PKW(pB1,2),PKW(pB1,4),PKW(pB1,6)};pw3=(u32x4){PKW(pB1,8),PKW(pB1,10),PKW(pB1,12),PKW(pB1,14)};
    SBAR(); pv(o,vb0+sl_cur,PAF(0),PAF(1),PAF(2),PAF(3)); }
  #undef PKW
  #undef PAF
  #undef VFR
  #undef PIN
  #undef MX3
  #undef GAPA
  #undef GAPB
  #undef EX
  #undef VRD
  #undef KRD
  #undef STEP
  #undef ENDW
  {auto rr=__builtin_amdgcn_permlane32_swap(__float_as_uint(l_reg),__float_as_uint(l_reg),false,false);l_reg=__uint_as_float(rr[0])+__uint_as_float(rr[1]);}
  if(hi==0)wsf[32+r32]=l_reg;asm volatile("s_waitcnt lgkmcnt(0)":::"memory");
  float rli[16];
  #pragma unroll
  for(int r=0;r<16;++r)rli[r]=__builtin_amdgcn_rcpf(wsf[32+crow(r,hi)]);
  bf16*Ow=Oh+(long)(q0+wid*QBLK)*opitch;
  { bf16*stg=(bf16*)(shm+LDS_OST)+wid*2048;
    #pragma unroll
    for(int r=0;r<16;++r){const int orow=crow(r,hi);
      #pragma unroll
      for(int d0=0;d0<2;++d0)stg[orow*64+d0*32+r32]=__float2bfloat16(o[d0][r]*rli[r]);}
    asm volatile("s_waitcnt lgkmcnt(0)":::"memory");
    #pragma unroll
    for(int i=0;i<4;++i){const int row=i*8+(lane>>3),ch=lane&7; const u32x4 v=*(const u32x4*)(stg+row*64+ch*8); ATTN_STORE16(Ow+(long)row*opitch+ch*8,v);} }
  asm volatile("s_waitcnt lgkmcnt(0)\n\ts_barrier":::"memory");
  #undef DMA_K
  #undef DMA_V
  #undef CMASK
  #undef CIN
  #undef BIASADD
  #undef START
  #undef RESC
  #undef ROT
}
constexpr int ATTN_LDS_BYTES=LDS_BYTES;
#undef SBAR
#undef WAIT_BAR
}
__constant__ unsigned short UNIT_TAB[256][8] = {
  {0x8007,0x8002,0x0003,0x0001,0xffff,0xffff,0xffff,0xffff},
  {0x8027,0x8022,0x0043,0x0041,0xffff,0xffff,0xffff,0xffff},
  {0x8047,0x8042,0x0083,0x0081,0xffff,0xffff,0xffff,0xffff},
  {0x8067,0x8062,0x00c3,0x00c1,0xffff,0xffff,0xffff,0xffff},
  {0x8087,0x8082,0x0103,0x0101,0xffff,0xffff,0xffff,0xffff},
  {0x80a7,0x80a2,0x0143,0x0141,0xffff,0xffff,0xffff,0xffff},
  {0x80c7,0x80c2,0x0183,0x0181,0xffff,0xffff,0xffff,0xffff},
  {0x80e7,0x80e2,0x01c3,0x01c1,0xffff,0xffff,0xffff,0xffff},
  {0x8107,0x8102,0x000b,0x0009,0xffff,0xffff,0xffff,0xffff},
  {0x8127,0x8122,0x004b,0x0049,0xffff,0xffff,0xffff,0xffff},
  {0x8147,0x8142,0x008b,0x0089,0xffff,0xffff,0xffff,0xffff},
  {0x8167,0x8162,0x00cb,0x00c9,0xffff,0xffff,0xffff,0xffff},
  {0x8187,0x8182,0x010b,0x0109,0xffff,0xffff,0xffff,0xffff},
  {0x81a7,0x81a2,0x014b,0x0149,0xffff,0xffff,0xffff,0xffff},
  {0x81c7,0x81c2,0x018b,0x0189,0xffff,0xffff,0xffff,0xffff},
  {0x81e7,0x81e2,0x01cb,0x01c9,0xffff,0xffff,0xffff,0xffff},
  {0x800f,0x800a,0x0013,0x0011,0xffff,0xffff,0xffff,0xffff},
  {0x802f,0x802a,0x0053,0x0051,0xffff,0xffff,0xffff,0xffff},
  {0x804f,0x804a,0x0093,0x0091,0xffff,0xffff,0xffff,0xffff},
  {0x806f,0x806a,0x00d3,0x00d1,0xffff,0xffff,0xffff,0xffff},
  {0x808f,0x808a,0x0113,0x0111,0xffff,0xffff,0xffff,0xffff},
  {0x80af,0x80aa,0x0153,0x0151,0xffff,0xffff,0xffff,0xffff},
  {0x80cf,0x80ca,0x0193,0x0191,0xffff,0xffff,0xffff,0xffff},
  {0x80ef,0x80ea,0x01d3,0x01d1,0xffff,0xffff,0xffff,0xffff},
  {0x810f,0x810a,0x001b,0x0019,0xffff,0xffff,0xffff,0xffff},
  {0x812f,0x812a,0x005b,0x0059,0xffff,0xffff,0xffff,0xffff},
  {0x814f,0x814a,0x009b,0x0099,0xffff,0xffff,0xffff,0xffff},
  {0x816f,0x816a,0x00db,0x00d9,0xffff,0xffff,0xffff,0xffff},
  {0x818f,0x818a,0x011b,0x0119,0xffff,0xffff,0xffff,0xffff},
  {0x81af,0x81aa,0x015b,0x0159,0xffff,0xffff,0xffff,0xffff},
  {0x81cf,0x81ca,0x019b,0x0199,0xffff,0xffff,0xffff,0xffff},
  {0x81ef,0x81ea,0x01db,0x01d9,0xffff,0xffff,0xffff,0xffff},
  {0x8017,0x8012,0x0023,0x0021,0xffff,0xffff,0xffff,0xffff},
  {0x8037,0x8032,0x0063,0x0061,0xffff,0xffff,0xffff,0xffff},
  {0x8057,0x8052,0x00a3,0x00a1,0xffff,0xffff,0xffff,0xffff},
  {0x8077,0x8072,0x00e3,0x00e1,0xffff,0xffff,0xffff,0xffff},
  {0x8097,0x8092,0x0123,0x0121,0xffff,0xffff,0xffff,0xffff},
  {0x80b7,0x80b2,0x0163,0x0161,0xffff,0xffff,0xffff,0xffff},
  {0x80d7,0x80d2,0x01a3,0x01a1,0xffff,0xffff,0xffff,0xffff},
  {0x80f7,0x80f2,0x01e3,0x01e1,0xffff,0xffff,0xffff,0xffff},
  {0x8117,0x8112,0x002b,0x0029,0xffff,0xffff,0xffff,0xffff},
  {0x8137,0x8132,0x006b,0x0069,0xffff,0xffff,0xffff,0xffff},
  {0x8157,0x8152,0x00ab,0x00a9,0xffff,0xffff,0xffff,0xffff},
  {0x8177,0x8172,0x00eb,0x00e9,0xffff,0xffff,0xffff,0xffff},
  {0x8197,0x8192,0x012b,0x0129,0xffff,0xffff,0xffff,0xffff},
  {0x81b7,0x81b2,0x016b,0x0169,0xffff,0xffff,0xffff,0xffff},
  {0x81d7,0x81d2,0x01ab,0x01a9,0xffff,0xffff,0xffff,0xffff},
  {0x81f7,0x81f2,0x01eb,0x01e9,0xffff,0xffff,0xffff,0xffff},
  {0x801f,0x801a,0x0033,0x0031,0xffff,0xffff,0xffff,0xffff},
  {0x803f,0x803a,0x0073,0x0071,0xffff,0xffff,0xffff,0xffff},
  {0x805f,0x805a,0x00b3,0x00b1,0xffff,0xffff,0xffff,0xffff},
  {0x807f,0x807a,0x00f3,0x00f1,0xffff,0xffff,0xffff,0xffff},
  {0x809f,0x809a,0x0133,0x0131,0xffff,0xffff,0xffff,0xffff},
  {0x80bf,0x80ba,0x0173,0x0171,0xffff,0xffff,0xffff,0xffff},
  {0x80df,0x80da,0x01b3,0x01b1,0xffff,0xffff,0xffff,0xffff},
  {0x80ff,0x80fa,0x01f3,0x01f1,0xffff,0xffff,0xffff,0xffff},
  {0x811f,0x811a,0x003b,0x0039,0xffff,0xffff,0xffff,0xffff},
  {0x813f,0x813a,0x007b,0x0079,0xffff,0xffff,0xffff,0xffff},
  {0x815f,0x815a,0x00bb,0x00b9,0xffff,0xffff,0xffff,0xffff},
  {0x817f,0x817a,0x00fb,0x00f9,0xffff,0xffff,0xffff,0xffff},
  {0x819f,0x819a,0x013b,0x0139,0xffff,0xffff,0xffff,0xffff},
  {0x81bf,0x81ba,0x017b,0x0179,0xffff,0xffff,0xffff,0xffff},
  {0x81df,0x81da,0x01bb,0x01b9,0xffff,0xffff,0xffff,0xffff},
  {0x81ff,0x81fa,0x01fb,0x01f9,0xffff,0xffff,0xffff,0xffff},
  {0x8006,0x0006,0x8001,0x8000,0x0000,0xffff,0xffff,0xffff},
  {0x8026,0x0046,0x8021,0x8020,0x0040,0xffff,0xffff,0xffff},
  {0x8046,0x0086,0x8041,0x8040,0x0080,0xffff,0xffff,0xffff},
  {0x8066,0x00c6,0x8061,0x8060,0x00c0,0xffff,0xffff,0xffff},
  {0x8086,0x0106,0x8081,0x8080,0x0100,0xffff,0xffff,0xffff},
  {0x80a6,0x0146,0x80a1,0x80a0,0x0140,0xffff,0xffff,0xffff},
  {0x80c6,0x0186,0x80c1,0x80c0,0x0180,0xffff,0xffff,0xffff},
  {0x80e6,0x01c6,0x80e1,0x80e0,0x01c0,0xffff,0xffff,0xffff},
  {0x8106,0x000e,0x8101,0x8100,0x0008,0xffff,0xffff,0xffff},
  {0x8126,0x004e,0x8121,0x8120,0x0048,0xffff,0xffff,0xffff},
  {0x8146,0x008e,0x8141,0x8140,0x0088,0xffff,0xffff,0xffff},
  {0x8166,0x00ce,0x8161,0x8160,0x00c8,0xffff,0xffff,0xffff},
  {0x8186,0x010e,0x8181,0x8180,0x0108,0xffff,0xffff,0xffff},
  {0x81a6,0x014e,0x81a1,0x81a0,0x0148,0xffff,0xffff,0xffff},
  {0x81c6,0x018e,0x81c1,0x81c0,0x0188,0xffff,0xffff,0xffff},
  {0x81e6,0x01ce,0x81e1,0x81e0,0x01c8,0xffff,0xffff,0xffff},
  {0x800e,0x0016,0x8009,0x8008,0x0010,0xffff,0xffff,0xffff},
  {0x802e,0x0056,0x8029,0x8028,0x0050,0xffff,0xffff,0xffff},
  {0x804e,0x0096,0x8049,0x8048,0x0090,0xffff,0xffff,0xffff},
  {0x806e,0x00d6,0x8069,0x8068,0x00d0,0xffff,0xffff,0xffff},
  {0x808e,0x0116,0x8089,0x8088,0x0110,0xffff,0xffff,0xffff},
  {0x80ae,0x0156,0x80a9,0x80a8,0x0150,0xffff,0xffff,0xffff},
  {0x80ce,0x0196,0x80c9,0x80c8,0x0190,0xffff,0xffff,0xffff},
  {0x80ee,0x01d6,0x80e9,0x80e8,0x01d0,0xffff,0xffff,0xffff},
  {0x810e,0x001e,0x8109,0x8108,0x0018,0xffff,0xffff,0xffff},
  {0x812e,0x005e,0x8129,0x8128,0x0058,0xffff,0xffff,0xffff},
  {0x814e,0x009e,0x8149,0x8148,0x0098,0xffff,0xffff,0xffff},
  {0x816e,0x00de,0x8169,0x8168,0x00d8,0xffff,0xffff,0xffff},
  {0x818e,0x011e,0x8189,0x8188,0x0118,0xffff,0xffff,0xffff},
  {0x81ae,0x015e,0x81a9,0x81a8,0x0158,0xffff,0xffff,0xffff},
  {0x81ce,0x019e,0x81c9,0x81c8,0x0198,0xffff,0xffff,0xffff},
  {0x81ee,0x01de,0x81e9,0x81e8,0x01d8,0xffff,0xffff,0xffff},
  {0x8016,0x0026,0x8011,0x8010,0x0020,0xffff,0xffff,0xffff},
  {0x8036,0x0066,0x8031,0x8030,0x0060,0xffff,0xffff,0xffff},
  {0x8056,0x00a6,0x8051,0x8050,0x00a0,0xffff,0xffff,0xffff},
  {0x8076,0x00e6,0x8071,0x8070,0x00e0,0xffff,0xffff,0xffff},
  {0x8096,0x0126,0x8091,0x8090,0x0120,0xffff,0xffff,0xffff},
  {0x80b6,0x0166,0x80b1,0x80b0,0x0160,0xffff,0xffff,0xffff},
  {0x80d6,0x01a6,0x80d1,0x80d0,0x01a0,0xffff,0xffff,0xffff},
  {0x80f6,0x01e6,0x80f1,0x80f0,0x01e0,0xffff,0xffff,0xffff},
  {0x8116,0x002e,0x8111,0x8110,0x0028,0xffff,0xffff,0xffff},
  {0x8136,0x006e,0x8131,0x8130,0x0068,0xffff,0xffff,0xffff},
  {0x8156,0x00ae,0x8151,0x8150,0x00a8,0xffff,0xffff,0xffff},
  {0x8176,0x00ee,0x8171,0x8170,0x00e8,0xffff,0xffff,0xffff},
  {0x8196,0x012e,0x8191,0x8190,0x0128,0xffff,0xffff,0xffff},
  {0x81b6,0x016e,0x81b1,0x81b0,0x0168,0xffff,0xffff,0xffff},
  {0x81d6,0x01ae,0x81d1,0x81d0,0x01a8,0xffff,0xffff,0xffff},
  {0x81f6,0x01ee,0x81f1,0x81f0,0x01e8,0xffff,0xffff,0xffff},
  {0x801e,0x0036,0x8019,0x8018,0x0030,0xffff,0xffff,0xffff},
  {0x803e,0x0076,0x8039,0x8038,0x0070,0xffff,0xffff,0xffff},
  {0x805e,0x00b6,0x8059,0x8058,0x00b0,0xffff,0xffff,0xffff},
  {0x807e,0x00f6,0x8079,0x8078,0x00f0,0xffff,0xffff,0xffff},
  {0x809e,0x0136,0x8099,0x8098,0x0130,0xffff,0xffff,0xffff},
  {0x80be,0x0176,0x80b9,0x80b8,0x0170,0xffff,0xffff,0xffff},
  {0x80de,0x01b6,0x80d9,0x80d8,0x01b0,0xffff,0xffff,0xffff},
  {0x80fe,0x01f6,0x80f9,0x80f8,0x01f0,0xffff,0xffff,0xffff},
  {0x811e,0x003e,0x8119,0x8118,0x0038,0xffff,0xffff,0xffff},
  {0x813e,0x007e,0x8139,0x8138,0x0078,0xffff,0xffff,0xffff},
  {0x815e,0x00be,0x8159,0x8158,0x00b8,0xffff,0xffff,0xffff},
  {0x817e,0x00fe,0x8179,0x8178,0x00f8,0xffff,0xffff,0xffff},
  {0x819e,0x013e,0x8199,0x8198,0x0138,0xffff,0xffff,0xffff},
  {0x81be,0x017e,0x81b9,0x81b8,0x0178,0xffff,0xffff,0xffff},
  {0x81de,0x01be,0x81d9,0x81d8,0x01b8,0xffff,0xffff,0xffff},
  {0x81fe,0x01fe,0x81f9,0x81f8,0x01f8,0xffff,0xffff,0xffff},
  {0x8005,0x0007,0x0004,0x0002,0xffff,0xffff,0xffff,0xffff},
  {0x8025,0x0047,0x0044,0x0042,0xffff,0xffff,0xffff,0xffff},
  {0x8045,0x0087,0x0084,0x0082,0xffff,0xffff,0xffff,0xffff},
  {0x8065,0x00c7,0x00c4,0x00c2,0xffff,0xffff,0xffff,0xffff},
  {0x8085,0x0107,0x0104,0x0102,0xffff,0xffff,0xffff,0xffff},
  {0x80a5,0x0147,0x0144,0x0142,0xffff,0xffff,0xffff,0xffff},
  {0x80c5,0x0187,0x0184,0x0182,0xffff,0xffff,0xffff,0xffff},
  {0x80e5,0x01c7,0x01c4,0x01c2,0xffff,0xffff,0xffff,0xffff},
  {0x8105,0x000f,0x000c,0x000a,0xffff,0xffff,0xffff,0xffff},
  {0x8125,0x004f,0x004c,0x004a,0xffff,0xffff,0xffff,0xffff},
  {0x8145,0x008f,0x008c,0x008a,0xffff,0xffff,0xffff,0xffff},
  {0x8165,0x00cf,0x00cc,0x00ca,0xffff,0xffff,0xffff,0xffff},
  {0x8185,0x010f,0x010c,0x010a,0xffff,0xffff,0xffff,0xffff},
  {0x81a5,0x014f,0x014c,0x014a,0xffff,0xffff,0xffff,0xffff},
  {0x81c5,0x018f,0x018c,0x018a,0xffff,0xffff,0xffff,0xffff},
  {0x81e5,0x01cf,0x01cc,0x01ca,0xffff,0xffff,0xffff,0xffff},
  {0x800d,0x0017,0x0014,0x0012,0xffff,0xffff,0xffff,0xffff},
  {0x802d,0x0057,0x0054,0x0052,0xffff,0xffff,0xffff,0xffff},
  {0x804d,0x0097,0x0094,0x0092,0xffff,0xffff,0xffff,0xffff},
  {0x806d,0x00d7,0x00d4,0x00d2,0xffff,0xffff,0xffff,0xffff},
  {0x808d,0x0117,0x0114,0x0112,0xffff,0xffff,0xffff,0xffff},
  {0x80ad,0x0157,0x0154,0x0152,0xffff,0xffff,0xffff,0xffff},
  {0x80cd,0x0197,0x0194,0x0192,0xffff,0xffff,0xffff,0xffff},
  {0x80ed,0x01d7,0x01d4,0x01d2,0xffff,0xffff,0xffff,0xffff},
  {0x810d,0x001f,0x001c,0x001a,0xffff,0xffff,0xffff,0xffff},
  {0x812d,0x005f,0x005c,0x005a,0xffff,0xffff,0xffff,0xffff},
  {0x814d,0x009f,0x009c,0x009a,0xffff,0xffff,0xffff,0xffff},
  {0x816d,0x00df,0x00dc,0x00da,0xffff,0xffff,0xffff,0xffff},
  {0x818d,0x011f,0x011c,0x011a,0xffff,0xffff,0xffff,0xffff},
  {0x81ad,0x015f,0x015c,0x015a,0xffff,0xffff,0xffff,0xffff},
  {0x81cd,0x019f,0x019c,0x019a,0xffff,0xffff,0xffff,0xffff},
  {0x81ed,0x01df,0x01dc,0x01da,0xffff,0xffff,0xffff,0xffff},
  {0x8015,0x0027,0x0024,0x0022,0xffff,0xffff,0xffff,0xffff},
  {0x8035,0x0067,0x0064,0x0062,0xffff,0xffff,0xffff,0xffff},
  {0x8055,0x00a7,0x00a4,0x00a2,0xffff,0xffff,0xffff,0xffff},
  {0x8075,0x00e7,0x00e4,0x00e2,0xffff,0xffff,0xffff,0xffff},
  {0x8095,0x0127,0x0124,0x0122,0xffff,0xffff,0xffff,0xffff},
  {0x80b5,0x0167,0x0164,0x0162,0xffff,0xffff,0xffff,0xffff},
  {0x80d5,0x01a7,0x01a4,0x01a2,0xffff,0xffff,0xffff,0xffff},
  {0x80f5,0x01e7,0x01e4,0x01e2,0xffff,0xffff,0xffff,0xffff},
  {0x8115,0x002f,0x002c,0x002a,0xffff,0xffff,0xffff,0xffff},
  {0x8135,0x006f,0x006c,0x006a,0xffff,0xffff,0xffff,0xffff},
  {0x8155,0x00af,0x00ac,0x00aa,0xffff,0xffff,0xffff,0xffff},
  {0x8175,0x00ef,0x00ec,0x00ea,0xffff,0xffff,0xffff,0xffff},
  {0x8195,0x012f,0x012c,0x012a,0xffff,0xffff,0xffff,0xffff},
  {0x81b5,0x016f,0x016c,0x016a,0xffff,0xffff,0xffff,0xffff},
  {0x81d5,0x01af,0x01ac,0x01aa,0xffff,0xffff,0xffff,0xffff},
  {0x81f5,0x01ef,0x01ec,0x01ea,0xffff,0xffff,0xffff,0xffff},
  {0x801d,0x0037,0x0034,0x0032,0xffff,0xffff,0xffff,0xffff},
  {0x803d,0x0077,0x0074,0x0072,0xffff,0xffff,0xffff,0xffff},
  {0x805d,0x00b7,0x00b4,0x00b2,0xffff,0xffff,0xffff,0xffff},
  {0x807d,0x00f7,0x00f4,0x00f2,0xffff,0xffff,0xffff,0xffff},
  {0x809d,0x0137,0x0134,0x0132,0xffff,0xffff,0xffff,0xffff},
  {0x80bd,0x0177,0x0174,0x0172,0xffff,0xffff,0xffff,0xffff},
  {0x80dd,0x01b7,0x01b4,0x01b2,0xffff,0xffff,0xffff,0xffff},
  {0x80fd,0x01f7,0x01f4,0x01f2,0xffff,0xffff,0xffff,0xffff},
  {0x811d,0x003f,0x003c,0x003a,0xffff,0xffff,0xffff,0xffff},
  {0x813d,0x007f,0x007c,0x007a,0xffff,0xffff,0xffff,0xffff},
  {0x815d,0x00bf,0x00bc,0x00ba,0xffff,0xffff,0xffff,0xffff},
  {0x817d,0x00ff,0x00fc,0x00fa,0xffff,0xffff,0xffff,0xffff},
  {0x819d,0x013f,0x013c,0x013a,0xffff,0xffff,0xffff,0xffff},
  {0x81bd,0x017f,0x017c,0x017a,0xffff,0xffff,0xffff,0xffff},
  {0x81dd,0x01bf,0x01bc,0x01ba,0xffff,0xffff,0xffff,0xffff},
  {0x81fd,0x01ff,0x01fc,0x01fa,0xffff,0xffff,0xffff,0xffff},
  {0x8004,0x8003,0x0005,0x4000,0xffff,0xffff,0xffff,0xffff},
  {0x8024,0x8023,0x0045,0x4008,0xffff,0xffff,0xffff,0xffff},
  {0x8044,0x8043,0x0085,0x4010,0xffff,0xffff,0xffff,0xffff},
  {0x8064,0x8063,0x00c5,0x4018,0xffff,0xffff,0xffff,0xffff},
  {0x8084,0x8083,0x0105,0x4020,0xffff,0xffff,0xffff,0xffff},
  {0x80a4,0x80a3,0x0145,0x4028,0xffff,0xffff,0xffff,0xffff},
  {0x80c4,0x80c3,0x0185,0x4030,0xffff,0xffff,0xffff,0xffff},
  {0x80e4,0x80e3,0x01c5,0x4038,0xffff,0xffff,0xffff,0xffff},
  {0x8104,0x8103,0x000d,0x4001,0xffff,0xffff,0xffff,0xffff},
  {0x8124,0x8123,0x004d,0x4009,0xffff,0xffff,0xffff,0xffff},
  {0x8144,0x8143,0x008d,0x4011,0xffff,0xffff,0xffff,0xffff},
  {0x8164,0x8163,0x00cd,0x4019,0xffff,0xffff,0xffff,0xffff},
  {0x8184,0x8183,0x010d,0x4021,0xffff,0xffff,0xffff,0xffff},
  {0x81a4,0x81a3,0x014d,0x4029,0xffff,0xffff,0xffff,0xffff},
  {0x81c4,0x81c3,0x018d,0x4031,0xffff,0xffff,0xffff,0xffff},
  {0x81e4,0x81e3,0x01cd,0x4039,0xffff,0xffff,0xffff,0xffff},
  {0x800c,0x800b,0x0015,0x4002,0xffff,0xffff,0xffff,0xffff},
  {0x802c,0x802b,0x0055,0x400a,0xffff,0xffff,0xffff,0xffff},
  {0x804c,0x804b,0x0095,0x4012,0xffff,0xffff,0xffff,0xffff},
  {0x806c,0x806b,0x00d5,0x401a,0xffff,0xffff,0xffff,0xffff},
  {0x808c,0x808b,0x0115,0x4022,0xffff,0xffff,0xffff,0xffff},
  {0x80ac,0x80ab,0x0155,0x402a,0xffff,0xffff,0xffff,0xffff},
  {0x80cc,0x80cb,0x0195,0x4032,0xffff,0xffff,0xffff,0xffff},
  {0x80ec,0x80eb,0x01d5,0x403a,0xffff,0xffff,0xffff,0xffff},
  {0x810c,0x810b,0x001d,0x4003,0xffff,0xffff,0xffff,0xffff},
  {0x812c,0x812b,0x005d,0x400b,0xffff,0xffff,0xffff,0xffff},
  {0x814c,0x814b,0x009d,0x4013,0xffff,0xffff,0xffff,0xffff},
  {0x816c,0x816b,0x00dd,0x401b,0xffff,0xffff,0xffff,0xffff},
  {0x818c,0x818b,0x011d,0x4023,0xffff,0xffff,0xffff,0xffff},
  {0x81ac,0x81ab,0x015d,0x402b,0xffff,0xffff,0xffff,0xffff},
  {0x81cc,0x81cb,0x019d,0x4033,0xffff,0xffff,0xffff,0xffff},
  {0x81ec,0x81eb,0x01dd,0x403b,0xffff,0xffff,0xffff,0xffff},
  {0x8014,0x8013,0x0025,0x4004,0xffff,0xffff,0xffff,0xffff},
  {0x8034,0x8033,0x0065,0x400c,0xffff,0xffff,0xffff,0xffff},
  {0x8054,0x8053,0x00a5,0x4014,0xffff,0xffff,0xffff,0xffff},
  {0x8074,0x8073,0x00e5,0x401c,0xffff,0xffff,0xffff,0xffff},
  {0x8094,0x8093,0x0125,0x4024,0xffff,0xffff,0xffff,0xffff},
  {0x80b4,0x80b3,0x0165,0x402c,0xffff,0xffff,0xffff,0xffff},
  {0x80d4,0x80d3,0x01a5,0x4034,0xffff,0xffff,0xffff,0xffff},
  {0x80f4,0x80f3,0x01e5,0x403c,0xffff,0xffff,0xffff,0xffff},
  {0x8114,0x8113,0x002d,0x4005,0xffff,0xffff,0xffff,0xffff},
  {0x8134,0x8133,0x006d,0x400d,0xffff,0xffff,0xffff,0xffff},
  {0x8154,0x8153,0x00ad,0x4015,0xffff,0xffff,0xffff,0xffff},
  {0x8174,0x8173,0x00ed,0x401d,0xffff,0xffff,0xffff,0xffff},
  {0x8194,0x8193,0x012d,0x4025,0xffff,0xffff,0xffff,0xffff},
  {0x81b4,0x81b3,0x016d,0x402d,0xffff,0xffff,0xffff,0xffff},
  {0x81d4,0x81d3,0x01ad,0x4035,0xffff,0xffff,0xffff,0xffff},
  {0x81f4,0x81f3,0x01ed,0x403d,0xffff,0xffff,0xffff,0xffff},
  {0x801c,0x801b,0x0035,0x4006,0xffff,0xffff,0xffff,0xffff},
  {0x803c,0x803b,0x0075,0x400e,0xffff,0xffff,0xffff,0xffff},
  {0x805c,0x805b,0x00b5,0x4016,0xffff,0xffff,0xffff,0xffff},
  {0x807c,0x807b,0x00f5,0x401e,0xffff,0xffff,0xffff,0xffff},
  {0x809c,0x809b,0x0135,0x4026,0xffff,0xffff,0xffff,0xffff},
  {0x80bc,0x80bb,0x0175,0x402e,0xffff,0xffff,0xffff,0xffff},
  {0x80dc,0x80db,0x01b5,0x4036,0xffff,0xffff,0xffff,0xffff},
  {0x80fc,0x80fb,0x01f5,0x403e,0xffff,0xffff,0xffff,0xffff},
  {0x811c,0x811b,0x003d,0x4007,0xffff,0xffff,0xffff,0xffff},
  {0x813c,0x813b,0x007d,0x400f,0xffff,0xffff,0xffff,0xffff},
  {0x815c,0x815b,0x00bd,0x4017,0xffff,0xffff,0xffff,0xffff},
  {0x817c,0x817b,0x00fd,0x401f,0xffff,0xffff,0xffff,0xffff},
  {0x819c,0x819b,0x013d,0x4027,0xffff,0xffff,0xffff,0xffff},
  {0x81bc,0x81bb,0x017d,0x402f,0xffff,0xffff,0xffff,0xffff},
  {0x81dc,0x81db,0x01bd,0x4037,0xffff,0xffff,0xffff,0xffff},
  {0x81fc,0x81fb,0x01fd,0x403f,0xffff,0xffff,0xffff,0xffff},
};
constexpr size_t WS_DIFFO = 224 * MiB;
constexpr size_t WS_END2 = 256 * MiB;
constexpr int CW_DIFF = 65536;
static_assert((CW_DIFF + 256 * 64) * 4 <= (int)CTL_ZERO_BYTES, "counters inside the zeroed control region");
static_assert(ab::ATTN_LDS_BYTES <= RING_BYTES, "attention LDS fits the ring region");
__device__ __forceinline__ void diff_combine(const bf16_t* DIFFO, bf16_t* ATT, const float* subw, float lam, int b, int h, int qb, int wid, int lane_) {
    int lane = lane_; asm volatile("" : "+v"(lane));
    const int row = b * SEQ + 256 * qb + 32 * wid + (lane >> 1), hf = lane & 1;
    const GAS v4u* s1 = (const GAS v4u*)(DIFFO + (size_t)row * 1024 + h * 256 + hf * 64);
    const GAS v4u* s2 = (const GAS v4u*)(DIFFO + (size_t)row * 1024 + h * 256 + 128 + hf * 64);
    f32x4 v[16]; float ss = 0.f;
#pragma unroll
    for (int q = 0; q < 8; ++q) { const v4u a = s1[q], c = s2[q];
        const f32x4 a0 = {__uint_as_float(a.x << 16), __uint_as_float(a.x & 0xffff0000u), __uint_as_float(a.y << 16), __uint_as_float(a.y & 0xffff0000u)};
        const f32x4 a1 = {__uint_as_float(a.z << 16), __uint_as_float(a.z & 0xffff0000u), __uint_as_float(a.w << 16), __uint_as_float(a.w & 0xffff0000u)};
        const f32x4 c0 = {__uint_as_float(c.x << 16), __uint_as_float(c.x & 0xffff0000u), __uint_as_float(c.y << 16), __uint_as_float(c.y & 0xffff0000u)};
        const f32x4 c1 = {__uint_as_float(c.z << 16), __uint_as_float(c.z & 0xffff0000u), __uint_as_float(c.w << 16), __uint_as_float(c.w & 0xffff0000u)};
        v[2 * q] = a0 - c0 * lam; v[2 * q + 1] = a1 - c1 * lam;
        ss += ((v[2 * q].x * v[2 * q].x + v[2 * q].y * v[2 * q].y) + (v[2 * q].z * v[2 * q].z + v[2 * q].w * v[2 * q].w)) + ((v[2 * q + 1].x * v[2 * q + 1].x + v[2 * q + 1].y * v[2 * q + 1].y) + (v[2 * q + 1].z * v[2 * q + 1].z + v[2 * q + 1].w * v[2 * q + 1].w)); }
    ss += __shfl_xor(ss, 1);
    const float rstd = rsqrtf(ss * (1.f / 128.f) + EPS) * 0.8f;
    GAS v4u* dst = (GAS v4u*)(ATT + (size_t)row * DM + h * 128 + hf * 64);
    const GAS f32x4* sw = (const GAS f32x4*)(subw + hf * 64);
#pragma unroll
    for (int q = 0; q < 8; ++q) { const f32x4 g0 = sw[2 * q] * rstd, g1 = sw[2 * q + 1] * rstd; const f32x4 o0 = v[2 * q] * g0, o1 = v[2 * q + 1] * g1;
        dst[q] = (v4u){pk2(o0.x, o0.y), pk2(o0.z, o0.w), pk2(o1.x, o1.y), pk2(o1.z, o1.w)}; }
}
__device__ __forceinline__ void attn_phase(Frame& F, char* shm, gu32* ctl, const bf16_t* PROJ, const float* CUMB, bf16_t* ATT, bf16_t* DIFFO, const float* subw, const float* lq1, const float* lk1, const float* lq2, const float* lk2,
                                           const bf16_t* HM, const bf16_t* WKV, bf16_t* MKN, bf16_t* VT, const float* mkw, const float* mqw) {
    const float s1 = wave_sum(lq1[F.lane] * lk1[F.lane]), s2 = wave_sum(lq2[F.lane] * lk2[F.lane]);
    const float lam = __uint_as_float(__builtin_amdgcn_readfirstlane(__float_as_uint(__expf(s1) - __expf(s2) + 0.2f)));
    const int bx = (int)blockIdx.x & 255;
    for (int k = 0; k < 8; ++k) {
        const unsigned u = UNIT_TAB[bx][k]; if (u == 0xFFFFu) break;
        const int qb = u & 7;
        if (u & 0x4000u) {
            const int idx = u & 63;
            if (idx < 32) {
                pg8::Gemm g{HM, WKV, DM, DM, DM}; const Sched S = sched_one(idx >> 2, idx & 3, true);
                pg8::EpiHeadNormK E{MKN, mkw, mqw};
                pg8::gemm_phase<pg8::EpiHeadNormK, Sched, false, true>(F.lds + RING_OFF, g, S, E);
            } else {
                pg8::Gemm g{WKV + (size_t)1024 * DM, HM, DM, DM, DM}; const Sched S = sched_one((idx - 32) >> 3, (idx - 32) & 7, true);
                pg8::EpiStore<0> E{VT, MMEM, nullptr};
                pg8::gemm_phase<pg8::EpiStore<0>, Sched, true, true>(F.lds + RING_OFF, g, S, E);
            }
            __syncthreads();
        } else if (u & 0x8000u) {
            const int bh = (u >> 3) & 31, mp = (u >> 8) & 1, b = bh >> 2, h = bh & 3;
            const ab::bf16* base = (const ab::bf16*)PROJ + (size_t)b * SEQ * NPROJ;
#pragma unroll 1
            for (int hf = 0; hf < 2; ++hf)
                ab::attn_unit<8, 1, false>(qb, base + C_DQ + 128 * h + 64 * mp, base + C_DK + 128 * h + 64 * mp, base + C_DV + 128 * h + 64 * hf,
                                           (ab::bf16*)DIFFO + (size_t)b * SEQ * 1024 + h * 256 + (mp * 2 + hf) * 64, 1024, nullptr, shm);
            VM_WAIT(); __syncthreads();
            if (F.tid == 0) { __builtin_amdgcn_fence(__ATOMIC_RELEASE, "agent"); VM_WAIT();
                const unsigned old = __hip_atomic_fetch_add((unsigned*)(ctl + CW_DIFF + 64 * (bh * 8 + qb)), 1u, __ATOMIC_RELAXED, __HIP_MEMORY_SCOPE_AGENT);
                if (old == 1u) { __builtin_amdgcn_fence(__ATOMIC_ACQUIRE, "agent"); VM_WAIT(); }
                F.MISC[12] = old; }
            __syncthreads();
            if (F.MISC[12] == 1u) diff_combine(DIFFO, ATT, subw, lam, b, h, qb, F.wave, F.lane);
            __syncthreads();
        } else {
            const int bh = (u >> 3) & 63, b = bh >> 3, h = bh & 7;
            const ab::bf16* base = (const ab::bf16*)PROJ + (size_t)b * SEQ * NPROJ;
            ab::attn_unit<8, 0, true>(qb, base + C_FQ + 64 * h, base + C_FK + 64 * h, base + C_FV + 64 * h, (ab::bf16*)ATT + (size_t)b * SEQ * DM + 512 + 64 * h, DM, CUMB + (size_t)bh * SEQ, shm);
        }
    }
}
#ifndef REP3
#define REP3 1
#endif
#define ATTN_PHASE_HOOK if (IN(3)) { PP; for (int rep_ = 0; rep_ < REP3; ++rep_) attn_phase(F, (char*)lds + RING_OFF, F.ctl, P.PROJ, P.CUMB, P.ATT, (bf16_t*)(args.ws + WS_DIFFO), P.subw, P.lq1, P.lk1, P.lq2, P.lk2, P.HM, P.WKV, P.MKN, P.VT, P.mkw, P.mqw); }
#ifndef REP0
#define REP0 1
#endif
#ifndef REP1
#define REP1 1
#endif
#ifndef REP2
#define REP2 1
#endif
#ifndef REP3
#define REP3 1
#endif
#ifndef REP4
#define REP4 1
#endif
#ifndef REP5
#define REP5 1
#endif
#ifndef REP6
#define REP6 1
#endif
#ifndef REP7
#define REP7 1
#endif
#ifndef REP8
#define REP8 1
#endif
constexpr int NPHASE = 9;

__global__ void __launch_bounds__(NWAVES * 64, 2) mega_fwd(Args args) {
    extern __shared__ __attribute__((aligned(16))) unsigned char lds[];
    Frame F;
    F.lds = (LAS unsigned char*)lds; F.MISC = (volatile LAS unsigned*)(F.lds + MISC_OFF);
    F.tid = threadIdx.x; F.lane = F.tid & 63; F.wave = __builtin_amdgcn_readfirstlane(F.tid >> 6);
    F.G = gridDim.x; { const int bx = blockIdx.x; F.vcu = (F.G % 8 == 0) ? (bx % 8) * (F.G / 8) + bx / 8 : bx; }
    F.ctl = (gu32*)(args.ws + WS_CTL);
    for (int u = F.tid; u < (LDS_BYTES - LDSCTL_OFF) / 4; u += NWAVES * 64) ((LAS unsigned*)(F.lds + LDSCTL_OFF))[u] = 0u;
    __syncthreads();
    XcdBarrier bar = xcd_barrier_post((unsigned*)(F.ctl + CW_BAR) + args.ph_lo * XCD_BAR_WORDS, F.MISC + 8);
    const int lo = args.ph_lo, hi = args.ph_hi;
#define IN(k) (lo <= (k) && (k) < hi)
#define PP const Ptrs P = make_ptrs(args.in, args.out, args.ws)
#define SEAM(k) do { if (IN(k) && IN((k) + 1)) xcd_barrier(bar); } while (0)
#define SEAM2(k) do { if (IN(k) && IN((k) + 2)) xcd_barrier(bar); } while (0)
    const int bx = (int)blockIdx.x;

    if (IN(0)) { PP; for (int rep_ = 0; rep_ < REP0; ++rep_) p0_prologue(F, P); } SEAM(0);

    if (IN(1)) {
        PP; for (int rep_ = 0; rep_ < REP1; ++rep_) {
        pg8::Gemm g{P.XB, P.WIN, DM, DM, DM}; const Sched S = sched_static(MTOK, NPROJ, F.G, bx);
        if (bx < 8) p1b_cumsum(P, bx * NWAVES + F.wave, F.lane);
        pg8::EpiProj E{P.PROJ, P.QKW, P.ROPE};
        pg8::gemm_phase<pg8::EpiProj, Sched, true, true>(F.lds + RING_OFF, g, S, E);
    }} SEAM2(1);


    ATTN_PHASE_HOOK
    SEAM(3);

    if (IN(4)) {
        PP; for (int rep_ = 0; rep_ < REP4; ++rep_) {
        pg8::Gemm g{P.ATT, P.WOUT, DM, DM, DM}; const Sched S = sched_static(MTOK, DM, F.G, bx);
        pg8::EpiResid<0> E{P.x, P.XB, nullptr, P.SS};
        pg8::gemm_phase<pg8::EpiResid<0>, Sched, false, true>(F.lds + RING_OFF, g, S, E);
    }} SEAM(4);

    if (IN(5)) {
        PP; for (int rep_ = 0; rep_ < REP5; ++rep_) {
        const Sched S0 = sched_static(MTOK, DM, F.G, bx); pg8::Unit u{0, 0}; const bool has = S0.next(0, u);
        PG8_LAS float* RQ = (PG8_LAS float*)(F.lds + LDS_RQ); PG8_LAS float* IL = (PG8_LAS float*)(F.lds + LDS_IL);
        {   pg8::Gemm g{P.XB, P.WQ, DM, DM, DM}; const Sched S = sched_one(u.pm, u.pn, has);
            pg8::EpiMemQ E{P.MQ, P.SS, RQ};
            pg8::gemm_phase<pg8::EpiMemQ, Sched, false, true>(F.lds + RING_OFF, g, S, E); }
        VM_WAIT(); __syncthreads(); if (F.tid == 0) { __builtin_amdgcn_fence(__ATOMIC_ACQUIRE, "agent"); VM_WAIT(); } __syncthreads();
        const int head = u.pn, bh = (u.pm >> 3) * 4 + head;
        {   pg8::Gemm g{P.MQ + head * 256, P.MKN + (size_t)bh * 65536, DM, 256, 256}; const Sched S = sched_one(u.pm, 0, has);
            pg8::EpiMemS E{P.MQ, head, RQ, IL};
            pg8::gemm_phase<pg8::EpiMemS, Sched, false, true>(F.lds + RING_OFF, g, S, E); }
        VM_WAIT(); __syncthreads(); if (F.tid == 0) { __builtin_amdgcn_fence(__ATOMIC_ACQUIRE, "agent"); VM_WAIT(); } __syncthreads();
        {   pg8::Gemm g{P.MQ + head * 256, P.VT + (size_t)(head * 256) * MMEM + (u.pm >> 3) * 256, DM, MMEM, 256}; const Sched S = sched_one(u.pm, 0, has);
            pg8::EpiMemPV E{P.MO, head, IL};
            pg8::gemm_phase<pg8::EpiMemPV, Sched, true, true>(F.lds + RING_OFF, g, S, E); }
    }} SEAM(5);

    if (IN(6)) {
        PP; for (int rep_ = 0; rep_ < REP6; ++rep_) {
        pg8::Gemm g{P.MO, P.WO, DM, DM, DM}; const Sched S = sched_static(MTOK, DM, F.G, bx);
        pg8::EpiResid<1> E{nullptr, P.XB, nullptr, P.SS};
        pg8::gemm_phase<pg8::EpiResid<1>, Sched, false, true>(F.lds + RING_OFF, g, S, E);
    }} SEAM(6);

    if (IN(7)) {
        PP; for (int rep_ = 0; rep_ < REP7; ++rep_) {
        pg8::Gemm g{P.XB, P.WUP, DM, DM, DM}; const Sched S = sched_static(MTOK, DFF, F.G, bx);
        pg8::EpiStore<3> E{P.H, DFF, P.SS};
        pg8::gemm_phase<pg8::EpiStore<3>, Sched, true, true>(F.lds + RING_OFF, g, S, E);
    }} SEAM(7);

    if (IN(8)) {
        PP; for (int rep_ = 0; rep_ < REP8; ++rep_) {
        pg8::Gemm g{P.H, P.WDN, DFF, DFF, DFF}; const Sched S = sched_static(MTOK, DM, F.G, bx);
        pg8::EpiResid<2> E{nullptr, P.XB, P.out, nullptr};
        pg8::gemm_phase<pg8::EpiResid<2>, Sched, false, true>(F.lds + RING_OFF, g, S, E);
    }}
#undef IN
#undef SEAM
#undef SEAM2
}
extern "C" void kernel_launch(void* const* d_in, const int* in_sizes, int n_in, void* d_out, int out_size, void* d_ws, size_t ws_size, hipStream_t stream) {
    static int grid = 0;
    if (grid == 0) {
        if (n_in != 26 || in_sizes[0] != MTOK * DM || out_size != MTOK * DM || ws_size < WS_END2) { fprintf(stderr, "kernel_launch: unexpected shapes (n_in %d, in0 %d, out %d, ws %zu)\n", n_in, n_in > 0 ? in_sizes[0] : -1, out_size, ws_size); grid = -1; return; }
        int dev = 0, cus = 0, per_cu = 0;
        if (hipGetDevice(&dev) != hipSuccess || hipDeviceGetAttribute(&cus, hipDeviceAttributeMultiprocessorCount, dev) != hipSuccess) { grid = -1; return; }
        if (hipFuncSetAttribute((const void*)mega_fwd, hipFuncAttributeMaxDynamicSharedMemorySize, LDS_BYTES) != hipSuccess) { fprintf(stderr, "kernel_launch: hipFuncSetAttribute failed\n"); grid = -1; return; }
        if (hipOccupancyMaxActiveBlocksPerMultiprocessor(&per_cu, (const void*)mega_fwd, NWAVES * 64, LDS_BYTES) != hipSuccess || per_cu < 1) { fprintf(stderr, "kernel_launch: occupancy query says %d blocks per CU\n", per_cu); (void)hipGetLastError(); grid = -1; return; }
        grid = cus;
        if (grid != 256) fprintf(stderr, "kernel_launch: %d CUs; the one-unit-per-workgroup phases assume 256\n", grid);
    }
    if (grid < 0) return;
    (void)hipMemsetAsync((char*)d_ws + WS_CTL, 0, CTL_ZERO_BYTES, stream);
    Args a{};
    for (int i = 0; i < 26; ++i) a.in[i] = d_in[i];
    a.out = (float*)d_out; a.ws = (unsigned char*)d_ws;
#if MK_HYBRID
    const Ptrs P = make_ptrs(a.in, a.out, a.ws);
    a.ph_lo = 0; a.ph_hi = 3; hipLaunchKernelGGL(mega_fwd, dim3(grid), dim3(NWAVES * 64), LDS_BYTES, stream, a);
    float* OF = a.out;
    hipLaunchKernelGGL(k_attn, dim3(MTOK / 64, 8), dim3(64), 0, stream, P.PROJ, P.CUMB, 1, OF, 8);
    hipLaunchKernelGGL(k_fox_fin, dim3(MTOK * 512 / 256), dim3(256), 0, stream, OF, P.ATT);
    hipLaunchKernelGGL(k_attn, dim3(MTOK / 64, 16), dim3(64), 0, stream, P.PROJ, P.CUMB, 0, OF, 16);
    hipLaunchKernelGGL(k_diff_fin, dim3(MTOK), dim3(256), 0, stream, OF, P.lq1, P.lk1, P.lq2, P.lk2, P.subw, P.ATT);
    a.ph_lo = 4; a.ph_hi = 9; hipLaunchKernelGGL(mega_fwd, dim3(grid), dim3(NWAVES * 64), LDS_BYTES, stream, a);
#else
    a.ph_lo = 0; a.ph_hi = NPHASE; hipLaunchKernelGGL(mega_fwd, dim3(grid), dim3(NWAVES * 64), LDS_BYTES, stream, a);
#endif
}
```

```cpp
#include <hip/hip_runtime.h>
#include <cstdint>
#include <cstdio>

typedef unsigned short bf16_t;
__device__ __forceinline__ float bf2f(bf16_t v) { return __uint_as_float(((unsigned)v) << 16); }
__device__ __forceinline__ bf16_t f2bf(float f) { unsigned u = __float_as_uint(f); return (bf16_t)((u + 0x7fffu + ((u >> 16) & 1u)) >> 16); }

constexpr int NB = 8, SEQ = 2048, DM = 1024, MTOK = NB * SEQ, MEML = 256, MMEM = NB * MEML;
constexpr int NPROJ = 3072, INCOLS = 3080, DFF = 4096;
constexpr float EPS = 1e-6f;
constexpr float LOG2E = 1.4426950408889634f;
constexpr float C2 = 0.125f * LOG2E;
constexpr float CM = 0.0625f * LOG2E;
constexpr int C_DQ = 0, C_DK = 512, C_DV = 1024, C_FQ = 1536, C_FK = 2048, C_FV = 2560;

constexpr size_t MiB = 1u << 20;
constexpr size_t WS_CTL = 0, CTL_ZERO_BYTES = 1 * MiB;
constexpr size_t WS_FLOG = 1 * MiB;
constexpr size_t WS_CUMB = 2 * MiB;
constexpr size_t WS_ROPE = 3 * MiB;
constexpr size_t WS_QKW = 4 * MiB + 512 * 1024;
constexpr size_t WS_SS = 4 * MiB;
constexpr size_t WS_WIN = 8 * MiB, WS_WOUT = 14 * MiB, WS_WQ = 16 * MiB, WS_WKV = 18 * MiB, WS_WO = 22 * MiB, WS_WUP = 24 * MiB, WS_WDN = 32 * MiB;
constexpr size_t WS_XB = 40 * MiB;
constexpr size_t WS_HM = 72 * MiB;
constexpr size_t WS_MK = 76 * MiB;
constexpr size_t WS_VT = 80 * MiB;
constexpr size_t WS_MKN = 84 * MiB;
constexpr size_t WS_PROJ = 96 * MiB;
constexpr size_t WS_ATT = 192 * MiB;
constexpr size_t WS_MQ = 96 * MiB;
constexpr size_t WS_MO = 128 * MiB;
constexpr size_t WS_H = 96 * MiB;
constexpr size_t WS_END = 224 * MiB;
#define MK_HYBRID 0
namespace pg8 {
#define PG8_LAS __attribute__((address_space(3)))
typedef short bf16x8 __attribute__((ext_vector_type(8)));
typedef float f32x4 __attribute__((ext_vector_type(4)));
typedef unsigned u32x4 __attribute__((ext_vector_type(4)));
typedef unsigned u32x2 __attribute__((ext_vector_type(2)));
constexpr int BM = 256, BK = 64, HALF = 128, HTB = HALF * BK * 2  , STAGE_BYTES = 8 * HTB, NXCD = 8, WGM = 8;

__host__ __device__ __forceinline__ int lds_byte(int r, int c) { const int st = (r >> 4) * 2 + (c >> 5), rr = r & 15, cc = c & 31, ob = rr * 64 + cc * 2; return st * 1024 + (ob ^ (((ob >> 9) & 1) << 5)); }
__host__ __device__ __forceinline__ void stage_rc(int b, int& R, int& C) { const int st = b / 1024, sb = b % 1024, swz = sb ^ (((sb >> 9) & 1) << 5); R = (st >> 1) * 16 + swz / 64; C = (st & 1) * 32 + (swz % 64) / 2; }
__host__ __device__ __forceinline__ int perm32(int rho) { const int n = rho >> 4, i = rho & 15; return 8 * (i >> 2) + 4 * n + (i & 3); }

struct Unit { int pm, pn; };
struct Gemm { const bf16_t* A; const bf16_t* Bt; int lda, ldb, K; };

struct StaticOrder {
    int nM, nN, nwg, G, c;
    __host__ __device__ void init(int M, int N, int G_, int c_) { nM = M / BM; nN = N / BM; nwg = nM * nN; G = G_; c = c_; }
    __host__ __device__ bool next(int i, Unit& u) const {
        const long L = (long)i * G + c; if (L >= nwg) return false;
        int wgid = (int)L; { const int q = nwg / NXCD, r = nwg % NXCD, xcd = wgid % NXCD, off = wgid / NXCD; wgid = (xcd < r ? xcd * (q + 1) : r * (q + 1) + (xcd - r) * q) + off; }
        const int nig = WGM * nN, gid = wgid / nig, fm = gid * WGM, gsz = (nM - fm) < WGM ? (nM - fm) : WGM;
        u.pm = fm + ((wgid % nig) % gsz); u.pn = (wgid % nig) / gsz; return true;
    }
    __device__ __forceinline__ void a_ready(const Unit&) const {}
    __device__ __forceinline__ void done(const Unit&) const {}
};
struct OneUnit {
    int pm, pn; bool has;
    __device__ __forceinline__ bool next(int i, Unit& u) const { if (i != 0 || !has) return false; u.pm = pm; u.pn = pn; return true; }
    __device__ __forceinline__ void a_ready(const Unit&) const {}
    __device__ __forceinline__ void done(const Unit&) const {}
};

__device__ __forceinline__ unsigned cvt_pk_bf16(float lo, float hi) { unsigned r; asm volatile("v_cvt_pk_bf16_f32 %0, %1, %2" : "=v"(r) : "v"(lo), "v"(hi)); return r; }
#define PG8_LBAR() do { asm volatile("s_waitcnt lgkmcnt(0)" ::: "memory"); __builtin_amdgcn_s_barrier(); asm volatile("" ::: "memory"); } while (0)

template <int MODE> struct EpiStore {
    static constexpr bool PERM = true, AFTER_DRAIN = false;
    bf16_t* O; int ldc; const float* SS;
    __device__ __forceinline__ void operator()(const f32x4 (&acc)[2][2][4][2], const Unit& u, int wr, int wc, int fr, int fq) const {
        const int row0 = u.pm * BM + wr * 64 + fr, col0 = u.pn * BM + wc * 32 + 8 * fq;
#pragma unroll
        for (int ai = 0; ai < 2; ++ai)
#pragma unroll
            for (int m = 0; m < 4; ++m) { const int row = row0 + ai * HALF + m * 16; float rs = 1.f;
                if (MODE != 0) { const f32x4 s = *(const f32x4*)(SS + (size_t)row * 4); rs = rsqrtf(((s[0] + s[1]) + (s[2] + s[3])) * (1.f / DM) + EPS); }
                bf16_t* rowp = O + (size_t)row * ldc + col0;
#pragma unroll
                for (int bj = 0; bj < 2; ++bj) { f32x4 v0 = acc[ai][bj][m][0] * rs, v1 = acc[ai][bj][m][1] * rs;
                    if (MODE == 3) {
#pragma unroll
                        for (int e = 0; e < 4; ++e) { const float a = fmaxf(v0[e], 0.f), b = fmaxf(v1[e], 0.f); v0[e] = a * a; v1[e] = b * b; } }
                    u32x4 w; w.x = cvt_pk_bf16(v0[0], v0[1]); w.y = cvt_pk_bf16(v0[2], v0[3]); w.z = cvt_pk_bf16(v1[0], v1[1]); w.w = cvt_pk_bf16(v1[2], v1[3]);
                    *(u32x4*)(rowp + bj * HALF) = w; } }
    }
};
struct EpiProj {
    static constexpr bool PERM = true, AFTER_DRAIN = false;
    bf16_t* O; const float* QKW; const float* ROPE;
    __device__ __forceinline__ void operator()(const f32x4 (&acc)[2][2][4][2], const Unit& u, int wr, int wc, int fr, int fq) const {
        const int sec = u.pn >> 1, row0 = u.pm * BM + wr * 64 + fr, col0 = u.pn * BM + wc * 64 + 8 * fq;
        if (sec == 2 || sec == 5) {
#pragma unroll
            for (int ai = 0; ai < 2; ++ai)
#pragma unroll
                for (int m = 0; m < 4; ++m) { bf16_t* rowp = O + (size_t)(row0 + ai * HALF + m * 16) * NPROJ + col0;
#pragma unroll
                    for (int bj = 0; bj < 2; ++bj) { const f32x4 v0 = acc[ai][bj][m][0], v1 = acc[ai][bj][m][1];
                        u32x4 w; w.x = cvt_pk_bf16(v0[0], v0[1]); w.y = cvt_pk_bf16(v0[2], v0[3]); w.z = cvt_pk_bf16(v1[0], v1[1]); w.w = cvt_pk_bf16(v1[2], v1[3]);
                        *(u32x4*)(rowp + bj * 32) = w; } }
            return;
        }
        const float* w = QKW + 64 * (sec < 2 ? sec : sec - 1);
        const float sc = (sec == 0 || sec == 3) ? C2 : 1.f; const bool rope = sec < 2;
        f32x4 g[2][2];
#pragma unroll
        for (int bj = 0; bj < 2; ++bj)
#pragma unroll
            for (int n = 0; n < 2; ++n) g[bj][n] = *(const f32x4*)(w + 32 * bj + 8 * fq + 4 * n);
        const float sgn = fq == 0 ? -1.f : 1.f; const bool rl = fq < 2;
#pragma unroll
        for (int ai = 0; ai < 2; ++ai)
#pragma unroll
            for (int m = 0; m < 4; ++m) { const int row = row0 + ai * HALF + m * 16; float ss = 0.f;
#pragma unroll
                for (int bj = 0; bj < 2; ++bj)
#pragma unroll
                    for (int n = 0; n < 2; ++n) { const f32x4 a = acc[ai][bj][m][n]; ss += (a[0] * a[0] + a[1] * a[1]) + (a[2] * a[2] + a[3] * a[3]); }
                ss += __shfl_xor(ss, 16); ss += __shfl_xor(ss, 32);
                const float rstd = rsqrtf(ss * (1.f / 64.f) + EPS) * sc;
                f32x4 v[2][2];
#pragma unroll
                for (int bj = 0; bj < 2; ++bj)
#pragma unroll
                    for (int n = 0; n < 2; ++n) v[bj][n] = acc[ai][bj][m][n] * rstd * g[bj][n];
                if (rope) {
#pragma unroll
                    for (int n = 0; n < 2; ++n) { f32x4 pr;
#pragma unroll
                        for (int e = 0; e < 4; ++e) pr[e] = __shfl_xor(v[0][n][e], 16);
                        const f32x4 c = *(const f32x4*)(ROPE + (size_t)row * 16 + 4 * n), s = *(const f32x4*)(ROPE + (size_t)row * 16 + 8 + 4 * n);
                        const f32x4 r = v[0][n] * c + pr * s * sgn;
                        if (rl) v[0][n] = r; }
                }
                bf16_t* rowp = O + (size_t)row * NPROJ + col0;
#pragma unroll
                for (int bj = 0; bj < 2; ++bj) { u32x4 wv; wv.x = cvt_pk_bf16(v[bj][0][0], v[bj][0][1]); wv.y = cvt_pk_bf16(v[bj][0][2], v[bj][0][3]); wv.z = cvt_pk_bf16(v[bj][1][0], v[bj][1][1]); wv.w = cvt_pk_bf16(v[bj][1][2], v[bj][1][3]);
                    *(u32x4*)(rowp + bj * 32) = wv; } }
    }
};
template <int MODE> struct EpiResid {
    static constexpr bool PERM = true, AFTER_DRAIN = true;
    const float* xf; bf16_t* xb; float* outf; float* SS;
    __device__ __forceinline__ void fused(f32x4 (&acc)[2][2][4][2], const Unit& u, int wr, int wc, int fr, int fq, PG8_LAS unsigned char* lds, int wid, int lane) const {
        PG8_LAS float* P = (PG8_LAS float*)lds;
        const int col0 = u.pn * BM + wc * 32 + 8 * fq;
#pragma unroll
        for (int ai = 0; ai < 2; ++ai)
#pragma unroll
            for (int m = 0; m < 4; ++m) { const int r = ai * HALF + wr * 64 + m * 16 + fr; const size_t off = (size_t)(u.pm * BM + r) * DM + col0; float s = 0.f;
#pragma unroll
                for (int bj = 0; bj < 2; ++bj) { f32x4 b0, b1;
                    if (MODE == 0) { b0 = *(const f32x4*)(xf + off + bj * HALF); b1 = *(const f32x4*)(xf + off + bj * HALF + 4); }
                    else { const u32x4 w = *(const u32x4*)(xb + off + bj * HALF);
                        b0 = (f32x4){__uint_as_float(w.x << 16), __uint_as_float(w.x & 0xffff0000u), __uint_as_float(w.y << 16), __uint_as_float(w.y & 0xffff0000u)};
                        b1 = (f32x4){__uint_as_float(w.z << 16), __uint_as_float(w.z & 0xffff0000u), __uint_as_float(w.w << 16), __uint_as_float(w.w & 0xffff0000u)}; }
                    const f32x4 o0 = b0 + acc[ai][bj][m][0], o1 = b1 + acc[ai][bj][m][1];
                    if (MODE == 2) { *(f32x4*)(outf + off + bj * HALF) = o0; *(f32x4*)(outf + off + bj * HALF + 4) = o1; }
                    else { u32x4 w; w.x = cvt_pk_bf16(o0[0], o0[1]); w.y = cvt_pk_bf16(o0[2], o0[3]); w.z = cvt_pk_bf16(o1[0], o1[1]); w.w = cvt_pk_bf16(o1[2], o1[3]); *(u32x4*)(xb + off + bj * HALF) = w;
                        s += ((o0[0] * o0[0] + o0[1] * o0[1]) + (o0[2] * o0[2] + o0[3] * o0[3])) + ((o1[0] * o1[0] + o1[1] * o1[1]) + (o1[2] * o1[2] + o1[3] * o1[3])); } }
                if (MODE != 2) { s += __shfl_xor(s, 16); s += __shfl_xor(s, 32); if (fq == 0) P[r * 4 + wc] = s; }
                if (m & 1) asm volatile("" ::: "memory"); }
        if (MODE != 2) { PG8_LBAR();
            const int t = wid * 64 + lane; if (t < 256) { const f32x4 p = *(const PG8_LAS f32x4*)(P + t * 4); SS[(size_t)(u.pm * BM + t) * 4 + u.pn] = (p[0] + p[1]) + (p[2] + p[3]); } }
    }
};
struct EpiHeadNormK {
    static constexpr bool PERM = true, AFTER_DRAIN = true;
    bf16_t* MKn; const float* kw; const float* qw;
    __device__ __forceinline__ void fused(f32x4 (&acc)[2][2][4][2], const Unit& u, int wr, int wc, int fr, int fq, PG8_LAS unsigned char* lds, int wid, int lane) const {
        PG8_LAS float* P = (PG8_LAS float*)lds; PG8_LAS float* R = (PG8_LAS float*)(lds + 4096);
#pragma unroll
        for (int ai = 0; ai < 2; ++ai)
#pragma unroll
            for (int m = 0; m < 4; ++m) { float s = 0.f;
#pragma unroll
                for (int bj = 0; bj < 2; ++bj)
#pragma unroll
                    for (int n = 0; n < 2; ++n) { const f32x4 v = acc[ai][bj][m][n]; s += (v[0] * v[0] + v[1] * v[1]) + (v[2] * v[2] + v[3] * v[3]); }
                s += __shfl_xor(s, 16); s += __shfl_xor(s, 32); if (fq == 0) P[(ai * HALF + wr * 64 + m * 16 + fr) * 4 + wc] = s; }
        PG8_LBAR();
        { const int t = wid * 64 + lane; if (t < 256) { const f32x4 p = *(const PG8_LAS f32x4*)(P + t * 4); R[t] = rsqrtf(((p[0] + p[1]) + (p[2] + p[3])) * (1.f / 256.f) + EPS); } }
        PG8_LBAR();
        const int c0 = wc * 32 + 8 * fq; f32x4 g[2][2];
#pragma unroll
        for (int bj = 0; bj < 2; ++bj)
#pragma unroll
            for (int n = 0; n < 2; ++n) { const f32x4 a = *(const f32x4*)(kw + c0 + bj * HALF + 4 * n), b = *(const f32x4*)(qw + c0 + bj * HALF + 4 * n); g[bj][n] = a * b * CM; }
        bf16_t* basep = MKn + (size_t)(u.pm * 4 + u.pn) * 65536;
#pragma unroll
        for (int ai = 0; ai < 2; ++ai)
#pragma unroll
            for (int m = 0; m < 4; ++m) { const int r = ai * HALF + wr * 64 + m * 16 + fr; const float rk = R[r];
#pragma unroll
                for (int bj = 0; bj < 2; ++bj) { const f32x4 v0 = acc[ai][bj][m][0] * rk * g[bj][0], v1 = acc[ai][bj][m][1] * rk * g[bj][1];
                    u32x4 w; w.x = cvt_pk_bf16(v0[0], v0[1]); w.y = cvt_pk_bf16(v0[2], v0[3]); w.z = cvt_pk_bf16(v1[0], v1[1]); w.w = cvt_pk_bf16(v1[2], v1[3]);
                    *(u32x4*)(basep + (size_t)r * 256 + c0 + bj * HALF) = w; } }
    }
};
struct EpiMemQ {
    static constexpr bool PERM = true, AFTER_DRAIN = true;
    bf16_t* MQ; const float* SS; PG8_LAS float* RQ;
    __device__ __forceinline__ void fused(f32x4 (&acc)[2][2][4][2], const Unit& u, int wr, int wc, int fr, int fq, PG8_LAS unsigned char* lds, int wid, int lane) const {
        PG8_LAS float* P = (PG8_LAS float*)lds;
        const int col0 = u.pn * BM + wc * 32 + 8 * fq;
#pragma unroll
        for (int ai = 0; ai < 2; ++ai)
#pragma unroll
            for (int m = 0; m < 4; ++m) { const int r = ai * HALF + wr * 64 + m * 16 + fr; const int row = u.pm * BM + r;
                const f32x4 ss = *(const f32x4*)(SS + (size_t)row * 4); const float rs = rsqrtf(((ss[0] + ss[1]) + (ss[2] + ss[3])) * (1.f / DM) + EPS); float s = 0.f;
#pragma unroll
                for (int bj = 0; bj < 2; ++bj) { const f32x4 v0 = acc[ai][bj][m][0] * rs, v1 = acc[ai][bj][m][1] * rs;
                    s += (v0[0] * v0[0] + v0[1] * v0[1]) + (v0[2] * v0[2] + v0[3] * v0[3]) + (v1[0] * v1[0] + v1[1] * v1[1]) + (v1[2] * v1[2] + v1[3] * v1[3]);
                    u32x4 w; w.x = cvt_pk_bf16(v0[0], v0[1]); w.y = cvt_pk_bf16(v0[2], v0[3]); w.z = cvt_pk_bf16(v1[0], v1[1]); w.w = cvt_pk_bf16(v1[2], v1[3]);
                    *(u32x4*)(MQ + (size_t)row * DM + col0 + bj * HALF) = w; }
                s += __shfl_xor(s, 16); s += __shfl_xor(s, 32); if (fq == 0) P[r * 4 + wc] = s; }
        PG8_LBAR();
        { const int t = wid * 64 + lane; if (t < 256) { const f32x4 p = *(const PG8_LAS f32x4*)(P + t * 4); RQ[t] = rsqrtf(((p[0] + p[1]) + (p[2] + p[3])) * (1.f / 256.f) + EPS); } }
        PG8_LBAR();
    }
};
struct EpiMemS {
    static constexpr bool PERM = true, AFTER_DRAIN = true;
    bf16_t* Pt; int head; const PG8_LAS float* RQ; PG8_LAS float* IL;
    __device__ __forceinline__ void fused(f32x4 (&acc)[2][2][4][2], const Unit& u, int wr, int wc, int fr, int fq, PG8_LAS unsigned char* lds, int wid, int lane) const {
        PG8_LAS float* P = (PG8_LAS float*)lds;
        const int col0 = head * BM + wc * 32 + 8 * fq;
#pragma unroll
        for (int ai = 0; ai < 2; ++ai)
#pragma unroll
            for (int m = 0; m < 4; ++m) { const int r = ai * HALF + wr * 64 + m * 16 + fr; const int row = u.pm * BM + r; const float rq = RQ[r]; float s = 0.f;
#pragma unroll
                for (int bj = 0; bj < 2; ++bj) { f32x4 v0 = acc[ai][bj][m][0] * rq, v1 = acc[ai][bj][m][1] * rq;
#pragma unroll
                    for (int e = 0; e < 4; ++e) { v0[e] = __builtin_amdgcn_exp2f(v0[e]); v1[e] = __builtin_amdgcn_exp2f(v1[e]); }
                    s += (v0[0] + v0[1]) + (v0[2] + v0[3]) + (v1[0] + v1[1]) + (v1[2] + v1[3]);
                    u32x4 w; w.x = cvt_pk_bf16(v0[0], v0[1]); w.y = cvt_pk_bf16(v0[2], v0[3]); w.z = cvt_pk_bf16(v1[0], v1[1]); w.w = cvt_pk_bf16(v1[2], v1[3]);
                    *(u32x4*)(Pt + (size_t)row * DM + col0 + bj * HALF) = w; }
                s += __shfl_xor(s, 16); s += __shfl_xor(s, 32); if (fq == 0) P[r * 4 + wc] = s; }
        PG8_LBAR();
        { const int t = wid * 64 + lane; if (t < 256) { const f32x4 p = *(const PG8_LAS f32x4*)(P + t * 4); IL[t] = 1.0f / ((p[0] + p[1]) + (p[2] + p[3])); } }
        PG8_LBAR();
    }
};
struct EpiMemPV {
    static constexpr bool PERM = true, AFTER_DRAIN = false;
    bf16_t* MO; int head; const PG8_LAS float* IL;
    __device__ __forceinline__ void operator()(const f32x4 (&acc)[2][2][4][2], const Unit& u, int wr, int wc, int fr, int fq) const {
        const int col0 = head * BM + wc * 32 + 8 * fq;
#pragma unroll
        for (int ai = 0; ai < 2; ++ai)
#pragma unroll
            for (int m = 0; m < 4; ++m) { const int r = ai * HALF + wr * 64 + m * 16 + fr; const int row = u.pm * BM + r; const float il = IL[r];
#pragma unroll
                for (int bj = 0; bj < 2; ++bj) { const f32x4 v0 = acc[ai][bj][m][0] * il, v1 = acc[ai][bj][m][1] * il;
                    u32x4 w; w.x = cvt_pk_bf16(v0[0], v0[1]); w.y = cvt_pk_bf16(v0[2], v0[3]); w.z = cvt_pk_bf16(v1[0], v1[1]); w.w = cvt_pk_bf16(v1[2], v1[3]);
                    *(u32x4*)(MO + (size_t)row * DM + col0 + bj * HALF) = w; } }
    }
};

template <class Epi, class Sched, bool ALIGN_EPI = false, bool SP2 = false>
__device__ __forceinline__ void gemm_phase(PG8_LAS unsigned char* lds, const Gemm g, const Sched& S, const Epi& E) {
    const int tid = threadIdx.x, wid = __builtin_amdgcn_readfirstlane(tid >> 6), lane = tid & 63, wr = wid >> 2, wc = wid & 3, fr = lane & 15, fq = lane >> 4;
    const int K = g.K, nt = K / BK;
    unsigned voffA[2], voffB[2];
#pragma unroll
    for (int i = 0; i < 2; ++i) { int R, C; stage_rc(tid * 16 + i * 8192, R, C); const int Rb = Epi::PERM ? ((R & ~31) + perm32(R & 31)) : R;
        voffA[i] = (unsigned)(R * g.lda + C) * 2u; voffB[i] = (unsigned)(Rb * g.ldb + C) * 2u; }
    const size_t kstep = (size_t)(BK * 2);
    const size_t hsA = (size_t)HALF * g.lda * 2, hsB = (size_t)HALF * g.ldb * 2;
    const size_t tsA = 2 * hsA, tsB = 2 * hsB;
    const unsigned ldsw = (unsigned)wid * 1024u;
    const int aoff = lds_byte(wr * 64 + fr, fq * 8), boff = lds_byte(wc * 32 + fr, fq * 8);
#define PG8_SA(b, h) (((b) * 2 + (h)) * HTB)
#define PG8_SB(b, h) ((4 + (b) * 2 + (h)) * HTB)
#define PG8_STAGE(bufoff, gbase, voff) do { _Pragma("unroll") for (int _i = 0; _i < 2; ++_i) \
        __builtin_amdgcn_global_load_lds((const unsigned*)((const char*)(gbase) + (voff)[_i]), (PG8_LAS unsigned*)(lds + (bufoff) + ldsw + _i * 8192), 16, 0, 0); } while (0)
#define PG8_LDA(dst, b, h) do { _Pragma("unroll") for (int m = 0; m < 4; ++m) _Pragma("unroll") for (int k = 0; k < 2; ++k) dst[m][k] = *(const PG8_LAS bf16x8*)(lds + PG8_SA(b, h) + aoff + m * 2048 + k * 1024); } while (0)
#define PG8_LDB(dst, b, h) do { _Pragma("unroll") for (int n = 0; n < 2; ++n) _Pragma("unroll") for (int k = 0; k < 2; ++k) dst[n][k] = *(const PG8_LAS bf16x8*)(lds + PG8_SB(b, h) + boff + n * 2048 + k * 1024); } while (0)
#define PG8_MMA(ai, bj, At, Bt) do { __builtin_amdgcn_s_setprio(1); _Pragma("unroll") for (int m = 0; m < 4; ++m) _Pragma("unroll") for (int n = 0; n < 2; ++n) _Pragma("unroll") for (int k = 0; k < 2; ++k) \
        acc[ai][bj][m][n] = __builtin_amdgcn_mfma_f32_16x16x32_bf16(Bt[n][k], At[m][k], acc[ai][bj][m][n], 0, 0, 0); __builtin_amdgcn_s_setprio(0); } while (0)
#define PG8_WAIT_V(n) asm volatile("s_waitcnt vmcnt(" #n ")" ::: "memory")
#define PG8_WAIT_L(n) asm volatile("s_waitcnt lgkmcnt(" #n ")" ::: "memory")
#define PG8_BAR __builtin_amdgcn_s_barrier()
#define PG8_SCHED __builtin_amdgcn_sched_barrier(0)
    Unit cur, nxt; int ui = 0;
    if (!S.next(0, cur)) return;
    f32x4 acc[2][2][4][2];
#pragma unroll
    for (int a = 0; a < 2; ++a)
#pragma unroll
        for (int b = 0; b < 2; ++b)
#pragma unroll
            for (int m = 0; m < 4; ++m)
#pragma unroll
                for (int n = 0; n < 2; ++n) acc[a][b][m][n] = (f32x4){0.f, 0.f, 0.f, 0.f};
    bf16x8 At[4][2], B0[2][2], B1[2][2];
    const char* cA = (const char*)g.A + (size_t)cur.pm * tsA; const char* cB = (const char*)g.Bt + (size_t)cur.pn * tsB;
    S.a_ready(cur);
    if constexpr (SP2) {
        PG8_STAGE(PG8_SB(0, 0), cB, voffB); PG8_STAGE(PG8_SB(0, 1), cB + hsB, voffB); PG8_STAGE(PG8_SA(0, 0), cA, voffA); PG8_STAGE(PG8_SA(0, 1), cA + hsA, voffA);
        if (wr == 1) PG8_BAR;
        PG8_WAIT_V(2); PG8_BAR;
        PG8_STAGE(PG8_SB(1, 0), cB + kstep, voffB); PG8_STAGE(PG8_SA(1, 0), cA + kstep, voffA); PG8_STAGE(PG8_SB(1, 1), cB + hsB + kstep, voffB);
        PG8_WAIT_V(6); PG8_BAR;
    } else {
        PG8_STAGE(PG8_SB(0, 0), cB, voffB); PG8_STAGE(PG8_SA(0, 0), cA, voffA); PG8_STAGE(PG8_SB(0, 1), cB + hsB, voffB); PG8_STAGE(PG8_SA(0, 1), cA + hsA, voffA);
        if (wr == 1) PG8_BAR;
        PG8_WAIT_V(4); PG8_BAR;
        PG8_STAGE(PG8_SB(1, 0), cB + kstep, voffB); PG8_STAGE(PG8_SA(1, 0), cA + kstep, voffA); PG8_STAGE(PG8_SB(1, 1), cB + hsB + kstep, voffB);
        PG8_WAIT_V(6); PG8_BAR;
    }
    for (;;) {
        const bool has_next = S.next(ui + 1, nxt);
        const char* nA = has_next ? (const char*)g.A + (size_t)nxt.pm * tsA : cA; const char* nB = has_next ? (const char*)g.Bt + (size_t)nxt.pn * tsB : cB;
        for (int t = 0; t < nt; t += 2) {
            const bool last = (t == nt - 2);
            const char* a1 = cA + (size_t)(t + 1) * kstep;
            const char* a2 = last ? nA : cA + (size_t)(t + 2) * kstep; const char* b2 = last ? nB : cB + (size_t)(t + 2) * kstep;
            const char* a3 = a2 + kstep; const char* b3 = b2 + kstep;
            if (last && has_next) S.a_ready(nxt);
            if constexpr (SP2) {
            PG8_LDB(B0, 0, 0); PG8_LDB(B1, 0, 1); PG8_SCHED; PG8_LDA(At, 0, 0); PG8_STAGE(PG8_SA(1, 1), a1 + hsA, voffA);
            PG8_WAIT_V(8); PG8_WAIT_L(0); PG8_BAR; PG8_MMA(0, 0, At, B0); PG8_MMA(0, 1, At, B1); PG8_BAR; PG8_SCHED;
            PG8_LDA(At, 0, 1); PG8_STAGE(PG8_SB(0, 0), b2, voffB); PG8_STAGE(PG8_SB(0, 1), b2 + hsB, voffB); PG8_STAGE(PG8_SA(0, 0), a2, voffA);
            PG8_WAIT_V(8); PG8_WAIT_L(0); PG8_BAR; PG8_MMA(1, 0, At, B0); PG8_MMA(1, 1, At, B1); PG8_BAR; PG8_SCHED;
            PG8_LDB(B0, 1, 0); PG8_LDB(B1, 1, 1); PG8_SCHED; PG8_LDA(At, 1, 0); PG8_STAGE(PG8_SA(0, 1), a2 + hsA, voffA);
            PG8_WAIT_V(8); PG8_WAIT_L(0); PG8_BAR; PG8_MMA(0, 0, At, B0); PG8_MMA(0, 1, At, B1); PG8_BAR; PG8_SCHED;
            PG8_LDA(At, 1, 1); PG8_STAGE(PG8_SB(1, 0), b3, voffB); PG8_STAGE(PG8_SB(1, 1), b3 + hsB, voffB); PG8_STAGE(PG8_SA(1, 0), a3, voffA);
            PG8_WAIT_V(8); PG8_WAIT_L(0); PG8_BAR; PG8_MMA(1, 0, At, B0); PG8_MMA(1, 1, At, B1); PG8_BAR; PG8_SCHED;
            } else {
            PG8_LDB(B0, 0, 0); PG8_SCHED; PG8_LDA(At, 0, 0); PG8_STAGE(PG8_SA(1, 1), a1 + hsA, voffA);
            PG8_WAIT_L(8); PG8_BAR; PG8_WAIT_L(0); PG8_MMA(0, 0, At, B0); PG8_BAR; PG8_SCHED;
            PG8_LDB(B1, 0, 1); PG8_STAGE(PG8_SB(0, 0), b2, voffB);
            PG8_BAR; PG8_WAIT_L(0); PG8_MMA(0, 1, At, B1); PG8_BAR;
            PG8_LDA(At, 0, 1); PG8_STAGE(PG8_SA(0, 0), a2, voffA);
            PG8_BAR; PG8_WAIT_L(0); PG8_MMA(1, 0, At, B0); PG8_BAR; PG8_SCHED;
            PG8_STAGE(PG8_SB(0, 1), b2 + hsB, voffB);
            PG8_WAIT_V(6); PG8_BAR; PG8_MMA(1, 1, At, B1); PG8_BAR;
            PG8_LDB(B0, 1, 0); PG8_SCHED; PG8_LDA(At, 1, 0); PG8_STAGE(PG8_SA(0, 1), a2 + hsA, voffA);
            PG8_WAIT_L(8); PG8_BAR; PG8_WAIT_L(0); PG8_MMA(0, 0, At, B0); PG8_BAR; PG8_SCHED;
            PG8_LDB(B1, 1, 1); PG8_STAGE(PG8_SB(1, 0), b3, voffB);
            PG8_BAR; PG8_WAIT_L(0); PG8_MMA(0, 1, At, B1); PG8_BAR;
            PG8_LDA(At, 1, 1); PG8_STAGE(PG8_SA(1, 0), a3, voffA);
            PG8_BAR; PG8_WAIT_L(0); PG8_MMA(1, 0, At, B0); PG8_BAR; PG8_SCHED;
            PG8_STAGE(PG8_SB(1, 1), b3 + hsB, voffB);
            PG8_WAIT_V(6); PG8_BAR; PG8_MMA(1, 1, At, B1); PG8_BAR;
            }
        }
        if constexpr (ALIGN_EPI) { if (wr == 0) PG8_BAR; }
        if constexpr (!Epi::AFTER_DRAIN) { int fr2 = fr, fq2 = fq; asm volatile("" : "+v"(fr2), "+v"(fq2)); E(acc, cur, wr, wc, fr2, fq2); S.done(cur); }
        if (!has_next) break;
#pragma unroll
        for (int a = 0; a < 2; ++a)
#pragma unroll
            for (int b = 0; b < 2; ++b)
#pragma unroll
                for (int m = 0; m < 4; ++m)
#pragma unroll
                    for (int n = 0; n < 2; ++n) acc[a][b][m][n] = (f32x4){0.f, 0.f, 0.f, 0.f};
        cur = nxt; cA = nA; cB = nB; ++ui;
        if constexpr (ALIGN_EPI) { if (wr == 1) PG8_BAR; }
    }
    PG8_WAIT_V(0);
    if constexpr (!ALIGN_EPI) { if (wr == 0) PG8_BAR; }
    PG8_BAR;
    if constexpr (Epi::AFTER_DRAIN) { int fr2 = fr, fq2 = fq, lane2 = lane; asm volatile("" : "+v"(fr2), "+v"(fq2), "+v"(lane2)); E.fused(acc, cur, wr, wc, fr2, fq2, lds, wid, lane2); S.done(cur); }
#undef PG8_SA
#undef PG8_SB
#undef PG8_STAGE
#undef PG8_LDA
#undef PG8_LDB
#undef PG8_MMA
#undef PG8_WAIT_V
#undef PG8_WAIT_L
#undef PG8_BAR
#undef PG8_SCHED
}}

#define GAS __attribute__((address_space(1)))
#define LAS __attribute__((address_space(3)))
typedef unsigned v4u __attribute__((ext_vector_type(4)));
typedef float f32x4 __attribute__((ext_vector_type(4)));
typedef short bf16x8 __attribute__((ext_vector_type(8)));
typedef GAS unsigned gu32;
typedef GAS unsigned long long gu64;
#define RLX_AGENT __ATOMIC_RELAXED, __HIP_MEMORY_SCOPE_AGENT
#define LDS_WAIT() asm volatile("s_waitcnt lgkmcnt(0)" ::: "memory")
#define VM_WAIT() asm volatile("s_waitcnt vmcnt(0)" ::: "memory")
__device__ __forceinline__ unsigned long long rt() { return __builtin_amdgcn_s_memrealtime(); }
__device__ __forceinline__ unsigned pk2(float lo, float hi) { return (unsigned)f2bf(lo) | ((unsigned)f2bf(hi) << 16); }

#define XB_TMO      128
#define XB_XCNT(j)  (256  + 64 * (j))
#define XB_XSUB(j)  (1280 + 64 * (j))
#define XB_XGEN(j)  (2304 + 64 * (j))
#define XB_TOP      3328
#define XB_TOPGEN   3392
#define XCD_BAR_WORDS 3456
#define XB_SPIN_CAP (1u << 18)

__device__ __forceinline__ unsigned xb_ld(unsigned* p)              { return __hip_atomic_load(p, __ATOMIC_RELAXED, __HIP_MEMORY_SCOPE_AGENT); }
__device__ __forceinline__ unsigned xb_add(unsigned* p, unsigned v) { return __hip_atomic_fetch_add(p, v, __ATOMIC_RELAXED, __HIP_MEMORY_SCOPE_AGENT); }
__device__ __forceinline__ unsigned xb_xcc_id() { return (unsigned)__builtin_amdgcn_s_getreg((3 << 11) | 20) & 0xFu; }
#define XB_SPIN(cond, bar) do { unsigned _sp = 0; while (cond) { __builtin_amdgcn_s_sleep(1); \
    if ((++_sp & 255u) == 0u) { if (xb_ld(&(bar)[XB_TMO])) break; if (_sp > XB_SPIN_CAP) { atomicAdd(&(bar)[XB_TMO], 1u); break; } } } } while (0)

struct XcdBarrier {
    unsigned* bar; unsigned x;
    volatile LAS unsigned* st;
};

__device__ __forceinline__ XcdBarrier xcd_barrier_post(unsigned* bar, volatile LAS unsigned* st) {
    XcdBarrier b; b.bar = bar; b.x = xb_xcc_id(); b.st = st;
    if (threadIdx.x == 0) (void)xb_add(&bar[XB_XCNT(b.x)], 1u);
    return b;
}
__device__ __forceinline__ void xcd_barrier_complete(unsigned* bar, unsigned x, unsigned& nloc, unsigned& nx) {
    const unsigned G = gridDim.x * gridDim.y * gridDim.z;
    unsigned sum, cnt, mine, sp = 0u;
    for (;;) {
        sum = 0u; cnt = 0u; mine = 0u;
#pragma unroll
        for (unsigned j = 0; j < 16; ++j) { const unsigned c = xb_ld(&bar[XB_XCNT(j)]); sum += c; cnt += (c > 0u) ? 1u : 0u; mine = (j == x) ? c : mine; }
        if (sum == G) break;
        __builtin_amdgcn_s_sleep(1);
        if ((++sp & 255u) == 0u) { if (xb_ld(&bar[XB_TMO])) break; if (sp > XB_SPIN_CAP) { atomicAdd(&bar[XB_TMO], 1u); break; } }
    }
    nloc = mine > 0u ? mine : 1u; nx = cnt > 0u ? cnt : 1u;
}

__device__ __forceinline__ void xcd_barrier(const XcdBarrier& b) {
    asm volatile("s_waitcnt vmcnt(0)" ::: "memory");
    __syncthreads();
    if (threadIdx.x == 0) {
        unsigned* bar = b.bar;
        __builtin_amdgcn_s_waitcnt(0);
        unsigned nloc = b.st[0], nx = b.st[1];
        if (nloc == 0u) { xcd_barrier_complete(bar, b.x, nloc, nx); b.st[0] = nloc; b.st[1] = nx; }
        const unsigned old = xb_add(&bar[XB_XSUB(b.x)], 1u);
        const unsigned gen = old / nloc;
        if (old + 1u == (gen + 1u) * nloc) {
            __builtin_amdgcn_fence(__ATOMIC_RELEASE, "agent");
            asm volatile("s_waitcnt vmcnt(0)" ::: "memory");
            const unsigned og = xb_add(&bar[XB_TOP], 1u);
            const unsigned tg = og / nx;
            if (og + 1u == (tg + 1u) * nx) xb_add(&bar[XB_TOPGEN], 1u);
            else XB_SPIN(xb_ld(&bar[XB_TOPGEN]) == tg, bar);
            __builtin_amdgcn_fence(__ATOMIC_ACQUIRE, "agent");
            xb_add(&bar[XB_XGEN(b.x)], 1u);
            asm volatile("s_waitcnt vmcnt(0)" ::: "memory");
        } else {
            XB_SPIN(xb_ld(&bar[XB_XGEN(b.x)]) == gen, bar);
            __builtin_amdgcn_fence(__ATOMIC_ACQUIRE, "agent");
            asm volatile("s_waitcnt vmcnt(0)" ::: "memory");
        }
    }
    __syncthreads();
}
constexpr int NWAVES = 8;
constexpr int RING_OFF = 0, RING_BYTES = 131072;
constexpr int LDSCTL_OFF = RING_BYTES, MISC_OFF = LDSCTL_OFF + 320;
constexpr int LDS_RQ = RING_BYTES + 1024, LDS_IL = RING_BYTES + 2048;
constexpr int LDS_BYTES = 147456;
constexpr int CW_TMO = 0, CW_BAR = 4096;

struct Frame {
    LAS unsigned char* lds; volatile LAS unsigned* MISC; gu32* ctl;
    int tid, lane, wave, vcu, G;
};
struct Args { const void* in[26]; float* out; unsigned char* ws; int ph_lo, ph_hi; };

__device__ __forceinline__ float wave_sum(float v) {
#pragma unroll
    for (int o = 1; o < 64; o <<= 1) v += __shfl_xor(v, o);
    return v;
}
template <bool HEADPERM> __device__ __forceinline__ void p0_transpose_item(const float* W, int ldw, int K, int N, const float* g, bf16_t* WT, LAS float* scr, int item, int lane) {
    const int nblk = N / 32, kb = item / nblk, nb = item % nblk, k0 = 64 * kb, n0 = 32 * nb;
    const int r8 = lane >> 3, c4 = (lane & 7) * 4;
    f32x4 v[8]; float gg[8];
#pragma unroll
    for (int i = 0; i < 8; ++i) { v[i] = *(const GAS f32x4*)(W + (size_t)(k0 + r8 + 8 * i) * ldw + n0 + c4); gg[i] = g ? g[k0 + r8 + 8 * i] : 1.f; }
#pragma unroll
    for (int i = 0; i < 8; ++i) { LAS float* d = scr + (r8 + 8 * i) * 33 + c4; const f32x4 x = v[i] * gg[i]; d[0] = x.x; d[1] = x.y; d[2] = x.z; d[3] = x.w; }
    LDS_WAIT(); asm volatile("" ::: "memory");
    const int c = lane & 7;
#pragma unroll
    for (int j = 0; j < 4; ++j) { const int n = (lane >> 3) + 8 * j; const LAS float* s = scr + (8 * c) * 33 + n;
        v4u o; o.x = pk2(s[0 * 33], s[1 * 33]); o.y = pk2(s[2 * 33], s[3 * 33]); o.z = pk2(s[4 * 33], s[5 * 33]); o.w = pk2(s[6 * 33], s[7 * 33]);
        int nr = n0 + n; if (HEADPERM) { const int l = nr & 255; nr = (nr & ~255) | (((l >> 5) & 1) * 128 + (l >> 6) * 32 + (l & 31)); }
        *(GAS v4u*)(WT + (size_t)nr * K + k0 + 8 * c) = o; }
    LDS_WAIT(); asm volatile("" ::: "memory");
}
template <bool FLOG> __device__ __forceinline__ void rms_rows_to_bf16(int lane, const float* X, bf16_t* O, int m0, int step, int rows, const float* g, const float* win, float* flog) {
    if (m0 >= rows) return;
    f32x4 wf[4][4][2];
    if (FLOG) {
#pragma unroll
        for (int j = 0; j < 4; ++j) { const f32x4 gg = *(const GAS f32x4*)(g + 256 * j + 4 * lane);
#pragma unroll
            for (int e = 0; e < 4; ++e) { const int k = 256 * j + 4 * lane + e; wf[j][e][0] = *(const GAS f32x4*)(win + (size_t)k * INCOLS + NPROJ) * gg[e]; wf[j][e][1] = *(const GAS f32x4*)(win + (size_t)k * INCOLS + NPROJ + 4) * gg[e]; } }
    }
    f32x4 nx[4], nx2[4];
    { const GAS f32x4* xr = (const GAS f32x4*)(X + (size_t)m0 * DM) + lane;
#pragma unroll
      for (int j = 0; j < 4; ++j) nx[j] = xr[64 * j];
      if (m0 + step < rows) { const GAS f32x4* xr2 = (const GAS f32x4*)(X + (size_t)(m0 + step) * DM) + lane;
#pragma unroll
          for (int j = 0; j < 4; ++j) nx2[j] = xr2[64 * j]; } }
    for (int m = m0; m < rows; m += step) {
        f32x4 v[4];
#pragma unroll
        for (int j = 0; j < 4; ++j) { v[j] = nx[j]; nx[j] = nx2[j]; }
        if (m + 2 * step < rows) { const GAS f32x4* xr = (const GAS f32x4*)(X + (size_t)(m + 2 * step) * DM) + lane;
#pragma unroll
            for (int j = 0; j < 4; ++j) nx2[j] = xr[64 * j]; }
        float s2 = 0.f;
#pragma unroll
        for (int j = 0; j < 4; ++j) s2 += (v[j].x * v[j].x + v[j].y * v[j].y) + (v[j].z * v[j].z + v[j].w * v[j].w);
        const float rstd = rsqrtf(wave_sum(s2) * (1.f / DM) + EPS);
        GAS unsigned long long* o8 = (GAS unsigned long long*)(O + (size_t)m * DM) + lane;
#pragma unroll
        for (int j = 0; j < 4; ++j) { v[j] = v[j] * rstd; o8[64 * j] = (unsigned long long)pk2(v[j].x, v[j].y) | ((unsigned long long)pk2(v[j].z, v[j].w) << 32); }
        if (FLOG) {
            f32x4 a0 = {0.f, 0.f, 0.f, 0.f}, a1 = {0.f, 0.f, 0.f, 0.f};
#pragma unroll
            for (int j = 0; j < 4; ++j)
#pragma unroll
                for (int e = 0; e < 4; ++e) { a0 += wf[j][e][0] * v[j][e]; a1 += wf[j][e][1] * v[j][e]; }
#pragma unroll
            for (int e = 0; e < 4; ++e) { a0[e] = wave_sum(a0[e]); a1[e] = wave_sum(a1[e]); }
            if (lane == 0) { *(GAS f32x4*)(flog + (size_t)m * 8) = a0; *(GAS f32x4*)(flog + (size_t)m * 8 + 4) = a1; }
        }
    }
}
__constant__ float INV_FREQ[8] = {1.0f, 0.1939227432012558f, 0.03760603070259094f, 0.007292664609849453f, 0.0014142135623842478f, 0.00027424818836152554f, 5.318296098266728e-05f, 1.0313386155758053e-05f};

struct Ptrs {
    const float *x, *mem; const int* pos; const float *norm_mix_w, *w_in, *b_forget, *dqw, *dkw, *lq1, *lk1, *lq2, *lk2, *subw, *fqw, *fkw, *w_out, *nmq, *nmkv, *w_mq, *w_mkv, *mqw, *mkw, *w_mo, *nmlp, *w_up, *w_dn;
    float* out; float *FLOG, *CUMB, *ROPE, *SS, *QKW;
    bf16_t *WIN, *WOUT, *WQ, *WKV, *WO, *WUP, *WDN, *XB, *HM, *MK, *VT, *MKN, *PROJ, *ATT, *MQ, *MO, *H;
};
__host__ __device__ __forceinline__ Ptrs make_ptrs(const void* const* in, float* out, unsigned char* ws) {
    Ptrs p;
    p.x = (const float*)in[0]; p.mem = (const float*)in[1]; p.pos = (const int*)in[2]; p.norm_mix_w = (const float*)in[3]; p.w_in = (const float*)in[4]; p.b_forget = (const float*)in[5];
    p.dqw = (const float*)in[6]; p.dkw = (const float*)in[7]; p.lq1 = (const float*)in[8]; p.lk1 = (const float*)in[9]; p.lq2 = (const float*)in[10]; p.lk2 = (const float*)in[11];
    p.subw = (const float*)in[12]; p.fqw = (const float*)in[13]; p.fkw = (const float*)in[14]; p.w_out = (const float*)in[15]; p.nmq = (const float*)in[16]; p.nmkv = (const float*)in[17];
    p.w_mq = (const float*)in[18]; p.w_mkv = (const float*)in[19]; p.mqw = (const float*)in[20]; p.mkw = (const float*)in[21]; p.w_mo = (const float*)in[22]; p.nmlp = (const float*)in[23];
    p.w_up = (const float*)in[24]; p.w_dn = (const float*)in[25]; p.out = out;
    p.FLOG = (float*)(ws + WS_FLOG); p.CUMB = (float*)(ws + WS_CUMB); p.ROPE = (float*)(ws + WS_ROPE); p.SS = (float*)(ws + WS_SS); p.QKW = (float*)(ws + WS_QKW);
    p.WIN = (bf16_t*)(ws + WS_WIN); p.WOUT = (bf16_t*)(ws + WS_WOUT); p.WQ = (bf16_t*)(ws + WS_WQ); p.WKV = (bf16_t*)(ws + WS_WKV); p.WO = (bf16_t*)(ws + WS_WO); p.WUP = (bf16_t*)(ws + WS_WUP); p.WDN = (bf16_t*)(ws + WS_WDN);
    p.XB = (bf16_t*)(ws + WS_XB); p.HM = (bf16_t*)(ws + WS_HM); p.MK = (bf16_t*)(ws + WS_MK); p.VT = (bf16_t*)(ws + WS_VT); p.MKN = (bf16_t*)(ws + WS_MKN);
    p.PROJ = (bf16_t*)(ws + WS_PROJ); p.ATT = (bf16_t*)(ws + WS_ATT); p.MQ = (bf16_t*)(ws + WS_MQ); p.MO = (bf16_t*)(ws + WS_MO); p.H = (bf16_t*)(ws + WS_H);
    return p;
}

__device__ __forceinline__ void p0_prologue(Frame& F, const Ptrs& P) {
    LAS float* scr = (LAS float*)(F.lds + RING_OFF + F.wave * 16384);
    const int gw = F.vcu * NWAVES + F.wave, NGW = F.G * NWAVES;
    constexpr int I_IN = 16 * 96, I_SQ = 16 * 32, I_KV = 16 * 64, I_UP = 16 * 128, I_DN = 64 * 32;
    constexpr int NITEMS = I_IN + 3 * I_SQ + I_KV + I_UP + I_DN;
    for (int it = gw; it < NITEMS; it += NGW) {
        int r = it;
        if (r < I_IN) { p0_transpose_item<true>(P.w_in, INCOLS, DM, NPROJ, P.norm_mix_w, P.WIN, scr, r, F.lane); continue; } r -= I_IN;
        if (r < I_SQ) { p0_transpose_item<false>(P.w_out, DM, DM, DM, nullptr, P.WOUT, scr, r, F.lane); continue; } r -= I_SQ;
        if (r < I_SQ) { p0_transpose_item<false>(P.w_mq, DM, DM, DM, P.nmq, P.WQ, scr, r, F.lane); continue; } r -= I_SQ;
        if (r < I_KV) { p0_transpose_item<false>(P.w_mkv, 2048, DM, 2048, P.nmkv, P.WKV, scr, r, F.lane); continue; } r -= I_KV;
        if (r < I_SQ) { p0_transpose_item<false>(P.w_mo, DM, DM, DM, nullptr, P.WO, scr, r, F.lane); continue; } r -= I_SQ;
        if (r < I_UP) { p0_transpose_item<false>(P.w_up, DFF, DM, DFF, P.nmlp, P.WUP, scr, r, F.lane); continue; } r -= I_UP;
        p0_transpose_item<false>(P.w_dn, DM, DFF, DM, nullptr, P.WDN, scr, r, F.lane);
    }
    rms_rows_to_bf16<true>(F.lane, P.x, P.XB, gw, NGW, MTOK, P.norm_mix_w, P.w_in, P.FLOG);
    rms_rows_to_bf16<false>(F.lane, P.mem, P.HM, gw, NGW, MMEM, nullptr, nullptr, nullptr);
    if (blockIdx.x == 0 && F.tid < 64) { const int t = F.tid; P.QKW[t] = P.dqw[t]; P.QKW[64 + t] = P.dkw[t]; P.QKW[128 + t] = P.fqw[t]; P.QKW[192 + t] = P.fkw[t]; }
    for (int id = (F.vcu * NWAVES * 64) + F.tid; id < MTOK * 8; id += F.G * NWAVES * 64) {
        const int row = id >> 3, i = id & 7;
        const float ang = (float)P.pos[row] * INV_FREQ[i];
        const double a = (double)ang; const double k = rint(a * 0.15915494309189535); const float r = (float)fma(-k, 6.283185307179586, a);
        P.ROPE[(size_t)row * 16 + i] = cosf(r); P.ROPE[(size_t)row * 16 + 8 + i] = sinf(r);
    }
}
__device__ __forceinline__ void p1b_row(bf16_t* PROJ, const float* dqw, const float* dkw, const float* fqw, const float* fkw, const float* ROPE, int row, int lane) {
    const int sg = lane >> 1, hf = lane & 1;
    const int col = (sg < 16 ? sg * 64 : 1536 + (sg - 16) * 64) + hf * 32;
    const float* w = (sg < 8 ? dqw : sg < 16 ? dkw : sg < 24 ? fqw : fkw) + hf * 32;
    const bool rope = (sg < 16) && (hf == 0), isq = (sg < 8) || (sg >= 16 && sg < 24);
    GAS v4u* p = (GAS v4u*)(PROJ + (size_t)row * NPROJ + col);
    const v4u u0 = p[0], u1 = p[1], u2 = p[2], u3 = p[3];
#define UNP_LO(u) (f32x4){__uint_as_float(u.x << 16), __uint_as_float(u.x & 0xffff0000u), __uint_as_float(u.y << 16), __uint_as_float(u.y & 0xffff0000u)}
#define UNP_HI(u) (f32x4){__uint_as_float(u.z << 16), __uint_as_float(u.z & 0xffff0000u), __uint_as_float(u.w << 16), __uint_as_float(u.w & 0xffff0000u)}
    f32x4 v0 = UNP_LO(u0), v1 = UNP_HI(u0), v2 = UNP_LO(u1), v3 = UNP_HI(u1), v4 = UNP_LO(u2), v5 = UNP_HI(u2), v6 = UNP_LO(u3), v7 = UNP_HI(u3);
#undef UNP_LO
#undef UNP_HI
#define SQ4(v) ((v.x * v.x + v.y * v.y) + (v.z * v.z + v.w * v.w))
    float ss = (SQ4(v0) + SQ4(v1)) + (SQ4(v2) + SQ4(v3)) + (SQ4(v4) + SQ4(v5)) + (SQ4(v6) + SQ4(v7));
#undef SQ4
    ss += __shfl_xor(ss, 1);
    const float rstd = rsqrtf(ss * (1.f / 64.f) + EPS);
    const GAS f32x4* wg = (const GAS f32x4*)w;
    v0 = v0 * rstd * wg[0]; v1 = v1 * rstd * wg[1]; v2 = v2 * rstd * wg[2]; v3 = v3 * rstd * wg[3]; v4 = v4 * rstd * wg[4]; v5 = v5 * rstd * wg[5]; v6 = v6 * rstd * wg[6]; v7 = v7 * rstd * wg[7];
    if (rope) {
        const GAS f32x4* rt = (const GAS f32x4*)(ROPE + (size_t)row * 16);
        const f32x4 c0 = rt[0], c1 = rt[1], s0 = rt[2], s1 = rt[3];
        const f32x4 a0 = v0 * c0 - v2 * s0, b0 = v2 * c0 + v0 * s0, a1 = v1 * c1 - v3 * s1, b1 = v3 * c1 + v1 * s1;
        v0 = a0; v2 = b0; v1 = a1; v3 = b1;
    }
    const float sc = isq ? C2 : 1.f;
#define PK4(a, b) (v4u){pk2(a.x * sc, a.y * sc), pk2(a.z * sc, a.w * sc), pk2(b.x * sc, b.y * sc), pk2(b.z * sc, b.w * sc)}
    p[0] = PK4(v0, v1); p[1] = PK4(v2, v3); p[2] = PK4(v4, v5); p[3] = PK4(v6, v7);
#undef PK4
}
__device__ __forceinline__ void p1b_cumsum_wg(const float* FLOG, const float* b_forget, float* CUMB, int seq, int tid, LAS float* scr) {
    const int b = seq >> 3, h = seq & 7, lane = tid & 63, wv = tid >> 6; const float bf = b_forget[h];
    float lf[4]; float run = 0.f;
#pragma unroll
    for (int i = 0; i < 4; ++i) { const float z = FLOG[(size_t)(b * SEQ + tid * 4 + i) * 8 + h] + bf; const float e = __expf(-fabsf(z)); lf[i] = fminf(z, 0.f) - log1pf(e); run += lf[i]; }
    float inc = run;
#pragma unroll
    for (int o = 1; o < 64; o <<= 1) { const float t = __shfl_up(inc, o); if (lane >= o) inc += t; }
    if (lane == 63) scr[wv] = inc;
    __syncthreads();
    float base = 0.f;
#pragma unroll
    for (int w = 0; w < 8; ++w) { const float t = scr[w]; if (w < wv) base += t; }
    float c = base + inc - run;
    f32x4 o;
#pragma unroll
    for (int i = 0; i < 4; ++i) { c += lf[i]; o[i] = -c * LOG2E; }
    *(GAS f32x4*)(CUMB + (size_t)seq * SEQ + tid * 4) = o;
    __syncthreads();
}
__device__ __forceinline__ void p1b_cumsum(const Ptrs& P, int seq, int lane) {
    const int b = seq >> 3, h = seq & 7; const float bf = P.b_forget[h];
    float lf[32]; float run = 0.f;
#pragma unroll
    for (int i = 0; i < 32; ++i) { const float z = P.FLOG[(size_t)(b * SEQ + lane * 32 + i) * 8 + h] + bf;
        const float e = __expf(-fabsf(z)); lf[i] = fminf(z, 0.f) - log1pf(e); run += lf[i]; }
    float inc = run;
#pragma unroll
    for (int o = 1; o < 64; o <<= 1) { const float t = __shfl_up(inc, o); if (lane >= o) inc += t; }
    float c = inc - run;
#pragma unroll
    for (int i = 0; i < 32; ++i) { c += lf[i]; P.CUMB[(size_t)seq * SEQ + lane * 32 + i] = -c * LOG2E; }
}
struct Sched {
    pg8::StaticOrder so; int mode, pm, pn; bool has;
    __device__ __forceinline__ bool next(int i, pg8::Unit& u) const { if (mode == 0) return so.next(i, u); if (i != 0 || !has) return false; u.pm = pm; u.pn = pn; return true; }
    __device__ __forceinline__ void a_ready(const pg8::Unit&) const {}
    __device__ __forceinline__ void done(const pg8::Unit&) const {}
};
__device__ __forceinline__ Sched sched_static(int M, int N, int G, int c) { Sched s; s.so.init(M, N, G, c); s.mode = 0; s.pm = 0; s.pn = 0; s.has = true; return s; }
__device__ __forceinline__ Sched sched_one(int pm, int pn, bool has) { Sched s; s.so.init(256, 256, 1, 0); s.mode = 1; s.pm = pm; s.pn = pn; s.has = has; return s; }

#include <hip/hip_bf16.h>
#include <cmath>
namespace ab {
using bf16=__hip_bfloat16;
using bf16x8=__attribute__((ext_vector_type(8)))short;
using s16x4=__attribute__((ext_vector_type(4)))short;
using f32x16=__attribute__((ext_vector_type(16)))float;
using u32x4=__attribute__((ext_vector_type(4)))unsigned;
using f32x4v=__attribute__((ext_vector_type(4)))float;
constexpr int D=64,PIN=NPROJ;
constexpr int NW=8,QBLK=32,QB=QBLK*NW,KVBLK=64;
__device__ __forceinline__ int crow(int r,int hi){return (r&3)+8*(r>>2)+4*hi;}
#define SBAR() __builtin_amdgcn_sched_barrier(0)
__device__ __forceinline__ void cmask(f32x16&p0,f32x16&p1,int jb,int qrel,int hi){
  const float NEG=-INFINITY; int kb=64*jb+4*hi;
  #pragma unroll
  for(int r=0;r<16;++r){int kv=kb+(r&3)+8*(r>>2); if(kv>qrel)p0[r]=NEG; if(kv+32>qrel)p1[r]=NEG;}
}

__device__ __forceinline__ void kmask(f32x16&p0,f32x16&p1,int jb,int wid){
  if(jb>(wid>>1)){const float NEG=-INFINITY;
  #pragma unroll
  for(int r=0;r<16;++r){p0[r]=NEG;p1[r]=NEG;}}
}

constexpr int NSLOT=3, SLOTB=8192;
constexpr int LDS_K=0, LDS_V=NSLOT*SLOTB, LDS_WS=2*NSLOT*SLOTB, LDS_OST=LDS_WS+NW*64*4, LDS_BIAS=LDS_OST+NW*4096, LDS_BYTES=LDS_BIAS+8192;
__device__ __forceinline__ void glds16(const void*gsrc,unsigned lds_dst){unsigned keep;
  asm volatile("s_mov_b32 %0, m0\n\ts_mov_b32 m0, %2\n\ts_nop 0\n\tglobal_load_lds_dwordx4 %1, off\n\ts_mov_b32 m0, %0":"=&s"(keep):"v"(gsrc),"s"(lds_dst):"memory");}
__device__ __forceinline__ float max3f(float a,float b,float c){float r;asm("v_max3_f32 %0, %1, %2, %3":"=v"(r):"v"(a),"v"(b),"v"(c));return r;}
__device__ __forceinline__ float max2f(float a,float b){float r;asm("v_max_f32_e32 %0, %1, %2":"=v"(r):"v"(a),"v"(b));return r;}
__device__ __forceinline__ float fadd_s(float a,float b){float r;asm("v_add_f32_e32 %0, %1, %2":"=v"(r):"v"(a),"v"(b));return r;}
__device__ __forceinline__ float fsub_s(float a,float b){float r;asm("v_sub_f32_e32 %0, %1, %2":"=v"(r):"v"(a),"v"(b));return r;}
typedef float f32x2_t __attribute__((ext_vector_type(2))); typedef __bf16 bf16x2_t __attribute__((ext_vector_type(2)));
__device__ __forceinline__ unsigned cvtpk_s(float lo,float hi){f32x2_t v={lo,hi};bf16x2_t b=__builtin_convertvector(v,bf16x2_t);return __builtin_bit_cast(unsigned,b);}
#define WAIT_BAR(N) asm volatile("s_waitcnt vmcnt(" #N ") lgkmcnt(0)\n\ts_barrier":::"memory")

__device__ __forceinline__ void qkt(f32x16&p0,f32x16&p1,const char*Kslot,const bf16x8*qr,const f32x16&negm,int r32,int hi){
  const char*kb=Kslot+hi*1024+r32*16;
  #pragma unroll
  for(int d0=0;d0<4;++d0){
    const bf16x8 b0=*reinterpret_cast<const bf16x8*>(kb+d0*2048);
    const bf16x8 b1=*reinterpret_cast<const bf16x8*>(kb+d0*2048+512);
    if(d0==0){p0=__builtin_amdgcn_mfma_f32_32x32x16_bf16(b0,qr[0],negm,0,0,0);p1=__builtin_amdgcn_mfma_f32_32x32x16_bf16(b1,qr[0],negm,0,0,0);}
    else{p0=__builtin_amdgcn_mfma_f32_32x32x16_bf16(b0,qr[d0],p0,0,0,0);p1=__builtin_amdgcn_mfma_f32_32x32x16_bf16(b1,qr[d0],p1,0,0,0);}}
}
typedef __attribute__((address_space(3))) const char* lds_cptr;
typedef short v4i16_t __attribute__((ext_vector_type(4)));
__device__ __forceinline__ void kload8(bf16x8*kf,lds_cptr kp){
  kf[0]=*(const __attribute__((address_space(3))) bf16x8*)(kp);      kf[1]=*(const __attribute__((address_space(3))) bf16x8*)(kp+512);
  kf[2]=*(const __attribute__((address_space(3))) bf16x8*)(kp+2048); kf[3]=*(const __attribute__((address_space(3))) bf16x8*)(kp+2560);
  kf[4]=*(const __attribute__((address_space(3))) bf16x8*)(kp+4096); kf[5]=*(const __attribute__((address_space(3))) bf16x8*)(kp+4608);
  kf[6]=*(const __attribute__((address_space(3))) bf16x8*)(kp+6144); kf[7]=*(const __attribute__((address_space(3))) bf16x8*)(kp+6656);
}
__device__ __forceinline__ void kload2(bf16x8*kf,lds_cptr kp,int j){ kf[2*j]=*(const __attribute__((address_space(3))) bf16x8*)(kp+j*2048); kf[2*j+1]=*(const __attribute__((address_space(3))) bf16x8*)(kp+j*2048+512); }
__device__ __forceinline__ s16x4 vtr(lds_cptr p){ return __builtin_bit_cast(s16x4,__builtin_amdgcn_ds_read_tr16_b64_v4i16((__attribute__((address_space(3))) v4i16_t*)p)); }
__device__ __forceinline__ float rowmax(const f32x16&p0,const f32x16&p1){
  float a=max3f(p0[0],p0[1],p1[0]),b=max3f(p0[2],p0[3],p1[1]);a=max3f(a,p1[2],p1[3]);
  #pragma unroll
  for(int r=4;r<16;r+=4){a=max3f(a,p0[r],p0[r+1]);b=max3f(b,p0[r+2],p0[r+3]);a=max3f(a,p1[r],p1[r+1]);b=max3f(b,p1[r+2],p1[r+3]);}
  const float m=max2f(a,b);
  auto rr=__builtin_amdgcn_permlane32_swap(__float_as_uint(m),__float_as_uint(m),false,false);
  return max2f(__uint_as_float(rr[0]),__uint_as_float(rr[1]));
}
__device__ __forceinline__ void pv(f32x16*o,int vb,bf16x8 pa0,bf16x8 pa1,bf16x8 pa2,bf16x8 pa3){
  #pragma unroll
  for(int d0=0;d0<2;++d0){s16x4 lo[4],hi[4];
    #pragma unroll
    for(int ks=0;ks<4;++ks){
      asm volatile("ds_read_b64_tr_b16 %0,%1 offset:%c2":"=&v"(lo[ks]):"v"(vb),"i"(d0*4096+ks*1024):"memory");
      asm volatile("ds_read_b64_tr_b16 %0,%1 offset:%c2":"=&v"(hi[ks]):"v"(vb),"i"(d0*4096+ks*1024+512):"memory");}
    asm volatile("s_waitcnt lgkmcnt(0)":::"memory");SBAR();
    #define PK(k) (bf16x8){lo[k][0],lo[k][1],lo[k][2],lo[k][3],hi[k][0],hi[k][1],hi[k][2],hi[k][3]}
    o[d0]=__builtin_amdgcn_mfma_f32_32x32x16_bf16(pa0,PK(0),o[d0],0,0,0);
    o[d0]=__builtin_amdgcn_mfma_f32_32x32x16_bf16(pa1,PK(1),o[d0],0,0,0);
    o[d0]=__builtin_amdgcn_mfma_f32_32x32x16_bf16(pa2,PK(2),o[d0],0,0,0);
    o[d0]=__builtin_amdgcn_mfma_f32_32x32x16_bf16(pa3,PK(3),o[d0],0,0,0);
    #undef PK
  }
}

#ifndef ATTN_STORE16
#define ATTN_STORE16(p,v) (*(u32x4*)(p)=(v))
#endif
template<int THRL,int MASK,bool BIAS> __device__ __forceinline__ void attn_unit(int qb,const bf16*Qh,const bf16*__restrict__ Kh,const bf16*__restrict__ Vh,bf16*Oh,int opitch,const float*__restrict__ biasg,char*shm){
  int tid_=threadIdx.x; asm volatile("":"+v"(tid_));
  const int tid=tid_,lane=tid&63,r32=lane&31,hi=lane>>5; const int wid=__builtin_amdgcn_readfirstlane(tid>>6);
  const int q0=qb*QB;
  const bf16*Qw=Qh+(long)(q0+wid*QBLK)*PIN;
  const unsigned lds0=(unsigned)(uintptr_t)shm;
  float*wsf=(float*)(shm+LDS_WS)+wid*64;
  const bf16*ksrc=Kh+(long)lane*PIN+wid*8;
  const bf16*vsrc=Vh+(long)(16*(wid&3)+(lane>>2))*PIN+(wid>>2)*32+(lane&3)*8;
  const unsigned kdst=lds0+LDS_K+wid*1024, vdst=lds0+LDS_V+wid*1024;
  #define DMA_K(t,slot) glds16(ksrc+(long)(t)*KVBLK*PIN,(unsigned)__builtin_amdgcn_readfirstlane(kdst+(slot)))
  #define DMA_V(t,slot) glds16(vsrc+(long)(t)*KVBLK*PIN,(unsigned)__builtin_amdgcn_readfirstlane(vdst+(slot)))
  const int vb0=(int)(lds0+LDS_V)+((lane>>4)&1)*32+(lane&3)*8+(4*hi+((lane&15)>>2))*64;
  const char*Kbase=shm+LDS_K; bf16x8 kf[8];
  const lds_cptr shm3=(lds_cptr)shm; const lds_cptr kp0=shm3+LDS_K+hi*1024+r32*16; const lds_cptr vp0=shm3+LDS_V+((lane>>4)&1)*32+(lane&3)*8+(4*hi+((lane&15)>>2))*64;
  const int NT=(q0+QB)/KVBLK;
  DMA_K(0,0);DMA_V(0,0);DMA_K(1,SLOTB);
  const float*biasl=(const float*)(shm+LDS_BIAS);
  if(BIAS){ int t2=tid; asm volatile("":"+v"(t2)); if(t2<NT*16){ const f32x4v bv=*reinterpret_cast<const f32x4v*>(biasg+t2*4); *reinterpret_cast<f32x4v*>(shm+LDS_BIAS+t2*16)=bv; } }
  bf16x8 qr[4];
  #pragma unroll
  for(int d0=0;d0<4;++d0)qr[d0]=*reinterpret_cast<const bf16x8*>(&Qw[(long)r32*PIN+d0*16+hi*8]);
  float mhat=0.f,l_reg=0.f;f32x16 o[2];o[0]=f32x16{};o[1]=f32x16{};f32x16 negm=f32x16{}; if(!BIAS){asm volatile("":"+v"(negm));}
  #define CIN (BIAS?f32x16{}:negm)
  const int qrel=wid*QBLK+r32;
  #define CMASK(P0,P1,t) do{int jb_=(t)-(NT-4); if(jb_>=0){ if(MASK==0)cmask(P0,P1,jb_,qrel,hi); else kmask(P0,P1,jb_,wid); } }while(0)
  #define BIASADD(P0,P1,t) do{ if(BIAS){ const float*bp_=biasl+64*(t)+4*hi; \
    _Pragma("unroll") for(int g_=0;g_<4;++g_){ const f32x4v a_=*reinterpret_cast<const f32x4v*>(bp_+8*g_)-mhat, b_=*reinterpret_cast<const f32x4v*>(bp_+32+8*g_)-mhat; \
      _Pragma("unroll") for(int e_=0;e_<4;++e_){ P0[4*g_+e_]+=a_[e_]; P1[4*g_+e_]+=b_[e_]; } if(g_&1){SBAR();} } } }while(0)
  bool resc=false;
  #define START(P0,P1) do{ const float rm=rowmax(P0,P1); resc=false; \
    { const float dl=rm; mhat=fadd_s(mhat,dl); \
      _Pragma("unroll") for(int r=0;r<16;++r){P0[r]=fsub_s(P0[r],dl);P1[r]=fsub_s(P1[r],dl);} \
      if(!BIAS){ _Pragma("unroll") for(int r=0;r<16;++r)negm[r]=-mhat; asm volatile("":"+v"(negm)); } } \
    _Pragma("unroll") for(int r=0;r<16;++r)P0[r]=__builtin_amdgcn_exp2f(P0[r]); }while(0)
  #define RESC() do{ if(resc){ asm volatile("s_waitcnt lgkmcnt(0)":::"memory"); \
      _Pragma("unroll") for(int d_=0;d_<2;++d_) _Pragma("unroll") for(int r=0;r<16;++r)o[d_][r]*=wsf[crow(r,hi)]; } }while(0)
  f32x16 pA0,pA1,pB0,pB1;
  int sl_prev=0,sl_cur=0,sl_next=SLOTB;
  #define ROT() do{sl_prev=sl_cur;sl_cur=sl_next;sl_next=(sl_next==(NSLOT-1)*SLOTB)?0:sl_next+SLOTB;}while(0)
  DMA_K(2,2*SLOTB);
  WAIT_BAR(3);
  qkt(pA0,pA1,Kbase,qr,CIN,r32,hi);asm volatile("s_nop 15\n\ts_nop 7":"+v"(pA0),"+v"(pA1));BIASADD(pA0,pA1,0);CMASK(pA0,pA1,0);
  START(pA0,pA1);
  _Pragma("unroll") for(int r=0;r<16;++r)pA1[r]=__builtin_amdgcn_exp2f(pA1[r]);
  WAIT_BAR(0);
  DMA_K(3,0);DMA_V(1,SLOTB);
  ROT();
  kload8(kf,kp0+sl_cur);
  WAIT_BAR(2);
  s16x4 vlo[8],vhi[8]; u32x4 pw0,pw1,pw2,pw3;
  #define PKW(P,B) cvtpk_s(P[B],P[B+1])
  #define PAF(k) __builtin_bit_cast(bf16x8,pw##k)
  #define VFR(i) (bf16x8){vlo[i][0],vlo[i][1],vlo[i][2],vlo[i][3],vhi[i][0],vhi[i][1],vhi[i][2],vhi[i][3]}
  #define PIN(x) asm volatile("":"+v"(x))
  #define MX3(a,b,c) __builtin_fmaxf(__builtin_fmaxf((a),(b)),(c))
  #define GAPA(MF,A0,A1,A2,A3,W0,W1,PW) do{ MF; sacc+=A0; sacc+=A1; sacc+=A2; sacc+=A3; PIN(sacc); W0; W1; PIN(PW); SBAR(); }while(0)
  #define EX(v) __builtin_amdgcn_exp2f(v)
  #define GAPB(MF,X,B) do{ MF; X[B]=EX(X[B]); X[B+1]=EX(X[B+1]); X[B+2]=EX(X[B+2]); X[B+3]=EX(X[B+3]); PIN(X); SBAR(); }while(0)
  #define VRD(i) do{ vlo[i]=vtr(vp_+(((i)>>2)*4096+((i)&3)*1024)); vhi[i]=vtr(vp_+(((i)>>2)*4096+((i)&3)*1024+512)); }while(0)
  #define KRD(G,j) do{ if(G){ kload2(kf,kp0+sl_next,j); SBAR(); } }while(0)
  #define STEP(C0,C1,P0,P1,t,GK,GV,GL) do{ SBAR(); \
    const lds_cptr vp_=vp0+sl_prev; \
    VRD(0); SBAR(); float sacc=(P0[0]+P0[1]); \
    GAPA(C0=__builtin_amdgcn_mfma_f32_32x32x16_bf16(kf[0],qr[0],CIN,0,0,0), P0[2],P0[3],P0[4],P0[5],     pw0[0]=PKW(P0,0), pw0[1]=PKW(P0,2), pw0); \
    VRD(4); SBAR(); GAPA(C1=__builtin_amdgcn_mfma_f32_32x32x16_bf16(kf[1],qr[0],CIN,0,0,0), P0[6],P0[7],P0[8],P0[9],     pw0[2]=PKW(P0,4), pw0[3]=PKW(P0,6), pw0); \
    VRD(1); SBAR(); GAPA(C0=__builtin_amdgcn_mfma_f32_32x32x16_bf16(kf[2],qr[1],C0,0,0,0),   P0[10],P0[11],P0[12],P0[13], pw1[0]=PKW(P0,8), pw1[1]=PKW(P0,10), pw1); \
    VRD(5); SBAR(); GAPA(C1=__builtin_amdgcn_mfma_f32_32x32x16_bf16(kf[3],qr[1],C1,0,0,0),   P0[14],P0[15],P1[0],P1[1],   pw1[2]=PKW(P0,12),pw1[3]=PKW(P0,14), pw1); \
    VRD(2); SBAR(); GAPA(C0=__builtin_amdgcn_mfma_f32_32x32x16_bf16(kf[4],qr[2],C0,0,0,0),   P1[2],P1[3],P1[4],P1[5],     pw2[0]=PKW(P1,0), pw2[1]=PKW(P1,2), pw2); \
    VRD(6); SBAR(); GAPA(C1=__builtin_amdgcn_mfma_f32_32x32x16_bf16(kf[5],qr[2],C1,0,0,0),   P1[6],P1[7],P1[8],P1[9],     pw2[2]=PKW(P1,4), pw2[3]=PKW(P1,6), pw2); \
    VRD(3); SBAR(); GAPA(C0=__builtin_amdgcn_mfma_f32_32x32x16_bf16(kf[6],qr[3],C0,0,0,0),   P1[10],P1[11],P1[12],P1[13], pw3[0]=PKW(P1,8), pw3[1]=PKW(P1,10), pw3); \
    VRD(7); SBAR(); GAPA(C1=__builtin_amdgcn_mfma_f32_32x32x16_bf16(kf[7],qr[3],C1,0,0,0),   P1[14],P1[15],0.f,0.f,       pw3[2]=PKW(P1,12),pw3[3]=PKW(P1,14), pw3); \
    l_reg+=sacc; \
    if(GK){DMA_K((t)+3,sl_cur);} if(GV){DMA_V((t)+1,sl_next);} \
    BIASADD(C0,C1,t); CMASK(C0,C1,t); \
    { float a=MX3(C0[0],C0[1],C1[0]),b=MX3(C0[2],C0[3],C1[1]); a=MX3(a,C1[2],C1[3]); \
      _Pragma("unroll") for(int r=4;r<16;r+=4){a=MX3(a,C0[r],C0[r+1]);b=MX3(b,C0[r+2],C0[r+3]);a=MX3(a,C1[r],C1[r+1]);b=MX3(b,C1[r+2],C1[r+3]);} \
      float rm=__builtin_fmaxf(a,b); { auto rr=__builtin_amdgcn_permlane32_swap(__float_as_uint(rm),__float_as_uint(rm),false,false); rm=__builtin_fmaxf(__uint_as_float(rr[0]),__uint_as_float(rr[1])); } \
      resc=false; \
      if(__builtin_expect(__any(rm>(float)THRL),0)){ const float dl=__builtin_fmaxf(rm,0.f); mhat+=dl; \
        _Pragma("unroll") for(int r=0;r<16;++r){C0[r]-=dl;C1[r]-=dl;} \
        if(!BIAS){ _Pragma("unroll") for(int r=0;r<16;++r)negm[r]=-mhat; asm volatile("":"+v"(negm)); } \
        const float f=__builtin_amdgcn_exp2f(-dl); l_reg*=f; if(hi==0)wsf[r32]=f; resc=true; } } \
    SBAR(); \
    GAPB(o[0]=__builtin_amdgcn_mfma_f32_32x32x16_bf16(PAF(0),VFR(0),o[0],0,0,0), C0,0); \
    GAPB(o[1]=__builtin_amdgcn_mfma_f32_32x32x16_bf16(PAF(0),VFR(4),o[1],0,0,0), C0,4); \
    KRD(GL,0); GAPB(o[0]=__builtin_amdgcn_mfma_f32_32x32x16_bf16(PAF(1),VFR(1),o[0],0,0,0), C0,8); \
    KRD(GL,1); GAPB(o[1]=__builtin_amdgcn_mfma_f32_32x32x16_bf16(PAF(1),VFR(5),o[1],0,0,0), C0,12); \
    KRD(GL,2); GAPB(o[0]=__builtin_amdgcn_mfma_f32_32x32x16_bf16(PAF(2),VFR(2),o[0],0,0,0), C1,0); \
    KRD(GL,3); GAPB(o[1]=__builtin_amdgcn_mfma_f32_32x32x16_bf16(PAF(2),VFR(6),o[1],0,0,0), C1,4); \
    GAPB(o[0]=__builtin_amdgcn_mfma_f32_32x32x16_bf16(PAF(3),VFR(3),o[0],0,0,0), C1,8); \
    GAPB(o[1]=__builtin_amdgcn_mfma_f32_32x32x16_bf16(PAF(3),VFR(7),o[1],0,0,0), C1,12); \
    }while(0)
  int t=1;
  #undef CMASK
  #define CMASK(P0,P1,t) do{}while(0)
  for(;t+5<NT;t+=2){
    STEP(pB0,pB1,pA0,pA1,t,true,true,true);     WAIT_BAR(2); RESC(); ROT();
    STEP(pA0,pA1,pB0,pB1,t+1,true,true,true);   WAIT_BAR(2); RESC(); ROT();
  }
  #undef CMASK
  #define CMASK(P0,P1,t) do{int jb_=(t)-(NT-4); if(jb_>=0){ if(MASK==0)cmask(P0,P1,jb_,qrel,hi); else kmask(P0,P1,jb_,wid); } }while(0)
  #define ENDW(tt) do{ if((tt)+3<NT){WAIT_BAR(2);} else if((tt)+2<NT){WAIT_BAR(1);} else {WAIT_BAR(0);} }while(0)
  for(;t+1<NT;t+=2){
    STEP(pB0,pB1,pA0,pA1,t,(t+3<NT),(t+1<NT),(t+1<NT));       ENDW(t);   RESC(); ROT();
    STEP(pA0,pA1,pB0,pB1,t+1,(t+4<NT),(t+2<NT),(t+2<NT));     ENDW(t+1); RESC(); ROT();
  }
  STEP(pB0,pB1,pA0,pA1,NT-1,false,false,false); RESC();
  { float sacc=pB0[0]+pB0[1]; _Pragma("unroll") for(int r=2;r<16;++r)sacc+=pB0[r]; _Pragma("unroll") for(int r=0;r<16;++r)sacc+=pB1[r]; l_reg+=sacc;
    pw0=(u32x4){PKW(pB0,0),PKW(pB0,2),PKW(pB0,4),PKW(pB0,6)};pw1=(u32x4){PKW(pB0,8),PKW(pB0,10),PKW(pB0,12),PKW(pB0,14)};pw2=(u32x4){PKW(pB1,0),PKW(pB1,2),PKW(pB1,4),PKW(pB1,6)};pw3=(u32x4){PKW(pB1,8),PKW(pB1,10),PKW(pB1,12),PKW(pB1,14)};
    SBAR(); pv(o,vb0+sl_cur,PAF(0),PAF(1),PAF(2),PAF(3)); }
  #undef PKW
  #undef PAF
  #undef VFR
  #undef PIN
  #undef MX3
  #undef GAPA
  #undef GAPB
  #undef EX
  #undef VRD
  #undef KRD
  #undef STEP
  #undef ENDW
  {auto rr=__builtin_amdgcn_permlane32_swap(__float_as_uint(l_reg),__float_as_uint(l_reg),false,false);l_reg=__uint_as_float(rr[0])+__uint_as_float(rr[1]);}
  if(hi==0)wsf[32+r32]=l_reg;asm volatile("s_waitcnt lgkmcnt(0)":::"memory");
  float rli[16];
  #pragma unroll
  for(int r=0;r<16;++r)rli[r]=__builtin_amdgcn_rcpf(wsf[32+crow(r,hi)]);
  bf16*Ow=Oh+(long)(q0+wid*QBLK)*opitch;
  { bf16*stg=(bf16*)(shm+LDS_OST)+wid*2048;
    #pragma unroll
    for(int r=0;r<16;++r){const int orow=crow(r,hi);
      #pragma unroll
      for(int d0=0;d0<2;++d0)stg[orow*64+d0*32+r32]=__float2bfloat16(o[d0][r]*rli[r]);}
    asm volatile("s_waitcnt lgkmcnt(0)":::"memory");
    #pragma unroll
    for(int i=0;i<4;++i){const int row=i*8+(lane>>3),ch=lane&7; const u32x4 v=*(const u32x4*)(stg+row*64+ch*8); ATTN_STORE16(Ow+(long)row*opitch+ch*8,v);} }
  asm volatile("s_waitcnt lgkmcnt(0)\n\ts_barrier":::"memory");
  #undef DMA_K
  #undef DMA_V
  #undef CMASK
  #undef CIN
  #undef BIASADD
  #undef START
  #undef RESC
  #undef ROT
}
constexpr int ATTN_LDS_BYTES=LDS_BYTES;
#undef SBAR
#undef WAIT_BAR
}
__constant__ unsigned short UNIT_TAB[256][8] = {
  {0x8007,0x8002,0x0003,0x0001,0xffff,0xffff,0xffff,0xffff},
  {0x8027,0x8022,0x0043,0x0041,0xffff,0xffff,0xffff,0xffff},
  {0x8047,0x8042,0x0083,0x0081,0xffff,0xffff,0xffff,0xffff},
  {0x8067,0x8062,0x00c3,0x00c1,0xffff,0xffff,0xffff,0xffff},
  {0x8087,0x8082,0x0103,0x0101,0xffff,0xffff,0xffff,0xffff},
  {0x80a7,0x80a2,0x0143,0x0141,0xffff,0xffff,0xffff,0xffff},
  {0x80c7,0x80c2,0x0183,0x0181,0xffff,0xffff,0xffff,0xffff},
  {0x80e7,0x80e2,0x01c3,0x01c1,0xffff,0xffff,0xffff,0xffff},
  {0x8107,0x8102,0x000b,0x0009,0xffff,0xffff,0xffff,0xffff},
  {0x8127,0x8122,0x004b,0x0049,0xffff,0xffff,0xffff,0xffff},
  {0x8147,0x8142,0x008b,0x0089,0xffff,0xffff,0xffff,0xffff},
  {0x8167,0x8162,0x00cb,0x00c9,0xffff,0xffff,0xffff,0xffff},
  {0x8187,0x8182,0x010b,0x0109,0xffff,0xffff,0xffff,0xffff},
  {0x81a7,0x81a2,0x014b,0x0149,0xffff,0xffff,0xffff,0xffff},
  {0x81c7,0x81c2,0x018b,0x0189,0xffff,0xffff,0xffff,0xffff},
  {0x81e7,0x81e2,0x01cb,0x01c9,0xffff,0xffff,0xffff,0xffff},
  {0x800f,0x800a,0x0013,0x0011,0xffff,0xffff,0xffff,0xffff},
  {0x802f,0x802a,0x0053,0x0051,0xffff,0xffff,0xffff,0xffff},
  {0x804f,0x804a,0x0093,0x0091,0xffff,0xffff,0xffff,0xffff},
  {0x806f,0x806a,0x00d3,0x00d1,0xffff,0xffff,0xffff,0xffff},
  {0x808f,0x808a,0x0113,0x0111,0xffff,0xffff,0xffff,0xffff},
  {0x80af,0x80aa,0x0153,0x0151,0xffff,0xffff,0xffff,0xffff},
  {0x80cf,0x80ca,0x0193,0x0191,0xffff,0xffff,0xffff,0xffff},
  {0x80ef,0x80ea,0x01d3,0x01d1,0xffff,0xffff,0xffff,0xffff},
  {0x810f,0x810a,0x001b,0x0019,0xffff,0xffff,0xffff,0xffff},
  {0x812f,0x812a,0x005b,0x0059,0xffff,0xffff,0xffff,0xffff},
  {0x814f,0x814a,0x009b,0x0099,0xffff,0xffff,0xffff,0xffff},
  {0x816f,0x816a,0x00db,0x00d9,0xffff,0xffff,0xffff,0xffff},
  {0x818f,0x818a,0x011b,0x0119,0xffff,0xffff,0xffff,0xffff},
  {0x81af,0x81aa,0x015b,0x0159,0xffff,0xffff,0xffff,0xffff},
  {0x81cf,0x81ca,0x019b,0x0199,0xffff,0xffff,0xffff,0xffff},
  {0x81ef,0x81ea,0x01db,0x01d9,0xffff,0xffff,0xffff,0xffff},
  {0x8017,0x8012,0x0023,0x0021,0xffff,0xffff,0xffff,0xffff},
  {0x8037,0x8032,0x0063,0x0061,0xffff,0xffff,0xffff,0xffff},
  {0x8057,0x8052,0x00a3,0x00a1,0xffff,0xffff,0xffff,0xffff},
  {0x8077,0x8072,0x00e3,0x00e1,0xffff,0xffff,0xffff,0xffff},
  {0x8097,0x8092,0x0123,0x0121,0xffff,0xffff,0xffff,0xffff},
  {0x80b7,0x80b2,0x0163,0x0161,0xffff,0xffff,0xffff,0xffff},
  {0x80d7,0x80d2,0x01a3,0x01a1,0xffff,0xffff,0xffff,0xffff},
  {0x80f7,0x80f2,0x01e3,0x01e1,0xffff,0xffff,0xffff,0xffff},
  {0x8117,0x8112,0x002b,0x0029,0xffff,0xffff,0xffff,0xffff},
  {0x8137,0x8132,0x006b,0x0069,0xffff,0xffff,0xffff,0xffff},
  {0x8157,0x8152,0x00ab,0x00a9,0xffff,0xffff,0xffff,0xffff},
  {0x8177,0x8172,0x00eb,0x00e9,0xffff,0xffff,0xffff,0xffff},
  {0x8197,0x8192,0x012b,0x0129,0xffff,0xffff,0xffff,0xffff},
  {0x81b7,0x81b2,0x016b,0x0169,0xffff,0xffff,0xffff,0xffff},
  {0x81d7,0x81d2,0x01ab,0x01a9,0xffff,0xffff,0xffff,0xffff},
  {0x81f7,0x81f2,0x01eb,0x01e9,0xffff,0xffff,0xffff,0xffff},
  {0x801f,0x801a,0x0033,0x0031,0xffff,0xffff,0xffff,0xffff},
  {0x803f,0x803a,0x0073,0x0071,0xffff,0xffff,0xffff,0xffff},
  {0x805f,0x805a,0x00b3,0x00b1,0xffff,0xffff,0xffff,0xffff},
  {0x807f,0x807a,0x00f3,0x00f1,0xffff,0xffff,0xffff,0xffff},
  {0x809f,0x809a,0x0133,0x0131,0xffff,0xffff,0xffff,0xffff},
  {0x80bf,0x80ba,0x0173,0x0171,0xffff,0xffff,0xffff,0xffff},
  {0x80df,0x80da,0x01b3,0x01b1,0xffff,0xffff,0xffff,0xffff},
  {0x80ff,0x80fa,0x01f3,0x01f1,0xffff,0xffff,0xffff,0xffff},
  {0x811f,0x811a,0x003b,0x0039,0xffff,0xffff,0xffff,0xffff},
  {0x813f,0x813a,0x007b,0x0079,0xffff,0xffff,0xffff,0xffff},
  {0x815f,0x815a,0x00bb,0x00b9,0xffff,0xffff,0xffff,0xffff},
  {0x817f,0x817a,0x00fb,0x00f9,0xffff,0xffff,0xffff,0xffff},
  {0x819f,0x819a,0x013b,0x0139,0xffff,0xffff,0xffff,0xffff},
  {0x81bf,0x81ba,0x017b,0x0179,0xffff,0xffff,0xffff,0xffff},
  {0x81df,0x81da,0x01bb,0x01b9,0xffff,0xffff,0xffff,0xffff},
  {0x81ff,0x81fa,0x01fb,0x01f9,0xffff,0xffff,0xffff,0xffff},
  {0x8006,0x0006,0x8001,0x8000,0x0000,0xffff,0xffff,0xffff},
  {0x8026,0x0046,0x8021,0x8020,0x0040,0xffff,0xffff,0xffff},
  {0x8046,0x0086,0x8041,0x8040,0x0080,0xffff,0xffff,0xffff},
  {0x8066,0x00c6,0x8061,0x8060,0x00c0,0xffff,0xffff,0xffff},
  {0x8086,0x0106,0x8081,0x8080,0x0100,0xffff,0xffff,0xffff},
  {0x80a6,0x0146,0x80a1,0x80a0,0x0140,0xffff,0xffff,0xffff},
  {0x80c6,0x0186,0x80c1,0x80c0,0x0180,0xffff,0xffff,0xffff},
  {0x80e6,0x01c6,0x80e1,0x80e0,0x01c0,0xffff,0xffff,0xffff},
  {0x8106,0x000e,0x8101,0x8100,0x0008,0xffff,0xffff,0xffff},
  {0x8126,0x004e,0x8121,0x8120,0x0048,0xffff,0xffff,0xffff},
  {0x8146,0x008e,0x8141,0x8140,0x0088,0xffff,0xffff,0xffff},
  {0x8166,0x00ce,0x8161,0x8160,0x00c8,0xffff,0xffff,0xffff},
  {0x8186,0x010e,0x8181,0x8180,0x0108,0xffff,0xffff,0xffff},
  {0x81a6,0x014e,0x81a1,0x81a0,0x0148,0xffff,0xffff,0xffff},
  {0x81c6,0x018e,0x81c1,0x81c0,0x0188,0xffff,0xffff,0xffff},
  {0x81e6,0x01ce,0x81e1,0x81e0,0x01c8,0xffff,0xffff,0xffff},
  {0x800e,0x0016,0x8009,0x8008,0x0010,0xffff,0xffff,0xffff},
  {0x802e,0x0056,0x8029,0x8028,0x0050,0xffff,0xffff,0xffff},
  {0x804e,0x0096,0x8049,0x8048,0x0090,0xffff,0xffff,0xffff},
  {0x806e,0x00d6,0x8069,0x8068,0x00d0,0xffff,0xffff,0xffff},
  {0x808e,0x0116,0x8089,0x8088,0x0110,0xffff,0xffff,0xffff},
  {0x80ae,0x0156,0x80a9,0x80a8,0x0150,0xffff,0xffff,0xffff},
  {0x80ce,0x0196,0x80c9,0x80c8,0x0190,0xffff,0xffff,0xffff},
  {0x80ee,0x01d6,0x80e9,0x80e8,0x01d0,0xffff,0xffff,0xffff},
  {0x810e,0x001e,0x8109,0x8108,0x0018,0xffff,0xffff,0xffff},
  {0x812e,0x005e,0x8129,0x8128,0x0058,0xffff,0xffff,0xffff},
  {0x814e,0x009e,0x8149,0x8148,0x0098,0xffff,0xffff,0xffff},
  {0x816e,0x00de,0x8169,0x8168,0x00d8,0xffff,0xffff,0xffff},
  {0x818e,0x011e,0x8189,0x8188,0x0118,0xffff,0xffff,0xffff},
  {0x81ae,0x015e,0x81a9,0x81a8,0x0158,0xffff,0xffff,0xffff},
  {0x81ce,0x019e,0x81c9,0x81c8,0x0198,0xffff,0xffff,0xffff},
  {0x81ee,0x01de,0x81e9,0x81e8,0x01d8,0xffff,0xffff,0xffff},
  {0x8016,0x0026,0x8011,0x8010,0x0020,0xffff,0xffff,0xffff},
  {0x8036,0x0066,0x8031,0x8030,0x0060,0xffff,0xffff,0xffff},
  {0x8056,0x00a6,0x8051,0x8050,0x00a0,0xffff,0xffff,0xffff},
  {0x8076,0x00e6,0x8071,0x8070,0x00e0,0xffff,0xffff,0xffff},
  {0x8096,0x0126,0x8091,0x8090,0x0120,0xffff,0xffff,0xffff},
  {0x80b6,0x0166,0x80b1,0x80b0,0x0160,0xffff,0xffff,0xffff},
  {0x80d6,0x01a6,0x80d1,0x80d0,0x01a0,0xffff,0xffff,0xffff},
  {0x80f6,0x01e6,0x80f1,0x80f0,0x01e0,0xffff,0xffff,0xffff},
  {0x8116,0x002e,0x8111,0x8110,0x0028,0xffff,0xffff,0xffff},
  {0x8136,0x006e,0x8131,0x8130,0x0068,0xffff,0xffff,0xffff},
  {0x8156,0x00ae,0x8151,0x8150,0x00a8,0xffff,0xffff,0xffff},
  {0x8176,0x00ee,0x8171,0x8170,0x00e8,0xffff,0xffff,0xffff},
  {0x8196,0x012e,0x8191,0x8190,0x0128,0xffff,0xffff,0xffff},
  {0x81b6,0x016e,0x81b1,0x81b0,0x0168,0xffff,0xffff,0xffff},
  {0x81d6,0x01ae,0x81d1,0x81d0,0x01a8,0xffff,0xffff,0xffff},
  {0x81f6,0x01ee,0x81f1,0x81f0,0x01e8,0xffff,0xffff,0xffff},
  {0x801e,0x0036,0x8019,0x8018,0x0030,0xffff,0xffff,0xffff},
  {0x803e,0x0076,0x8039,0x8038,0x0070,0xffff,0xffff,0xffff},
  {0x805e,0x00b6,0x8059,0x8058,0x00b0,0xffff,0xffff,0xffff},
  {0x807e,0x00f6,0x8079,0x8078,0x00f0,0xffff,0xffff,0xffff},
  {0x809e,0x0136,0x8099,0x8098,0x0130,0xffff,0xffff,0xffff},
  {0x80be,0x0176,0x80b9,0x80b8,0x0170,0xffff,0xffff,0xffff},
  {0x80de,0x01b6,0x80d9,0x80d8,0x01b0,0xffff,0xffff,0xffff},
  {0x80fe,0x01f6,0x80f9,0x80f8,0x01f0,0xffff,0xffff,0xffff},
  {0x811e,0x003e,0x8119,0x8118,0x0038,0xffff,0xffff,0xffff},
  {0x813e,0x007e,0x8139,0x8138,0x0078,0xffff,0xffff,0xffff},
  {0x815e,0x00be,0x8159,0x8158,0x00b8,0xffff,0xffff,0xffff},
  {0x817e,0x00fe,0x8179,0x8178,0x00f8,0xffff,0xffff,0xffff},
  {0x819e,0x013e,0x8199,0x8198,0x0138,0xffff,0xffff,0xffff},
  {0x81be,0x017e,0x81b9,0x81b8,0x0178,0xffff,0xffff,0xffff},
  {0x81de,0x01be,0x81d9,0x81d8,0x01b8,0xffff,0xffff,0xffff},
  {0x81fe,0x01fe,0x81f9,0x81f8,0x01f8,0xffff,0xffff,0xffff},
  {0x8005,0x0007,0x0004,0x0002,0xffff,0xffff,0xffff,0xffff},
  {0x8025,0x0047,0x0044,0x0042,0xffff,0xffff,0xffff,0xffff},
  {0x8045,0x0087,0x0084,0x0082,0xffff,0xffff,0xffff,0xffff},
  {0x8065,0x00c7,0x00c4,0x00c2,0xffff,0xffff,0xffff,0xffff},
  {0x8085,0x0107,0x0104,0x0102,0xffff,0xffff,0xffff,0xffff},
  {0x80a5,0x0147,0x0144,0x0142,0xffff,0xffff,0xffff,0xffff},
  {0x80c5,0x0187,0x0184,0x0182,0xffff,0xffff,0xffff,0xffff},
  {0x80e5,0x01c7,0x01c4,0x01c2,0xffff,0xffff,0xffff,0xffff},
  {0x8105,0x000f,0x000c,0x000a,0xffff,0xffff,0xffff,0xffff},
  {0x8125,0x004f,0x004c,0x004a,0xffff,0xffff,0xffff,0xffff},
  {0x8145,0x008f,0x008c,0x008a,0xffff,0xffff,0xffff,0xffff},
  {0x8165,0x00cf,0x00cc,0x00ca,0xffff,0xffff,0xffff,0xffff},
  {0x8185,0x010f,0x010c,0x010a,0xffff,0xffff,0xffff,0xffff},
  {0x81a5,0x014f,0x014c,0x014a,0xffff,0xffff,0xffff,0xffff},
  {0x81c5,0x018f,0x018c,0x018a,0xffff,0xffff,0xffff,0xffff},
  {0x81e5,0x01cf,0x01cc,0x01ca,0xffff,0xffff,0xffff,0xffff},
  {0x800d,0x0017,0x0014,0x0012,0xffff,0xffff,0xffff,0xffff},
  {0x802d,0x0057,0x0054,0x0052,0xffff,0xffff,0xffff,0xffff},
  {0x804d,0x0097,0x0094,0x0092,0xffff,0xffff,0xffff,0xffff},
  {0x806d,0x00d7,0x00d4,0x00d2,0xffff,0xffff,0xffff,0xffff},
  {0x808d,0x0117,0x0114,0x0112,0xffff,0xffff,0xffff,0xffff},
  {0x80ad,0x0157,0x0154,0x0152,0xffff,0xffff,0xffff,0xffff},
  {0x80cd,0x0197,0x0194,0x0192,0xffff,0xffff,0xffff,0xffff},
  {0x80ed,0x01d7,0x01d4,0x01d2,0xffff,0xffff,0xffff,0xffff},
  {0x810d,0x001f,0x001c,0x001a,0xffff,0xffff,0xffff,0xffff},
  {0x812d,0x005f,0x005c,0x005a,0xffff,0xffff,0xffff,0xffff},
  {0x814d,0x009f,0x009c,0x009a,0xffff,0xffff,0xffff,0xffff},
  {0x816d,0x00df,0x00dc,0x00da,0xffff,0xffff,0xffff,0xffff},
  {0x818d,0x011f,0x011c,0x011a,0xffff,0xffff,0xffff,0xffff},
  {0x81ad,0x015f,0x015c,0x015a,0xffff,0xffff,0xffff,0xffff},
  {0x81cd,0x019f,0x019c,0x019a,0xffff,0xffff,0xffff,0xffff},
  {0x81ed,0x01df,0x01dc,0x01da,0xffff,0xffff,0xffff,0xffff},
  {0x8015,0x0027,0x0024,0x0022,0xffff,0xffff,0xffff,0xffff},
  {0x8035,0x0067,0x0064,0x0062,0xffff,0xffff,0xffff,0xffff},
  {0x8055,0x00a7,0x00a4,0x00a2,0xffff,0xffff,0xffff,0xffff},
  {0x8075,0x00e7,0x00e4,0x00e2,0xffff,0xffff,0xffff,0xffff},
  {0x8095,0x0127,0x0124,0x0122,0xffff,0xffff,0xffff,0xffff},
  {0x80b5,0x0167,0x0164,0x0162,0xffff,0xffff,0xffff,0xffff},
  {0x80d5,0x01a7,0x01a4,0x01a2,0xffff,0xffff,0xffff,0xffff},
  {0x80f5,0x01e7,0x01e4,0x01e2,0xffff,0xffff,0xffff,0xffff},
  {0x8115,0x002f,0x002c,0x002a,0xffff,0xffff,0xffff,0xffff},
  {0x8135,0x006f,0x006c,0x006a,0xffff,0xffff,0xffff,0xffff},
  {0x8155,0x00af,0x00ac,0x00aa,0xffff,0xffff,0xffff,0xffff},
  {0x8175,0x00ef,0x00ec,0x00ea,0xffff,0xffff,0xffff,0xffff},
  {0x8195,0x012f,0x012c,0x012a,0xffff,0xffff,0xffff,0xffff},
  {0x81b5,0x016f,0x016c,0x016a,0xffff,0xffff,0xffff,0xffff},
  {0x81d5,0x01af,0x01ac,0x01aa,0xffff,0xffff,0xffff,0xffff},
  {0x81f5,0x01ef,0x01ec,0x01ea,0xffff,0xffff,0xffff,0xffff},
  {0x801d,0x0037,0x0034,0x0032,0xffff,0xffff,0xffff,0xffff},
  {0x803d,0x0077,0x0074,0x0072,0xffff,0xffff,0xffff,0xffff},
  {0x805d,0x00b7,0x00b4,0x00b2,0xffff,0xffff,0xffff,0xffff},
  {0x807d,0x00f7,0x00f4,0x00f2,0xffff,0xffff,0xffff,0xffff},
  {0x809d,0x0137,0x0134,0x0132,0xffff,0xffff,0xffff,0xffff},
  {0x80bd,0x0177,0x0174,0x0172,0xffff,0xffff,0xffff,0xffff},
  {0x80dd,0x01b7,0x01b4,0x01b2,0xffff,0xffff,0xffff,0xffff},
  {0x80fd,0x01f7,0x01f4,0x01f2,0xffff,0xffff,0xffff,0xffff},
  {0x811d,0x003f,0x003c,0x003a,0xffff,0xffff,0xffff,0xffff},
  {0x813d,0x007f,0x007c,0x007a,0xffff,0xffff,0xffff,0xffff},
  {0x815d,0x00bf,0x00bc,0x00ba,0xffff,0xffff,0xffff,0xffff},
  {0x817d,0x00ff,0x00fc,0x00fa,0xffff,0xffff,0xffff,0xffff},
  {0x819d,0x013f,0x013c,0x013a,0xffff,0xffff,0xffff,0xffff},
  {0x81bd,0x017f,0x017c,0x017a,0xffff,0xffff,0xffff,0xffff},
  {0x81dd,0x01bf,0x01bc,0x01ba,0xffff,0xffff,0xffff,0xffff},
  {0x81fd,0x01ff,0x01fc,0x01fa,0xffff,0xffff,0xffff,0xffff},
  {0x8004,0x8003,0x0005,0x4000,0xffff,0xffff,0xffff,0xffff},
  {0x8024,0x8023,0x0045,0x4008,0xffff,0xffff,0xffff,0xffff},
  {0x8044,0x8043,0x0085,0x4010,0xffff,0xffff,0xffff,0xffff},
  {0x8064,0x8063,0x00c5,0x4018,0xffff,0xffff,0xffff,0xffff},
  {0x8084,0x8083,0x0105,0x4020,0xffff,0xffff,0xffff,0xffff},
  {0x80a4,0x80a3,0x0145,0x4028,0xffff,0xffff,0xffff,0xffff},
  {0x80c4,0x80c3,0x0185,0x4030,0xffff,0xffff,0xffff,0xffff},
  {0x80e4,0x80e3,0x01c5,0x4038,0xffff,0xffff,0xffff,0xffff},
  {0x8104,0x8103,0x000d,0x4001,0xffff,0xffff,0xffff,0xffff},
  {0x8124,0x8123,0x004d,0x4009,0xffff,0xffff,0xffff,0xffff},
  {0x8144,0x8143,0x008d,0x4011,0xffff,0xffff,0xffff,0xffff},
  {0x8164,0x8163,0x00cd,0x4019,0xffff,0xffff,0xffff,0xffff},
  {0x8184,0x8183,0x010d,0x4021,0xffff,0xffff,0xffff,0xffff},
  {0x81a4,0x81a3,0x014d,0x4029,0xffff,0xffff,0xffff,0xffff},
  {0x81c4,0x81c3,0x018d,0x4031,0xffff,0xffff,0xffff,0xffff},
  {0x81e4,0x81e3,0x01cd,0x4039,0xffff,0xffff,0xffff,0xffff},
  {0x800c,0x800b,0x0015,0x4002,0xffff,0xffff,0xffff,0xffff},
  {0x802c,0x802b,0x0055,0x400a,0xffff,0xffff,0xffff,0xffff},
  {0x804c,0x804b,0x0095,0x4012,0xffff,0xffff,0xffff,0xffff},
  {0x806c,0x806b,0x00d5,0x401a,0xffff,0xffff,0xffff,0xffff},
  {0x808c,0x808b,0x0115,0x4022,0xffff,0xffff,0xffff,0xffff},
  {0x80ac,0x80ab,0x0155,0x402a,0xffff,0xffff,0xffff,0xffff},
  {0x80cc,0x80cb,0x0195,0x4032,0xffff,0xffff,0xffff,0xffff},
  {0x80ec,0x80eb,0x01d5,0x403a,0xffff,0xffff,0xffff,0xffff},
  {0x810c,0x810b,0x001d,0x4003,0xffff,0xffff,0xffff,0xffff},
  {0x812c,0x812b,0x005d,0x400b,0xffff,0xffff,0xffff,0xffff},
  {0x814c,0x814b,0x009d,0x4013,0xffff,0xffff,0xffff,0xffff},
  {0x816c,0x816b,0x00dd,0x401b,0xffff,0xffff,0xffff,0xffff},
  {0x818c,0x818b,0x011d,0x4023,0xffff,0xffff,0xffff,0xffff},
  {0x81ac,0x81ab,0x015d,0x402b,0xffff,0xffff,0xffff,0xffff},
  {0x81cc,0x81cb,0x019d,0x4033,0xffff,0xffff,0xffff,0xffff},
  {0x81ec,0x81eb,0x01dd,0x403b,0xffff,0xffff,0xffff,0xffff},
  {0x8014,0x8013,0x0025,0x4004,0xffff,0xffff,0xffff,0xffff},
  {0x8034,0x8033,0x0065,0x400c,0xffff,0xffff,0xffff,0xffff},
  {0x8054,0x8053,0x00a5,0x4014,0xffff,0xffff,0xffff,0xffff},
  {0x8074,0x8073,0x00e5,0x401c,0xffff,0xffff,0xffff,0xffff},
  {0x8094,0x8093,0x0125,0x4024,0xffff,0xffff,0xffff,0xffff},
  {0x80b4,0x80b3,0x0165,0x402c,0xffff,0xffff,0xffff,0xffff},
  {0x80d4,0x80d3,0x01a5,0x4034,0xffff,0xffff,0xffff,0xffff},
  {0x80f4,0x80f3,0x01e5,0x403c,0xffff,0xffff,0xffff,0xffff},
  {0x8114,0x8113,0x002d,0x4005,0xffff,0xffff,0xffff,0xffff},
  {0x8134,0x8133,0x006d,0x400d,0xffff,0xffff,0xffff,0xffff},
  {0x8154,0x8153,0x00ad,0x4015,0xffff,0xffff,0xffff,0xffff},
  {0x8174,0x8173,0x00ed,0x401d,0xffff,0xffff,0xffff,0xffff},
  {0x8194,0x8193,0x012d,0x4025,0xffff,0xffff,0xffff,0xffff},
  {0x81b4,0x81b3,0x016d,0x402d,0xffff,0xffff,0xffff,0xffff},
  {0x81d4,0x81d3,0x01ad,0x4035,0xffff,0xffff,0xffff,0xffff},
  {0x81f4,0x81f3,0x01ed,0x403d,0xffff,0xffff,0xffff,0xffff},
  {0x801c,0x801b,0x0035,0x4006,0xffff,0xffff,0xffff,0xffff},
  {0x803c,0x803b,0x0075,0x400e,0xffff,0xffff,0xffff,0xffff},
  {0x805c,0x805b,0x00b5,0x4016,0xffff,0xffff,0xffff,0xffff},
  {0x807c,0x807b,0x00f5,0x401e,0xffff,0xffff,0xffff,0xffff},
  {0x809c,0x809b,0x0135,0x4026,0xffff,0xffff,0xffff,0xffff},
  {0x80bc,0x80bb,0x0175,0x402e,0xffff,0xffff,0xffff,0xffff},
  {0x80dc,0x80db,0x01b5,0x4036,0xffff,0xffff,0xffff,0xffff},
  {0x80fc,0x80fb,0x01f5,0x403e,0xffff,0xffff,0xffff,0xffff},
  {0x811c,0x811b,0x003d,0x4007,0xffff,0xffff,0xffff,0xffff},
  {0x813c,0x813b,0x007d,0x400f,0xffff,0xffff,0xffff,0xffff},
  {0x815c,0x815b,0x00bd,0x4017,0xffff,0xffff,0xffff,0xffff},
  {0x817c,0x817b,0x00fd,0x401f,0xffff,0xffff,0xffff,0xffff},
  {0x819c,0x819b,0x013d,0x4027,0xffff,0xffff,0xffff,0xffff},
  {0x81bc,0x81bb,0x017d,0x402f,0xffff,0xffff,0xffff,0xffff},
  {0x81dc,0x81db,0x01bd,0x4037,0xffff,0xffff,0xffff,0xffff},
  {0x81fc,0x81fb,0x01fd,0x403f,0xffff,0xffff,0xffff,0xffff},
};
constexpr size_t WS_DIFFO = 224 * MiB;
constexpr size_t WS_END2 = 256 * MiB;
constexpr int CW_DIFF = 65536;
static_assert((CW_DIFF + 256 * 64) * 4 <= (int)CTL_ZERO_BYTES, "counters inside the zeroed control region");
static_assert(ab::ATTN_LDS_BYTES <= RING_BYTES, "attention LDS fits the ring region");
__device__ __forceinline__ void diff_combine(const bf16_t* DIFFO, bf16_t* ATT, const float* subw, float lam, int b, int h, int qb, int wid, int lane_) {
    int lane = lane_; asm volatile("" : "+v"(lane));
    const int row = b * SEQ + 256 * qb + 32 * wid + (lane >> 1), hf = lane & 1;
    const GAS v4u* s1 = (const GAS v4u*)(DIFFO + (size_t)row * 1024 + h * 256 + hf * 64);
    const GAS v4u* s2 = (const GAS v4u*)(DIFFO + (size_t)row * 1024 + h * 256 + 128 + hf * 64);
    f32x4 v[16]; float ss = 0.f;
#pragma unroll
    for (int q = 0; q < 8; ++q) { const v4u a = s1[q], c = s2[q];
        const f32x4 a0 = {__uint_as_float(a.x << 16), __uint_as_float(a.x & 0xffff0000u), __uint_as_float(a.y << 16), __uint_as_float(a.y & 0xffff0000u)};
        const f32x4 a1 = {__uint_as_float(a.z << 16), __uint_as_float(a.z & 0xffff0000u), __uint_as_float(a.w << 16), __uint_as_float(a.w & 0xffff0000u)};
        const f32x4 c0 = {__uint_as_float(c.x << 16), __uint_as_float(c.x & 0xffff0000u), __uint_as_float(c.y << 16), __uint_as_float(c.y & 0xffff0000u)};
        const f32x4 c1 = {__uint_as_float(c.z << 16), __uint_as_float(c.z & 0xffff0000u), __uint_as_float(c.w << 16), __uint_as_float(c.w & 0xffff0000u)};
        v[2 * q] = a0 - c0 * lam; v[2 * q + 1] = a1 - c1 * lam;
        ss += ((v[2 * q].x * v[2 * q].x + v[2 * q].y * v[2 * q].y) + (v[2 * q].z * v[2 * q].z + v[2 * q].w * v[2 * q].w)) + ((v[2 * q + 1].x * v[2 * q + 1].x + v[2 * q + 1].y * v[2 * q + 1].y) + (v[2 * q + 1].z * v[2 * q + 1].z + v[2 * q + 1].w * v[2 * q + 1].w)); }
    ss += __shfl_xor(ss, 1);
    const float rstd = rsqrtf(ss * (1.f / 128.f) + EPS) * 0.8f;
    GAS v4u* dst = (GAS v4u*)(ATT + (size_t)row * DM + h * 128 + hf * 64);
    const GAS f32x4* sw = (const GAS f32x4*)(subw + hf * 64);
#pragma unroll
    for (int q = 0; q < 8; ++q) { const f32x4 g0 = sw[2 * q] * rstd, g1 = sw[2 * q + 1] * rstd; const f32x4 o0 = v[2 * q] * g0, o1 = v[2 * q + 1] * g1;
        dst[q] = (v4u){pk2(o0.x, o0.y), pk2(o0.z, o0.w), pk2(o1.x, o1.y), pk2(o1.z, o1.w)}; }
}
__device__ __forceinline__ void attn_phase(Frame& F, char* shm, gu32* ctl, const bf16_t* PROJ, const float* CUMB, bf16_t* ATT, bf16_t* DIFFO, const float* subw, const float* lq1, const float* lk1, const float* lq2, const float* lk2,
                                           const bf16_t* HM, const bf16_t* WKV, bf16_t* MKN, bf16_t* VT, const float* mkw, const float* mqw) {
    const float s1 = wave_sum(lq1[F.lane] * lk1[F.lane]), s2 = wave_sum(lq2[F.lane] * lk2[F.lane]);
    const float lam = __uint_as_float(__builtin_amdgcn_readfirstlane(__float_as_uint(__expf(s1) - __expf(s2) + 0.2f)));
    const int bx = (int)blockIdx.x & 255;
    for (int k = 0; k < 8; ++k) {
        const unsigned u = UNIT_TAB[bx][k]; if (u == 0xFFFFu) break;
        const int qb = u & 7;
        if (u & 0x4000u) {
            const int idx = u & 63;
            if (idx < 32) {
                pg8::Gemm g{HM, WKV, DM, DM, DM}; const Sched S = sched_one(idx >> 2, idx & 3, true);
                pg8::EpiHeadNormK E{MKN, mkw, mqw};
                pg8::gemm_phase<pg8::EpiHeadNormK, Sched, false, true>(F.lds + RING_OFF, g, S, E);
            } else {
                pg8::Gemm g{WKV + (size_t)1024 * DM, HM, DM, DM, DM}; const Sched S = sched_one((idx - 32) >> 3, (idx - 32) & 7, true);
                pg8::EpiStore<0> E{VT, MMEM, nullptr};
                pg8::gemm_phase<pg8::EpiStore<0>, Sched, true, true>(F.lds + RING_OFF, g, S, E);
            }
            __syncthreads();
        } else if (u & 0x8000u) {
            const int bh = (u >> 3) & 31, mp = (u >> 8) & 1, b = bh >> 2, h = bh & 3;
            const ab::bf16* base = (const ab::bf16*)PROJ + (size_t)b * SEQ * NPROJ;
#pragma unroll 1
            for (int hf = 0; hf < 2; ++hf)
                ab::attn_unit<8, 1, false>(qb, base + C_DQ + 128 * h + 64 * mp, base + C_DK + 128 * h + 64 * mp, base + C_DV + 128 * h + 64 * hf,
                                           (ab::bf16*)DIFFO + (size_t)b * SEQ * 1024 + h * 256 + (mp * 2 + hf) * 64, 1024, nullptr, shm);
            VM_WAIT(); __syncthreads();
            if (F.tid == 0) { __builtin_amdgcn_fence(__ATOMIC_RELEASE, "agent"); VM_WAIT();
                const unsigned old = __hip_atomic_fetch_add((unsigned*)(ctl + CW_DIFF + 64 * (bh * 8 + qb)), 1u, __ATOMIC_RELAXED, __HIP_MEMORY_SCOPE_AGENT);
                if (old == 1u) { __builtin_amdgcn_fence(__ATOMIC_ACQUIRE, "agent"); VM_WAIT(); }
                F.MISC[12] = old; }
            __syncthreads();
            if (F.MISC[12] == 1u) diff_combine(DIFFO, ATT, subw, lam, b, h, qb, F.wave, F.lane);
            __syncthreads();
        } else {
            const int bh = (u >> 3) & 63, b = bh >> 3, h = bh & 7;
            const ab::bf16* base = (const ab::bf16*)PROJ + (size_t)b * SEQ * NPROJ;
            ab::attn_unit<8, 0, true>(qb, base + C_FQ + 64 * h, base + C_FK + 64 * h, base + C_FV + 64 * h, (ab::bf16*)ATT + (size_t)b * SEQ * DM + 512 + 64 * h, DM, CUMB + (size_t)bh * SEQ, shm);
        }
    }
}
#ifndef REP3
#define REP3 1
#endif
#define ATTN_PHASE_HOOK if (IN(3)) { PP; for (int rep_ = 0; rep_ < REP3; ++rep_) attn_phase(F, (char*)lds + RING_OFF, F.ctl, P.PROJ, P.CUMB, P.ATT, (bf16_t*)(args.ws + WS_DIFFO), P.subw, P.lq1, P.lk1, P.lq2, P.lk2, P.HM, P.WKV, P.MKN, P.VT, P.mkw, P.mqw); }
#ifndef PROBE_K
#define PROBE_K -1
#endif
#ifndef PROBE_MULT
#define PROBE_MULT 4
#endif
#define STAMP(i) do { if (PROBE_K >= 0 && F.tid == 0) { const unsigned long long t_ = __builtin_amdgcn_s_memrealtime(); F.MISC[16 + 2 * (i)] = (unsigned)t_; F.MISC[17 + 2 * (i)] = (unsigned)(t_ >> 32); } } while (0)
#ifndef REP0
#define REP0 1
#endif
#ifndef REP1
#define REP1 1
#endif
#ifndef REP2
#define REP2 1
#endif
#ifndef REP3
#define REP3 1
#endif
#ifndef REP4
#define REP4 1
#endif
#ifndef REP5
#define REP5 1
#endif
#ifndef REP6
#define REP6 1
#endif
#ifndef REP7
#define REP7 1
#endif
#ifndef REP8
#define REP8 1
#endif
constexpr int NPHASE = 9;

__global__ void __launch_bounds__(NWAVES * 64, 2) mega_fwd(Args args) {
    extern __shared__ __attribute__((aligned(16))) unsigned char lds[];
    Frame F;
    F.lds = (LAS unsigned char*)lds; F.MISC = (volatile LAS unsigned*)(F.lds + MISC_OFF);
    F.tid = threadIdx.x; F.lane = F.tid & 63; F.wave = __builtin_amdgcn_readfirstlane(F.tid >> 6);
    F.G = gridDim.x; { const int bx = blockIdx.x; F.vcu = (F.G % 8 == 0) ? (bx % 8) * (F.G / 8) + bx / 8 : bx; }
    F.ctl = (gu32*)(args.ws + WS_CTL);
    for (int u = F.tid; u < (LDS_BYTES - LDSCTL_OFF) / 4; u += NWAVES * 64) ((LAS unsigned*)(F.lds + LDSCTL_OFF))[u] = 0u;
    __syncthreads();
    XcdBarrier bar = xcd_barrier_post((unsigned*)(F.ctl + CW_BAR) + args.ph_lo * XCD_BAR_WORDS, F.MISC + 8);
    const int lo = args.ph_lo, hi = args.ph_hi;
#define IN(k) (lo <= (k) && (k) < hi)
#define PP const Ptrs P = make_ptrs(args.in, args.out, args.ws)
#define SEAM(k) do { if (IN(k) && IN((k) + 1)) xcd_barrier(bar); } while (0)
#define SEAM2(k) do { if (IN(k) && IN((k) + 2)) xcd_barrier(bar); } while (0)
    const int bx = (int)blockIdx.x;
    STAMP(0);

    if (IN(0)) { PP; for (int rep_ = 0; rep_ < REP0; ++rep_) p0_prologue(F, P); } SEAM(0); STAMP(1);

    if (IN(1)) {
        PP; for (int rep_ = 0; rep_ < REP1; ++rep_) {
        pg8::Gemm g{P.XB, P.WIN, DM, DM, DM}; const Sched S = sched_static(MTOK, NPROJ, F.G, bx);
        if (bx < 64) p1b_cumsum_wg(P.FLOG, P.b_forget, P.CUMB, bx, F.tid, (LAS float*)(F.lds + LDS_RQ));
        pg8::EpiProj E{P.PROJ, P.QKW, P.ROPE};
        pg8::gemm_phase<pg8::EpiProj, Sched, true, true>(F.lds + RING_OFF, g, S, E);
    }} SEAM2(1); STAMP(2);


    ATTN_PHASE_HOOK
    SEAM(3); STAMP(3);

    if (IN(4)) {
        PP; for (int rep_ = 0; rep_ < REP4; ++rep_) {
        pg8::Gemm g{P.ATT, P.WOUT, DM, DM, DM}; const Sched S = sched_static(MTOK, DM, F.G, bx);
        pg8::EpiResid<0> E{P.x, P.XB, nullptr, P.SS};
        pg8::gemm_phase<pg8::EpiResid<0>, Sched, false, true>(F.lds + RING_OFF, g, S, E);
    }} SEAM(4); STAMP(4);

    if (IN(5)) {
        PP; for (int rep_ = 0; rep_ < REP5; ++rep_) {
        const Sched S0 = sched_static(MTOK, DM, F.G, bx); pg8::Unit u{0, 0}; const bool has = S0.next(0, u);
        PG8_LAS float* RQ = (PG8_LAS float*)(F.lds + LDS_RQ); PG8_LAS float* IL = (PG8_LAS float*)(F.lds + LDS_IL);
        {   pg8::Gemm g{P.XB, P.WQ, DM, DM, DM}; const Sched S = sched_one(u.pm, u.pn, has);
            pg8::EpiMemQ E{P.MQ, P.SS, RQ};
            pg8::gemm_phase<pg8::EpiMemQ, Sched, false, true>(F.lds + RING_OFF, g, S, E); }
        VM_WAIT(); __syncthreads(); if (F.tid == 0) { __builtin_amdgcn_fence(__ATOMIC_ACQUIRE, "agent"); VM_WAIT(); } __syncthreads();
        const int head = u.pn, bh = (u.pm >> 3) * 4 + head;
        {   pg8::Gemm g{P.MQ + head * 256, P.MKN + (size_t)bh * 65536, DM, 256, 256}; const Sched S = sched_one(u.pm, 0, has);
            pg8::EpiMemS E{P.MQ, head, RQ, IL};
            pg8::gemm_phase<pg8::EpiMemS, Sched, false, true>(F.lds + RING_OFF, g, S, E); }
        VM_WAIT(); __syncthreads(); if (F.tid == 0) { __builtin_amdgcn_fence(__ATOMIC_ACQUIRE, "agent"); VM_WAIT(); } __syncthreads();
        {   pg8::Gemm g{P.MQ + head * 256, P.VT + (size_t)(head * 256) * MMEM + (u.pm >> 3) * 256, DM, MMEM, 256}; const Sched S = sched_one(u.pm, 0, has);
            pg8::EpiMemPV E{P.MO, head, IL};
            pg8::gemm_phase<pg8::EpiMemPV, Sched, true, true>(F.lds + RING_OFF, g, S, E); }
    }} SEAM(5); STAMP(5);

    if (IN(6)) {
        PP; for (int rep_ = 0; rep_ < REP6; ++rep_) {
        pg8::Gemm g{P.MO, P.WO, DM, DM, DM}; const Sched S = sched_static(MTOK, DM, F.G, bx);
        pg8::EpiResid<1> E{nullptr, P.XB, nullptr, P.SS};
        pg8::gemm_phase<pg8::EpiResid<1>, Sched, false, true>(F.lds + RING_OFF, g, S, E);
    }} SEAM(6); STAMP(6);

    if (IN(7)) {
        PP; for (int rep_ = 0; rep_ < REP7; ++rep_) {
        pg8::Gemm g{P.XB, P.WUP, DM, DM, DM}; const Sched S = sched_static(MTOK, DFF, F.G, bx);
        pg8::EpiStore<3> E{P.H, DFF, P.SS};
        pg8::gemm_phase<pg8::EpiStore<3>, Sched, true, true>(F.lds + RING_OFF, g, S, E);
    }} SEAM(7); STAMP(7);

    if (IN(8)) {
        PP; for (int rep_ = 0; rep_ < REP8; ++rep_) {
        pg8::Gemm g{P.H, P.WDN, DFF, DFF, DFF}; const Sched S = sched_static(MTOK, DM, F.G, bx);
        pg8::EpiResid<2> E{nullptr, P.XB, P.out, nullptr};
        pg8::gemm_phase<pg8::EpiResid<2>, Sched, false, true>(F.lds + RING_OFF, g, S, E);
    }}
    STAMP(8);
    if (PROBE_K >= 0 && F.tid == 0) {
        const unsigned long long a_ = ((unsigned long long)F.MISC[17 + 2 * PROBE_K] << 32) | F.MISC[16 + 2 * PROBE_K], b_ = ((unsigned long long)F.MISC[19 + 2 * PROBE_K] << 32) | F.MISC[18 + 2 * PROBE_K];
        const unsigned long long w_ = (b_ - a_) * PROBE_MULT, t0_ = __builtin_amdgcn_s_memrealtime();
        while (__builtin_amdgcn_s_memrealtime() - t0_ < w_) __builtin_amdgcn_s_sleep(8);
    }
#undef IN
#undef SEAM
#undef SEAM2
}
extern "C" void kernel_launch(void* const* d_in, const int* in_sizes, int n_in, void* d_out, int out_size, void* d_ws, size_t ws_size, hipStream_t stream) {
    static int grid = 0;
    if (grid == 0) {
        if (n_in != 26 || in_sizes[0] != MTOK * DM || out_size != MTOK * DM || ws_size < WS_END2) { fprintf(stderr, "kernel_launch: unexpected shapes (n_in %d, in0 %d, out %d, ws %zu)\n", n_in, n_in > 0 ? in_sizes[0] : -1, out_size, ws_size); grid = -1; return; }
        int dev = 0, cus = 0, per_cu = 0;
        if (hipGetDevice(&dev) != hipSuccess || hipDeviceGetAttribute(&cus, hipDeviceAttributeMultiprocessorCount, dev) != hipSuccess) { grid = -1; return; }
        if (hipFuncSetAttribute((const void*)mega_fwd, hipFuncAttributeMaxDynamicSharedMemorySize, LDS_BYTES) != hipSuccess) { fprintf(stderr, "kernel_launch: hipFuncSetAttribute failed\n"); grid = -1; return; }
        if (hipOccupancyMaxActiveBlocksPerMultiprocessor(&per_cu, (const void*)mega_fwd, NWAVES * 64, LDS_BYTES) != hipSuccess || per_cu < 1) { fprintf(stderr, "kernel_launch: occupancy query says %d blocks per CU\n", per_cu); (void)hipGetLastError(); grid = -1; return; }
        grid = cus;
        if (grid != 256) fprintf(stderr, "kernel_launch: %d CUs; the one-unit-per-workgroup phases assume 256\n", grid);
    }
    if (grid < 0) return;
    (void)hipMemsetAsync((char*)d_ws + WS_CTL, 0, CTL_ZERO_BYTES, stream);
    Args a{};
    for (int i = 0; i < 26; ++i) a.in[i] = d_in[i];
    a.out = (float*)d_out; a.ws = (unsigned char*)d_ws;
#if MK_HYBRID
    const Ptrs P = make_ptrs(a.in, a.out, a.ws);
    a.ph_lo = 0; a.ph_hi = 3; hipLaunchKernelGGL(mega_fwd, dim3(grid), dim3(NWAVES * 64), LDS_BYTES, stream, a);
    float* OF = a.out;
    hipLaunchKernelGGL(k_attn, dim3(MTOK / 64, 8), dim3(64), 0, stream, P.PROJ, P.CUMB, 1, OF, 8);
    hipLaunchKernelGGL(k_fox_fin, dim3(MTOK * 512 / 256), dim3(256), 0, stream, OF, P.ATT);
    hipLaunchKernelGGL(k_attn, dim3(MTOK / 64, 16), dim3(64), 0, stream, P.PROJ, P.CUMB, 0, OF, 16);
    hipLaunchKernelGGL(k_diff_fin, dim3(MTOK), dim3(256), 0, stream, OF, P.lq1, P.lk1, P.lq2, P.lk2, P.subw, P.ATT);
    a.ph_lo = 4; a.ph_hi = 9; hipLaunchKernelGGL(mega_fwd, dim3(grid), dim3(NWAVES * 64), LDS_BYTES, stream, a);
#else
    a.ph_lo = 0; a.ph_hi = NPHASE; hipLaunchKernelGGL(mega_fwd, dim3(grid), dim3(NWAVES * 64), LDS_BYTES, stream, a);
#endif
}
```

```cpp
#include <hip/hip_runtime.h>
#include <cstdint>
#include <cstdio>

typedef unsigned short bf16_t;
__device__ __forceinline__ float bf2f(bf16_t v) { return __uint_as_float(((unsigned)v) << 16); }
__device__ __forceinline__ bf16_t f2bf(float f) { unsigned u = __float_as_uint(f); return (bf16_t)((u + 0x7fffu + ((u >> 16) & 1u)) >> 16); }

constexpr int NB = 8, SEQ = 2048, DM = 1024, MTOK = NB * SEQ, MEML = 256, MMEM = NB * MEML;
constexpr int NPROJ = 3072, INCOLS = 3080, DFF = 4096;
constexpr float EPS = 1e-6f;
constexpr float LOG2E = 1.4426950408889634f;
constexpr float C2 = 0.125f * LOG2E;
constexpr float CM = 0.0625f * LOG2E;
constexpr int C_DQ = 0, C_DK = 512, C_DV = 1024, C_FQ = 1536, C_FK = 2048, C_FV = 2560;

constexpr size_t MiB = 1u << 20;
constexpr size_t WS_CTL = 0, CTL_ZERO_BYTES = 1 * MiB;
constexpr size_t WS_FLOG = 1 * MiB;
constexpr size_t WS_CUMB = 2 * MiB;
constexpr size_t WS_ROPE = 3 * MiB;
constexpr size_t WS_RS0 = 4 * MiB + 256 * 1024;
constexpr size_t WS_QKW = 4 * MiB + 512 * 1024;
constexpr size_t WS_SS = 4 * MiB;
constexpr size_t WS_WIN = 8 * MiB, WS_WOUT = 14 * MiB, WS_WQ = 16 * MiB, WS_WKV = 18 * MiB, WS_WO = 22 * MiB, WS_WUP = 24 * MiB, WS_WDN = 32 * MiB;
constexpr size_t WS_XB = 40 * MiB;
constexpr size_t WS_HM = 72 * MiB;
constexpr size_t WS_MK = 76 * MiB;
constexpr size_t WS_VT = 80 * MiB;
constexpr size_t WS_MKN = 84 * MiB;
constexpr size_t WS_PROJ = 96 * MiB;
constexpr size_t WS_ATT = 192 * MiB;
constexpr size_t WS_MQ = 96 * MiB;
constexpr size_t WS_MO = 128 * MiB;
constexpr size_t WS_H = 96 * MiB;
constexpr size_t WS_END = 224 * MiB;
#define MK_HYBRID 0
namespace pg8 {
#define PG8_LAS __attribute__((address_space(3)))
typedef short bf16x8 __attribute__((ext_vector_type(8)));
typedef float f32x4 __attribute__((ext_vector_type(4)));
typedef unsigned u32x4 __attribute__((ext_vector_type(4)));
typedef unsigned u32x2 __attribute__((ext_vector_type(2)));
constexpr int BM = 256, BK = 64, HALF = 128, HTB = HALF * BK * 2  , STAGE_BYTES = 8 * HTB, NXCD = 8, WGM = 8;

__host__ __device__ __forceinline__ int lds_byte(int r, int c) { const int st = (r >> 4) * 2 + (c >> 5), rr = r & 15, cc = c & 31, ob = rr * 64 + cc * 2; return st * 1024 + (ob ^ (((ob >> 9) & 1) << 5)); }
__host__ __device__ __forceinline__ void stage_rc(int b, int& R, int& C) { const int st = b / 1024, sb = b % 1024, swz = sb ^ (((sb >> 9) & 1) << 5); R = (st >> 1) * 16 + swz / 64; C = (st & 1) * 32 + (swz % 64) / 2; }
__host__ __device__ __forceinline__ int perm32(int rho) { const int n = rho >> 4, i = rho & 15; return 8 * (i >> 2) + 4 * n + (i & 3); }

struct Unit { int pm, pn; };
struct Gemm { const bf16_t* A; const bf16_t* Bt; int lda, ldb, K; };

struct StaticOrder {
    int nM, nN, nwg, G, c;
    __host__ __device__ void init(int M, int N, int G_, int c_) { nM = M / BM; nN = N / BM; nwg = nM * nN; G = G_; c = c_; }
    __host__ __device__ bool next(int i, Unit& u) const {
        const long L = (long)i * G + c; if (L >= nwg) return false;
        int wgid = (int)L; { const int q = nwg / NXCD, r = nwg % NXCD, xcd = wgid % NXCD, off = wgid / NXCD; wgid = (xcd < r ? xcd * (q + 1) : r * (q + 1) + (xcd - r) * q) + off; }
        const int nig = WGM * nN, gid = wgid / nig, fm = gid * WGM, gsz = (nM - fm) < WGM ? (nM - fm) : WGM;
        u.pm = fm + ((wgid % nig) % gsz); u.pn = (wgid % nig) / gsz; return true;
    }
    __device__ __forceinline__ void a_ready(const Unit&) const {}
    __device__ __forceinline__ void done(const Unit&) const {}
};
struct OneUnit {
    int pm, pn; bool has;
    __device__ __forceinline__ bool next(int i, Unit& u) const { if (i != 0 || !has) return false; u.pm = pm; u.pn = pn; return true; }
    __device__ __forceinline__ void a_ready(const Unit&) const {}
    __device__ __forceinline__ void done(const Unit&) const {}
};

__device__ __forceinline__ unsigned cvt_pk_bf16(float lo, float hi) { unsigned r; asm volatile("v_cvt_pk_bf16_f32 %0, %1, %2" : "=v"(r) : "v"(lo), "v"(hi)); return r; }
#define PG8_LBAR() do { asm volatile("s_waitcnt lgkmcnt(0)" ::: "memory"); __builtin_amdgcn_s_barrier(); asm volatile("" ::: "memory"); } while (0)

template <int MODE> struct EpiStore {
    static constexpr bool PERM = true, AFTER_DRAIN = false;
    bf16_t* O; int ldc; const float* SS;
    __device__ __forceinline__ void operator()(const f32x4 (&acc)[2][2][4][2], const Unit& u, int wr, int wc, int fr, int fq) const {
        const int row0 = u.pm * BM + wr * 64 + fr, col0 = u.pn * BM + wc * 32 + 8 * fq;
#pragma unroll
        for (int ai = 0; ai < 2; ++ai)
#pragma unroll
            for (int m = 0; m < 4; ++m) { const int row = row0 + ai * HALF + m * 16; float rs = 1.f;
                if (MODE != 0) { const f32x4 s = *(const f32x4*)(SS + (size_t)row * 4); rs = rsqrtf(((s[0] + s[1]) + (s[2] + s[3])) * (1.f / DM) + EPS); }
                bf16_t* rowp = O + (size_t)row * ldc + col0;
#pragma unroll
                for (int bj = 0; bj < 2; ++bj) { f32x4 v0 = acc[ai][bj][m][0] * rs, v1 = acc[ai][bj][m][1] * rs;
                    if (MODE == 3) {
#pragma unroll
                        for (int e = 0; e < 4; ++e) { const float a = fmaxf(v0[e], 0.f), b = fmaxf(v1[e], 0.f); v0[e] = a * a; v1[e] = b * b; } }
                    u32x4 w; w.x = cvt_pk_bf16(v0[0], v0[1]); w.y = cvt_pk_bf16(v0[2], v0[3]); w.z = cvt_pk_bf16(v1[0], v1[1]); w.w = cvt_pk_bf16(v1[2], v1[3]);
                    *(u32x4*)(rowp + bj * HALF) = w; } }
    }
};
struct EpiProj {
    static constexpr bool PERM = true, AFTER_DRAIN = false;
    bf16_t* O; const float* QKW; const float* ROPE;
    __device__ __forceinline__ void operator()(const f32x4 (&acc)[2][2][4][2], const Unit& u, int wr, int wc, int fr, int fq) const {
        const int sec = u.pn >> 1, row0 = u.pm * BM + wr * 64 + fr, col0 = u.pn * BM + wc * 64 + 8 * fq;
        if (sec == 2 || sec == 5) {
#pragma unroll
            for (int ai = 0; ai < 2; ++ai)
#pragma unroll
                for (int m = 0; m < 4; ++m) { bf16_t* rowp = O + (size_t)(row0 + ai * HALF + m * 16) * NPROJ + col0;
#pragma unroll
                    for (int bj = 0; bj < 2; ++bj) { const f32x4 v0 = acc[ai][bj][m][0], v1 = acc[ai][bj][m][1];
                        u32x4 w; w.x = cvt_pk_bf16(v0[0], v0[1]); w.y = cvt_pk_bf16(v0[2], v0[3]); w.z = cvt_pk_bf16(v1[0], v1[1]); w.w = cvt_pk_bf16(v1[2], v1[3]);
                        *(u32x4*)(rowp + bj * 32) = w; } }
            return;
        }
        const float* w = QKW + 64 * (sec < 2 ? sec : sec - 1);
        const float sc = (sec == 0 || sec == 3) ? C2 : 1.f; const bool rope = sec < 2;
        f32x4 g[2][2];
#pragma unroll
        for (int bj = 0; bj < 2; ++bj)
#pragma unroll
            for (int n = 0; n < 2; ++n) g[bj][n] = *(const f32x4*)(w + 32 * bj + 8 * fq + 4 * n);
        const float sgn = fq == 0 ? -1.f : 1.f; const bool rl = fq < 2;
#pragma unroll
        for (int ai = 0; ai < 2; ++ai)
#pragma unroll
            for (int m = 0; m < 4; ++m) { const int row = row0 + ai * HALF + m * 16; float ss = 0.f;
#pragma unroll
                for (int bj = 0; bj < 2; ++bj)
#pragma unroll
                    for (int n = 0; n < 2; ++n) { const f32x4 a = acc[ai][bj][m][n]; ss += (a[0] * a[0] + a[1] * a[1]) + (a[2] * a[2] + a[3] * a[3]); }
                ss += __shfl_xor(ss, 16); ss += __shfl_xor(ss, 32);
                const float rstd = rsqrtf(ss * (1.f / 64.f) + EPS) * sc;
                f32x4 v[2][2];
#pragma unroll
                for (int bj = 0; bj < 2; ++bj)
#pragma unroll
                    for (int n = 0; n < 2; ++n) v[bj][n] = acc[ai][bj][m][n] * rstd * g[bj][n];
                if (rope) {
#pragma unroll
                    for (int n = 0; n < 2; ++n) { f32x4 pr;
#pragma unroll
                        for (int e = 0; e < 4; ++e) pr[e] = __shfl_xor(v[0][n][e], 16);
                        const f32x4 c = *(const f32x4*)(ROPE + (size_t)row * 16 + 4 * n), s = *(const f32x4*)(ROPE + (size_t)row * 16 + 8 + 4 * n);
                        const f32x4 r = v[0][n] * c + pr * s * sgn;
                        if (rl) v[0][n] = r; }
                }
                bf16_t* rowp = O + (size_t)row * NPROJ + col0;
#pragma unroll
                for (int bj = 0; bj < 2; ++bj) { u32x4 wv; wv.x = cvt_pk_bf16(v[bj][0][0], v[bj][0][1]); wv.y = cvt_pk_bf16(v[bj][0][2], v[bj][0][3]); wv.z = cvt_pk_bf16(v[bj][1][0], v[bj][1][1]); wv.w = cvt_pk_bf16(v[bj][1][2], v[bj][1][3]);
                    *(u32x4*)(rowp + bj * 32) = wv; } }
    }
};
template <int MODE> struct EpiResid {
    static constexpr bool PERM = true, AFTER_DRAIN = true;
    const float* xf; bf16_t* xb; float* outf; float* SS;
    __device__ __forceinline__ void fused(f32x4 (&acc)[2][2][4][2], const Unit& u, int wr, int wc, int fr, int fq, PG8_LAS unsigned char* lds, int wid, int lane) const {
        PG8_LAS float* P = (PG8_LAS float*)lds;
        const int col0 = u.pn * BM + wc * 32 + 8 * fq;
#pragma unroll
        for (int ai = 0; ai < 2; ++ai)
#pragma unroll
            for (int m = 0; m < 4; ++m) { const int r = ai * HALF + wr * 64 + m * 16 + fr; const size_t off = (size_t)(u.pm * BM + r) * DM + col0; float s = 0.f;
                const float rsc = MODE == 0 ? xf[u.pm * BM + r] : 1.f;
#pragma unroll
                for (int bj = 0; bj < 2; ++bj) { f32x4 b0, b1;
                    { const u32x4 w = *(const u32x4*)(xb + off + bj * HALF);
                        b0 = (f32x4){__uint_as_float(w.x << 16), __uint_as_float(w.x & 0xffff0000u), __uint_as_float(w.y << 16), __uint_as_float(w.y & 0xffff0000u)};
                        b1 = (f32x4){__uint_as_float(w.z << 16), __uint_as_float(w.z & 0xffff0000u), __uint_as_float(w.w << 16), __uint_as_float(w.w & 0xffff0000u)}; }
                    const f32x4 o0 = b0 * rsc + acc[ai][bj][m][0], o1 = b1 * rsc + acc[ai][bj][m][1];
                    if (MODE == 2) { *(f32x4*)(outf + off + bj * HALF) = o0; *(f32x4*)(outf + off + bj * HALF + 4) = o1; }
                    else { u32x4 w; w.x = cvt_pk_bf16(o0[0], o0[1]); w.y = cvt_pk_bf16(o0[2], o0[3]); w.z = cvt_pk_bf16(o1[0], o1[1]); w.w = cvt_pk_bf16(o1[2], o1[3]); *(u32x4*)(xb + off + bj * HALF) = w;
                        s += ((o0[0] * o0[0] + o0[1] * o0[1]) + (o0[2] * o0[2] + o0[3] * o0[3])) + ((o1[0] * o1[0] + o1[1] * o1[1]) + (o1[2] * o1[2] + o1[3] * o1[3])); } }
                if (MODE != 2) { s += __shfl_xor(s, 16); s += __shfl_xor(s, 32); if (fq == 0) P[r * 4 + wc] = s; }
                if (MODE == 0 ? (m == 3) : false) asm volatile("" ::: "memory"); }
        if (MODE != 2) { PG8_LBAR();
            const int t = wid * 64 + lane; if (t < 256) { const f32x4 p = *(const PG8_LAS f32x4*)(P + t * 4); SS[(size_t)(u.pm * BM + t) * 4 + u.pn] = (p[0] + p[1]) + (p[2] + p[3]); } }
    }
};
struct EpiHeadNormK {
    static constexpr bool PERM = true, AFTER_DRAIN = true;
    bf16_t* MKn; const float* kw; const float* qw;
    __device__ __forceinline__ void fused(f32x4 (&acc)[2][2][4][2], const Unit& u, int wr, int wc, int fr, int fq, PG8_LAS unsigned char* lds, int wid, int lane) const {
        PG8_LAS float* P = (PG8_LAS float*)lds; PG8_LAS float* R = (PG8_LAS float*)(lds + 4096);
#pragma unroll
        for (int ai = 0; ai < 2; ++ai)
#pragma unroll
            for (int m = 0; m < 4; ++m) { float s = 0.f;
#pragma unroll
                for (int bj = 0; bj < 2; ++bj)
#pragma unroll
                    for (int n = 0; n < 2; ++n) { const f32x4 v = acc[ai][bj][m][n]; s += (v[0] * v[0] + v[1] * v[1]) + (v[2] * v[2] + v[3] * v[3]); }
                s += __shfl_xor(s, 16); s += __shfl_xor(s, 32); if (fq == 0) P[(ai * HALF + wr * 64 + m * 16 + fr) * 4 + wc] = s; }
        PG8_LBAR();
        { const int t = wid * 64 + lane; if (t < 256) { const f32x4 p = *(const PG8_LAS f32x4*)(P + t * 4); R[t] = rsqrtf(((p[0] + p[1]) + (p[2] + p[3])) * (1.f / 256.f) + EPS); } }
        PG8_LBAR();
        const int c0 = wc * 32 + 8 * fq; f32x4 g[2][2];
#pragma unroll
        for (int bj = 0; bj < 2; ++bj)
#pragma unroll
            for (int n = 0; n < 2; ++n) { const f32x4 a = *(const f32x4*)(kw + c0 + bj * HALF + 4 * n), b = *(const f32x4*)(qw + c0 + bj * HALF + 4 * n); g[bj][n] = a * b * CM; }
        bf16_t* basep = MKn + (size_t)(u.pm * 4 + u.pn) * 65536;
#pragma unroll
        for (int ai = 0; ai < 2; ++ai)
#pragma unroll
            for (int m = 0; m < 4; ++m) { const int r = ai * HALF + wr * 64 + m * 16 + fr; const float rk = R[r];
#pragma unroll
                for (int bj = 0; bj < 2; ++bj) { const f32x4 v0 = acc[ai][bj][m][0] * rk * g[bj][0], v1 = acc[ai][bj][m][1] * rk * g[bj][1];
                    u32x4 w; w.x = cvt_pk_bf16(v0[0], v0[1]); w.y = cvt_pk_bf16(v0[2], v0[3]); w.z = cvt_pk_bf16(v1[0], v1[1]); w.w = cvt_pk_bf16(v1[2], v1[3]);
                    *(u32x4*)(basep + (size_t)r * 256 + c0 + bj * HALF) = w; } }
    }
};
struct EpiMemQ {
    static constexpr bool PERM = true, AFTER_DRAIN = true;
    bf16_t* MQ; const float* SS; PG8_LAS float* RQ;
    __device__ __forceinline__ void fused(f32x4 (&acc)[2][2][4][2], const Unit& u, int wr, int wc, int fr, int fq, PG8_LAS unsigned char* lds, int wid, int lane) const {
        PG8_LAS float* P = (PG8_LAS float*)lds;
        const int col0 = u.pn * BM + wc * 32 + 8 * fq;
#pragma unroll
        for (int ai = 0; ai < 2; ++ai)
#pragma unroll
            for (int m = 0; m < 4; ++m) { const int r = ai * HALF + wr * 64 + m * 16 + fr; const int row = u.pm * BM + r;
                const f32x4 ss = *(const f32x4*)(SS + (size_t)row * 4); const float rs = rsqrtf(((ss[0] + ss[1]) + (ss[2] + ss[3])) * (1.f / DM) + EPS); float s = 0.f;
#pragma unroll
                for (int bj = 0; bj < 2; ++bj) { const f32x4 v0 = acc[ai][bj][m][0] * rs, v1 = acc[ai][bj][m][1] * rs;
                    s += (v0[0] * v0[0] + v0[1] * v0[1]) + (v0[2] * v0[2] + v0[3] * v0[3]) + (v1[0] * v1[0] + v1[1] * v1[1]) + (v1[2] * v1[2] + v1[3] * v1[3]);
                    u32x4 w; w.x = cvt_pk_bf16(v0[0], v0[1]); w.y = cvt_pk_bf16(v0[2], v0[3]); w.z = cvt_pk_bf16(v1[0], v1[1]); w.w = cvt_pk_bf16(v1[2], v1[3]);
                    *(u32x4*)(MQ + (size_t)row * DM + col0 + bj * HALF) = w; }
                s += __shfl_xor(s, 16); s += __shfl_xor(s, 32); if (fq == 0) P[r * 4 + wc] = s; }
        PG8_LBAR();
        { const int t = wid * 64 + lane; if (t < 256) { const f32x4 p = *(const PG8_LAS f32x4*)(P + t * 4); RQ[t] = rsqrtf(((p[0] + p[1]) + (p[2] + p[3])) * (1.f / 256.f) + EPS); } }
        PG8_LBAR();
    }
};
struct EpiMemS {
    static constexpr bool PERM = true, AFTER_DRAIN = true;
    bf16_t* Pt; int head; const PG8_LAS float* RQ; PG8_LAS float* IL;
    __device__ __forceinline__ void fused(f32x4 (&acc)[2][2][4][2], const Unit& u, int wr, int wc, int fr, int fq, PG8_LAS unsigned char* lds, int wid, int lane) const {
        PG8_LAS float* P = (PG8_LAS float*)lds;
        const int col0 = head * BM + wc * 32 + 8 * fq;
#pragma unroll
        for (int ai = 0; ai < 2; ++ai)
#pragma unroll
            for (int m = 0; m < 4; ++m) { const int r = ai * HALF + wr * 64 + m * 16 + fr; const int row = u.pm * BM + r; const float rq = RQ[r]; float s = 0.f;
#pragma unroll
                for (int bj = 0; bj < 2; ++bj) { f32x4 v0 = acc[ai][bj][m][0] * rq, v1 = acc[ai][bj][m][1] * rq;
#pragma unroll
                    for (int e = 0; e < 4; ++e) { v0[e] = __builtin_amdgcn_exp2f(v0[e]); v1[e] = __builtin_amdgcn_exp2f(v1[e]); }
                    s += (v0[0] + v0[1]) + (v0[2] + v0[3]) + (v1[0] + v1[1]) + (v1[2] + v1[3]);
                    u32x4 w; w.x = cvt_pk_bf16(v0[0], v0[1]); w.y = cvt_pk_bf16(v0[2], v0[3]); w.z = cvt_pk_bf16(v1[0], v1[1]); w.w = cvt_pk_bf16(v1[2], v1[3]);
                    *(u32x4*)(Pt + (size_t)row * DM + col0 + bj * HALF) = w; }
                s += __shfl_xor(s, 16); s += __shfl_xor(s, 32); if (fq == 0) P[r * 4 + wc] = s; }
        PG8_LBAR();
        { const int t = wid * 64 + lane; if (t < 256) { const f32x4 p = *(const PG8_LAS f32x4*)(P + t * 4); IL[t] = 1.0f / ((p[0] + p[1]) + (p[2] + p[3])); } }
        PG8_LBAR();
    }
};
struct EpiMemPV {
    static constexpr bool PERM = true, AFTER_DRAIN = false;
    bf16_t* MO; int head; const PG8_LAS float* IL;
    __device__ __forceinline__ void operator()(const f32x4 (&acc)[2][2][4][2], const Unit& u, int wr, int wc, int fr, int fq) const {
        const int col0 = head * BM + wc * 32 + 8 * fq;
#pragma unroll
        for (int ai = 0; ai < 2; ++ai)
#pragma unroll
            for (int m = 0; m < 4; ++m) { const int r = ai * HALF + wr * 64 + m * 16 + fr; const int row = u.pm * BM + r; const float il = IL[r];
#pragma unroll
                for (int bj = 0; bj < 2; ++bj) { const f32x4 v0 = acc[ai][bj][m][0] * il, v1 = acc[ai][bj][m][1] * il;
                    u32x4 w; w.x = cvt_pk_bf16(v0[0], v0[1]); w.y = cvt_pk_bf16(v0[2], v0[3]); w.z = cvt_pk_bf16(v1[0], v1[1]); w.w = cvt_pk_bf16(v1[2], v1[3]);
                    *(u32x4*)(MO + (size_t)row * DM + col0 + bj * HALF) = w; } }
    }
};

template <class Epi, class Sched, bool ALIGN_EPI = false, bool SP2 = false>
__device__ __forceinline__ void gemm_phase(PG8_LAS unsigned char* lds, const Gemm g, const Sched& S, const Epi& E) {
    const int tid = threadIdx.x, wid = __builtin_amdgcn_readfirstlane(tid >> 6), lane = tid & 63, wr = wid >> 2, wc = wid & 3, fr = lane & 15, fq = lane >> 4;
    const int K = g.K, nt = K / BK;
    unsigned voffA[2], voffB[2];
#pragma unroll
    for (int i = 0; i < 2; ++i) { int R, C; stage_rc(tid * 16 + i * 8192, R, C); const int Rb = Epi::PERM ? ((R & ~31) + perm32(R & 31)) : R;
        voffA[i] = (unsigned)(R * g.lda + C) * 2u; voffB[i] = (unsigned)(Rb * g.ldb + C) * 2u; }
    const size_t kstep = (size_t)(BK * 2);
    const size_t hsA = (size_t)HALF * g.lda * 2, hsB = (size_t)HALF * g.ldb * 2;
    const size_t tsA = 2 * hsA, tsB = 2 * hsB;
    const unsigned ldsw = (unsigned)wid * 1024u;
    const int aoff = lds_byte(wr * 64 + fr, fq * 8), boff = lds_byte(wc * 32 + fr, fq * 8);
#define PG8_SA(b, h) (((b) * 2 + (h)) * HTB)
#define PG8_SB(b, h) ((4 + (b) * 2 + (h)) * HTB)
#define PG8_STAGE(bufoff, gbase, voff) do { _Pragma("unroll") for (int _i = 0; _i < 2; ++_i) \
        __builtin_amdgcn_global_load_lds((const unsigned*)((const char*)(gbase) + (voff)[_i]), (PG8_LAS unsigned*)(lds + (bufoff) + ldsw + _i * 8192), 16, 0, 0); } while (0)
#define PG8_LDA(dst, b, h) do { _Pragma("unroll") for (int m = 0; m < 4; ++m) _Pragma("unroll") for (int k = 0; k < 2; ++k) dst[m][k] = *(const PG8_LAS bf16x8*)(lds + PG8_SA(b, h) + aoff + m * 2048 + k * 1024); } while (0)
#define PG8_LDB(dst, b, h) do { _Pragma("unroll") for (int n = 0; n < 2; ++n) _Pragma("unroll") for (int k = 0; k < 2; ++k) dst[n][k] = *(const PG8_LAS bf16x8*)(lds + PG8_SB(b, h) + boff + n * 2048 + k * 1024); } while (0)
#define PG8_MMA(ai, bj, At, Bt) do { __builtin_amdgcn_s_setprio(1); _Pragma("unroll") for (int m = 0; m < 4; ++m) _Pragma("unroll") for (int n = 0; n < 2; ++n) _Pragma("unroll") for (int k = 0; k < 2; ++k) \
        acc[ai][bj][m][n] = __builtin_amdgcn_mfma_f32_16x16x32_bf16(Bt[n][k], At[m][k], acc[ai][bj][m][n], 0, 0, 0); __builtin_amdgcn_s_setprio(0); } while (0)
#define PG8_WAIT_V(n) asm volatile("s_waitcnt vmcnt(" #n ")" ::: "memory")
#define PG8_WAIT_L(n) asm volatile("s_waitcnt lgkmcnt(" #n ")" ::: "memory")
#define PG8_BAR __builtin_amdgcn_s_barrier()
#define PG8_SCHED __builtin_amdgcn_sched_barrier(0)
    Unit cur, nxt; int ui = 0;
    if (!S.next(0, cur)) return;
    f32x4 acc[2][2][4][2];
#pragma unroll
    for (int a = 0; a < 2; ++a)
#pragma unroll
        for (int b = 0; b < 2; ++b)
#pragma unroll
            for (int m = 0; m < 4; ++m)
#pragma unroll
                for (int n = 0; n < 2; ++n) acc[a][b][m][n] = (f32x4){0.f, 0.f, 0.f, 0.f};
    bf16x8 At[4][2], B0[2][2], B1[2][2];
    const char* cA = (const char*)g.A + (size_t)cur.pm * tsA; const char* cB = (const char*)g.Bt + (size_t)cur.pn * tsB;
    S.a_ready(cur);
    if constexpr (SP2) {
        PG8_STAGE(PG8_SB(0, 0), cB, voffB); PG8_STAGE(PG8_SB(0, 1), cB + hsB, voffB); PG8_STAGE(PG8_SA(0, 0), cA, voffA); PG8_STAGE(PG8_SA(0, 1), cA + hsA, voffA);
        if (wr == 1) PG8_BAR;
        PG8_WAIT_V(2); PG8_BAR;
        PG8_STAGE(PG8_SB(1, 0), cB + kstep, voffB); PG8_STAGE(PG8_SA(1, 0), cA + kstep, voffA); PG8_STAGE(PG8_SB(1, 1), cB + hsB + kstep, voffB);
        PG8_WAIT_V(6); PG8_BAR;
    } else {
        PG8_STAGE(PG8_SB(0, 0), cB, voffB); PG8_STAGE(PG8_SA(0, 0), cA, voffA); PG8_STAGE(PG8_SB(0, 1), cB + hsB, voffB); PG8_STAGE(PG8_SA(0, 1), cA + hsA, voffA);
        if (wr == 1) PG8_BAR;
        PG8_WAIT_V(4); PG8_BAR;
        PG8_STAGE(PG8_SB(1, 0), cB + kstep, voffB); PG8_STAGE(PG8_SA(1, 0), cA + kstep, voffA); PG8_STAGE(PG8_SB(1, 1), cB + hsB + kstep, voffB);
        PG8_WAIT_V(6); PG8_BAR;
    }
    for (;;) {
        const bool has_next = S.next(ui + 1, nxt);
        const char* nA = has_next ? (const char*)g.A + (size_t)nxt.pm * tsA : cA; const char* nB = has_next ? (const char*)g.Bt + (size_t)nxt.pn * tsB : cB;
        for (int t = 0; t < nt; t += 2) {
            const bool last = (t == nt - 2);
            const char* a1 = cA + (size_t)(t + 1) * kstep;
            const char* a2 = last ? nA : cA + (size_t)(t + 2) * kstep; const char* b2 = last ? nB : cB + (size_t)(t + 2) * kstep;
            const char* a3 = a2 + kstep; const char* b3 = b2 + kstep;
            if (last && has_next) S.a_ready(nxt);
            if constexpr (SP2) {
            PG8_LDB(B0, 0, 0); PG8_LDB(B1, 0, 1); PG8_SCHED; PG8_LDA(At, 0, 0); PG8_STAGE(PG8_SA(1, 1), a1 + hsA, voffA);
            PG8_WAIT_V(8); PG8_WAIT_L(0); PG8_BAR; PG8_MMA(0, 0, At, B0); PG8_MMA(0, 1, At, B1); PG8_BAR; PG8_SCHED;
            PG8_LDA(At, 0, 1); PG8_STAGE(PG8_SB(0, 0), b2, voffB); PG8_STAGE(PG8_SB(0, 1), b2 + hsB, voffB); PG8_STAGE(PG8_SA(0, 0), a2, voffA);
            PG8_WAIT_V(8); PG8_WAIT_L(0); PG8_BAR; PG8_MMA(1, 0, At, B0); PG8_MMA(1, 1, At, B1); PG8_BAR; PG8_SCHED;
            PG8_LDB(B0, 1, 0); PG8_LDB(B1, 1, 1); PG8_SCHED; PG8_LDA(At, 1, 0); PG8_STAGE(PG8_SA(0, 1), a2 + hsA, voffA);
            PG8_WAIT_V(8); PG8_WAIT_L(0); PG8_BAR; PG8_MMA(0, 0, At, B0); PG8_MMA(0, 1, At, B1); PG8_BAR; PG8_SCHED;
            PG8_LDA(At, 1, 1); PG8_STAGE(PG8_SB(1, 0), b3, voffB); PG8_STAGE(PG8_SB(1, 1), b3 + hsB, voffB); PG8_STAGE(PG8_SA(1, 0), a3, voffA);
            PG8_WAIT_V(8); PG8_WAIT_L(0); PG8_BAR; PG8_MMA(1, 0, At, B0); PG8_MMA(1, 1, At, B1); PG8_BAR; PG8_SCHED;
            } else {
            PG8_LDB(B0, 0, 0); PG8_SCHED; PG8_LDA(At, 0, 0); PG8_STAGE(PG8_SA(1, 1), a1 + hsA, voffA);
            PG8_WAIT_L(8); PG8_BAR; PG8_WAIT_L(0); PG8_MMA(0, 0, At, B0); PG8_BAR; PG8_SCHED;
            PG8_LDB(B1, 0, 1); PG8_STAGE(PG8_SB(0, 0), b2, voffB);
            PG8_BAR; PG8_WAIT_L(0); PG8_MMA(0, 1, At, B1); PG8_BAR;
            PG8_LDA(At, 0, 1); PG8_STAGE(PG8_SA(0, 0), a2, voffA);
            PG8_BAR; PG8_WAIT_L(0); PG8_MMA(1, 0, At, B0); PG8_BAR; PG8_SCHED;
            PG8_STAGE(PG8_SB(0, 1), b2 + hsB, voffB);
            PG8_WAIT_V(6); PG8_BAR; PG8_MMA(1, 1, At, B1); PG8_BAR;
            PG8_LDB(B0, 1, 0); PG8_SCHED; PG8_LDA(At, 1, 0); PG8_STAGE(PG8_SA(0, 1), a2 + hsA, voffA);
            PG8_WAIT_L(8); PG8_BAR; PG8_WAIT_L(0); PG8_MMA(0, 0, At, B0); PG8_BAR; PG8_SCHED;
            PG8_LDB(B1, 1, 1); PG8_STAGE(PG8_SB(1, 0), b3, voffB);
            PG8_BAR; PG8_WAIT_L(0); PG8_MMA(0, 1, At, B1); PG8_BAR;
            PG8_LDA(At, 1, 1); PG8_STAGE(PG8_SA(1, 0), a3, voffA);
            PG8_BAR; PG8_WAIT_L(0); PG8_MMA(1, 0, At, B0); PG8_BAR; PG8_SCHED;
            PG8_STAGE(PG8_SB(1, 1), b3 + hsB, voffB);
            PG8_WAIT_V(6); PG8_BAR; PG8_MMA(1, 1, At, B1); PG8_BAR;
            }
        }
        if constexpr (ALIGN_EPI) { if (wr == 0) PG8_BAR; }
        if constexpr (!Epi::AFTER_DRAIN) { int fr2 = fr, fq2 = fq; asm volatile("" : "+v"(fr2), "+v"(fq2)); E(acc, cur, wr, wc, fr2, fq2); S.done(cur); }
        if (!has_next) break;
#pragma unroll
        for (int a = 0; a < 2; ++a)
#pragma unroll
            for (int b = 0; b < 2; ++b)
#pragma unroll
                for (int m = 0; m < 4; ++m)
#pragma unroll
                    for (int n = 0; n < 2; ++n) acc[a][b][m][n] = (f32x4){0.f, 0.f, 0.f, 0.f};
        cur = nxt; cA = nA; cB = nB; ++ui;
        if constexpr (ALIGN_EPI) { if (wr == 1) PG8_BAR; }
    }
    PG8_WAIT_V(0);
    if constexpr (!ALIGN_EPI) { if (wr == 0) PG8_BAR; }
    PG8_BAR;
    if constexpr (Epi::AFTER_DRAIN) { int fr2 = fr, fq2 = fq, lane2 = lane; asm volatile("" : "+v"(fr2), "+v"(fq2), "+v"(lane2)); E.fused(acc, cur, wr, wc, fr2, fq2, lds, wid, lane2); S.done(cur); }
#undef PG8_SA
#undef PG8_SB
#undef PG8_STAGE
#undef PG8_LDA
#undef PG8_LDB
#undef PG8_MMA
#undef PG8_WAIT_V
#undef PG8_WAIT_L
#undef PG8_BAR
#undef PG8_SCHED
}}

#define GAS __attribute__((address_space(1)))
#define LAS __attribute__((address_space(3)))
typedef unsigned v4u __attribute__((ext_vector_type(4)));
typedef float f32x4 __attribute__((ext_vector_type(4)));
typedef short bf16x8 __attribute__((ext_vector_type(8)));
typedef GAS unsigned gu32;
typedef GAS unsigned long long gu64;
#define RLX_AGENT __ATOMIC_RELAXED, __HIP_MEMORY_SCOPE_AGENT
#define LDS_WAIT() asm volatile("s_waitcnt lgkmcnt(0)" ::: "memory")
#define VM_WAIT() asm volatile("s_waitcnt vmcnt(0)" ::: "memory")
__device__ __forceinline__ unsigned long long rt() { return __builtin_amdgcn_s_memrealtime(); }
__device__ __forceinline__ unsigned pk2(float lo, float hi) { return (unsigned)f2bf(lo) | ((unsigned)f2bf(hi) << 16); }

#define XB_TMO      128
#define XB_XCNT(j)  (256  + 64 * (j))
#define XB_XSUB(j)  (1280 + 64 * (j))
#define XB_XGEN(j)  (2304 + 64 * (j))
#define XB_TOP      3328
#define XB_TOPGEN   3392
#define XCD_BAR_WORDS 3456
#define XB_SPIN_CAP (1u << 18)

__device__ __forceinline__ unsigned xb_ld(unsigned* p)              { return __hip_atomic_load(p, __ATOMIC_RELAXED, __HIP_MEMORY_SCOPE_AGENT); }
__device__ __forceinline__ unsigned xb_add(unsigned* p, unsigned v) { return __hip_atomic_fetch_add(p, v, __ATOMIC_RELAXED, __HIP_MEMORY_SCOPE_AGENT); }
__device__ __forceinline__ unsigned xb_xcc_id() { return (unsigned)__builtin_amdgcn_s_getreg((3 << 11) | 20) & 0xFu; }
#define XB_SPIN(cond, bar) do { unsigned _sp = 0; while (cond) { __builtin_amdgcn_s_sleep(1); \
    if ((++_sp & 255u) == 0u) { if (xb_ld(&(bar)[XB_TMO])) break; if (_sp > XB_SPIN_CAP) { atomicAdd(&(bar)[XB_TMO], 1u); break; } } } } while (0)

struct XcdBarrier {
    unsigned* bar; unsigned x;
    volatile LAS unsigned* st;
};

__device__ __forceinline__ XcdBarrier xcd_barrier_post(unsigned* bar, volatile LAS unsigned* st) {
    XcdBarrier b; b.bar = bar; b.x = xb_xcc_id(); b.st = st;
    if (threadIdx.x == 0) (void)xb_add(&bar[XB_XCNT(b.x)], 1u);
    return b;
}
__device__ __forceinline__ void xcd_barrier_complete(unsigned* bar, unsigned x, unsigned& nloc, unsigned& nx) {
    const unsigned G = gridDim.x * gridDim.y * gridDim.z;
    unsigned sum, cnt, mine, sp = 0u;
    for (;;) {
        sum = 0u; cnt = 0u; mine = 0u;
#pragma unroll
        for (unsigned j = 0; j < 16; ++j) { const unsigned c = xb_ld(&bar[XB_XCNT(j)]); sum += c; cnt += (c > 0u) ? 1u : 0u; mine = (j == x) ? c : mine; }
        if (sum == G) break;
        __builtin_amdgcn_s_sleep(1);
        if ((++sp & 255u) == 0u) { if (xb_ld(&bar[XB_TMO])) break; if (sp > XB_SPIN_CAP) { atomicAdd(&bar[XB_TMO], 1u); break; } }
    }
    nloc = mine > 0u ? mine : 1u; nx = cnt > 0u ? cnt : 1u;
}

__device__ __forceinline__ void xcd_barrier(const XcdBarrier& b) {
    asm volatile("s_waitcnt vmcnt(0)" ::: "memory");
    __syncthreads();
    if (threadIdx.x == 0) {
        unsigned* bar = b.bar;
        __builtin_amdgcn_s_waitcnt(0);
        unsigned nloc = b.st[0], nx = b.st[1];
        if (nloc == 0u) { xcd_barrier_complete(bar, b.x, nloc, nx); b.st[0] = nloc; b.st[1] = nx; }
        const unsigned old = xb_add(&bar[XB_XSUB(b.x)], 1u);
        const unsigned gen = old / nloc;
        if (old + 1u == (gen + 1u) * nloc) {
            __builtin_amdgcn_fence(__ATOMIC_RELEASE, "agent");
            asm volatile("s_waitcnt vmcnt(0)" ::: "memory");
            const unsigned og = xb_add(&bar[XB_TOP], 1u);
            const unsigned tg = og / nx;
            if (og + 1u == (tg + 1u) * nx) xb_add(&bar[XB_TOPGEN], 1u);
            else XB_SPIN(xb_ld(&bar[XB_TOPGEN]) == tg, bar);
            __builtin_amdgcn_fence(__ATOMIC_ACQUIRE, "agent");
            xb_add(&bar[XB_XGEN(b.x)], 1u);
            asm volatile("s_waitcnt vmcnt(0)" ::: "memory");
        } else {
            XB_SPIN(xb_ld(&bar[XB_XGEN(b.x)]) == gen, bar);
            __builtin_amdgcn_fence(__ATOMIC_ACQUIRE, "agent");
            asm volatile("s_waitcnt vmcnt(0)" ::: "memory");
        }
    }
    __syncthreads();
}
constexpr int NWAVES = 8;
constexpr int RING_OFF = 0, RING_BYTES = 131072;
constexpr int LDSCTL_OFF = RING_BYTES, MISC_OFF = LDSCTL_OFF + 320;
constexpr int LDS_RQ = RING_BYTES + 1024, LDS_IL = RING_BYTES + 2048;
constexpr int LDS_BYTES = 147456;
constexpr int CW_TMO = 0, CW_BAR = 4096;

struct Frame {
    LAS unsigned char* lds; volatile LAS unsigned* MISC; gu32* ctl;
    int tid, lane, wave, vcu, G;
};
struct Args { const void* in[26]; float* out; unsigned char* ws; int ph_lo, ph_hi; };

__device__ __forceinline__ float wave_sum(float v) {
#pragma unroll
    for (int o = 1; o < 64; o <<= 1) v += __shfl_xor(v, o);
    return v;
}
template <bool HEADPERM> __device__ __forceinline__ void p0_transpose_item(const float* W, int ldw, int K, int N, const float* g, bf16_t* WT, LAS float* scr, int item, int lane) {
    const int nblk = N / 32, kb = item / nblk, nb = item % nblk, k0 = 64 * kb, n0 = 32 * nb;
    const int r8 = lane >> 3, c4 = (lane & 7) * 4;
    f32x4 v[8]; float gg[8];
#pragma unroll
    for (int i = 0; i < 8; ++i) { v[i] = *(const GAS f32x4*)(W + (size_t)(k0 + r8 + 8 * i) * ldw + n0 + c4); gg[i] = g ? g[k0 + r8 + 8 * i] : 1.f; }
#pragma unroll
    for (int i = 0; i < 8; ++i) { LAS float* d = scr + (r8 + 8 * i) * 33 + c4; const f32x4 x = v[i] * gg[i]; d[0] = x.x; d[1] = x.y; d[2] = x.z; d[3] = x.w; }
    LDS_WAIT(); asm volatile("" ::: "memory");
    const int c = lane & 7;
#pragma unroll
    for (int j = 0; j < 4; ++j) { const int n = (lane >> 3) + 8 * j; const LAS float* s = scr + (8 * c) * 33 + n;
        v4u o; o.x = pk2(s[0 * 33], s[1 * 33]); o.y = pk2(s[2 * 33], s[3 * 33]); o.z = pk2(s[4 * 33], s[5 * 33]); o.w = pk2(s[6 * 33], s[7 * 33]);
        int nr = n0 + n; if (HEADPERM) { const int l = nr & 255; nr = (nr & ~255) | (((l >> 5) & 1) * 128 + (l >> 6) * 32 + (l & 31)); }
        *(GAS v4u*)(WT + (size_t)nr * K + k0 + 8 * c) = o; }
    LDS_WAIT(); asm volatile("" ::: "memory");
}
template <bool FLOG> __device__ __forceinline__ void rms_rows_to_bf16(int lane, const float* X, bf16_t* O, int m0, int step, int rows, const float* g, const float* win, float* flog, float* rs0) {
    if (m0 >= rows) return;
    f32x4 wf[4][4][2];
    if (FLOG) {
#pragma unroll
        for (int j = 0; j < 4; ++j) { const f32x4 gg = *(const GAS f32x4*)(g + 256 * j + 4 * lane);
#pragma unroll
            for (int e = 0; e < 4; ++e) { const int k = 256 * j + 4 * lane + e; wf[j][e][0] = *(const GAS f32x4*)(win + (size_t)k * INCOLS + NPROJ) * gg[e]; wf[j][e][1] = *(const GAS f32x4*)(win + (size_t)k * INCOLS + NPROJ + 4) * gg[e]; } }
    }
    f32x4 nx[4], nx2[4];
    { const GAS f32x4* xr = (const GAS f32x4*)(X + (size_t)m0 * DM) + lane;
#pragma unroll
      for (int j = 0; j < 4; ++j) nx[j] = xr[64 * j];
      if (m0 + step < rows) { const GAS f32x4* xr2 = (const GAS f32x4*)(X + (size_t)(m0 + step) * DM) + lane;
#pragma unroll
          for (int j = 0; j < 4; ++j) nx2[j] = xr2[64 * j]; } }
    for (int m = m0; m < rows; m += step) {
        f32x4 v[4];
#pragma unroll
        for (int j = 0; j < 4; ++j) { v[j] = nx[j]; nx[j] = nx2[j]; }
        if (m + 2 * step < rows) { const GAS f32x4* xr = (const GAS f32x4*)(X + (size_t)(m + 2 * step) * DM) + lane;
#pragma unroll
            for (int j = 0; j < 4; ++j) nx2[j] = xr[64 * j]; }
        float s2 = 0.f;
#pragma unroll
        for (int j = 0; j < 4; ++j) s2 += (v[j].x * v[j].x + v[j].y * v[j].y) + (v[j].z * v[j].z + v[j].w * v[j].w);
        const float ms_ = wave_sum(s2) * (1.f / DM) + EPS; const float rstd = rsqrtf(ms_);
        if (FLOG) { if (lane == 0) rs0[m] = sqrtf(ms_); }
        GAS unsigned long long* o8 = (GAS unsigned long long*)(O + (size_t)m * DM) + lane;
#pragma unroll
        for (int j = 0; j < 4; ++j) { v[j] = v[j] * rstd; o8[64 * j] = (unsigned long long)pk2(v[j].x, v[j].y) | ((unsigned long long)pk2(v[j].z, v[j].w) << 32); }
        if (FLOG) {
            f32x4 a0 = {0.f, 0.f, 0.f, 0.f}, a1 = {0.f, 0.f, 0.f, 0.f};
#pragma unroll
            for (int j = 0; j < 4; ++j)
#pragma unroll
                for (int e = 0; e < 4; ++e) { a0 += wf[j][e][0] * v[j][e]; a1 += wf[j][e][1] * v[j][e]; }
#pragma unroll
            for (int e = 0; e < 4; ++e) { a0[e] = wave_sum(a0[e]); a1[e] = wave_sum(a1[e]); }
            if (lane == 0) { *(GAS f32x4*)(flog + (size_t)m * 8) = a0; *(GAS f32x4*)(flog + (size_t)m * 8 + 4) = a1; }
        }
    }
}
__constant__ float INV_FREQ[8] = {1.0f, 0.1939227432012558f, 0.03760603070259094f, 0.007292664609849453f, 0.0014142135623842478f, 0.00027424818836152554f, 5.318296098266728e-05f, 1.0313386155758053e-05f};

struct Ptrs {
    const float *x, *mem; const int* pos; const float *norm_mix_w, *w_in, *b_forget, *dqw, *dkw, *lq1, *lk1, *lq2, *lk2, *subw, *fqw, *fkw, *w_out, *nmq, *nmkv, *w_mq, *w_mkv, *mqw, *mkw, *w_mo, *nmlp, *w_up, *w_dn;
    float* out; float *FLOG, *CUMB, *ROPE, *SS, *QKW, *RS0;
    bf16_t *WIN, *WOUT, *WQ, *WKV, *WO, *WUP, *WDN, *XB, *HM, *MK, *VT, *MKN, *PROJ, *ATT, *MQ, *MO, *H;
};
__host__ __device__ __forceinline__ Ptrs make_ptrs(const void* const* in, float* out, unsigned char* ws) {
    Ptrs p;
    p.x = (const float*)in[0]; p.mem = (const float*)in[1]; p.pos = (const int*)in[2]; p.norm_mix_w = (const float*)in[3]; p.w_in = (const float*)in[4]; p.b_forget = (const float*)in[5];
    p.dqw = (const float*)in[6]; p.dkw = (const float*)in[7]; p.lq1 = (const float*)in[8]; p.lk1 = (const float*)in[9]; p.lq2 = (const float*)in[10]; p.lk2 = (const float*)in[11];
    p.subw = (const float*)in[12]; p.fqw = (const float*)in[13]; p.fkw = (const float*)in[14]; p.w_out = (const float*)in[15]; p.nmq = (const float*)in[16]; p.nmkv = (const float*)in[17];
    p.w_mq = (const float*)in[18]; p.w_mkv = (const float*)in[19]; p.mqw = (const float*)in[20]; p.mkw = (const float*)in[21]; p.w_mo = (const float*)in[22]; p.nmlp = (const float*)in[23];
    p.w_up = (const float*)in[24]; p.w_dn = (const float*)in[25]; p.out = out;
    p.FLOG = (float*)(ws + WS_FLOG); p.CUMB = (float*)(ws + WS_CUMB); p.ROPE = (float*)(ws + WS_ROPE); p.SS = (float*)(ws + WS_SS); p.QKW = (float*)(ws + WS_QKW); p.RS0 = (float*)(ws + WS_RS0);
    p.WIN = (bf16_t*)(ws + WS_WIN); p.WOUT = (bf16_t*)(ws + WS_WOUT); p.WQ = (bf16_t*)(ws + WS_WQ); p.WKV = (bf16_t*)(ws + WS_WKV); p.WO = (bf16_t*)(ws + WS_WO); p.WUP = (bf16_t*)(ws + WS_WUP); p.WDN = (bf16_t*)(ws + WS_WDN);
    p.XB = (bf16_t*)(ws + WS_XB); p.HM = (bf16_t*)(ws + WS_HM); p.MK = (bf16_t*)(ws + WS_MK); p.VT = (bf16_t*)(ws + WS_VT); p.MKN = (bf16_t*)(ws + WS_MKN);
    p.PROJ = (bf16_t*)(ws + WS_PROJ); p.ATT = (bf16_t*)(ws + WS_ATT); p.MQ = (bf16_t*)(ws + WS_MQ); p.MO = (bf16_t*)(ws + WS_MO); p.H = (bf16_t*)(ws + WS_H);
    return p;
}

__device__ __forceinline__ void p0_prologue(Frame& F, const Ptrs& P) {
    LAS float* scr = (LAS float*)(F.lds + RING_OFF + F.wave * 16384);
    const int gw = F.vcu * NWAVES + F.wave, NGW = F.G * NWAVES;
    constexpr int I_IN = 16 * 96, I_KV = 16 * 64;
    constexpr int NITEMS = I_IN + I_KV;
    for (int it = gw; it < NITEMS; it += NGW) {
        if (it < I_IN) p0_transpose_item<true>(P.w_in, INCOLS, DM, NPROJ, P.norm_mix_w, P.WIN, scr, it, F.lane);
        else p0_transpose_item<false>(P.w_mkv, 2048, DM, 2048, P.nmkv, P.WKV, scr, it - I_IN, F.lane);
    }
    rms_rows_to_bf16<true>(F.lane, P.x, P.XB, gw, NGW, MTOK, P.norm_mix_w, P.w_in, P.FLOG, P.RS0);
    rms_rows_to_bf16<false>(F.lane, P.mem, P.HM, gw, NGW, MMEM, nullptr, nullptr, nullptr, nullptr);
    if (blockIdx.x == 0 && F.tid < 64) { const int t = F.tid; P.QKW[t] = P.dqw[t]; P.QKW[64 + t] = P.dkw[t]; P.QKW[128 + t] = P.fqw[t]; P.QKW[192 + t] = P.fkw[t]; }
    for (int id = (F.vcu * NWAVES * 64) + F.tid; id < MTOK * 8; id += F.G * NWAVES * 64) {
        const int row = id >> 3, i = id & 7;
        const float ang = (float)P.pos[row] * INV_FREQ[i];
        const double a = (double)ang; const double k = rint(a * 0.15915494309189535); const float r = (float)fma(-k, 6.283185307179586, a);
        P.ROPE[(size_t)row * 16 + i] = cosf(r); P.ROPE[(size_t)row * 16 + 8 + i] = sinf(r);
    }
}
__device__ __forceinline__ void p1b_row(bf16_t* PROJ, const float* dqw, const float* dkw, const float* fqw, const float* fkw, const float* ROPE, int row, int lane) {
    const int sg = lane >> 1, hf = lane & 1;
    const int col = (sg < 16 ? sg * 64 : 1536 + (sg - 16) * 64) + hf * 32;
    const float* w = (sg < 8 ? dqw : sg < 16 ? dkw : sg < 24 ? fqw : fkw) + hf * 32;
    const bool rope = (sg < 16) && (hf == 0), isq = (sg < 8) || (sg >= 16 && sg < 24);
    GAS v4u* p = (GAS v4u*)(PROJ + (size_t)row * NPROJ + col);
    const v4u u0 = p[0], u1 = p[1], u2 = p[2], u3 = p[3];
#define UNP_LO(u) (f32x4){__uint_as_float(u.x << 16), __uint_as_float(u.x & 0xffff0000u), __uint_as_float(u.y << 16), __uint_as_float(u.y & 0xffff0000u)}
#define UNP_HI(u) (f32x4){__uint_as_float(u.z << 16), __uint_as_float(u.z & 0xffff0000u), __uint_as_float(u.w << 16), __uint_as_float(u.w & 0xffff0000u)}
    f32x4 v0 = UNP_LO(u0), v1 = UNP_HI(u0), v2 = UNP_LO(u1), v3 = UNP_HI(u1), v4 = UNP_LO(u2), v5 = UNP_HI(u2), v6 = UNP_LO(u3), v7 = UNP_HI(u3);
#undef UNP_LO
#undef UNP_HI
#define SQ4(v) ((v.x * v.x + v.y * v.y) + (v.z * v.z + v.w * v.w))
    float ss = (SQ4(v0) + SQ4(v1)) + (SQ4(v2) + SQ4(v3)) + (SQ4(v4) + SQ4(v5)) + (SQ4(v6) + SQ4(v7));
#undef SQ4
    ss += __shfl_xor(ss, 1);
    const float rstd = rsqrtf(ss * (1.f / 64.f) + EPS);
    const GAS f32x4* wg = (const GAS f32x4*)w;
    v0 = v0 * rstd * wg[0]; v1 = v1 * rstd * wg[1]; v2 = v2 * rstd * wg[2]; v3 = v3 * rstd * wg[3]; v4 = v4 * rstd * wg[4]; v5 = v5 * rstd * wg[5]; v6 = v6 * rstd * wg[6]; v7 = v7 * rstd * wg[7];
    if (rope) {
        const GAS f32x4* rt = (const GAS f32x4*)(ROPE + (size_t)row * 16);
        const f32x4 c0 = rt[0], c1 = rt[1], s0 = rt[2], s1 = rt[3];
        const f32x4 a0 = v0 * c0 - v2 * s0, b0 = v2 * c0 + v0 * s0, a1 = v1 * c1 - v3 * s1, b1 = v3 * c1 + v1 * s1;
        v0 = a0; v2 = b0; v1 = a1; v3 = b1;
    }
    const float sc = isq ? C2 : 1.f;
#define PK4(a, b) (v4u){pk2(a.x * sc, a.y * sc), pk2(a.z * sc, a.w * sc), pk2(b.x * sc, b.y * sc), pk2(b.z * sc, b.w * sc)}
    p[0] = PK4(v0, v1); p[1] = PK4(v2, v3); p[2] = PK4(v4, v5); p[3] = PK4(v6, v7);
#undef PK4
}
__device__ __forceinline__ void p1b_cumsum_wg(const float* FLOG, const float* b_forget, float* CUMB, int seq, int tid, LAS float* scr) {
    const int b = seq >> 3, h = seq & 7, lane = tid & 63, wv = tid >> 6; const float bf = b_forget[h];
    float lf[4]; float run = 0.f;
#pragma unroll
    for (int i = 0; i < 4; ++i) { const float z = FLOG[(size_t)(b * SEQ + tid * 4 + i) * 8 + h] + bf; const float e = __expf(-fabsf(z)); lf[i] = fminf(z, 0.f) - log1pf(e); run += lf[i]; }
    float inc = run;
#pragma unroll
    for (int o = 1; o < 64; o <<= 1) { const float t = __shfl_up(inc, o); if (lane >= o) inc += t; }
    if (lane == 63) scr[wv] = inc;
    __syncthreads();
    float base = 0.f;
#pragma unroll
    for (int w = 0; w < 8; ++w) { const float t = scr[w]; if (w < wv) base += t; }
    float c = base + inc - run;
    f32x4 o;
#pragma unroll
    for (int i = 0; i < 4; ++i) { c += lf[i]; o[i] = -c * LOG2E; }
    *(GAS f32x4*)(CUMB + (size_t)seq * SEQ + tid * 4) = o;
    __syncthreads();
}
__device__ __forceinline__ void p1b_cumsum(const Ptrs& P, int seq, int lane) {
    const int b = seq >> 3, h = seq & 7; const float bf = P.b_forget[h];
    float lf[32]; float run = 0.f;
#pragma unroll
    for (int i = 0; i < 32; ++i) { const float z = P.FLOG[(size_t)(b * SEQ + lane * 32 + i) * 8 + h] + bf;
        const float e = __expf(-fabsf(z)); lf[i] = fminf(z, 0.f) - log1pf(e); run += lf[i]; }
    float inc = run;
#pragma unroll
    for (int o = 1; o < 64; o <<= 1) { const float t = __shfl_up(inc, o); if (lane >= o) inc += t; }
    float c = inc - run;
#pragma unroll
    for (int i = 0; i < 32; ++i) { c += lf[i]; P.CUMB[(size_t)seq * SEQ + lane * 32 + i] = -c * LOG2E; }
}
#ifndef PROBE_K
#define PROBE_K -1
#endif
struct Sched {
    pg8::StaticOrder so; int mode, pm, pn; bool has;
    __device__ __forceinline__ bool next(int i, pg8::Unit& u) const { if (mode == 0) return so.next(i, u); if (i != 0 || !has) return false; u.pm = pm; u.pn = pn; return true; }
    __device__ __forceinline__ void a_ready(const pg8::Unit&) const {}
    __device__ __forceinline__ void done(const pg8::Unit&) const {}
};
__device__ __forceinline__ Sched sched_static(int M, int N, int G, int c) { Sched s; s.so.init(M, N, G, c); s.mode = 0; s.pm = 0; s.pn = 0; s.has = true; return s; }
__device__ __forceinline__ Sched sched_one(int pm, int pn, bool has) { Sched s; s.so.init(256, 256, 1, 0); s.mode = 1; s.pm = pm; s.pn = pn; s.has = has; return s; }

#include <hip/hip_bf16.h>
#include <cmath>
namespace ab {
using bf16=__hip_bfloat16;
using bf16x8=__attribute__((ext_vector_type(8)))short;
using s16x4=__attribute__((ext_vector_type(4)))short;
using f32x16=__attribute__((ext_vector_type(16)))float;
using u32x4=__attribute__((ext_vector_type(4)))unsigned;
using f32x4v=__attribute__((ext_vector_type(4)))float;
constexpr int D=64,PIN=NPROJ;
constexpr int NW=8,QBLK=32,QB=QBLK*NW,KVBLK=64;
__device__ __forceinline__ int crow(int r,int hi){return (r&3)+8*(r>>2)+4*hi;}
#define SBAR() __builtin_amdgcn_sched_barrier(0)
__device__ __forceinline__ void cmask(f32x16&p0,f32x16&p1,int jb,int qrel,int hi){
  const float NEG=-INFINITY; int kb=64*jb+4*hi;
  #pragma unroll
  for(int r=0;r<16;++r){int kv=kb+(r&3)+8*(r>>2); if(kv>qrel)p0[r]=NEG; if(kv+32>qrel)p1[r]=NEG;}
}

__device__ __forceinline__ void kmask(f32x16&p0,f32x16&p1,int jb,int wid){
  if(jb>(wid>>1)){const float NEG=-INFINITY;
  #pragma unroll
  for(int r=0;r<16;++r){p0[r]=NEG;p1[r]=NEG;}}
}

constexpr int NSLOT=3, SLOTB=8192;
constexpr int LDS_K=0, LDS_V=NSLOT*SLOTB, LDS_WS=2*NSLOT*SLOTB, LDS_OST=LDS_WS+NW*64*4, LDS_BIAS=LDS_OST+NW*4096, LDS_BYTES=LDS_BIAS+8192;
__device__ __forceinline__ void glds16(const void*gsrc,unsigned lds_dst){unsigned keep;
  asm volatile("s_mov_b32 %0, m0\n\ts_mov_b32 m0, %2\n\ts_nop 0\n\tglobal_load_lds_dwordx4 %1, off\n\ts_mov_b32 m0, %0":"=&s"(keep):"v"(gsrc),"s"(lds_dst):"memory");}
__device__ __forceinline__ float max3f(float a,float b,float c){float r;asm("v_max3_f32 %0, %1, %2, %3":"=v"(r):"v"(a),"v"(b),"v"(c));return r;}
__device__ __forceinline__ float max2f(float a,float b){float r;asm("v_max_f32_e32 %0, %1, %2":"=v"(r):"v"(a),"v"(b));return r;}
__device__ __forceinline__ float fadd_s(float a,float b){float r;asm("v_add_f32_e32 %0, %1, %2":"=v"(r):"v"(a),"v"(b));return r;}
__device__ __forceinline__ float fsub_s(float a,float b){float r;asm("v_sub_f32_e32 %0, %1, %2":"=v"(r):"v"(a),"v"(b));return r;}
typedef float f32x2_t __attribute__((ext_vector_type(2))); typedef __bf16 bf16x2_t __attribute__((ext_vector_type(2)));
__device__ __forceinline__ unsigned cvtpk_s(float lo,float hi){f32x2_t v={lo,hi};bf16x2_t b=__builtin_convertvector(v,bf16x2_t);return __builtin_bit_cast(unsigned,b);}
#define WAIT_BAR(N) asm volatile("s_waitcnt vmcnt(" #N ") lgkmcnt(0)\n\ts_barrier":::"memory")

__device__ __forceinline__ void qkt(f32x16&p0,f32x16&p1,const char*Kslot,const bf16x8*qr,const f32x16&negm,int r32,int hi){
  const char*kb=Kslot+hi*1024+r32*16;
  #pragma unroll
  for(int d0=0;d0<4;++d0){
    const bf16x8 b0=*reinterpret_cast<const bf16x8*>(kb+d0*2048);
    const bf16x8 b1=*reinterpret_cast<const bf16x8*>(kb+d0*2048+512);
    if(d0==0){p0=__builtin_amdgcn_mfma_f32_32x32x16_bf16(b0,qr[0],negm,0,0,0);p1=__builtin_amdgcn_mfma_f32_32x32x16_bf16(b1,qr[0],negm,0,0,0);}
    else{p0=__builtin_amdgcn_mfma_f32_32x32x16_bf16(b0,qr[d0],p0,0,0,0);p1=__builtin_amdgcn_mfma_f32_32x32x16_bf16(b1,qr[d0],p1,0,0,0);}}
}
typedef __attribute__((address_space(3))) const char* lds_cptr;
typedef short v4i16_t __attribute__((ext_vector_type(4)));
__device__ __forceinline__ void kload8(bf16x8*kf,lds_cptr kp){
  kf[0]=*(const __attribute__((address_space(3))) bf16x8*)(kp);      kf[1]=*(const __attribute__((address_space(3))) bf16x8*)(kp+512);
  kf[2]=*(const __attribute__((address_space(3))) bf16x8*)(kp+2048); kf[3]=*(const __attribute__((address_space(3))) bf16x8*)(kp+2560);
  kf[4]=*(const __attribute__((address_space(3))) bf16x8*)(kp+4096); kf[5]=*(const __attribute__((address_space(3))) bf16x8*)(kp+4608);
  kf[6]=*(const __attribute__((address_space(3))) bf16x8*)(kp+6144); kf[7]=*(const __attribute__((address_space(3))) bf16x8*)(kp+6656);
}
__device__ __forceinline__ void kload2(bf16x8*kf,lds_cptr kp,int j){ kf[2*j]=*(const __attribute__((address_space(3))) bf16x8*)(kp+j*2048); kf[2*j+1]=*(const __attribute__((address_space(3))) bf16x8*)(kp+j*2048+512); }
__device__ __forceinline__ s16x4 vtr(lds_cptr p){ return __builtin_bit_cast(s16x4,__builtin_amdgcn_ds_read_tr16_b64_v4i16((__attribute__((address_space(3))) v4i16_t*)p)); }
__device__ __forceinline__ float rowmax(const f32x16&p0,const f32x16&p1){
  float a=max3f(p0[0],p0[1],p1[0]),b=max3f(p0[2],p0[3],p1[1]);a=max3f(a,p1[2],p1[3]);
  #pragma unroll
  for(int r=4;r<16;r+=4){a=max3f(a,p0[r],p0[r+1]);b=max3f(b,p0[r+2],p0[r+3]);a=max3f(a,p1[r],p1[r+1]);b=max3f(b,p1[r+2],p1[r+3]);}
  const float m=max2f(a,b);
  auto rr=__builtin_amdgcn_permlane32_swap(__float_as_uint(m),__float_as_uint(m),false,false);
  return max2f(__uint_as_float(rr[0]),__uint_as_float(rr[1]));
}
__device__ __forceinline__ void pv(f32x16*o,int vb,bf16x8 pa0,bf16x8 pa1,bf16x8 pa2,bf16x8 pa3){
  #pragma unroll
  for(int d0=0;d0<2;++d0){s16x4 lo[4],hi[4];
    #pragma unroll
    for(int ks=0;ks<4;++ks){
      asm volatile("ds_read_b64_tr_b16 %0,%1 offset:%c2":"=&v"(lo[ks]):"v"(vb),"i"(d0*4096+ks*1024):"memory");
      asm volatile("ds_read_b64_tr_b16 %0,%1 offset:%c2":"=&v"(hi[ks]):"v"(vb),"i"(d0*4096+ks*1024+512):"memory");}
    asm volatile("s_waitcnt lgkmcnt(0)":::"memory");SBAR();
    #define PK(k) (bf16x8){lo[k][0],lo[k][1],lo[k][2],lo[k][3],hi[k][0],hi[k][1],hi[k][2],hi[k][3]}
    o[d0]=__builtin_amdgcn_mfma_f32_32x32x16_bf16(pa0,PK(0),o[d0],0,0,0);
    o[d0]=__builtin_amdgcn_mfma_f32_32x32x16_bf16(pa1,PK(1),o[d0],0,0,0);
    o[d0]=__builtin_amdgcn_mfma_f32_32x32x16_bf16(pa2,PK(2),o[d0],0,0,0);
    o[d0]=__builtin_amdgcn_mfma_f32_32x32x16_bf16(pa3,PK(3),o[d0],0,0,0);
    #undef PK
  }
}

#ifndef ATTN_STORE16
#define ATTN_STORE16(p,v) (*(u32x4*)(p)=(v))
#endif
template<int THRL,int MASK,bool BIAS,bool WT> __device__ __forceinline__ void attn_unit(int qb,const bf16*Qh,const bf16*__restrict__ Kh,const bf16*__restrict__ Vh,bf16*Oh,int opitch,const float*__restrict__ biasg,char*shm){
  int tid_=threadIdx.x; asm volatile("":"+v"(tid_));
  const int tid=tid_,lane=tid&63,r32=lane&31,hi=lane>>5; const int wid=__builtin_amdgcn_readfirstlane(tid>>6);
  const int q0=qb*QB;
  const bf16*Qw=Qh+(long)(q0+wid*QBLK)*PIN;
  const unsigned lds0=(unsigned)(uintptr_t)shm;
  float*wsf=(float*)(shm+LDS_WS)+wid*64;
  const bf16*ksrc=Kh+(long)lane*PIN+wid*8;
  const bf16*vsrc=Vh+(long)(16*(wid&3)+(lane>>2))*PIN+(wid>>2)*32+(lane&3)*8;
  const unsigned kdst=lds0+LDS_K+wid*1024, vdst=lds0+LDS_V+wid*1024;
  #define DMA_K(t,slot) glds16(ksrc+(long)(t)*KVBLK*PIN,(unsigned)__builtin_amdgcn_readfirstlane(kdst+(slot)))
  #define DMA_V(t,slot) glds16(vsrc+(long)(t)*KVBLK*PIN,(unsigned)__builtin_amdgcn_readfirstlane(vdst+(slot)))
  const int vb0=(int)(lds0+LDS_V)+((lane>>4)&1)*32+(lane&3)*8+(4*hi+((lane&15)>>2))*64;
  const char*Kbase=shm+LDS_K; bf16x8 kf[8];
  const lds_cptr shm3=(lds_cptr)shm; const lds_cptr kp0=shm3+LDS_K+hi*1024+r32*16; const lds_cptr vp0=shm3+LDS_V+((lane>>4)&1)*32+(lane&3)*8+(4*hi+((lane&15)>>2))*64;
  const int NT=(q0+QB)/KVBLK;
  DMA_K(0,0);DMA_V(0,0);DMA_K(1,SLOTB);
  const float*biasl=(const float*)(shm+LDS_BIAS);
  if(BIAS){ int t2=tid; asm volatile("":"+v"(t2)); if(t2<NT*16){ const f32x4v bv=*reinterpret_cast<const f32x4v*>(biasg+t2*4); *reinterpret_cast<f32x4v*>(shm+LDS_BIAS+t2*16)=bv; } }
  bf16x8 qr[4];
  #pragma unroll
  for(int d0=0;d0<4;++d0)qr[d0]=*reinterpret_cast<const bf16x8*>(&Qw[(long)r32*PIN+d0*16+hi*8]);
  float mhat=0.f,l_reg=0.f;f32x16 o[2];o[0]=f32x16{};o[1]=f32x16{};f32x16 negm=f32x16{}; if(!BIAS){asm volatile("":"+v"(negm));}
  #define CIN (BIAS?f32x16{}:negm)
  const int qrel=wid*QBLK+r32;
  #define CMASK(P0,P1,t) do{int jb_=(t)-(NT-4); if(jb_>=0){ if(MASK==0)cmask(P0,P1,jb_,qrel,hi); else kmask(P0,P1,jb_,wid); } }while(0)
  #define BIASADD(P0,P1,t) do{ if(BIAS){ const float*bp_=biasl+64*(t)+4*hi; \
    _Pragma("unroll") for(int g_=0;g_<4;++g_){ const f32x4v a_=*reinterpret_cast<const f32x4v*>(bp_+8*g_)-mhat, b_=*reinterpret_cast<const f32x4v*>(bp_+32+8*g_)-mhat; \
      _Pragma("unroll") for(int e_=0;e_<4;++e_){ P0[4*g_+e_]+=a_[e_]; P1[4*g_+e_]+=b_[e_]; } if(g_&1){SBAR();} } } }while(0)
  bool resc=false;
  #define START(P0,P1) do{ const float rm=rowmax(P0,P1); resc=false; \
    { const float dl=rm; mhat=fadd_s(mhat,dl); \
      _Pragma("unroll") for(int r=0;r<16;++r){P0[r]=fsub_s(P0[r],dl);P1[r]=fsub_s(P1[r],dl);} \
      if(!BIAS){ _Pragma("unroll") for(int r=0;r<16;++r)negm[r]=-mhat; asm volatile("":"+v"(negm)); } } \
    _Pragma("unroll") for(int r=0;r<16;++r)P0[r]=__builtin_amdgcn_exp2f(P0[r]); }while(0)
  #define RESC() do{ if(resc){ asm volatile("s_waitcnt lgkmcnt(0)":::"memory"); \
      _Pragma("unroll") for(int d_=0;d_<2;++d_) _Pragma("unroll") for(int r=0;r<16;++r)o[d_][r]*=wsf[crow(r,hi)]; } }while(0)
  f32x16 pA0,pA1,pB0,pB1;
  int sl_prev=0,sl_cur=0,sl_next=SLOTB;
  #define ROT() do{sl_prev=sl_cur;sl_cur=sl_next;sl_next=(sl_next==(NSLOT-1)*SLOTB)?0:sl_next+SLOTB;}while(0)
  DMA_K(2,2*SLOTB);
  WAIT_BAR(3);
  qkt(pA0,pA1,Kbase,qr,CIN,r32,hi);asm volatile("s_nop 15\n\ts_nop 7":"+v"(pA0),"+v"(pA1));BIASADD(pA0,pA1,0);CMASK(pA0,pA1,0);
  START(pA0,pA1);
  _Pragma("unroll") for(int r=0;r<16;++r)pA1[r]=__builtin_amdgcn_exp2f(pA1[r]);
  WAIT_BAR(0);
  DMA_K(3,0);DMA_V(1,SLOTB);
  ROT();
  kload8(kf,kp0+sl_cur);
  WAIT_BAR(2);
  s16x4 vlo[8],vhi[8]; u32x4 pw0,pw1,pw2,pw3;
  #define PKW(P,B) cvtpk_s(P[B],P[B+1])
  #define PAF(k) __builtin_bit_cast(bf16x8,pw##k)
  #define VFR(i) (bf16x8){vlo[i][0],vlo[i][1],vlo[i][2],vlo[i][3],vhi[i][0],vhi[i][1],vhi[i][2],vhi[i][3]}
  #define PIN(x) asm volatile("":"+v"(x))
  #define MX3(a,b,c) __builtin_fmaxf(__builtin_fmaxf((a),(b)),(c))
  #define GAPA(MF,A0,A1,A2,A3,W0,W1,PW) do{ MF; sacc+=A0; sacc+=A1; sacc+=A2; sacc+=A3; PIN(sacc); W0; W1; PIN(PW); SBAR(); }while(0)
  #define EX(v) __builtin_amdgcn_exp2f(v)
  #define GAPB(MF,X,B) do{ MF; X[B]=EX(X[B]); X[B+1]=EX(X[B+1]); X[B+2]=EX(X[B+2]); X[B+3]=EX(X[B+3]); PIN(X); SBAR(); }while(0)
  #define VRD(i) do{ vlo[i]=vtr(vp_+(((i)>>2)*4096+((i)&3)*1024)); vhi[i]=vtr(vp_+(((i)>>2)*4096+((i)&3)*1024+512)); }while(0)
  #define KRD(G,j) do{ if(G){ kload2(kf,kp0+sl_next,j); SBAR(); } }while(0)
  #define STEP(C0,C1,P0,P1,t,GK,GV,GL) do{ SBAR(); \
    const lds_cptr vp_=vp0+sl_prev; \
    VRD(0); SBAR(); float sacc=(P0[0]+P0[1]); \
    GAPA(C0=__builtin_amdgcn_mfma_f32_32x32x16_bf16(kf[0],qr[0],CIN,0,0,0), P0[2],P0[3],P0[4],P0[5],     pw0[0]=PKW(P0,0), pw0[1]=PKW(P0,2), pw0); \
    VRD(4); SBAR(); GAPA(C1=__builtin_amdgcn_mfma_f32_32x32x16_bf16(kf[1],qr[0],CIN,0,0,0), P0[6],P0[7],P0[8],P0[9],     pw0[2]=PKW(P0,4), pw0[3]=PKW(P0,6), pw0); \
    VRD(1); SBAR(); GAPA(C0=__builtin_amdgcn_mfma_f32_32x32x16_bf16(kf[2],qr[1],C0,0,0,0),   P0[10],P0[11],P0[12],P0[13], pw1[0]=PKW(P0,8), pw1[1]=PKW(P0,10), pw1); \
    VRD(5); SBAR(); GAPA(C1=__builtin_amdgcn_mfma_f32_32x32x16_bf16(kf[3],qr[1],C1,0,0,0),   P0[14],P0[15],P1[0],P1[1],   pw1[2]=PKW(P0,12),pw1[3]=PKW(P0,14), pw1); \
    VRD(2); SBAR(); GAPA(C0=__builtin_amdgcn_mfma_f32_32x32x16_bf16(kf[4],qr[2],C0,0,0,0),   P1[2],P1[3],P1[4],P1[5],     pw2[0]=PKW(P1,0), pw2[1]=PKW(P1,2), pw2); \
    VRD(6); SBAR(); GAPA(C1=__builtin_amdgcn_mfma_f32_32x32x16_bf16(kf[5],qr[2],C1,0,0,0),   P1[6],P1[7],P1[8],P1[9],     pw2[2]=PKW(P1,4), pw2[3]=PKW(P1,6), pw2); \
    VRD(3); SBAR(); GAPA(C0=__builtin_amdgcn_mfma_f32_32x32x16_bf16(kf[6],qr[3],C0,0,0,0),   P1[10],P1[11],P1[12],P1[13], pw3[0]=PKW(P1,8), pw3[1]=PKW(P1,10), pw3); \
    VRD(7); SBAR(); GAPA(C1=__builtin_amdgcn_mfma_f32_32x32x16_bf16(kf[7],qr[3],C1,0,0,0),   P1[14],P1[15],0.f,0.f,       pw3[2]=PKW(P1,12),pw3[3]=PKW(P1,14), pw3); \
    l_reg+=sacc; \
    if(GK){DMA_K((t)+3,sl_cur);} if(GV){DMA_V((t)+1,sl_next);} \
    BIASADD(C0,C1,t); CMASK(C0,C1,t); \
    { float a=MX3(C0[0],C0[1],C1[0]),b=MX3(C0[2],C0[3],C1[1]); a=MX3(a,C1[2],C1[3]); \
      _Pragma("unroll") for(int r=4;r<16;r+=4){a=MX3(a,C0[r],C0[r+1]);b=MX3(b,C0[r+2],C0[r+3]);a=MX3(a,C1[r],C1[r+1]);b=MX3(b,C1[r+2],C1[r+3]);} \
      float rm=__builtin_fmaxf(a,b); { auto rr=__builtin_amdgcn_permlane32_swap(__float_as_uint(rm),__float_as_uint(rm),false,false); rm=__builtin_fmaxf(__uint_as_float(rr[0]),__uint_as_float(rr[1])); } \
      resc=false; \
      if(__builtin_expect(__any(rm>(float)THRL),0)){ const float dl=__builtin_fmaxf(rm,0.f); mhat+=dl; \
        _Pragma("unroll") for(int r=0;r<16;++r){C0[r]-=dl;C1[r]-=dl;} \
        if(!BIAS){ _Pragma("unroll") for(int r=0;r<16;++r)negm[r]=-mhat; asm volatile("":"+v"(negm)); } \
        const float f=__builtin_amdgcn_exp2f(-dl); l_reg*=f; if(hi==0)wsf[r32]=f; resc=true; } } \
    SBAR(); \
    GAPB(o[0]=__builtin_amdgcn_mfma_f32_32x32x16_bf16(PAF(0),VFR(0),o[0],0,0,0), C0,0); \
    GAPB(o[1]=__builtin_amdgcn_mfma_f32_32x32x16_bf16(PAF(0),VFR(4),o[1],0,0,0), C0,4); \
    KRD(GL,0); GAPB(o[0]=__builtin_amdgcn_mfma_f32_32x32x16_bf16(PAF(1),VFR(1),o[0],0,0,0), C0,8); \
    KRD(GL,1); GAPB(o[1]=__builtin_amdgcn_mfma_f32_32x32x16_bf16(PAF(1),VFR(5),o[1],0,0,0), C0,12); \
    KRD(GL,2); GAPB(o[0]=__builtin_amdgcn_mfma_f32_32x32x16_bf16(PAF(2),VFR(2),o[0],0,0,0), C1,0); \
    KRD(GL,3); GAPB(o[1]=__builtin_amdgcn_mfma_f32_32x32x16_bf16(PAF(2),VFR(6),o[1],0,0,0), C1,4); \
    GAPB(o[0]=__builtin_amdgcn_mfma_f32_32x32x16_bf16(PAF(3),VFR(3),o[0],0,0,0), C1,8); \
    GAPB(o[1]=__builtin_amdgcn_mfma_f32_32x32x16_bf16(PAF(3),VFR(7),o[1],0,0,0), C1,12); \
    }while(0)
  int t=1;
  #undef CMASK
  #define CMASK(P0,P1,t) do{}while(0)
  for(;t+5<NT;t+=2){
    STEP(pB0,pB1,pA0,pA1,t,true,true,true);     WAIT_BAR(2); RESC(); ROT();
    STEP(pA0,pA1,pB0,pB1,t+1,true,true,true);   WAIT_BAR(2); RESC(); ROT();
  }
  #undef CMASK
  #define CMASK(P0,P1,t) do{int jb_=(t)-(NT-4); if(jb_>=0){ if(MASK==0)cmask(P0,P1,jb_,qrel,hi); else kmask(P0,P1,jb_,wid); } }while(0)
  #define ENDW(tt) do{ if((tt)+3<NT){WAIT_BAR(2);} else if((tt)+2<NT){WAIT_BAR(1);} else {WAIT_BAR(0);} }while(0)
  for(;t+1<NT;t+=2){
    STEP(pB0,pB1,pA0,pA1,t,(t+3<NT),(t+1<NT),(t+1<NT));       ENDW(t);   RESC(); ROT();
    STEP(pA0,pA1,pB0,pB1,t+1,(t+4<NT),(t+2<NT),(t+2<NT));     ENDW(t+1); RESC(); ROT();
  }
  STEP(pB0,pB1,pA0,pA1,NT-1,false,false,false); RESC();
  { float sacc=pB0[0]+pB0[1]; _Pragma("unroll") for(int r=2;r<16;++r)sacc+=pB0[r]; _Pragma("unroll") for(int r=0;r<16;++r)sacc+=pB1[r]; l_reg+=sacc;
    pw0=(u32x4){PKW(pB0,0),PKW(pB0,2),PKW(pB0,4),PKW(pB0,6)};pw1=(u32x4){PKW(pB0,8),PKW(pB0,10),PKW(pB0,12),PKW(pB0,14)};pw2=(u32x4){PKW(pB1,0),PKW(pB1,2),PKW(pB1,4),PKW(pB1,6)};pw3=(u32x4){PKW(pB1,8),PKW(pB1,10),PKW(pB1,12),PKW(pB1,14)};
    SBAR(); pv(o,vb0+sl_cur,PAF(0),PAF(1),PAF(2),PAF(3)); }
  #undef PKW
  #undef PAF
  #undef VFR
  #undef PIN
  #undef MX3
  #undef GAPA
  #undef GAPB
  #undef EX
  #undef VRD
  #undef KRD
  #undef STEP
  #undef ENDW
  {auto rr=__builtin_amdgcn_permlane32_swap(__float_as_uint(l_reg),__float_as_uint(l_reg),false,false);l_reg=__uint_as_float(rr[0])+__uint_as_float(rr[1]);}
  if(hi==0)wsf[32+r32]=l_reg;asm volatile("s_waitcnt lgkmcnt(0)":::"memory");
  float rli[16];
  #pragma unroll
  for(int r=0;r<16;++r)rli[r]=__builtin_amdgcn_rcpf(wsf[32+crow(r,hi)]);
  bf16*Ow=Oh+(long)(q0+wid*QBLK)*opitch;
  { bf16*stg=(bf16*)(shm+LDS_OST)+wid*2048;
    #pragma unroll
    for(int r=0;r<16;++r){const int orow=crow(r,hi);
      #pragma unroll
      for(int d0=0;d0<2;++d0)stg[orow*64+d0*32+r32]=__float2bfloat16(o[d0][r]*rli[r]);}
    asm volatile("s_waitcnt lgkmcnt(0)":::"memory");
    if(WT){ const __amdgpu_buffer_rsrc_t rs_=__builtin_amdgcn_make_buffer_rsrc((void*)Oh,(short)0,0x7fffffff,0x00020000);
      #pragma unroll
      for(int i=0;i<4;++i){const int row=i*8+(lane>>3),ch=lane&7; const u32x4 v=*(const u32x4*)(stg+row*64+ch*8); __builtin_amdgcn_raw_buffer_store_b128(v,rs_,(int)(((long)(q0+wid*QBLK+row)*opitch+ch*8)*2),0,16);} }
    else{
    #pragma unroll
    for(int i=0;i<4;++i){const int row=i*8+(lane>>3),ch=lane&7; const u32x4 v=*(const u32x4*)(stg+row*64+ch*8); ATTN_STORE16(Ow+(long)row*opitch+ch*8,v);} } }
  asm volatile("s_waitcnt lgkmcnt(0)\n\ts_barrier":::"memory");
  #undef DMA_K
  #undef DMA_V
  #undef CMASK
  #undef CIN
  #undef BIASADD
  #undef START
  #undef RESC
  #undef ROT
}
constexpr int ATTN_LDS_BYTES=LDS_BYTES;
#undef SBAR
#undef WAIT_BAR
}
__constant__ unsigned short UNIT_Q[8][180] = {
  {0x4000,0x4001,0x4002,0x4003,0x4004,0x4005,0x4006,0x4007,0x8007,0x8107,0x800f,0x810f,0x8006,0x8106,0x800e,0x810e,0x8005,0x8105,0x800d,0x810d,0x8004,0x8104,0x800c,0x810c,0x8003,0x8103,0x800b,0x810b,0x8002,0x8102,0x800a,0x810a,0x8001,0x8101,0x8009,0x8109,0x8000,0x8100,0x8008,0x8108,0x8017,0x8117,0x801f,0x811f,0x8016,0x8116,0x801e,0x811e,0x8015,0x8115,0x801d,0x811d,0x8014,0x8114,0x801c,0x811c,0x8013,0x8113,0x801b,0x811b,0x8012,0x8112,0x801a,0x811a,0x8011,0x8111,0x8019,0x8119,0x8010,0x8110,0x8018,0x8118,0x0007,0x000f,0x0017,0x001f,0x0006,0x000e,0x0016,0x001e,0x0005,0x000d,0x0015,0x001d,0x0004,0x000c,0x0014,0x001c,0x0003,0x000b,0x0013,0x001b,0x0002,0x000a,0x0012,0x001a,0x0001,0x0009,0x0011,0x0019,0x0000,0x0008,0x0010,0x0018,0x0027,0x002f,0x0037,0x003f,0x0026,0x002e,0x0036,0x003e,0x0025,0x002d,0x0035,0x003d,0x0024,0x002c,0x0034,0x003c,0x0023,0x002b,0x0033,0x003b,0x0022,0x002a,0x0032,0x003a,0x0021,0x0029,0x0031,0x0039,0x0020,0x0028,0x0030,0x0038,0x2000,0x2001,0x2002,0x2003,0x2004,0x2005,0x2006,0x2007,0x2008,0x2009,0x200a,0x200b,0x200c,0x200d,0x200e,0x200f,0x2010,0x2011,0x2012,0x2013,0x2014,0x2015,0x2016,0x2017,0x2018,0x2019,0x201a,0x201b,0x201c,0x201d,0x201e,0x201f,0x2020,0x2021,0x2022,0x2023,0x2024,0x2025,0x2026,0x2027,0x2028,0x2029,0x202a,0x202b},
  {0x4008,0x4009,0x400a,0x400b,0x400c,0x400d,0x400e,0x400f,0x8027,0x8127,0x802f,0x812f,0x8026,0x8126,0x802e,0x812e,0x8025,0x8125,0x802d,0x812d,0x8024,0x8124,0x802c,0x812c,0x8023,0x8123,0x802b,0x812b,0x8022,0x8122,0x802a,0x812a,0x8021,0x8121,0x8029,0x8129,0x8020,0x8120,0x8028,0x8128,0x8037,0x8137,0x803f,0x813f,0x8036,0x8136,0x803e,0x813e,0x8035,0x8135,0x803d,0x813d,0x8034,0x8134,0x803c,0x813c,0x8033,0x8133,0x803b,0x813b,0x8032,0x8132,0x803a,0x813a,0x8031,0x8131,0x8039,0x8139,0x8030,0x8130,0x8038,0x8138,0x0047,0x004f,0x0057,0x005f,0x0046,0x004e,0x0056,0x005e,0x0045,0x004d,0x0055,0x005d,0x0044,0x004c,0x0054,0x005c,0x0043,0x004b,0x0053,0x005b,0x0042,0x004a,0x0052,0x005a,0x0041,0x0049,0x0051,0x0059,0x0040,0x0048,0x0050,0x0058,0x0067,0x006f,0x0077,0x007f,0x0066,0x006e,0x0076,0x007e,0x0065,0x006d,0x0075,0x007d,0x0064,0x006c,0x0074,0x007c,0x0063,0x006b,0x0073,0x007b,0x0062,0x006a,0x0072,0x007a,0x0061,0x0069,0x0071,0x0079,0x0060,0x0068,0x0070,0x0078,0x202c,0x202d,0x202e,0x202f,0x2030,0x2031,0x2032,0x2033,0x2034,0x2035,0x2036,0x2037,0x2038,0x2039,0x203a,0x203b,0x203c,0x203d,0x203e,0x203f,0x2040,0x2041,0x2042,0x2043,0x2044,0x2045,0x2046,0x2047,0x2048,0x2049,0x204a,0x204b,0x204c,0x204d,0x204e,0x204f,0x2050,0x2051,0x2052,0x2053,0x2054,0x2055,0x2056,0x2057},
  {0x4010,0x4011,0x4012,0x4013,0x4014,0x4015,0x4016,0x4017,0x8047,0x8147,0x804f,0x814f,0x8046,0x8146,0x804e,0x814e,0x8045,0x8145,0x804d,0x814d,0x8044,0x8144,0x804c,0x814c,0x8043,0x8143,0x804b,0x814b,0x8042,0x8142,0x804a,0x814a,0x8041,0x8141,0x8049,0x8149,0x8040,0x8140,0x8048,0x8148,0x8057,0x8157,0x805f,0x815f,0x8056,0x8156,0x805e,0x815e,0x8055,0x8155,0x805d,0x815d,0x8054,0x8154,0x805c,0x815c,0x8053,0x8153,0x805b,0x815b,0x8052,0x8152,0x805a,0x815a,0x8051,0x8151,0x8059,0x8159,0x8050,0x8150,0x8058,0x8158,0x0087,0x008f,0x0097,0x009f,0x0086,0x008e,0x0096,0x009e,0x0085,0x008d,0x0095,0x009d,0x0084,0x008c,0x0094,0x009c,0x0083,0x008b,0x0093,0x009b,0x0082,0x008a,0x0092,0x009a,0x0081,0x0089,0x0091,0x0099,0x0080,0x0088,0x0090,0x0098,0x00a7,0x00af,0x00b7,0x00bf,0x00a6,0x00ae,0x00b6,0x00be,0x00a5,0x00ad,0x00b5,0x00bd,0x00a4,0x00ac,0x00b4,0x00bc,0x00a3,0x00ab,0x00b3,0x00bb,0x00a2,0x00aa,0x00b2,0x00ba,0x00a1,0x00a9,0x00b1,0x00b9,0x00a0,0x00a8,0x00b0,0x00b8,0x2058,0x2059,0x205a,0x205b,0x205c,0x205d,0x205e,0x205f,0x2060,0x2061,0x2062,0x2063,0x2064,0x2065,0x2066,0x2067,0x2068,0x2069,0x206a,0x206b,0x206c,0x206d,0x206e,0x206f,0x2070,0x2071,0x2072,0x2073,0x2074,0x2075,0x2076,0x2077,0x2078,0x2079,0x207a,0x207b,0x207c,0x207d,0x207e,0x207f,0x2080,0x2081,0x2082,0x2083},
  {0x4018,0x4019,0x401a,0x401b,0x401c,0x401d,0x401e,0x401f,0x8067,0x8167,0x806f,0x816f,0x8066,0x8166,0x806e,0x816e,0x8065,0x8165,0x806d,0x816d,0x8064,0x8164,0x806c,0x816c,0x8063,0x8163,0x806b,0x816b,0x8062,0x8162,0x806a,0x816a,0x8061,0x8161,0x8069,0x8169,0x8060,0x8160,0x8068,0x8168,0x8077,0x8177,0x807f,0x817f,0x8076,0x8176,0x807e,0x817e,0x8075,0x8175,0x807d,0x817d,0x8074,0x8174,0x807c,0x817c,0x8073,0x8173,0x807b,0x817b,0x8072,0x8172,0x807a,0x817a,0x8071,0x8171,0x8079,0x8179,0x8070,0x8170,0x8078,0x8178,0x00c7,0x00cf,0x00d7,0x00df,0x00c6,0x00ce,0x00d6,0x00de,0x00c5,0x00cd,0x00d5,0x00dd,0x00c4,0x00cc,0x00d4,0x00dc,0x00c3,0x00cb,0x00d3,0x00db,0x00c2,0x00ca,0x00d2,0x00da,0x00c1,0x00c9,0x00d1,0x00d9,0x00c0,0x00c8,0x00d0,0x00d8,0x00e7,0x00ef,0x00f7,0x00ff,0x00e6,0x00ee,0x00f6,0x00fe,0x00e5,0x00ed,0x00f5,0x00fd,0x00e4,0x00ec,0x00f4,0x00fc,0x00e3,0x00eb,0x00f3,0x00fb,0x00e2,0x00ea,0x00f2,0x00fa,0x00e1,0x00e9,0x00f1,0x00f9,0x00e0,0x00e8,0x00f0,0x00f8,0x2084,0x2085,0x2086,0x2087,0x2088,0x2089,0x208a,0x208b,0x208c,0x208d,0x208e,0x208f,0x2090,0x2091,0x2092,0x2093,0x2094,0x2095,0x2096,0x2097,0x2098,0x2099,0x209a,0x209b,0x209c,0x209d,0x209e,0x209f,0x20a0,0x20a1,0x20a2,0x20a3,0x20a4,0x20a5,0x20a6,0x20a7,0x20a8,0x20a9,0x20aa,0x20ab,0x20ac,0x20ad,0x20ae,0x20af},
  {0x4020,0x4021,0x4022,0x4023,0x4024,0x4025,0x4026,0x4027,0x8087,0x8187,0x808f,0x818f,0x8086,0x8186,0x808e,0x818e,0x8085,0x8185,0x808d,0x818d,0x8084,0x8184,0x808c,0x818c,0x8083,0x8183,0x808b,0x818b,0x8082,0x8182,0x808a,0x818a,0x8081,0x8181,0x8089,0x8189,0x8080,0x8180,0x8088,0x8188,0x8097,0x8197,0x809f,0x819f,0x8096,0x8196,0x809e,0x819e,0x8095,0x8195,0x809d,0x819d,0x8094,0x8194,0x809c,0x819c,0x8093,0x8193,0x809b,0x819b,0x8092,0x8192,0x809a,0x819a,0x8091,0x8191,0x8099,0x8199,0x8090,0x8190,0x8098,0x8198,0x0107,0x010f,0x0117,0x011f,0x0106,0x010e,0x0116,0x011e,0x0105,0x010d,0x0115,0x011d,0x0104,0x010c,0x0114,0x011c,0x0103,0x010b,0x0113,0x011b,0x0102,0x010a,0x0112,0x011a,0x0101,0x0109,0x0111,0x0119,0x0100,0x0108,0x0110,0x0118,0x0127,0x012f,0x0137,0x013f,0x0126,0x012e,0x0136,0x013e,0x0125,0x012d,0x0135,0x013d,0x0124,0x012c,0x0134,0x013c,0x0123,0x012b,0x0133,0x013b,0x0122,0x012a,0x0132,0x013a,0x0121,0x0129,0x0131,0x0139,0x0120,0x0128,0x0130,0x0138,0x20b0,0x20b1,0x20b2,0x20b3,0x20b4,0x20b5,0x20b6,0x20b7,0x20b8,0x20b9,0x20ba,0x20bb,0x20bc,0x20bd,0x20be,0x20bf,0x20c0,0x20c1,0x20c2,0x20c3,0x20c4,0x20c5,0x20c6,0x20c7,0x20c8,0x20c9,0x20ca,0x20cb,0x20cc,0x20cd,0x20ce,0x20cf,0x20d0,0x20d1,0x20d2,0x20d3,0x20d4,0x20d5,0x20d6,0x20d7,0x20d8,0x20d9,0x20da,0x20db},
  {0x4028,0x4029,0x402a,0x402b,0x402c,0x402d,0x402e,0x402f,0x80a7,0x81a7,0x80af,0x81af,0x80a6,0x81a6,0x80ae,0x81ae,0x80a5,0x81a5,0x80ad,0x81ad,0x80a4,0x81a4,0x80ac,0x81ac,0x80a3,0x81a3,0x80ab,0x81ab,0x80a2,0x81a2,0x80aa,0x81aa,0x80a1,0x81a1,0x80a9,0x81a9,0x80a0,0x81a0,0x80a8,0x81a8,0x80b7,0x81b7,0x80bf,0x81bf,0x80b6,0x81b6,0x80be,0x81be,0x80b5,0x81b5,0x80bd,0x81bd,0x80b4,0x81b4,0x80bc,0x81bc,0x80b3,0x81b3,0x80bb,0x81bb,0x80b2,0x81b2,0x80ba,0x81ba,0x80b1,0x81b1,0x80b9,0x81b9,0x80b0,0x81b0,0x80b8,0x81b8,0x0147,0x014f,0x0157,0x015f,0x0146,0x014e,0x0156,0x015e,0x0145,0x014d,0x0155,0x015d,0x0144,0x014c,0x0154,0x015c,0x0143,0x014b,0x0153,0x015b,0x0142,0x014a,0x0152,0x015a,0x0141,0x0149,0x0151,0x0159,0x0140,0x0148,0x0150,0x0158,0x0167,0x016f,0x0177,0x017f,0x0166,0x016e,0x0176,0x017e,0x0165,0x016d,0x0175,0x017d,0x0164,0x016c,0x0174,0x017c,0x0163,0x016b,0x0173,0x017b,0x0162,0x016a,0x0172,0x017a,0x0161,0x0169,0x0171,0x0179,0x0160,0x0168,0x0170,0x0178,0x20dc,0x20dd,0x20de,0x20df,0x20e0,0x20e1,0x20e2,0x20e3,0x20e4,0x20e5,0x20e6,0x20e7,0x20e8,0x20e9,0x20ea,0x20eb,0x20ec,0x20ed,0x20ee,0x20ef,0x20f0,0x20f1,0x20f2,0x20f3,0x20f4,0x20f5,0x20f6,0x20f7,0x20f8,0x20f9,0x20fa,0x20fb,0x20fc,0x20fd,0x20fe,0x20ff,0x2100,0x2101,0x2102,0x2103,0x2104,0x2105,0x2106,0x2107},
  {0x4030,0x4031,0x4032,0x4033,0x4034,0x4035,0x4036,0x4037,0x80c7,0x81c7,0x80cf,0x81cf,0x80c6,0x81c6,0x80ce,0x81ce,0x80c5,0x81c5,0x80cd,0x81cd,0x80c4,0x81c4,0x80cc,0x81cc,0x80c3,0x81c3,0x80cb,0x81cb,0x80c2,0x81c2,0x80ca,0x81ca,0x80c1,0x81c1,0x80c9,0x81c9,0x80c0,0x81c0,0x80c8,0x81c8,0x80d7,0x81d7,0x80df,0x81df,0x80d6,0x81d6,0x80de,0x81de,0x80d5,0x81d5,0x80dd,0x81dd,0x80d4,0x81d4,0x80dc,0x81dc,0x80d3,0x81d3,0x80db,0x81db,0x80d2,0x81d2,0x80da,0x81da,0x80d1,0x81d1,0x80d9,0x81d9,0x80d0,0x81d0,0x80d8,0x81d8,0x0187,0x018f,0x0197,0x019f,0x0186,0x018e,0x0196,0x019e,0x0185,0x018d,0x0195,0x019d,0x0184,0x018c,0x0194,0x019c,0x0183,0x018b,0x0193,0x019b,0x0182,0x018a,0x0192,0x019a,0x0181,0x0189,0x0191,0x0199,0x0180,0x0188,0x0190,0x0198,0x01a7,0x01af,0x01b7,0x01bf,0x01a6,0x01ae,0x01b6,0x01be,0x01a5,0x01ad,0x01b5,0x01bd,0x01a4,0x01ac,0x01b4,0x01bc,0x01a3,0x01ab,0x01b3,0x01bb,0x01a2,0x01aa,0x01b2,0x01ba,0x01a1,0x01a9,0x01b1,0x01b9,0x01a0,0x01a8,0x01b0,0x01b8,0x2108,0x2109,0x210a,0x210b,0x210c,0x210d,0x210e,0x210f,0x2110,0x2111,0x2112,0x2113,0x2114,0x2115,0x2116,0x2117,0x2118,0x2119,0x211a,0x211b,0x211c,0x211d,0x211e,0x211f,0x2120,0x2121,0x2122,0x2123,0x2124,0x2125,0x2126,0x2127,0x2128,0x2129,0x212a,0x212b,0x212c,0x212d,0x212e,0x212f,0x2130,0x2131,0x2132,0x2133},
  {0x4038,0x4039,0x403a,0x403b,0x403c,0x403d,0x403e,0x403f,0x80e7,0x81e7,0x80ef,0x81ef,0x80e6,0x81e6,0x80ee,0x81ee,0x80e5,0x81e5,0x80ed,0x81ed,0x80e4,0x81e4,0x80ec,0x81ec,0x80e3,0x81e3,0x80eb,0x81eb,0x80e2,0x81e2,0x80ea,0x81ea,0x80e1,0x81e1,0x80e9,0x81e9,0x80e0,0x81e0,0x80e8,0x81e8,0x80f7,0x81f7,0x80ff,0x81ff,0x80f6,0x81f6,0x80fe,0x81fe,0x80f5,0x81f5,0x80fd,0x81fd,0x80f4,0x81f4,0x80fc,0x81fc,0x80f3,0x81f3,0x80fb,0x81fb,0x80f2,0x81f2,0x80fa,0x81fa,0x80f1,0x81f1,0x80f9,0x81f9,0x80f0,0x81f0,0x80f8,0x81f8,0x01c7,0x01cf,0x01d7,0x01df,0x01c6,0x01ce,0x01d6,0x01de,0x01c5,0x01cd,0x01d5,0x01dd,0x01c4,0x01cc,0x01d4,0x01dc,0x01c3,0x01cb,0x01d3,0x01db,0x01c2,0x01ca,0x01d2,0x01da,0x01c1,0x01c9,0x01d1,0x01d9,0x01c0,0x01c8,0x01d0,0x01d8,0x01e7,0x01ef,0x01f7,0x01ff,0x01e6,0x01ee,0x01f6,0x01fe,0x01e5,0x01ed,0x01f5,0x01fd,0x01e4,0x01ec,0x01f4,0x01fc,0x01e3,0x01eb,0x01f3,0x01fb,0x01e2,0x01ea,0x01f2,0x01fa,0x01e1,0x01e9,0x01f1,0x01f9,0x01e0,0x01e8,0x01f0,0x01f8,0x2134,0x2135,0x2136,0x2137,0x2138,0x2139,0x213a,0x213b,0x213c,0x213d,0x213e,0x213f,0x2140,0x2141,0x2142,0x2143,0x2144,0x2145,0x2146,0x2147,0x2148,0x2149,0x214a,0x214b,0x214c,0x214d,0x214e,0x214f,0x2150,0x2151,0x2152,0x2153,0x2154,0x2155,0x2156,0x2157,0x2158,0x2159,0x215a,0x215b,0x215c,0x215d,0x215e,0x215f},
};
constexpr int NQ_UNITS = 180;
constexpr size_t WS_DIFFO = 224 * MiB;
constexpr size_t WS_END2 = 256 * MiB;
constexpr int CW_QHEAD = 32768;
constexpr int CW_DIFF = 65536;
static_assert((CW_DIFF + 256 * 64) * 4 <= (int)CTL_ZERO_BYTES, "counters inside the zeroed control region");
static_assert(ab::ATTN_LDS_BYTES <= RING_BYTES, "attention LDS fits the ring region");
__device__ __forceinline__ void diff_combine(const bf16_t* DIFFO, bf16_t* ATT, const float* subw, float lam, int b, int h, int qb, int wid, int lane_) {
    int lane = lane_; asm volatile("" : "+v"(lane));
    const int row = b * SEQ + 256 * qb + 32 * wid + (lane >> 1), hf = lane & 1;
    gu64* s1 = (gu64*)(DIFFO + (size_t)row * 1024 + h * 256 + hf * 64);
    gu64* s2 = (gu64*)(DIFFO + (size_t)row * 1024 + h * 256 + 128 + hf * 64);
    f32x4 v[16]; float ss = 0.f;
#pragma unroll
    for (int q = 0; q < 8; ++q) { const unsigned long long a01 = __hip_atomic_load(s1 + 2 * q, RLX_AGENT), a23 = __hip_atomic_load(s1 + 2 * q + 1, RLX_AGENT), c01 = __hip_atomic_load(s2 + 2 * q, RLX_AGENT), c23 = __hip_atomic_load(s2 + 2 * q + 1, RLX_AGENT);
        const v4u a = {(unsigned)a01, (unsigned)(a01 >> 32), (unsigned)a23, (unsigned)(a23 >> 32)}, c = {(unsigned)c01, (unsigned)(c01 >> 32), (unsigned)c23, (unsigned)(c23 >> 32)};
        const f32x4 a0 = {__uint_as_float(a.x << 16), __uint_as_float(a.x & 0xffff0000u), __uint_as_float(a.y << 16), __uint_as_float(a.y & 0xffff0000u)};
        const f32x4 a1 = {__uint_as_float(a.z << 16), __uint_as_float(a.z & 0xffff0000u), __uint_as_float(a.w << 16), __uint_as_float(a.w & 0xffff0000u)};
        const f32x4 c0 = {__uint_as_float(c.x << 16), __uint_as_float(c.x & 0xffff0000u), __uint_as_float(c.y << 16), __uint_as_float(c.y & 0xffff0000u)};
        const f32x4 c1 = {__uint_as_float(c.z << 16), __uint_as_float(c.z & 0xffff0000u), __uint_as_float(c.w << 16), __uint_as_float(c.w & 0xffff0000u)};
        v[2 * q] = a0 - c0 * lam; v[2 * q + 1] = a1 - c1 * lam;
        ss += ((v[2 * q].x * v[2 * q].x + v[2 * q].y * v[2 * q].y) + (v[2 * q].z * v[2 * q].z + v[2 * q].w * v[2 * q].w)) + ((v[2 * q + 1].x * v[2 * q + 1].x + v[2 * q + 1].y * v[2 * q + 1].y) + (v[2 * q + 1].z * v[2 * q + 1].z + v[2 * q + 1].w * v[2 * q + 1].w)); }
    ss += __shfl_xor(ss, 1);
    const float rstd = rsqrtf(ss * (1.f / 128.f) + EPS) * 0.8f;
    GAS v4u* dst = (GAS v4u*)(ATT + (size_t)row * DM + h * 128 + hf * 64);
    const GAS f32x4* sw = (const GAS f32x4*)(subw + hf * 64);
#pragma unroll
    for (int q = 0; q < 8; ++q) { const f32x4 g0 = sw[2 * q] * rstd, g1 = sw[2 * q + 1] * rstd; const f32x4 o0 = v[2 * q] * g0, o1 = v[2 * q + 1] * g1;
        dst[q] = (v4u){pk2(o0.x, o0.y), pk2(o0.z, o0.w), pk2(o1.x, o1.y), pk2(o1.z, o1.w)}; }
}
#if PROBE_K >= 200
#define ACC_T0() unsigned long long acc_t0_ = __builtin_amdgcn_s_memrealtime()
#define ACC_ADD(cat) do { if (F.tid == 0) { const unsigned long long t1_ = __builtin_amdgcn_s_memrealtime(); F.MISC[40 + (cat)] += (unsigned)(t1_ - acc_t0_); } acc_t0_ = __builtin_amdgcn_s_memrealtime(); } while (0)
#else
#define ACC_T0() do {} while (0)
#define ACC_ADD(cat) do {} while (0)
#endif
__device__ __forceinline__ void attn_phase(Frame& F, char* shm, gu32* ctl, const bf16_t* PROJ, const float* CUMB, bf16_t* ATT, bf16_t* DIFFO, const float* subw, const float* lq1, const float* lk1, const float* lq2, const float* lk2,
                                           const bf16_t* HM, const bf16_t* WKV, bf16_t* MKN, bf16_t* VT, const float* mkw, const float* mqw) {
    const float s1 = wave_sum(lq1[F.lane] * lk1[F.lane]), s2 = wave_sum(lq2[F.lane] * lk2[F.lane]);
    const float lam = __uint_as_float(__builtin_amdgcn_readfirstlane(__float_as_uint(__expf(s1) - __expf(s2) + 0.2f)));
    const int xq = (int)blockIdx.x & 7;
    ACC_T0();
    for (;;) {
        if (F.tid == 0) F.MISC[13] = __hip_atomic_fetch_add((unsigned*)(ctl + CW_QHEAD + 64 * xq), 1u, __ATOMIC_RELAXED, __HIP_MEMORY_SCOPE_AGENT);
        __syncthreads();
        const unsigned qi = F.MISC[13];
        __syncthreads();
        if (qi >= (unsigned)NQ_UNITS) break;
        ACC_ADD(5);
        const unsigned u = UNIT_Q[xq][qi];
        const int qb = u & 7;
        if (u & 0x2000u) {
            LAS float* scr = (LAS float*)(F.lds + RING_OFF + F.wave * 16384);
            const unsigned char* ka_ = (const unsigned char*)__builtin_amdgcn_kernarg_segment_ptr(); asm volatile("" : "+s"(ka_));
            const Args* ap_ = (const Args*)ka_; const Ptrs P = make_ptrs(ap_->in, ap_->out, ap_->ws);
            const int it0 = (int)(u & 511) * 16 + F.wave * 2;
            int ln_ = F.lane; asm volatile("" : "+v"(ln_));
#pragma unroll 1
            for (int it = it0; it < it0 + 2; ++it) {
                int r = it;
                if (r < 512) { p0_transpose_item<false>(P.w_out, DM, DM, DM, nullptr, P.WOUT, scr, r, ln_); continue; } r -= 512;
                if (r < 512) { p0_transpose_item<false>(P.w_mq, DM, DM, DM, P.nmq, P.WQ, scr, r, ln_); continue; } r -= 512;
                if (r < 512) { p0_transpose_item<false>(P.w_mo, DM, DM, DM, nullptr, P.WO, scr, r, ln_); continue; } r -= 512;
                if (r < 2048) { p0_transpose_item<false>(P.w_up, DFF, DM, DFF, P.nmlp, P.WUP, scr, r, ln_); continue; } r -= 2048;
                p0_transpose_item<false>(P.w_dn, DM, DFF, DM, nullptr, P.WDN, scr, r, ln_);
            }
            __syncthreads(); ACC_ADD(4);
        } else if (u & 0x4000u) {
            const int idx = u & 63;
            if (idx < 32) {
                pg8::Gemm g{HM, WKV, DM, DM, DM}; const Sched S = sched_one(idx >> 2, idx & 3, true);
                pg8::EpiHeadNormK E{MKN, mkw, mqw};
                pg8::gemm_phase<pg8::EpiHeadNormK, Sched, false, true>(F.lds + RING_OFF, g, S, E);
            } else {
                pg8::Gemm g{WKV + (size_t)1024 * DM, HM, DM, DM, DM}; const Sched S = sched_one((idx - 32) >> 3, (idx - 32) & 7, true);
                pg8::EpiStore<0> E{VT, MMEM, nullptr};
                pg8::gemm_phase<pg8::EpiStore<0>, Sched, true, true>(F.lds + RING_OFF, g, S, E);
            }
            __syncthreads(); ACC_ADD(3);
        } else if (u & 0x8000u) {
            const int bh = (u >> 3) & 31, mp = (u >> 8) & 1, b = bh >> 2, h = bh & 3;
            const ab::bf16* base = (const ab::bf16*)PROJ + (size_t)b * SEQ * NPROJ;
#pragma unroll 1
            for (int hf = 0; hf < 2; ++hf)
                ab::attn_unit<8, 1, false, true>(qb, base + C_DQ + 128 * h + 64 * mp, base + C_DK + 128 * h + 64 * mp, base + C_DV + 128 * h + 64 * hf,
                                           (ab::bf16*)DIFFO + (size_t)b * SEQ * 1024 + h * 256 + (mp * 2 + hf) * 64, 1024, nullptr, shm);
            ACC_ADD(1);
            VM_WAIT(); __syncthreads();
            if (F.tid == 0) {
                const unsigned old = __hip_atomic_fetch_add((unsigned*)(ctl + CW_DIFF + 64 * (bh * 8 + qb)), 1u, __ATOMIC_RELAXED, __HIP_MEMORY_SCOPE_AGENT);
                F.MISC[12] = old; }
            __syncthreads();
            if (F.MISC[12] == 1u) diff_combine(DIFFO, ATT, subw, lam, b, h, qb, F.wave, F.lane);
            __syncthreads(); ACC_ADD(2);
        } else {
            const int bh = (u >> 3) & 63, b = bh >> 3, h = bh & 7;
            const ab::bf16* base = (const ab::bf16*)PROJ + (size_t)b * SEQ * NPROJ;
            ab::attn_unit<8, 0, true, false>(qb, base + C_FQ + 64 * h, base + C_FK + 64 * h, base + C_FV + 64 * h, (ab::bf16*)ATT + (size_t)b * SEQ * DM + 512 + 64 * h, DM, CUMB + (size_t)bh * SEQ, shm);
            ACC_ADD(0);
        }
    }
}
#ifndef REP3
#define REP3 1
#endif
#define ATTN_PHASE_HOOK if (IN(3)) { PP; for (int rep_ = 0; rep_ < REP3; ++rep_) attn_phase(F, (char*)lds + RING_OFF, F.ctl, P.PROJ, P.CUMB, P.ATT, (bf16_t*)(args.ws + WS_DIFFO), P.subw, P.lq1, P.lk1, P.lq2, P.lk2, P.HM, P.WKV, P.MKN, P.VT, P.mkw, P.mqw); }
#ifndef PROBE_K
#define PROBE_K -1
#endif
#ifndef PROBE_MULT
#define PROBE_MULT 4
#endif
#define STAMP(i) do { if (PROBE_K >= 0 && F.tid == 0) { const unsigned long long t_ = __builtin_amdgcn_s_memrealtime(); F.MISC[16 + 2 * (i)] = (unsigned)t_; F.MISC[17 + 2 * (i)] = (unsigned)(t_ >> 32); } } while (0)
#ifndef REP0
#define REP0 1
#endif
#ifndef REP1
#define REP1 1
#endif
#ifndef REP2
#define REP2 1
#endif
#ifndef REP3
#define REP3 1
#endif
#ifndef REP4
#define REP4 1
#endif
#ifndef REP5
#define REP5 1
#endif
#ifndef REP6
#define REP6 1
#endif
#ifndef REP7
#define REP7 1
#endif
#ifndef REP8
#define REP8 1
#endif
constexpr int NPHASE = 9;

__global__ void __launch_bounds__(NWAVES * 64, 2) mega_fwd(Args args) {
    extern __shared__ __attribute__((aligned(16))) unsigned char lds[];
    Frame F;
    F.lds = (LAS unsigned char*)lds; F.MISC = (volatile LAS unsigned*)(F.lds + MISC_OFF);
    F.tid = threadIdx.x; F.lane = F.tid & 63; F.wave = __builtin_amdgcn_readfirstlane(F.tid >> 6);
    F.G = gridDim.x; { const int bx = blockIdx.x; F.vcu = (F.G % 8 == 0) ? (bx % 8) * (F.G / 8) + bx / 8 : bx; }
    F.ctl = (gu32*)(args.ws + WS_CTL);
    for (int u = F.tid; u < (LDS_BYTES - LDSCTL_OFF) / 4; u += NWAVES * 64) ((LAS unsigned*)(F.lds + LDSCTL_OFF))[u] = 0u;
    __syncthreads();
    XcdBarrier bar = xcd_barrier_post((unsigned*)(F.ctl + CW_BAR) + args.ph_lo * XCD_BAR_WORDS, F.MISC + 8);
    const int lo = args.ph_lo, hi = args.ph_hi;
#define IN(k) (lo <= (k) && (k) < hi)
#define PP const Ptrs P = make_ptrs(args.in, args.out, args.ws)
#define SEAM(k) do { if (IN(k) && IN((k) + 1)) xcd_barrier(bar); } while (0)
#define SEAM2(k) do { if (IN(k) && IN((k) + 2)) xcd_barrier(bar); } while (0)
    const int bx = (int)blockIdx.x;
    STAMP(0);

    if (IN(0)) { PP; for (int rep_ = 0; rep_ < REP0; ++rep_) p0_prologue(F, P); } SEAM(0); STAMP(1);

    if (IN(1)) {
        PP; for (int rep_ = 0; rep_ < REP1; ++rep_) {
        pg8::Gemm g{P.XB, P.WIN, DM, DM, DM}; const Sched S = sched_static(MTOK, NPROJ, F.G, bx);
        if (bx < 64) p1b_cumsum_wg(P.FLOG, P.b_forget, P.CUMB, bx, F.tid, (LAS float*)(F.lds + LDS_RQ));
        pg8::EpiProj E{P.PROJ, P.QKW, P.ROPE};
        pg8::gemm_phase<pg8::EpiProj, Sched, true, true>(F.lds + RING_OFF, g, S, E);
    }} SEAM2(1); STAMP(2);


    ATTN_PHASE_HOOK
    STAMP(9); SEAM(3); STAMP(3);

    if (IN(4)) {
        PP; for (int rep_ = 0; rep_ < REP4; ++rep_) {
        pg8::Gemm g{P.ATT, P.WOUT, DM, DM, DM}; const Sched S = sched_static(MTOK, DM, F.G, bx);
        pg8::EpiResid<0> E{P.RS0, P.XB, nullptr, P.SS};
        pg8::gemm_phase<pg8::EpiResid<0>, Sched, false, true>(F.lds + RING_OFF, g, S, E);
    }} SEAM(4); STAMP(4);

    if (IN(5)) {
        PP; for (int rep_ = 0; rep_ < REP5; ++rep_) {
        const Sched S0 = sched_static(MTOK, DM, F.G, bx); pg8::Unit u{0, 0}; const bool has = S0.next(0, u);
        PG8_LAS float* RQ = (PG8_LAS float*)(F.lds + LDS_RQ); PG8_LAS float* IL = (PG8_LAS float*)(F.lds + LDS_IL);
        {   pg8::Gemm g{P.XB, P.WQ, DM, DM, DM}; const Sched S = sched_one(u.pm, u.pn, has);
            pg8::EpiMemQ E{P.MQ, P.SS, RQ};
            pg8::gemm_phase<pg8::EpiMemQ, Sched, false, true>(F.lds + RING_OFF, g, S, E); }
        VM_WAIT(); __syncthreads(); if (F.tid == 0) { __builtin_amdgcn_fence(__ATOMIC_ACQUIRE, "agent"); VM_WAIT(); } __syncthreads();
        const int head = u.pn, bh = (u.pm >> 3) * 4 + head;
        {   pg8::Gemm g{P.MQ + head * 256, P.MKN + (size_t)bh * 65536, DM, 256, 256}; const Sched S = sched_one(u.pm, 0, has);
            pg8::EpiMemS E{P.MQ, head, RQ, IL};
            pg8::gemm_phase<pg8::EpiMemS, Sched, false, true>(F.lds + RING_OFF, g, S, E); }
        VM_WAIT(); __syncthreads(); if (F.tid == 0) { __builtin_amdgcn_fence(__ATOMIC_ACQUIRE, "agent"); VM_WAIT(); } __syncthreads();
        {   pg8::Gemm g{P.MQ + head * 256, P.VT + (size_t)(head * 256) * MMEM + (u.pm >> 3) * 256, DM, MMEM, 256}; const Sched S = sched_one(u.pm, 0, has);
            pg8::EpiMemPV E{P.MO, head, IL};
            pg8::gemm_phase<pg8::EpiMemPV, Sched, true, true>(F.lds + RING_OFF, g, S, E); }
    }} SEAM(5); STAMP(5);

    if (IN(6)) {
        PP; for (int rep_ = 0; rep_ < REP6; ++rep_) {
        pg8::Gemm g{P.MO, P.WO, DM, DM, DM}; const Sched S = sched_static(MTOK, DM, F.G, bx);
        pg8::EpiResid<1> E{nullptr, P.XB, nullptr, P.SS};
        pg8::gemm_phase<pg8::EpiResid<1>, Sched, false, true>(F.lds + RING_OFF, g, S, E);
    }} SEAM(6); STAMP(6);

    if (IN(7)) {
        PP; for (int rep_ = 0; rep_ < REP7; ++rep_) {
        pg8::Gemm g{P.XB, P.WUP, DM, DM, DM}; const Sched S = sched_static(MTOK, DFF, F.G, bx);
        pg8::EpiStore<3> E{P.H, DFF, P.SS};
        pg8::gemm_phase<pg8::EpiStore<3>, Sched, true, true>(F.lds + RING_OFF, g, S, E);
    }} SEAM(7); STAMP(7);

    if (IN(8)) {
        PP; for (int rep_ = 0; rep_ < REP8; ++rep_) {
        pg8::Gemm g{P.H, P.WDN, DFF, DFF, DFF}; const Sched S = sched_static(MTOK, DM, F.G, bx);
        pg8::EpiResid<2> E{nullptr, P.XB, P.out, nullptr};
        pg8::gemm_phase<pg8::EpiResid<2>, Sched, false, true>(F.lds + RING_OFF, g, S, E);
    }}
    STAMP(8);
    if (PROBE_K >= 0 && F.tid == 0) {
        constexpr int IA_ = PROBE_K == 100 ? 9 : (PROBE_K >= 200 ? 0 : PROBE_K), IB_ = PROBE_K == 100 ? 3 : (PROBE_K >= 200 ? 1 : PROBE_K + 1);
        const unsigned long long a_ = ((unsigned long long)F.MISC[17 + 2 * IA_] << 32) | F.MISC[16 + 2 * IA_], b_ = ((unsigned long long)F.MISC[17 + 2 * IB_] << 32) | F.MISC[16 + 2 * IB_];
        unsigned long long w_ = (b_ - a_) * PROBE_MULT; if (PROBE_K >= 200) w_ = (unsigned long long)F.MISC[40 + (PROBE_K >= 200 ? PROBE_K - 200 : 0)] * PROBE_MULT;
        const unsigned long long t0_ = __builtin_amdgcn_s_memrealtime();
        while (__builtin_amdgcn_s_memrealtime() - t0_ < w_) __builtin_amdgcn_s_sleep(8);
    }
#undef IN
#undef SEAM
#undef SEAM2
}
extern "C" void kernel_launch(void* const* d_in, const int* in_sizes, int n_in, void* d_out, int out_size, void* d_ws, size_t ws_size, hipStream_t stream) {
    static int grid = 0;
    if (grid == 0) {
        if (n_in != 26 || in_sizes[0] != MTOK * DM || out_size != MTOK * DM || ws_size < WS_END2) { fprintf(stderr, "kernel_launch: unexpected shapes (n_in %d, in0 %d, out %d, ws %zu)\n", n_in, n_in > 0 ? in_sizes[0] : -1, out_size, ws_size); grid = -1; return; }
        int dev = 0, cus = 0, per_cu = 0;
        if (hipGetDevice(&dev) != hipSuccess || hipDeviceGetAttribute(&cus, hipDeviceAttributeMultiprocessorCount, dev) != hipSuccess) { grid = -1; return; }
        if (hipFuncSetAttribute((const void*)mega_fwd, hipFuncAttributeMaxDynamicSharedMemorySize, LDS_BYTES) != hipSuccess) { fprintf(stderr, "kernel_launch: hipFuncSetAttribute failed\n"); grid = -1; return; }
        if (hipOccupancyMaxActiveBlocksPerMultiprocessor(&per_cu, (const void*)mega_fwd, NWAVES * 64, LDS_BYTES) != hipSuccess || per_cu < 1) { fprintf(stderr, "kernel_launch: occupancy query says %d blocks per CU\n", per_cu); (void)hipGetLastError(); grid = -1; return; }
        grid = cus;
        if (grid != 256) fprintf(stderr, "kernel_launch: %d CUs; the one-unit-per-workgroup phases assume 256\n", grid);
    }
    if (grid < 0) return;
    (void)hipMemsetAsync((char*)d_ws + WS_CTL, 0, CTL_ZERO_BYTES, stream);
    Args a{};
    for (int i = 0; i < 26; ++i) a.in[i] = d_in[i];
    a.out = (float*)d_out; a.ws = (unsigned char*)d_ws;
#if MK_HYBRID
    const Ptrs P = make_ptrs(a.in, a.out, a.ws);
    a.ph_lo = 0; a.ph_hi = 3; hipLaunchKernelGGL(mega_fwd, dim3(grid), dim3(NWAVES * 64), LDS_BYTES, stream, a);
    float* OF = a.out;
    hipLaunchKernelGGL(k_attn, dim3(MTOK / 64, 8), dim3(64), 0, stream, P.PROJ, P.CUMB, 1, OF, 8);
    hipLaunchKernelGGL(k_fox_fin, dim3(MTOK * 512 / 256), dim3(256), 0, stream, OF, P.ATT);
    hipLaunchKernelGGL(k_attn, dim3(MTOK / 64, 16), dim3(64), 0, stream, P.PROJ, P.CUMB, 0, OF, 16);
    hipLaunchKernelGGL(k_diff_fin, dim3(MTOK), dim3(256), 0, stream, OF, P.lq1, P.lk1, P.lq2, P.lk2, P.subw, P.ATT);
    a.ph_lo = 4; a.ph_hi = 9; hipLaunchKernelGGL(mega_fwd, dim3(grid), dim3(NWAVES * 64), LDS_BYTES, stream, a);
#else
    a.ph_lo = 0; a.ph_hi = NPHASE; hipLaunchKernelGGL(mega_fwd, dim3(grid), dim3(NWAVES * 64), LDS_BYTES, stream, a);
#endif
}
```

```cpp
#include <hip/hip_runtime.h>
#include <cstdint>
#include <cstdio>

typedef unsigned short bf16_t;
__device__ __forceinline__ float bf2f(bf16_t v) { return __uint_as_float(((unsigned)v) << 16); }
__device__ __forceinline__ bf16_t f2bf(float f) { unsigned u = __float_as_uint(f); return (bf16_t)((u + 0x7fffu + ((u >> 16) & 1u)) >> 16); }

constexpr int NB = 8, SEQ = 2048, DM = 1024, MTOK = NB * SEQ, MEML = 256, MMEM = NB * MEML;
constexpr int NPROJ = 3072, INCOLS = 3080, DFF = 4096;
constexpr float EPS = 1e-6f;
constexpr float LOG2E = 1.4426950408889634f;
constexpr float C2 = 0.125f * LOG2E;
constexpr float CM = 0.0625f * LOG2E;
constexpr int C_DQ = 0, C_DK = 512, C_DV = 1024, C_FQ = 1536, C_FK = 2048, C_FV = 2560;

constexpr size_t MiB = 1u << 20;
constexpr size_t WS_CTL = 0, CTL_ZERO_BYTES = 1 * MiB;
constexpr size_t WS_FLOG = 1 * MiB;
constexpr size_t WS_CUMB = 2 * MiB;
constexpr size_t WS_ROPE = 3 * MiB;
constexpr size_t WS_RS0 = 4 * MiB + 256 * 1024;
constexpr size_t WS_QKW = 4 * MiB + 512 * 1024;
constexpr size_t WS_SS = 4 * MiB;
constexpr size_t WS_WIN = 8 * MiB, WS_WOUT = 14 * MiB, WS_WQ = 16 * MiB, WS_WKV = 18 * MiB, WS_WO = 22 * MiB, WS_WUP = 24 * MiB, WS_WDN = 32 * MiB;
constexpr size_t WS_XB = 40 * MiB;
constexpr size_t WS_HM = 72 * MiB;
constexpr size_t WS_MK = 76 * MiB;
constexpr size_t WS_VT = 80 * MiB;
constexpr size_t WS_MKN = 84 * MiB;
constexpr size_t WS_PROJ = 96 * MiB;
constexpr size_t WS_ATT = 192 * MiB;
constexpr size_t WS_MQ = 96 * MiB;
constexpr size_t WS_MO = 128 * MiB;
constexpr size_t WS_H = 96 * MiB;
constexpr size_t WS_END = 224 * MiB;
#define MK_HYBRID 0
namespace pg8 {
#define PG8_LAS __attribute__((address_space(3)))
typedef short bf16x8 __attribute__((ext_vector_type(8)));
typedef float f32x4 __attribute__((ext_vector_type(4)));
typedef unsigned u32x4 __attribute__((ext_vector_type(4)));
typedef unsigned u32x2 __attribute__((ext_vector_type(2)));
constexpr int BM = 256, BK = 64, HALF = 128, HTB = HALF * BK * 2  , STAGE_BYTES = 8 * HTB, NXCD = 8, WGM = 8;

__host__ __device__ __forceinline__ int lds_byte(int r, int c) { const int st = (r >> 4) * 2 + (c >> 5), rr = r & 15, cc = c & 31, ob = rr * 64 + cc * 2; return st * 1024 + (ob ^ (((ob >> 9) & 1) << 5)); }
__host__ __device__ __forceinline__ void stage_rc(int b, int& R, int& C) { const int st = b / 1024, sb = b % 1024, swz = sb ^ (((sb >> 9) & 1) << 5); R = (st >> 1) * 16 + swz / 64; C = (st & 1) * 32 + (swz % 64) / 2; }
__host__ __device__ __forceinline__ int perm32(int rho) { const int n = rho >> 4, i = rho & 15; return 8 * (i >> 2) + 4 * n + (i & 3); }

struct Unit { int pm, pn; };
struct Gemm { const bf16_t* A; const bf16_t* Bt; int lda, ldb, K; };

struct StaticOrder {
    int nM, nN, nwg, G, c;
    __host__ __device__ void init(int M, int N, int G_, int c_) { nM = M / BM; nN = N / BM; nwg = nM * nN; G = G_; c = c_; }
    __host__ __device__ bool next(int i, Unit& u) const {
        const long L = (long)i * G + c; if (L >= nwg) return false;
        int wgid = (int)L; { const int q = nwg / NXCD, r = nwg % NXCD, xcd = wgid % NXCD, off = wgid / NXCD; wgid = (xcd < r ? xcd * (q + 1) : r * (q + 1) + (xcd - r) * q) + off; }
        const int nig = WGM * nN, gid = wgid / nig, fm = gid * WGM, gsz = (nM - fm) < WGM ? (nM - fm) : WGM;
        u.pm = fm + ((wgid % nig) % gsz); u.pn = (wgid % nig) / gsz; return true;
    }
    __device__ __forceinline__ void a_ready(const Unit&) const {}
    __device__ __forceinline__ void done(const Unit&) const {}
};
struct OneUnit {
    int pm, pn; bool has;
    __device__ __forceinline__ bool next(int i, Unit& u) const { if (i != 0 || !has) return false; u.pm = pm; u.pn = pn; return true; }
    __device__ __forceinline__ void a_ready(const Unit&) const {}
    __device__ __forceinline__ void done(const Unit&) const {}
};

__device__ __forceinline__ unsigned cvt_pk_bf16(float lo, float hi) { unsigned r; asm volatile("v_cvt_pk_bf16_f32 %0, %1, %2" : "=v"(r) : "v"(lo), "v"(hi)); return r; }
#define PG8_LBAR() do { asm volatile("s_waitcnt lgkmcnt(0)" ::: "memory"); __builtin_amdgcn_s_barrier(); asm volatile("" ::: "memory"); } while (0)

template <int MODE> struct EpiStore {
    static constexpr bool PERM = true, AFTER_DRAIN = false;
    bf16_t* O; int ldc; const float* SS;
    __device__ __forceinline__ void operator()(const f32x4 (&acc)[2][2][4][2], const Unit& u, int wr, int wc, int fr, int fq) const {
        const int row0 = u.pm * BM + wr * 64 + fr, col0 = u.pn * BM + wc * 32 + 8 * fq;
#pragma unroll
        for (int ai = 0; ai < 2; ++ai)
#pragma unroll
            for (int m = 0; m < 4; ++m) { const int row = row0 + ai * HALF + m * 16; float rs = 1.f;
                if (MODE != 0) { const f32x4 s = *(const f32x4*)(SS + (size_t)row * 4); rs = rsqrtf(((s[0] + s[1]) + (s[2] + s[3])) * (1.f / DM) + EPS); }
                bf16_t* rowp = O + (size_t)row * ldc + col0;
#pragma unroll
                for (int bj = 0; bj < 2; ++bj) { f32x4 v0 = acc[ai][bj][m][0] * rs, v1 = acc[ai][bj][m][1] * rs;
                    if (MODE == 3) {
#pragma unroll
                        for (int e = 0; e < 4; ++e) { const float a = fmaxf(v0[e], 0.f), b = fmaxf(v1[e], 0.f); v0[e] = a * a; v1[e] = b * b; } }
                    u32x4 w; w.x = cvt_pk_bf16(v0[0], v0[1]); w.y = cvt_pk_bf16(v0[2], v0[3]); w.z = cvt_pk_bf16(v1[0], v1[1]); w.w = cvt_pk_bf16(v1[2], v1[3]);
                    *(u32x4*)(rowp + bj * HALF) = w; } }
    }
};
struct EpiProj {
    static constexpr bool PERM = true, AFTER_DRAIN = false;
    bf16_t* O; const float* QKW; const float* ROPE;
    __device__ __forceinline__ void operator()(const f32x4 (&acc)[2][2][4][2], const Unit& u, int wr, int wc, int fr, int fq) const {
        const int sec = u.pn >> 1, row0 = u.pm * BM + wr * 64 + fr, col0 = u.pn * BM + wc * 64 + 8 * fq;
        if (sec == 2 || sec == 5) {
#pragma unroll
            for (int ai = 0; ai < 2; ++ai)
#pragma unroll
                for (int m = 0; m < 4; ++m) { bf16_t* rowp = O + (size_t)(row0 + ai * HALF + m * 16) * NPROJ + col0;
#pragma unroll
                    for (int bj = 0; bj < 2; ++bj) { const f32x4 v0 = acc[ai][bj][m][0], v1 = acc[ai][bj][m][1];
                        u32x4 w; w.x = cvt_pk_bf16(v0[0], v0[1]); w.y = cvt_pk_bf16(v0[2], v0[3]); w.z = cvt_pk_bf16(v1[0], v1[1]); w.w = cvt_pk_bf16(v1[2], v1[3]);
                        *(u32x4*)(rowp + bj * 32) = w; } }
            return;
        }
        const float* w = QKW + 64 * (sec < 2 ? sec : sec - 1);
        const float sc = (sec == 0 || sec == 3) ? C2 : 1.f; const bool rope = sec < 2;
        f32x4 g[2][2];
#pragma unroll
        for (int bj = 0; bj < 2; ++bj)
#pragma unroll
            for (int n = 0; n < 2; ++n) g[bj][n] = *(const f32x4*)(w + 32 * bj + 8 * fq + 4 * n);
        const float sgn = fq == 0 ? -1.f : 1.f; const bool rl = fq < 2;
#pragma unroll
        for (int ai = 0; ai < 2; ++ai)
#pragma unroll
            for (int m = 0; m < 4; ++m) { const int row = row0 + ai * HALF + m * 16; float ss = 0.f;
#pragma unroll
                for (int bj = 0; bj < 2; ++bj)
#pragma unroll
                    for (int n = 0; n < 2; ++n) { const f32x4 a = acc[ai][bj][m][n]; ss += (a[0] * a[0] + a[1] * a[1]) + (a[2] * a[2] + a[3] * a[3]); }
                ss += __shfl_xor(ss, 16); ss += __shfl_xor(ss, 32);
                const float rstd = rsqrtf(ss * (1.f / 64.f) + EPS) * sc;
                f32x4 v[2][2];
#pragma unroll
                for (int bj = 0; bj < 2; ++bj)
#pragma unroll
                    for (int n = 0; n < 2; ++n) v[bj][n] = acc[ai][bj][m][n] * rstd * g[bj][n];
                if (rope) {
#pragma unroll
                    for (int n = 0; n < 2; ++n) { f32x4 pr;
#pragma unroll
                        for (int e = 0; e < 4; ++e) pr[e] = __shfl_xor(v[0][n][e], 16);
                        const f32x4 c = *(const f32x4*)(ROPE + (size_t)row * 16 + 4 * n), s = *(const f32x4*)(ROPE + (size_t)row * 16 + 8 + 4 * n);
                        const f32x4 r = v[0][n] * c + pr * s * sgn;
                        if (rl) v[0][n] = r; }
                }
                bf16_t* rowp = O + (size_t)row * NPROJ + col0;
#pragma unroll
                for (int bj = 0; bj < 2; ++bj) { u32x4 wv; wv.x = cvt_pk_bf16(v[bj][0][0], v[bj][0][1]); wv.y = cvt_pk_bf16(v[bj][0][2], v[bj][0][3]); wv.z = cvt_pk_bf16(v[bj][1][0], v[bj][1][1]); wv.w = cvt_pk_bf16(v[bj][1][2], v[bj][1][3]);
                    *(u32x4*)(rowp + bj * 32) = wv; } }
    }
};
template <int MODE> struct EpiResid {
    static constexpr bool PERM = true, AFTER_DRAIN = true;
    const float* xf; bf16_t* xb; float* outf; float* SS;
    __device__ __forceinline__ void fused(f32x4 (&acc)[2][2][4][2], const Unit& u, int wr, int wc, int fr, int fq, PG8_LAS unsigned char* lds, int wid, int lane) const {
        PG8_LAS float* P = (PG8_LAS float*)lds;
        const int col0 = u.pn * BM + wc * 32 + 8 * fq;
#pragma unroll
        for (int ai = 0; ai < 2; ++ai)
#pragma unroll
            for (int m = 0; m < 4; ++m) { const int r = ai * HALF + wr * 64 + m * 16 + fr; const size_t off = (size_t)(u.pm * BM + r) * DM + col0; float s = 0.f;
                const float rsc = MODE == 0 ? xf[u.pm * BM + r] : 1.f;
#pragma unroll
                for (int bj = 0; bj < 2; ++bj) { f32x4 b0, b1;
                    { const u32x4 w = *(const u32x4*)(xb + off + bj * HALF);
                        b0 = (f32x4){__uint_as_float(w.x << 16), __uint_as_float(w.x & 0xffff0000u), __uint_as_float(w.y << 16), __uint_as_float(w.y & 0xffff0000u)};
                        b1 = (f32x4){__uint_as_float(w.z << 16), __uint_as_float(w.z & 0xffff0000u), __uint_as_float(w.w << 16), __uint_as_float(w.w & 0xffff0000u)}; }
                    const f32x4 o0 = b0 * rsc + acc[ai][bj][m][0], o1 = b1 * rsc + acc[ai][bj][m][1];
                    if (MODE == 2) { *(f32x4*)(outf + off + bj * HALF) = o0; *(f32x4*)(outf + off + bj * HALF + 4) = o1; }
                    else { u32x4 w; w.x = cvt_pk_bf16(o0[0], o0[1]); w.y = cvt_pk_bf16(o0[2], o0[3]); w.z = cvt_pk_bf16(o1[0], o1[1]); w.w = cvt_pk_bf16(o1[2], o1[3]); *(u32x4*)(xb + off + bj * HALF) = w;
                        s += ((o0[0] * o0[0] + o0[1] * o0[1]) + (o0[2] * o0[2] + o0[3] * o0[3])) + ((o1[0] * o1[0] + o1[1] * o1[1]) + (o1[2] * o1[2] + o1[3] * o1[3])); } }
                if (MODE != 2) { s += __shfl_xor(s, 16); s += __shfl_xor(s, 32); if (fq == 0) P[r * 4 + wc] = s; }
                if (MODE == 0 ? (m == 3) : false) asm volatile("" ::: "memory"); }
        if (MODE != 2) { PG8_LBAR();
            const int t = wid * 64 + lane; if (t < 256) { const f32x4 p = *(const PG8_LAS f32x4*)(P + t * 4); SS[(size_t)(u.pm * BM + t) * 4 + u.pn] = (p[0] + p[1]) + (p[2] + p[3]); } }
    }
};
struct EpiHeadNormK {
    static constexpr bool PERM = true, AFTER_DRAIN = true;
    bf16_t* MKn; const float* kw; const float* qw;
    __device__ __forceinline__ void fused(f32x4 (&acc)[2][2][4][2], const Unit& u, int wr, int wc, int fr, int fq, PG8_LAS unsigned char* lds, int wid, int lane) const {
        PG8_LAS float* P = (PG8_LAS float*)lds; PG8_LAS float* R = (PG8_LAS float*)(lds + 4096);
#pragma unroll
        for (int ai = 0; ai < 2; ++ai)
#pragma unroll
            for (int m = 0; m < 4; ++m) { float s = 0.f;
#pragma unroll
                for (int bj = 0; bj < 2; ++bj)
#pragma unroll
                    for (int n = 0; n < 2; ++n) { const f32x4 v = acc[ai][bj][m][n]; s += (v[0] * v[0] + v[1] * v[1]) + (v[2] * v[2] + v[3] * v[3]); }
                s += __shfl_xor(s, 16); s += __shfl_xor(s, 32); if (fq == 0) P[(ai * HALF + wr * 64 + m * 16 + fr) * 4 + wc] = s; }
        PG8_LBAR();
        { const int t = wid * 64 + lane; if (t < 256) { const f32x4 p = *(const PG8_LAS f32x4*)(P + t * 4); R[t] = rsqrtf(((p[0] + p[1]) + (p[2] + p[3])) * (1.f / 256.f) + EPS); } }
        PG8_LBAR();
        const int c0 = wc * 32 + 8 * fq; f32x4 g[2][2];
#pragma unroll
        for (int bj = 0; bj < 2; ++bj)
#pragma unroll
            for (int n = 0; n < 2; ++n) { const f32x4 a = *(const f32x4*)(kw + c0 + bj * HALF + 4 * n), b = *(const f32x4*)(qw + c0 + bj * HALF + 4 * n); g[bj][n] = a * b * CM; }
        bf16_t* basep = MKn + (size_t)(u.pm * 4 + u.pn) * 65536;
#pragma unroll
        for (int ai = 0; ai < 2; ++ai)
#pragma unroll
            for (int m = 0; m < 4; ++m) { const int r = ai * HALF + wr * 64 + m * 16 + fr; const float rk = R[r];
#pragma unroll
                for (int bj = 0; bj < 2; ++bj) { const f32x4 v0 = acc[ai][bj][m][0] * rk * g[bj][0], v1 = acc[ai][bj][m][1] * rk * g[bj][1];
                    u32x4 w; w.x = cvt_pk_bf16(v0[0], v0[1]); w.y = cvt_pk_bf16(v0[2], v0[3]); w.z = cvt_pk_bf16(v1[0], v1[1]); w.w = cvt_pk_bf16(v1[2], v1[3]);
                    *(u32x4*)(basep + (size_t)r * 256 + c0 + bj * HALF) = w; } }
    }
};
struct EpiMemQ {
    static constexpr bool PERM = true, AFTER_DRAIN = true;
    bf16_t* MQ; const float* SS; PG8_LAS float* RQ;
    __device__ __forceinline__ void fused(f32x4 (&acc)[2][2][4][2], const Unit& u, int wr, int wc, int fr, int fq, PG8_LAS unsigned char* lds, int wid, int lane) const {
        PG8_LAS float* P = (PG8_LAS float*)lds;
        const int col0 = u.pn * BM + wc * 32 + 8 * fq;
#pragma unroll
        for (int ai = 0; ai < 2; ++ai)
#pragma unroll
            for (int m = 0; m < 4; ++m) { const int r = ai * HALF + wr * 64 + m * 16 + fr; const int row = u.pm * BM + r;
                const f32x4 ss = *(const f32x4*)(SS + (size_t)row * 4); const float rs = rsqrtf(((ss[0] + ss[1]) + (ss[2] + ss[3])) * (1.f / DM) + EPS); float s = 0.f;
#pragma unroll
                for (int bj = 0; bj < 2; ++bj) { const f32x4 v0 = acc[ai][bj][m][0] * rs, v1 = acc[ai][bj][m][1] * rs;
                    s += (v0[0] * v0[0] + v0[1] * v0[1]) + (v0[2] * v0[2] + v0[3] * v0[3]) + (v1[0] * v1[0] + v1[1] * v1[1]) + (v1[2] * v1[2] + v1[3] * v1[3]);
                    u32x4 w; w.x = cvt_pk_bf16(v0[0], v0[1]); w.y = cvt_pk_bf16(v0[2], v0[3]); w.z = cvt_pk_bf16(v1[0], v1[1]); w.w = cvt_pk_bf16(v1[2], v1[3]);
                    *(u32x4*)(MQ + (size_t)row * DM + col0 + bj * HALF) = w; }
                s += __shfl_xor(s, 16); s += __shfl_xor(s, 32); if (fq == 0) P[r * 4 + wc] = s; }
        PG8_LBAR();
        { const int t = wid * 64 + lane; if (t < 256) { const f32x4 p = *(const PG8_LAS f32x4*)(P + t * 4); RQ[t] = rsqrtf(((p[0] + p[1]) + (p[2] + p[3])) * (1.f / 256.f) + EPS); } }
        PG8_LBAR();
    }
};
struct EpiMemS {
    static constexpr bool PERM = true, AFTER_DRAIN = true;
    bf16_t* Pt; int head; const PG8_LAS float* RQ; PG8_LAS float* IL;
    __device__ __forceinline__ void fused(f32x4 (&acc)[2][2][4][2], const Unit& u, int wr, int wc, int fr, int fq, PG8_LAS unsigned char* lds, int wid, int lane) const {
        PG8_LAS float* P = (PG8_LAS float*)lds;
        const int col0 = head * BM + wc * 32 + 8 * fq;
#pragma unroll
        for (int ai = 0; ai < 2; ++ai)
#pragma unroll
            for (int m = 0; m < 4; ++m) { const int r = ai * HALF + wr * 64 + m * 16 + fr; const int row = u.pm * BM + r; const float rq = RQ[r]; float s = 0.f;
#pragma unroll
                for (int bj = 0; bj < 2; ++bj) { f32x4 v0 = acc[ai][bj][m][0] * rq, v1 = acc[ai][bj][m][1] * rq;
#pragma unroll
                    for (int e = 0; e < 4; ++e) { v0[e] = __builtin_amdgcn_exp2f(v0[e]); v1[e] = __builtin_amdgcn_exp2f(v1[e]); }
                    s += (v0[0] + v0[1]) + (v0[2] + v0[3]) + (v1[0] + v1[1]) + (v1[2] + v1[3]);
                    u32x4 w; w.x = cvt_pk_bf16(v0[0], v0[1]); w.y = cvt_pk_bf16(v0[2], v0[3]); w.z = cvt_pk_bf16(v1[0], v1[1]); w.w = cvt_pk_bf16(v1[2], v1[3]);
                    *(u32x4*)(Pt + (size_t)row * DM + col0 + bj * HALF) = w; }
                s += __shfl_xor(s, 16); s += __shfl_xor(s, 32); if (fq == 0) P[r * 4 + wc] = s; }
        PG8_LBAR();
        { const int t = wid * 64 + lane; if (t < 256) { const f32x4 p = *(const PG8_LAS f32x4*)(P + t * 4); IL[t] = 1.0f / ((p[0] + p[1]) + (p[2] + p[3])); } }
        PG8_LBAR();
    }
};
struct EpiMemPV {
    static constexpr bool PERM = true, AFTER_DRAIN = false;
    bf16_t* MO; int head; const PG8_LAS float* IL;
    __device__ __forceinline__ void operator()(const f32x4 (&acc)[2][2][4][2], const Unit& u, int wr, int wc, int fr, int fq) const {
        const int col0 = head * BM + wc * 32 + 8 * fq;
#pragma unroll
        for (int ai = 0; ai < 2; ++ai)
#pragma unroll
            for (int m = 0; m < 4; ++m) { const int r = ai * HALF + wr * 64 + m * 16 + fr; const int row = u.pm * BM + r; const float il = IL[r];
#pragma unroll
                for (int bj = 0; bj < 2; ++bj) { const f32x4 v0 = acc[ai][bj][m][0] * il, v1 = acc[ai][bj][m][1] * il;
                    u32x4 w; w.x = cvt_pk_bf16(v0[0], v0[1]); w.y = cvt_pk_bf16(v0[2], v0[3]); w.z = cvt_pk_bf16(v1[0], v1[1]); w.w = cvt_pk_bf16(v1[2], v1[3]);
                    *(u32x4*)(MO + (size_t)row * DM + col0 + bj * HALF) = w; } }
    }
};

template <class Epi, class Sched, bool ALIGN_EPI = false, bool SP2 = false>
__device__ __forceinline__ void gemm_phase(PG8_LAS unsigned char* lds, const Gemm g, const Sched& S, const Epi& E) {
    const int tid = threadIdx.x, wid = __builtin_amdgcn_readfirstlane(tid >> 6), lane = tid & 63, wr = wid >> 2, wc = wid & 3, fr = lane & 15, fq = lane >> 4;
    const int K = g.K, nt = K / BK;
    unsigned voffA[2], voffB[2];
#pragma unroll
    for (int i = 0; i < 2; ++i) { int R, C; stage_rc(tid * 16 + i * 8192, R, C); const int Rb = Epi::PERM ? ((R & ~31) + perm32(R & 31)) : R;
        voffA[i] = (unsigned)(R * g.lda + C) * 2u; voffB[i] = (unsigned)(Rb * g.ldb + C) * 2u; }
    const size_t kstep = (size_t)(BK * 2);
    const size_t hsA = (size_t)HALF * g.lda * 2, hsB = (size_t)HALF * g.ldb * 2;
    const size_t tsA = 2 * hsA, tsB = 2 * hsB;
    const unsigned ldsw = (unsigned)wid * 1024u;
    const int aoff = lds_byte(wr * 64 + fr, fq * 8), boff = lds_byte(wc * 32 + fr, fq * 8);
#define PG8_SA(b, h) (((b) * 2 + (h)) * HTB)
#define PG8_SB(b, h) ((4 + (b) * 2 + (h)) * HTB)
#define PG8_STAGE(bufoff, gbase, voff) do { _Pragma("unroll") for (int _i = 0; _i < 2; ++_i) \
        __builtin_amdgcn_global_load_lds((const unsigned*)((const char*)(gbase) + (voff)[_i]), (PG8_LAS unsigned*)(lds + (bufoff) + ldsw + _i * 8192), 16, 0, 0); } while (0)
#define PG8_LDA(dst, b, h) do { _Pragma("unroll") for (int m = 0; m < 4; ++m) _Pragma("unroll") for (int k = 0; k < 2; ++k) dst[m][k] = *(const PG8_LAS bf16x8*)(lds + PG8_SA(b, h) + aoff + m * 2048 + k * 1024); } while (0)
#define PG8_LDB(dst, b, h) do { _Pragma("unroll") for (int n = 0; n < 2; ++n) _Pragma("unroll") for (int k = 0; k < 2; ++k) dst[n][k] = *(const PG8_LAS bf16x8*)(lds + PG8_SB(b, h) + boff + n * 2048 + k * 1024); } while (0)
#define PG8_MMA(ai, bj, At, Bt) do { __builtin_amdgcn_s_setprio(1); _Pragma("unroll") for (int m = 0; m < 4; ++m) _Pragma("unroll") for (int n = 0; n < 2; ++n) _Pragma("unroll") for (int k = 0; k < 2; ++k) \
        acc[ai][bj][m][n] = __builtin_amdgcn_mfma_f32_16x16x32_bf16(Bt[n][k], At[m][k], acc[ai][bj][m][n], 0, 0, 0); __builtin_amdgcn_s_setprio(0); } while (0)
#define PG8_WAIT_V(n) asm volatile("s_waitcnt vmcnt(" #n ")" ::: "memory")
#define PG8_WAIT_L(n) asm volatile("s_waitcnt lgkmcnt(" #n ")" ::: "memory")
#define PG8_BAR __builtin_amdgcn_s_barrier()
#define PG8_SCHED __builtin_amdgcn_sched_barrier(0)
    Unit cur, nxt; int ui = 0;
    if (!S.next(0, cur)) return;
    f32x4 acc[2][2][4][2];
#pragma unroll
    for (int a = 0; a < 2; ++a)
#pragma unroll
        for (int b = 0; b < 2; ++b)
#pragma unroll
            for (int m = 0; m < 4; ++m)
#pragma unroll
                for (int n = 0; n < 2; ++n) acc[a][b][m][n] = (f32x4){0.f, 0.f, 0.f, 0.f};
    bf16x8 At[4][2], B0[2][2], B1[2][2];
    const char* cA = (const char*)g.A + (size_t)cur.pm * tsA; const char* cB = (const char*)g.Bt + (size_t)cur.pn * tsB;
    S.a_ready(cur);
    if constexpr (SP2) {
        PG8_STAGE(PG8_SB(0, 0), cB, voffB); PG8_STAGE(PG8_SB(0, 1), cB + hsB, voffB); PG8_STAGE(PG8_SA(0, 0), cA, voffA); PG8_STAGE(PG8_SA(0, 1), cA + hsA, voffA);
        if (wr == 1) PG8_BAR;
        PG8_WAIT_V(2); PG8_BAR;
        PG8_STAGE(PG8_SB(1, 0), cB + kstep, voffB); PG8_STAGE(PG8_SA(1, 0), cA + kstep, voffA); PG8_STAGE(PG8_SB(1, 1), cB + hsB + kstep, voffB);
        PG8_WAIT_V(6); PG8_BAR;
    } else {
        PG8_STAGE(PG8_SB(0, 0), cB, voffB); PG8_STAGE(PG8_SA(0, 0), cA, voffA); PG8_STAGE(PG8_SB(0, 1), cB + hsB, voffB); PG8_STAGE(PG8_SA(0, 1), cA + hsA, voffA);
        if (wr == 1) PG8_BAR;
        PG8_WAIT_V(4); PG8_BAR;
        PG8_STAGE(PG8_SB(1, 0), cB + kstep, voffB); PG8_STAGE(PG8_SA(1, 0), cA + kstep, voffA); PG8_STAGE(PG8_SB(1, 1), cB + hsB + kstep, voffB);
        PG8_WAIT_V(6); PG8_BAR;
    }
    for (;;) {
        const bool has_next = S.next(ui + 1, nxt);
        const char* nA = has_next ? (const char*)g.A + (size_t)nxt.pm * tsA : cA; const char* nB = has_next ? (const char*)g.Bt + (size_t)nxt.pn * tsB : cB;
        for (int t = 0; t < nt; t += 2) {
            const bool last = (t == nt - 2);
            const char* a1 = cA + (size_t)(t + 1) * kstep;
            const char* a2 = last ? nA : cA + (size_t)(t + 2) * kstep; const char* b2 = last ? nB : cB + (size_t)(t + 2) * kstep;
            const char* a3 = a2 + kstep; const char* b3 = b2 + kstep;
            if (last && has_next) S.a_ready(nxt);
            if constexpr (SP2) {
            PG8_LDB(B0, 0, 0); PG8_LDB(B1, 0, 1); PG8_SCHED; PG8_LDA(At, 0, 0); PG8_STAGE(PG8_SA(1, 1), a1 + hsA, voffA);
            PG8_WAIT_V(8); PG8_WAIT_L(0); PG8_BAR; PG8_MMA(0, 0, At, B0); PG8_MMA(0, 1, At, B1); PG8_BAR; PG8_SCHED;
            PG8_LDA(At, 0, 1); PG8_STAGE(PG8_SB(0, 0), b2, voffB); PG8_STAGE(PG8_SB(0, 1), b2 + hsB, voffB); PG8_STAGE(PG8_SA(0, 0), a2, voffA);
            PG8_WAIT_V(8); PG8_WAIT_L(0); PG8_BAR; PG8_MMA(1, 0, At, B0); PG8_MMA(1, 1, At, B1); PG8_BAR; PG8_SCHED;
            PG8_LDB(B0, 1, 0); PG8_LDB(B1, 1, 1); PG8_SCHED; PG8_LDA(At, 1, 0); PG8_STAGE(PG8_SA(0, 1), a2 + hsA, voffA);
            PG8_WAIT_V(8); PG8_WAIT_L(0); PG8_BAR; PG8_MMA(0, 0, At, B0); PG8_MMA(0, 1, At, B1); PG8_BAR; PG8_SCHED;
            PG8_LDA(At, 1, 1); PG8_STAGE(PG8_SB(1, 0), b3, voffB); PG8_STAGE(PG8_SB(1, 1), b3 + hsB, voffB); PG8_STAGE(PG8_SA(1, 0), a3, voffA);
            PG8_WAIT_V(8); PG8_WAIT_L(0); PG8_BAR; PG8_MMA(1, 0, At, B0); PG8_MMA(1, 1, At, B1); PG8_BAR; PG8_SCHED;
            } else {
            PG8_LDB(B0, 0, 0); PG8_SCHED; PG8_LDA(At, 0, 0); PG8_STAGE(PG8_SA(1, 1), a1 + hsA, voffA);
            PG8_WAIT_L(8); PG8_BAR; PG8_WAIT_L(0); PG8_MMA(0, 0, At, B0); PG8_BAR; PG8_SCHED;
            PG8_LDB(B1, 0, 1); PG8_STAGE(PG8_SB(0, 0), b2, voffB);
            PG8_BAR; PG8_WAIT_L(0); PG8_MMA(0, 1, At, B1); PG8_BAR;
            PG8_LDA(At, 0, 1); PG8_STAGE(PG8_SA(0, 0), a2, voffA);
            PG8_BAR; PG8_WAIT_L(0); PG8_MMA(1, 0, At, B0); PG8_BAR; PG8_SCHED;
            PG8_STAGE(PG8_SB(0, 1), b2 + hsB, voffB);
            PG8_WAIT_V(6); PG8_BAR; PG8_MMA(1, 1, At, B1); PG8_BAR;
            PG8_LDB(B0, 1, 0); PG8_SCHED; PG8_LDA(At, 1, 0); PG8_STAGE(PG8_SA(0, 1), a2 + hsA, voffA);
            PG8_WAIT_L(8); PG8_BAR; PG8_WAIT_L(0); PG8_MMA(0, 0, At, B0); PG8_BAR; PG8_SCHED;
            PG8_LDB(B1, 1, 1); PG8_STAGE(PG8_SB(1, 0), b3, voffB);
            PG8_BAR; PG8_WAIT_L(0); PG8_MMA(0, 1, At, B1); PG8_BAR;
            PG8_LDA(At, 1, 1); PG8_STAGE(PG8_SA(1, 0), a3, voffA);
            PG8_BAR; PG8_WAIT_L(0); PG8_MMA(1, 0, At, B0); PG8_BAR; PG8_SCHED;
            PG8_STAGE(PG8_SB(1, 1), b3 + hsB, voffB);
            PG8_WAIT_V(6); PG8_BAR; PG8_MMA(1, 1, At, B1); PG8_BAR;
            }
        }
        if constexpr (ALIGN_EPI) { if (wr == 0) PG8_BAR; }
        if constexpr (!Epi::AFTER_DRAIN) { int fr2 = fr, fq2 = fq; asm volatile("" : "+v"(fr2), "+v"(fq2)); E(acc, cur, wr, wc, fr2, fq2); S.done(cur); }
        if (!has_next) break;
#pragma unroll
        for (int a = 0; a < 2; ++a)
#pragma unroll
            for (int b = 0; b < 2; ++b)
#pragma unroll
                for (int m = 0; m < 4; ++m)
#pragma unroll
                    for (int n = 0; n < 2; ++n) acc[a][b][m][n] = (f32x4){0.f, 0.f, 0.f, 0.f};
        cur = nxt; cA = nA; cB = nB; ++ui;
        if constexpr (ALIGN_EPI) { if (wr == 1) PG8_BAR; }
    }
    PG8_WAIT_V(0);
    if constexpr (!ALIGN_EPI) { if (wr == 0) PG8_BAR; }
    PG8_BAR;
    if constexpr (Epi::AFTER_DRAIN) { int fr2 = fr, fq2 = fq, lane2 = lane; asm volatile("" : "+v"(fr2), "+v"(fq2), "+v"(lane2)); E.fused(acc, cur, wr, wc, fr2, fq2, lds, wid, lane2); S.done(cur); }
#undef PG8_SA
#undef PG8_SB
#undef PG8_STAGE
#undef PG8_LDA
#undef PG8_LDB
#undef PG8_MMA
#undef PG8_WAIT_V
#undef PG8_WAIT_L
#undef PG8_BAR
#undef PG8_SCHED
}}

#define GAS __attribute__((address_space(1)))
#define LAS __attribute__((address_space(3)))
typedef unsigned v4u __attribute__((ext_vector_type(4)));
typedef float f32x4 __attribute__((ext_vector_type(4)));
typedef short bf16x8 __attribute__((ext_vector_type(8)));
typedef GAS unsigned gu32;
typedef GAS unsigned long long gu64;
#define RLX_AGENT __ATOMIC_RELAXED, __HIP_MEMORY_SCOPE_AGENT
#define LDS_WAIT() asm volatile("s_waitcnt lgkmcnt(0)" ::: "memory")
#define VM_WAIT() asm volatile("s_waitcnt vmcnt(0)" ::: "memory")
__device__ __forceinline__ unsigned long long rt() { return __builtin_amdgcn_s_memrealtime(); }
__device__ __forceinline__ unsigned pk2(float lo, float hi) { return (unsigned)f2bf(lo) | ((unsigned)f2bf(hi) << 16); }

#define XB_TMO      128
#define XB_XCNT(j)  (256  + 64 * (j))
#define XB_XSUB(j)  (1280 + 64 * (j))
#define XB_XGEN(j)  (2304 + 64 * (j))
#define XB_TOP      3328
#define XB_TOPGEN   3392
#define XCD_BAR_WORDS 3456
#define XB_SPIN_CAP (1u << 18)

__device__ __forceinline__ unsigned xb_ld(unsigned* p)              { return __hip_atomic_load(p, __ATOMIC_RELAXED, __HIP_MEMORY_SCOPE_AGENT); }
__device__ __forceinline__ unsigned xb_add(unsigned* p, unsigned v) { return __hip_atomic_fetch_add(p, v, __ATOMIC_RELAXED, __HIP_MEMORY_SCOPE_AGENT); }
__device__ __forceinline__ unsigned xb_xcc_id() { return (unsigned)__builtin_amdgcn_s_getreg((3 << 11) | 20) & 0xFu; }
#define XB_SPIN(cond, bar) do { unsigned _sp = 0; while (cond) { __builtin_amdgcn_s_sleep(1); \
    if ((++_sp & 255u) == 0u) { if (xb_ld(&(bar)[XB_TMO])) break; if (_sp > XB_SPIN_CAP) { atomicAdd(&(bar)[XB_TMO], 1u); break; } } } } while (0)

struct XcdBarrier {
    unsigned* bar; unsigned x;
    volatile LAS unsigned* st;
};

__device__ __forceinline__ XcdBarrier xcd_barrier_post(unsigned* bar, volatile LAS unsigned* st) {
    XcdBarrier b; b.bar = bar; b.x = xb_xcc_id(); b.st = st;
    if (threadIdx.x == 0) (void)xb_add(&bar[XB_XCNT(b.x)], 1u);
    return b;
}
__device__ __forceinline__ void xcd_barrier_complete(unsigned* bar, unsigned x, unsigned& nloc, unsigned& nx) {
    const unsigned G = gridDim.x * gridDim.y * gridDim.z;
    unsigned sum, cnt, mine, sp = 0u;
    for (;;) {
        sum = 0u; cnt = 0u; mine = 0u;
#pragma unroll
        for (unsigned j = 0; j < 16; ++j) { const unsigned c = xb_ld(&bar[XB_XCNT(j)]); sum += c; cnt += (c > 0u) ? 1u : 0u; mine = (j == x) ? c : mine; }
        if (sum == G) break;
        __builtin_amdgcn_s_sleep(1);
        if ((++sp & 255u) == 0u) { if (xb_ld(&bar[XB_TMO])) break; if (sp > XB_SPIN_CAP) { atomicAdd(&bar[XB_TMO], 1u); break; } }
    }
    nloc = mine > 0u ? mine : 1u; nx = cnt > 0u ? cnt : 1u;
}

__device__ __forceinline__ void xcd_barrier(const XcdBarrier& b) {
    asm volatile("s_waitcnt vmcnt(0)" ::: "memory");
    __syncthreads();
    if (threadIdx.x == 0) {
        unsigned* bar = b.bar;
        __builtin_amdgcn_s_waitcnt(0);
        unsigned nloc = b.st[0], nx = b.st[1];
        if (nloc == 0u) { xcd_barrier_complete(bar, b.x, nloc, nx); b.st[0] = nloc; b.st[1] = nx; }
        const unsigned old = xb_add(&bar[XB_XSUB(b.x)], 1u);
        const unsigned gen = old / nloc;
        if (old + 1u == (gen + 1u) * nloc) {
            __builtin_amdgcn_fence(__ATOMIC_RELEASE, "agent");
            asm volatile("s_waitcnt vmcnt(0)" ::: "memory");
            const unsigned og = xb_add(&bar[XB_TOP], 1u);
            const unsigned tg = og / nx;
            if (og + 1u == (tg + 1u) * nx) xb_add(&bar[XB_TOPGEN], 1u);
            else XB_SPIN(xb_ld(&bar[XB_TOPGEN]) == tg, bar);
            __builtin_amdgcn_fence(__ATOMIC_ACQUIRE, "agent");
            xb_add(&bar[XB_XGEN(b.x)], 1u);
            asm volatile("s_waitcnt vmcnt(0)" ::: "memory");
        } else {
            XB_SPIN(xb_ld(&bar[XB_XGEN(b.x)]) == gen, bar);
            __builtin_amdgcn_fence(__ATOMIC_ACQUIRE, "agent");
            asm volatile("s_waitcnt vmcnt(0)" ::: "memory");
        }
    }
    __syncthreads();
}
constexpr int NWAVES = 8;
constexpr int RING_OFF = 0, RING_BYTES = 131072;
constexpr int LDSCTL_OFF = RING_BYTES, MISC_OFF = LDSCTL_OFF + 320;
constexpr int LDS_RQ = RING_BYTES + 1024, LDS_IL = RING_BYTES + 2048;
constexpr int LDS_BYTES = 147456;
constexpr int CW_TMO = 0, CW_BAR = 4096;

struct Frame {
    LAS unsigned char* lds; volatile LAS unsigned* MISC; gu32* ctl;
    int tid, lane, wave, vcu, G;
};
struct Args { const void* in[26]; float* out; unsigned char* ws; int ph_lo, ph_hi; };

__device__ __forceinline__ float wave_sum(float v) {
#pragma unroll
    for (int o = 1; o < 64; o <<= 1) v += __shfl_xor(v, o);
    return v;
}
template <bool HEADPERM> __device__ __forceinline__ void p0_transpose_item(const float* W, int ldw, int K, int N, const float* g, bf16_t* WT, LAS float* scr, int item, int lane) {
    const int nblk = N / 32, kb = item / nblk, nb = item % nblk, k0 = 64 * kb, n0 = 32 * nb;
    const int r8 = lane >> 3, c4 = (lane & 7) * 4;
    f32x4 v[8]; float gg[8];
#pragma unroll
    for (int i = 0; i < 8; ++i) { v[i] = *(const GAS f32x4*)(W + (size_t)(k0 + r8 + 8 * i) * ldw + n0 + c4); gg[i] = g ? g[k0 + r8 + 8 * i] : 1.f; }
#pragma unroll
    for (int i = 0; i < 8; ++i) { LAS float* d = scr + (r8 + 8 * i) * 33 + c4; const f32x4 x = v[i] * gg[i]; d[0] = x.x; d[1] = x.y; d[2] = x.z; d[3] = x.w; }
    LDS_WAIT(); asm volatile("" ::: "memory");
    const int c = lane & 7;
#pragma unroll
    for (int j = 0; j < 4; ++j) { const int n = (lane >> 3) + 8 * j; const LAS float* s = scr + (8 * c) * 33 + n;
        v4u o; o.x = pk2(s[0 * 33], s[1 * 33]); o.y = pk2(s[2 * 33], s[3 * 33]); o.z = pk2(s[4 * 33], s[5 * 33]); o.w = pk2(s[6 * 33], s[7 * 33]);
        int nr = n0 + n; if (HEADPERM) { const int l = nr & 255; nr = (nr & ~255) | (((l >> 5) & 1) * 128 + (l >> 6) * 32 + (l & 31)); }
        *(GAS v4u*)(WT + (size_t)nr * K + k0 + 8 * c) = o; }
    LDS_WAIT(); asm volatile("" ::: "memory");
}
template <bool FLOG> __device__ __forceinline__ void rms_rows_to_bf16(int lane, const float* X, bf16_t* O, int m0, int step, int rows, const float* g, const float* win, float* flog, float* rs0) {
    if (m0 >= rows) return;
    f32x4 wf[4][4][2];
    if (FLOG) {
#pragma unroll
        for (int j = 0; j < 4; ++j) { const f32x4 gg = *(const GAS f32x4*)(g + 256 * j + 4 * lane);
#pragma unroll
            for (int e = 0; e < 4; ++e) { const int k = 256 * j + 4 * lane + e; wf[j][e][0] = *(const GAS f32x4*)(win + (size_t)k * INCOLS + NPROJ) * gg[e]; wf[j][e][1] = *(const GAS f32x4*)(win + (size_t)k * INCOLS + NPROJ + 4) * gg[e]; } }
    }
    f32x4 nx[4], nx2[4];
    { const GAS f32x4* xr = (const GAS f32x4*)(X + (size_t)m0 * DM) + lane;
#pragma unroll
      for (int j = 0; j < 4; ++j) nx[j] = xr[64 * j];
      if (m0 + step < rows) { const GAS f32x4* xr2 = (const GAS f32x4*)(X + (size_t)(m0 + step) * DM) + lane;
#pragma unroll
          for (int j = 0; j < 4; ++j) nx2[j] = xr2[64 * j]; } }
    for (int m = m0; m < rows; m += step) {
        f32x4 v[4];
#pragma unroll
        for (int j = 0; j < 4; ++j) { v[j] = nx[j]; nx[j] = nx2[j]; }
        if (m + 2 * step < rows) { const GAS f32x4* xr = (const GAS f32x4*)(X + (size_t)(m + 2 * step) * DM) + lane;
#pragma unroll
            for (int j = 0; j < 4; ++j) nx2[j] = xr[64 * j]; }
        float s2 = 0.f;
#pragma unroll
        for (int j = 0; j < 4; ++j) s2 += (v[j].x * v[j].x + v[j].y * v[j].y) + (v[j].z * v[j].z + v[j].w * v[j].w);
        const float ms_ = wave_sum(s2) * (1.f / DM) + EPS; const float rstd = rsqrtf(ms_);
        if (FLOG) { if (lane == 0) rs0[m] = sqrtf(ms_); }
        GAS unsigned long long* o8 = (GAS unsigned long long*)(O + (size_t)m * DM) + lane;
#pragma unroll
        for (int j = 0; j < 4; ++j) { v[j] = v[j] * rstd; o8[64 * j] = (unsigned long long)pk2(v[j].x, v[j].y) | ((unsigned long long)pk2(v[j].z, v[j].w) << 32); }
        if (FLOG) {
            f32x4 a0 = {0.f, 0.f, 0.f, 0.f}, a1 = {0.f, 0.f, 0.f, 0.f};
#pragma unroll
            for (int j = 0; j < 4; ++j)
#pragma unroll
                for (int e = 0; e < 4; ++e) { a0 += wf[j][e][0] * v[j][e]; a1 += wf[j][e][1] * v[j][e]; }
#pragma unroll
            for (int e = 0; e < 4; ++e) { a0[e] = wave_sum(a0[e]); a1[e] = wave_sum(a1[e]); }
            if (lane == 0) { *(GAS f32x4*)(flog + (size_t)m * 8) = a0; *(GAS f32x4*)(flog + (size_t)m * 8 + 4) = a1; }
        }
    }
}
__constant__ float INV_FREQ[8] = {1.0f, 0.1939227432012558f, 0.03760603070259094f, 0.007292664609849453f, 0.0014142135623842478f, 0.00027424818836152554f, 5.318296098266728e-05f, 1.0313386155758053e-05f};

struct Ptrs {
    const float *x, *mem; const int* pos; const float *norm_mix_w, *w_in, *b_forget, *dqw, *dkw, *lq1, *lk1, *lq2, *lk2, *subw, *fqw, *fkw, *w_out, *nmq, *nmkv, *w_mq, *w_mkv, *mqw, *mkw, *w_mo, *nmlp, *w_up, *w_dn;
    float* out; float *FLOG, *CUMB, *ROPE, *SS, *QKW, *RS0;
    bf16_t *WIN, *WOUT, *WQ, *WKV, *WO, *WUP, *WDN, *XB, *HM, *MK, *VT, *MKN, *PROJ, *ATT, *MQ, *MO, *H;
};
__host__ __device__ __forceinline__ Ptrs make_ptrs(const void* const* in, float* out, unsigned char* ws) {
    Ptrs p;
    p.x = (const float*)in[0]; p.mem = (const float*)in[1]; p.pos = (const int*)in[2]; p.norm_mix_w = (const float*)in[3]; p.w_in = (const float*)in[4]; p.b_forget = (const float*)in[5];
    p.dqw = (const float*)in[6]; p.dkw = (const float*)in[7]; p.lq1 = (const float*)in[8]; p.lk1 = (const float*)in[9]; p.lq2 = (const float*)in[10]; p.lk2 = (const float*)in[11];
    p.subw = (const float*)in[12]; p.fqw = (const float*)in[13]; p.fkw = (const float*)in[14]; p.w_out = (const float*)in[15]; p.nmq = (const float*)in[16]; p.nmkv = (const float*)in[17];
    p.w_mq = (const float*)in[18]; p.w_mkv = (const float*)in[19]; p.mqw = (const float*)in[20]; p.mkw = (const float*)in[21]; p.w_mo = (const float*)in[22]; p.nmlp = (const float*)in[23];
    p.w_up = (const float*)in[24]; p.w_dn = (const float*)in[25]; p.out = out;
    p.FLOG = (float*)(ws + WS_FLOG); p.CUMB = (float*)(ws + WS_CUMB); p.ROPE = (float*)(ws + WS_ROPE); p.SS = (float*)(ws + WS_SS); p.QKW = (float*)(ws + WS_QKW); p.RS0 = (float*)(ws + WS_RS0);
    p.WIN = (bf16_t*)(ws + WS_WIN); p.WOUT = (bf16_t*)(ws + WS_WOUT); p.WQ = (bf16_t*)(ws + WS_WQ); p.WKV = (bf16_t*)(ws + WS_WKV); p.WO = (bf16_t*)(ws + WS_WO); p.WUP = (bf16_t*)(ws + WS_WUP); p.WDN = (bf16_t*)(ws + WS_WDN);
    p.XB = (bf16_t*)(ws + WS_XB); p.HM = (bf16_t*)(ws + WS_HM); p.MK = (bf16_t*)(ws + WS_MK); p.VT = (bf16_t*)(ws + WS_VT); p.MKN = (bf16_t*)(ws + WS_MKN);
    p.PROJ = (bf16_t*)(ws + WS_PROJ); p.ATT = (bf16_t*)(ws + WS_ATT); p.MQ = (bf16_t*)(ws + WS_MQ); p.MO = (bf16_t*)(ws + WS_MO); p.H = (bf16_t*)(ws + WS_H);
    return p;
}

__device__ __forceinline__ void p0_prologue(Frame& F, const Ptrs& P) {
    LAS float* scr = (LAS float*)(F.lds + RING_OFF + F.wave * 16384);
    const int gw = F.vcu * NWAVES + F.wave, NGW = F.G * NWAVES;
    constexpr int I_IN = 16 * 96, I_KV = 16 * 64;
    constexpr int NITEMS = I_IN + I_KV;
    for (int it = gw; it < NITEMS; it += NGW) {
        if (it < I_IN) p0_transpose_item<true>(P.w_in, INCOLS, DM, NPROJ, P.norm_mix_w, P.WIN, scr, it, F.lane);
        else p0_transpose_item<false>(P.w_mkv, 2048, DM, 2048, P.nmkv, P.WKV, scr, it - I_IN, F.lane);
    }
    rms_rows_to_bf16<true>(F.lane, P.x, P.XB, gw, NGW, MTOK, P.norm_mix_w, P.w_in, P.FLOG, P.RS0);
    rms_rows_to_bf16<false>(F.lane, P.mem, P.HM, gw, NGW, MMEM, nullptr, nullptr, nullptr, nullptr);
    if (blockIdx.x == 0 && F.tid < 64) { const int t = F.tid; P.QKW[t] = P.dqw[t]; P.QKW[64 + t] = P.dkw[t]; P.QKW[128 + t] = P.fqw[t]; P.QKW[192 + t] = P.fkw[t]; }
    for (int id = (F.vcu * NWAVES * 64) + F.tid; id < MTOK * 8; id += F.G * NWAVES * 64) {
        const int row = id >> 3, i = id & 7;
        const float ang = (float)P.pos[row] * INV_FREQ[i];
        const double a = (double)ang; const double k = rint(a * 0.15915494309189535); const float r = (float)fma(-k, 6.283185307179586, a);
        P.ROPE[(size_t)row * 16 + i] = cosf(r); P.ROPE[(size_t)row * 16 + 8 + i] = sinf(r);
    }
}
__device__ __forceinline__ void p1b_row(bf16_t* PROJ, const float* dqw, const float* dkw, const float* fqw, const float* fkw, const float* ROPE, int row, int lane) {
    const int sg = lane >> 1, hf = lane & 1;
    const int col = (sg < 16 ? sg * 64 : 1536 + (sg - 16) * 64) + hf * 32;
    const float* w = (sg < 8 ? dqw : sg < 16 ? dkw : sg < 24 ? fqw : fkw) + hf * 32;
    const bool rope = (sg < 16) && (hf == 0), isq = (sg < 8) || (sg >= 16 && sg < 24);
    GAS v4u* p = (GAS v4u*)(PROJ + (size_t)row * NPROJ + col);
    const v4u u0 = p[0], u1 = p[1], u2 = p[2], u3 = p[3];
#define UNP_LO(u) (f32x4){__uint_as_float(u.x << 16), __uint_as_float(u.x & 0xffff0000u), __uint_as_float(u.y << 16), __uint_as_float(u.y & 0xffff0000u)}
#define UNP_HI(u) (f32x4){__uint_as_float(u.z << 16), __uint_as_float(u.z & 0xffff0000u), __uint_as_float(u.w << 16), __uint_as_float(u.w & 0xffff0000u)}
    f32x4 v0 = UNP_LO(u0), v1 = UNP_HI(u0), v2 = UNP_LO(u1), v3 = UNP_HI(u1), v4 = UNP_LO(u2), v5 = UNP_HI(u2), v6 = UNP_LO(u3), v7 = UNP_HI(u3);
#undef UNP_LO
#undef UNP_HI
#define SQ4(v) ((v.x * v.x + v.y * v.y) + (v.z * v.z + v.w * v.w))
    float ss = (SQ4(v0) + SQ4(v1)) + (SQ4(v2) + SQ4(v3)) + (SQ4(v4) + SQ4(v5)) + (SQ4(v6) + SQ4(v7));
#undef SQ4
    ss += __shfl_xor(ss, 1);
    const float rstd = rsqrtf(ss * (1.f / 64.f) + EPS);
    const GAS f32x4* wg = (const GAS f32x4*)w;
    v0 = v0 * rstd * wg[0]; v1 = v1 * rstd * wg[1]; v2 = v2 * rstd * wg[2]; v3 = v3 * rstd * wg[3]; v4 = v4 * rstd * wg[4]; v5 = v5 * rstd * wg[5]; v6 = v6 * rstd * wg[6]; v7 = v7 * rstd * wg[7];
    if (rope) {
        const GAS f32x4* rt = (const GAS f32x4*)(ROPE + (size_t)row * 16);
        const f32x4 c0 = rt[0], c1 = rt[1], s0 = rt[2], s1 = rt[3];
        const f32x4 a0 = v0 * c0 - v2 * s0, b0 = v2 * c0 + v0 * s0, a1 = v1 * c1 - v3 * s1, b1 = v3 * c1 + v1 * s1;
        v0 = a0; v2 = b0; v1 = a1; v3 = b1;
    }
    const float sc = isq ? C2 : 1.f;
#define PK4(a, b) (v4u){pk2(a.x * sc, a.y * sc), pk2(a.z * sc, a.w * sc), pk2(b.x * sc, b.y * sc), pk2(b.z * sc, b.w * sc)}
    p[0] = PK4(v0, v1); p[1] = PK4(v2, v3); p[2] = PK4(v4, v5); p[3] = PK4(v6, v7);
#undef PK4
}
__device__ __forceinline__ void p1b_cumsum_wg(const float* FLOG, const float* b_forget, float* CUMB, int seq, int tid, LAS float* scr) {
    const int b = seq >> 3, h = seq & 7, lane = tid & 63, wv = tid >> 6; const float bf = b_forget[h];
    float lf[4]; float run = 0.f;
#pragma unroll
    for (int i = 0; i < 4; ++i) { const float z = FLOG[(size_t)(b * SEQ + tid * 4 + i) * 8 + h] + bf; const float e = __expf(-fabsf(z)); lf[i] = fminf(z, 0.f) - log1pf(e); run += lf[i]; }
    float inc = run;
#pragma unroll
    for (int o = 1; o < 64; o <<= 1) { const float t = __shfl_up(inc, o); if (lane >= o) inc += t; }
    if (lane == 63) scr[wv] = inc;
    __syncthreads();
    float base = 0.f;
#pragma unroll
    for (int w = 0; w < 8; ++w) { const float t = scr[w]; if (w < wv) base += t; }
    float c = base + inc - run;
    f32x4 o;
#pragma unroll
    for (int i = 0; i < 4; ++i) { c += lf[i]; o[i] = -c * LOG2E; }
    *(GAS f32x4*)(CUMB + (size_t)seq * SEQ + tid * 4) = o;
    __syncthreads();
}
__device__ __forceinline__ void p1b_cumsum(const Ptrs& P, int seq, int lane) {
    const int b = seq >> 3, h = seq & 7; const float bf = P.b_forget[h];
    float lf[32]; float run = 0.f;
#pragma unroll
    for (int i = 0; i < 32; ++i) { const float z = P.FLOG[(size_t)(b * SEQ + lane * 32 + i) * 8 + h] + bf;
        const float e = __expf(-fabsf(z)); lf[i] = fminf(z, 0.f) - log1pf(e); run += lf[i]; }
    float inc = run;
#pragma unroll
    for (int o = 1; o < 64; o <<= 1) { const float t = __shfl_up(inc, o); if (lane >= o) inc += t; }
    float c = inc - run;
#pragma unroll
    for (int i = 0; i < 32; ++i) { c += lf[i]; P.CUMB[(size_t)seq * SEQ + lane * 32 + i] = -c * LOG2E; }
}
#ifndef PROBE_K
#define PROBE_K -1
#endif
struct Sched {
    pg8::StaticOrder so; int mode, pm, pn; bool has;
    __device__ __forceinline__ bool next(int i, pg8::Unit& u) const { if (mode == 0) return so.next(i, u); if (i != 0 || !has) return false; u.pm = pm; u.pn = pn; return true; }
    __device__ __forceinline__ void a_ready(const pg8::Unit&) const {}
    __device__ __forceinline__ void done(const pg8::Unit&) const {}
};
__device__ __forceinline__ Sched sched_static(int M, int N, int G, int c) { Sched s; s.so.init(M, N, G, c); s.mode = 0; s.pm = 0; s.pn = 0; s.has = true; return s; }
__device__ __forceinline__ Sched sched_one(int pm, int pn, bool has) { Sched s; s.so.init(256, 256, 1, 0); s.mode = 1; s.pm = pm; s.pn = pn; s.has = has; return s; }

#include <hip/hip_bf16.h>
#include <cmath>
namespace ab {
using bf16=__hip_bfloat16;
using bf16x8=__attribute__((ext_vector_type(8)))short;
using s16x4=__attribute__((ext_vector_type(4)))short;
using f32x16=__attribute__((ext_vector_type(16)))float;
using u32x4=__attribute__((ext_vector_type(4)))unsigned;
using f32x4v=__attribute__((ext_vector_type(4)))float;
constexpr int D=64,PIN=NPROJ;
constexpr int NW=8,QBLK=32,QB=QBLK*NW,KVBLK=64;
__device__ __forceinline__ int crow(int r,int hi){return (r&3)+8*(r>>2)+4*hi;}
#define SBAR() __builtin_amdgcn_sched_barrier(0)
__device__ __forceinline__ void cmask(f32x16&p0,f32x16&p1,int jb,int qrel,int hi){
  const float NEG=-INFINITY; int kb=64*jb+4*hi;
  #pragma unroll
  for(int r=0;r<16;++r){int kv=kb+(r&3)+8*(r>>2); if(kv>qrel)p0[r]=NEG; if(kv+32>qrel)p1[r]=NEG;}
}

__device__ __forceinline__ void kmask(f32x16&p0,f32x16&p1,int jb,int wid){
  if(jb>(wid>>1)){const float NEG=-INFINITY;
  #pragma unroll
  for(int r=0;r<16;++r){p0[r]=NEG;p1[r]=NEG;}}
}

constexpr int NSLOT=3, SLOTB=8192;
constexpr int LDS_K=0, LDS_V=NSLOT*SLOTB, LDS_WS=2*NSLOT*SLOTB, LDS_OST=LDS_WS+NW*64*4, LDS_BIAS=LDS_OST+NW*4096, LDS_BYTES=LDS_BIAS+32768;
__device__ __forceinline__ void glds16(const void*gsrc,unsigned lds_dst){unsigned keep;
  asm volatile("s_mov_b32 %0, m0\n\ts_mov_b32 m0, %2\n\ts_nop 0\n\tglobal_load_lds_dwordx4 %1, off\n\ts_mov_b32 m0, %0":"=&s"(keep):"v"(gsrc),"s"(lds_dst):"memory");}
__device__ __forceinline__ float max3f(float a,float b,float c){float r;asm("v_max3_f32 %0, %1, %2, %3":"=v"(r):"v"(a),"v"(b),"v"(c));return r;}
__device__ __forceinline__ float max2f(float a,float b){float r;asm("v_max_f32_e32 %0, %1, %2":"=v"(r):"v"(a),"v"(b));return r;}
__device__ __forceinline__ float fadd_s(float a,float b){float r;asm("v_add_f32_e32 %0, %1, %2":"=v"(r):"v"(a),"v"(b));return r;}
__device__ __forceinline__ float fsub_s(float a,float b){float r;asm("v_sub_f32_e32 %0, %1, %2":"=v"(r):"v"(a),"v"(b));return r;}
typedef float f32x2_t __attribute__((ext_vector_type(2))); typedef __bf16 bf16x2_t __attribute__((ext_vector_type(2)));
__device__ __forceinline__ unsigned cvtpk_s(float lo,float hi){f32x2_t v={lo,hi};bf16x2_t b=__builtin_convertvector(v,bf16x2_t);return __builtin_bit_cast(unsigned,b);}
#define WAIT_BAR(N) asm volatile("s_waitcnt vmcnt(" #N ") lgkmcnt(0)\n\ts_barrier":::"memory")

__device__ __forceinline__ void qkt(f32x16&p0,f32x16&p1,const char*Kslot,const bf16x8*qr,const f32x16&negm,int r32,int hi){
  const char*kb=Kslot+hi*1024+r32*16;
  #pragma unroll
  for(int d0=0;d0<4;++d0){
    const bf16x8 b0=*reinterpret_cast<const bf16x8*>(kb+d0*2048);
    const bf16x8 b1=*reinterpret_cast<const bf16x8*>(kb+d0*2048+512);
    if(d0==0){p0=__builtin_amdgcn_mfma_f32_32x32x16_bf16(b0,qr[0],negm,0,0,0);p1=__builtin_amdgcn_mfma_f32_32x32x16_bf16(b1,qr[0],negm,0,0,0);}
    else{p0=__builtin_amdgcn_mfma_f32_32x32x16_bf16(b0,qr[d0],p0,0,0,0);p1=__builtin_amdgcn_mfma_f32_32x32x16_bf16(b1,qr[d0],p1,0,0,0);}}
}
typedef __attribute__((address_space(3))) const char* lds_cptr;
typedef short v4i16_t __attribute__((ext_vector_type(4)));
__device__ __forceinline__ void kload8(bf16x8*kf,lds_cptr kp){
  kf[0]=*(const __attribute__((address_space(3))) bf16x8*)(kp);      kf[1]=*(const __attribute__((address_space(3))) bf16x8*)(kp+512);
  kf[2]=*(const __attribute__((address_space(3))) bf16x8*)(kp+2048); kf[3]=*(const __attribute__((address_space(3))) bf16x8*)(kp+2560);
  kf[4]=*(const __attribute__((address_space(3))) bf16x8*)(kp+4096); kf[5]=*(const __attribute__((address_space(3))) bf16x8*)(kp+4608);
  kf[6]=*(const __attribute__((address_space(3))) bf16x8*)(kp+6144); kf[7]=*(const __attribute__((address_space(3))) bf16x8*)(kp+6656);
}
__device__ __forceinline__ void kload2(bf16x8*kf,lds_cptr kp,int j){ kf[2*j]=*(const __attribute__((address_space(3))) bf16x8*)(kp+j*2048); kf[2*j+1]=*(const __attribute__((address_space(3))) bf16x8*)(kp+j*2048+512); }
__device__ __forceinline__ s16x4 vtr(lds_cptr p){ return __builtin_bit_cast(s16x4,__builtin_amdgcn_ds_read_tr16_b64_v4i16((__attribute__((address_space(3))) v4i16_t*)p)); }
__device__ __forceinline__ float rowmax(const f32x16&p0,const f32x16&p1){
  float a=max3f(p0[0],p0[1],p1[0]),b=max3f(p0[2],p0[3],p1[1]);a=max3f(a,p1[2],p1[3]);
  #pragma unroll
  for(int r=4;r<16;r+=4){a=max3f(a,p0[r],p0[r+1]);b=max3f(b,p0[r+2],p0[r+3]);a=max3f(a,p1[r],p1[r+1]);b=max3f(b,p1[r+2],p1[r+3]);}
  const float m=max2f(a,b);
  auto rr=__builtin_amdgcn_permlane32_swap(__float_as_uint(m),__float_as_uint(m),false,false);
  return max2f(__uint_as_float(rr[0]),__uint_as_float(rr[1]));
}
__device__ __forceinline__ void pv(f32x16*o,int vb,bf16x8 pa0,bf16x8 pa1,bf16x8 pa2,bf16x8 pa3){
  #pragma unroll
  for(int d0=0;d0<2;++d0){s16x4 lo[4],hi[4];
    #pragma unroll
    for(int ks=0;ks<4;++ks){
      asm volatile("ds_read_b64_tr_b16 %0,%1 offset:%c2":"=&v"(lo[ks]):"v"(vb),"i"(d0*4096+ks*1024):"memory");
      asm volatile("ds_read_b64_tr_b16 %0,%1 offset:%c2":"=&v"(hi[ks]):"v"(vb),"i"(d0*4096+ks*1024+512):"memory");}
    asm volatile("s_waitcnt lgkmcnt(0)":::"memory");SBAR();
    #define PK(k) (bf16x8){lo[k][0],lo[k][1],lo[k][2],lo[k][3],hi[k][0],hi[k][1],hi[k][2],hi[k][3]}
    o[d0]=__builtin_amdgcn_mfma_f32_32x32x16_bf16(pa0,PK(0),o[d0],0,0,0);
    o[d0]=__builtin_amdgcn_mfma_f32_32x32x16_bf16(pa1,PK(1),o[d0],0,0,0);
    o[d0]=__builtin_amdgcn_mfma_f32_32x32x16_bf16(pa2,PK(2),o[d0],0,0,0);
    o[d0]=__builtin_amdgcn_mfma_f32_32x32x16_bf16(pa3,PK(3),o[d0],0,0,0);
    #undef PK
  }
}

#ifndef ATTN_STORE16
#define ATTN_STORE16(p,v) (*(u32x4*)(p)=(v))
#endif
__device__ __forceinline__ void split3(float x,float&h,float&m,float&l){
  h=__uint_as_float(cvtpk_s(x,0.f)<<16); const float r1=x-h; m=__uint_as_float(cvtpk_s(r1,0.f)<<16); const float r2=r1-m; l=__uint_as_float(cvtpk_s(r2,0.f)<<16);
}
template<int THRL,int MASK,bool BIAS,bool WT> __device__ __forceinline__ void attn_unit(int qb,const bf16*Qh,const bf16*__restrict__ Kh,const bf16*__restrict__ Vh,bf16*Oh,int opitch,const float*__restrict__ biasg,char*shm){
  int tid_=threadIdx.x; asm volatile("":"+v"(tid_));
  const int tid=tid_,lane=tid&63,r32=lane&31,hi=lane>>5; const int wid=__builtin_amdgcn_readfirstlane(tid>>6);
  const int q0=qb*QB;
  const bf16*Qw=Qh+(long)(q0+wid*QBLK)*PIN;
  const unsigned lds0=(unsigned)(uintptr_t)shm;
  float*wsf=(float*)(shm+LDS_WS)+wid*64;
  const bf16*ksrc=Kh+(long)lane*PIN+wid*8;
  const bf16*vsrc=Vh+(long)(16*(wid&3)+(lane>>2))*PIN+(wid>>2)*32+(lane&3)*8;
  const unsigned kdst=lds0+LDS_K+wid*1024, vdst=lds0+LDS_V+wid*1024;
  #define DMA_K(t,slot) glds16(ksrc+(long)(t)*KVBLK*PIN,(unsigned)__builtin_amdgcn_readfirstlane(kdst+(slot)))
  #define DMA_V(t,slot) glds16(vsrc+(long)(t)*KVBLK*PIN,(unsigned)__builtin_amdgcn_readfirstlane(vdst+(slot)))
  const int vb0=(int)(lds0+LDS_V)+((lane>>4)&1)*32+(lane&3)*8+(4*hi+((lane&15)>>2))*64;
  const char*Kbase=shm+LDS_K; bf16x8 kf[8];
  const lds_cptr shm3=(lds_cptr)shm; const lds_cptr kp0=shm3+LDS_K+hi*1024+r32*16; const lds_cptr vp0=shm3+LDS_V+((lane>>4)&1)*32+(lane&3)*8+(4*hi+((lane&15)>>2))*64;
  const int NT=(q0+QB)/KVBLK;
  DMA_K(0,0);DMA_V(0,0);DMA_K(1,SLOTB);
  if(BIAS){ int t2=tid; asm volatile("":"+v"(t2)); if(t2<NT*16){ const f32x4v bv=*reinterpret_cast<const f32x4v*>(biasg+t2*4);
      _Pragma("unroll") for(int e_=0;e_<4;++e_){ float h_,m_,l_; split3(bv[e_],h_,m_,l_); u32x4 w_; w_.x=cvtpk_s(h_,m_); w_.y=cvtpk_s(l_,1.f); w_.z=0x3F803F80u; w_.w=0u; *reinterpret_cast<u32x4*>(shm+LDS_BIAS+(t2*4+e_)*16)=w_; } } }
  u32x4 mfr; mfr.x=hi?0u:0x3F803F80u; mfr.y=hi?0u:0x00003F80u; mfr.z=0u; mfr.w=0u;
  #define MFR_UPDATE() do{ if(BIAS){ float h_,m_,l_; split3(-mhat,h_,m_,l_); const unsigned y_=cvtpk_s(1.f,h_), z_=cvtpk_s(m_,l_); mfr.y=hi?0u:y_; mfr.z=hi?0u:z_; } }while(0)
  #define MFRB __builtin_bit_cast(bf16x8,mfr)
  const lds_cptr bt0=(lds_cptr)shm+LDS_BIAS+r32*16;
  bf16x8 qr[4];
  #pragma unroll
  for(int d0=0;d0<4;++d0)qr[d0]=*reinterpret_cast<const bf16x8*>(&Qw[(long)r32*PIN+d0*16+hi*8]);
  float mhat=0.f,l_reg=0.f;f32x16 o[2];o[0]=f32x16{};o[1]=f32x16{};f32x16 negm=f32x16{}; if(!BIAS){asm volatile("":"+v"(negm));}
  #define CIN (BIAS?f32x16{}:negm)
  const int qrel=wid*QBLK+r32;
  #define CMASK(P0,P1,t) do{int jb_=(t)-(NT-4); if(jb_>=0){ if(MASK==0)cmask(P0,P1,jb_,qrel,hi); else kmask(P0,P1,jb_,wid); } }while(0)
  bool resc=false;
  #define START(P0,P1) do{ const float rm=rowmax(P0,P1); resc=false; \
    { const float dl=rm; mhat=fadd_s(mhat,dl); \
      _Pragma("unroll") for(int r=0;r<16;++r){P0[r]=fsub_s(P0[r],dl);P1[r]=fsub_s(P1[r],dl);} \
      if(!BIAS){ _Pragma("unroll") for(int r=0;r<16;++r)negm[r]=-mhat; asm volatile("":"+v"(negm)); } MFR_UPDATE(); } \
    _Pragma("unroll") for(int r=0;r<16;++r)P0[r]=__builtin_amdgcn_exp2f(P0[r]); }while(0)
  #define RESC() do{ if(resc){ asm volatile("s_waitcnt lgkmcnt(0)":::"memory"); \
      _Pragma("unroll") for(int d_=0;d_<2;++d_) _Pragma("unroll") for(int r=0;r<16;++r)o[d_][r]*=wsf[crow(r,hi)]; } }while(0)
  f32x16 pA0,pA1,pB0,pB1;
  int sl_prev=0,sl_cur=0,sl_next=SLOTB;
  #define ROT() do{sl_prev=sl_cur;sl_cur=sl_next;sl_next=(sl_next==(NSLOT-1)*SLOTB)?0:sl_next+SLOTB;}while(0)
  DMA_K(2,2*SLOTB);
  WAIT_BAR(3);
  qkt(pA0,pA1,Kbase,qr,CIN,r32,hi);
  if(BIAS){ const bf16x8 b0_=*(const __attribute__((address_space(3))) bf16x8*)(bt0), b1_=*(const __attribute__((address_space(3))) bf16x8*)(bt0+512);
    pA0=__builtin_amdgcn_mfma_f32_32x32x16_bf16(b0_,MFRB,pA0,0,0,0); pA1=__builtin_amdgcn_mfma_f32_32x32x16_bf16(b1_,MFRB,pA1,0,0,0); }
  asm volatile("s_nop 15\n\ts_nop 7":"+v"(pA0),"+v"(pA1));CMASK(pA0,pA1,0);
  START(pA0,pA1);
  _Pragma("unroll") for(int r=0;r<16;++r)pA1[r]=__builtin_amdgcn_exp2f(pA1[r]);
  WAIT_BAR(0);
  DMA_K(3,0);DMA_V(1,SLOTB);
  ROT();
  kload8(kf,kp0+sl_cur);
  WAIT_BAR(2);
  s16x4 vlo[8],vhi[8]; u32x4 pw0,pw1,pw2,pw3;
  #define PKW(P,B) cvtpk_s(P[B],P[B+1])
  #define PAF(k) __builtin_bit_cast(bf16x8,pw##k)
  #define VFR(i) (bf16x8){vlo[i][0],vlo[i][1],vlo[i][2],vlo[i][3],vhi[i][0],vhi[i][1],vhi[i][2],vhi[i][3]}
  #define PIN(x) asm volatile("":"+v"(x))
  #define MX3(a,b,c) __builtin_fmaxf(__builtin_fmaxf((a),(b)),(c))
  #define GAPA(MF,A0,A1,A2,A3,W0,W1,PW) do{ MF; sacc+=A0; sacc+=A1; sacc+=A2; sacc+=A3; PIN(sacc); W0; W1; PIN(PW); SBAR(); }while(0)
  #define EX(v) __builtin_amdgcn_exp2f(v)
  #define GAPB(MF,X,B) do{ MF; X[B]=EX(X[B]); X[B+1]=EX(X[B+1]); X[B+2]=EX(X[B+2]); X[B+3]=EX(X[B+3]); PIN(X); SBAR(); }while(0)
  #define VRD(i) do{ vlo[i]=vtr(vp_+(((i)>>2)*4096+((i)&3)*1024)); vhi[i]=vtr(vp_+(((i)>>2)*4096+((i)&3)*1024+512)); }while(0)
  #define KRD(G,j) do{ if(G){ kload2(kf,kp0+sl_next,j); SBAR(); } }while(0)
  #define STEP(C0,C1,P0,P1,t,GK,GV,GL) do{ SBAR(); \
    const lds_cptr vp_=vp0+sl_prev; \
    bf16x8 bb0_,bb1_; if(BIAS){ bb0_=*(const __attribute__((address_space(3))) bf16x8*)(bt0+(t)*1024); bb1_=*(const __attribute__((address_space(3))) bf16x8*)(bt0+(t)*1024+512); } \
    VRD(0); SBAR(); float sacc=(P0[0]+P0[1]); \
    GAPA(C0=__builtin_amdgcn_mfma_f32_32x32x16_bf16(kf[0],qr[0],CIN,0,0,0), P0[2],P0[3],P0[4],P0[5],     pw0[0]=PKW(P0,0), pw0[1]=PKW(P0,2), pw0); \
    VRD(4); SBAR(); GAPA(C1=__builtin_amdgcn_mfma_f32_32x32x16_bf16(kf[1],qr[0],CIN,0,0,0), P0[6],P0[7],P0[8],P0[9],     pw0[2]=PKW(P0,4), pw0[3]=PKW(P0,6), pw0); \
    VRD(1); SBAR(); GAPA(C0=__builtin_amdgcn_mfma_f32_32x32x16_bf16(kf[2],qr[1],C0,0,0,0),   P0[10],P0[11],P0[12],P0[13], pw1[0]=PKW(P0,8), pw1[1]=PKW(P0,10), pw1); \
    VRD(5); SBAR(); GAPA(C1=__builtin_amdgcn_mfma_f32_32x32x16_bf16(kf[3],qr[1],C1,0,0,0),   P0[14],P0[15],P1[0],P1[1],   pw1[2]=PKW(P0,12),pw1[3]=PKW(P0,14), pw1); \
    VRD(2); SBAR(); GAPA(C0=__builtin_amdgcn_mfma_f32_32x32x16_bf16(kf[4],qr[2],C0,0,0,0),   P1[2],P1[3],P1[4],P1[5],     pw2[0]=PKW(P1,0), pw2[1]=PKW(P1,2), pw2); \
    VRD(6); SBAR(); GAPA(C1=__builtin_amdgcn_mfma_f32_32x32x16_bf16(kf[5],qr[2],C1,0,0,0),   P1[6],P1[7],P1[8],P1[9],     pw2[2]=PKW(P1,4), pw2[3]=PKW(P1,6), pw2); \
    VRD(3); SBAR(); GAPA(C0=__builtin_amdgcn_mfma_f32_32x32x16_bf16(kf[6],qr[3],C0,0,0,0),   P1[10],P1[11],P1[12],P1[13], pw3[0]=PKW(P1,8), pw3[1]=PKW(P1,10), pw3); \
    VRD(7); SBAR(); GAPA(C1=__builtin_amdgcn_mfma_f32_32x32x16_bf16(kf[7],qr[3],C1,0,0,0),   P1[14],P1[15],0.f,0.f,       pw3[2]=PKW(P1,12),pw3[3]=PKW(P1,14), pw3); \
    if(BIAS){ C0=__builtin_amdgcn_mfma_f32_32x32x16_bf16(bb0_,MFRB,C0,0,0,0); C1=__builtin_amdgcn_mfma_f32_32x32x16_bf16(bb1_,MFRB,C1,0,0,0); SBAR(); } \
    l_reg+=sacc; \
    if(GK){DMA_K((t)+3,sl_cur);} if(GV){DMA_V((t)+1,sl_next);} \
    CMASK(C0,C1,t); \
    { float a=MX3(C0[0],C0[1],C1[0]),b=MX3(C0[2],C0[3],C1[1]); a=MX3(a,C1[2],C1[3]); \
      _Pragma("unroll") for(int r=4;r<16;r+=4){a=MX3(a,C0[r],C0[r+1]);b=MX3(b,C0[r+2],C0[r+3]);a=MX3(a,C1[r],C1[r+1]);b=MX3(b,C1[r+2],C1[r+3]);} \
      float rm=__builtin_fmaxf(a,b); { auto rr=__builtin_amdgcn_permlane32_swap(__float_as_uint(rm),__float_as_uint(rm),false,false); rm=__builtin_fmaxf(__uint_as_float(rr[0]),__uint_as_float(rr[1])); } \
      resc=false; \
      if(__builtin_expect(__any(rm>(float)THRL),0)){ const float dl=__builtin_fmaxf(rm,0.f); mhat+=dl; \
        _Pragma("unroll") for(int r=0;r<16;++r){C0[r]-=dl;C1[r]-=dl;} \
        if(!BIAS){ _Pragma("unroll") for(int r=0;r<16;++r)negm[r]=-mhat; asm volatile("":"+v"(negm)); } MFR_UPDATE(); \
        const float f=__builtin_amdgcn_exp2f(-dl); l_reg*=f; if(hi==0)wsf[r32]=f; resc=true; } } \
    SBAR(); \
    GAPB(o[0]=__builtin_amdgcn_mfma_f32_32x32x16_bf16(PAF(0),VFR(0),o[0],0,0,0), C0,0); \
    GAPB(o[1]=__builtin_amdgcn_mfma_f32_32x32x16_bf16(PAF(0),VFR(4),o[1],0,0,0), C0,4); \
    KRD(GL,0); GAPB(o[0]=__builtin_amdgcn_mfma_f32_32x32x16_bf16(PAF(1),VFR(1),o[0],0,0,0), C0,8); \
    KRD(GL,1); GAPB(o[1]=__builtin_amdgcn_mfma_f32_32x32x16_bf16(PAF(1),VFR(5),o[1],0,0,0), C0,12); \
    KRD(GL,2); GAPB(o[0]=__builtin_amdgcn_mfma_f32_32x32x16_bf16(PAF(2),VFR(2),o[0],0,0,0), C1,0); \
    KRD(GL,3); GAPB(o[1]=__builtin_amdgcn_mfma_f32_32x32x16_bf16(PAF(2),VFR(6),o[1],0,0,0), C1,4); \
    GAPB(o[0]=__builtin_amdgcn_mfma_f32_32x32x16_bf16(PAF(3),VFR(3),o[0],0,0,0), C1,8); \
    GAPB(o[1]=__builtin_amdgcn_mfma_f32_32x32x16_bf16(PAF(3),VFR(7),o[1],0,0,0), C1,12); \
    }while(0)
  int t=1;
  #undef CMASK
  #define CMASK(P0,P1,t) do{}while(0)
  for(;t+5<NT;t+=2){
    STEP(pB0,pB1,pA0,pA1,t,true,true,true);     WAIT_BAR(2); RESC(); ROT();
    STEP(pA0,pA1,pB0,pB1,t+1,true,true,true);   WAIT_BAR(2); RESC(); ROT();
  }
  #undef CMASK
  #define CMASK(P0,P1,t) do{int jb_=(t)-(NT-4); if(jb_>=0){ if(MASK==0)cmask(P0,P1,jb_,qrel,hi); else kmask(P0,P1,jb_,wid); } }while(0)
  #define ENDW(tt) do{ if((tt)+3<NT){WAIT_BAR(2);} else if((tt)+2<NT){WAIT_BAR(1);} else {WAIT_BAR(0);} }while(0)
  for(;t+1<NT;t+=2){
    STEP(pB0,pB1,pA0,pA1,t,(t+3<NT),(t+1<NT),(t+1<NT));       ENDW(t);   RESC(); ROT();
    STEP(pA0,pA1,pB0,pB1,t+1,(t+4<NT),(t+2<NT),(t+2<NT));     ENDW(t+1); RESC(); ROT();
  }
  STEP(pB0,pB1,pA0,pA1,NT-1,false,false,false); RESC();
  { float sacc=pB0[0]+pB0[1]; _Pragma("unroll") for(int r=2;r<16;++r)sacc+=pB0[r]; _Pragma("unroll") for(int r=0;r<16;++r)sacc+=pB1[r]; l_reg+=sacc;
    pw0=(u32x4){PKW(pB0,0),PKW(pB0,2),PKW(pB0,4),PKW(pB0,6)};pw1=(u32x4){PKW(pB0,8),PKW(pB0,10),PKW(pB0,12),PKW(pB0,14)};pw2=(u32x4){PKW(pB1,0),PKW(pB1,2),PKW(pB1,4),PKW(pB1,6)};pw3=(u32x4){PKW(pB1,8),PKW(pB1,10),PKW(pB1,12),PKW(pB1,14)};
    SBAR(); pv(o,vb0+sl_cur,PAF(0),PAF(1),PAF(2),PAF(3)); }
  #undef PKW
  #undef PAF
  #undef VFR
  #undef PIN
  #undef MX3
  #undef GAPA
  #undef GAPB
  #undef EX
  #undef VRD
  #undef KRD
  #undef STEP
  #undef ENDW
  {auto rr=__builtin_amdgcn_permlane32_swap(__float_as_uint(l_reg),__float_as_uint(l_reg),false,false);l_reg=__uint_as_float(rr[0])+__uint_as_float(rr[1]);}
  if(hi==0)wsf[32+r32]=l_reg;asm volatile("s_waitcnt lgkmcnt(0)":::"memory");
  float rli[16];
  #pragma unroll
  for(int r=0;r<16;++r)rli[r]=__builtin_amdgcn_rcpf(wsf[32+crow(r,hi)]);
  bf16*Ow=Oh+(long)(q0+wid*QBLK)*opitch;
  { bf16*stg=(bf16*)(shm+LDS_OST)+wid*2048;
    #pragma unroll
    for(int r=0;r<16;++r){const int orow=crow(r,hi);
      #pragma unroll
      for(int d0=0;d0<2;++d0)stg[orow*64+d0*32+r32]=__float2bfloat16(o[d0][r]*rli[r]);}
    asm volatile("s_waitcnt lgkmcnt(0)":::"memory");
    if(WT){ const __amdgpu_buffer_rsrc_t rs_=__builtin_amdgcn_make_buffer_rsrc((void*)Oh,(short)0,0x7fffffff,0x00020000);
      #pragma unroll
      for(int i=0;i<4;++i){const int row=i*8+(lane>>3),ch=lane&7; const u32x4 v=*(const u32x4*)(stg+row*64+ch*8); __builtin_amdgcn_raw_buffer_store_b128(v,rs_,(int)(((long)(q0+wid*QBLK+row)*opitch+ch*8)*2),0,16);} }
    else{
    #pragma unroll
    for(int i=0;i<4;++i){const int row=i*8+(lane>>3),ch=lane&7; const u32x4 v=*(const u32x4*)(stg+row*64+ch*8); ATTN_STORE16(Ow+(long)row*opitch+ch*8,v);} } }
  asm volatile("s_waitcnt lgkmcnt(0)\n\ts_barrier":::"memory");
  #undef DMA_K
  #undef DMA_V
  #undef CMASK
  #undef CIN
  #undef MFR_UPDATE
  #undef MFRB
  #undef START
  #undef RESC
  #undef ROT
}
constexpr int ATTN_LDS_BYTES=LDS_BYTES;
#undef SBAR
#undef WAIT_BAR
}
__constant__ unsigned short UNIT_Q[8][180] = {
  {0x4000,0x4001,0x4002,0x4003,0x4004,0x4005,0x4006,0x4007,0x8007,0x8107,0x800f,0x810f,0x8006,0x8106,0x800e,0x810e,0x8005,0x8105,0x800d,0x810d,0x8004,0x8104,0x800c,0x810c,0x8003,0x8103,0x800b,0x810b,0x8002,0x8102,0x800a,0x810a,0x8001,0x8101,0x8009,0x8109,0x8000,0x8100,0x8008,0x8108,0x8017,0x8117,0x801f,0x811f,0x8016,0x8116,0x801e,0x811e,0x8015,0x8115,0x801d,0x811d,0x8014,0x8114,0x801c,0x811c,0x8013,0x8113,0x801b,0x811b,0x8012,0x8112,0x801a,0x811a,0x8011,0x8111,0x8019,0x8119,0x8010,0x8110,0x8018,0x8118,0x0007,0x000f,0x0017,0x001f,0x0006,0x000e,0x0016,0x001e,0x0005,0x000d,0x0015,0x001d,0x0004,0x000c,0x0014,0x001c,0x0003,0x000b,0x0013,0x001b,0x0002,0x000a,0x0012,0x001a,0x0001,0x0009,0x0011,0x0019,0x0000,0x0008,0x0010,0x0018,0x0027,0x002f,0x0037,0x003f,0x0026,0x002e,0x0036,0x003e,0x0025,0x002d,0x0035,0x003d,0x0024,0x002c,0x0034,0x003c,0x0023,0x002b,0x0033,0x003b,0x0022,0x002a,0x0032,0x003a,0x0021,0x0029,0x0031,0x0039,0x0020,0x0028,0x0030,0x0038,0x2000,0x2001,0x2002,0x2003,0x2004,0x2005,0x2006,0x2007,0x2008,0x2009,0x200a,0x200b,0x200c,0x200d,0x200e,0x200f,0x2010,0x2011,0x2012,0x2013,0x2014,0x2015,0x2016,0x2017,0x2018,0x2019,0x201a,0x201b,0x201c,0x201d,0x201e,0x201f,0x2020,0x2021,0x2022,0x2023,0x2024,0x2025,0x2026,0x2027,0x2028,0x2029,0x202a,0x202b},
  {0x4008,0x4009,0x400a,0x400b,0x400c,0x400d,0x400e,0x400f,0x8027,0x8127,0x802f,0x812f,0x8026,0x8126,0x802e,0x812e,0x8025,0x8125,0x802d,0x812d,0x8024,0x8124,0x802c,0x812c,0x8023,0x8123,0x802b,0x812b,0x8022,0x8122,0x802a,0x812a,0x8021,0x8121,0x8029,0x8129,0x8020,0x8120,0x8028,0x8128,0x8037,0x8137,0x803f,0x813f,0x8036,0x8136,0x803e,0x813e,0x8035,0x8135,0x803d,0x813d,0x8034,0x8134,0x803c,0x813c,0x8033,0x8133,0x803b,0x813b,0x8032,0x8132,0x803a,0x813a,0x8031,0x8131,0x8039,0x8139,0x8030,0x8130,0x8038,0x8138,0x0047,0x004f,0x0057,0x005f,0x0046,0x004e,0x0056,0x005e,0x0045,0x004d,0x0055,0x005d,0x0044,0x004c,0x0054,0x005c,0x0043,0x004b,0x0053,0x005b,0x0042,0x004a,0x0052,0x005a,0x0041,0x0049,0x0051,0x0059,0x0040,0x0048,0x0050,0x0058,0x0067,0x006f,0x0077,0x007f,0x0066,0x006e,0x0076,0x007e,0x0065,0x006d,0x0075,0x007d,0x0064,0x006c,0x0074,0x007c,0x0063,0x006b,0x0073,0x007b,0x0062,0x006a,0x0072,0x007a,0x0061,0x0069,0x0071,0x0079,0x0060,0x0068,0x0070,0x0078,0x202c,0x202d,0x202e,0x202f,0x2030,0x2031,0x2032,0x2033,0x2034,0x2035,0x2036,0x2037,0x2038,0x2039,0x203a,0x203b,0x203c,0x203d,0x203e,0x203f,0x2040,0x2041,0x2042,0x2043,0x2044,0x2045,0x2046,0x2047,0x2048,0x2049,0x204a,0x204b,0x204c,0x204d,0x204e,0x204f,0x2050,0x2051,0x2052,0x2053,0x2054,0x2055,0x2056,0x2057},
  {0x4010,0x4011,0x4012,0x4013,0x4014,0x4015,0x4016,0x4017,0x8047,0x8147,0x804f,0x814f,0x8046,0x8146,0x804e,0x814e,0x8045,0x8145,0x804d,0x814d,0x8044,0x8144,0x804c,0x814c,0x8043,0x8143,0x804b,0x814b,0x8042,0x8142,0x804a,0x814a,0x8041,0x8141,0x8049,0x8149,0x8040,0x8140,0x8048,0x8148,0x8057,0x8157,0x805f,0x815f,0x8056,0x8156,0x805e,0x815e,0x8055,0x8155,0x805d,0x815d,0x8054,0x8154,0x805c,0x815c,0x8053,0x8153,0x805b,0x815b,0x8052,0x8152,0x805a,0x815a,0x8051,0x8151,0x8059,0x8159,0x8050,0x8150,0x8058,0x8158,0x0087,0x008f,0x0097,0x009f,0x0086,0x008e,0x0096,0x009e,0x0085,0x008d,0x0095,0x009d,0x0084,0x008c,0x0094,0x009c,0x0083,0x008b,0x0093,0x009b,0x0082,0x008a,0x0092,0x009a,0x0081,0x0089,0x0091,0x0099,0x0080,0x0088,0x0090,0x0098,0x00a7,0x00af,0x00b7,0x00bf,0x00a6,0x00ae,0x00b6,0x00be,0x00a5,0x00ad,0x00b5,0x00bd,0x00a4,0x00ac,0x00b4,0x00bc,0x00a3,0x00ab,0x00b3,0x00bb,0x00a2,0x00aa,0x00b2,0x00ba,0x00a1,0x00a9,0x00b1,0x00b9,0x00a0,0x00a8,0x00b0,0x00b8,0x2058,0x2059,0x205a,0x205b,0x205c,0x205d,0x205e,0x205f,0x2060,0x2061,0x2062,0x2063,0x2064,0x2065,0x2066,0x2067,0x2068,0x2069,0x206a,0x206b,0x206c,0x206d,0x206e,0x206f,0x2070,0x2071,0x2072,0x2073,0x2074,0x2075,0x2076,0x2077,0x2078,0x2079,0x207a,0x207b,0x207c,0x207d,0x207e,0x207f,0x2080,0x2081,0x2082,0x2083},
  {0x4018,0x4019,0x401a,0x401b,0x401c,0x401d,0x401e,0x401f,0x8067,0x8167,0x806f,0x816f,0x8066,0x8166,0x806e,0x816e,0x8065,0x8165,0x806d,0x816d,0x8064,0x8164,0x806c,0x816c,0x8063,0x8163,0x806b,0x816b,0x8062,0x8162,0x806a,0x816a,0x8061,0x8161,0x8069,0x8169,0x8060,0x8160,0x8068,0x8168,0x8077,0x8177,0x807f,0x817f,0x8076,0x8176,0x807e,0x817e,0x8075,0x8175,0x807d,0x817d,0x8074,0x8174,0x807c,0x817c,0x8073,0x8173,0x807b,0x817b,0x8072,0x8172,0x807a,0x817a,0x8071,0x8171,0x8079,0x8179,0x8070,0x8170,0x8078,0x8178,0x00c7,0x00cf,0x00d7,0x00df,0x00c6,0x00ce,0x00d6,0x00de,0x00c5,0x00cd,0x00d5,0x00dd,0x00c4,0x00cc,0x00d4,0x00dc,0x00c3,0x00cb,0x00d3,0x00db,0x00c2,0x00ca,0x00d2,0x00da,0x00c1,0x00c9,0x00d1,0x00d9,0x00c0,0x00c8,0x00d0,0x00d8,0x00e7,0x00ef,0x00f7,0x00ff,0x00e6,0x00ee,0x00f6,0x00fe,0x00e5,0x00ed,0x00f5,0x00fd,0x00e4,0x00ec,0x00f4,0x00fc,0x00e3,0x00eb,0x00f3,0x00fb,0x00e2,0x00ea,0x00f2,0x00fa,0x00e1,0x00e9,0x00f1,0x00f9,0x00e0,0x00e8,0x00f0,0x00f8,0x2084,0x2085,0x2086,0x2087,0x2088,0x2089,0x208a,0x208b,0x208c,0x208d,0x208e,0x208f,0x2090,0x2091,0x2092,0x2093,0x2094,0x2095,0x2096,0x2097,0x2098,0x2099,0x209a,0x209b,0x209c,0x209d,0x209e,0x209f,0x20a0,0x20a1,0x20a2,0x20a3,0x20a4,0x20a5,0x20a6,0x20a7,0x20a8,0x20a9,0x20aa,0x20ab,0x20ac,0x20ad,0x20ae,0x20af},
  {0x4020,0x4021,0x4022,0x4023,0x4024,0x4025,0x4026,0x4027,0x8087,0x8187,0x808f,0x818f,0x8086,0x8186,0x808e,0x818e,0x8085,0x8185,0x808d,0x818d,0x8084,0x8184,0x808c,0x818c,0x8083,0x8183,0x808b,0x818b,0x8082,0x8182,0x808a,0x818a,0x8081,0x8181,0x8089,0x8189,0x8080,0x8180,0x8088,0x8188,0x8097,0x8197,0x809f,0x819f,0x8096,0x8196,0x809e,0x819e,0x8095,0x8195,0x809d,0x819d,0x8094,0x8194,0x809c,0x819c,0x8093,0x8193,0x809b,0x819b,0x8092,0x8192,0x809a,0x819a,0x8091,0x8191,0x8099,0x8199,0x8090,0x8190,0x8098,0x8198,0x0107,0x010f,0x0117,0x011f,0x0106,0x010e,0x0116,0x011e,0x0105,0x010d,0x0115,0x011d,0x0104,0x010c,0x0114,0x011c,0x0103,0x010b,0x0113,0x011b,0x0102,0x010a,0x0112,0x011a,0x0101,0x0109,0x0111,0x0119,0x0100,0x0108,0x0110,0x0118,0x0127,0x012f,0x0137,0x013f,0x0126,0x012e,0x0136,0x013e,0x0125,0x012d,0x0135,0x013d,0x0124,0x012c,0x0134,0x013c,0x0123,0x012b,0x0133,0x013b,0x0122,0x012a,0x0132,0x013a,0x0121,0x0129,0x0131,0x0139,0x0120,0x0128,0x0130,0x0138,0x20b0,0x20b1,0x20b2,0x20b3,0x20b4,0x20b5,0x20b6,0x20b7,0x20b8,0x20b9,0x20ba,0x20bb,0x20bc,0x20bd,0x20be,0x20bf,0x20c0,0x20c1,0x20c2,0x20c3,0x20c4,0x20c5,0x20c6,0x20c7,0x20c8,0x20c9,0x20ca,0x20cb,0x20cc,0x20cd,0x20ce,0x20cf,0x20d0,0x20d1,0x20d2,0x20d3,0x20d4,0x20d5,0x20d6,0x20d7,0x20d8,0x20d9,0x20da,0x20db},
  {0x4028,0x4029,0x402a,0x402b,0x402c,0x402d,0x402e,0x402f,0x80a7,0x81a7,0x80af,0x81af,0x80a6,0x81a6,0x80ae,0x81ae,0x80a5,0x81a5,0x80ad,0x81ad,0x80a4,0x81a4,0x80ac,0x81ac,0x80a3,0x81a3,0x80ab,0x81ab,0x80a2,0x81a2,0x80aa,0x81aa,0x80a1,0x81a1,0x80a9,0x81a9,0x80a0,0x81a0,0x80a8,0x81a8,0x80b7,0x81b7,0x80bf,0x81bf,0x80b6,0x81b6,0x80be,0x81be,0x80b5,0x81b5,0x80bd,0x81bd,0x80b4,0x81b4,0x80bc,0x81bc,0x80b3,0x81b3,0x80bb,0x81bb,0x80b2,0x81b2,0x80ba,0x81ba,0x80b1,0x81b1,0x80b9,0x81b9,0x80b0,0x81b0,0x80b8,0x81b8,0x0147,0x014f,0x0157,0x015f,0x0146,0x014e,0x0156,0x015e,0x0145,0x014d,0x0155,0x015d,0x0144,0x014c,0x0154,0x015c,0x0143,0x014b,0x0153,0x015b,0x0142,0x014a,0x0152,0x015a,0x0141,0x0149,0x0151,0x0159,0x0140,0x0148,0x0150,0x0158,0x0167,0x016f,0x0177,0x017f,0x0166,0x016e,0x0176,0x017e,0x0165,0x016d,0x0175,0x017d,0x0164,0x016c,0x0174,0x017c,0x0163,0x016b,0x0173,0x017b,0x0162,0x016a,0x0172,0x017a,0x0161,0x0169,0x0171,0x0179,0x0160,0x0168,0x0170,0x0178,0x20dc,0x20dd,0x20de,0x20df,0x20e0,0x20e1,0x20e2,0x20e3,0x20e4,0x20e5,0x20e6,0x20e7,0x20e8,0x20e9,0x20ea,0x20eb,0x20ec,0x20ed,0x20ee,0x20ef,0x20f0,0x20f1,0x20f2,0x20f3,0x20f4,0x20f5,0x20f6,0x20f7,0x20f8,0x20f9,0x20fa,0x20fb,0x20fc,0x20fd,0x20fe,0x20ff,0x2100,0x2101,0x2102,0x2103,0x2104,0x2105,0x2106,0x2107},
  {0x4030,0x4031,0x4032,0x4033,0x4034,0x4035,0x4036,0x4037,0x80c7,0x81c7,0x80cf,0x81cf,0x80c6,0x81c6,0x80ce,0x81ce,0x80c5,0x81c5,0x80cd,0x81cd,0x80c4,0x81c4,0x80cc,0x81cc,0x80c3,0x81c3,0x80cb,0x81cb,0x80c2,0x81c2,0x80ca,0x81ca,0x80c1,0x81c1,0x80c9,0x81c9,0x80c0,0x81c0,0x80c8,0x81c8,0x80d7,0x81d7,0x80df,0x81df,0x80d6,0x81d6,0x80de,0x81de,0x80d5,0x81d5,0x80dd,0x81dd,0x80d4,0x81d4,0x80dc,0x81dc,0x80d3,0x81d3,0x80db,0x81db,0x80d2,0x81d2,0x80da,0x81da,0x80d1,0x81d1,0x80d9,0x81d9,0x80d0,0x81d0,0x80d8,0x81d8,0x0187,0x018f,0x0197,0x019f,0x0186,0x018e,0x0196,0x019e,0x0185,0x018d,0x0195,0x019d,0x0184,0x018c,0x0194,0x019c,0x0183,0x018b,0x0193,0x019b,0x0182,0x018a,0x0192,0x019a,0x0181,0x0189,0x0191,0x0199,0x0180,0x0188,0x0190,0x0198,0x01a7,0x01af,0x01b7,0x01bf,0x01a6,0x01ae,0x01b6,0x01be,0x01a5,0x01ad,0x01b5,0x01bd,0x01a4,0x01ac,0x01b4,0x01bc,0x01a3,0x01ab,0x01b3,0x01bb,0x01a2,0x01aa,0x01b2,0x01ba,0x01a1,0x01a9,0x01b1,0x01b9,0x01a0,0x01a8,0x01b0,0x01b8,0x2108,0x2109,0x210a,0x210b,0x210c,0x210d,0x210e,0x210f,0x2110,0x2111,0x2112,0x2113,0x2114,0x2115,0x2116,0x2117,0x2118,0x2119,0x211a,0x211b,0x211c,0x211d,0x211e,0x211f,0x2120,0x2121,0x2122,0x2123,0x2124,0x2125,0x2126,0x2127,0x2128,0x2129,0x212a,0x212b,0x212c,0x212d,0x212e,0x212f,0x2130,0x2131,0x2132,0x2133},
  {0x4038,0x4039,0x403a,0x403b,0x403c,0x403d,0x403e,0x403f,0x80e7,0x81e7,0x80ef,0x81ef,0x80e6,0x81e6,0x80ee,0x81ee,0x80e5,0x81e5,0x80ed,0x81ed,0x80e4,0x81e4,0x80ec,0x81ec,0x80e3,0x81e3,0x80eb,0x81eb,0x80e2,0x81e2,0x80ea,0x81ea,0x80e1,0x81e1,0x80e9,0x81e9,0x80e0,0x81e0,0x80e8,0x81e8,0x80f7,0x81f7,0x80ff,0x81ff,0x80f6,0x81f6,0x80fe,0x81fe,0x80f5,0x81f5,0x80fd,0x81fd,0x80f4,0x81f4,0x80fc,0x81fc,0x80f3,0x81f3,0x80fb,0x81fb,0x80f2,0x81f2,0x80fa,0x81fa,0x80f1,0x81f1,0x80f9,0x81f9,0x80f0,0x81f0,0x80f8,0x81f8,0x01c7,0x01cf,0x01d7,0x01df,0x01c6,0x01ce,0x01d6,0x01de,0x01c5,0x01cd,0x01d5,0x01dd,0x01c4,0x01cc,0x01d4,0x01dc,0x01c3,0x01cb,0x01d3,0x01db,0x01c2,0x01ca,0x01d2,0x01da,0x01c1,0x01c9,0x01d1,0x01d9,0x01c0,0x01c8,0x01d0,0x01d8,0x01e7,0x01ef,0x01f7,0x01ff,0x01e6,0x01ee,0x01f6,0x01fe,0x01e5,0x01ed,0x01f5,0x01fd,0x01e4,0x01ec,0x01f4,0x01fc,0x01e3,0x01eb,0x01f3,0x01fb,0x01e2,0x01ea,0x01f2,0x01fa,0x01e1,0x01e9,0x01f1,0x01f9,0x01e0,0x01e8,0x01f0,0x01f8,0x2134,0x2135,0x2136,0x2137,0x2138,0x2139,0x213a,0x213b,0x213c,0x213d,0x213e,0x213f,0x2140,0x2141,0x2142,0x2143,0x2144,0x2145,0x2146,0x2147,0x2148,0x2149,0x214a,0x214b,0x214c,0x214d,0x214e,0x214f,0x2150,0x2151,0x2152,0x2153,0x2154,0x2155,0x2156,0x2157,0x2158,0x2159,0x215a,0x215b,0x215c,0x215d,0x215e,0x215f},
};
constexpr int NQ_UNITS = 180;
constexpr size_t WS_DIFFO = 224 * MiB;
constexpr size_t WS_END2 = 256 * MiB;
constexpr int CW_QHEAD = 32768;
constexpr int CW_DIFF = 65536;
static_assert((CW_DIFF + 256 * 64) * 4 <= (int)CTL_ZERO_BYTES, "counters inside the zeroed control region");
static_assert(ab::ATTN_LDS_BYTES <= RING_BYTES, "attention LDS fits the ring region");
__device__ __forceinline__ void diff_combine(const bf16_t* DIFFO, bf16_t* ATT, const float* subw, float lam, int b, int h, int qb, int wid, int lane_) {
    int lane = lane_; asm volatile("" : "+v"(lane));
    const int row = b * SEQ + 256 * qb + 32 * wid + (lane >> 1), hf = lane & 1;
    gu64* s1 = (gu64*)(DIFFO + (size_t)row * 1024 + h * 256 + hf * 64);
    gu64* s2 = (gu64*)(DIFFO + (size_t)row * 1024 + h * 256 + 128 + hf * 64);
    f32x4 v[16]; float ss = 0.f;
#pragma unroll
    for (int q = 0; q < 8; ++q) { const unsigned long long a01 = __hip_atomic_load(s1 + 2 * q, RLX_AGENT), a23 = __hip_atomic_load(s1 + 2 * q + 1, RLX_AGENT), c01 = __hip_atomic_load(s2 + 2 * q, RLX_AGENT), c23 = __hip_atomic_load(s2 + 2 * q + 1, RLX_AGENT);
        const v4u a = {(unsigned)a01, (unsigned)(a01 >> 32), (unsigned)a23, (unsigned)(a23 >> 32)}, c = {(unsigned)c01, (unsigned)(c01 >> 32), (unsigned)c23, (unsigned)(c23 >> 32)};
        const f32x4 a0 = {__uint_as_float(a.x << 16), __uint_as_float(a.x & 0xffff0000u), __uint_as_float(a.y << 16), __uint_as_float(a.y & 0xffff0000u)};
        const f32x4 a1 = {__uint_as_float(a.z << 16), __uint_as_float(a.z & 0xffff0000u), __uint_as_float(a.w << 16), __uint_as_float(a.w & 0xffff0000u)};
        const f32x4 c0 = {__uint_as_float(c.x << 16), __uint_as_float(c.x & 0xffff0000u), __uint_as_float(c.y << 16), __uint_as_float(c.y & 0xffff0000u)};
        const f32x4 c1 = {__uint_as_float(c.z << 16), __uint_as_float(c.z & 0xffff0000u), __uint_as_float(c.w << 16), __uint_as_float(c.w & 0xffff0000u)};
        v[2 * q] = a0 - c0 * lam; v[2 * q + 1] = a1 - c1 * lam;
        ss += ((v[2 * q].x * v[2 * q].x + v[2 * q].y * v[2 * q].y) + (v[2 * q].z * v[2 * q].z + v[2 * q].w * v[2 * q].w)) + ((v[2 * q + 1].x * v[2 * q + 1].x + v[2 * q + 1].y * v[2 * q + 1].y) + (v[2 * q + 1].z * v[2 * q + 1].z + v[2 * q + 1].w * v[2 * q + 1].w)); }
    ss += __shfl_xor(ss, 1);
    const float rstd = rsqrtf(ss * (1.f / 128.f) + EPS) * 0.8f;
    GAS v4u* dst = (GAS v4u*)(ATT + (size_t)row * DM + h * 128 + hf * 64);
    const GAS f32x4* sw = (const GAS f32x4*)(subw + hf * 64);
#pragma unroll
    for (int q = 0; q < 8; ++q) { const f32x4 g0 = sw[2 * q] * rstd, g1 = sw[2 * q + 1] * rstd; const f32x4 o0 = v[2 * q] * g0, o1 = v[2 * q + 1] * g1;
        dst[q] = (v4u){pk2(o0.x, o0.y), pk2(o0.z, o0.w), pk2(o1.x, o1.y), pk2(o1.z, o1.w)}; }
}
#if PROBE_K >= 200
#define ACC_T0() unsigned long long acc_t0_ = __builtin_amdgcn_s_memrealtime()
#define ACC_ADD(cat) do { if (F.tid == 0) { const unsigned long long t1_ = __builtin_amdgcn_s_memrealtime(); F.MISC[40 + (cat)] += (unsigned)(t1_ - acc_t0_); } acc_t0_ = __builtin_amdgcn_s_memrealtime(); } while (0)
#else
#define ACC_T0() do {} while (0)
#define ACC_ADD(cat) do {} while (0)
#endif
__device__ __forceinline__ void attn_phase(Frame& F, char* shm, gu32* ctl, const bf16_t* PROJ, const float* CUMB, bf16_t* ATT, bf16_t* DIFFO, const float* subw, const float* lq1, const float* lk1, const float* lq2, const float* lk2,
                                           const bf16_t* HM, const bf16_t* WKV, bf16_t* MKN, bf16_t* VT, const float* mkw, const float* mqw) {
    const float s1 = wave_sum(lq1[F.lane] * lk1[F.lane]), s2 = wave_sum(lq2[F.lane] * lk2[F.lane]);
    const float lam = __uint_as_float(__builtin_amdgcn_readfirstlane(__float_as_uint(__expf(s1) - __expf(s2) + 0.2f)));
    const int xq = (int)blockIdx.x & 7;
    ACC_T0();
    for (;;) {
        if (F.tid == 0) F.MISC[13] = __hip_atomic_fetch_add((unsigned*)(ctl + CW_QHEAD + 64 * xq), 1u, __ATOMIC_RELAXED, __HIP_MEMORY_SCOPE_AGENT);
        __syncthreads();
        const unsigned qi = F.MISC[13];
        __syncthreads();
        if (qi >= (unsigned)NQ_UNITS) break;
        ACC_ADD(5);
        const unsigned u = UNIT_Q[xq][qi];
        const int qb = u & 7;
        if (u & 0x2000u) {
            LAS float* scr = (LAS float*)(F.lds + RING_OFF + F.wave * 16384);
            const unsigned char* ka_ = (const unsigned char*)__builtin_amdgcn_kernarg_segment_ptr(); asm volatile("" : "+s"(ka_));
            const Args* ap_ = (const Args*)ka_; const Ptrs P = make_ptrs(ap_->in, ap_->out, ap_->ws);
            const int it0 = (int)(u & 511) * 16 + F.wave * 2;
            int ln_ = F.lane; asm volatile("" : "+v"(ln_));
#pragma unroll 1
            for (int it = it0; it < it0 + 2; ++it) {
                int r = it;
                if (r < 512) { p0_transpose_item<false>(P.w_out, DM, DM, DM, nullptr, P.WOUT, scr, r, ln_); continue; } r -= 512;
                if (r < 512) { p0_transpose_item<false>(P.w_mq, DM, DM, DM, P.nmq, P.WQ, scr, r, ln_); continue; } r -= 512;
                if (r < 512) { p0_transpose_item<false>(P.w_mo, DM, DM, DM, nullptr, P.WO, scr, r, ln_); continue; } r -= 512;
                if (r < 2048) { p0_transpose_item<false>(P.w_up, DFF, DM, DFF, P.nmlp, P.WUP, scr, r, ln_); continue; } r -= 2048;
                p0_transpose_item<false>(P.w_dn, DM, DFF, DM, nullptr, P.WDN, scr, r, ln_);
            }
            __syncthreads(); ACC_ADD(4);
        } else if (u & 0x4000u) {
            const int idx = u & 63;
            if (idx < 32) {
                pg8::Gemm g{HM, WKV, DM, DM, DM}; const Sched S = sched_one(idx >> 2, idx & 3, true);
                pg8::EpiHeadNormK E{MKN, mkw, mqw};
                pg8::gemm_phase<pg8::EpiHeadNormK, Sched, false, true>(F.lds + RING_OFF, g, S, E);
            } else {
                pg8::Gemm g{WKV + (size_t)1024 * DM, HM, DM, DM, DM}; const Sched S = sched_one((idx - 32) >> 3, (idx - 32) & 7, true);
                pg8::EpiStore<0> E{VT, MMEM, nullptr};
                pg8::gemm_phase<pg8::EpiStore<0>, Sched, true, true>(F.lds + RING_OFF, g, S, E);
            }
            __syncthreads(); ACC_ADD(3);
        } else if (u & 0x8000u) {
            const int bh = (u >> 3) & 31, mp = (u >> 8) & 1, b = bh >> 2, h = bh & 3;
            const ab::bf16* base = (const ab::bf16*)PROJ + (size_t)b * SEQ * NPROJ;
#pragma unroll 1
            for (int hf = 0; hf < 2; ++hf)
                ab::attn_unit<8, 1, false, true>(qb, base + C_DQ + 128 * h + 64 * mp, base + C_DK + 128 * h + 64 * mp, base + C_DV + 128 * h + 64 * hf,
                                           (ab::bf16*)DIFFO + (size_t)b * SEQ * 1024 + h * 256 + (mp * 2 + hf) * 64, 1024, nullptr, shm);
            ACC_ADD(1);
            VM_WAIT(); __syncthreads();
            if (F.tid == 0) {
                const unsigned old = __hip_atomic_fetch_add((unsigned*)(ctl + CW_DIFF + 64 * (bh * 8 + qb)), 1u, __ATOMIC_RELAXED, __HIP_MEMORY_SCOPE_AGENT);
                F.MISC[12] = old; }
            __syncthreads();
            if (F.MISC[12] == 1u) diff_combine(DIFFO, ATT, subw, lam, b, h, qb, F.wave, F.lane);
            __syncthreads(); ACC_ADD(2);
        } else {
            const int bh = (u >> 3) & 63, b = bh >> 3, h = bh & 7;
            const ab::bf16* base = (const ab::bf16*)PROJ + (size_t)b * SEQ * NPROJ;
            ab::attn_unit<8, 0, true, false>(qb, base + C_FQ + 64 * h, base + C_FK + 64 * h, base + C_FV + 64 * h, (ab::bf16*)ATT + (size_t)b * SEQ * DM + 512 + 64 * h, DM, CUMB + (size_t)bh * SEQ, shm);
            ACC_ADD(0);
        }
    }
}
#ifndef REP3
#define REP3 1
#endif
#define ATTN_PHASE_HOOK if (IN(3)) { PP; for (int rep_ = 0; rep_ < REP3; ++rep_) attn_phase(F, (char*)lds + RING_OFF, F.ctl, P.PROJ, P.CUMB, P.ATT, (bf16_t*)(args.ws + WS_DIFFO), P.subw, P.lq1, P.lk1, P.lq2, P.lk2, P.HM, P.WKV, P.MKN, P.VT, P.mkw, P.mqw); }
#ifndef PROBE_K
#define PROBE_K -1
#endif
#ifndef PROBE_MULT
#define PROBE_MULT 4
#endif
#define STAMP(i) do { if (PROBE_K >= 0 && F.tid == 0) { const unsigned long long t_ = __builtin_amdgcn_s_memrealtime(); F.MISC[16 + 2 * (i)] = (unsigned)t_; F.MISC[17 + 2 * (i)] = (unsigned)(t_ >> 32); } } while (0)
#ifndef REP0
#define REP0 1
#endif
#ifndef REP1
#define REP1 1
#endif
#ifndef REP2
#define REP2 1
#endif
#ifndef REP3
#define REP3 1
#endif
#ifndef REP4
#define REP4 1
#endif
#ifndef REP5
#define REP5 1
#endif
#ifndef REP6
#define REP6 1
#endif
#ifndef REP7
#define REP7 1
#endif
#ifndef REP8
#define REP8 1
#endif
constexpr int NPHASE = 9;

__global__ void __launch_bounds__(NWAVES * 64, 2) mega_fwd(Args args) {
    extern __shared__ __attribute__((aligned(16))) unsigned char lds[];
    Frame F;
    F.lds = (LAS unsigned char*)lds; F.MISC = (volatile LAS unsigned*)(F.lds + MISC_OFF);
    F.tid = threadIdx.x; F.lane = F.tid & 63; F.wave = __builtin_amdgcn_readfirstlane(F.tid >> 6);
    F.G = gridDim.x; { const int bx = blockIdx.x; F.vcu = (F.G % 8 == 0) ? (bx % 8) * (F.G / 8) + bx / 8 : bx; }
    F.ctl = (gu32*)(args.ws + WS_CTL);
    for (int u = F.tid; u < (LDS_BYTES - LDSCTL_OFF) / 4; u += NWAVES * 64) ((LAS unsigned*)(F.lds + LDSCTL_OFF))[u] = 0u;
    __syncthreads();
    XcdBarrier bar = xcd_barrier_post((unsigned*)(F.ctl + CW_BAR) + args.ph_lo * XCD_BAR_WORDS, F.MISC + 8);
    const int lo = args.ph_lo, hi = args.ph_hi;
#define IN(k) (lo <= (k) && (k) < hi)
#define PP const Ptrs P = make_ptrs(args.in, args.out, args.ws)
#define SEAM(k) do { if (IN(k) && IN((k) + 1)) xcd_barrier(bar); } while (0)
#define SEAM2(k) do { if (IN(k) && IN((k) + 2)) xcd_barrier(bar); } while (0)
    const int bx = (int)blockIdx.x;
    STAMP(0);

    if (IN(0)) { PP; for (int rep_ = 0; rep_ < REP0; ++rep_) p0_prologue(F, P); } SEAM(0); STAMP(1);

    if (IN(1)) {
        PP; for (int rep_ = 0; rep_ < REP1; ++rep_) {
        pg8::Gemm g{P.XB, P.WIN, DM, DM, DM}; const Sched S = sched_static(MTOK, NPROJ, F.G, bx);
        if (bx < 64) p1b_cumsum_wg(P.FLOG, P.b_forget, P.CUMB, bx, F.tid, (LAS float*)(F.lds + LDS_RQ));
        pg8::EpiProj E{P.PROJ, P.QKW, P.ROPE};
        pg8::gemm_phase<pg8::EpiProj, Sched, true, true>(F.lds + RING_OFF, g, S, E);
    }} SEAM2(1); STAMP(2);


    ATTN_PHASE_HOOK
    if (PROBE_K >= 300 && F.tid == 0) { __hip_atomic_fetch_add((unsigned*)(F.ctl + 3000), F.MISC[40 + (PROBE_K >= 300 ? PROBE_K - 300 : 0)], __ATOMIC_RELAXED, __HIP_MEMORY_SCOPE_AGENT); }
    STAMP(9); SEAM(3); STAMP(3);
    if (PROBE_K >= 300 && F.tid == 0) { F.MISC[39] = __hip_atomic_load((unsigned*)(F.ctl + 3000), __ATOMIC_RELAXED, __HIP_MEMORY_SCOPE_AGENT) / 256u; }

    if (IN(4)) {
        PP; for (int rep_ = 0; rep_ < REP4; ++rep_) {
        pg8::Gemm g{P.ATT, P.WOUT, DM, DM, DM}; const Sched S = sched_static(MTOK, DM, F.G, bx);
        pg8::EpiResid<0> E{P.RS0, P.XB, nullptr, P.SS};
        pg8::gemm_phase<pg8::EpiResid<0>, Sched, false, true>(F.lds + RING_OFF, g, S, E);
    }} SEAM(4); STAMP(4);

    if (IN(5)) {
        PP; for (int rep_ = 0; rep_ < REP5; ++rep_) {
        const Sched S0 = sched_static(MTOK, DM, F.G, bx); pg8::Unit u{0, 0}; const bool has = S0.next(0, u);
        PG8_LAS float* RQ = (PG8_LAS float*)(F.lds + LDS_RQ); PG8_LAS float* IL = (PG8_LAS float*)(F.lds + LDS_IL);
        {   pg8::Gemm g{P.XB, P.WQ, DM, DM, DM}; const Sched S = sched_one(u.pm, u.pn, has);
            pg8::EpiMemQ E{P.MQ, P.SS, RQ};
            pg8::gemm_phase<pg8::EpiMemQ, Sched, false, true>(F.lds + RING_OFF, g, S, E); }
        VM_WAIT(); __syncthreads(); if (F.tid == 0) { __builtin_amdgcn_fence(__ATOMIC_ACQUIRE, "agent"); VM_WAIT(); } __syncthreads();
        const int head = u.pn, bh = (u.pm >> 3) * 4 + head;
        {   pg8::Gemm g{P.MQ + head * 256, P.MKN + (size_t)bh * 65536, DM, 256, 256}; const Sched S = sched_one(u.pm, 0, has);
            pg8::EpiMemS E{P.MQ, head, RQ, IL};
            pg8::gemm_phase<pg8::EpiMemS, Sched, false, true>(F.lds + RING_OFF, g, S, E); }
        VM_WAIT(); __syncthreads(); if (F.tid == 0) { __builtin_amdgcn_fence(__ATOMIC_ACQUIRE, "agent"); VM_WAIT(); } __syncthreads();
        {   pg8::Gemm g{P.MQ + head * 256, P.VT + (size_t)(head * 256) * MMEM + (u.pm >> 3) * 256, DM, MMEM, 256}; const Sched S = sched_one(u.pm, 0, has);
            pg8::EpiMemPV E{P.MO, head, IL};
            pg8::gemm_phase<pg8::EpiMemPV, Sched, true, true>(F.lds + RING_OFF, g, S, E); }
    }} SEAM(5); STAMP(5);

    if (IN(6)) {
        PP; for (int rep_ = 0; rep_ < REP6; ++rep_) {
        pg8::Gemm g{P.MO, P.WO, DM, DM, DM}; const Sched S = sched_static(MTOK, DM, F.G, bx);
        pg8::EpiResid<1> E{nullptr, P.XB, nullptr, P.SS};
        pg8::gemm_phase<pg8::EpiResid<1>, Sched, false, true>(F.lds + RING_OFF, g, S, E);
    }} SEAM(6); STAMP(6);

    if (IN(7)) {
        PP; for (int rep_ = 0; rep_ < REP7; ++rep_) {
        pg8::Gemm g{P.XB, P.WUP, DM, DM, DM}; const Sched S = sched_static(MTOK, DFF, F.G, bx);
        pg8::EpiStore<3> E{P.H, DFF, P.SS};
        pg8::gemm_phase<pg8::EpiStore<3>, Sched, true, true>(F.lds + RING_OFF, g, S, E);
    }} SEAM(7); STAMP(7);

    if (IN(8)) {
        PP; for (int rep_ = 0; rep_ < REP8; ++rep_) {
        pg8::Gemm g{P.H, P.WDN, DFF, DFF, DFF}; const Sched S = sched_static(MTOK, DM, F.G, bx);
        pg8::EpiResid<2> E{nullptr, P.XB, P.out, nullptr};
        pg8::gemm_phase<pg8::EpiResid<2>, Sched, false, true>(F.lds + RING_OFF, g, S, E);
    }}
    STAMP(8);
    if (PROBE_K >= 0 && F.tid == 0) {
        constexpr int IA_ = PROBE_K == 100 ? 9 : (PROBE_K >= 200 ? 0 : PROBE_K), IB_ = PROBE_K == 100 ? 3 : (PROBE_K >= 200 ? 1 : PROBE_K + 1);
        const unsigned long long a_ = ((unsigned long long)F.MISC[17 + 2 * IA_] << 32) | F.MISC[16 + 2 * IA_], b_ = ((unsigned long long)F.MISC[17 + 2 * IB_] << 32) | F.MISC[16 + 2 * IB_];
        unsigned long long w_ = (b_ - a_) * PROBE_MULT; if (PROBE_K >= 200 && PROBE_K < 300) w_ = (unsigned long long)F.MISC[40 + (PROBE_K >= 200 && PROBE_K < 300 ? PROBE_K - 200 : 0)] * PROBE_MULT; if (PROBE_K >= 300) w_ = (unsigned long long)F.MISC[39] * PROBE_MULT;
        const unsigned long long t0_ = __builtin_amdgcn_s_memrealtime();
        while (__builtin_amdgcn_s_memrealtime() - t0_ < w_) __builtin_amdgcn_s_sleep(8);
    }
#undef IN
#undef SEAM
#undef SEAM2
}
extern "C" void kernel_launch(void* const* d_in, const int* in_sizes, int n_in, void* d_out, int out_size, void* d_ws, size_t ws_size, hipStream_t stream) {
    static int grid = 0;
    if (grid == 0) {
        if (n_in != 26 || in_sizes[0] != MTOK * DM || out_size != MTOK * DM || ws_size < WS_END2) { fprintf(stderr, "kernel_launch: unexpected shapes (n_in %d, in0 %d, out %d, ws %zu)\n", n_in, n_in > 0 ? in_sizes[0] : -1, out_size, ws_size); grid = -1; return; }
        int dev = 0, cus = 0, per_cu = 0;
        if (hipGetDevice(&dev) != hipSuccess || hipDeviceGetAttribute(&cus, hipDeviceAttributeMultiprocessorCount, dev) != hipSuccess) { grid = -1; return; }
        if (hipFuncSetAttribute((const void*)mega_fwd, hipFuncAttributeMaxDynamicSharedMemorySize, LDS_BYTES) != hipSuccess) { fprintf(stderr, "kernel_launch: hipFuncSetAttribute failed\n"); grid = -1; return; }
        if (hipOccupancyMaxActiveBlocksPerMultiprocessor(&per_cu, (const void*)mega_fwd, NWAVES * 64, LDS_BYTES) != hipSuccess || per_cu < 1) { fprintf(stderr, "kernel_launch: occupancy query says %d blocks per CU\n", per_cu); (void)hipGetLastError(); grid = -1; return; }
        grid = cus;
        if (grid != 256) fprintf(stderr, "kernel_launch: %d CUs; the one-unit-per-workgroup phases assume 256\n", grid);
    }
    if (grid < 0) return;
    (void)hipMemsetAsync((char*)d_ws + WS_CTL, 0, CTL_ZERO_BYTES, stream);
    Args a{};
    for (int i = 0; i < 26; ++i) a.in[i] = d_in[i];
    a.out = (float*)d_out; a.ws = (unsigned char*)d_ws;
#if MK_HYBRID
    const Ptrs P = make_ptrs(a.in, a.out, a.ws);
    a.ph_lo = 0; a.ph_hi = 3; hipLaunchKernelGGL(mega_fwd, dim3(grid), dim3(NWAVES * 64), LDS_BYTES, stream, a);
    float* OF = a.out;
    hipLaunchKernelGGL(k_attn, dim3(MTOK / 64, 8), dim3(64), 0, stream, P.PROJ, P.CUMB, 1, OF, 8);
    hipLaunchKernelGGL(k_fox_fin, dim3(MTOK * 512 / 256), dim3(256), 0, stream, OF, P.ATT);
    hipLaunchKernelGGL(k_attn, dim3(MTOK / 64, 16), dim3(64), 0, stream, P.PROJ, P.CUMB, 0, OF, 16);
    hipLaunchKernelGGL(k_diff_fin, dim3(MTOK), dim3(256), 0, stream, OF, P.lq1, P.lk1, P.lq2, P.lk2, P.subw, P.ATT);
    a.ph_lo = 4; a.ph_hi = 9; hipLaunchKernelGGL(mega_fwd, dim3(grid), dim3(NWAVES * 64), LDS_BYTES, stream, a);
#else
    a.ph_lo = 0; a.ph_hi = NPHASE; hipLaunchKernelGGL(mega_fwd, dim3(grid), dim3(NWAVES * 64), LDS_BYTES, stream, a);
#endif
}
```

```cpp
#include <hip/hip_runtime.h>
#include <cstdint>
#include <cstdio>

typedef unsigned short bf16_t;
__device__ __forceinline__ float bf2f(bf16_t v) { return __uint_as_float(((unsigned)v) << 16); }
__device__ __forceinline__ bf16_t f2bf(float f) { unsigned u = __float_as_uint(f); return (bf16_t)((u + 0x7fffu + ((u >> 16) & 1u)) >> 16); }

constexpr int NB = 8, SEQ = 2048, DM = 1024, MTOK = NB * SEQ, MEML = 256, MMEM = NB * MEML;
constexpr int NPROJ = 3072, INCOLS = 3080, DFF = 4096;
constexpr float EPS = 1e-6f;
constexpr float LOG2E = 1.4426950408889634f;
constexpr float C2 = 0.125f * LOG2E;
constexpr float CM = 0.0625f * LOG2E;
constexpr int C_DQ = 0, C_DK = 512, C_DV = 1024, C_FQ = 1536, C_FK = 2048, C_FV = 2560;

constexpr size_t MiB = 1u << 20;
constexpr size_t WS_CTL = 0, CTL_ZERO_BYTES = 112 * 1024;
constexpr size_t WS_FLOG = 1 * MiB;
constexpr size_t WS_CUMB = 2 * MiB;
constexpr size_t WS_ROPE = 3 * MiB;
constexpr size_t WS_RS0 = 4 * MiB + 256 * 1024;
constexpr size_t WS_QKW = 4 * MiB + 512 * 1024;
constexpr size_t WS_SS = 4 * MiB;
constexpr size_t WS_WIN = 8 * MiB, WS_WOUT = 14 * MiB, WS_WQ = 16 * MiB, WS_WKV = 18 * MiB, WS_WO = 22 * MiB, WS_WUP = 24 * MiB, WS_WDN = 32 * MiB;
constexpr size_t WS_XB = 40 * MiB;
constexpr size_t WS_HM = 72 * MiB;
constexpr size_t WS_MK = 76 * MiB;
constexpr size_t WS_VT = 80 * MiB;
constexpr size_t WS_MKN = 84 * MiB;
constexpr size_t WS_PROJ = 96 * MiB;
constexpr size_t WS_ATT = 192 * MiB;
constexpr size_t WS_MQ = 96 * MiB;
constexpr size_t WS_MO = 128 * MiB;
constexpr size_t WS_H = 96 * MiB;
constexpr size_t WS_END = 224 * MiB;
#define MK_HYBRID 0
namespace pg8 {
#define PG8_LAS __attribute__((address_space(3)))
typedef short bf16x8 __attribute__((ext_vector_type(8)));
typedef float f32x4 __attribute__((ext_vector_type(4)));
typedef unsigned u32x4 __attribute__((ext_vector_type(4)));
typedef unsigned u32x2 __attribute__((ext_vector_type(2)));
constexpr int BM = 256, BK = 64, HALF = 128, HTB = HALF * BK * 2  , STAGE_BYTES = 8 * HTB, NXCD = 8, WGM = 8;

__host__ __device__ __forceinline__ int lds_byte(int r, int c) { const int st = (r >> 4) * 2 + (c >> 5), rr = r & 15, cc = c & 31, ob = rr * 64 + cc * 2; return st * 1024 + (ob ^ (((ob >> 9) & 1) << 5)); }
__host__ __device__ __forceinline__ void stage_rc(int b, int& R, int& C) { const int st = b / 1024, sb = b % 1024, swz = sb ^ (((sb >> 9) & 1) << 5); R = (st >> 1) * 16 + swz / 64; C = (st & 1) * 32 + (swz % 64) / 2; }
__host__ __device__ __forceinline__ int perm32(int rho) { const int n = rho >> 4, i = rho & 15; return 8 * (i >> 2) + 4 * n + (i & 3); }

struct Unit { int pm, pn; };
struct Gemm { const bf16_t* A; const bf16_t* Bt; int lda, ldb, K; };

struct StaticOrder {
    int nM, nN, nwg, G, c;
    __host__ __device__ void init(int M, int N, int G_, int c_) { nM = M / BM; nN = N / BM; nwg = nM * nN; G = G_; c = c_; }
    __host__ __device__ bool next(int i, Unit& u) const {
        const long L = (long)i * G + c; if (L >= nwg) return false;
        int wgid = (int)L; { const int q = nwg / NXCD, r = nwg % NXCD, xcd = wgid % NXCD, off = wgid / NXCD; wgid = (xcd < r ? xcd * (q + 1) : r * (q + 1) + (xcd - r) * q) + off; }
        const int nig = WGM * nN, gid = wgid / nig, fm = gid * WGM, gsz = (nM - fm) < WGM ? (nM - fm) : WGM;
        u.pm = fm + ((wgid % nig) % gsz); u.pn = (wgid % nig) / gsz; return true;
    }
    __device__ __forceinline__ void a_ready(const Unit&) const {}
    __device__ __forceinline__ void done(const Unit&) const {}
};
struct OneUnit {
    int pm, pn; bool has;
    __device__ __forceinline__ bool next(int i, Unit& u) const { if (i != 0 || !has) return false; u.pm = pm; u.pn = pn; return true; }
    __device__ __forceinline__ void a_ready(const Unit&) const {}
    __device__ __forceinline__ void done(const Unit&) const {}
};

__device__ __forceinline__ unsigned cvt_pk_bf16(float lo, float hi) { unsigned r; asm volatile("v_cvt_pk_bf16_f32 %0, %1, %2" : "=v"(r) : "v"(lo), "v"(hi)); return r; }
#define PG8_LBAR() do { asm volatile("s_waitcnt lgkmcnt(0)" ::: "memory"); __builtin_amdgcn_s_barrier(); asm volatile("" ::: "memory"); } while (0)

template <int MODE> struct EpiStore {
    static constexpr bool PERM = true, AFTER_DRAIN = false;
    bf16_t* O; int ldc; const float* SS;
    __device__ __forceinline__ void operator()(const f32x4 (&acc)[2][2][4][2], const Unit& u, int wr, int wc, int fr, int fq) const {
        const int row0 = u.pm * BM + wr * 64 + fr, col0 = u.pn * BM + wc * 32 + 8 * fq;
#pragma unroll
        for (int ai = 0; ai < 2; ++ai)
#pragma unroll
            for (int m = 0; m < 4; ++m) { const int row = row0 + ai * HALF + m * 16; float rs = 1.f;
                if (MODE != 0) { const f32x4 s = *(const f32x4*)(SS + (size_t)row * 4); rs = rsqrtf(((s[0] + s[1]) + (s[2] + s[3])) * (1.f / DM) + EPS); }
                bf16_t* rowp = O + (size_t)row * ldc + col0;
#pragma unroll
                for (int bj = 0; bj < 2; ++bj) { f32x4 v0 = acc[ai][bj][m][0] * rs, v1 = acc[ai][bj][m][1] * rs;
                    if (MODE == 3) {
#pragma unroll
                        for (int e = 0; e < 4; ++e) { const float a = fmaxf(v0[e], 0.f), b = fmaxf(v1[e], 0.f); v0[e] = a * a; v1[e] = b * b; } }
                    u32x4 w; w.x = cvt_pk_bf16(v0[0], v0[1]); w.y = cvt_pk_bf16(v0[2], v0[3]); w.z = cvt_pk_bf16(v1[0], v1[1]); w.w = cvt_pk_bf16(v1[2], v1[3]);
                    *(u32x4*)(rowp + bj * HALF) = w; } }
    }
};
struct EpiProj {
    static constexpr bool PERM = true, AFTER_DRAIN = false;
    bf16_t* O; const float* QKW; const float* ROPE;
    __device__ __forceinline__ void operator()(const f32x4 (&acc)[2][2][4][2], const Unit& u, int wr, int wc, int fr, int fq) const {
        const int sec = u.pn >> 1, row0 = u.pm * BM + wr * 64 + fr, col0 = u.pn * BM + wc * 64 + 8 * fq;
        if (sec == 2 || sec == 5) {
#pragma unroll
            for (int ai = 0; ai < 2; ++ai)
#pragma unroll
                for (int m = 0; m < 4; ++m) { bf16_t* rowp = O + (size_t)(row0 + ai * HALF + m * 16) * NPROJ + col0;
#pragma unroll
                    for (int bj = 0; bj < 2; ++bj) { const f32x4 v0 = acc[ai][bj][m][0], v1 = acc[ai][bj][m][1];
                        u32x4 w; w.x = cvt_pk_bf16(v0[0], v0[1]); w.y = cvt_pk_bf16(v0[2], v0[3]); w.z = cvt_pk_bf16(v1[0], v1[1]); w.w = cvt_pk_bf16(v1[2], v1[3]);
                        *(u32x4*)(rowp + bj * 32) = w; } }
            return;
        }
        const float* w = QKW + 64 * (sec < 2 ? sec : sec - 1);
        const float sc = (sec == 0 || sec == 3) ? C2 : 1.f; const bool rope = sec < 2;
        f32x4 g[2][2];
#pragma unroll
        for (int bj = 0; bj < 2; ++bj)
#pragma unroll
            for (int n = 0; n < 2; ++n) g[bj][n] = *(const f32x4*)(w + 32 * bj + 8 * fq + 4 * n);
        const float sgn = fq == 0 ? -1.f : 1.f; const bool rl = fq < 2;
#pragma unroll
        for (int ai = 0; ai < 2; ++ai)
#pragma unroll
            for (int m = 0; m < 4; ++m) { const int row = row0 + ai * HALF + m * 16; float ss = 0.f;
#pragma unroll
                for (int bj = 0; bj < 2; ++bj)
#pragma unroll
                    for (int n = 0; n < 2; ++n) { const f32x4 a = acc[ai][bj][m][n]; ss += (a[0] * a[0] + a[1] * a[1]) + (a[2] * a[2] + a[3] * a[3]); }
                ss += __shfl_xor(ss, 16); ss += __shfl_xor(ss, 32);
                const float rstd = rsqrtf(ss * (1.f / 64.f) + EPS) * sc;
                f32x4 v[2][2];
#pragma unroll
                for (int bj = 0; bj < 2; ++bj)
#pragma unroll
                    for (int n = 0; n < 2; ++n) v[bj][n] = acc[ai][bj][m][n] * rstd * g[bj][n];
                if (rope) {
#pragma unroll
                    for (int n = 0; n < 2; ++n) { f32x4 pr;
#pragma unroll
                        for (int e = 0; e < 4; ++e) pr[e] = __shfl_xor(v[0][n][e], 16);
                        const f32x4 c = *(const f32x4*)(ROPE + (size_t)row * 16 + 4 * n), s = *(const f32x4*)(ROPE + (size_t)row * 16 + 8 + 4 * n);
                        const f32x4 r = v[0][n] * c + pr * s * sgn;
                        if (rl) v[0][n] = r; }
                }
                bf16_t* rowp = O + (size_t)row * NPROJ + col0;
#pragma unroll
                for (int bj = 0; bj < 2; ++bj) { u32x4 wv; wv.x = cvt_pk_bf16(v[bj][0][0], v[bj][0][1]); wv.y = cvt_pk_bf16(v[bj][0][2], v[bj][0][3]); wv.z = cvt_pk_bf16(v[bj][1][0], v[bj][1][1]); wv.w = cvt_pk_bf16(v[bj][1][2], v[bj][1][3]);
                    *(u32x4*)(rowp + bj * 32) = wv; } }
    }
};
template <int MODE> struct EpiResid {
    static constexpr bool PERM = true, AFTER_DRAIN = true;
    const float* xf; bf16_t* xb; float* outf; float* SS;
    __device__ __forceinline__ void fused(f32x4 (&acc)[2][2][4][2], const Unit& u, int wr, int wc, int fr, int fq, PG8_LAS unsigned char* lds, int wid, int lane) const {
        PG8_LAS float* P = (PG8_LAS float*)lds;
        const int col0 = u.pn * BM + wc * 32 + 8 * fq;
#pragma unroll
        for (int ai = 0; ai < 2; ++ai)
#pragma unroll
            for (int m = 0; m < 4; ++m) { const int r = ai * HALF + wr * 64 + m * 16 + fr; const size_t off = (size_t)(u.pm * BM + r) * DM + col0; float s = 0.f;
                const float rsc = MODE == 0 ? xf[u.pm * BM + r] : 1.f;
#pragma unroll
                for (int bj = 0; bj < 2; ++bj) { f32x4 b0, b1;
                    { const u32x4 w = *(const u32x4*)(xb + off + bj * HALF);
                        b0 = (f32x4){__uint_as_float(w.x << 16), __uint_as_float(w.x & 0xffff0000u), __uint_as_float(w.y << 16), __uint_as_float(w.y & 0xffff0000u)};
                        b1 = (f32x4){__uint_as_float(w.z << 16), __uint_as_float(w.z & 0xffff0000u), __uint_as_float(w.w << 16), __uint_as_float(w.w & 0xffff0000u)}; }
                    const f32x4 o0 = b0 * rsc + acc[ai][bj][m][0], o1 = b1 * rsc + acc[ai][bj][m][1];
                    if (MODE == 2) { __builtin_nontemporal_store(o0, (f32x4*)(outf + off + bj * HALF)); __builtin_nontemporal_store(o1, (f32x4*)(outf + off + bj * HALF + 4)); }
                    else { u32x4 w; w.x = cvt_pk_bf16(o0[0], o0[1]); w.y = cvt_pk_bf16(o0[2], o0[3]); w.z = cvt_pk_bf16(o1[0], o1[1]); w.w = cvt_pk_bf16(o1[2], o1[3]); *(u32x4*)(xb + off + bj * HALF) = w;
                        s += ((o0[0] * o0[0] + o0[1] * o0[1]) + (o0[2] * o0[2] + o0[3] * o0[3])) + ((o1[0] * o1[0] + o1[1] * o1[1]) + (o1[2] * o1[2] + o1[3] * o1[3])); } }
                if (MODE != 2) { s += __shfl_xor(s, 16); s += __shfl_xor(s, 32); if (fq == 0) P[r * 4 + wc] = s; }
                if (MODE == 0 ? (m == 3) : false) asm volatile("" ::: "memory"); }
        if (MODE != 2) { PG8_LBAR();
            const int t = wid * 64 + lane; if (t < 256) { const f32x4 p = *(const PG8_LAS f32x4*)(P + t * 4); SS[(size_t)(u.pm * BM + t) * 4 + u.pn] = (p[0] + p[1]) + (p[2] + p[3]); } }
    }
};
struct EpiHeadNormK {
    static constexpr bool PERM = true, AFTER_DRAIN = true;
    bf16_t* MKn; const float* kw; const float* qw;
    __device__ __forceinline__ void fused(f32x4 (&acc)[2][2][4][2], const Unit& u, int wr, int wc, int fr, int fq, PG8_LAS unsigned char* lds, int wid, int lane) const {
        PG8_LAS float* P = (PG8_LAS float*)lds; PG8_LAS float* R = (PG8_LAS float*)(lds + 4096);
#pragma unroll
        for (int ai = 0; ai < 2; ++ai)
#pragma unroll
            for (int m = 0; m < 4; ++m) { float s = 0.f;
#pragma unroll
                for (int bj = 0; bj < 2; ++bj)
#pragma unroll
                    for (int n = 0; n < 2; ++n) { const f32x4 v = acc[ai][bj][m][n]; s += (v[0] * v[0] + v[1] * v[1]) + (v[2] * v[2] + v[3] * v[3]); }
                s += __shfl_xor(s, 16); s += __shfl_xor(s, 32); if (fq == 0) P[(ai * HALF + wr * 64 + m * 16 + fr) * 4 + wc] = s; }
        PG8_LBAR();
        { const int t = wid * 64 + lane; if (t < 256) { const f32x4 p = *(const PG8_LAS f32x4*)(P + t * 4); R[t] = rsqrtf(((p[0] + p[1]) + (p[2] + p[3])) * (1.f / 256.f) + EPS); } }
        PG8_LBAR();
        const int c0 = wc * 32 + 8 * fq; f32x4 g[2][2];
#pragma unroll
        for (int bj = 0; bj < 2; ++bj)
#pragma unroll
            for (int n = 0; n < 2; ++n) { const f32x4 a = *(const f32x4*)(kw + c0 + bj * HALF + 4 * n), b = *(const f32x4*)(qw + c0 + bj * HALF + 4 * n); g[bj][n] = a * b * CM; }
        bf16_t* basep = MKn + (size_t)(u.pm * 4 + u.pn) * 65536;
#pragma unroll
        for (int ai = 0; ai < 2; ++ai)
#pragma unroll
            for (int m = 0; m < 4; ++m) { const int r = ai * HALF + wr * 64 + m * 16 + fr; const float rk = R[r];
#pragma unroll
                for (int bj = 0; bj < 2; ++bj) { const f32x4 v0 = acc[ai][bj][m][0] * rk * g[bj][0], v1 = acc[ai][bj][m][1] * rk * g[bj][1];
                    u32x4 w; w.x = cvt_pk_bf16(v0[0], v0[1]); w.y = cvt_pk_bf16(v0[2], v0[3]); w.z = cvt_pk_bf16(v1[0], v1[1]); w.w = cvt_pk_bf16(v1[2], v1[3]);
                    *(u32x4*)(basep + (size_t)r * 256 + c0 + bj * HALF) = w; } }
    }
};
struct EpiMemQ {
    static constexpr bool PERM = true, AFTER_DRAIN = true;
    bf16_t* MQ; const float* SS; PG8_LAS float* RQ;
    __device__ __forceinline__ void fused(f32x4 (&acc)[2][2][4][2], const Unit& u, int wr, int wc, int fr, int fq, PG8_LAS unsigned char* lds, int wid, int lane) const {
        PG8_LAS float* P = (PG8_LAS float*)lds;
        const int col0 = u.pn * BM + wc * 32 + 8 * fq;
#pragma unroll
        for (int ai = 0; ai < 2; ++ai)
#pragma unroll
            for (int m = 0; m < 4; ++m) { const int r = ai * HALF + wr * 64 + m * 16 + fr; const int row = u.pm * BM + r;
                const f32x4 ss = *(const f32x4*)(SS + (size_t)row * 4); const float rs = rsqrtf(((ss[0] + ss[1]) + (ss[2] + ss[3])) * (1.f / DM) + EPS); float s = 0.f;
#pragma unroll
                for (int bj = 0; bj < 2; ++bj) { const f32x4 v0 = acc[ai][bj][m][0] * rs, v1 = acc[ai][bj][m][1] * rs;
                    s += (v0[0] * v0[0] + v0[1] * v0[1]) + (v0[2] * v0[2] + v0[3] * v0[3]) + (v1[0] * v1[0] + v1[1] * v1[1]) + (v1[2] * v1[2] + v1[3] * v1[3]);
                    u32x4 w; w.x = cvt_pk_bf16(v0[0], v0[1]); w.y = cvt_pk_bf16(v0[2], v0[3]); w.z = cvt_pk_bf16(v1[0], v1[1]); w.w = cvt_pk_bf16(v1[2], v1[3]);
                    *(u32x4*)(MQ + (size_t)row * DM + col0 + bj * HALF) = w; }
                s += __shfl_xor(s, 16); s += __shfl_xor(s, 32); if (fq == 0) P[r * 4 + wc] = s; }
        PG8_LBAR();
        { const int t = wid * 64 + lane; if (t < 256) { const f32x4 p = *(const PG8_LAS f32x4*)(P + t * 4); RQ[t] = rsqrtf(((p[0] + p[1]) + (p[2] + p[3])) * (1.f / 256.f) + EPS); } }
        PG8_LBAR();
    }
};
struct EpiMemS {
    static constexpr bool PERM = true, AFTER_DRAIN = true;
    bf16_t* Pt; int head; const PG8_LAS float* RQ; PG8_LAS float* IL;
    __device__ __forceinline__ void fused(f32x4 (&acc)[2][2][4][2], const Unit& u, int wr, int wc, int fr, int fq, PG8_LAS unsigned char* lds, int wid, int lane) const {
        PG8_LAS float* P = (PG8_LAS float*)lds;
        const int col0 = head * BM + wc * 32 + 8 * fq;
#pragma unroll
        for (int ai = 0; ai < 2; ++ai)
#pragma unroll
            for (int m = 0; m < 4; ++m) { const int r = ai * HALF + wr * 64 + m * 16 + fr; const int row = u.pm * BM + r; const float rq = RQ[r]; float s = 0.f;
#pragma unroll
                for (int bj = 0; bj < 2; ++bj) { f32x4 v0 = acc[ai][bj][m][0] * rq, v1 = acc[ai][bj][m][1] * rq;
#pragma unroll
                    for (int e = 0; e < 4; ++e) { v0[e] = __builtin_amdgcn_exp2f(v0[e]); v1[e] = __builtin_amdgcn_exp2f(v1[e]); }
                    s += (v0[0] + v0[1]) + (v0[2] + v0[3]) + (v1[0] + v1[1]) + (v1[2] + v1[3]);
                    u32x4 w; w.x = cvt_pk_bf16(v0[0], v0[1]); w.y = cvt_pk_bf16(v0[2], v0[3]); w.z = cvt_pk_bf16(v1[0], v1[1]); w.w = cvt_pk_bf16(v1[2], v1[3]);
                    *(u32x4*)(Pt + (size_t)row * DM + col0 + bj * HALF) = w; }
                s += __shfl_xor(s, 16); s += __shfl_xor(s, 32); if (fq == 0) P[r * 4 + wc] = s; }
        PG8_LBAR();
        { const int t = wid * 64 + lane; if (t < 256) { const f32x4 p = *(const PG8_LAS f32x4*)(P + t * 4); IL[t] = 1.0f / ((p[0] + p[1]) + (p[2] + p[3])); } }
        PG8_LBAR();
    }
};
struct EpiMemPV {
    static constexpr bool PERM = true, AFTER_DRAIN = false;
    bf16_t* MO; int head; const PG8_LAS float* IL;
    __device__ __forceinline__ void operator()(const f32x4 (&acc)[2][2][4][2], const Unit& u, int wr, int wc, int fr, int fq) const {
        const int col0 = head * BM + wc * 32 + 8 * fq;
#pragma unroll
        for (int ai = 0; ai < 2; ++ai)
#pragma unroll
            for (int m = 0; m < 4; ++m) { const int r = ai * HALF + wr * 64 + m * 16 + fr; const int row = u.pm * BM + r; const float il = IL[r];
#pragma unroll
                for (int bj = 0; bj < 2; ++bj) { const f32x4 v0 = acc[ai][bj][m][0] * il, v1 = acc[ai][bj][m][1] * il;
                    u32x4 w; w.x = cvt_pk_bf16(v0[0], v0[1]); w.y = cvt_pk_bf16(v0[2], v0[3]); w.z = cvt_pk_bf16(v1[0], v1[1]); w.w = cvt_pk_bf16(v1[2], v1[3]);
                    *(u32x4*)(MO + (size_t)row * DM + col0 + bj * HALF) = w; } }
    }
};

template <class Epi, class Sched, bool ALIGN_EPI = false, bool SP2 = false>
__device__ __forceinline__ void gemm_phase(PG8_LAS unsigned char* lds, const Gemm g, const Sched& S, const Epi& E) {
    int tid_ = threadIdx.x; asm volatile("" : "+v"(tid_));
    const int tid = tid_, wid = __builtin_amdgcn_readfirstlane(tid >> 6), lane = tid & 63, wr = wid >> 2, wc = wid & 3, fr = lane & 15, fq = lane >> 4;
    const int K = g.K, nt = K / BK;
    unsigned voffA[2], voffB[2];
#pragma unroll
    for (int i = 0; i < 2; ++i) { int R, C; stage_rc(tid * 16 + i * 8192, R, C); const int Rb = Epi::PERM ? ((R & ~31) + perm32(R & 31)) : R;
        voffA[i] = (unsigned)(R * g.lda + C) * 2u; voffB[i] = (unsigned)(Rb * g.ldb + C) * 2u; }
    const size_t kstep = (size_t)(BK * 2);
    const size_t hsA = (size_t)HALF * g.lda * 2, hsB = (size_t)HALF * g.ldb * 2;
    const size_t tsA = 2 * hsA, tsB = 2 * hsB;
    const unsigned ldsw = (unsigned)wid * 1024u;
    const int aoff = lds_byte(wr * 64 + fr, fq * 8), boff = lds_byte(wc * 32 + fr, fq * 8);
#define PG8_SA(b, h) (((b) * 2 + (h)) * HTB)
#define PG8_SB(b, h) ((4 + (b) * 2 + (h)) * HTB)
#define PG8_STAGE(bufoff, gbase, voff) do { _Pragma("unroll") for (int _i = 0; _i < 2; ++_i) \
        __builtin_amdgcn_global_load_lds((const unsigned*)((const char*)(gbase) + (voff)[_i]), (PG8_LAS unsigned*)(lds + (bufoff) + ldsw + _i * 8192), 16, 0, 0); } while (0)
#define PG8_LDA(dst, b, h) do { _Pragma("unroll") for (int m = 0; m < 4; ++m) _Pragma("unroll") for (int k = 0; k < 2; ++k) dst[m][k] = *(const PG8_LAS bf16x8*)(lds + PG8_SA(b, h) + aoff + m * 2048 + k * 1024); } while (0)
#define PG8_LDB(dst, b, h) do { _Pragma("unroll") for (int n = 0; n < 2; ++n) _Pragma("unroll") for (int k = 0; k < 2; ++k) dst[n][k] = *(const PG8_LAS bf16x8*)(lds + PG8_SB(b, h) + boff + n * 2048 + k * 1024); } while (0)
#define PG8_MMA(ai, bj, At, Bt) do { __builtin_amdgcn_s_setprio(1); _Pragma("unroll") for (int m = 0; m < 4; ++m) _Pragma("unroll") for (int n = 0; n < 2; ++n) _Pragma("unroll") for (int k = 0; k < 2; ++k) \
        acc[ai][bj][m][n] = __builtin_amdgcn_mfma_f32_16x16x32_bf16(Bt[n][k], At[m][k], acc[ai][bj][m][n], 0, 0, 0); __builtin_amdgcn_s_setprio(0); } while (0)
#define PG8_WAIT_V(n) asm volatile("s_waitcnt vmcnt(" #n ")" ::: "memory")
#define PG8_WAIT_L(n) asm volatile("s_waitcnt lgkmcnt(" #n ")" ::: "memory")
#define PG8_BAR __builtin_amdgcn_s_barrier()
#define PG8_SCHED __builtin_amdgcn_sched_barrier(0)
    Unit cur, nxt; int ui = 0;
    if (!S.next(0, cur)) return;
    f32x4 acc[2][2][4][2];
#pragma unroll
    for (int a = 0; a < 2; ++a)
#pragma unroll
        for (int b = 0; b < 2; ++b)
#pragma unroll
            for (int m = 0; m < 4; ++m)
#pragma unroll
                for (int n = 0; n < 2; ++n) acc[a][b][m][n] = (f32x4){0.f, 0.f, 0.f, 0.f};
    bf16x8 At[4][2], B0[2][2], B1[2][2];
    const char* cA = (const char*)g.A + (size_t)cur.pm * tsA; const char* cB = (const char*)g.Bt + (size_t)cur.pn * tsB;
    S.a_ready(cur);
    if constexpr (SP2) {
        PG8_STAGE(PG8_SB(0, 0), cB, voffB); PG8_STAGE(PG8_SB(0, 1), cB + hsB, voffB); PG8_STAGE(PG8_SA(0, 0), cA, voffA); PG8_STAGE(PG8_SA(0, 1), cA + hsA, voffA);
        if (wr == 1) PG8_BAR;
        PG8_WAIT_V(2); PG8_BAR;
        PG8_STAGE(PG8_SB(1, 0), cB + kstep, voffB); PG8_STAGE(PG8_SA(1, 0), cA + kstep, voffA); PG8_STAGE(PG8_SB(1, 1), cB + hsB + kstep, voffB);
        PG8_WAIT_V(6); PG8_BAR;
    } else {
        PG8_STAGE(PG8_SB(0, 0), cB, voffB); PG8_STAGE(PG8_SA(0, 0), cA, voffA); PG8_STAGE(PG8_SB(0, 1), cB + hsB, voffB); PG8_STAGE(PG8_SA(0, 1), cA + hsA, voffA);
        if (wr == 1) PG8_BAR;
        PG8_WAIT_V(4); PG8_BAR;
        PG8_STAGE(PG8_SB(1, 0), cB + kstep, voffB); PG8_STAGE(PG8_SA(1, 0), cA + kstep, voffA); PG8_STAGE(PG8_SB(1, 1), cB + hsB + kstep, voffB);
        PG8_WAIT_V(6); PG8_BAR;
    }
    for (;;) {
        const bool has_next = S.next(ui + 1, nxt);
        const char* nA = has_next ? (const char*)g.A + (size_t)nxt.pm * tsA : cA; const char* nB = has_next ? (const char*)g.Bt + (size_t)nxt.pn * tsB : cB;
        for (int t = 0; t < nt; t += 2) {
            const bool last = (t == nt - 2);
            const char* a1 = cA + (size_t)(t + 1) * kstep;
            const char* a2 = last ? nA : cA + (size_t)(t + 2) * kstep; const char* b2 = last ? nB : cB + (size_t)(t + 2) * kstep;
            const char* a3 = a2 + kstep; const char* b3 = b2 + kstep;
            if (last && has_next) S.a_ready(nxt);
            if constexpr (SP2) {
            PG8_LDB(B0, 0, 0); PG8_LDB(B1, 0, 1); PG8_SCHED; PG8_LDA(At, 0, 0); PG8_STAGE(PG8_SA(1, 1), a1 + hsA, voffA);
            PG8_WAIT_V(8); PG8_WAIT_L(0); PG8_BAR; PG8_MMA(0, 0, At, B0); PG8_MMA(0, 1, At, B1); PG8_BAR; PG8_SCHED;
            PG8_LDA(At, 0, 1); PG8_STAGE(PG8_SB(0, 0), b2, voffB); PG8_STAGE(PG8_SB(0, 1), b2 + hsB, voffB); PG8_STAGE(PG8_SA(0, 0), a2, voffA);
            PG8_WAIT_V(8); PG8_WAIT_L(0); PG8_BAR; PG8_MMA(1, 0, At, B0); PG8_MMA(1, 1, At, B1); PG8_BAR; PG8_SCHED;
            PG8_LDB(B0, 1, 0); PG8_LDB(B1, 1, 1); PG8_SCHED; PG8_LDA(At, 1, 0); PG8_STAGE(PG8_SA(0, 1), a2 + hsA, voffA);
            PG8_WAIT_V(8); PG8_WAIT_L(0); PG8_BAR; PG8_MMA(0, 0, At, B0); PG8_MMA(0, 1, At, B1); PG8_BAR; PG8_SCHED;
            PG8_LDA(At, 1, 1); PG8_STAGE(PG8_SB(1, 0), b3, voffB); PG8_STAGE(PG8_SB(1, 1), b3 + hsB, voffB); PG8_STAGE(PG8_SA(1, 0), a3, voffA);
            PG8_WAIT_V(8); PG8_WAIT_L(0); PG8_BAR; PG8_MMA(1, 0, At, B0); PG8_MMA(1, 1, At, B1); PG8_BAR; PG8_SCHED;
            } else {
            PG8_LDB(B0, 0, 0); PG8_SCHED; PG8_LDA(At, 0, 0); PG8_STAGE(PG8_SA(1, 1), a1 + hsA, voffA);
            PG8_WAIT_L(8); PG8_BAR; PG8_WAIT_L(0); PG8_MMA(0, 0, At, B0); PG8_BAR; PG8_SCHED;
            PG8_LDB(B1, 0, 1); PG8_STAGE(PG8_SB(0, 0), b2, voffB);
            PG8_BAR; PG8_WAIT_L(0); PG8_MMA(0, 1, At, B1); PG8_BAR;
            PG8_LDA(At, 0, 1); PG8_STAGE(PG8_SA(0, 0), a2, voffA);
            PG8_BAR; PG8_WAIT_L(0); PG8_MMA(1, 0, At, B0); PG8_BAR; PG8_SCHED;
            PG8_STAGE(PG8_SB(0, 1), b2 + hsB, voffB);
            PG8_WAIT_V(6); PG8_BAR; PG8_MMA(1, 1, At, B1); PG8_BAR;
            PG8_LDB(B0, 1, 0); PG8_SCHED; PG8_LDA(At, 1, 0); PG8_STAGE(PG8_SA(0, 1), a2 + hsA, voffA);
            PG8_WAIT_L(8); PG8_BAR; PG8_WAIT_L(0); PG8_MMA(0, 0, At, B0); PG8_BAR; PG8_SCHED;
            PG8_LDB(B1, 1, 1); PG8_STAGE(PG8_SB(1, 0), b3, voffB);
            PG8_BAR; PG8_WAIT_L(0); PG8_MMA(0, 1, At, B1); PG8_BAR;
            PG8_LDA(At, 1, 1); PG8_STAGE(PG8_SA(1, 0), a3, voffA);
            PG8_BAR; PG8_WAIT_L(0); PG8_MMA(1, 0, At, B0); PG8_BAR; PG8_SCHED;
            PG8_STAGE(PG8_SB(1, 1), b3 + hsB, voffB);
            PG8_WAIT_V(6); PG8_BAR; PG8_MMA(1, 1, At, B1); PG8_BAR;
            }
        }
        if constexpr (ALIGN_EPI) { if (wr == 0) PG8_BAR; }
        if constexpr (!Epi::AFTER_DRAIN) { int fr2 = fr, fq2 = fq; asm volatile("" : "+v"(fr2), "+v"(fq2)); E(acc, cur, wr, wc, fr2, fq2); S.done(cur); }
        if (!has_next) break;
#pragma unroll
        for (int a = 0; a < 2; ++a)
#pragma unroll
            for (int b = 0; b < 2; ++b)
#pragma unroll
                for (int m = 0; m < 4; ++m)
#pragma unroll
                    for (int n = 0; n < 2; ++n) acc[a][b][m][n] = (f32x4){0.f, 0.f, 0.f, 0.f};
        cur = nxt; cA = nA; cB = nB; ++ui;
        if constexpr (ALIGN_EPI) { if (wr == 1) PG8_BAR; }
    }
    PG8_WAIT_V(0);
    if constexpr (!ALIGN_EPI) { if (wr == 0) PG8_BAR; }
    PG8_BAR;
    if constexpr (Epi::AFTER_DRAIN) { int fr2 = fr, fq2 = fq, lane2 = lane; asm volatile("" : "+v"(fr2), "+v"(fq2), "+v"(lane2)); E.fused(acc, cur, wr, wc, fr2, fq2, lds, wid, lane2); S.done(cur); }
#undef PG8_SA
#undef PG8_SB
#undef PG8_STAGE
#undef PG8_LDA
#undef PG8_LDB
#undef PG8_MMA
#undef PG8_WAIT_V
#undef PG8_WAIT_L
#undef PG8_BAR
#undef PG8_SCHED
}}

#define GAS __attribute__((address_space(1)))
#define LAS __attribute__((address_space(3)))
typedef unsigned v4u __attribute__((ext_vector_type(4)));
typedef float f32x4 __attribute__((ext_vector_type(4)));
typedef short bf16x8 __attribute__((ext_vector_type(8)));
typedef GAS unsigned gu32;
typedef GAS unsigned long long gu64;
#define RLX_AGENT __ATOMIC_RELAXED, __HIP_MEMORY_SCOPE_AGENT
#define LDS_WAIT() asm volatile("s_waitcnt lgkmcnt(0)" ::: "memory")
#define VM_WAIT() asm volatile("s_waitcnt vmcnt(0)" ::: "memory")
__device__ __forceinline__ unsigned long long rt() { return __builtin_amdgcn_s_memrealtime(); }
__device__ __forceinline__ unsigned pk2(float lo, float hi) { return (unsigned)f2bf(lo) | ((unsigned)f2bf(hi) << 16); }

#define XB_TMO      128
#define XB_XCNT(j)  (256  + 64 * (j))
#define XB_XSUB(j)  (1280 + 64 * (j))
#define XB_XGEN(j)  (2304 + 64 * (j))
#define XB_TOP      3328
#define XB_TOPGEN   3392
#define XL_SUB(j)   (3456 + 64 * (j))
#define XL_GEN(j)   (4480 + 64 * (j))
#define XCD_BAR_WORDS 5504
#define XB_SPIN_CAP (1u << 18)

__device__ __forceinline__ unsigned xb_ld(unsigned* p)              { return __hip_atomic_load(p, __ATOMIC_RELAXED, __HIP_MEMORY_SCOPE_AGENT); }
__device__ __forceinline__ unsigned xb_add(unsigned* p, unsigned v) { return __hip_atomic_fetch_add(p, v, __ATOMIC_RELAXED, __HIP_MEMORY_SCOPE_AGENT); }
__device__ __forceinline__ unsigned xb_xcc_id() { return (unsigned)__builtin_amdgcn_s_getreg((3 << 11) | 20) & 0xFu; }
#define XB_SPIN(cond, bar) do { unsigned _sp = 0; while (cond) { __builtin_amdgcn_s_sleep(1); \
    if ((++_sp & 255u) == 0u) { if (xb_ld(&(bar)[XB_TMO])) break; if (_sp > XB_SPIN_CAP) { atomicAdd(&(bar)[XB_TMO], 1u); break; } } } } while (0)

struct XcdBarrier {
    unsigned* bar; unsigned x;
    volatile LAS unsigned* st;
};

__device__ __forceinline__ XcdBarrier xcd_barrier_post(unsigned* bar, volatile LAS unsigned* st) {
    XcdBarrier b; b.bar = bar; b.x = xb_xcc_id(); b.st = st;
    if (threadIdx.x == 0) st[2] = xb_add(&bar[XB_XCNT(b.x)], 1u);
    return b;
}
__device__ __forceinline__ void xcd_barrier_complete(unsigned* bar, unsigned x, unsigned& nloc, unsigned& nx) {
    const unsigned G = gridDim.x * gridDim.y * gridDim.z;
    unsigned sum, cnt, mine, sp = 0u;
    for (;;) {
        sum = 0u; cnt = 0u; mine = 0u;
#pragma unroll
        for (unsigned j = 0; j < 16; ++j) { const unsigned c = xb_ld(&bar[XB_XCNT(j)]); sum += c; cnt += (c > 0u) ? 1u : 0u; mine = (j == x) ? c : mine; }
        if (sum == G) break;
        __builtin_amdgcn_s_sleep(1);
        if ((++sp & 255u) == 0u) { if (xb_ld(&bar[XB_TMO])) break; if (sp > XB_SPIN_CAP) { atomicAdd(&bar[XB_TMO], 1u); break; } }
    }
    nloc = mine > 0u ? mine : 1u; nx = cnt > 0u ? cnt : 1u;
}
__device__ __forceinline__ unsigned xcd_census_even(unsigned* bar) {
    unsigned ok = (gridDim.x == 256u) ? 1u : 0u;
#pragma unroll
    for (unsigned j = 0; j < 8; ++j) ok &= (xb_ld(&bar[XB_XCNT(j)]) == 32u) ? 1u : 0u;
    return ok;
}

__device__ __forceinline__ void xcd_barrier(const XcdBarrier& b) {
    asm volatile("s_waitcnt vmcnt(0)" ::: "memory");
    __syncthreads();
    if (threadIdx.x == 0) {
        unsigned* bar = b.bar;
        __builtin_amdgcn_s_waitcnt(0);
        unsigned nloc = b.st[0], nx = b.st[1];
        if (nloc == 0u) { xcd_barrier_complete(bar, b.x, nloc, nx); b.st[0] = nloc; b.st[1] = nx; b.st[3] = xcd_census_even(bar); }
        const unsigned old = xb_add(&bar[XB_XSUB(b.x)], 1u);
        const unsigned gen = old / nloc;
        if (old + 1u == (gen + 1u) * nloc) {
            __builtin_amdgcn_fence(__ATOMIC_RELEASE, "agent");
            asm volatile("s_waitcnt vmcnt(0)" ::: "memory");
            const unsigned og = xb_add(&bar[XB_TOP], 1u);
            const unsigned tg = og / nx;
            if (og + 1u == (tg + 1u) * nx) xb_add(&bar[XB_TOPGEN], 1u);
            else XB_SPIN(xb_ld(&bar[XB_TOPGEN]) == tg, bar);
            __builtin_amdgcn_fence(__ATOMIC_ACQUIRE, "agent");
            xb_add(&bar[XB_XGEN(b.x)], 1u);
            asm volatile("s_waitcnt vmcnt(0)" ::: "memory");
        } else {
            XB_SPIN(xb_ld(&bar[XB_XGEN(b.x)]) == gen, bar);
            __builtin_amdgcn_fence(__ATOMIC_ACQUIRE, "agent");
            asm volatile("s_waitcnt vmcnt(0)" ::: "memory");
        }
    }
    __syncthreads();
}

__device__ __forceinline__ void xcc_barrier(const XcdBarrier& b) {
    asm volatile("s_waitcnt vmcnt(0)" ::: "memory");
    __syncthreads();
    if (threadIdx.x == 0) {
        unsigned* bar = b.bar;
        const unsigned old = xb_add(&bar[XL_SUB(b.x)], 1u);
        const unsigned gen = old / 32u;
        if (old + 1u == (gen + 1u) * 32u) xb_add(&bar[XL_GEN(b.x)], 1u);
        else XB_SPIN(xb_ld(&bar[XL_GEN(b.x)]) == gen, bar);
        __builtin_amdgcn_fence(__ATOMIC_ACQUIRE, "agent");
        asm volatile("s_waitcnt vmcnt(0)" ::: "memory");
    }
    __syncthreads();
}

constexpr int NWAVES = 8;
constexpr int RING_OFF = 0, RING_BYTES = 131072;
constexpr int LDSCTL_OFF = 158720, MISC_OFF = LDSCTL_OFF + 320;
constexpr int LDS_RQ = LDSCTL_OFF + 1024, LDS_IL = LDSCTL_OFF + 2048;
constexpr int LDS_BYTES = 163840;
constexpr int CW_TMO = 0, CW_BAR = 4096;

struct Frame {
    LAS unsigned char* lds; volatile LAS unsigned* MISC; gu32* ctl;
    int tid, lane, wave, vcu, G;
};
struct Args { const void* in[26]; float* out; unsigned char* ws; int ph_lo, ph_hi; };

__device__ __forceinline__ float wave_sum(float v) {
#pragma unroll
    for (int o = 1; o < 64; o <<= 1) v += __shfl_xor(v, o);
    return v;
}
template <bool HEADPERM, bool WT = false> __device__ __forceinline__ void p0_transpose_item(const float* W, int ldw, int K, int N, const float* g, bf16_t* WT_, LAS float* scr, int item, int lane) {
    const int nblk = N / 32, kb = item / nblk, nb = item % nblk, k0 = 64 * kb, n0 = 32 * nb;
    const int r8 = lane >> 3, c4 = (lane & 7) * 4;
    f32x4 v[8]; float gg[8];
#pragma unroll
    for (int i = 0; i < 8; ++i) { v[i] = __builtin_nontemporal_load((const GAS f32x4*)(W + (size_t)(k0 + r8 + 8 * i) * ldw + n0 + c4)); gg[i] = g ? g[k0 + r8 + 8 * i] : 1.f; }
#pragma unroll
    for (int i = 0; i < 8; ++i) { LAS float* d = scr + (r8 + 8 * i) * 33 + c4; const f32x4 x = v[i] * gg[i]; d[0] = x.x; d[1] = x.y; d[2] = x.z; d[3] = x.w; }
    LDS_WAIT(); asm volatile("" ::: "memory");
    const int c = lane & 7;
#pragma unroll
    for (int j = 0; j < 4; ++j) { const int n = (lane >> 3) + 8 * j; const LAS float* s = scr + (8 * c) * 33 + n;
        v4u o; o.x = pk2(s[0 * 33], s[1 * 33]); o.y = pk2(s[2 * 33], s[3 * 33]); o.z = pk2(s[4 * 33], s[5 * 33]); o.w = pk2(s[6 * 33], s[7 * 33]);
        int nr = n0 + n; if (HEADPERM) { const int l = nr & 255; nr = (nr & ~255) | (((l >> 5) & 1) * 128 + (l >> 6) * 32 + (l & 31)); }
        if (WT) { const __amdgpu_buffer_rsrc_t rs_ = __builtin_amdgcn_make_buffer_rsrc((void*)WT_, (short)0, 0x7fffffff, 0x00020000); __builtin_amdgcn_raw_buffer_store_b128(o, rs_, (int)(((size_t)nr * K + k0 + 8 * c) * 2), 0, 16); }
        else *(GAS v4u*)(WT_ + (size_t)nr * K + k0 + 8 * c) = o; }
    LDS_WAIT(); asm volatile("" ::: "memory");
}
template <bool FLOG> __device__ __forceinline__ void rms_rows_to_bf16(int lane, const float* X, bf16_t* O, int m0, int step, int rows, const float* g, const float* win, float* flog, float* rs0) {
    if (m0 >= rows) return;
    f32x4 wf[4][4][2];
    if (FLOG) {
#pragma unroll
        for (int j = 0; j < 4; ++j) { const f32x4 gg = *(const GAS f32x4*)(g + 256 * j + 4 * lane);
#pragma unroll
            for (int e = 0; e < 4; ++e) { const int k = 256 * j + 4 * lane + e; wf[j][e][0] = *(const GAS f32x4*)(win + (size_t)k * INCOLS + NPROJ) * gg[e]; wf[j][e][1] = *(const GAS f32x4*)(win + (size_t)k * INCOLS + NPROJ + 4) * gg[e]; } }
    }
    f32x4 nx[4], nx2[4];
    { const GAS f32x4* xr = (const GAS f32x4*)(X + (size_t)m0 * DM) + lane;
#pragma unroll
      for (int j = 0; j < 4; ++j) nx[j] = __builtin_nontemporal_load(xr + 64 * j);
      if (m0 + step < rows) { const GAS f32x4* xr2 = (const GAS f32x4*)(X + (size_t)(m0 + step) * DM) + lane;
#pragma unroll
          for (int j = 0; j < 4; ++j) nx2[j] = __builtin_nontemporal_load(xr2 + 64 * j); } }
    for (int m = m0; m < rows; m += step) {
        f32x4 v[4];
#pragma unroll
        for (int j = 0; j < 4; ++j) { v[j] = nx[j]; nx[j] = nx2[j]; }
        if (m + 2 * step < rows) { const GAS f32x4* xr = (const GAS f32x4*)(X + (size_t)(m + 2 * step) * DM) + lane;
#pragma unroll
            for (int j = 0; j < 4; ++j) nx2[j] = __builtin_nontemporal_load(xr + 64 * j); }
        float s2 = 0.f;
#pragma unroll
        for (int j = 0; j < 4; ++j) s2 += (v[j].x * v[j].x + v[j].y * v[j].y) + (v[j].z * v[j].z + v[j].w * v[j].w);
        const float ms_ = wave_sum(s2) * (1.f / DM) + EPS; const float rstd = rsqrtf(ms_);
        if (FLOG) { if (lane == 0) rs0[m] = sqrtf(ms_); }
        GAS unsigned long long* o8 = (GAS unsigned long long*)(O + (size_t)m * DM) + lane;
#pragma unroll
        for (int j = 0; j < 4; ++j) { v[j] = v[j] * rstd; o8[64 * j] = (unsigned long long)pk2(v[j].x, v[j].y) | ((unsigned long long)pk2(v[j].z, v[j].w) << 32); }
        if (FLOG) {
            f32x4 a0 = {0.f, 0.f, 0.f, 0.f}, a1 = {0.f, 0.f, 0.f, 0.f};
#pragma unroll
            for (int j = 0; j < 4; ++j)
#pragma unroll
                for (int e = 0; e < 4; ++e) { a0 += wf[j][e][0] * v[j][e]; a1 += wf[j][e][1] * v[j][e]; }
            { const bool b0 = lane & 1, b1 = lane & 2, b2 = lane & 4;
              const f32x4 snd = b0 ? a0 : a1, kp = b0 ? a1 : a0; f32x4 rc;
#pragma unroll
              for (int e = 0; e < 4; ++e) rc[e] = __shfl_xor(snd[e], 1);
              const f32x4 w4 = kp + rc;
              const float s0 = b1 ? w4[0] : w4[2], s1 = b1 ? w4[1] : w4[3], k0 = b1 ? w4[2] : w4[0], k1 = b1 ? w4[3] : w4[1];
              const float w20 = k0 + __shfl_xor(s0, 2), w21 = k1 + __shfl_xor(s1, 2);
              float w1 = (b2 ? w21 : w20) + __shfl_xor(b2 ? w20 : w21, 4);
              w1 += __shfl_xor(w1, 8); w1 += __shfl_xor(w1, 16); w1 += __shfl_xor(w1, 32);
              if (lane < 8) flog[(size_t)m * 8 + 4 * (lane & 1) + (lane & 2) + ((lane >> 2) & 1)] = w1; }
        }
    }
}
__constant__ float INV_FREQ[8] = {1.0f, 0.1939227432012558f, 0.03760603070259094f, 0.007292664609849453f, 0.0014142135623842478f, 0.00027424818836152554f, 5.318296098266728e-05f, 1.0313386155758053e-05f};

struct Ptrs {
    const float *x, *mem; const int* pos; const float *norm_mix_w, *w_in, *b_forget, *dqw, *dkw, *lq1, *lk1, *lq2, *lk2, *subw, *fqw, *fkw, *w_out, *nmq, *nmkv, *w_mq, *w_mkv, *mqw, *mkw, *w_mo, *nmlp, *w_up, *w_dn;
    float* out; float *FLOG, *CUMB, *ROPE, *SS, *QKW, *RS0;
    bf16_t *WIN, *WOUT, *WQ, *WKV, *WO, *WUP, *WDN, *XB, *HM, *MK, *VT, *MKN, *PROJ, *ATT, *MQ, *MO, *H;
};
__host__ __device__ __forceinline__ Ptrs make_ptrs(const void* const* in, float* out, unsigned char* ws) {
    Ptrs p;
    p.x = (const float*)in[0]; p.mem = (const float*)in[1]; p.pos = (const int*)in[2]; p.norm_mix_w = (const float*)in[3]; p.w_in = (const float*)in[4]; p.b_forget = (const float*)in[5];
    p.dqw = (const float*)in[6]; p.dkw = (const float*)in[7]; p.lq1 = (const float*)in[8]; p.lk1 = (const float*)in[9]; p.lq2 = (const float*)in[10]; p.lk2 = (const float*)in[11];
    p.subw = (const float*)in[12]; p.fqw = (const float*)in[13]; p.fkw = (const float*)in[14]; p.w_out = (const float*)in[15]; p.nmq = (const float*)in[16]; p.nmkv = (const float*)in[17];
    p.w_mq = (const float*)in[18]; p.w_mkv = (const float*)in[19]; p.mqw = (const float*)in[20]; p.mkw = (const float*)in[21]; p.w_mo = (const float*)in[22]; p.nmlp = (const float*)in[23];
    p.w_up = (const float*)in[24]; p.w_dn = (const float*)in[25]; p.out = out;
    p.FLOG = (float*)(ws + WS_FLOG); p.CUMB = (float*)(ws + WS_CUMB); p.ROPE = (float*)(ws + WS_ROPE); p.SS = (float*)(ws + WS_SS); p.QKW = (float*)(ws + WS_QKW); p.RS0 = (float*)(ws + WS_RS0);
    p.WIN = (bf16_t*)(ws + WS_WIN); p.WOUT = (bf16_t*)(ws + WS_WOUT); p.WQ = (bf16_t*)(ws + WS_WQ); p.WKV = (bf16_t*)(ws + WS_WKV); p.WO = (bf16_t*)(ws + WS_WO); p.WUP = (bf16_t*)(ws + WS_WUP); p.WDN = (bf16_t*)(ws + WS_WDN);
    p.XB = (bf16_t*)(ws + WS_XB); p.HM = (bf16_t*)(ws + WS_HM); p.MK = (bf16_t*)(ws + WS_MK); p.VT = (bf16_t*)(ws + WS_VT); p.MKN = (bf16_t*)(ws + WS_MKN);
    p.PROJ = (bf16_t*)(ws + WS_PROJ); p.ATT = (bf16_t*)(ws + WS_ATT); p.MQ = (bf16_t*)(ws + WS_MQ); p.MO = (bf16_t*)(ws + WS_MO); p.H = (bf16_t*)(ws + WS_H);
    return p;
}

__device__ __forceinline__ void p0_prologue(Frame& F, const Ptrs& P) {
    LAS float* scr = (LAS float*)(F.lds + RING_OFF + F.wave * 16384);
    const int gw = F.vcu * NWAVES + F.wave, NGW = F.G * NWAVES;
    constexpr int I_IN = 16 * 96, I_KV = 16 * 64, I_OUT = 16 * 32;
    constexpr int NITEMS = I_IN + I_KV + I_OUT;
    for (int it = gw; it < NITEMS; it += NGW) {
        if (it < I_IN) p0_transpose_item<true>(P.w_in, INCOLS, DM, NPROJ, P.norm_mix_w, P.WIN, scr, it, F.lane);
        else if (it < I_IN + I_KV) p0_transpose_item<false>(P.w_mkv, 2048, DM, 2048, P.nmkv, P.WKV, scr, it - I_IN, F.lane);
        else p0_transpose_item<false>(P.w_out, DM, DM, DM, nullptr, P.WOUT, scr, it - I_IN - I_KV, F.lane);
    }
    rms_rows_to_bf16<true>(F.lane, P.x, P.XB, gw, NGW, MTOK, P.norm_mix_w, P.w_in, P.FLOG, P.RS0);
    rms_rows_to_bf16<false>(F.lane, P.mem, P.HM, gw, NGW, MMEM, nullptr, nullptr, nullptr, nullptr);
    if (blockIdx.x == 0 && F.tid < 64) { const int t = F.tid; P.QKW[t] = P.dqw[t]; P.QKW[64 + t] = P.dkw[t]; P.QKW[128 + t] = P.fqw[t]; P.QKW[192 + t] = P.fkw[t]; }
    for (int id = (F.vcu * NWAVES * 64) + F.tid; id < MTOK * 8; id += F.G * NWAVES * 64) {
        const int row = id >> 3, i = id & 7;
        const float ang = (float)P.pos[row] * INV_FREQ[i];
        const double a = (double)ang; const double k = rint(a * 0.15915494309189535); const float r = (float)fma(-k, 6.283185307179586, a);
        P.ROPE[(size_t)row * 16 + i] = cosf(r); P.ROPE[(size_t)row * 16 + 8 + i] = sinf(r);
    }
}
__device__ __forceinline__ void p1b_row(bf16_t* PROJ, const float* dqw, const float* dkw, const float* fqw, const float* fkw, const float* ROPE, int row, int lane) {
    const int sg = lane >> 1, hf = lane & 1;
    const int col = (sg < 16 ? sg * 64 : 1536 + (sg - 16) * 64) + hf * 32;
    const float* w = (sg < 8 ? dqw : sg < 16 ? dkw : sg < 24 ? fqw : fkw) + hf * 32;
    const bool rope = (sg < 16) && (hf == 0), isq = (sg < 8) || (sg >= 16 && sg < 24);
    GAS v4u* p = (GAS v4u*)(PROJ + (size_t)row * NPROJ + col);
    const v4u u0 = p[0], u1 = p[1], u2 = p[2], u3 = p[3];
#define UNP_LO(u) (f32x4){__uint_as_float(u.x << 16), __uint_as_float(u.x & 0xffff0000u), __uint_as_float(u.y << 16), __uint_as_float(u.y & 0xffff0000u)}
#define UNP_HI(u) (f32x4){__uint_as_float(u.z << 16), __uint_as_float(u.z & 0xffff0000u), __uint_as_float(u.w << 16), __uint_as_float(u.w & 0xffff0000u)}
    f32x4 v0 = UNP_LO(u0), v1 = UNP_HI(u0), v2 = UNP_LO(u1), v3 = UNP_HI(u1), v4 = UNP_LO(u2), v5 = UNP_HI(u2), v6 = UNP_LO(u3), v7 = UNP_HI(u3);
#undef UNP_LO
#undef UNP_HI
#define SQ4(v) ((v.x * v.x + v.y * v.y) + (v.z * v.z + v.w * v.w))
    float ss = (SQ4(v0) + SQ4(v1)) + (SQ4(v2) + SQ4(v3)) + (SQ4(v4) + SQ4(v5)) + (SQ4(v6) + SQ4(v7));
#undef SQ4
    ss += __shfl_xor(ss, 1);
    const float rstd = rsqrtf(ss * (1.f / 64.f) + EPS);
    const GAS f32x4* wg = (const GAS f32x4*)w;
    v0 = v0 * rstd * wg[0]; v1 = v1 * rstd * wg[1]; v2 = v2 * rstd * wg[2]; v3 = v3 * rstd * wg[3]; v4 = v4 * rstd * wg[4]; v5 = v5 * rstd * wg[5]; v6 = v6 * rstd * wg[6]; v7 = v7 * rstd * wg[7];
    if (rope) {
        const GAS f32x4* rt = (const GAS f32x4*)(ROPE + (size_t)row * 16);
        const f32x4 c0 = rt[0], c1 = rt[1], s0 = rt[2], s1 = rt[3];
        const f32x4 a0 = v0 * c0 - v2 * s0, b0 = v2 * c0 + v0 * s0, a1 = v1 * c1 - v3 * s1, b1 = v3 * c1 + v1 * s1;
        v0 = a0; v2 = b0; v1 = a1; v3 = b1;
    }
    const float sc = isq ? C2 : 1.f;
#define PK4(a, b) (v4u){pk2(a.x * sc, a.y * sc), pk2(a.z * sc, a.w * sc), pk2(b.x * sc, b.y * sc), pk2(b.z * sc, b.w * sc)}
    p[0] = PK4(v0, v1); p[1] = PK4(v2, v3); p[2] = PK4(v4, v5); p[3] = PK4(v6, v7);
#undef PK4
}
__device__ __forceinline__ void p1b_cumsum_wg(const float* FLOG, const float* b_forget, float* CUMB, int seq, int tid, LAS float* scr) {
    const int b = seq >> 3, h = seq & 7, lane = tid & 63, wv = tid >> 6; const float bf = b_forget[h];
    float lf[4]; float run = 0.f;
#pragma unroll
    for (int i = 0; i < 4; ++i) { const float z = FLOG[(size_t)(b * SEQ + tid * 4 + i) * 8 + h] + bf; const float e = __expf(-fabsf(z)); lf[i] = fminf(z, 0.f) - log1pf(e); run += lf[i]; }
    float inc = run;
#pragma unroll
    for (int o = 1; o < 64; o <<= 1) { const float t = __shfl_up(inc, o); if (lane >= o) inc += t; }
    if (lane == 63) scr[wv] = inc;
    __syncthreads();
    float base = 0.f;
#pragma unroll
    for (int w = 0; w < 8; ++w) { const float t = scr[w]; if (w < wv) base += t; }
    float c = base + inc - run;
    f32x4 o;
#pragma unroll
    for (int i = 0; i < 4; ++i) { c += lf[i]; o[i] = -c * LOG2E; }
    *(GAS f32x4*)(CUMB + (size_t)seq * SEQ + tid * 4) = o;
    __syncthreads();
}
__device__ __forceinline__ void p1b_cumsum(const Ptrs& P, int seq, int lane) {
    const int b = seq >> 3, h = seq & 7; const float bf = P.b_forget[h];
    float lf[32]; float run = 0.f;
#pragma unroll
    for (int i = 0; i < 32; ++i) { const float z = P.FLOG[(size_t)(b * SEQ + lane * 32 + i) * 8 + h] + bf;
        const float e = __expf(-fabsf(z)); lf[i] = fminf(z, 0.f) - log1pf(e); run += lf[i]; }
    float inc = run;
#pragma unroll
    for (int o = 1; o < 64; o <<= 1) { const float t = __shfl_up(inc, o); if (lane >= o) inc += t; }
    float c = inc - run;
#pragma unroll
    for (int i = 0; i < 32; ++i) { c += lf[i]; P.CUMB[(size_t)seq * SEQ + lane * 32 + i] = -c * LOG2E; }
}
#ifndef PROBE_K
#define PROBE_K -1
#endif
struct Sched {
    pg8::StaticOrder so; int mode, pm, pn; bool has;
    __device__ __forceinline__ bool next(int i, pg8::Unit& u) const { if (mode == 0) return so.next(i, u); if (i != 0 || !has) return false; u.pm = pm; u.pn = pn; return true; }
    __device__ __forceinline__ void a_ready(const pg8::Unit&) const {}
    __device__ __forceinline__ void done(const pg8::Unit&) const {}
};
__device__ __forceinline__ Sched sched_static(int M, int N, int G, int c) { Sched s; s.so.init(M, N, G, c); s.mode = 0; s.pm = 0; s.pn = 0; s.has = true; return s; }
__device__ __forceinline__ Sched sched_one(int pm, int pn, bool has) { Sched s; s.so.init(256, 256, 1, 0); s.mode = 1; s.pm = pm; s.pn = pn; s.has = has; return s; }

#include <hip/hip_bf16.h>
#include <cmath>
namespace ab {
using bf16=__hip_bfloat16;
using bf16x8=__attribute__((ext_vector_type(8)))short;
using s16x4=__attribute__((ext_vector_type(4)))short;
using f32x16=__attribute__((ext_vector_type(16)))float;
using u32x4=__attribute__((ext_vector_type(4)))unsigned;
using f32x4v=__attribute__((ext_vector_type(4)))float;
constexpr int D=64,PIN=NPROJ;
constexpr int NW=8,QBLK=32,QB=QBLK*NW,KVBLK=64;
__device__ __forceinline__ int crow(int r,int hi){return (r&3)+8*(r>>2)+4*hi;}
#define SBAR() __builtin_amdgcn_sched_barrier(0)
__device__ __forceinline__ void cmask(f32x16&p0,f32x16&p1,int jb,int qrel,int hi){
  const float NEG=-INFINITY; int kb=64*jb+4*hi;
  #pragma unroll
  for(int r=0;r<16;++r){int kv=kb+(r&3)+8*(r>>2); if(kv>qrel)p0[r]=NEG; if(kv+32>qrel)p1[r]=NEG;}
}

__device__ __forceinline__ void kmask(f32x16&p0,f32x16&p1,int jb,int wid){
  if(jb>(wid>>1)){const float NEG=-INFINITY;
  #pragma unroll
  for(int r=0;r<16;++r){p0[r]=NEG;p1[r]=NEG;}}
}

constexpr int NSLOT=4, SLOTB=8192;
constexpr int LDS_K=0, LDS_V=NSLOT*SLOTB, LDS_WS=2*NSLOT*SLOTB, LDS_OST=LDS_WS+NW*64*4, LDS_BIAS=LDS_OST+NW*4096, LDS_BYTES=LDS_BIAS+32768;
__device__ __forceinline__ void glds16(const void*gsrc,unsigned lds_dst){unsigned keep;
  asm volatile("s_mov_b32 %0, m0\n\ts_mov_b32 m0, %2\n\ts_nop 0\n\tglobal_load_lds_dwordx4 %1, off\n\ts_mov_b32 m0, %0":"=&s"(keep):"v"(gsrc),"s"(lds_dst):"memory");}
__device__ __forceinline__ float max3f(float a,float b,float c){float r;asm("v_max3_f32 %0, %1, %2, %3":"=v"(r):"v"(a),"v"(b),"v"(c));return r;}
__device__ __forceinline__ float max2f(float a,float b){float r;asm("v_max_f32_e32 %0, %1, %2":"=v"(r):"v"(a),"v"(b));return r;}
__device__ __forceinline__ float fadd_s(float a,float b){float r;asm("v_add_f32_e32 %0, %1, %2":"=v"(r):"v"(a),"v"(b));return r;}
__device__ __forceinline__ float fsub_s(float a,float b){float r;asm("v_sub_f32_e32 %0, %1, %2":"=v"(r):"v"(a),"v"(b));return r;}
typedef float f32x2_t __attribute__((ext_vector_type(2))); typedef __bf16 bf16x2_t __attribute__((ext_vector_type(2)));
__device__ __forceinline__ unsigned cvtpk_s(float lo,float hi){f32x2_t v={lo,hi};bf16x2_t b=__builtin_convertvector(v,bf16x2_t);return __builtin_bit_cast(unsigned,b);}
#define WAIT_BAR(N) asm volatile("s_waitcnt vmcnt(" #N ") lgkmcnt(0)\n\ts_barrier":::"memory")

__device__ __forceinline__ void qkt(f32x16&p0,f32x16&p1,const char*Kslot,const bf16x8*qr,const f32x16&negm,int r32,int hi){
  const char*kb=Kslot+hi*1024+r32*16;
  #pragma unroll
  for(int d0=0;d0<4;++d0){
    const bf16x8 b0=*reinterpret_cast<const bf16x8*>(kb+d0*2048);
    const bf16x8 b1=*reinterpret_cast<const bf16x8*>(kb+d0*2048+512);
    if(d0==0){p0=__builtin_amdgcn_mfma_f32_32x32x16_bf16(b0,qr[0],negm,0,0,0);p1=__builtin_amdgcn_mfma_f32_32x32x16_bf16(b1,qr[0],negm,0,0,0);}
    else{p0=__builtin_amdgcn_mfma_f32_32x32x16_bf16(b0,qr[d0],p0,0,0,0);p1=__builtin_amdgcn_mfma_f32_32x32x16_bf16(b1,qr[d0],p1,0,0,0);}}
}
typedef __attribute__((address_space(3))) const char* lds_cptr;
typedef short v4i16_t __attribute__((ext_vector_type(4)));
__device__ __forceinline__ void kload8(bf16x8*kf,lds_cptr kp){
  kf[0]=*(const __attribute__((address_space(3))) bf16x8*)(kp);      kf[1]=*(const __attribute__((address_space(3))) bf16x8*)(kp+512);
  kf[2]=*(const __attribute__((address_space(3))) bf16x8*)(kp+2048); kf[3]=*(const __attribute__((address_space(3))) bf16x8*)(kp+2560);
  kf[4]=*(const __attribute__((address_space(3))) bf16x8*)(kp+4096); kf[5]=*(const __attribute__((address_space(3))) bf16x8*)(kp+4608);
  kf[6]=*(const __attribute__((address_space(3))) bf16x8*)(kp+6144); kf[7]=*(const __attribute__((address_space(3))) bf16x8*)(kp+6656);
}
__device__ __forceinline__ void kload2(bf16x8*kf,lds_cptr kp,int j){ kf[2*j]=*(const __attribute__((address_space(3))) bf16x8*)(kp+j*2048); kf[2*j+1]=*(const __attribute__((address_space(3))) bf16x8*)(kp+j*2048+512); }
__device__ __forceinline__ s16x4 vtr(lds_cptr p){ return __builtin_bit_cast(s16x4,__builtin_amdgcn_ds_read_tr16_b64_v4i16((__attribute__((address_space(3))) v4i16_t*)p)); }
__device__ __forceinline__ float rowmax(const f32x16&p0,const f32x16&p1){
  float a=max3f(p0[0],p0[1],p1[0]),b=max3f(p0[2],p0[3],p1[1]);a=max3f(a,p1[2],p1[3]);
  #pragma unroll
  for(int r=4;r<16;r+=4){a=max3f(a,p0[r],p0[r+1]);b=max3f(b,p0[r+2],p0[r+3]);a=max3f(a,p1[r],p1[r+1]);b=max3f(b,p1[r+2],p1[r+3]);}
  const float m=max2f(a,b);
  auto rr=__builtin_amdgcn_permlane32_swap(__float_as_uint(m),__float_as_uint(m),false,false);
  return max2f(__uint_as_float(rr[0]),__uint_as_float(rr[1]));
}
__device__ __forceinline__ void pv(f32x16*o,int vb,bf16x8 pa0,bf16x8 pa1,bf16x8 pa2,bf16x8 pa3){
  #pragma unroll
  for(int d0=0;d0<2;++d0){s16x4 lo[4],hi[4];
    #pragma unroll
    for(int ks=0;ks<4;++ks){
      asm volatile("ds_read_b64_tr_b16 %0,%1 offset:%c2":"=&v"(lo[ks]):"v"(vb),"i"(d0*4096+ks*1024):"memory");
      asm volatile("ds_read_b64_tr_b16 %0,%1 offset:%c2":"=&v"(hi[ks]):"v"(vb),"i"(d0*4096+ks*1024+512):"memory");}
    asm volatile("s_waitcnt lgkmcnt(0)":::"memory");SBAR();
    #define PK(k) (bf16x8){lo[k][0],lo[k][1],lo[k][2],lo[k][3],hi[k][0],hi[k][1],hi[k][2],hi[k][3]}
    o[d0]=__builtin_amdgcn_mfma_f32_32x32x16_bf16(pa0,PK(0),o[d0],0,0,0);
    o[d0]=__builtin_amdgcn_mfma_f32_32x32x16_bf16(pa1,PK(1),o[d0],0,0,0);
    o[d0]=__builtin_amdgcn_mfma_f32_32x32x16_bf16(pa2,PK(2),o[d0],0,0,0);
    o[d0]=__builtin_amdgcn_mfma_f32_32x32x16_bf16(pa3,PK(3),o[d0],0,0,0);
    #undef PK
  }
}

#ifndef ATTN_STORE16
#define ATTN_STORE16(p,v) (*(u32x4*)(p)=(v))
#endif
__device__ __forceinline__ void split3(float x,float&h,float&m,float&l){
  h=__uint_as_float(cvtpk_s(x,0.f)<<16); const float r1=x-h; m=__uint_as_float(cvtpk_s(r1,0.f)<<16); const float r2=r1-m; l=__uint_as_float(cvtpk_s(r2,0.f)<<16);
}
template<int THRL,int MASK,bool BIAS,bool WT> __device__ __forceinline__ void attn_unit(int qb,const bf16*Qh,const bf16*__restrict__ Kh,const bf16*__restrict__ Vh,bf16*Oh,int opitch,const float*__restrict__ biasg,char*shm){
  int tid_=threadIdx.x; asm volatile("":"+v"(tid_));
  const int tid=tid_,lane=tid&63,r32=lane&31,hi=lane>>5; const int wid=__builtin_amdgcn_readfirstlane(tid>>6);
  const int q0=qb*QB;
  const bf16*Qw=Qh+(long)(q0+wid*QBLK)*PIN;
  const unsigned lds0=(unsigned)(uintptr_t)shm;
  float*wsf=(float*)(shm+LDS_WS)+wid*64;
  const bf16*ksrc=Kh+(long)lane*PIN+wid*8;
  const bf16*vsrc=Vh+(long)(16*(wid&3)+(lane>>2))*PIN+(wid>>2)*32+(lane&3)*8;
  const unsigned kdst=lds0+LDS_K+wid*1024, vdst=lds0+LDS_V+wid*1024;
  #define DMA_K(t,slot) glds16(ksrc+(long)(t)*KVBLK*PIN,(unsigned)__builtin_amdgcn_readfirstlane(kdst+(slot)))
  #define DMA_V(t,slot) glds16(vsrc+(long)(t)*KVBLK*PIN,(unsigned)__builtin_amdgcn_readfirstlane(vdst+(slot)))
  const int vb0=(int)(lds0+LDS_V)+((lane>>4)&1)*32+(lane&3)*8+(4*hi+((lane&15)>>2))*64;
  const char*Kbase=shm+LDS_K; bf16x8 kf[8];
  const lds_cptr shm3=(lds_cptr)shm; const lds_cptr kp0=shm3+LDS_K+hi*1024+r32*16; const lds_cptr vp0=shm3+LDS_V+((lane>>4)&1)*32+(lane&3)*8+(4*hi+((lane&15)>>2))*64;
  const int NT=(q0+QB)/KVBLK;
  DMA_K(0,0);DMA_V(0,0);DMA_K(1,SLOTB);
  if(BIAS){ int t2=tid; asm volatile("":"+v"(t2)); if(t2<NT*16){ const f32x4v bv=*reinterpret_cast<const f32x4v*>(biasg+t2*4);
      _Pragma("unroll") for(int e_=0;e_<4;++e_){ float h_,m_,l_; split3(bv[e_],h_,m_,l_); u32x4 w_; w_.x=cvtpk_s(h_,m_); w_.y=cvtpk_s(l_,1.f); w_.z=0x3F803F80u; w_.w=0u; *reinterpret_cast<u32x4*>(shm+LDS_BIAS+(t2*4+e_)*16)=w_; } } }
  u32x4 mfr; mfr.x=hi?0u:0x3F803F80u; mfr.y=hi?0u:0x00003F80u; mfr.z=0u; mfr.w=0u;
  #define MFR_UPDATE() do{ if(BIAS){ float h_,m_,l_; split3(-mhat,h_,m_,l_); const unsigned y_=cvtpk_s(1.f,h_), z_=cvtpk_s(m_,l_); mfr.y=hi?0u:y_; mfr.z=hi?0u:z_; } }while(0)
  #define MFRB __builtin_bit_cast(bf16x8,mfr)
  const lds_cptr bt0=(lds_cptr)shm+LDS_BIAS+r32*16;
  bf16x8 qr[4];
  #pragma unroll
  for(int d0=0;d0<4;++d0)qr[d0]=*reinterpret_cast<const bf16x8*>(&Qw[(long)r32*PIN+d0*16+hi*8]);
  float mhat=0.f,l_reg=0.f;f32x16 o[2];o[0]=f32x16{};o[1]=f32x16{};f32x16 negm=f32x16{}; if(!BIAS){asm volatile("":"+v"(negm));}
  #define CIN (BIAS?f32x16{}:negm)
  const int qrel=wid*QBLK+r32;
  #define CMASK(P0,P1,t) do{int jb_=(t)-(NT-4); if(jb_>=0){ if(MASK==0)cmask(P0,P1,jb_,qrel,hi); else kmask(P0,P1,jb_,wid); } }while(0)
  bool resc=false;
  #define START(P0,P1) do{ const float rm=rowmax(P0,P1); resc=false; \
    { const float dl=rm; mhat=fadd_s(mhat,dl); \
      _Pragma("unroll") for(int r=0;r<16;++r){P0[r]=fsub_s(P0[r],dl);P1[r]=fsub_s(P1[r],dl);} \
      if(!BIAS){ _Pragma("unroll") for(int r=0;r<16;++r)negm[r]=-mhat; asm volatile("":"+v"(negm)); } MFR_UPDATE(); } \
    _Pragma("unroll") for(int r=0;r<16;++r)P0[r]=__builtin_amdgcn_exp2f(P0[r]); }while(0)
  #define RESC() do{ if(resc){ asm volatile("s_waitcnt lgkmcnt(0)":::"memory"); \
      _Pragma("unroll") for(int d_=0;d_<2;++d_) _Pragma("unroll") for(int r=0;r<16;++r)o[d_][r]*=wsf[crow(r,hi)]; } }while(0)
  f32x16 pA0,pA1,pB0,pB1;
  #define KS(t) ((((t))&3)*SLOTB)
  #define ROT() do{}while(0)
  DMA_K(2,2*SLOTB);DMA_V(1,SLOTB);DMA_K(3,3*SLOTB);
  WAIT_BAR(5);
  qkt(pA0,pA1,Kbase,qr,CIN,r32,hi);
  if(BIAS){ const bf16x8 b0_=*(const __attribute__((address_space(3))) bf16x8*)(bt0), b1_=*(const __attribute__((address_space(3))) bf16x8*)(bt0+512);
    pA0=__builtin_amdgcn_mfma_f32_32x32x16_bf16(b0_,MFRB,pA0,0,0,0); pA1=__builtin_amdgcn_mfma_f32_32x32x16_bf16(b1_,MFRB,pA1,0,0,0); }
  asm volatile("s_nop 15\n\ts_nop 7":"+v"(pA0),"+v"(pA1));CMASK(pA0,pA1,0);
  START(pA0,pA1);
  _Pragma("unroll") for(int r=0;r<16;++r)pA1[r]=__builtin_amdgcn_exp2f(pA1[r]);
  WAIT_BAR(3);
  DMA_K(4,KS(4));DMA_V(2,KS(2));
  kload8(kf,kp0+KS(1));
  WAIT_BAR(4);
  s16x4 vlo[8],vhi[8]; u32x4 pw0,pw1,pw2,pw3;
  #define PKW(P,B) cvtpk_s(P[B],P[B+1])
  #define PAF(k) __builtin_bit_cast(bf16x8,pw##k)
  #define VFR(i) (bf16x8){vlo[i][0],vlo[i][1],vlo[i][2],vlo[i][3],vhi[i][0],vhi[i][1],vhi[i][2],vhi[i][3]}
  #define PIN(x) asm volatile("":"+v"(x))
  #define MX3(a,b,c) __builtin_fmaxf(__builtin_fmaxf((a),(b)),(c))
  #define GAPA(MF,A0,A1,A2,A3,W0,W1,PW) do{ MF; sacc+=A0; sacc+=A1; sacc+=A2; sacc+=A3; PIN(sacc); W0; W1; PIN(PW); SBAR(); }while(0)
  #define EX(v) __builtin_amdgcn_exp2f(v)
  #define GAPB(MF,X,B) do{ MF; X[B]=EX(X[B]); X[B+1]=EX(X[B+1]); X[B+2]=EX(X[B+2]); X[B+3]=EX(X[B+3]); PIN(X); SBAR(); }while(0)
  #define VRD(i) do{ vlo[i]=vtr(vp_+(((i)>>2)*4096+((i)&3)*1024)); vhi[i]=vtr(vp_+(((i)>>2)*4096+((i)&3)*1024+512)); }while(0)
  #define KRD(G,j) do{ if(G){ kload2(kf,kn_,j); SBAR(); } }while(0)
  #define STEP(C0,C1,P0,P1,t,GK,GV,GL) do{ SBAR(); \
    const lds_cptr vp_=vp0+KS((t)-1); const lds_cptr kn_=kp0+KS((t)+1); \
    bf16x8 bb0_,bb1_; if(BIAS){ bb0_=*(const __attribute__((address_space(3))) bf16x8*)(bt0+(t)*1024); bb1_=*(const __attribute__((address_space(3))) bf16x8*)(bt0+(t)*1024+512); } \
    VRD(0); SBAR(); float sacc=(P0[0]+P0[1]); \
    GAPA(C0=__builtin_amdgcn_mfma_f32_32x32x16_bf16(kf[0],qr[0],CIN,0,0,0), P0[2],P0[3],P0[4],P0[5],     pw0[0]=PKW(P0,0), pw0[1]=PKW(P0,2), pw0); \
    VRD(4); SBAR(); GAPA(C1=__builtin_amdgcn_mfma_f32_32x32x16_bf16(kf[1],qr[0],CIN,0,0,0), P0[6],P0[7],P0[8],P0[9],     pw0[2]=PKW(P0,4), pw0[3]=PKW(P0,6), pw0); \
    VRD(1); SBAR(); GAPA(C0=__builtin_amdgcn_mfma_f32_32x32x16_bf16(kf[2],qr[1],C0,0,0,0),   P0[10],P0[11],P0[12],P0[13], pw1[0]=PKW(P0,8), pw1[1]=PKW(P0,10), pw1); \
    VRD(5); SBAR(); GAPA(C1=__builtin_amdgcn_mfma_f32_32x32x16_bf16(kf[3],qr[1],C1,0,0,0),   P0[14],P0[15],P1[0],P1[1],   pw1[2]=PKW(P0,12),pw1[3]=PKW(P0,14), pw1); \
    VRD(2); SBAR(); GAPA(C0=__builtin_amdgcn_mfma_f32_32x32x16_bf16(kf[4],qr[2],C0,0,0,0),   P1[2],P1[3],P1[4],P1[5],     pw2[0]=PKW(P1,0), pw2[1]=PKW(P1,2), pw2); \
    VRD(6); SBAR(); GAPA(C1=__builtin_amdgcn_mfma_f32_32x32x16_bf16(kf[5],qr[2],C1,0,0,0),   P1[6],P1[7],P1[8],P1[9],     pw2[2]=PKW(P1,4), pw2[3]=PKW(P1,6), pw2); \
    VRD(3); SBAR(); GAPA(C0=__builtin_amdgcn_mfma_f32_32x32x16_bf16(kf[6],qr[3],C0,0,0,0),   P1[10],P1[11],P1[12],P1[13], pw3[0]=PKW(P1,8), pw3[1]=PKW(P1,10), pw3); \
    VRD(7); SBAR(); GAPA(C1=__builtin_amdgcn_mfma_f32_32x32x16_bf16(kf[7],qr[3],C1,0,0,0),   P1[14],P1[15],0.f,0.f,       pw3[2]=PKW(P1,12),pw3[3]=PKW(P1,14), pw3); \
    if(BIAS){ C0=__builtin_amdgcn_mfma_f32_32x32x16_bf16(bb0_,MFRB,C0,0,0,0); C1=__builtin_amdgcn_mfma_f32_32x32x16_bf16(bb1_,MFRB,C1,0,0,0); SBAR(); } \
    l_reg+=sacc; \
    if(GK){DMA_K((t)+4,KS((t)+4));} if(GV){DMA_V((t)+2,KS((t)+2));} \
    CMASK(C0,C1,t); \
    { float a=MX3(C0[0],C0[1],C1[0]),b=MX3(C0[2],C0[3],C1[1]); a=MX3(a,C1[2],C1[3]); \
      _Pragma("unroll") for(int r=4;r<16;r+=4){a=MX3(a,C0[r],C0[r+1]);b=MX3(b,C0[r+2],C0[r+3]);a=MX3(a,C1[r],C1[r+1]);b=MX3(b,C1[r+2],C1[r+3]);} \
      float rm=__builtin_fmaxf(a,b); { auto rr=__builtin_amdgcn_permlane32_swap(__float_as_uint(rm),__float_as_uint(rm),false,false); rm=__builtin_fmaxf(__uint_as_float(rr[0]),__uint_as_float(rr[1])); } \
      resc=false; \
      if(__builtin_expect(__any(rm>(float)THRL),0)){ const float dl=__builtin_fmaxf(rm,0.f); mhat+=dl; \
        _Pragma("unroll") for(int r=0;r<16;++r){C0[r]-=dl;C1[r]-=dl;} \
        if(!BIAS){ _Pragma("unroll") for(int r=0;r<16;++r)negm[r]=-mhat; asm volatile("":"+v"(negm)); } MFR_UPDATE(); \
        const float f=__builtin_amdgcn_exp2f(-dl); l_reg*=f; if(hi==0)wsf[r32]=f; resc=true; } } \
    SBAR(); \
    GAPB(o[0]=__builtin_amdgcn_mfma_f32_32x32x16_bf16(PAF(0),VFR(0),o[0],0,0,0), C0,0); \
    GAPB(o[1]=__builtin_amdgcn_mfma_f32_32x32x16_bf16(PAF(0),VFR(4),o[1],0,0,0), C0,4); \
    KRD(GL,0); GAPB(o[0]=__builtin_amdgcn_mfma_f32_32x32x16_bf16(PAF(1),VFR(1),o[0],0,0,0), C0,8); \
    KRD(GL,1); GAPB(o[1]=__builtin_amdgcn_mfma_f32_32x32x16_bf16(PAF(1),VFR(5),o[1],0,0,0), C0,12); \
    KRD(GL,2); GAPB(o[0]=__builtin_amdgcn_mfma_f32_32x32x16_bf16(PAF(2),VFR(2),o[0],0,0,0), C1,0); \
    KRD(GL,3); GAPB(o[1]=__builtin_amdgcn_mfma_f32_32x32x16_bf16(PAF(2),VFR(6),o[1],0,0,0), C1,4); \
    GAPB(o[0]=__builtin_amdgcn_mfma_f32_32x32x16_bf16(PAF(3),VFR(3),o[0],0,0,0), C1,8); \
    GAPB(o[1]=__builtin_amdgcn_mfma_f32_32x32x16_bf16(PAF(3),VFR(7),o[1],0,0,0), C1,12); \
    }while(0)
  int t=1;
  #undef CMASK
  #define CMASK(P0,P1,t) do{}while(0)
  for(;t+5<NT;t+=2){
    STEP(pB0,pB1,pA0,pA1,t,true,true,true);     WAIT_BAR(4); RESC(); ROT();
    STEP(pA0,pA1,pB0,pB1,t+1,true,true,true);   WAIT_BAR(4); RESC(); ROT();
  }
  #undef CMASK
  #define CMASK(P0,P1,t) do{int jb_=(t)-(NT-4); if(jb_>=0){ if(MASK==0)cmask(P0,P1,jb_,qrel,hi); else kmask(P0,P1,jb_,wid); } }while(0)
  #define ENDW(tt) do{ const int n_=((tt)+2>=NT)?0:((int)((tt)+3<NT)+(int)((tt)+1<NT)+(int)((tt)+4<NT)+(int)((tt)+2<NT)); if(n_>=4){WAIT_BAR(4);} else if(n_==3){WAIT_BAR(3);} else if(n_==2){WAIT_BAR(2);} else if(n_==1){WAIT_BAR(1);} else {WAIT_BAR(0);} }while(0)
  for(;t+1<NT;t+=2){
    STEP(pB0,pB1,pA0,pA1,t,(t+4<NT),(t+2<NT),(t+1<NT));       ENDW(t);   RESC(); ROT();
    STEP(pA0,pA1,pB0,pB1,t+1,(t+5<NT),(t+3<NT),(t+2<NT));     ENDW(t+1); RESC(); ROT();
  }
  STEP(pB0,pB1,pA0,pA1,NT-1,false,false,false); RESC();
  { float sacc=pB0[0]+pB0[1]; _Pragma("unroll") for(int r=2;r<16;++r)sacc+=pB0[r]; _Pragma("unroll") for(int r=0;r<16;++r)sacc+=pB1[r]; l_reg+=sacc;
    pw0=(u32x4){PKW(pB0,0),PKW(pB0,2),PKW(pB0,4),PKW(pB0,6)};pw1=(u32x4){PKW(pB0,8),PKW(pB0,10),PKW(pB0,12),PKW(pB0,14)};pw2=(u32x4){PKW(pB1,0),PKW(pB1,2),PKW(pB1,4),PKW(pB1,6)};pw3=(u32x4){PKW(pB1,8),PKW(pB1,10),PKW(pB1,12),PKW(pB1,14)};
    SBAR(); pv(o,vb0+KS(NT-1),PAF(0),PAF(1),PAF(2),PAF(3)); }
  #undef PKW
  #undef PAF
  #undef VFR
  #undef PIN
  #undef MX3
  #undef GAPA
  #undef GAPB
  #undef EX
  #undef VRD
  #undef KRD
  #undef STEP
  #undef ENDW
  {auto rr=__builtin_amdgcn_permlane32_swap(__float_as_uint(l_reg),__float_as_uint(l_reg),false,false);l_reg=__uint_as_float(rr[0])+__uint_as_float(rr[1]);}
  if(hi==0)wsf[32+r32]=l_reg;asm volatile("s_waitcnt lgkmcnt(0)":::"memory");
  float rli[16];
  #pragma unroll
  for(int r=0;r<16;++r)rli[r]=__builtin_amdgcn_rcpf(wsf[32+crow(r,hi)]);
  bf16*Ow=Oh+(long)(q0+wid*QBLK)*opitch;
  { bf16*stg=(bf16*)(shm+LDS_OST)+wid*2048;
    #pragma unroll
    for(int r=0;r<16;++r){const int orow=crow(r,hi);
      #pragma unroll
      for(int d0=0;d0<2;++d0)stg[orow*64+d0*32+r32]=__float2bfloat16(o[d0][r]*rli[r]);}
    asm volatile("s_waitcnt lgkmcnt(0)":::"memory");
    if(WT){ const __amdgpu_buffer_rsrc_t rs_=__builtin_amdgcn_make_buffer_rsrc((void*)Oh,(short)0,0x7fffffff,0x00020000);
      #pragma unroll
      for(int i=0;i<4;++i){const int row=i*8+(lane>>3),ch=lane&7; const u32x4 v=*(const u32x4*)(stg+row*64+ch*8); __builtin_amdgcn_raw_buffer_store_b128(v,rs_,(int)(((long)(q0+wid*QBLK+row)*opitch+ch*8)*2),0,16);} }
    else{
    #pragma unroll
    for(int i=0;i<4;++i){const int row=i*8+(lane>>3),ch=lane&7; const u32x4 v=*(const u32x4*)(stg+row*64+ch*8); ATTN_STORE16(Ow+(long)row*opitch+ch*8,v);} } }
  asm volatile("s_waitcnt lgkmcnt(0)\n\ts_barrier":::"memory");
  #undef DMA_K
  #undef DMA_V
  #undef CMASK
  #undef CIN
  #undef MFR_UPDATE
  #undef MFRB
  #undef START
  #undef RESC
  #undef ROT
  #undef KS
}
constexpr int ATTN_LDS_BYTES=LDS_BYTES;
#undef SBAR
#undef WAIT_BAR
}
#define SBAR() __builtin_amdgcn_sched_barrier(0)
namespace ab {
constexpr int B_LK=0, B_LV=24576, B_VSLOT=16384, B_LP=90112, B_LW=122880, B_LST=124928, B_LSS=157696, B_LDS_BYTES=158720;
typedef __attribute__((address_space(3))) unsigned char* ldsb;

template<int THRL> __device__ __forceinline__ void diff_pass_A(int rblk,const bf16*Qh,const bf16*__restrict__ Kh,const bf16*__restrict__ Vh,char*shm,f32x16(&o)[2],float(&rli)[16]){
  int tid_=threadIdx.x; asm volatile("":"+v"(tid_));
  const int tid=tid_,lane=tid&63,r32=lane&31,hi=lane>>5; const int wid=__builtin_amdgcn_readfirstlane(tid>>6);
  const int rb=wid&3;
  const int q0=rblk*128;
  const bf16*Qw=Qh+(long)(q0+rb*QBLK)*PIN;
  const unsigned lds0=(unsigned)(uintptr_t)shm;
  const ldsb L=(ldsb)shm;
  volatile __attribute__((address_space(3))) float*wf=(volatile __attribute__((address_space(3))) float*)(L+B_LW+rb*512);
  const bf16*ksrc=Kh+(long)lane*PIN+wid*8;
  const bf16*vsrc0=Vh+(long)(16*((2*wid)&3)+(lane>>2))*PIN+(wid>>1)*32+(lane&3)*8;
  const bf16*vsrc1=Vh+(long)(16*((2*wid+1)&3)+(lane>>2))*PIN+(wid>>1)*32+(lane&3)*8;
  const unsigned kdst=lds0+B_LK+wid*1024, vdst=lds0+B_LV+wid*2048;
  #define DMA_K(t,slot) glds16(ksrc+(long)(t)*KVBLK*PIN,(unsigned)__builtin_amdgcn_readfirstlane(kdst+(slot)))
  #define VS(t) ((((t))&3)*B_VSLOT)
  #define DMA_V(t) do{ glds16(vsrc0+(long)(t)*KVBLK*PIN,(unsigned)__builtin_amdgcn_readfirstlane(vdst+VS(t))); glds16(vsrc1+(long)(t)*KVBLK*PIN,(unsigned)__builtin_amdgcn_readfirstlane(vdst+VS(t)+1024)); }while(0)
  const int vb0=(int)(lds0+B_LV)+((lane>>4)&1)*32+(lane&3)*8+(4*hi+((lane&15)>>2))*64;
  const char*Kbase=shm+B_LK; bf16x8 kf[8];
  const lds_cptr shm3=(lds_cptr)shm; const lds_cptr kp0=shm3+B_LK+hi*1024+r32*16; const lds_cptr vp0=shm3+B_LV+((lane>>4)&1)*32+(lane&3)*8+(4*hi+((lane&15)>>2))*64;
  const ldsb pbase=L+B_LP+rb*8192+lane*16;
  const int NT=(2*rblk+2)<4?4:(2*rblk+2);
  const int lim=2*rblk+(rb>>1);
  DMA_K(0,0);DMA_V(0);DMA_K(1,SLOTB);
  bf16x8 qr[4];
  #pragma unroll
  for(int d0=0;d0<4;++d0)qr[d0]=*reinterpret_cast<const bf16x8*>(&Qw[(long)r32*PIN+d0*16+hi*8]);
  float mhat=0.f,l_reg=0.f;o[0]=f32x16{};o[1]=f32x16{};f32x16 negm=f32x16{}; asm volatile("":"+v"(negm));
  #define CMASK(P0,P1,t) do{ if((t)>=NT-4){ if((t)>lim){ const float NEG_=-INFINITY; _Pragma("unroll") for(int r_=0;r_<16;++r_){P0[r_]=NEG_;P1[r_]=NEG_;} } } }while(0)
  bool resc=false;
  #define START(P0,P1) do{ const float rm=rowmax(P0,P1); resc=false; \
    { const float dl=rm; mhat=fadd_s(mhat,dl); \
      _Pragma("unroll") for(int r=0;r<16;++r){P0[r]=fsub_s(P0[r],dl);P1[r]=fsub_s(P1[r],dl);} \
      _Pragma("unroll") for(int r=0;r<16;++r)negm[r]=-mhat; asm volatile("":"+v"(negm)); } \
    _Pragma("unroll") for(int r=0;r<16;++r)P0[r]=__builtin_amdgcn_exp2f(P0[r]); }while(0)
  #define RESC(t) do{ if(resc){ asm volatile("s_waitcnt lgkmcnt(0)":::"memory"); \
      _Pragma("unroll") for(int d_=0;d_<2;++d_) _Pragma("unroll") for(int r=0;r<16;++r)o[d_][r]*=wf[32*((t)&1)+crow(r,hi)]; } }while(0)
  f32x16 pA0,pA1,pB0,pB1;
  int sl_prev=0,sl_cur=0,sl_next=SLOTB;
  #define ROT() do{sl_prev=sl_cur;sl_cur=sl_next;sl_next=(sl_next==2*SLOTB)?0:sl_next+SLOTB;}while(0)
  #define WAIT_BAR(N) asm volatile("s_waitcnt vmcnt(" #N ") lgkmcnt(0)\n\ts_barrier":::"memory")
  DMA_K(2,2*SLOTB);
  WAIT_BAR(3);
  {
    qkt(pA0,pA1,Kbase,qr,negm,r32,hi);
    asm volatile("s_nop 15\n\ts_nop 7":"+v"(pA0),"+v"(pA1));CMASK(pA0,pA1,0);
    START(pA0,pA1);
    _Pragma("unroll") for(int r=0;r<16;++r)pA1[r]=__builtin_amdgcn_exp2f(pA1[r]);
    if(lane==0){wf[96]=0.f;wf[97]=0.f;} }
  WAIT_BAR(0);
  DMA_K(3,0);DMA_V(1);
  ROT();
  kload8(kf,kp0+sl_cur);
  WAIT_BAR(3);
  s16x4 vlo[8],vhi[8]; u32x4 pw0,pw1,pw2,pw3;
  #define PKW(P,B) cvtpk_s(P[B],P[B+1])
  #define PAF(k) __builtin_bit_cast(bf16x8,pw##k)
  #define VFR(i) (bf16x8){vlo[i][0],vlo[i][1],vlo[i][2],vlo[i][3],vhi[i][0],vhi[i][1],vhi[i][2],vhi[i][3]}
  #define PIN(x) asm volatile("":"+v"(x))
  #define MX3(a,b,c) __builtin_fmaxf(__builtin_fmaxf((a),(b)),(c))
  #define GAPA(MF,A0,A1,A2,A3,W0,W1,PW) do{ MF; sacc+=A0; sacc+=A1; sacc+=A2; sacc+=A3; PIN(sacc); W0; W1; PIN(PW); SBAR(); }while(0)
  #define EX(v) __builtin_amdgcn_exp2f(v)
  #define GAPB(MF,X,B) do{ MF; X[B]=EX(X[B]); X[B+1]=EX(X[B+1]); X[B+2]=EX(X[B+2]); X[B+3]=EX(X[B+3]); PIN(X); SBAR(); }while(0)
  #define VRD(i) do{ vlo[i]=vtr(vp_+(((i)>>2)*4096+((i)&3)*1024)); vhi[i]=vtr(vp_+(((i)>>2)*4096+((i)&3)*1024+512)); }while(0)
  #define KRD(G,j) do{ if(G){ kload2(kf,kp0+sl_next,j); SBAR(); } }while(0)
  #define PST(k,slot) (*(__attribute__((address_space(3))) u32x4*)(pbase+(slot)*4096+(k)*1024))
  #define STEP_A(C0,C1,P0,P1,t,GK,GV,GL) do{ SBAR(); \
    const lds_cptr vp_=vp0+VS((t)-1); \
    VRD(0); SBAR(); float sacc=(P0[0]+P0[1]); \
    GAPA(C0=__builtin_amdgcn_mfma_f32_32x32x16_bf16(kf[0],qr[0],negm,0,0,0), P0[2],P0[3],P0[4],P0[5],     pw0[0]=PKW(P0,0), pw0[1]=PKW(P0,2), pw0); \
    VRD(4); SBAR(); GAPA(C1=__builtin_amdgcn_mfma_f32_32x32x16_bf16(kf[1],qr[0],negm,0,0,0), P0[6],P0[7],P0[8],P0[9],     pw0[2]=PKW(P0,4), pw0[3]=PKW(P0,6), pw0); \
    VRD(1); SBAR(); GAPA(C0=__builtin_amdgcn_mfma_f32_32x32x16_bf16(kf[2],qr[1],C0,0,0,0),   P0[10],P0[11],P0[12],P0[13], pw1[0]=PKW(P0,8), pw1[1]=PKW(P0,10), pw1); \
    VRD(5); SBAR(); GAPA(C1=__builtin_amdgcn_mfma_f32_32x32x16_bf16(kf[3],qr[1],C1,0,0,0),   P0[14],P0[15],P1[0],P1[1],   pw1[2]=PKW(P0,12),pw1[3]=PKW(P0,14), pw1); \
    VRD(2); SBAR(); GAPA(C0=__builtin_amdgcn_mfma_f32_32x32x16_bf16(kf[4],qr[2],C0,0,0,0),   P1[2],P1[3],P1[4],P1[5],     pw2[0]=PKW(P1,0), pw2[1]=PKW(P1,2), pw2); \
    VRD(6); SBAR(); GAPA(C1=__builtin_amdgcn_mfma_f32_32x32x16_bf16(kf[5],qr[2],C1,0,0,0),   P1[6],P1[7],P1[8],P1[9],     pw2[2]=PKW(P1,4), pw2[3]=PKW(P1,6), pw2); \
    VRD(3); SBAR(); GAPA(C0=__builtin_amdgcn_mfma_f32_32x32x16_bf16(kf[6],qr[3],C0,0,0,0),   P1[10],P1[11],P1[12],P1[13], pw3[0]=PKW(P1,8), pw3[1]=PKW(P1,10), pw3); \
    VRD(7); SBAR(); GAPA(C1=__builtin_amdgcn_mfma_f32_32x32x16_bf16(kf[7],qr[3],C1,0,0,0),   P1[14],P1[15],0.f,0.f,       pw3[2]=PKW(P1,12),pw3[3]=PKW(P1,14), pw3); \
    PST(0,(t)&1)=pw0; PST(1,(t)&1)=pw1; PST(2,(t)&1)=pw2; PST(3,(t)&1)=pw3; \
    l_reg+=sacc; \
    if(GK){DMA_K((t)+3,sl_cur);} if(GV){DMA_V((t)+1);} \
    CMASK(C0,C1,t); \
    { float a=MX3(C0[0],C0[1],C1[0]),b=MX3(C0[2],C0[3],C1[1]); a=MX3(a,C1[2],C1[3]); \
      _Pragma("unroll") for(int r=4;r<16;r+=4){a=MX3(a,C0[r],C0[r+1]);b=MX3(b,C0[r+2],C0[r+3]);a=MX3(a,C1[r],C1[r+1]);b=MX3(b,C1[r+2],C1[r+3]);} \
      float rm=__builtin_fmaxf(a,b); { auto rr=__builtin_amdgcn_permlane32_swap(__float_as_uint(rm),__float_as_uint(rm),false,false); rm=__builtin_fmaxf(__uint_as_float(rr[0]),__uint_as_float(rr[1])); } \
      resc=false; \
      if(__builtin_expect(__any(rm>(float)THRL),0)){ const float dl=__builtin_fmaxf(rm,0.f); mhat+=dl; \
        _Pragma("unroll") for(int r=0;r<16;++r){C0[r]-=dl;C1[r]-=dl;} \
        _Pragma("unroll") for(int r=0;r<16;++r)negm[r]=-mhat; asm volatile("":"+v"(negm)); \
        const float f=__builtin_amdgcn_exp2f(-dl); l_reg*=f; if(hi==0)wf[32*((t)&1)+r32]=f; resc=true; } \
      if(lane==0)wf[96+((t)&1)]=resc?1.f:0.f; } \
    SBAR(); \
    GAPB(o[0]=__builtin_amdgcn_mfma_f32_32x32x16_bf16(PAF(0),VFR(0),o[0],0,0,0), C0,0); \
    GAPB(o[1]=__builtin_amdgcn_mfma_f32_32x32x16_bf16(PAF(0),VFR(4),o[1],0,0,0), C0,4); \
    KRD(GL,0); GAPB(o[0]=__builtin_amdgcn_mfma_f32_32x32x16_bf16(PAF(1),VFR(1),o[0],0,0,0), C0,8); \
    KRD(GL,1); GAPB(o[1]=__builtin_amdgcn_mfma_f32_32x32x16_bf16(PAF(1),VFR(5),o[1],0,0,0), C0,12); \
    KRD(GL,2); GAPB(o[0]=__builtin_amdgcn_mfma_f32_32x32x16_bf16(PAF(2),VFR(2),o[0],0,0,0), C1,0); \
    KRD(GL,3); GAPB(o[1]=__builtin_amdgcn_mfma_f32_32x32x16_bf16(PAF(2),VFR(6),o[1],0,0,0), C1,4); \
    GAPB(o[0]=__builtin_amdgcn_mfma_f32_32x32x16_bf16(PAF(3),VFR(3),o[0],0,0,0), C1,8); \
    GAPB(o[1]=__builtin_amdgcn_mfma_f32_32x32x16_bf16(PAF(3),VFR(7),o[1],0,0,0), C1,12); \
    }while(0)
  #define STEP(C0,C1,P0,P1,t,GK,GV,GL) STEP_A(C0,C1,P0,P1,t,GK,GV,GL)
  int t=1;
  #undef CMASK
  #define CMASK(P0,P1,t) do{}while(0)
  for(;t+5<NT;t+=2){
    STEP(pB0,pB1,pA0,pA1,t,true,true,true);     WAIT_BAR(3); RESC(t); ROT();
    STEP(pA0,pA1,pB0,pB1,t+1,true,true,true);   WAIT_BAR(3); RESC(t+1); ROT();
  }
  #undef CMASK
  #define CMASK(P0,P1,t) do{ if((t)>=NT-4){ if((t)>lim){ const float NEG_=-INFINITY; _Pragma("unroll") for(int r_=0;r_<16;++r_){P0[r_]=NEG_;P1[r_]=NEG_;} } } }while(0)
  #define ENDW(tt) do{ if((tt)+3<NT){WAIT_BAR(3);} else if((tt)+2<NT){WAIT_BAR(2);} else {WAIT_BAR(0);} }while(0)
  for(;t+1<NT;t+=2){
    STEP(pB0,pB1,pA0,pA1,t,(t+3<NT),(t+1<NT),(t+1<NT));       ENDW(t);   RESC(t); ROT();
    STEP(pA0,pA1,pB0,pB1,t+1,(t+4<NT),(t+2<NT),(t+2<NT));     ENDW(t+1); RESC(t+1); ROT();
  }
  STEP(pB0,pB1,pA0,pA1,NT-1,false,false,false); WAIT_BAR(0); RESC(NT-1);
  { float sacc=pB0[0]+pB0[1]; _Pragma("unroll") for(int r=2;r<16;++r)sacc+=pB0[r]; _Pragma("unroll") for(int r=0;r<16;++r)sacc+=pB1[r]; l_reg+=sacc;
    pw0=(u32x4){PKW(pB0,0),PKW(pB0,2),PKW(pB0,4),PKW(pB0,6)};pw1=(u32x4){PKW(pB0,8),PKW(pB0,10),PKW(pB0,12),PKW(pB0,14)};pw2=(u32x4){PKW(pB1,0),PKW(pB1,2),PKW(pB1,4),PKW(pB1,6)};pw3=(u32x4){PKW(pB1,8),PKW(pB1,10),PKW(pB1,12),PKW(pB1,14)};
    PST(0,NT&1)=pw0; PST(1,NT&1)=pw1; PST(2,NT&1)=pw2; PST(3,NT&1)=pw3;
    {auto rr=__builtin_amdgcn_permlane32_swap(__float_as_uint(l_reg),__float_as_uint(l_reg),false,false);l_reg=__uint_as_float(rr[0])+__uint_as_float(rr[1]);}
    if(hi==0)wf[64+r32]=l_reg;
    SBAR(); pv(o,vb0+VS(NT-1),PAF(0),PAF(1),PAF(2),PAF(3)); }
  WAIT_BAR(0);
  #pragma unroll
  for(int r=0;r<16;++r)rli[r]=__builtin_amdgcn_rcpf(wf[64+crow(r,hi)]);
  asm volatile("s_waitcnt lgkmcnt(0)\n\ts_barrier":::"memory");
  #undef PKW
  #undef PAF
  #undef VFR
  #undef PIN
  #undef MX3
  #undef GAPA
  #undef GAPB
  #undef EX
  #undef VRD
  #undef KRD
  #undef PST
  #undef STEP_A
  #undef STEP
  #undef ENDW
  #undef DMA_K
  #undef DMA_V
  #undef VS
  #undef CMASK
  #undef START
  #undef RESC
  #undef ROT
  #undef WAIT_BAR
}
template<int THRL> __device__ __forceinline__ void diff_pass_B(int rblk,const bf16*__restrict__ Kh,const bf16*__restrict__ Vh,char*shm,f32x16(&o)[2],float(&rli)[16]){
  int tid_=threadIdx.x; asm volatile("":"+v"(tid_));
  const int tid=tid_,lane=tid&63,hi=lane>>5; const int wid=__builtin_amdgcn_readfirstlane(tid>>6);
  const int rb=wid&3;
  const unsigned lds0=(unsigned)(uintptr_t)shm;
  const ldsb L=(ldsb)shm;
  volatile __attribute__((address_space(3))) float*wf=(volatile __attribute__((address_space(3))) float*)(L+B_LW+rb*512);
  const bf16*ksrc=Kh+(long)lane*PIN+wid*8;
  const bf16*vsrc0=Vh+(long)(16*((2*wid)&3)+(lane>>2))*PIN+(wid>>1)*32+(lane&3)*8;
  const bf16*vsrc1=Vh+(long)(16*((2*wid+1)&3)+(lane>>2))*PIN+(wid>>1)*32+(lane&3)*8;
  const unsigned kdst=lds0+B_LK+wid*1024, vdst=lds0+B_LV+wid*2048;
  #define DMA_K(t,slot) glds16(ksrc+(long)(t)*KVBLK*PIN,(unsigned)__builtin_amdgcn_readfirstlane(kdst+(slot)))
  #define VS(t) ((((t))&3)*B_VSLOT)
  #define DMA_V(t) do{ glds16(vsrc0+(long)(t)*KVBLK*PIN,(unsigned)__builtin_amdgcn_readfirstlane(vdst+VS(t))); glds16(vsrc1+(long)(t)*KVBLK*PIN,(unsigned)__builtin_amdgcn_readfirstlane(vdst+VS(t)+1024)); }while(0)
  #define WAIT_BAR(N) asm volatile("s_waitcnt vmcnt(" #N ") lgkmcnt(0)\n\ts_barrier":::"memory")
  const int vb0=(int)(lds0+B_LV)+8192+((lane>>4)&1)*32+(lane&3)*8+(4*hi+((lane&15)>>2))*64;
  const ldsb pbase=L+B_LP+rb*8192+lane*16;
  const int NT=(2*rblk+2)<4?4:(2*rblk+2);
  o[0]=f32x16{};o[1]=f32x16{};
  int sl_cur=0,sl_next=SLOTB;
  #define ROT() do{sl_cur=sl_next;sl_next=(sl_next==2*SLOTB)?0:sl_next+SLOTB;}while(0)
  #define PVB(tp,ps,fpar) do{ \
    const bf16x8 pa0_=*(const __attribute__((address_space(3))) bf16x8*)(pbase+(ps)*4096), pa1_=*(const __attribute__((address_space(3))) bf16x8*)(pbase+(ps)*4096+1024), \
                 pa2_=*(const __attribute__((address_space(3))) bf16x8*)(pbase+(ps)*4096+2048), pa3_=*(const __attribute__((address_space(3))) bf16x8*)(pbase+(ps)*4096+3072); \
    pv(o,vb0+VS(tp),pa0_,pa1_,pa2_,pa3_); \
    if((fpar)>=0){ if(wf[96+((fpar)&1)]!=0.f){ _Pragma("unroll") for(int d_=0;d_<2;++d_) _Pragma("unroll") for(int r=0;r<16;++r)o[d_][r]*=wf[32*((fpar)&1)+crow(r,hi)]; } } }while(0)
  #define STEP(t,GK,GV) do{ if((t)>=2){ PVB((t)-2,((t)-1)&1,(t)-1); } if(GK){DMA_K((t)+3,sl_cur);} if(GV){DMA_V((t)+1);} }while(0)
  DMA_K(0,0);DMA_V(0);DMA_K(1,SLOTB);
  DMA_K(2,2*SLOTB);
  WAIT_BAR(3);
  WAIT_BAR(0);
  DMA_K(3,0);DMA_V(1);
  ROT();
  WAIT_BAR(3);
  int t=1;
  for(;t+5<NT;t+=2){
    STEP(t,true,true);     WAIT_BAR(3); ROT();
    STEP(t+1,true,true);   WAIT_BAR(3); ROT();
  }
  #define ENDW(tt) do{ if((tt)+3<NT){WAIT_BAR(3);} else if((tt)+2<NT){WAIT_BAR(2);} else {WAIT_BAR(0);} }while(0)
  for(;t+1<NT;t+=2){
    STEP(t,(t+3<NT),(t+1<NT));       ENDW(t);   ROT();
    STEP(t+1,(t+4<NT),(t+2<NT));     ENDW(t+1); ROT();
  }
  STEP(NT-1,false,false); WAIT_BAR(0);
  PVB(NT-2,(NT-1)&1,NT-1);
  WAIT_BAR(0);
  PVB(NT-1,NT&1,-1);
  #pragma unroll
  for(int r=0;r<16;++r)rli[r]=__builtin_amdgcn_rcpf(wf[64+crow(r,hi)]);
  asm volatile("s_waitcnt lgkmcnt(0)\n\ts_barrier":::"memory");
  #undef DMA_K
  #undef DMA_V
  #undef VS
  #undef WAIT_BAR
  #undef ROT
  #undef PVB
  #undef STEP
  #undef ENDW
}
template<int THRL> __device__ __forceinline__ void diff_unit_ab(int rblk,const bf16*Qh,const bf16*Kh,const bf16*Vh,bf16_t*ATTh,const float*subw,float lam,char*shm){
  int lane_=threadIdx.x&63; asm volatile("":"+v"(lane_));
  const int lane=lane_,r32=lane&31,hi=lane>>5; const int wid=__builtin_amdgcn_readfirstlane((int)(threadIdx.x>>6)); const int rb=wid&3,hf=wid>>2;
  const ldsb L=(ldsb)shm;
  __attribute__((address_space(3))) bf16_t*stg=(__attribute__((address_space(3))) bf16_t*)(L+B_LST+wid*4096);
  f32x16 o[2]; float rli[16];
  if(wid<4)diff_pass_A<THRL>(rblk,Qh,Kh,Vh,shm,o,rli); else diff_pass_B<THRL>(rblk,Kh,Vh,shm,o,rli);
  #pragma unroll
  for(int r=0;r<16;++r){const int orow=crow(r,hi);
    #pragma unroll
    for(int d0=0;d0<2;++d0)stg[orow*64+d0*32+r32]=(bf16_t)(cvtpk_s(o[d0][r]*rli[r],0.f)&0xffffu);}
  if(wid<4)diff_pass_A<THRL>(rblk,Qh+64,Kh+64,Vh,shm,o,rli); else diff_pass_B<THRL>(rblk,Kh+64,Vh,shm,o,rli);
  #pragma unroll
  for(int r=0;r<16;++r){const int orow=crow(r,hi);
    #pragma unroll
    for(int d0=0;d0<2;++d0){ const float o1=__uint_as_float(((unsigned)stg[orow*64+d0*32+r32])<<16); stg[orow*64+d0*32+r32]=(bf16_t)(cvtpk_s(o1-lam*(o[d0][r]*rli[r]),0.f)&0xffffu); } }
  asm volatile("s_waitcnt lgkmcnt(0)":::"memory");
  u32x4 vv[4]; float ssr[4];
  #pragma unroll
  for(int i=0;i<4;++i){ const int row=i*8+(lane>>3),ch=lane&7; vv[i]=*(const __attribute__((address_space(3))) u32x4*)(stg+row*64+ch*8);
    float s=0.f;
    #pragma unroll
    for(int e=0;e<4;++e){ const float a=__uint_as_float(vv[i][e]<<16),b2=__uint_as_float(vv[i][e]&0xffff0000u); s+=a*a+b2*b2; }
    s+=__shfl_xor(s,1); s+=__shfl_xor(s,2); s+=__shfl_xor(s,4); ssr[i]=s;
    if(ch==0)((__attribute__((address_space(3))) float*)(L+B_LSS))[wid*32+row]=s; }
  asm volatile("s_waitcnt lgkmcnt(0)\n\ts_barrier":::"memory");
  #pragma unroll
  for(int i=0;i<4;++i){ const int row=i*8+(lane>>3),ch=lane&7;
    const float tot=ssr[i]+((const __attribute__((address_space(3))) float*)(L+B_LSS))[(wid^4)*32+row];
    const float rstd=rsqrtf(tot*(1.f/128.f)+EPS)*0.8f;
    const f32x4v g0=*reinterpret_cast<const f32x4v*>(subw+64*hf+8*ch), g1=*reinterpret_cast<const f32x4v*>(subw+64*hf+8*ch+4);
    u32x4 w;
    w.x=cvtpk_s(__uint_as_float(vv[i].x<<16)*rstd*g0[0],__uint_as_float(vv[i].x&0xffff0000u)*rstd*g0[1]);
    w.y=cvtpk_s(__uint_as_float(vv[i].y<<16)*rstd*g0[2],__uint_as_float(vv[i].y&0xffff0000u)*rstd*g0[3]);
    w.z=cvtpk_s(__uint_as_float(vv[i].z<<16)*rstd*g1[0],__uint_as_float(vv[i].z&0xffff0000u)*rstd*g1[1]);
    w.w=cvtpk_s(__uint_as_float(vv[i].w<<16)*rstd*g1[2],__uint_as_float(vv[i].w&0xffff0000u)*rstd*g1[3]);
    *reinterpret_cast<u32x4*>(ATTh+(size_t)(rblk*128+rb*32+row)*DM+64*hf+8*ch)=w; }
  asm volatile("s_waitcnt lgkmcnt(0)\n\ts_barrier":::"memory");
}
}
#undef SBAR
__constant__ unsigned short UNIT_Q[8][176] = {
  {0x4000,0x4001,0x4002,0x4003,0x4020,0x4028,0x4030,0x4038,0x800f,0x801f,0x802f,0x803f,0x800e,0x801e,0x802e,0x803e,0x800d,0x801d,0x802d,0x803d,0x0007,0x000f,0x0017,0x001f,0x0027,0x002f,0x0037,0x003f,0x800c,0x801c,0x802c,0x803c,0x800b,0x801b,0x802b,0x803b,0x0006,0x000e,0x0016,0x001e,0x0026,0x002e,0x0036,0x003e,0x800a,0x801a,0x802a,0x803a,0x8009,0x8019,0x8029,0x8039,0x0005,0x000d,0x0015,0x001d,0x0025,0x002d,0x0035,0x003d,0x8008,0x8018,0x8028,0x8038,0x8007,0x8017,0x8027,0x8037,0x0004,0x000c,0x0014,0x001c,0x0024,0x002c,0x0034,0x003c,0x8006,0x8016,0x8026,0x8036,0x8005,0x8015,0x8025,0x8035,0x0003,0x000b,0x0013,0x001b,0x0023,0x002b,0x0033,0x003b,0x8004,0x8014,0x8024,0x8034,0x8003,0x8013,0x8023,0x8033,0x0002,0x000a,0x0012,0x001a,0x0022,0x002a,0x0032,0x003a,0x8002,0x8012,0x8022,0x8032,0x8000,0x8001,0x8010,0x8011,0x8020,0x8021,0x8030,0x8031,0x0001,0x0009,0x0011,0x0019,0x0021,0x0029,0x0031,0x0039,0x0000,0x0008,0x0010,0x0018,0x0020,0x0028,0x0030,0x0038,0x2000,0x2001,0x2002,0x2003,0x2004,0x2005,0x2006,0x2007,0x2008,0x2009,0x200a,0x200b,0x200c,0x200d,0x200e,0x200f,0x2010,0x2011,0x2012,0x2013,0x2014,0x2015,0x2016,0x2017,0x2018,0x2019,0x201a,0x201b,0x201c,0x201d,0x201e,0x201f,0x2020,0x2021,0x2022,0x2023,0x2024,0x2025,0x2026,0x2027},
  {0x4004,0x4005,0x4006,0x4007,0x4021,0x4029,0x4031,0x4039,0x804f,0x805f,0x806f,0x807f,0x804e,0x805e,0x806e,0x807e,0x804d,0x805d,0x806d,0x807d,0x0047,0x004f,0x0057,0x005f,0x0067,0x006f,0x0077,0x007f,0x804c,0x805c,0x806c,0x807c,0x804b,0x805b,0x806b,0x807b,0x0046,0x004e,0x0056,0x005e,0x0066,0x006e,0x0076,0x007e,0x804a,0x805a,0x806a,0x807a,0x8049,0x8059,0x8069,0x8079,0x0045,0x004d,0x0055,0x005d,0x0065,0x006d,0x0075,0x007d,0x8048,0x8058,0x8068,0x8078,0x8047,0x8057,0x8067,0x8077,0x0044,0x004c,0x0054,0x005c,0x0064,0x006c,0x0074,0x007c,0x8046,0x8056,0x8066,0x8076,0x8045,0x8055,0x8065,0x8075,0x0043,0x004b,0x0053,0x005b,0x0063,0x006b,0x0073,0x007b,0x8044,0x8054,0x8064,0x8074,0x8043,0x8053,0x8063,0x8073,0x0042,0x004a,0x0052,0x005a,0x0062,0x006a,0x0072,0x007a,0x8042,0x8052,0x8062,0x8072,0x8040,0x8041,0x8050,0x8051,0x8060,0x8061,0x8070,0x8071,0x0041,0x0049,0x0051,0x0059,0x0061,0x0069,0x0071,0x0079,0x0040,0x0048,0x0050,0x0058,0x0060,0x0068,0x0070,0x0078,0x2028,0x2029,0x202a,0x202b,0x202c,0x202d,0x202e,0x202f,0x2030,0x2031,0x2032,0x2033,0x2034,0x2035,0x2036,0x2037,0x2038,0x2039,0x203a,0x203b,0x203c,0x203d,0x203e,0x203f,0x2040,0x2041,0x2042,0x2043,0x2044,0x2045,0x2046,0x2047,0x2048,0x2049,0x204a,0x204b,0x204c,0x204d,0x204e,0x204f},
  {0x4008,0x4009,0x400a,0x400b,0x4022,0x402a,0x4032,0x403a,0x808f,0x809f,0x80af,0x80bf,0x808e,0x809e,0x80ae,0x80be,0x808d,0x809d,0x80ad,0x80bd,0x0087,0x008f,0x0097,0x009f,0x00a7,0x00af,0x00b7,0x00bf,0x808c,0x809c,0x80ac,0x80bc,0x808b,0x809b,0x80ab,0x80bb,0x0086,0x008e,0x0096,0x009e,0x00a6,0x00ae,0x00b6,0x00be,0x808a,0x809a,0x80aa,0x80ba,0x8089,0x8099,0x80a9,0x80b9,0x0085,0x008d,0x0095,0x009d,0x00a5,0x00ad,0x00b5,0x00bd,0x8088,0x8098,0x80a8,0x80b8,0x8087,0x8097,0x80a7,0x80b7,0x0084,0x008c,0x0094,0x009c,0x00a4,0x00ac,0x00b4,0x00bc,0x8086,0x8096,0x80a6,0x80b6,0x8085,0x8095,0x80a5,0x80b5,0x0083,0x008b,0x0093,0x009b,0x00a3,0x00ab,0x00b3,0x00bb,0x8084,0x8094,0x80a4,0x80b4,0x8083,0x8093,0x80a3,0x80b3,0x0082,0x008a,0x0092,0x009a,0x00a2,0x00aa,0x00b2,0x00ba,0x8082,0x8092,0x80a2,0x80b2,0x8080,0x8081,0x8090,0x8091,0x80a0,0x80a1,0x80b0,0x80b1,0x0081,0x0089,0x0091,0x0099,0x00a1,0x00a9,0x00b1,0x00b9,0x0080,0x0088,0x0090,0x0098,0x00a0,0x00a8,0x00b0,0x00b8,0x2050,0x2051,0x2052,0x2053,0x2054,0x2055,0x2056,0x2057,0x2058,0x2059,0x205a,0x205b,0x205c,0x205d,0x205e,0x205f,0x2060,0x2061,0x2062,0x2063,0x2064,0x2065,0x2066,0x2067,0x2068,0x2069,0x206a,0x206b,0x206c,0x206d,0x206e,0x206f,0x2070,0x2071,0x2072,0x2073,0x2074,0x2075,0x2076,0x2077},
  {0x400c,0x400d,0x400e,0x400f,0x4023,0x402b,0x4033,0x403b,0x80cf,0x80df,0x80ef,0x80ff,0x80ce,0x80de,0x80ee,0x80fe,0x80cd,0x80dd,0x80ed,0x80fd,0x00c7,0x00cf,0x00d7,0x00df,0x00e7,0x00ef,0x00f7,0x00ff,0x80cc,0x80dc,0x80ec,0x80fc,0x80cb,0x80db,0x80eb,0x80fb,0x00c6,0x00ce,0x00d6,0x00de,0x00e6,0x00ee,0x00f6,0x00fe,0x80ca,0x80da,0x80ea,0x80fa,0x80c9,0x80d9,0x80e9,0x80f9,0x00c5,0x00cd,0x00d5,0x00dd,0x00e5,0x00ed,0x00f5,0x00fd,0x80c8,0x80d8,0x80e8,0x80f8,0x80c7,0x80d7,0x80e7,0x80f7,0x00c4,0x00cc,0x00d4,0x00dc,0x00e4,0x00ec,0x00f4,0x00fc,0x80c6,0x80d6,0x80e6,0x80f6,0x80c5,0x80d5,0x80e5,0x80f5,0x00c3,0x00cb,0x00d3,0x00db,0x00e3,0x00eb,0x00f3,0x00fb,0x80c4,0x80d4,0x80e4,0x80f4,0x80c3,0x80d3,0x80e3,0x80f3,0x00c2,0x00ca,0x00d2,0x00da,0x00e2,0x00ea,0x00f2,0x00fa,0x80c2,0x80d2,0x80e2,0x80f2,0x80c0,0x80c1,0x80d0,0x80d1,0x80e0,0x80e1,0x80f0,0x80f1,0x00c1,0x00c9,0x00d1,0x00d9,0x00e1,0x00e9,0x00f1,0x00f9,0x00c0,0x00c8,0x00d0,0x00d8,0x00e0,0x00e8,0x00f0,0x00f8,0x2078,0x2079,0x207a,0x207b,0x207c,0x207d,0x207e,0x207f,0x2080,0x2081,0x2082,0x2083,0x2084,0x2085,0x2086,0x2087,0x2088,0x2089,0x208a,0x208b,0x208c,0x208d,0x208e,0x208f,0x2090,0x2091,0x2092,0x2093,0x2094,0x2095,0x2096,0x2097,0x2098,0x2099,0x209a,0x209b,0x209c,0x209d,0x209e,0x209f},
  {0x4010,0x4011,0x4012,0x4013,0x4024,0x402c,0x4034,0x403c,0x810f,0x811f,0x812f,0x813f,0x810e,0x811e,0x812e,0x813e,0x810d,0x811d,0x812d,0x813d,0x0107,0x010f,0x0117,0x011f,0x0127,0x012f,0x0137,0x013f,0x810c,0x811c,0x812c,0x813c,0x810b,0x811b,0x812b,0x813b,0x0106,0x010e,0x0116,0x011e,0x0126,0x012e,0x0136,0x013e,0x810a,0x811a,0x812a,0x813a,0x8109,0x8119,0x8129,0x8139,0x0105,0x010d,0x0115,0x011d,0x0125,0x012d,0x0135,0x013d,0x8108,0x8118,0x8128,0x8138,0x8107,0x8117,0x8127,0x8137,0x0104,0x010c,0x0114,0x011c,0x0124,0x012c,0x0134,0x013c,0x8106,0x8116,0x8126,0x8136,0x8105,0x8115,0x8125,0x8135,0x0103,0x010b,0x0113,0x011b,0x0123,0x012b,0x0133,0x013b,0x8104,0x8114,0x8124,0x8134,0x8103,0x8113,0x8123,0x8133,0x0102,0x010a,0x0112,0x011a,0x0122,0x012a,0x0132,0x013a,0x8102,0x8112,0x8122,0x8132,0x8100,0x8101,0x8110,0x8111,0x8120,0x8121,0x8130,0x8131,0x0101,0x0109,0x0111,0x0119,0x0121,0x0129,0x0131,0x0139,0x0100,0x0108,0x0110,0x0118,0x0120,0x0128,0x0130,0x0138,0x20a0,0x20a1,0x20a2,0x20a3,0x20a4,0x20a5,0x20a6,0x20a7,0x20a8,0x20a9,0x20aa,0x20ab,0x20ac,0x20ad,0x20ae,0x20af,0x20b0,0x20b1,0x20b2,0x20b3,0x20b4,0x20b5,0x20b6,0x20b7,0x20b8,0x20b9,0x20ba,0x20bb,0x20bc,0x20bd,0x20be,0x20bf,0x20c0,0x20c1,0x20c2,0x20c3,0x20c4,0x20c5,0x20c6,0x20c7},
  {0x4014,0x4015,0x4016,0x4017,0x4025,0x402d,0x4035,0x403d,0x814f,0x815f,0x816f,0x817f,0x814e,0x815e,0x816e,0x817e,0x814d,0x815d,0x816d,0x817d,0x0147,0x014f,0x0157,0x015f,0x0167,0x016f,0x0177,0x017f,0x814c,0x815c,0x816c,0x817c,0x814b,0x815b,0x816b,0x817b,0x0146,0x014e,0x0156,0x015e,0x0166,0x016e,0x0176,0x017e,0x814a,0x815a,0x816a,0x817a,0x8149,0x8159,0x8169,0x8179,0x0145,0x014d,0x0155,0x015d,0x0165,0x016d,0x0175,0x017d,0x8148,0x8158,0x8168,0x8178,0x8147,0x8157,0x8167,0x8177,0x0144,0x014c,0x0154,0x015c,0x0164,0x016c,0x0174,0x017c,0x8146,0x8156,0x8166,0x8176,0x8145,0x8155,0x8165,0x8175,0x0143,0x014b,0x0153,0x015b,0x0163,0x016b,0x0173,0x017b,0x8144,0x8154,0x8164,0x8174,0x8143,0x8153,0x8163,0x8173,0x0142,0x014a,0x0152,0x015a,0x0162,0x016a,0x0172,0x017a,0x8142,0x8152,0x8162,0x8172,0x8140,0x8141,0x8150,0x8151,0x8160,0x8161,0x8170,0x8171,0x0141,0x0149,0x0151,0x0159,0x0161,0x0169,0x0171,0x0179,0x0140,0x0148,0x0150,0x0158,0x0160,0x0168,0x0170,0x0178,0x20c8,0x20c9,0x20ca,0x20cb,0x20cc,0x20cd,0x20ce,0x20cf,0x20d0,0x20d1,0x20d2,0x20d3,0x20d4,0x20d5,0x20d6,0x20d7,0x20d8,0x20d9,0x20da,0x20db,0x20dc,0x20dd,0x20de,0x20df,0x20e0,0x20e1,0x20e2,0x20e3,0x20e4,0x20e5,0x20e6,0x20e7,0x20e8,0x20e9,0x20ea,0x20eb,0x20ec,0x20ed,0x20ee,0x20ef},
  {0x4018,0x4019,0x401a,0x401b,0x4026,0x402e,0x4036,0x403e,0x818f,0x819f,0x81af,0x81bf,0x818e,0x819e,0x81ae,0x81be,0x818d,0x819d,0x81ad,0x81bd,0x0187,0x018f,0x0197,0x019f,0x01a7,0x01af,0x01b7,0x01bf,0x818c,0x819c,0x81ac,0x81bc,0x818b,0x819b,0x81ab,0x81bb,0x0186,0x018e,0x0196,0x019e,0x01a6,0x01ae,0x01b6,0x01be,0x818a,0x819a,0x81aa,0x81ba,0x8189,0x8199,0x81a9,0x81b9,0x0185,0x018d,0x0195,0x019d,0x01a5,0x01ad,0x01b5,0x01bd,0x8188,0x8198,0x81a8,0x81b8,0x8187,0x8197,0x81a7,0x81b7,0x0184,0x018c,0x0194,0x019c,0x01a4,0x01ac,0x01b4,0x01bc,0x8186,0x8196,0x81a6,0x81b6,0x8185,0x8195,0x81a5,0x81b5,0x0183,0x018b,0x0193,0x019b,0x01a3,0x01ab,0x01b3,0x01bb,0x8184,0x8194,0x81a4,0x81b4,0x8183,0x8193,0x81a3,0x81b3,0x0182,0x018a,0x0192,0x019a,0x01a2,0x01aa,0x01b2,0x01ba,0x8182,0x8192,0x81a2,0x81b2,0x8180,0x8181,0x8190,0x8191,0x81a0,0x81a1,0x81b0,0x81b1,0x0181,0x0189,0x0191,0x0199,0x01a1,0x01a9,0x01b1,0x01b9,0x0180,0x0188,0x0190,0x0198,0x01a0,0x01a8,0x01b0,0x01b8,0x20f0,0x20f1,0x20f2,0x20f3,0x20f4,0x20f5,0x20f6,0x20f7,0x20f8,0x20f9,0x20fa,0x20fb,0x20fc,0x20fd,0x20fe,0x20ff,0x2100,0x2101,0x2102,0x2103,0x2104,0x2105,0x2106,0x2107,0x2108,0x2109,0x210a,0x210b,0x210c,0x210d,0x210e,0x210f,0x2110,0x2111,0x2112,0x2113,0x2114,0x2115,0x2116,0x2117},
  {0x401c,0x401d,0x401e,0x401f,0x4027,0x402f,0x4037,0x403f,0x81cf,0x81df,0x81ef,0x81ff,0x81ce,0x81de,0x81ee,0x81fe,0x81cd,0x81dd,0x81ed,0x81fd,0x01c7,0x01cf,0x01d7,0x01df,0x01e7,0x01ef,0x01f7,0x01ff,0x81cc,0x81dc,0x81ec,0x81fc,0x81cb,0x81db,0x81eb,0x81fb,0x01c6,0x01ce,0x01d6,0x01de,0x01e6,0x01ee,0x01f6,0x01fe,0x81ca,0x81da,0x81ea,0x81fa,0x81c9,0x81d9,0x81e9,0x81f9,0x01c5,0x01cd,0x01d5,0x01dd,0x01e5,0x01ed,0x01f5,0x01fd,0x81c8,0x81d8,0x81e8,0x81f8,0x81c7,0x81d7,0x81e7,0x81f7,0x01c4,0x01cc,0x01d4,0x01dc,0x01e4,0x01ec,0x01f4,0x01fc,0x81c6,0x81d6,0x81e6,0x81f6,0x81c5,0x81d5,0x81e5,0x81f5,0x01c3,0x01cb,0x01d3,0x01db,0x01e3,0x01eb,0x01f3,0x01fb,0x81c4,0x81d4,0x81e4,0x81f4,0x81c3,0x81d3,0x81e3,0x81f3,0x01c2,0x01ca,0x01d2,0x01da,0x01e2,0x01ea,0x01f2,0x01fa,0x81c2,0x81d2,0x81e2,0x81f2,0x81c0,0x81c1,0x81d0,0x81d1,0x81e0,0x81e1,0x81f0,0x81f1,0x01c1,0x01c9,0x01d1,0x01d9,0x01e1,0x01e9,0x01f1,0x01f9,0x01c0,0x01c8,0x01d0,0x01d8,0x01e0,0x01e8,0x01f0,0x01f8,0x2118,0x2119,0x211a,0x211b,0x211c,0x211d,0x211e,0x211f,0x2120,0x2121,0x2122,0x2123,0x2124,0x2125,0x2126,0x2127,0x2128,0x2129,0x212a,0x212b,0x212c,0x212d,0x212e,0x212f,0x2130,0x2131,0x2132,0x2133,0x2134,0x2135,0x2136,0x2137,0x2138,0x2139,0x213a,0x213b,0x213c,0x213d,0x213e,0x213f},
};
constexpr int NQ_UNITS = 176;
constexpr size_t WS_DIFFO = 224 * MiB;
constexpr size_t WS_END2 = 256 * MiB;
constexpr int CW_FILL = 9984;
constexpr int N_FILL_ARRIVALS = 8 * 320;
constexpr int CW_QHEAD = 10240;
constexpr int CW_DIFF = 11264;
static_assert((CW_DIFF + 256 * 8) * 4 <= (int)CTL_ZERO_BYTES, "counters inside the zeroed control region");
static_assert(ab::ATTN_LDS_BYTES <= LDSCTL_OFF && ab::B_LDS_BYTES <= LDSCTL_OFF, "attention LDS fits below the control words");
__device__ __forceinline__ void diff_combine(const bf16_t* DIFFO, bf16_t* ATT, const float* subw, float lam, int b, int h, int qb, int wid, int lane_) {
    int lane = lane_; asm volatile("" : "+v"(lane));
    const int row = b * SEQ + 256 * qb + 32 * wid + (lane >> 1), hf = lane & 1;
    const __amdgpu_buffer_rsrc_t rs_ = __builtin_amdgcn_make_buffer_rsrc((void*)DIFFO, (short)0, 0x7fffffff, 0x00020000);
    const int o1_ = (int)(((size_t)row * 1024 + h * 256 + hf * 64) * 2), o2_ = o1_ + 256;
    f32x4 v[16]; float ss = 0.f;
#pragma unroll
    for (int q = 0; q < 8; ++q) { const v4u a = __builtin_amdgcn_raw_buffer_load_b128(rs_, o1_ + 16 * q, 0, 16), c = __builtin_amdgcn_raw_buffer_load_b128(rs_, o2_ + 16 * q, 0, 16);
        const f32x4 a0 = {__uint_as_float(a.x << 16), __uint_as_float(a.x & 0xffff0000u), __uint_as_float(a.y << 16), __uint_as_float(a.y & 0xffff0000u)};
        const f32x4 a1 = {__uint_as_float(a.z << 16), __uint_as_float(a.z & 0xffff0000u), __uint_as_float(a.w << 16), __uint_as_float(a.w & 0xffff0000u)};
        const f32x4 c0 = {__uint_as_float(c.x << 16), __uint_as_float(c.x & 0xffff0000u), __uint_as_float(c.y << 16), __uint_as_float(c.y & 0xffff0000u)};
        const f32x4 c1 = {__uint_as_float(c.z << 16), __uint_as_float(c.z & 0xffff0000u), __uint_as_float(c.w << 16), __uint_as_float(c.w & 0xffff0000u)};
        v[2 * q] = a0 - c0 * lam; v[2 * q + 1] = a1 - c1 * lam;
        ss += ((v[2 * q].x * v[2 * q].x + v[2 * q].y * v[2 * q].y) + (v[2 * q].z * v[2 * q].z + v[2 * q].w * v[2 * q].w)) + ((v[2 * q + 1].x * v[2 * q + 1].x + v[2 * q + 1].y * v[2 * q + 1].y) + (v[2 * q + 1].z * v[2 * q + 1].z + v[2 * q + 1].w * v[2 * q + 1].w)); }
    ss += __shfl_xor(ss, 1);
    const float rstd = rsqrtf(ss * (1.f / 128.f) + EPS) * 0.8f;
    GAS v4u* dst = (GAS v4u*)(ATT + (size_t)row * DM + h * 128 + hf * 64);
    const GAS f32x4* sw = (const GAS f32x4*)(subw + hf * 64);
#pragma unroll
    for (int q = 0; q < 8; ++q) { const f32x4 g0 = sw[2 * q] * rstd, g1 = sw[2 * q + 1] * rstd; const f32x4 o0 = v[2 * q] * g0, o1 = v[2 * q + 1] * g1;
        dst[q] = (v4u){pk2(o0.x, o0.y), pk2(o0.z, o0.w), pk2(o1.x, o1.y), pk2(o1.z, o1.w)}; }
}
#if PROBE_K >= 200
#define ACC_T0() unsigned long long acc_t0_ = __builtin_amdgcn_s_memrealtime()
#define ACC_ADD(cat) do { if (F.tid == 0) { const unsigned long long t1_ = __builtin_amdgcn_s_memrealtime(); F.MISC[40 + (cat)] += (unsigned)(t1_ - acc_t0_); } acc_t0_ = __builtin_amdgcn_s_memrealtime(); } while (0)
#else
#define ACC_T0() do {} while (0)
#define ACC_ADD(cat) do {} while (0)
#endif
__device__ __forceinline__ void attn_phase(Frame& F, char* shm, gu32* ctl, const bf16_t* PROJ, const float* CUMB, bf16_t* ATT, bf16_t* DIFFO, const float* subw, const float* lq1, const float* lk1, const float* lq2, const float* lk2,
                                           const bf16_t* HM, const bf16_t* WKV, bf16_t* MKN, bf16_t* VT, const float* mkw, const float* mqw) {
    const float s1 = wave_sum(lq1[F.lane] * lk1[F.lane]), s2 = wave_sum(lq2[F.lane] * lk2[F.lane]);
    const float lam = __uint_as_float(__builtin_amdgcn_readfirstlane(__float_as_uint(__expf(s1) - __expf(s2) + 0.2f)));
    const int xq = (int)(xb_xcc_id() & 7u);
    ACC_T0();
    for (;;) {
        if (F.tid == 0) F.MISC[13] = __hip_atomic_fetch_add((unsigned*)(ctl + CW_QHEAD + 64 * xq), 1u, __ATOMIC_RELAXED, __HIP_MEMORY_SCOPE_AGENT);
        __syncthreads();
        const unsigned qi = F.MISC[13];
        __syncthreads();
        if (qi >= (unsigned)NQ_UNITS) break;
        ACC_ADD(5);
        const unsigned u = UNIT_Q[xq][qi];
        const int qb = u & 7;
        if (u & 0x2000u) {
            LAS float* scr = (LAS float*)(F.lds + RING_OFF + F.wave * 16384);
            const unsigned char* ka_ = (const unsigned char*)__builtin_amdgcn_kernarg_segment_ptr(); asm volatile("" : "+s"(ka_));
            const Args* ap_ = (const Args*)ka_; const Ptrs P = make_ptrs(ap_->in, ap_->out, ap_->ws);
            const int it0 = (int)(u & 511) * 16 + F.wave * 2;
            int ln_ = F.lane; asm volatile("" : "+v"(ln_));
#pragma unroll 1
            for (int it = it0; it < it0 + 2; ++it) {
                int r = it;
                if (r < 512) { p0_transpose_item<false, true>(P.w_mq, DM, DM, DM, P.nmq, P.WQ, scr, r, ln_); continue; } r -= 512;
                if (r < 512) { p0_transpose_item<false, true>(P.w_mo, DM, DM, DM, nullptr, P.WO, scr, r, ln_); continue; } r -= 512;
                if (r < 2048) { p0_transpose_item<false, true>(P.w_up, DFF, DM, DFF, P.nmlp, P.WUP, scr, r, ln_); continue; } r -= 2048;
                p0_transpose_item<false, true>(P.w_dn, DM, DFF, DM, nullptr, P.WDN, scr, r, ln_);
            }
            VM_WAIT(); if (ln_ == 0) __hip_atomic_fetch_add((unsigned*)(ctl + CW_FILL), 1u, __ATOMIC_RELAXED, __HIP_MEMORY_SCOPE_AGENT);
            __syncthreads(); ACC_ADD(4);
        } else if (u & 0x4000u) {
            const int idx = u & 63;
            if (idx < 32) {
                pg8::Gemm g{HM, WKV, DM, DM, DM}; const Sched S = sched_one(idx >> 2, idx & 3, true);
                pg8::EpiHeadNormK E{MKN, mkw, mqw};
                pg8::gemm_phase<pg8::EpiHeadNormK, Sched, false, true>(F.lds + RING_OFF, g, S, E);
            } else {
                pg8::Gemm g{WKV + (size_t)1024 * DM, HM, DM, DM, DM}; const Sched S = sched_one((idx - 32) >> 3, (idx - 32) & 7, true);
                pg8::EpiStore<0> E{VT, MMEM, nullptr};
                pg8::gemm_phase<pg8::EpiStore<0>, Sched, true, true>(F.lds + RING_OFF, g, S, E);
            }
            __syncthreads(); ACC_ADD(3);
        } else if (u & 0x8000u) {
            const int rblk = u & 15, bh = (u >> 4) & 31, b = bh >> 2, h = bh & 3;
            const ab::bf16* base = (const ab::bf16*)PROJ + (size_t)b * SEQ * NPROJ;
            ab::diff_unit_ab<8>(rblk, base + C_DQ + 128 * h, base + C_DK + 128 * h, base + C_DV + 128 * h, ATT + (size_t)b * SEQ * DM + 128 * h, subw, lam, shm);
            ACC_ADD(1);
        } else {
            const int bh = (u >> 3) & 63, b = bh >> 3, h = bh & 7;
            const ab::bf16* base = (const ab::bf16*)PROJ + (size_t)b * SEQ * NPROJ;
            ab::attn_unit<8, 0, true, false>(qb, base + C_FQ + 64 * h, base + C_FK + 64 * h, base + C_FV + 64 * h, (ab::bf16*)ATT + (size_t)b * SEQ * DM + 512 + 64 * h, DM, CUMB + (size_t)bh * SEQ, shm);
            ACC_ADD(0);
        }
    }
}
#ifndef REP3
#define REP3 1
#endif
#define ATTN_PHASE_HOOK if (IN(3)) { PP; for (int rep_ = 0; rep_ < REP3; ++rep_) attn_phase(F, (char*)lds + RING_OFF, F.ctl, P.PROJ, P.CUMB, P.ATT, (bf16_t*)(args.ws + WS_DIFFO), P.subw, P.lq1, P.lk1, P.lq2, P.lk2, P.HM, P.WKV, P.MKN, P.VT, P.mkw, P.mqw); }
#ifndef PROBE_K
#define PROBE_K -1
#endif
#ifndef PROBE_MULT
#define PROBE_MULT 4
#endif
#define STAMP(i) do { if (PROBE_K >= 0 && F.tid == 0) { const unsigned long long t_ = __builtin_amdgcn_s_memrealtime(); F.MISC[16 + 2 * (i)] = (unsigned)t_; F.MISC[17 + 2 * (i)] = (unsigned)(t_ >> 32); } } while (0)
#ifndef REP0
#define REP0 1
#endif
#ifndef REP1
#define REP1 1
#endif
#ifndef REP2
#define REP2 1
#endif
#ifndef REP3
#define REP3 1
#endif
#ifndef REP4
#define REP4 1
#endif
#ifndef REP5
#define REP5 1
#endif
#ifndef REP6
#define REP6 1
#endif
#ifndef REP7
#define REP7 1
#endif
#ifndef REP8
#define REP8 1
#endif
constexpr int NPHASE = 9;

__global__ void __launch_bounds__(NWAVES * 64, 2) mega_fwd(Args args) {
    extern __shared__ __attribute__((aligned(16))) unsigned char lds[];
    Frame F;
    F.lds = (LAS unsigned char*)lds; F.MISC = (volatile LAS unsigned*)(F.lds + MISC_OFF);
    F.tid = threadIdx.x; F.lane = F.tid & 63; F.wave = __builtin_amdgcn_readfirstlane(F.tid >> 6);
    F.G = gridDim.x; { const int bx = blockIdx.x; F.vcu = (F.G % 8 == 0) ? (bx % 8) * (F.G / 8) + bx / 8 : bx; }
    F.ctl = (gu32*)(args.ws + WS_CTL);
    for (int u = F.tid; u < (LDS_BYTES - LDSCTL_OFF) / 4; u += NWAVES * 64) ((LAS unsigned*)(F.lds + LDSCTL_OFF))[u] = 0u;
    __syncthreads();
    XcdBarrier bar = xcd_barrier_post((unsigned*)(F.ctl + CW_BAR) + args.ph_lo * XCD_BAR_WORDS, F.MISC + 8);
    const int lo = args.ph_lo, hi = args.ph_hi;
#define IN(k) (lo <= (k) && (k) < hi)
#define PP const Ptrs P = make_ptrs(args.in, args.out, args.ws)
#define SEAM(k) do { if (IN(k) && IN((k) + 1)) xcd_barrier(bar); } while (0)
#define SEAM2(k) do { if (IN(k) && IN((k) + 2)) xcd_barrier(bar); } while (0)
#define SEAML(k) do { if (IN(k) && IN((k) + 1)) { if (loc) xcc_barrier(bar); else xcd_barrier(bar); } } while (0)
    const int bx = (int)blockIdx.x;
    STAMP(0);

    if (IN(0)) { PP; for (int rep_ = 0; rep_ < REP0; ++rep_) p0_prologue(F, P); } SEAM(0); STAMP(1);
    const bool loc = (lo == 0) && (F.MISC[11] != 0u);
    const int cx = loc ? (int)(F.MISC[10] * 8u + bar.x) : bx;

    if (IN(1)) {
        PP; for (int rep_ = 0; rep_ < REP1; ++rep_) {
        pg8::Gemm g{P.XB, P.WIN, DM, DM, DM}; const Sched S = sched_static(MTOK, NPROJ, F.G, cx);
        { const int sq = loc ? ((cx >> 3) < 8 ? (cx & 7) * 8 + (cx >> 3) : -1) : (bx < 64 ? bx : -1);
          if (sq >= 0) p1b_cumsum_wg(P.FLOG, P.b_forget, P.CUMB, sq, F.tid, (LAS float*)(F.lds + LDS_RQ)); }
        pg8::EpiProj E{P.PROJ, P.QKW, P.ROPE};
        pg8::gemm_phase<pg8::EpiProj, Sched, true, true>(F.lds + RING_OFF, g, S, E);
    }} if (IN(1) && IN(3)) { if (loc) xcc_barrier(bar); else xcd_barrier(bar); } STAMP(2);


    ATTN_PHASE_HOOK
    if (PROBE_K >= 300 && F.tid == 0) { __hip_atomic_fetch_add((unsigned*)(F.ctl + 3000), F.MISC[40 + (PROBE_K >= 300 ? PROBE_K - 300 : 0)], __ATOMIC_RELAXED, __HIP_MEMORY_SCOPE_AGENT); }
    STAMP(9); SEAML(3); STAMP(3);
    if (PROBE_K >= 300 && F.tid == 0) { F.MISC[39] = __hip_atomic_load((unsigned*)(F.ctl + 3000), __ATOMIC_RELAXED, __HIP_MEMORY_SCOPE_AGENT) / 256u; }

    if (IN(4)) {
        PP; for (int rep_ = 0; rep_ < REP4; ++rep_) {
        pg8::Gemm g{P.ATT, P.WOUT, DM, DM, DM}; const Sched S = sched_static(MTOK, DM, F.G, cx);
        pg8::EpiResid<0> E{P.RS0, P.XB, nullptr, P.SS};
        pg8::gemm_phase<pg8::EpiResid<0>, Sched, false, true>(F.lds + RING_OFF, g, S, E);
    }} SEAML(4); STAMP(4);

    if (IN(5)) {
        PP; for (int rep_ = 0; rep_ < REP5; ++rep_) {
        if (F.tid == 0) { XB_SPIN(__hip_atomic_load((unsigned*)(F.ctl + CW_FILL), __ATOMIC_RELAXED, __HIP_MEMORY_SCOPE_AGENT) < (unsigned)N_FILL_ARRIVALS, (unsigned*)(F.ctl + CW_BAR)); }
        __syncthreads();
        const Sched S0 = sched_static(MTOK, DM, F.G, cx); pg8::Unit u{0, 0}; const bool has = S0.next(0, u);
        PG8_LAS float* RQ = (PG8_LAS float*)(F.lds + LDS_RQ); PG8_LAS float* IL = (PG8_LAS float*)(F.lds + LDS_IL);
        {   pg8::Gemm g{P.XB, P.WQ, DM, DM, DM}; const Sched S = sched_one(u.pm, u.pn, has);
            pg8::EpiMemQ E{P.MQ, P.SS, RQ};
            pg8::gemm_phase<pg8::EpiMemQ, Sched, false, true>(F.lds + RING_OFF, g, S, E); }
        VM_WAIT(); __syncthreads(); if (F.tid == 0) { __builtin_amdgcn_fence(__ATOMIC_ACQUIRE, "agent"); VM_WAIT(); } __syncthreads();
        const int head = u.pn, bh = (u.pm >> 3) * 4 + head;
        {   pg8::Gemm g{P.MQ + head * 256, P.MKN + (size_t)bh * 65536, DM, 256, 256}; const Sched S = sched_one(u.pm, 0, has);
            pg8::EpiMemS E{P.MQ, head, RQ, IL};
            pg8::gemm_phase<pg8::EpiMemS, Sched, false, true>(F.lds + RING_OFF, g, S, E); }
        VM_WAIT(); __syncthreads(); if (F.tid == 0) { __builtin_amdgcn_fence(__ATOMIC_ACQUIRE, "agent"); VM_WAIT(); } __syncthreads();
        {   pg8::Gemm g{P.MQ + head * 256, P.VT + (size_t)(head * 256) * MMEM + (u.pm >> 3) * 256, DM, MMEM, 256}; const Sched S = sched_one(u.pm, 0, has);
            pg8::EpiMemPV E{P.MO, head, IL};
            pg8::gemm_phase<pg8::EpiMemPV, Sched, true, true>(F.lds + RING_OFF, g, S, E); }
    }} SEAML(5); STAMP(5);

    if (IN(6)) {
        PP; for (int rep_ = 0; rep_ < REP6; ++rep_) {
        pg8::Gemm g{P.MO, P.WO, DM, DM, DM}; const Sched S = sched_static(MTOK, DM, F.G, cx);
        pg8::EpiResid<1> E{nullptr, P.XB, nullptr, P.SS};
        pg8::gemm_phase<pg8::EpiResid<1>, Sched, false, true>(F.lds + RING_OFF, g, S, E);
    }} SEAML(6); STAMP(6);

    if (IN(7)) {
        PP; for (int rep_ = 0; rep_ < REP7; ++rep_) {
        pg8::Gemm g{P.XB, P.WUP, DM, DM, DM}; const Sched S = sched_static(MTOK, DFF, F.G, cx);
        pg8::EpiStore<3> E{P.H, DFF, P.SS};
        pg8::gemm_phase<pg8::EpiStore<3>, Sched, true, true>(F.lds + RING_OFF, g, S, E);
    }} SEAML(7); STAMP(7);

    if (IN(8)) {
        PP; for (int rep_ = 0; rep_ < REP8; ++rep_) {
        pg8::Gemm g{P.H, P.WDN, DFF, DFF, DFF}; const Sched S = sched_static(MTOK, DM, F.G, cx);
        pg8::EpiResid<2> E{nullptr, P.XB, P.out, nullptr};
        pg8::gemm_phase<pg8::EpiResid<2>, Sched, false, true>(F.lds + RING_OFF, g, S, E);
    }}
    STAMP(8);
    if (PROBE_K >= 0 && F.tid == 0) {
        constexpr int IA_ = PROBE_K == 100 ? 9 : (PROBE_K >= 200 ? 0 : PROBE_K), IB_ = PROBE_K == 100 ? 3 : (PROBE_K >= 200 ? 1 : PROBE_K + 1);
        const unsigned long long a_ = ((unsigned long long)F.MISC[17 + 2 * IA_] << 32) | F.MISC[16 + 2 * IA_], b_ = ((unsigned long long)F.MISC[17 + 2 * IB_] << 32) | F.MISC[16 + 2 * IB_];
        unsigned long long w_ = (b_ - a_) * PROBE_MULT; if (PROBE_K >= 200 && PROBE_K < 300) w_ = (unsigned long long)F.MISC[40 + (PROBE_K >= 200 && PROBE_K < 300 ? PROBE_K - 200 : 0)] * PROBE_MULT; if (PROBE_K >= 300) w_ = (unsigned long long)F.MISC[39] * PROBE_MULT;
        const unsigned long long t0_ = __builtin_amdgcn_s_memrealtime();
        while (__builtin_amdgcn_s_memrealtime() - t0_ < w_) __builtin_amdgcn_s_sleep(8);
    }
#undef IN
#undef SEAM
#undef SEAM2
}
extern "C" void kernel_launch(void* const* d_in, const int* in_sizes, int n_in, void* d_out, int out_size, void* d_ws, size_t ws_size, hipStream_t stream) {
    static int grid = 0;
    if (grid == 0) {
        if (n_in != 26 || in_sizes[0] != MTOK * DM || out_size != MTOK * DM || ws_size < WS_END2) { fprintf(stderr, "kernel_launch: unexpected shapes (n_in %d, in0 %d, out %d, ws %zu)\n", n_in, n_in > 0 ? in_sizes[0] : -1, out_size, ws_size); grid = -1; return; }
        int dev = 0, cus = 0, per_cu = 0;
        if (hipGetDevice(&dev) != hipSuccess || hipDeviceGetAttribute(&cus, hipDeviceAttributeMultiprocessorCount, dev) != hipSuccess) { grid = -1; return; }
        if (hipFuncSetAttribute((const void*)mega_fwd, hipFuncAttributeMaxDynamicSharedMemorySize, LDS_BYTES) != hipSuccess) { fprintf(stderr, "kernel_launch: hipFuncSetAttribute failed\n"); grid = -1; return; }
        if (hipOccupancyMaxActiveBlocksPerMultiprocessor(&per_cu, (const void*)mega_fwd, NWAVES * 64, LDS_BYTES) != hipSuccess || per_cu < 1) { fprintf(stderr, "kernel_launch: occupancy query says %d blocks per CU\n", per_cu); (void)hipGetLastError(); grid = -1; return; }
        grid = cus;
        if (grid != 256) fprintf(stderr, "kernel_launch: %d CUs; the one-unit-per-workgroup phases assume 256\n", grid);
    }
    if (grid < 0) return;
    (void)hipMemsetAsync((char*)d_ws + WS_CTL, 0, CTL_ZERO_BYTES, stream);
    Args a{};
    for (int i = 0; i < 26; ++i) a.in[i] = d_in[i];
    a.out = (float*)d_out; a.ws = (unsigned char*)d_ws;
#if MK_HYBRID
    const Ptrs P = make_ptrs(a.in, a.out, a.ws);
    a.ph_lo = 0; a.ph_hi = 3; hipLaunchKernelGGL(mega_fwd, dim3(grid), dim3(NWAVES * 64), LDS_BYTES, stream, a);
    float* OF = a.out;
    hipLaunchKernelGGL(k_attn, dim3(MTOK / 64, 8), dim3(64), 0, stream, P.PROJ, P.CUMB, 1, OF, 8);
    hipLaunchKernelGGL(k_fox_fin, dim3(MTOK * 512 / 256), dim3(256), 0, stream, OF, P.ATT);
    hipLaunchKernelGGL(k_attn, dim3(MTOK / 64, 16), dim3(64), 0, stream, P.PROJ, P.CUMB, 0, OF, 16);
    hipLaunchKernelGGL(k_diff_fin, dim3(MTOK), dim3(256), 0, stream, OF, P.lq1, P.lk1, P.lq2, P.lk2, P.subw, P.ATT);
    a.ph_lo = 4; a.ph_hi = 9; hipLaunchKernelGGL(mega_fwd, dim3(grid), dim3(NWAVES * 64), LDS_BYTES, stream, a);
#else
    a.ph_lo = 0; a.ph_hi = NPHASE; hipLaunchKernelGGL(mega_fwd, dim3(grid), dim3(NWAVES * 64), LDS_BYTES, stream, a);
#endif
}
```

```cpp
#include <hip/hip_runtime.h>
#include <cstdint>
#include <cstdio>

typedef unsigned short bf16_t;
__device__ __forceinline__ float bf2f(bf16_t v) { return __uint_as_float(((unsigned)v) << 16); }
__device__ __forceinline__ bf16_t f2bf(float f) { unsigned u = __float_as_uint(f); return (bf16_t)((u + 0x7fffu + ((u >> 16) & 1u)) >> 16); }

constexpr int NB = 8, SEQ = 2048, DM = 1024, MTOK = NB * SEQ, MEML = 256, MMEM = NB * MEML;
constexpr int NPROJ = 3072, INCOLS = 3080, DFF = 4096;
constexpr float EPS = 1e-6f;
constexpr float LOG2E = 1.4426950408889634f;
constexpr float C2 = 0.125f * LOG2E;
constexpr float CM = 0.0625f * LOG2E;
constexpr int C_DQ = 0, C_DK = 512, C_DV = 1024, C_FQ = 1536, C_FK = 2048, C_FV = 2560;

constexpr size_t MiB = 1u << 20;
constexpr size_t WS_CTL = 0, CTL_ZERO_BYTES = 112 * 1024;
constexpr size_t WS_FLOG = 1 * MiB;
constexpr size_t WS_CUMB = 2 * MiB;
constexpr size_t WS_ROPE = 3 * MiB;
constexpr size_t WS_RS0 = 4 * MiB + 256 * 1024;
constexpr size_t WS_QKW = 4 * MiB + 512 * 1024;
constexpr size_t WS_SS = 4 * MiB;
constexpr size_t WS_WIN = 8 * MiB, WS_WOUT = 14 * MiB, WS_WQ = 16 * MiB, WS_WKV = 18 * MiB, WS_WO = 22 * MiB, WS_WUP = 24 * MiB, WS_WDN = 32 * MiB;
constexpr size_t WS_XB = 40 * MiB;
constexpr size_t WS_HM = 72 * MiB;
constexpr size_t WS_MK = 76 * MiB;
constexpr size_t WS_VT = 80 * MiB;
constexpr size_t WS_MKN = 84 * MiB;
constexpr size_t WS_PROJ = 96 * MiB;
constexpr size_t WS_ATT = 192 * MiB;
constexpr size_t WS_MQ = 96 * MiB;
constexpr size_t WS_MO = 128 * MiB;
constexpr size_t WS_H = 96 * MiB;
constexpr size_t WS_END = 224 * MiB;
#define MK_HYBRID 0
namespace pg8 {
#define PG8_LAS __attribute__((address_space(3)))
typedef short bf16x8 __attribute__((ext_vector_type(8)));
typedef float f32x4 __attribute__((ext_vector_type(4)));
typedef unsigned u32x4 __attribute__((ext_vector_type(4)));
typedef unsigned u32x2 __attribute__((ext_vector_type(2)));
constexpr int BM = 256, BK = 64, HALF = 128, HTB = HALF * BK * 2  , STAGE_BYTES = 8 * HTB, NXCD = 8, WGM = 8;

__host__ __device__ __forceinline__ int lds_byte(int r, int c) { const int st = (r >> 4) * 2 + (c >> 5), rr = r & 15, cc = c & 31, ob = rr * 64 + cc * 2; return st * 1024 + (ob ^ (((ob >> 9) & 1) << 5)); }
__host__ __device__ __forceinline__ void stage_rc(int b, int& R, int& C) { const int st = b / 1024, sb = b % 1024, swz = sb ^ (((sb >> 9) & 1) << 5); R = (st >> 1) * 16 + swz / 64; C = (st & 1) * 32 + (swz % 64) / 2; }
__host__ __device__ __forceinline__ int perm32(int rho) { const int n = rho >> 4, i = rho & 15; return 8 * (i >> 2) + 4 * n + (i & 3); }

struct Unit { int pm, pn; };
struct Gemm { const bf16_t* A; const bf16_t* Bt; int lda, ldb, K; };

struct StaticOrder {
    int nM, nN, nwg, G, c;
    __host__ __device__ void init(int M, int N, int G_, int c_) { nM = M / BM; nN = N / BM; nwg = nM * nN; G = G_; c = c_; }
    __host__ __device__ bool next(int i, Unit& u) const {
        const long L = (long)i * G + c; if (L >= nwg) return false;
        int wgid = (int)L; { const int q = nwg / NXCD, r = nwg % NXCD, xcd = wgid % NXCD, off = wgid / NXCD; wgid = (xcd < r ? xcd * (q + 1) : r * (q + 1) + (xcd - r) * q) + off; }
        const int nig = WGM * nN, gid = wgid / nig, fm = gid * WGM, gsz = (nM - fm) < WGM ? (nM - fm) : WGM;
        u.pm = fm + ((wgid % nig) % gsz); u.pn = (wgid % nig) / gsz; return true;
    }
    __device__ __forceinline__ void a_ready(const Unit&) const {}
    __device__ __forceinline__ void done(const Unit&) const {}
};
struct OneUnit {
    int pm, pn; bool has;
    __device__ __forceinline__ bool next(int i, Unit& u) const { if (i != 0 || !has) return false; u.pm = pm; u.pn = pn; return true; }
    __device__ __forceinline__ void a_ready(const Unit&) const {}
    __device__ __forceinline__ void done(const Unit&) const {}
};

__device__ __forceinline__ unsigned cvt_pk_bf16(float lo, float hi) { unsigned r; asm volatile("v_cvt_pk_bf16_f32 %0, %1, %2" : "=v"(r) : "v"(lo), "v"(hi)); return r; }
__device__ __forceinline__ float xsum_fq(float s) {
    const auto a = __builtin_amdgcn_permlane16_swap(__float_as_uint(s), __float_as_uint(s), false, false);
    s = __uint_as_float(a[0]) + __uint_as_float(a[1]);
    const auto b = __builtin_amdgcn_permlane32_swap(__float_as_uint(s), __float_as_uint(s), false, false);
    return __uint_as_float(b[0]) + __uint_as_float(b[1]);
}
__device__ __forceinline__ float xchg16(float v, int fq) {
    const auto a = __builtin_amdgcn_permlane16_swap(__float_as_uint(v), __float_as_uint(v), false, false);
    return (fq & 1) ? __uint_as_float(a[0]) : __uint_as_float(a[1]);
}
#define PG8_LBAR() do { asm volatile("s_waitcnt lgkmcnt(0)" ::: "memory"); __builtin_amdgcn_s_barrier(); asm volatile("" ::: "memory"); } while (0)

template <int MODE> struct EpiStore {
    static constexpr bool PERM = true, AFTER_DRAIN = false;
    bf16_t* O; int ldc; const float* SS;
    __device__ __forceinline__ void operator()(const f32x4 (&acc)[2][2][4][2], const Unit& u, int wr, int wc, int fr, int fq) const {
        const int row0 = u.pm * BM + wr * 64 + fr, col0 = u.pn * BM + wc * 32 + 8 * fq;
#pragma unroll
        for (int ai = 0; ai < 2; ++ai)
#pragma unroll
            for (int m = 0; m < 4; ++m) { const int row = row0 + ai * HALF + m * 16; float rs = 1.f;
                if (MODE != 0) { const f32x4 s = *(const f32x4*)(SS + (size_t)row * 4); rs = rsqrtf(((s[0] + s[1]) + (s[2] + s[3])) * (1.f / DM) + EPS); }
                bf16_t* rowp = O + (size_t)row * ldc + col0;
#pragma unroll
                for (int bj = 0; bj < 2; ++bj) { f32x4 v0 = acc[ai][bj][m][0] * rs, v1 = acc[ai][bj][m][1] * rs;
                    if (MODE == 3) {
#pragma unroll
                        for (int e = 0; e < 4; ++e) { const float a = fmaxf(v0[e], 0.f), b = fmaxf(v1[e], 0.f); v0[e] = a * a; v1[e] = b * b; } }
                    u32x4 w; w.x = cvt_pk_bf16(v0[0], v0[1]); w.y = cvt_pk_bf16(v0[2], v0[3]); w.z = cvt_pk_bf16(v1[0], v1[1]); w.w = cvt_pk_bf16(v1[2], v1[3]);
                    *(u32x4*)(rowp + bj * HALF) = w; } }
    }
};
struct EpiProj {
    static constexpr bool PERM = true, AFTER_DRAIN = false;
    bf16_t* O; const float* QKW; const float* ROPE;
    __device__ __forceinline__ void operator()(const f32x4 (&acc)[2][2][4][2], const Unit& u, int wr, int wc, int fr, int fq) const {
        const int sec = u.pn >> 1, row0 = u.pm * BM + wr * 64 + fr, col0 = u.pn * BM + wc * 64 + 8 * fq;
        if (sec == 2 || sec == 5) {
#pragma unroll
            for (int ai = 0; ai < 2; ++ai)
#pragma unroll
                for (int m = 0; m < 4; ++m) { bf16_t* rowp = O + (size_t)(row0 + ai * HALF + m * 16) * NPROJ + col0;
#pragma unroll
                    for (int bj = 0; bj < 2; ++bj) { const f32x4 v0 = acc[ai][bj][m][0], v1 = acc[ai][bj][m][1];
                        u32x4 w; w.x = cvt_pk_bf16(v0[0], v0[1]); w.y = cvt_pk_bf16(v0[2], v0[3]); w.z = cvt_pk_bf16(v1[0], v1[1]); w.w = cvt_pk_bf16(v1[2], v1[3]);
                        *(u32x4*)(rowp + bj * 32) = w; } }
            return;
        }
        const float* w = QKW + 64 * (sec < 2 ? sec : sec - 1);
        const float sc = (sec == 0 || sec == 3) ? C2 : 1.f; const bool rope = sec < 2;
        f32x4 g[2][2];
#pragma unroll
        for (int bj = 0; bj < 2; ++bj)
#pragma unroll
            for (int n = 0; n < 2; ++n) g[bj][n] = *(const f32x4*)(w + 32 * bj + 8 * fq + 4 * n);
        const float sgn = fq == 0 ? -1.f : 1.f; const bool rl = fq < 2;
#pragma unroll
        for (int ai = 0; ai < 2; ++ai)
#pragma unroll
            for (int m = 0; m < 4; ++m) { const int row = row0 + ai * HALF + m * 16; float ss = 0.f;
#pragma unroll
                for (int bj = 0; bj < 2; ++bj)
#pragma unroll
                    for (int n = 0; n < 2; ++n) { const f32x4 a = acc[ai][bj][m][n]; ss += (a[0] * a[0] + a[1] * a[1]) + (a[2] * a[2] + a[3] * a[3]); }
                ss = xsum_fq(ss);
                const float rstd = rsqrtf(ss * (1.f / 64.f) + EPS) * sc;
                f32x4 v[2][2];
#pragma unroll
                for (int bj = 0; bj < 2; ++bj)
#pragma unroll
                    for (int n = 0; n < 2; ++n) v[bj][n] = acc[ai][bj][m][n] * rstd * g[bj][n];
                if (rope) {
#pragma unroll
                    for (int n = 0; n < 2; ++n) { f32x4 pr;
#pragma unroll
                        for (int e = 0; e < 4; ++e) pr[e] = xchg16(v[0][n][e], fq);
                        const f32x4 c = *(const f32x4*)(ROPE + (size_t)row * 16 + 4 * n), s = *(const f32x4*)(ROPE + (size_t)row * 16 + 8 + 4 * n);
                        const f32x4 r = v[0][n] * c + pr * s * sgn;
                        if (rl) v[0][n] = r; }
                }
                bf16_t* rowp = O + (size_t)row * NPROJ + col0;
#pragma unroll
                for (int bj = 0; bj < 2; ++bj) { u32x4 wv; wv.x = cvt_pk_bf16(v[bj][0][0], v[bj][0][1]); wv.y = cvt_pk_bf16(v[bj][0][2], v[bj][0][3]); wv.z = cvt_pk_bf16(v[bj][1][0], v[bj][1][1]); wv.w = cvt_pk_bf16(v[bj][1][2], v[bj][1][3]);
                    *(u32x4*)(rowp + bj * 32) = wv; } }
    }
};
template <int MODE> struct EpiResid {
    static constexpr bool PERM = true, AFTER_DRAIN = true;
    const float* xf; bf16_t* xb; float* outf; float* SS;
    __device__ __forceinline__ void fused(f32x4 (&acc)[2][2][4][2], const Unit& u, int wr, int wc, int fr, int fq, PG8_LAS unsigned char* lds, int wid, int lane) const {
        PG8_LAS float* P = (PG8_LAS float*)lds;
        const int col0 = u.pn * BM + wc * 32 + 8 * fq;
#pragma unroll
        for (int ai = 0; ai < 2; ++ai)
#pragma unroll
            for (int m = 0; m < 4; ++m) { const int r = ai * HALF + wr * 64 + m * 16 + fr; const size_t off = (size_t)(u.pm * BM + r) * DM + col0; float s = 0.f;
                const float rsc = MODE == 0 ? xf[u.pm * BM + r] : 1.f;
#pragma unroll
                for (int bj = 0; bj < 2; ++bj) { f32x4 b0, b1;
                    { const u32x4 w = *(const u32x4*)(xb + off + bj * HALF);
                        b0 = (f32x4){__uint_as_float(w.x << 16), __uint_as_float(w.x & 0xffff0000u), __uint_as_float(w.y << 16), __uint_as_float(w.y & 0xffff0000u)};
                        b1 = (f32x4){__uint_as_float(w.z << 16), __uint_as_float(w.z & 0xffff0000u), __uint_as_float(w.w << 16), __uint_as_float(w.w & 0xffff0000u)}; }
                    const f32x4 o0 = b0 * rsc + acc[ai][bj][m][0], o1 = b1 * rsc + acc[ai][bj][m][1];
                    if (MODE == 2) { __builtin_nontemporal_store(o0, (f32x4*)(outf + off + bj * HALF)); __builtin_nontemporal_store(o1, (f32x4*)(outf + off + bj * HALF + 4)); }
                    else { u32x4 w; w.x = cvt_pk_bf16(o0[0], o0[1]); w.y = cvt_pk_bf16(o0[2], o0[3]); w.z = cvt_pk_bf16(o1[0], o1[1]); w.w = cvt_pk_bf16(o1[2], o1[3]); *(u32x4*)(xb + off + bj * HALF) = w;
                        s += ((o0[0] * o0[0] + o0[1] * o0[1]) + (o0[2] * o0[2] + o0[3] * o0[3])) + ((o1[0] * o1[0] + o1[1] * o1[1]) + (o1[2] * o1[2] + o1[3] * o1[3])); } }
                if (MODE != 2) { s = xsum_fq(s); if (fq == 0) P[r * 4 + wc] = s; }
                if (MODE == 0 ? (m == 3) : false) asm volatile("" ::: "memory"); }
        if (MODE != 2) { PG8_LBAR();
            const int t = wid * 64 + lane; if (t < 256) { const f32x4 p = *(const PG8_LAS f32x4*)(P + t * 4); SS[(size_t)(u.pm * BM + t) * 4 + u.pn] = (p[0] + p[1]) + (p[2] + p[3]); } }
    }
};
struct EpiHeadNormK {
    static constexpr bool PERM = true, AFTER_DRAIN = true;
    bf16_t* MKn; const float* kw; const float* qw;
    __device__ __forceinline__ void fused(f32x4 (&acc)[2][2][4][2], const Unit& u, int wr, int wc, int fr, int fq, PG8_LAS unsigned char* lds, int wid, int lane) const {
        PG8_LAS float* P = (PG8_LAS float*)lds; PG8_LAS float* R = (PG8_LAS float*)(lds + 4096);
#pragma unroll
        for (int ai = 0; ai < 2; ++ai)
#pragma unroll
            for (int m = 0; m < 4; ++m) { float s = 0.f;
#pragma unroll
                for (int bj = 0; bj < 2; ++bj)
#pragma unroll
                    for (int n = 0; n < 2; ++n) { const f32x4 v = acc[ai][bj][m][n]; s += (v[0] * v[0] + v[1] * v[1]) + (v[2] * v[2] + v[3] * v[3]); }
                s = xsum_fq(s); if (fq == 0) P[(ai * HALF + wr * 64 + m * 16 + fr) * 4 + wc] = s; }
        PG8_LBAR();
        { const int t = wid * 64 + lane; if (t < 256) { const f32x4 p = *(const PG8_LAS f32x4*)(P + t * 4); R[t] = rsqrtf(((p[0] + p[1]) + (p[2] + p[3])) * (1.f / 256.f) + EPS); } }
        PG8_LBAR();
        const int c0 = wc * 32 + 8 * fq; f32x4 g[2][2];
#pragma unroll
        for (int bj = 0; bj < 2; ++bj)
#pragma unroll
            for (int n = 0; n < 2; ++n) { const f32x4 a = *(const f32x4*)(kw + c0 + bj * HALF + 4 * n), b = *(const f32x4*)(qw + c0 + bj * HALF + 4 * n); g[bj][n] = a * b * CM; }
        bf16_t* basep = MKn + (size_t)(u.pm * 4 + u.pn) * 65536;
#pragma unroll
        for (int ai = 0; ai < 2; ++ai)
#pragma unroll
            for (int m = 0; m < 4; ++m) { const int r = ai * HALF + wr * 64 + m * 16 + fr; const float rk = R[r];
#pragma unroll
                for (int bj = 0; bj < 2; ++bj) { const f32x4 v0 = acc[ai][bj][m][0] * rk * g[bj][0], v1 = acc[ai][bj][m][1] * rk * g[bj][1];
                    u32x4 w; w.x = cvt_pk_bf16(v0[0], v0[1]); w.y = cvt_pk_bf16(v0[2], v0[3]); w.z = cvt_pk_bf16(v1[0], v1[1]); w.w = cvt_pk_bf16(v1[2], v1[3]);
                    *(u32x4*)(basep + (size_t)r * 256 + c0 + bj * HALF) = w; } }
    }
};
struct EpiMemQ {
    static constexpr bool PERM = true, AFTER_DRAIN = true;
    bf16_t* MQ; const float* SS; PG8_LAS float* RQ;
    __device__ __forceinline__ void fused(f32x4 (&acc)[2][2][4][2], const Unit& u, int wr, int wc, int fr, int fq, PG8_LAS unsigned char* lds, int wid, int lane) const {
        PG8_LAS float* P = (PG8_LAS float*)lds;
        const int col0 = u.pn * BM + wc * 32 + 8 * fq;
#pragma unroll
        for (int ai = 0; ai < 2; ++ai)
#pragma unroll
            for (int m = 0; m < 4; ++m) { const int r = ai * HALF + wr * 64 + m * 16 + fr; const int row = u.pm * BM + r;
                const f32x4 ss = *(const f32x4*)(SS + (size_t)row * 4); const float rs = rsqrtf(((ss[0] + ss[1]) + (ss[2] + ss[3])) * (1.f / DM) + EPS); float s = 0.f;
#pragma unroll
                for (int bj = 0; bj < 2; ++bj) { const f32x4 v0 = acc[ai][bj][m][0] * rs, v1 = acc[ai][bj][m][1] * rs;
                    s += (v0[0] * v0[0] + v0[1] * v0[1]) + (v0[2] * v0[2] + v0[3] * v0[3]) + (v1[0] * v1[0] + v1[1] * v1[1]) + (v1[2] * v1[2] + v1[3] * v1[3]);
                    u32x4 w; w.x = cvt_pk_bf16(v0[0], v0[1]); w.y = cvt_pk_bf16(v0[2], v0[3]); w.z = cvt_pk_bf16(v1[0], v1[1]); w.w = cvt_pk_bf16(v1[2], v1[3]);
                    *(u32x4*)(MQ + (size_t)row * DM + col0 + bj * HALF) = w; }
                s = xsum_fq(s); if (fq == 0) P[r * 4 + wc] = s; }
        PG8_LBAR();
        { const int t = wid * 64 + lane; if (t < 256) { const f32x4 p = *(const PG8_LAS f32x4*)(P + t * 4); RQ[t] = rsqrtf(((p[0] + p[1]) + (p[2] + p[3])) * (1.f / 256.f) + EPS); } }
        PG8_LBAR();
    }
};
struct EpiMemS {
    static constexpr bool PERM = true, AFTER_DRAIN = true;
    bf16_t* Pt; int head; const PG8_LAS float* RQ; PG8_LAS float* IL;
    __device__ __forceinline__ void fused(f32x4 (&acc)[2][2][4][2], const Unit& u, int wr, int wc, int fr, int fq, PG8_LAS unsigned char* lds, int wid, int lane) const {
        PG8_LAS float* P = (PG8_LAS float*)lds;
        const int col0 = head * BM + wc * 32 + 8 * fq;
#pragma unroll
        for (int ai = 0; ai < 2; ++ai)
#pragma unroll
            for (int m = 0; m < 4; ++m) { const int r = ai * HALF + wr * 64 + m * 16 + fr; const int row = u.pm * BM + r; const float rq = RQ[r]; float s = 0.f;
#pragma unroll
                for (int bj = 0; bj < 2; ++bj) { f32x4 v0 = acc[ai][bj][m][0] * rq, v1 = acc[ai][bj][m][1] * rq;
#pragma unroll
                    for (int e = 0; e < 4; ++e) { v0[e] = __builtin_amdgcn_exp2f(v0[e]); v1[e] = __builtin_amdgcn_exp2f(v1[e]); }
                    s += (v0[0] + v0[1]) + (v0[2] + v0[3]) + (v1[0] + v1[1]) + (v1[2] + v1[3]);
                    u32x4 w; w.x = cvt_pk_bf16(v0[0], v0[1]); w.y = cvt_pk_bf16(v0[2], v0[3]); w.z = cvt_pk_bf16(v1[0], v1[1]); w.w = cvt_pk_bf16(v1[2], v1[3]);
                    *(u32x4*)(Pt + (size_t)row * DM + col0 + bj * HALF) = w; }
                s = xsum_fq(s); if (fq == 0) P[r * 4 + wc] = s; }
        PG8_LBAR();
        { const int t = wid * 64 + lane; if (t < 256) { const f32x4 p = *(const PG8_LAS f32x4*)(P + t * 4); IL[t] = 1.0f / ((p[0] + p[1]) + (p[2] + p[3])); } }
        PG8_LBAR();
    }
};
struct EpiMemPV {
    static constexpr bool PERM = true, AFTER_DRAIN = false;
    bf16_t* MO; int head; const PG8_LAS float* IL;
    __device__ __forceinline__ void operator()(const f32x4 (&acc)[2][2][4][2], const Unit& u, int wr, int wc, int fr, int fq) const {
        const int col0 = head * BM + wc * 32 + 8 * fq;
#pragma unroll
        for (int ai = 0; ai < 2; ++ai)
#pragma unroll
            for (int m = 0; m < 4; ++m) { const int r = ai * HALF + wr * 64 + m * 16 + fr; const int row = u.pm * BM + r; const float il = IL[r];
#pragma unroll
                for (int bj = 0; bj < 2; ++bj) { const f32x4 v0 = acc[ai][bj][m][0] * il, v1 = acc[ai][bj][m][1] * il;
                    u32x4 w; w.x = cvt_pk_bf16(v0[0], v0[1]); w.y = cvt_pk_bf16(v0[2], v0[3]); w.z = cvt_pk_bf16(v1[0], v1[1]); w.w = cvt_pk_bf16(v1[2], v1[3]);
                    *(u32x4*)(MO + (size_t)row * DM + col0 + bj * HALF) = w; } }
    }
};

template <class Epi, class Sched, bool ALIGN_EPI = false, bool SP2 = false>
__device__ __forceinline__ void gemm_phase(PG8_LAS unsigned char* lds, const Gemm g, const Sched& S, const Epi& E) {
    int tid_ = threadIdx.x; asm volatile("" : "+v"(tid_));
    const int tid = tid_, wid = __builtin_amdgcn_readfirstlane(tid >> 6), lane = tid & 63, wr = wid >> 2, wc = wid & 3, fr = lane & 15, fq = lane >> 4;
    const int K = g.K, nt = K / BK;
    unsigned voffA[2], voffB[2];
#pragma unroll
    for (int i = 0; i < 2; ++i) { int R, C; stage_rc(tid * 16 + i * 8192, R, C); const int Rb = Epi::PERM ? ((R & ~31) + perm32(R & 31)) : R;
        voffA[i] = (unsigned)(R * g.lda + C) * 2u; voffB[i] = (unsigned)(Rb * g.ldb + C) * 2u; }
    const size_t kstep = (size_t)(BK * 2);
    const size_t hsA = (size_t)HALF * g.lda * 2, hsB = (size_t)HALF * g.ldb * 2;
    const size_t tsA = 2 * hsA, tsB = 2 * hsB;
    const unsigned ldsw = (unsigned)wid * 1024u;
    const int aoff = lds_byte(wr * 64 + fr, fq * 8), boff = lds_byte(wc * 32 + fr, fq * 8);
#define PG8_SA(b, h) (((b) * 2 + (h)) * HTB)
#define PG8_SB(b, h) ((4 + (b) * 2 + (h)) * HTB)
#define PG8_STAGE(bufoff, gbase, voff) do { _Pragma("unroll") for (int _i = 0; _i < 2; ++_i) \
        __builtin_amdgcn_global_load_lds((const unsigned*)((const char*)(gbase) + (voff)[_i]), (PG8_LAS unsigned*)(lds + (bufoff) + ldsw + _i * 8192), 16, 0, 0); } while (0)
#define PG8_LDA(dst, b, h) do { _Pragma("unroll") for (int m = 0; m < 4; ++m) _Pragma("unroll") for (int k = 0; k < 2; ++k) dst[m][k] = *(const PG8_LAS bf16x8*)(lds + PG8_SA(b, h) + aoff + m * 2048 + k * 1024); } while (0)
#define PG8_LDB(dst, b, h) do { _Pragma("unroll") for (int n = 0; n < 2; ++n) _Pragma("unroll") for (int k = 0; k < 2; ++k) dst[n][k] = *(const PG8_LAS bf16x8*)(lds + PG8_SB(b, h) + boff + n * 2048 + k * 1024); } while (0)
#define PG8_MMA(ai, bj, At, Bt) do { __builtin_amdgcn_s_setprio(1); _Pragma("unroll") for (int m = 0; m < 4; ++m) _Pragma("unroll") for (int n = 0; n < 2; ++n) _Pragma("unroll") for (int k = 0; k < 2; ++k) \
        acc[ai][bj][m][n] = __builtin_amdgcn_mfma_f32_16x16x32_bf16(Bt[n][k], At[m][k], acc[ai][bj][m][n], 0, 0, 0); __builtin_amdgcn_s_setprio(0); } while (0)
#define PG8_WAIT_V(n) asm volatile("s_waitcnt vmcnt(" #n ")" ::: "memory")
#define PG8_WAIT_L(n) asm volatile("s_waitcnt lgkmcnt(" #n ")" ::: "memory")
#define PG8_BAR __builtin_amdgcn_s_barrier()
#define PG8_SCHED __builtin_amdgcn_sched_barrier(0)
    Unit cur, nxt; int ui = 0;
    if (!S.next(0, cur)) return;
    f32x4 acc[2][2][4][2];
#pragma unroll
    for (int a = 0; a < 2; ++a)
#pragma unroll
        for (int b = 0; b < 2; ++b)
#pragma unroll
            for (int m = 0; m < 4; ++m)
#pragma unroll
                for (int n = 0; n < 2; ++n) acc[a][b][m][n] = (f32x4){0.f, 0.f, 0.f, 0.f};
    bf16x8 At[4][2], B0[2][2], B1[2][2];
    const char* cA = (const char*)g.A + (size_t)cur.pm * tsA; const char* cB = (const char*)g.Bt + (size_t)cur.pn * tsB;
    S.a_ready(cur);
    if constexpr (SP2) {
        PG8_STAGE(PG8_SB(0, 0), cB, voffB); PG8_STAGE(PG8_SB(0, 1), cB + hsB, voffB); PG8_STAGE(PG8_SA(0, 0), cA, voffA); PG8_STAGE(PG8_SA(0, 1), cA + hsA, voffA);
        if (wr == 1) PG8_BAR;
        PG8_WAIT_V(2); PG8_BAR;
        PG8_STAGE(PG8_SB(1, 0), cB + kstep, voffB); PG8_STAGE(PG8_SA(1, 0), cA + kstep, voffA); PG8_STAGE(PG8_SB(1, 1), cB + hsB + kstep, voffB);
        PG8_WAIT_V(6); PG8_BAR;
    } else {
        PG8_STAGE(PG8_SB(0, 0), cB, voffB); PG8_STAGE(PG8_SA(0, 0), cA, voffA); PG8_STAGE(PG8_SB(0, 1), cB + hsB, voffB); PG8_STAGE(PG8_SA(0, 1), cA + hsA, voffA);
        if (wr == 1) PG8_BAR;
        PG8_WAIT_V(4); PG8_BAR;
        PG8_STAGE(PG8_SB(1, 0), cB + kstep, voffB); PG8_STAGE(PG8_SA(1, 0), cA + kstep, voffA); PG8_STAGE(PG8_SB(1, 1), cB + hsB + kstep, voffB);
        PG8_WAIT_V(6); PG8_BAR;
    }
    for (;;) {
        const bool has_next = S.next(ui + 1, nxt);
        const char* nA = has_next ? (const char*)g.A + (size_t)nxt.pm * tsA : cA; const char* nB = has_next ? (const char*)g.Bt + (size_t)nxt.pn * tsB : cB;
        for (int t = 0; t < nt; t += 2) {
            const bool last = (t == nt - 2);
            const char* a1 = cA + (size_t)(t + 1) * kstep;
            const char* a2 = last ? nA : cA + (size_t)(t + 2) * kstep; const char* b2 = last ? nB : cB + (size_t)(t + 2) * kstep;
            const char* a3 = a2 + kstep; const char* b3 = b2 + kstep;
            if (last && has_next) S.a_ready(nxt);
            if constexpr (SP2) {
            PG8_LDB(B0, 0, 0); PG8_LDB(B1, 0, 1); PG8_SCHED; PG8_LDA(At, 0, 0); PG8_STAGE(PG8_SA(1, 1), a1 + hsA, voffA);
            PG8_WAIT_V(8); PG8_WAIT_L(0); PG8_BAR; PG8_MMA(0, 0, At, B0); PG8_MMA(0, 1, At, B1); PG8_BAR; PG8_SCHED;
            PG8_LDA(At, 0, 1); PG8_STAGE(PG8_SB(0, 0), b2, voffB); PG8_STAGE(PG8_SB(0, 1), b2 + hsB, voffB); PG8_STAGE(PG8_SA(0, 0), a2, voffA);
            PG8_WAIT_V(8); PG8_WAIT_L(0); PG8_BAR; PG8_MMA(1, 0, At, B0); PG8_MMA(1, 1, At, B1); PG8_BAR; PG8_SCHED;
            PG8_LDB(B0, 1, 0); PG8_LDB(B1, 1, 1); PG8_SCHED; PG8_LDA(At, 1, 0); PG8_STAGE(PG8_SA(0, 1), a2 + hsA, voffA);
            PG8_WAIT_V(8); PG8_WAIT_L(0); PG8_BAR; PG8_MMA(0, 0, At, B0); PG8_MMA(0, 1, At, B1); PG8_BAR; PG8_SCHED;
            PG8_LDA(At, 1, 1); PG8_STAGE(PG8_SB(1, 0), b3, voffB); PG8_STAGE(PG8_SB(1, 1), b3 + hsB, voffB); PG8_STAGE(PG8_SA(1, 0), a3, voffA);
            PG8_WAIT_V(8); PG8_WAIT_L(0); PG8_BAR; PG8_MMA(1, 0, At, B0); PG8_MMA(1, 1, At, B1); PG8_BAR; PG8_SCHED;
            } else {
            PG8_LDB(B0, 0, 0); PG8_SCHED; PG8_LDA(At, 0, 0); PG8_STAGE(PG8_SA(1, 1), a1 + hsA, voffA);
            PG8_WAIT_L(8); PG8_BAR; PG8_WAIT_L(0); PG8_MMA(0, 0, At, B0); PG8_BAR; PG8_SCHED;
            PG8_LDB(B1, 0, 1); PG8_STAGE(PG8_SB(0, 0), b2, voffB);
            PG8_BAR; PG8_WAIT_L(0); PG8_MMA(0, 1, At, B1); PG8_BAR;
            PG8_LDA(At, 0, 1); PG8_STAGE(PG8_SA(0, 0), a2, voffA);
            PG8_BAR; PG8_WAIT_L(0); PG8_MMA(1, 0, At, B0); PG8_BAR; PG8_SCHED;
            PG8_STAGE(PG8_SB(0, 1), b2 + hsB, voffB);
            PG8_WAIT_V(6); PG8_BAR; PG8_MMA(1, 1, At, B1); PG8_BAR;
            PG8_LDB(B0, 1, 0); PG8_SCHED; PG8_LDA(At, 1, 0); PG8_STAGE(PG8_SA(0, 1), a2 + hsA, voffA);
            PG8_WAIT_L(8); PG8_BAR; PG8_WAIT_L(0); PG8_MMA(0, 0, At, B0); PG8_BAR; PG8_SCHED;
            PG8_LDB(B1, 1, 1); PG8_STAGE(PG8_SB(1, 0), b3, voffB);
            PG8_BAR; PG8_WAIT_L(0); PG8_MMA(0, 1, At, B1); PG8_BAR;
            PG8_LDA(At, 1, 1); PG8_STAGE(PG8_SA(1, 0), a3, voffA);
            PG8_BAR; PG8_WAIT_L(0); PG8_MMA(1, 0, At, B0); PG8_BAR; PG8_SCHED;
            PG8_STAGE(PG8_SB(1, 1), b3 + hsB, voffB);
            PG8_WAIT_V(6); PG8_BAR; PG8_MMA(1, 1, At, B1); PG8_BAR;
            }
        }
        if constexpr (ALIGN_EPI) { if (wr == 0) PG8_BAR; }
        if constexpr (!Epi::AFTER_DRAIN) { int fr2 = fr, fq2 = fq; asm volatile("" : "+v"(fr2), "+v"(fq2)); E(acc, cur, wr, wc, fr2, fq2); S.done(cur); }
        if (!has_next) break;
#pragma unroll
        for (int a = 0; a < 2; ++a)
#pragma unroll
            for (int b = 0; b < 2; ++b)
#pragma unroll
                for (int m = 0; m < 4; ++m)
#pragma unroll
                    for (int n = 0; n < 2; ++n) acc[a][b][m][n] = (f32x4){0.f, 0.f, 0.f, 0.f};
        cur = nxt; cA = nA; cB = nB; ++ui;
        if constexpr (ALIGN_EPI) { if (wr == 1) PG8_BAR; }
    }
    PG8_WAIT_V(0);
    if constexpr (!ALIGN_EPI) { if (wr == 0) PG8_BAR; }
    PG8_BAR;
    if constexpr (Epi::AFTER_DRAIN) { int fr2 = fr, fq2 = fq, lane2 = lane; asm volatile("" : "+v"(fr2), "+v"(fq2), "+v"(lane2)); E.fused(acc, cur, wr, wc, fr2, fq2, lds, wid, lane2); S.done(cur); }
#undef PG8_SA
#undef PG8_SB
#undef PG8_STAGE
#undef PG8_LDA
#undef PG8_LDB
#undef PG8_MMA
#undef PG8_WAIT_V
#undef PG8_WAIT_L
#undef PG8_BAR
#undef PG8_SCHED
}}

#define GAS __attribute__((address_space(1)))
#define LAS __attribute__((address_space(3)))
typedef unsigned v4u __attribute__((ext_vector_type(4)));
typedef float f32x4 __attribute__((ext_vector_type(4)));
typedef short bf16x8 __attribute__((ext_vector_type(8)));
typedef GAS unsigned gu32;
typedef GAS unsigned long long gu64;
#define RLX_AGENT __ATOMIC_RELAXED, __HIP_MEMORY_SCOPE_AGENT
#define LDS_WAIT() asm volatile("s_waitcnt lgkmcnt(0)" ::: "memory")
#define VM_WAIT() asm volatile("s_waitcnt vmcnt(0)" ::: "memory")
__device__ __forceinline__ unsigned long long rt() { return __builtin_amdgcn_s_memrealtime(); }
__device__ __forceinline__ unsigned pk2(float lo, float hi) { return (unsigned)f2bf(lo) | ((unsigned)f2bf(hi) << 16); }

#define XB_TMO      128
#define XB_XCNT(j)  (256  + 64 * (j))
#define XB_XSUB(j)  (1280 + 64 * (j))
#define XB_XGEN(j)  (2304 + 64 * (j))
#define XB_TOP      3328
#define XB_TOPGEN   3392
#define XL_SUB(j)   (3456 + 64 * (j))
#define XL_GEN(j)   (4480 + 64 * (j))
#define XCD_BAR_WORDS 5504
#define XB_SPIN_CAP (1u << 18)

__device__ __forceinline__ unsigned xb_ld(unsigned* p)              { return __hip_atomic_load(p, __ATOMIC_RELAXED, __HIP_MEMORY_SCOPE_AGENT); }
__device__ __forceinline__ unsigned xb_add(unsigned* p, unsigned v) { return __hip_atomic_fetch_add(p, v, __ATOMIC_RELAXED, __HIP_MEMORY_SCOPE_AGENT); }
__device__ __forceinline__ unsigned xb_xcc_id() { return (unsigned)__builtin_amdgcn_s_getreg((3 << 11) | 20) & 0xFu; }
#define XB_SPIN(cond, bar) do { unsigned _sp = 0; while (cond) { __builtin_amdgcn_s_sleep(1); \
    if ((++_sp & 255u) == 0u) { if (xb_ld(&(bar)[XB_TMO])) break; if (_sp > XB_SPIN_CAP) { atomicAdd(&(bar)[XB_TMO], 1u); break; } } } } while (0)

struct XcdBarrier {
    unsigned* bar; unsigned x;
    volatile LAS unsigned* st;
};

__device__ __forceinline__ XcdBarrier xcd_barrier_post(unsigned* bar, volatile LAS unsigned* st) {
    XcdBarrier b; b.bar = bar; b.x = xb_xcc_id(); b.st = st;
    if (threadIdx.x == 0) st[2] = xb_add(&bar[XB_XCNT(b.x)], 1u);
    return b;
}
__device__ __forceinline__ void xcd_barrier_complete(unsigned* bar, unsigned x, unsigned& nloc, unsigned& nx) {
    const unsigned G = gridDim.x * gridDim.y * gridDim.z;
    unsigned sum, cnt, mine, sp = 0u;
    for (;;) {
        sum = 0u; cnt = 0u; mine = 0u;
#pragma unroll
        for (unsigned j = 0; j < 16; ++j) { const unsigned c = xb_ld(&bar[XB_XCNT(j)]); sum += c; cnt += (c > 0u) ? 1u : 0u; mine = (j == x) ? c : mine; }
        if (sum == G) break;
        __builtin_amdgcn_s_sleep(1);
        if ((++sp & 255u) == 0u) { if (xb_ld(&bar[XB_TMO])) break; if (sp > XB_SPIN_CAP) { atomicAdd(&bar[XB_TMO], 1u); break; } }
    }
    nloc = mine > 0u ? mine : 1u; nx = cnt > 0u ? cnt : 1u;
}
__device__ __forceinline__ unsigned xcd_census_even(unsigned* bar) {
    unsigned ok = (gridDim.x == 256u) ? 1u : 0u;
#pragma unroll
    for (unsigned j = 0; j < 8; ++j) ok &= (xb_ld(&bar[XB_XCNT(j)]) == 32u) ? 1u : 0u;
    return ok;
}

__device__ __forceinline__ void xcd_barrier(const XcdBarrier& b) {
    asm volatile("s_waitcnt vmcnt(0)" ::: "memory");
    __syncthreads();
    if (threadIdx.x == 0) {
        unsigned* bar = b.bar;
        __builtin_amdgcn_s_waitcnt(0);
        unsigned nloc = b.st[0], nx = b.st[1];
        if (nloc == 0u) { xcd_barrier_complete(bar, b.x, nloc, nx); b.st[0] = nloc; b.st[1] = nx; b.st[3] = xcd_census_even(bar); }
        const unsigned old = xb_add(&bar[XB_XSUB(b.x)], 1u);
        const unsigned gen = old / nloc;
        if (old + 1u == (gen + 1u) * nloc) {
            __builtin_amdgcn_fence(__ATOMIC_RELEASE, "agent");
            asm volatile("s_waitcnt vmcnt(0)" ::: "memory");
            const unsigned og = xb_add(&bar[XB_TOP], 1u);
            const unsigned tg = og / nx;
            if (og + 1u == (tg + 1u) * nx) xb_add(&bar[XB_TOPGEN], 1u);
            else XB_SPIN(xb_ld(&bar[XB_TOPGEN]) == tg, bar);
            __builtin_amdgcn_fence(__ATOMIC_ACQUIRE, "agent");
            xb_add(&bar[XB_XGEN(b.x)], 1u);
            asm volatile("s_waitcnt vmcnt(0)" ::: "memory");
        } else {
            XB_SPIN(xb_ld(&bar[XB_XGEN(b.x)]) == gen, bar);
            __builtin_amdgcn_fence(__ATOMIC_ACQUIRE, "agent");
            asm volatile("s_waitcnt vmcnt(0)" ::: "memory");
        }
    }
    __syncthreads();
}

__device__ __forceinline__ void xcc_barrier(const XcdBarrier& b) {
    asm volatile("s_waitcnt vmcnt(0)" ::: "memory");
    __syncthreads();
    if (threadIdx.x == 0) {
        unsigned* bar = b.bar;
        const unsigned old = xb_add(&bar[XL_SUB(b.x)], 1u);
        const unsigned gen = old / 32u;
        if (old + 1u == (gen + 1u) * 32u) xb_add(&bar[XL_GEN(b.x)], 1u);
        else XB_SPIN(xb_ld(&bar[XL_GEN(b.x)]) == gen, bar);
        __builtin_amdgcn_fence(__ATOMIC_ACQUIRE, "agent");
        asm volatile("s_waitcnt vmcnt(0)" ::: "memory");
    }
    __syncthreads();
}

constexpr int NWAVES = 8;
constexpr int RING_OFF = 0, RING_BYTES = 131072;
constexpr int LDSCTL_OFF = 158720, MISC_OFF = LDSCTL_OFF + 320;
constexpr int LDS_RQ = LDSCTL_OFF + 1024, LDS_IL = LDSCTL_OFF + 2048;
constexpr int LDS_BYTES = 163840;
constexpr int CW_TMO = 0, CW_BAR = 4096;

struct Frame {
    LAS unsigned char* lds; volatile LAS unsigned* MISC; gu32* ctl;
    int tid, lane, wave, vcu, G;
};
struct Args { const void* in[26]; float* out; unsigned char* ws; int ph_lo, ph_hi; };

__device__ __forceinline__ float wave_sum(float v) {
#pragma unroll
    for (int o = 1; o < 64; o <<= 1) v += __shfl_xor(v, o);
    return v;
}
template <bool HEADPERM, bool WT = false> __device__ __forceinline__ void p0_transpose_item(const float* W, int ldw, int K, int N, const float* g, bf16_t* WT_, LAS float* scr, int item, int lane) {
    const int nblk = N / 32, kb = item / nblk, nb = item % nblk, k0 = 64 * kb, n0 = 32 * nb;
    const int r8 = lane >> 3, c4 = (lane & 7) * 4;
    f32x4 v[8]; float gg[8];
#pragma unroll
    for (int i = 0; i < 8; ++i) { v[i] = __builtin_nontemporal_load((const GAS f32x4*)(W + (size_t)(k0 + r8 + 8 * i) * ldw + n0 + c4)); gg[i] = g ? g[k0 + r8 + 8 * i] : 1.f; }
#pragma unroll
    for (int i = 0; i < 8; ++i) { LAS float* d = scr + (r8 + 8 * i) * 33 + c4; const f32x4 x = v[i] * gg[i]; d[0] = x.x; d[1] = x.y; d[2] = x.z; d[3] = x.w; }
    LDS_WAIT(); asm volatile("" ::: "memory");
    const int c = lane & 7;
#pragma unroll
    for (int j = 0; j < 4; ++j) { const int n = (lane >> 3) + 8 * j; const LAS float* s = scr + (8 * c) * 33 + n;
        v4u o; o.x = pk2(s[0 * 33], s[1 * 33]); o.y = pk2(s[2 * 33], s[3 * 33]); o.z = pk2(s[4 * 33], s[5 * 33]); o.w = pk2(s[6 * 33], s[7 * 33]);
        int nr = n0 + n; if (HEADPERM) { const int l = nr & 255; nr = (nr & ~255) | (((l >> 5) & 1) * 128 + (l >> 6) * 32 + (l & 31)); }
        if (WT) { const __amdgpu_buffer_rsrc_t rs_ = __builtin_amdgcn_make_buffer_rsrc((void*)WT_, (short)0, 0x7fffffff, 0x00020000); __builtin_amdgcn_raw_buffer_store_b128(o, rs_, (int)(((size_t)nr * K + k0 + 8 * c) * 2), 0, 16); }
        else *(GAS v4u*)(WT_ + (size_t)nr * K + k0 + 8 * c) = o; }
    LDS_WAIT(); asm volatile("" ::: "memory");
}
template <bool FLOG> __device__ __forceinline__ void rms_rows_to_bf16(int lane, const float* X, bf16_t* O, int m0, int step, int rows, const float* g, const float* win, float* flog, float* rs0) {
    if (m0 >= rows) return;
    f32x4 wf[4][4][2];
    if (FLOG) {
#pragma unroll
        for (int j = 0; j < 4; ++j) { const f32x4 gg = *(const GAS f32x4*)(g + 256 * j + 4 * lane);
#pragma unroll
            for (int e = 0; e < 4; ++e) { const int k = 256 * j + 4 * lane + e; wf[j][e][0] = *(const GAS f32x4*)(win + (size_t)k * INCOLS + NPROJ) * gg[e]; wf[j][e][1] = *(const GAS f32x4*)(win + (size_t)k * INCOLS + NPROJ + 4) * gg[e]; } }
    }
    f32x4 nx[4], nx2[4];
    { const GAS f32x4* xr = (const GAS f32x4*)(X + (size_t)m0 * DM) + lane;
#pragma unroll
      for (int j = 0; j < 4; ++j) nx[j] = __builtin_nontemporal_load(xr + 64 * j);
      if (m0 + step < rows) { const GAS f32x4* xr2 = (const GAS f32x4*)(X + (size_t)(m0 + step) * DM) + lane;
#pragma unroll
          for (int j = 0; j < 4; ++j) nx2[j] = __builtin_nontemporal_load(xr2 + 64 * j); } }
    for (int m = m0; m < rows; m += step) {
        f32x4 v[4];
#pragma unroll
        for (int j = 0; j < 4; ++j) { v[j] = nx[j]; nx[j] = nx2[j]; }
        if (m + 2 * step < rows) { const GAS f32x4* xr = (const GAS f32x4*)(X + (size_t)(m + 2 * step) * DM) + lane;
#pragma unroll
            for (int j = 0; j < 4; ++j) nx2[j] = __builtin_nontemporal_load(xr + 64 * j); }
        float s2 = 0.f;
#pragma unroll
        for (int j = 0; j < 4; ++j) s2 += (v[j].x * v[j].x + v[j].y * v[j].y) + (v[j].z * v[j].z + v[j].w * v[j].w);
        const float ms_ = wave_sum(s2) * (1.f / DM) + EPS; const float rstd = rsqrtf(ms_);
        if (FLOG) { if (lane == 0) rs0[m] = sqrtf(ms_); }
        GAS unsigned long long* o8 = (GAS unsigned long long*)(O + (size_t)m * DM) + lane;
#pragma unroll
        for (int j = 0; j < 4; ++j) { v[j] = v[j] * rstd; o8[64 * j] = (unsigned long long)pk2(v[j].x, v[j].y) | ((unsigned long long)pk2(v[j].z, v[j].w) << 32); }
        if (FLOG) {
            f32x4 a0 = {0.f, 0.f, 0.f, 0.f}, a1 = {0.f, 0.f, 0.f, 0.f};
#pragma unroll
            for (int j = 0; j < 4; ++j)
#pragma unroll
                for (int e = 0; e < 4; ++e) { a0 += wf[j][e][0] * v[j][e]; a1 += wf[j][e][1] * v[j][e]; }
            { const bool b0 = lane & 1, b1 = lane & 2, b2 = lane & 4;
              const f32x4 snd = b0 ? a0 : a1, kp = b0 ? a1 : a0; f32x4 rc;
#pragma unroll
              for (int e = 0; e < 4; ++e) rc[e] = __shfl_xor(snd[e], 1);
              const f32x4 w4 = kp + rc;
              const float s0 = b1 ? w4[0] : w4[2], s1 = b1 ? w4[1] : w4[3], k0 = b1 ? w4[2] : w4[0], k1 = b1 ? w4[3] : w4[1];
              const float w20 = k0 + __shfl_xor(s0, 2), w21 = k1 + __shfl_xor(s1, 2);
              float w1 = (b2 ? w21 : w20) + __shfl_xor(b2 ? w20 : w21, 4);
              w1 += __shfl_xor(w1, 8); w1 += __shfl_xor(w1, 16); w1 += __shfl_xor(w1, 32);
              if (lane < 8) flog[(size_t)m * 8 + 4 * (lane & 1) + (lane & 2) + ((lane >> 2) & 1)] = w1; }
        }
    }
}
__constant__ float INV_FREQ[8] = {1.0f, 0.1939227432012558f, 0.03760603070259094f, 0.007292664609849453f, 0.0014142135623842478f, 0.00027424818836152554f, 5.318296098266728e-05f, 1.0313386155758053e-05f};

struct Ptrs {
    const float *x, *mem; const int* pos; const float *norm_mix_w, *w_in, *b_forget, *dqw, *dkw, *lq1, *lk1, *lq2, *lk2, *subw, *fqw, *fkw, *w_out, *nmq, *nmkv, *w_mq, *w_mkv, *mqw, *mkw, *w_mo, *nmlp, *w_up, *w_dn;
    float* out; float *FLOG, *CUMB, *ROPE, *SS, *QKW, *RS0;
    bf16_t *WIN, *WOUT, *WQ, *WKV, *WO, *WUP, *WDN, *XB, *HM, *MK, *VT, *MKN, *PROJ, *ATT, *MQ, *MO, *H;
};
__host__ __device__ __forceinline__ Ptrs make_ptrs(const void* const* in, float* out, unsigned char* ws) {
    Ptrs p;
    p.x = (const float*)in[0]; p.mem = (const float*)in[1]; p.pos = (const int*)in[2]; p.norm_mix_w = (const float*)in[3]; p.w_in = (const float*)in[4]; p.b_forget = (const float*)in[5];
    p.dqw = (const float*)in[6]; p.dkw = (const float*)in[7]; p.lq1 = (const float*)in[8]; p.lk1 = (const float*)in[9]; p.lq2 = (const float*)in[10]; p.lk2 = (const float*)in[11];
    p.subw = (const float*)in[12]; p.fqw = (const float*)in[13]; p.fkw = (const float*)in[14]; p.w_out = (const float*)in[15]; p.nmq = (const float*)in[16]; p.nmkv = (const float*)in[17];
    p.w_mq = (const float*)in[18]; p.w_mkv = (const float*)in[19]; p.mqw = (const float*)in[20]; p.mkw = (const float*)in[21]; p.w_mo = (const float*)in[22]; p.nmlp = (const float*)in[23];
    p.w_up = (const float*)in[24]; p.w_dn = (const float*)in[25]; p.out = out;
    p.FLOG = (float*)(ws + WS_FLOG); p.CUMB = (float*)(ws + WS_CUMB); p.ROPE = (float*)(ws + WS_ROPE); p.SS = (float*)(ws + WS_SS); p.QKW = (float*)(ws + WS_QKW); p.RS0 = (float*)(ws + WS_RS0);
    p.WIN = (bf16_t*)(ws + WS_WIN); p.WOUT = (bf16_t*)(ws + WS_WOUT); p.WQ = (bf16_t*)(ws + WS_WQ); p.WKV = (bf16_t*)(ws + WS_WKV); p.WO = (bf16_t*)(ws + WS_WO); p.WUP = (bf16_t*)(ws + WS_WUP); p.WDN = (bf16_t*)(ws + WS_WDN);
    p.XB = (bf16_t*)(ws + WS_XB); p.HM = (bf16_t*)(ws + WS_HM); p.MK = (bf16_t*)(ws + WS_MK); p.VT = (bf16_t*)(ws + WS_VT); p.MKN = (bf16_t*)(ws + WS_MKN);
    p.PROJ = (bf16_t*)(ws + WS_PROJ); p.ATT = (bf16_t*)(ws + WS_ATT); p.MQ = (bf16_t*)(ws + WS_MQ); p.MO = (bf16_t*)(ws + WS_MO); p.H = (bf16_t*)(ws + WS_H);
    return p;
}

__device__ __forceinline__ void p0_prologue(Frame& F, const Ptrs& P) {
    LAS float* scr = (LAS float*)(F.lds + RING_OFF + F.wave * 16384);
    const int gw = F.vcu * NWAVES + F.wave, NGW = F.G * NWAVES;
    constexpr int I_IN = 16 * 96, I_KV = 16 * 64, I_OUT = 16 * 32;
    constexpr int NITEMS = I_IN + I_KV + I_OUT;
    for (int it = gw; it < NITEMS; it += NGW) {
        if (it < I_IN) p0_transpose_item<true>(P.w_in, INCOLS, DM, NPROJ, P.norm_mix_w, P.WIN, scr, it, F.lane);
        else if (it < I_IN + I_KV) p0_transpose_item<false>(P.w_mkv, 2048, DM, 2048, P.nmkv, P.WKV, scr, it - I_IN, F.lane);
        else p0_transpose_item<false>(P.w_out, DM, DM, DM, nullptr, P.WOUT, scr, it - I_IN - I_KV, F.lane);
    }
    rms_rows_to_bf16<true>(F.lane, P.x, P.XB, gw, NGW, MTOK, P.norm_mix_w, P.w_in, P.FLOG, P.RS0);
    rms_rows_to_bf16<false>(F.lane, P.mem, P.HM, gw, NGW, MMEM, nullptr, nullptr, nullptr, nullptr);
    if (blockIdx.x == 0 && F.tid < 64) { const int t = F.tid; P.QKW[t] = P.dqw[t]; P.QKW[64 + t] = P.dkw[t]; P.QKW[128 + t] = P.fqw[t]; P.QKW[192 + t] = P.fkw[t]; }
    for (int id = (F.vcu * NWAVES * 64) + F.tid; id < MTOK * 8; id += F.G * NWAVES * 64) {
        const int row = id >> 3, i = id & 7;
        const float ang = (float)P.pos[row] * INV_FREQ[i];
        const double a = (double)ang; const double k = rint(a * 0.15915494309189535); const float r = (float)fma(-k, 6.283185307179586, a);
        P.ROPE[(size_t)row * 16 + i] = cosf(r); P.ROPE[(size_t)row * 16 + 8 + i] = sinf(r);
    }
}
__device__ __forceinline__ void p1b_row(bf16_t* PROJ, const float* dqw, const float* dkw, const float* fqw, const float* fkw, const float* ROPE, int row, int lane) {
    const int sg = lane >> 1, hf = lane & 1;
    const int col = (sg < 16 ? sg * 64 : 1536 + (sg - 16) * 64) + hf * 32;
    const float* w = (sg < 8 ? dqw : sg < 16 ? dkw : sg < 24 ? fqw : fkw) + hf * 32;
    const bool rope = (sg < 16) && (hf == 0), isq = (sg < 8) || (sg >= 16 && sg < 24);
    GAS v4u* p = (GAS v4u*)(PROJ + (size_t)row * NPROJ + col);
    const v4u u0 = p[0], u1 = p[1], u2 = p[2], u3 = p[3];
#define UNP_LO(u) (f32x4){__uint_as_float(u.x << 16), __uint_as_float(u.x & 0xffff0000u), __uint_as_float(u.y << 16), __uint_as_float(u.y & 0xffff0000u)}
#define UNP_HI(u) (f32x4){__uint_as_float(u.z << 16), __uint_as_float(u.z & 0xffff0000u), __uint_as_float(u.w << 16), __uint_as_float(u.w & 0xffff0000u)}
    f32x4 v0 = UNP_LO(u0), v1 = UNP_HI(u0), v2 = UNP_LO(u1), v3 = UNP_HI(u1), v4 = UNP_LO(u2), v5 = UNP_HI(u2), v6 = UNP_LO(u3), v7 = UNP_HI(u3);
#undef UNP_LO
#undef UNP_HI
#define SQ4(v) ((v.x * v.x + v.y * v.y) + (v.z * v.z + v.w * v.w))
    float ss = (SQ4(v0) + SQ4(v1)) + (SQ4(v2) + SQ4(v3)) + (SQ4(v4) + SQ4(v5)) + (SQ4(v6) + SQ4(v7));
#undef SQ4
    ss += __shfl_xor(ss, 1);
    const float rstd = rsqrtf(ss * (1.f / 64.f) + EPS);
    const GAS f32x4* wg = (const GAS f32x4*)w;
    v0 = v0 * rstd * wg[0]; v1 = v1 * rstd * wg[1]; v2 = v2 * rstd * wg[2]; v3 = v3 * rstd * wg[3]; v4 = v4 * rstd * wg[4]; v5 = v5 * rstd * wg[5]; v6 = v6 * rstd * wg[6]; v7 = v7 * rstd * wg[7];
    if (rope) {
        const GAS f32x4* rt = (const GAS f32x4*)(ROPE + (size_t)row * 16);
        const f32x4 c0 = rt[0], c1 = rt[1], s0 = rt[2], s1 = rt[3];
        const f32x4 a0 = v0 * c0 - v2 * s0, b0 = v2 * c0 + v0 * s0, a1 = v1 * c1 - v3 * s1, b1 = v3 * c1 + v1 * s1;
        v0 = a0; v2 = b0; v1 = a1; v3 = b1;
    }
    const float sc = isq ? C2 : 1.f;
#define PK4(a, b) (v4u){pk2(a.x * sc, a.y * sc), pk2(a.z * sc, a.w * sc), pk2(b.x * sc, b.y * sc), pk2(b.z * sc, b.w * sc)}
    p[0] = PK4(v0, v1); p[1] = PK4(v2, v3); p[2] = PK4(v4, v5); p[3] = PK4(v6, v7);
#undef PK4
}
__device__ __forceinline__ void p1b_cumsum_wg(const float* FLOG, const float* b_forget, float* CUMB, int seq, int tid, LAS float* scr) {
    const int b = seq >> 3, h = seq & 7, lane = tid & 63, wv = tid >> 6; const float bf = b_forget[h];
    float lf[4]; float run = 0.f;
#pragma unroll
    for (int i = 0; i < 4; ++i) { const float z = FLOG[(size_t)(b * SEQ + tid * 4 + i) * 8 + h] + bf; const float e = __expf(-fabsf(z)); lf[i] = fminf(z, 0.f) - log1pf(e); run += lf[i]; }
    float inc = run;
#pragma unroll
    for (int o = 1; o < 64; o <<= 1) { const float t = __shfl_up(inc, o); if (lane >= o) inc += t; }
    if (lane == 63) scr[wv] = inc;
    __syncthreads();
    float base = 0.f;
#pragma unroll
    for (int w = 0; w < 8; ++w) { const float t = scr[w]; if (w < wv) base += t; }
    float c = base + inc - run;
    f32x4 o;
#pragma unroll
    for (int i = 0; i < 4; ++i) { c += lf[i]; o[i] = -c * LOG2E; }
    *(GAS f32x4*)(CUMB + (size_t)seq * SEQ + tid * 4) = o;
    __syncthreads();
}
__device__ __forceinline__ void p1b_cumsum(const Ptrs& P, int seq, int lane) {
    const int b = seq >> 3, h = seq & 7; const float bf = P.b_forget[h];
    float lf[32]; float run = 0.f;
#pragma unroll
    for (int i = 0; i < 32; ++i) { const float z = P.FLOG[(size_t)(b * SEQ + lane * 32 + i) * 8 + h] + bf;
        const float e = __expf(-fabsf(z)); lf[i] = fminf(z, 0.f) - log1pf(e); run += lf[i]; }
    float inc = run;
#pragma unroll
    for (int o = 1; o < 64; o <<= 1) { const float t = __shfl_up(inc, o); if (lane >= o) inc += t; }
    float c = inc - run;
#pragma unroll
    for (int i = 0; i < 32; ++i) { c += lf[i]; P.CUMB[(size_t)seq * SEQ + lane * 32 + i] = -c * LOG2E; }
}
#ifndef PROBE_K
#define PROBE_K -1
#endif
struct Sched {
    pg8::StaticOrder so; int mode, pm, pn; bool has;
    __device__ __forceinline__ bool next(int i, pg8::Unit& u) const { if (mode == 0) return so.next(i, u); if (i != 0 || !has) return false; u.pm = pm; u.pn = pn; return true; }
    __device__ __forceinline__ void a_ready(const pg8::Unit&) const {}
    __device__ __forceinline__ void done(const pg8::Unit&) const {}
};
__device__ __forceinline__ Sched sched_static(int M, int N, int G, int c) { Sched s; s.so.init(M, N, G, c); s.mode = 0; s.pm = 0; s.pn = 0; s.has = true; return s; }
__device__ __forceinline__ Sched sched_one(int pm, int pn, bool has) { Sched s; s.so.init(256, 256, 1, 0); s.mode = 1; s.pm = pm; s.pn = pn; s.has = has; return s; }

#include <hip/hip_bf16.h>
#include <cmath>
namespace ab {
using bf16=__hip_bfloat16;
using bf16x8=__attribute__((ext_vector_type(8)))short;
using s16x4=__attribute__((ext_vector_type(4)))short;
using f32x16=__attribute__((ext_vector_type(16)))float;
using u32x4=__attribute__((ext_vector_type(4)))unsigned;
using f32x4v=__attribute__((ext_vector_type(4)))float;
constexpr int D=64,PIN=NPROJ;
constexpr int NW=8,QBLK=32,QB=QBLK*NW,KVBLK=64;
__device__ __forceinline__ int crow(int r,int hi){return (r&3)+8*(r>>2)+4*hi;}
#define SBAR() __builtin_amdgcn_sched_barrier(0)
__device__ __forceinline__ void cmask(f32x16&p0,f32x16&p1,int jb,int qrel,int hi){
  const float NEG=-INFINITY; int kb=64*jb+4*hi;
  #pragma unroll
  for(int r=0;r<16;++r){int kv=kb+(r&3)+8*(r>>2); if(kv>qrel)p0[r]=NEG; if(kv+32>qrel)p1[r]=NEG;}
}

__device__ __forceinline__ void kmask(f32x16&p0,f32x16&p1,int jb,int wid){
  if(jb>(wid>>1)){const float NEG=-INFINITY;
  #pragma unroll
  for(int r=0;r<16;++r){p0[r]=NEG;p1[r]=NEG;}}
}

constexpr int NSLOT=4, SLOTB=8192;
constexpr int LDS_K=0, LDS_V=NSLOT*SLOTB, LDS_WS=2*NSLOT*SLOTB, LDS_OST=LDS_WS+NW*64*4, LDS_BIAS=LDS_OST+NW*4096, LDS_BYTES=LDS_BIAS+32768;
__device__ __forceinline__ void glds16(const void*gsrc,unsigned lds_dst){unsigned keep;
  asm volatile("s_mov_b32 %0, m0\n\ts_mov_b32 m0, %2\n\ts_nop 0\n\tglobal_load_lds_dwordx4 %1, off\n\ts_mov_b32 m0, %0":"=&s"(keep):"v"(gsrc),"s"(lds_dst):"memory");}
__device__ __forceinline__ float max3f(float a,float b,float c){float r;asm("v_max3_f32 %0, %1, %2, %3":"=v"(r):"v"(a),"v"(b),"v"(c));return r;}
__device__ __forceinline__ float max2f(float a,float b){float r;asm("v_max_f32_e32 %0, %1, %2":"=v"(r):"v"(a),"v"(b));return r;}
__device__ __forceinline__ float fadd_s(float a,float b){float r;asm("v_add_f32_e32 %0, %1, %2":"=v"(r):"v"(a),"v"(b));return r;}
__device__ __forceinline__ float fsub_s(float a,float b){float r;asm("v_sub_f32_e32 %0, %1, %2":"=v"(r):"v"(a),"v"(b));return r;}
__device__ __forceinline__ float fmul_s(float a,float b){float r;asm("v_mul_f32_e32 %0, %1, %2":"=v"(r):"v"(a),"v"(b));return r;}
typedef float f32x2_t __attribute__((ext_vector_type(2))); typedef __bf16 bf16x2_t __attribute__((ext_vector_type(2)));
__device__ __forceinline__ unsigned cvtpk_s(float lo,float hi){f32x2_t v={lo,hi};bf16x2_t b=__builtin_convertvector(v,bf16x2_t);return __builtin_bit_cast(unsigned,b);}
#define WAIT_BAR(N) asm volatile("s_waitcnt vmcnt(" #N ") lgkmcnt(0)\n\ts_barrier":::"memory")

__device__ __forceinline__ void qkt(f32x16&p0,f32x16&p1,const char*Kslot,const bf16x8*qr,const f32x16&negm,int r32,int hi){
  const char*kb=Kslot+hi*1024+r32*16;
  #pragma unroll
  for(int d0=0;d0<4;++d0){
    const bf16x8 b0=*reinterpret_cast<const bf16x8*>(kb+d0*2048);
    const bf16x8 b1=*reinterpret_cast<const bf16x8*>(kb+d0*2048+512);
    if(d0==0){p0=__builtin_amdgcn_mfma_f32_32x32x16_bf16(b0,qr[0],negm,0,0,0);p1=__builtin_amdgcn_mfma_f32_32x32x16_bf16(b1,qr[0],negm,0,0,0);}
    else{p0=__builtin_amdgcn_mfma_f32_32x32x16_bf16(b0,qr[d0],p0,0,0,0);p1=__builtin_amdgcn_mfma_f32_32x32x16_bf16(b1,qr[d0],p1,0,0,0);}}
}
typedef __attribute__((address_space(3))) const char* lds_cptr;
typedef short v4i16_t __attribute__((ext_vector_type(4)));
__device__ __forceinline__ void kload8(bf16x8*kf,lds_cptr kp){
  kf[0]=*(const __attribute__((address_space(3))) bf16x8*)(kp);      kf[1]=*(const __attribute__((address_space(3))) bf16x8*)(kp+512);
  kf[2]=*(const __attribute__((address_space(3))) bf16x8*)(kp+2048); kf[3]=*(const __attribute__((address_space(3))) bf16x8*)(kp+2560);
  kf[4]=*(const __attribute__((address_space(3))) bf16x8*)(kp+4096); kf[5]=*(const __attribute__((address_space(3))) bf16x8*)(kp+4608);
  kf[6]=*(const __attribute__((address_space(3))) bf16x8*)(kp+6144); kf[7]=*(const __attribute__((address_space(3))) bf16x8*)(kp+6656);
}
__device__ __forceinline__ void kload2(bf16x8*kf,lds_cptr kp,int j){ kf[2*j]=*(const __attribute__((address_space(3))) bf16x8*)(kp+j*2048); kf[2*j+1]=*(const __attribute__((address_space(3))) bf16x8*)(kp+j*2048+512); }
__device__ __forceinline__ s16x4 vtr(lds_cptr p){ return __builtin_bit_cast(s16x4,__builtin_amdgcn_ds_read_tr16_b64_v4i16((__attribute__((address_space(3))) v4i16_t*)p)); }
__device__ __forceinline__ float rowmax(const f32x16&p0,const f32x16&p1){
  float a=max3f(p0[0],p0[1],p1[0]),b=max3f(p0[2],p0[3],p1[1]);a=max3f(a,p1[2],p1[3]);
  #pragma unroll
  for(int r=4;r<16;r+=4){a=max3f(a,p0[r],p0[r+1]);b=max3f(b,p0[r+2],p0[r+3]);a=max3f(a,p1[r],p1[r+1]);b=max3f(b,p1[r+2],p1[r+3]);}
  const float m=max2f(a,b);
  auto rr=__builtin_amdgcn_permlane32_swap(__float_as_uint(m),__float_as_uint(m),false,false);
  return max2f(__uint_as_float(rr[0]),__uint_as_float(rr[1]));
}
__device__ __forceinline__ void pv(f32x16*o,int vb,bf16x8 pa0,bf16x8 pa1,bf16x8 pa2,bf16x8 pa3){
  #pragma unroll
  for(int d0=0;d0<2;++d0){s16x4 lo[4],hi[4];
    #pragma unroll
    for(int ks=0;ks<4;++ks){
      asm volatile("ds_read_b64_tr_b16 %0,%1 offset:%c2":"=&v"(lo[ks]):"v"(vb),"i"(d0*4096+ks*1024):"memory");
      asm volatile("ds_read_b64_tr_b16 %0,%1 offset:%c2":"=&v"(hi[ks]):"v"(vb),"i"(d0*4096+ks*1024+512):"memory");}
    asm volatile("s_waitcnt lgkmcnt(0)":::"memory");SBAR();
    #define PK(k) (bf16x8){lo[k][0],lo[k][1],lo[k][2],lo[k][3],hi[k][0],hi[k][1],hi[k][2],hi[k][3]}
    o[d0]=__builtin_amdgcn_mfma_f32_32x32x16_bf16(pa0,PK(0),o[d0],0,0,0);
    o[d0]=__builtin_amdgcn_mfma_f32_32x32x16_bf16(pa1,PK(1),o[d0],0,0,0);
    o[d0]=__builtin_amdgcn_mfma_f32_32x32x16_bf16(pa2,PK(2),o[d0],0,0,0);
    o[d0]=__builtin_amdgcn_mfma_f32_32x32x16_bf16(pa3,PK(3),o[d0],0,0,0);
    #undef PK
  }
}

#ifndef ATTN_STORE16
#define ATTN_STORE16(p,v) (*(u32x4*)(p)=(v))
#endif
__device__ __forceinline__ void split3(float x,float&h,float&m,float&l){
  h=__uint_as_float(cvtpk_s(x,0.f)<<16); const float r1=x-h; m=__uint_as_float(cvtpk_s(r1,0.f)<<16); const float r2=r1-m; l=__uint_as_float(cvtpk_s(r2,0.f)<<16);
}
template<int THRL,int MASK,bool BIAS,bool WT> __device__ __forceinline__ void attn_unit(int qb,const bf16*Qh,const bf16*__restrict__ Kh,const bf16*__restrict__ Vh,bf16*Oh,int opitch,const float*__restrict__ biasg,char*shm){
  int tid_=threadIdx.x; asm volatile("":"+v"(tid_));
  const int tid=tid_,lane=tid&63,r32=lane&31,hi=lane>>5; const int wid=__builtin_amdgcn_readfirstlane(tid>>6);
  const int q0=qb*QB;
  const bf16*Qw=Qh+(long)(q0+wid*QBLK)*PIN;
  const unsigned lds0=(unsigned)(uintptr_t)shm;
  float*wsf=(float*)(shm+LDS_WS)+wid*64;
  const bf16*ksrc=Kh+(long)lane*PIN+wid*8;
  const bf16*vsrc=Vh+(long)(16*(wid&3)+(lane>>2))*PIN+(wid>>2)*32+(lane&3)*8;
  const unsigned kdst=lds0+LDS_K+wid*1024, vdst=lds0+LDS_V+wid*1024;
  #define DMA_K(t,slot) glds16(ksrc+(long)(t)*KVBLK*PIN,(unsigned)__builtin_amdgcn_readfirstlane(kdst+(slot)))
  #define DMA_V(t,slot) glds16(vsrc+(long)(t)*KVBLK*PIN,(unsigned)__builtin_amdgcn_readfirstlane(vdst+(slot)))
  const int vb0=(int)(lds0+LDS_V)+((lane>>4)&1)*32+(lane&3)*8+(4*hi+((lane&15)>>2))*64;
  const char*Kbase=shm+LDS_K; bf16x8 kf[8];
  const lds_cptr shm3=(lds_cptr)shm; const lds_cptr kp0=shm3+LDS_K+hi*1024+r32*16; const lds_cptr vp0=shm3+LDS_V+((lane>>4)&1)*32+(lane&3)*8+(4*hi+((lane&15)>>2))*64;
  const int NT=(q0+QB)/KVBLK;
  DMA_K(0,0);DMA_V(0,0);DMA_K(1,SLOTB);
  if(BIAS){ int t2=tid; asm volatile("":"+v"(t2)); if(t2<NT*16){ const f32x4v bv=*reinterpret_cast<const f32x4v*>(biasg+t2*4);
      _Pragma("unroll") for(int e_=0;e_<4;++e_){ float h_,m_,l_; split3(bv[e_],h_,m_,l_); u32x4 w_; w_.x=cvtpk_s(h_,m_); w_.y=cvtpk_s(l_,1.f); w_.z=0x3F803F80u; w_.w=0u; *reinterpret_cast<u32x4*>(shm+LDS_BIAS+(t2*4+e_)*16)=w_; } } }
  u32x4 mfr; mfr.x=hi?0u:0x3F803F80u; mfr.y=hi?0u:0x00003F80u; mfr.z=0u; mfr.w=0u;
  #define MFR_UPDATE() do{ if(BIAS){ float h_,m_,l_; split3(-mhat,h_,m_,l_); const unsigned y_=cvtpk_s(1.f,h_), z_=cvtpk_s(m_,l_); mfr.y=hi?0u:y_; mfr.z=hi?0u:z_; } }while(0)
  #define MFRB __builtin_bit_cast(bf16x8,mfr)
  const lds_cptr bt0=(lds_cptr)shm+LDS_BIAS+r32*16;
  bf16x8 qr[4];
  #pragma unroll
  for(int d0=0;d0<4;++d0)qr[d0]=*reinterpret_cast<const bf16x8*>(&Qw[(long)r32*PIN+d0*16+hi*8]);
  float mhat=0.f,l_reg=0.f;f32x16 o[2];o[0]=f32x16{};o[1]=f32x16{};f32x16 negm=f32x16{}; if(!BIAS){asm volatile("":"+v"(negm));}
  #define CIN (BIAS?f32x16{}:negm)
  const int qrel=wid*QBLK+r32;
  #define CMASK(P0,P1,t) do{int jb_=(t)-(NT-4); if(jb_>=0){ if(MASK==0)cmask(P0,P1,jb_,qrel,hi); else kmask(P0,P1,jb_,wid); } }while(0)
  bool resc=false;
  #define START(P0,P1) do{ const float rm=rowmax(P0,P1); resc=false; \
    { const float dl=rm; mhat=fadd_s(mhat,dl); \
      _Pragma("unroll") for(int r=0;r<16;++r){P0[r]=fsub_s(P0[r],dl);P1[r]=fsub_s(P1[r],dl);} \
      if(!BIAS){ _Pragma("unroll") for(int r=0;r<16;++r)negm[r]=-mhat; asm volatile("":"+v"(negm)); } MFR_UPDATE(); } \
    _Pragma("unroll") for(int r=0;r<16;++r)P0[r]=__builtin_amdgcn_exp2f(P0[r]); }while(0)
  #define RESC() do{ if(resc){ asm volatile("s_waitcnt lgkmcnt(0)":::"memory"); \
      _Pragma("unroll") for(int d_=0;d_<2;++d_) _Pragma("unroll") for(int r=0;r<16;++r)o[d_][r]=fmul_s(o[d_][r],wsf[crow(r,hi)]); } }while(0)
  f32x16 pA0,pA1,pB0,pB1;
  #define KS(t) ((((t))&3)*SLOTB)
  #define ROT() do{}while(0)
  DMA_K(2,2*SLOTB);DMA_V(1,SLOTB);DMA_K(3,3*SLOTB);
  WAIT_BAR(5);
  qkt(pA0,pA1,Kbase,qr,CIN,r32,hi);
  if(BIAS){ const bf16x8 b0_=*(const __attribute__((address_space(3))) bf16x8*)(bt0), b1_=*(const __attribute__((address_space(3))) bf16x8*)(bt0+512);
    pA0=__builtin_amdgcn_mfma_f32_32x32x16_bf16(b0_,MFRB,pA0,0,0,0); pA1=__builtin_amdgcn_mfma_f32_32x32x16_bf16(b1_,MFRB,pA1,0,0,0); }
  asm volatile("s_nop 15\n\ts_nop 7":"+v"(pA0),"+v"(pA1));CMASK(pA0,pA1,0);
  START(pA0,pA1);
  _Pragma("unroll") for(int r=0;r<16;++r)pA1[r]=__builtin_amdgcn_exp2f(pA1[r]);
  WAIT_BAR(3);
  DMA_K(4,KS(4));DMA_V(2,KS(2));
  kload8(kf,kp0+KS(1));
  WAIT_BAR(4);
  s16x4 vlo[8],vhi[8]; u32x4 pw0,pw1,pw2,pw3;
  #define PKW(P,B) cvtpk_s(P[B],P[B+1])
  #define PAF(k) __builtin_bit_cast(bf16x8,pw##k)
  #define VFR(i) (bf16x8){vlo[i][0],vlo[i][1],vlo[i][2],vlo[i][3],vhi[i][0],vhi[i][1],vhi[i][2],vhi[i][3]}
  #define PIN(x) asm volatile("":"+v"(x))
  #define MX3(a,b,c) __builtin_fmaxf(__builtin_fmaxf((a),(b)),(c))
  #define GAPA(MF,A0,A1,A2,A3,W0,W1,PW) do{ MF; sacc+=A0; sacc+=A1; sacc+=A2; sacc+=A3; PIN(sacc); W0; W1; PIN(PW); SBAR(); }while(0)
  #define EX(v) __builtin_amdgcn_exp2f(v)
  #define GAPB(MF,X,B) do{ MF; X[B]=EX(X[B]); X[B+1]=EX(X[B+1]); X[B+2]=EX(X[B+2]); X[B+3]=EX(X[B+3]); PIN(X); SBAR(); }while(0)
  #define VRD(i) do{ vlo[i]=vtr(vp_+(((i)>>2)*4096+((i)&3)*1024)); vhi[i]=vtr(vp_+(((i)>>2)*4096+((i)&3)*1024+512)); }while(0)
  #define KRD(G,j) do{ if(G){ kload2(kf,kn_,j); SBAR(); } }while(0)
  #define STEP(C0,C1,P0,P1,t,GK,GV,GL) do{ SBAR(); \
    const lds_cptr vp_=vp0+KS((t)-1); const lds_cptr kn_=kp0+KS((t)+1); \
    bf16x8 bb0_,bb1_; if(BIAS){ bb0_=*(const __attribute__((address_space(3))) bf16x8*)(bt0+(t)*1024); bb1_=*(const __attribute__((address_space(3))) bf16x8*)(bt0+(t)*1024+512); } \
    VRD(0); SBAR(); float sacc=(P0[0]+P0[1]); \
    GAPA(C0=__builtin_amdgcn_mfma_f32_32x32x16_bf16(kf[0],qr[0],CIN,0,0,0), P0[2],P0[3],P0[4],P0[5],     pw0[0]=PKW(P0,0), pw0[1]=PKW(P0,2), pw0); \
    VRD(4); SBAR(); GAPA(C1=__builtin_amdgcn_mfma_f32_32x32x16_bf16(kf[1],qr[0],CIN,0,0,0), P0[6],P0[7],P0[8],P0[9],     pw0[2]=PKW(P0,4), pw0[3]=PKW(P0,6), pw0); \
    VRD(1); SBAR(); GAPA(C0=__builtin_amdgcn_mfma_f32_32x32x16_bf16(kf[2],qr[1],C0,0,0,0),   P0[10],P0[11],P0[12],P0[13], pw1[0]=PKW(P0,8), pw1[1]=PKW(P0,10), pw1); \
    VRD(5); SBAR(); GAPA(C1=__builtin_amdgcn_mfma_f32_32x32x16_bf16(kf[3],qr[1],C1,0,0,0),   P0[14],P0[15],P1[0],P1[1],   pw1[2]=PKW(P0,12),pw1[3]=PKW(P0,14), pw1); \
    VRD(2); SBAR(); GAPA(C0=__builtin_amdgcn_mfma_f32_32x32x16_bf16(kf[4],qr[2],C0,0,0,0),   P1[2],P1[3],P1[4],P1[5],     pw2[0]=PKW(P1,0), pw2[1]=PKW(P1,2), pw2); \
    VRD(6); SBAR(); GAPA(C1=__builtin_amdgcn_mfma_f32_32x32x16_bf16(kf[5],qr[2],C1,0,0,0),   P1[6],P1[7],P1[8],P1[9],     pw2[2]=PKW(P1,4), pw2[3]=PKW(P1,6), pw2); \
    VRD(3); SBAR(); GAPA(C0=__builtin_amdgcn_mfma_f32_32x32x16_bf16(kf[6],qr[3],C0,0,0,0),   P1[10],P1[11],P1[12],P1[13], pw3[0]=PKW(P1,8), pw3[1]=PKW(P1,10), pw3); \
    VRD(7); SBAR(); GAPA(C1=__builtin_amdgcn_mfma_f32_32x32x16_bf16(kf[7],qr[3],C1,0,0,0),   P1[14],P1[15],0.f,0.f,       pw3[2]=PKW(P1,12),pw3[3]=PKW(P1,14), pw3); \
    if(BIAS){ C0=__builtin_amdgcn_mfma_f32_32x32x16_bf16(bb0_,MFRB,C0,0,0,0); C1=__builtin_amdgcn_mfma_f32_32x32x16_bf16(bb1_,MFRB,C1,0,0,0); SBAR(); } \
    l_reg+=sacc; \
    if(GK){DMA_K((t)+4,KS((t)+4));} if(GV){DMA_V((t)+2,KS((t)+2));} \
    CMASK(C0,C1,t); \
    { float a=MX3(C0[0],C0[1],C1[0]),b=MX3(C0[2],C0[3],C1[1]); a=MX3(a,C1[2],C1[3]); \
      _Pragma("unroll") for(int r=4;r<16;r+=4){a=MX3(a,C0[r],C0[r+1]);b=MX3(b,C0[r+2],C0[r+3]);a=MX3(a,C1[r],C1[r+1]);b=MX3(b,C1[r+2],C1[r+3]);} \
      float rm=__builtin_fmaxf(a,b); { auto rr=__builtin_amdgcn_permlane32_swap(__float_as_uint(rm),__float_as_uint(rm),false,false); rm=__builtin_fmaxf(__uint_as_float(rr[0]),__uint_as_float(rr[1])); } \
      resc=false; \
      if(__builtin_expect(__any(rm>(float)THRL),0)){ const float dl=__builtin_fmaxf(rm,0.f); mhat+=dl; \
        _Pragma("unroll") for(int r=0;r<16;++r){C0[r]-=dl;C1[r]-=dl;} \
        if(!BIAS){ _Pragma("unroll") for(int r=0;r<16;++r)negm[r]=-mhat; asm volatile("":"+v"(negm)); } MFR_UPDATE(); \
        const float f=__builtin_amdgcn_exp2f(-dl); l_reg*=f; if(hi==0)wsf[r32]=f; resc=true; } } \
    SBAR(); \
    GAPB(o[0]=__builtin_amdgcn_mfma_f32_32x32x16_bf16(PAF(0),VFR(0),o[0],0,0,0), C0,0); \
    GAPB(o[1]=__builtin_amdgcn_mfma_f32_32x32x16_bf16(PAF(0),VFR(4),o[1],0,0,0), C0,4); \
    KRD(GL,0); GAPB(o[0]=__builtin_amdgcn_mfma_f32_32x32x16_bf16(PAF(1),VFR(1),o[0],0,0,0), C0,8); \
    KRD(GL,1); GAPB(o[1]=__builtin_amdgcn_mfma_f32_32x32x16_bf16(PAF(1),VFR(5),o[1],0,0,0), C0,12); \
    KRD(GL,2); GAPB(o[0]=__builtin_amdgcn_mfma_f32_32x32x16_bf16(PAF(2),VFR(2),o[0],0,0,0), C1,0); \
    KRD(GL,3); GAPB(o[1]=__builtin_amdgcn_mfma_f32_32x32x16_bf16(PAF(2),VFR(6),o[1],0,0,0), C1,4); \
    GAPB(o[0]=__builtin_amdgcn_mfma_f32_32x32x16_bf16(PAF(3),VFR(3),o[0],0,0,0), C1,8); \
    GAPB(o[1]=__builtin_amdgcn_mfma_f32_32x32x16_bf16(PAF(3),VFR(7),o[1],0,0,0), C1,12); \
    }while(0)
  int t=1;
  #undef CMASK
  #define CMASK(P0,P1,t) do{}while(0)
  for(;t+5<NT;t+=2){
    STEP(pB0,pB1,pA0,pA1,t,true,true,true);     WAIT_BAR(4); RESC(); ROT();
    STEP(pA0,pA1,pB0,pB1,t+1,true,true,true);   WAIT_BAR(4); RESC(); ROT();
  }
  #undef CMASK
  #define CMASK(P0,P1,t) do{int jb_=(t)-(NT-4); if(jb_>=0){ if(MASK==0)cmask(P0,P1,jb_,qrel,hi); else kmask(P0,P1,jb_,wid); } }while(0)
  #define ENDW(tt) do{ const int n_=((tt)+2>=NT)?0:((int)((tt)+3<NT)+(int)((tt)+1<NT)+(int)((tt)+4<NT)+(int)((tt)+2<NT)); if(n_>=4){WAIT_BAR(4);} else if(n_==3){WAIT_BAR(3);} else if(n_==2){WAIT_BAR(2);} else if(n_==1){WAIT_BAR(1);} else {WAIT_BAR(0);} }while(0)
  for(;t+1<NT;t+=2){
    STEP(pB0,pB1,pA0,pA1,t,(t+4<NT),(t+2<NT),(t+1<NT));       ENDW(t);   RESC(); ROT();
    STEP(pA0,pA1,pB0,pB1,t+1,(t+5<NT),(t+3<NT),(t+2<NT));     ENDW(t+1); RESC(); ROT();
  }
  STEP(pB0,pB1,pA0,pA1,NT-1,false,false,false); RESC();
  { float sacc=pB0[0]+pB0[1]; _Pragma("unroll") for(int r=2;r<16;++r)sacc+=pB0[r]; _Pragma("unroll") for(int r=0;r<16;++r)sacc+=pB1[r]; l_reg+=sacc;
    pw0=(u32x4){PKW(pB0,0),PKW(pB0,2),PKW(pB0,4),PKW(pB0,6)};pw1=(u32x4){PKW(pB0,8),PKW(pB0,10),PKW(pB0,12),PKW(pB0,14)};pw2=(u32x4){PKW(pB1,0),PKW(pB1,2),PKW(pB1,4),PKW(pB1,6)};pw3=(u32x4){PKW(pB1,8),PKW(pB1,10),PKW(pB1,12),PKW(pB1,14)};
    SBAR(); pv(o,vb0+KS(NT-1),PAF(0),PAF(1),PAF(2),PAF(3)); }
  #undef PKW
  #undef PAF
  #undef VFR
  #undef PIN
  #undef MX3
  #undef GAPA
  #undef GAPB
  #undef EX
  #undef VRD
  #undef KRD
  #undef STEP
  #undef ENDW
  {auto rr=__builtin_amdgcn_permlane32_swap(__float_as_uint(l_reg),__float_as_uint(l_reg),false,false);l_reg=__uint_as_float(rr[0])+__uint_as_float(rr[1]);}
  if(hi==0)wsf[32+r32]=l_reg;asm volatile("s_waitcnt lgkmcnt(0)":::"memory");
  float rli[16];
  #pragma unroll
  for(int r=0;r<16;++r)rli[r]=__builtin_amdgcn_rcpf(wsf[32+crow(r,hi)]);
  bf16*Ow=Oh+(long)(q0+wid*QBLK)*opitch;
  { bf16*stg=(bf16*)(shm+LDS_OST)+wid*2048;
    #pragma unroll
    for(int r=0;r<16;++r){const int orow=crow(r,hi);
      #pragma unroll
      for(int d0=0;d0<2;++d0)stg[orow*64+d0*32+r32]=__float2bfloat16(o[d0][r]*rli[r]);}
    asm volatile("s_waitcnt lgkmcnt(0)":::"memory");
    if(WT){ const __amdgpu_buffer_rsrc_t rs_=__builtin_amdgcn_make_buffer_rsrc((void*)Oh,(short)0,0x7fffffff,0x00020000);
      #pragma unroll
      for(int i=0;i<4;++i){const int row=i*8+(lane>>3),ch=lane&7; const u32x4 v=*(const u32x4*)(stg+row*64+ch*8); __builtin_amdgcn_raw_buffer_store_b128(v,rs_,(int)(((long)(q0+wid*QBLK+row)*opitch+ch*8)*2),0,16);} }
    else{
    #pragma unroll
    for(int i=0;i<4;++i){const int row=i*8+(lane>>3),ch=lane&7; const u32x4 v=*(const u32x4*)(stg+row*64+ch*8); ATTN_STORE16(Ow+(long)row*opitch+ch*8,v);} } }
  asm volatile("s_waitcnt lgkmcnt(0)\n\ts_barrier":::"memory");
  #undef DMA_K
  #undef DMA_V
  #undef CMASK
  #undef CIN
  #undef MFR_UPDATE
  #undef MFRB
  #undef START
  #undef RESC
  #undef ROT
  #undef KS
}
constexpr int ATTN_LDS_BYTES=LDS_BYTES;
#undef SBAR
#undef WAIT_BAR
}
#define SBAR() __builtin_amdgcn_sched_barrier(0)
namespace ab {
constexpr int B_LK=0, B_LV=24576, B_VSLOT=16384, B_LP=90112, B_LW=122880, B_LST=124928, B_LSS=157696, B_LDS_BYTES=158720;
typedef __attribute__((address_space(3))) unsigned char* ldsb;

template<int THRL> __device__ __forceinline__ void diff_pass_A(int rblk,const bf16*Qh,const bf16*__restrict__ Kh,const bf16*__restrict__ Vh,char*shm,f32x16(&o)[2],float(&rli)[16]){
  int tid_=threadIdx.x; asm volatile("":"+v"(tid_));
  const int tid=tid_,lane=tid&63,r32=lane&31,hi=lane>>5; const int wid=__builtin_amdgcn_readfirstlane(tid>>6);
  const int rb=wid&3;
  const int q0=rblk*128;
  const bf16*Qw=Qh+(long)(q0+rb*QBLK)*PIN;
  const unsigned lds0=(unsigned)(uintptr_t)shm;
  const ldsb L=(ldsb)shm;
  volatile __attribute__((address_space(3))) float*wf=(volatile __attribute__((address_space(3))) float*)(L+B_LW+rb*512);
  const bf16*ksrc=Kh+(long)lane*PIN+wid*8;
  const bf16*vsrc0=Vh+(long)(16*((2*wid)&3)+(lane>>2))*PIN+(wid>>1)*32+(lane&3)*8;
  const bf16*vsrc1=Vh+(long)(16*((2*wid+1)&3)+(lane>>2))*PIN+(wid>>1)*32+(lane&3)*8;
  const unsigned kdst=lds0+B_LK+wid*1024, vdst=lds0+B_LV+wid*2048;
  #define DMA_K(t,slot) glds16(ksrc+(long)(t)*KVBLK*PIN,(unsigned)__builtin_amdgcn_readfirstlane(kdst+(slot)))
  #define VS(t) ((((t))&3)*B_VSLOT)
  #define DMA_V(t) do{ glds16(vsrc0+(long)(t)*KVBLK*PIN,(unsigned)__builtin_amdgcn_readfirstlane(vdst+VS(t))); glds16(vsrc1+(long)(t)*KVBLK*PIN,(unsigned)__builtin_amdgcn_readfirstlane(vdst+VS(t)+1024)); }while(0)
  const int vb0=(int)(lds0+B_LV)+((lane>>4)&1)*32+(lane&3)*8+(4*hi+((lane&15)>>2))*64;
  const char*Kbase=shm+B_LK; bf16x8 kf[8];
  const lds_cptr shm3=(lds_cptr)shm; const lds_cptr kp0=shm3+B_LK+hi*1024+r32*16; const lds_cptr vp0=shm3+B_LV+((lane>>4)&1)*32+(lane&3)*8+(4*hi+((lane&15)>>2))*64;
  const ldsb pbase=L+B_LP+rb*8192+lane*16;
  const int NT=(2*rblk+2)<4?4:(2*rblk+2);
  const int lim=2*rblk+(rb>>1);
  DMA_K(0,0);DMA_V(0);DMA_K(1,SLOTB);
  bf16x8 qr[4];
  #pragma unroll
  for(int d0=0;d0<4;++d0)qr[d0]=*reinterpret_cast<const bf16x8*>(&Qw[(long)r32*PIN+d0*16+hi*8]);
  float mhat=0.f,l_reg=0.f;o[0]=f32x16{};o[1]=f32x16{};f32x16 negm=f32x16{}; asm volatile("":"+v"(negm));
  #define CMASK(P0,P1,t) do{ if((t)>=NT-4){ if((t)>lim){ const float NEG_=-INFINITY; _Pragma("unroll") for(int r_=0;r_<16;++r_){P0[r_]=NEG_;P1[r_]=NEG_;} } } }while(0)
  bool resc=false;
  #define START(P0,P1) do{ const float rm=rowmax(P0,P1); resc=false; \
    { const float dl=rm; mhat=fadd_s(mhat,dl); \
      _Pragma("unroll") for(int r=0;r<16;++r){P0[r]=fsub_s(P0[r],dl);P1[r]=fsub_s(P1[r],dl);} \
      _Pragma("unroll") for(int r=0;r<16;++r)negm[r]=-mhat; asm volatile("":"+v"(negm)); } \
    _Pragma("unroll") for(int r=0;r<16;++r)P0[r]=__builtin_amdgcn_exp2f(P0[r]); }while(0)
  #define RESC(t) do{ if(resc){ asm volatile("s_waitcnt lgkmcnt(0)":::"memory"); \
      _Pragma("unroll") for(int d_=0;d_<2;++d_) _Pragma("unroll") for(int r=0;r<16;++r)o[d_][r]=fmul_s(o[d_][r],wf[32*((t)&1)+crow(r,hi)]); } }while(0)
  f32x16 pA0,pA1,pB0,pB1;
  int sl_prev=0,sl_cur=0,sl_next=SLOTB;
  #define ROT() do{sl_prev=sl_cur;sl_cur=sl_next;sl_next=(sl_next==2*SLOTB)?0:sl_next+SLOTB;}while(0)
  #define WAIT_BAR(N) asm volatile("s_waitcnt vmcnt(" #N ") lgkmcnt(0)\n\ts_barrier":::"memory")
  DMA_K(2,2*SLOTB);
  WAIT_BAR(3);
  {
    qkt(pA0,pA1,Kbase,qr,negm,r32,hi);
    asm volatile("s_nop 15\n\ts_nop 7":"+v"(pA0),"+v"(pA1));CMASK(pA0,pA1,0);
    START(pA0,pA1);
    _Pragma("unroll") for(int r=0;r<16;++r)pA1[r]=__builtin_amdgcn_exp2f(pA1[r]);
    if(lane==0){wf[96]=0.f;wf[97]=0.f;} }
  WAIT_BAR(0);
  DMA_K(3,0);DMA_V(1);
  ROT();
  kload8(kf,kp0+sl_cur);
  WAIT_BAR(3);
  s16x4 vlo[8],vhi[8]; u32x4 pw0,pw1,pw2,pw3;
  #define PKW(P,B) cvtpk_s(P[B],P[B+1])
  #define PAF(k) __builtin_bit_cast(bf16x8,pw##k)
  #define VFR(i) (bf16x8){vlo[i][0],vlo[i][1],vlo[i][2],vlo[i][3],vhi[i][0],vhi[i][1],vhi[i][2],vhi[i][3]}
  #define PIN(x) asm volatile("":"+v"(x))
  #define MX3(a,b,c) __builtin_fmaxf(__builtin_fmaxf((a),(b)),(c))
  #define GAPA(MF,A0,A1,A2,A3,W0,W1,PW) do{ MF; sacc+=A0; sacc+=A1; sacc+=A2; sacc+=A3; PIN(sacc); W0; W1; PIN(PW); SBAR(); }while(0)
  #define EX(v) __builtin_amdgcn_exp2f(v)
  #define GAPB(MF,X,B) do{ MF; X[B]=EX(X[B]); X[B+1]=EX(X[B+1]); X[B+2]=EX(X[B+2]); X[B+3]=EX(X[B+3]); PIN(X); SBAR(); }while(0)
  #define VRD(i) do{ vlo[i]=vtr(vp_+(((i)>>2)*4096+((i)&3)*1024)); vhi[i]=vtr(vp_+(((i)>>2)*4096+((i)&3)*1024+512)); }while(0)
  #define KRD(G,j) do{ if(G){ kload2(kf,kp0+sl_next,j); SBAR(); } }while(0)
  #define PST(k,slot) (*(__attribute__((address_space(3))) u32x4*)(pbase+(slot)*4096+(k)*1024))
  #define STEP_A(C0,C1,P0,P1,t,GK,GV,GL) do{ SBAR(); \
    const lds_cptr vp_=vp0+VS((t)-1); \
    VRD(0); SBAR(); float sacc=(P0[0]+P0[1]); \
    GAPA(C0=__builtin_amdgcn_mfma_f32_32x32x16_bf16(kf[0],qr[0],negm,0,0,0), P0[2],P0[3],P0[4],P0[5],     pw0[0]=PKW(P0,0), pw0[1]=PKW(P0,2), pw0); \
    VRD(4); SBAR(); GAPA(C1=__builtin_amdgcn_mfma_f32_32x32x16_bf16(kf[1],qr[0],negm,0,0,0), P0[6],P0[7],P0[8],P0[9],     pw0[2]=PKW(P0,4), pw0[3]=PKW(P0,6), pw0); \
    VRD(1); SBAR(); GAPA(C0=__builtin_amdgcn_mfma_f32_32x32x16_bf16(kf[2],qr[1],C0,0,0,0),   P0[10],P0[11],P0[12],P0[13], pw1[0]=PKW(P0,8), pw1[1]=PKW(P0,10), pw1); \
    VRD(5); SBAR(); GAPA(C1=__builtin_amdgcn_mfma_f32_32x32x16_bf16(kf[3],qr[1],C1,0,0,0),   P0[14],P0[15],P1[0],P1[1],   pw1[2]=PKW(P0,12),pw1[3]=PKW(P0,14), pw1); \
    VRD(2); SBAR(); GAPA(C0=__builtin_amdgcn_mfma_f32_32x32x16_bf16(kf[4],qr[2],C0,0,0,0),   P1[2],P1[3],P1[4],P1[5],     pw2[0]=PKW(P1,0), pw2[1]=PKW(P1,2), pw2); \
    VRD(6); SBAR(); GAPA(C1=__builtin_amdgcn_mfma_f32_32x32x16_bf16(kf[5],qr[2],C1,0,0,0),   P1[6],P1[7],P1[8],P1[9],     pw2[2]=PKW(P1,4), pw2[3]=PKW(P1,6), pw2); \
    VRD(3); SBAR(); GAPA(C0=__builtin_amdgcn_mfma_f32_32x32x16_bf16(kf[6],qr[3],C0,0,0,0),   P1[10],P1[11],P1[12],P1[13], pw3[0]=PKW(P1,8), pw3[1]=PKW(P1,10), pw3); \
    VRD(7); SBAR(); GAPA(C1=__builtin_amdgcn_mfma_f32_32x32x16_bf16(kf[7],qr[3],C1,0,0,0),   P1[14],P1[15],0.f,0.f,       pw3[2]=PKW(P1,12),pw3[3]=PKW(P1,14), pw3); \
    PST(0,(t)&1)=pw0; PST(1,(t)&1)=pw1; PST(2,(t)&1)=pw2; PST(3,(t)&1)=pw3; \
    l_reg+=sacc; \
    if(GK){DMA_K((t)+3,sl_cur);} if(GV){DMA_V((t)+1);} \
    CMASK(C0,C1,t); \
    { float a=MX3(C0[0],C0[1],C1[0]),b=MX3(C0[2],C0[3],C1[1]); a=MX3(a,C1[2],C1[3]); \
      _Pragma("unroll") for(int r=4;r<16;r+=4){a=MX3(a,C0[r],C0[r+1]);b=MX3(b,C0[r+2],C0[r+3]);a=MX3(a,C1[r],C1[r+1]);b=MX3(b,C1[r+2],C1[r+3]);} \
      float rm=__builtin_fmaxf(a,b); { auto rr=__builtin_amdgcn_permlane32_swap(__float_as_uint(rm),__float_as_uint(rm),false,false); rm=__builtin_fmaxf(__uint_as_float(rr[0]),__uint_as_float(rr[1])); } \
      resc=false; \
      if(__builtin_expect(__any(rm>(float)THRL),0)){ const float dl=__builtin_fmaxf(rm,0.f); mhat+=dl; \
        _Pragma("unroll") for(int r=0;r<16;++r){C0[r]-=dl;C1[r]-=dl;} \
        _Pragma("unroll") for(int r=0;r<16;++r)negm[r]=-mhat; asm volatile("":"+v"(negm)); \
        const float f=__builtin_amdgcn_exp2f(-dl); l_reg*=f; if(hi==0)wf[32*((t)&1)+r32]=f; resc=true; } \
      if(lane==0)wf[96+((t)&1)]=resc?1.f:0.f; } \
    SBAR(); \
    GAPB(o[0]=__builtin_amdgcn_mfma_f32_32x32x16_bf16(PAF(0),VFR(0),o[0],0,0,0), C0,0); \
    GAPB(o[1]=__builtin_amdgcn_mfma_f32_32x32x16_bf16(PAF(0),VFR(4),o[1],0,0,0), C0,4); \
    KRD(GL,0); GAPB(o[0]=__builtin_amdgcn_mfma_f32_32x32x16_bf16(PAF(1),VFR(1),o[0],0,0,0), C0,8); \
    KRD(GL,1); GAPB(o[1]=__builtin_amdgcn_mfma_f32_32x32x16_bf16(PAF(1),VFR(5),o[1],0,0,0), C0,12); \
    KRD(GL,2); GAPB(o[0]=__builtin_amdgcn_mfma_f32_32x32x16_bf16(PAF(2),VFR(2),o[0],0,0,0), C1,0); \
    KRD(GL,3); GAPB(o[1]=__builtin_amdgcn_mfma_f32_32x32x16_bf16(PAF(2),VFR(6),o[1],0,0,0), C1,4); \
    GAPB(o[0]=__builtin_amdgcn_mfma_f32_32x32x16_bf16(PAF(3),VFR(3),o[0],0,0,0), C1,8); \
    GAPB(o[1]=__builtin_amdgcn_mfma_f32_32x32x16_bf16(PAF(3),VFR(7),o[1],0,0,0), C1,12); \
    }while(0)
  #define STEP(C0,C1,P0,P1,t,GK,GV,GL) STEP_A(C0,C1,P0,P1,t,GK,GV,GL)
  int t=1;
  #undef CMASK
  #define CMASK(P0,P1,t) do{}while(0)
  for(;t+5<NT;t+=2){
    STEP(pB0,pB1,pA0,pA1,t,true,true,true);     WAIT_BAR(3); RESC(t); ROT();
    STEP(pA0,pA1,pB0,pB1,t+1,true,true,true);   WAIT_BAR(3); RESC(t+1); ROT();
  }
  #undef CMASK
  #define CMASK(P0,P1,t) do{ if((t)>=NT-4){ if((t)>lim){ const float NEG_=-INFINITY; _Pragma("unroll") for(int r_=0;r_<16;++r_){P0[r_]=NEG_;P1[r_]=NEG_;} } } }while(0)
  #define ENDW(tt) do{ if((tt)+3<NT){WAIT_BAR(3);} else if((tt)+2<NT){WAIT_BAR(2);} else {WAIT_BAR(0);} }while(0)
  for(;t+1<NT;t+=2){
    STEP(pB0,pB1,pA0,pA1,t,(t+3<NT),(t+1<NT),(t+1<NT));       ENDW(t);   RESC(t); ROT();
    STEP(pA0,pA1,pB0,pB1,t+1,(t+4<NT),(t+2<NT),(t+2<NT));     ENDW(t+1); RESC(t+1); ROT();
  }
  STEP(pB0,pB1,pA0,pA1,NT-1,false,false,false); WAIT_BAR(0); RESC(NT-1);
  { float sacc=pB0[0]+pB0[1]; _Pragma("unroll") for(int r=2;r<16;++r)sacc+=pB0[r]; _Pragma("unroll") for(int r=0;r<16;++r)sacc+=pB1[r]; l_reg+=sacc;
    pw0=(u32x4){PKW(pB0,0),PKW(pB0,2),PKW(pB0,4),PKW(pB0,6)};pw1=(u32x4){PKW(pB0,8),PKW(pB0,10),PKW(pB0,12),PKW(pB0,14)};pw2=(u32x4){PKW(pB1,0),PKW(pB1,2),PKW(pB1,4),PKW(pB1,6)};pw3=(u32x4){PKW(pB1,8),PKW(pB1,10),PKW(pB1,12),PKW(pB1,14)};
    PST(0,NT&1)=pw0; PST(1,NT&1)=pw1; PST(2,NT&1)=pw2; PST(3,NT&1)=pw3;
    {auto rr=__builtin_amdgcn_permlane32_swap(__float_as_uint(l_reg),__float_as_uint(l_reg),false,false);l_reg=__uint_as_float(rr[0])+__uint_as_float(rr[1]);}
    if(hi==0)wf[64+r32]=l_reg;
    SBAR(); pv(o,vb0+VS(NT-1),PAF(0),PAF(1),PAF(2),PAF(3)); }
  WAIT_BAR(0);
  #pragma unroll
  for(int r=0;r<16;++r)rli[r]=__builtin_amdgcn_rcpf(wf[64+crow(r,hi)]);
  asm volatile("s_waitcnt lgkmcnt(0)\n\ts_barrier":::"memory");
  #undef PKW
  #undef PAF
  #undef VFR
  #undef PIN
  #undef MX3
  #undef GAPA
  #undef GAPB
  #undef EX
  #undef VRD
  #undef KRD
  #undef PST
  #undef STEP_A
  #undef STEP
  #undef ENDW
  #undef DMA_K
  #undef DMA_V
  #undef VS
  #undef CMASK
  #undef START
  #undef RESC
  #undef ROT
  #undef WAIT_BAR
}
template<int THRL> __device__ __forceinline__ void diff_pass_B(int rblk,const bf16*__restrict__ Kh,const bf16*__restrict__ Vh,char*shm,f32x16(&o)[2],float(&rli)[16]){
  int tid_=threadIdx.x; asm volatile("":"+v"(tid_));
  const int tid=tid_,lane=tid&63,hi=lane>>5; const int wid=__builtin_amdgcn_readfirstlane(tid>>6);
  const int rb=wid&3;
  const unsigned lds0=(unsigned)(uintptr_t)shm;
  const ldsb L=(ldsb)shm;
  volatile __attribute__((address_space(3))) float*wf=(volatile __attribute__((address_space(3))) float*)(L+B_LW+rb*512);
  const bf16*ksrc=Kh+(long)lane*PIN+wid*8;
  const bf16*vsrc0=Vh+(long)(16*((2*wid)&3)+(lane>>2))*PIN+(wid>>1)*32+(lane&3)*8;
  const bf16*vsrc1=Vh+(long)(16*((2*wid+1)&3)+(lane>>2))*PIN+(wid>>1)*32+(lane&3)*8;
  const unsigned kdst=lds0+B_LK+wid*1024, vdst=lds0+B_LV+wid*2048;
  #define DMA_K(t,slot) glds16(ksrc+(long)(t)*KVBLK*PIN,(unsigned)__builtin_amdgcn_readfirstlane(kdst+(slot)))
  #define VS(t) ((((t))&3)*B_VSLOT)
  #define DMA_V(t) do{ glds16(vsrc0+(long)(t)*KVBLK*PIN,(unsigned)__builtin_amdgcn_readfirstlane(vdst+VS(t))); glds16(vsrc1+(long)(t)*KVBLK*PIN,(unsigned)__builtin_amdgcn_readfirstlane(vdst+VS(t)+1024)); }while(0)
  #define WAIT_BAR(N) asm volatile("s_waitcnt vmcnt(" #N ") lgkmcnt(0)\n\ts_barrier":::"memory")
  const int vb0=(int)(lds0+B_LV)+8192+((lane>>4)&1)*32+(lane&3)*8+(4*hi+((lane&15)>>2))*64;
  const ldsb pbase=L+B_LP+rb*8192+lane*16;
  const int NT=(2*rblk+2)<4?4:(2*rblk+2);
  o[0]=f32x16{};o[1]=f32x16{};
  int sl_cur=0,sl_next=SLOTB;
  #define ROT() do{sl_cur=sl_next;sl_next=(sl_next==2*SLOTB)?0:sl_next+SLOTB;}while(0)
  #define PVB(tp,ps,fpar) do{ \
    const bf16x8 pa0_=*(const __attribute__((address_space(3))) bf16x8*)(pbase+(ps)*4096), pa1_=*(const __attribute__((address_space(3))) bf16x8*)(pbase+(ps)*4096+1024), \
                 pa2_=*(const __attribute__((address_space(3))) bf16x8*)(pbase+(ps)*4096+2048), pa3_=*(const __attribute__((address_space(3))) bf16x8*)(pbase+(ps)*4096+3072); \
    pv(o,vb0+VS(tp),pa0_,pa1_,pa2_,pa3_); \
    if((fpar)>=0){ if(wf[96+((fpar)&1)]!=0.f){ _Pragma("unroll") for(int d_=0;d_<2;++d_) _Pragma("unroll") for(int r=0;r<16;++r)o[d_][r]=fmul_s(o[d_][r],wf[32*((fpar)&1)+crow(r,hi)]); } } }while(0)
  #define STEP(t,GK,GV) do{ if((t)>=2){ PVB((t)-2,((t)-1)&1,(t)-1); } if(GK){DMA_K((t)+3,sl_cur);} if(GV){DMA_V((t)+1);} }while(0)
  DMA_K(0,0);DMA_V(0);DMA_K(1,SLOTB);
  DMA_K(2,2*SLOTB);
  WAIT_BAR(3);
  WAIT_BAR(0);
  DMA_K(3,0);DMA_V(1);
  ROT();
  WAIT_BAR(3);
  int t=1;
  for(;t+5<NT;t+=2){
    STEP(t,true,true);     WAIT_BAR(3); ROT();
    STEP(t+1,true,true);   WAIT_BAR(3); ROT();
  }
  #define ENDW(tt) do{ if((tt)+3<NT){WAIT_BAR(3);} else if((tt)+2<NT){WAIT_BAR(2);} else {WAIT_BAR(0);} }while(0)
  for(;t+1<NT;t+=2){
    STEP(t,(t+3<NT),(t+1<NT));       ENDW(t);   ROT();
    STEP(t+1,(t+4<NT),(t+2<NT));     ENDW(t+1); ROT();
  }
  STEP(NT-1,false,false); WAIT_BAR(0);
  PVB(NT-2,(NT-1)&1,NT-1);
  WAIT_BAR(0);
  PVB(NT-1,NT&1,-1);
  #pragma unroll
  for(int r=0;r<16;++r)rli[r]=__builtin_amdgcn_rcpf(wf[64+crow(r,hi)]);
  asm volatile("s_waitcnt lgkmcnt(0)\n\ts_barrier":::"memory");
  #undef DMA_K
  #undef DMA_V
  #undef VS
  #undef WAIT_BAR
  #undef ROT
  #undef PVB
  #undef STEP
  #undef ENDW
}
template<int THRL> __device__ __forceinline__ void diff_unit_ab(int rblk,const bf16*Qh,const bf16*Kh,const bf16*Vh,bf16_t*ATTh,const float*subw,float lam,char*shm){
  int lane_=threadIdx.x&63; asm volatile("":"+v"(lane_));
  const int lane=lane_,r32=lane&31,hi=lane>>5; const int wid=__builtin_amdgcn_readfirstlane((int)(threadIdx.x>>6)); const int rb=wid&3,hf=wid>>2;
  const ldsb L=(ldsb)shm;
  __attribute__((address_space(3))) bf16_t*stg=(__attribute__((address_space(3))) bf16_t*)(L+B_LST+wid*4096);
  f32x16 o[2]; float rli[16];
  if(wid<4)diff_pass_A<THRL>(rblk,Qh,Kh,Vh,shm,o,rli); else diff_pass_B<THRL>(rblk,Kh,Vh,shm,o,rli);
  #pragma unroll
  for(int r=0;r<16;++r){const int orow=crow(r,hi);
    #pragma unroll
    for(int d0=0;d0<2;++d0)stg[orow*64+d0*32+r32]=(bf16_t)(cvtpk_s(o[d0][r]*rli[r],0.f)&0xffffu);}
  if(wid<4)diff_pass_A<THRL>(rblk,Qh+64,Kh+64,Vh,shm,o,rli); else diff_pass_B<THRL>(rblk,Kh+64,Vh,shm,o,rli);
  #pragma unroll
  for(int r=0;r<16;++r){const int orow=crow(r,hi);
    #pragma unroll
    for(int d0=0;d0<2;++d0){ const float o1=__uint_as_float(((unsigned)stg[orow*64+d0*32+r32])<<16); stg[orow*64+d0*32+r32]=(bf16_t)(cvtpk_s(o1-lam*(o[d0][r]*rli[r]),0.f)&0xffffu); } }
  asm volatile("s_waitcnt lgkmcnt(0)":::"memory");
  u32x4 vv[4]; float ssr[4];
  #pragma unroll
  for(int i=0;i<4;++i){ const int row=i*8+(lane>>3),ch=lane&7; vv[i]=*(const __attribute__((address_space(3))) u32x4*)(stg+row*64+ch*8);
    float s=0.f;
    #pragma unroll
    for(int e=0;e<4;++e){ const float a=__uint_as_float(vv[i][e]<<16),b2=__uint_as_float(vv[i][e]&0xffff0000u); s+=a*a+b2*b2; }
    s+=__shfl_xor(s,1); s+=__shfl_xor(s,2); s+=__shfl_xor(s,4); ssr[i]=s;
    if(ch==0)((__attribute__((address_space(3))) float*)(L+B_LSS))[wid*32+row]=s; }
  asm volatile("s_waitcnt lgkmcnt(0)\n\ts_barrier":::"memory");
  #pragma unroll
  for(int i=0;i<4;++i){ const int row=i*8+(lane>>3),ch=lane&7;
    const float tot=ssr[i]+((const __attribute__((address_space(3))) float*)(L+B_LSS))[(wid^4)*32+row];
    const float rstd=rsqrtf(tot*(1.f/128.f)+EPS)*0.8f;
    const f32x4v g0=*reinterpret_cast<const f32x4v*>(subw+64*hf+8*ch), g1=*reinterpret_cast<const f32x4v*>(subw+64*hf+8*ch+4);
    u32x4 w;
    w.x=cvtpk_s(__uint_as_float(vv[i].x<<16)*rstd*g0[0],__uint_as_float(vv[i].x&0xffff0000u)*rstd*g0[1]);
    w.y=cvtpk_s(__uint_as_float(vv[i].y<<16)*rstd*g0[2],__uint_as_float(vv[i].y&0xffff0000u)*rstd*g0[3]);
    w.z=cvtpk_s(__uint_as_float(vv[i].z<<16)*rstd*g1[0],__uint_as_float(vv[i].z&0xffff0000u)*rstd*g1[1]);
    w.w=cvtpk_s(__uint_as_float(vv[i].w<<16)*rstd*g1[2],__uint_as_float(vv[i].w&0xffff0000u)*rstd*g1[3]);
    *reinterpret_cast<u32x4*>(ATTh+(size_t)(rblk*128+rb*32+row)*DM+64*hf+8*ch)=w; }
  asm volatile("s_waitcnt lgkmcnt(0)\n\ts_barrier":::"memory");
}
}
#undef SBAR
__constant__ unsigned short UNIT_Q[8][176] = {
  {0x4000,0x4001,0x4002,0x4003,0x4020,0x4028,0x4030,0x4038,0x800f,0x801f,0x802f,0x803f,0x800e,0x801e,0x802e,0x803e,0x800d,0x801d,0x802d,0x803d,0x0007,0x000f,0x0017,0x001f,0x0027,0x002f,0x0037,0x003f,0x800c,0x801c,0x802c,0x803c,0x800b,0x801b,0x802b,0x803b,0x0006,0x000e,0x0016,0x001e,0x0026,0x002e,0x0036,0x003e,0x800a,0x801a,0x802a,0x803a,0x8009,0x8019,0x8029,0x8039,0x0005,0x000d,0x0015,0x001d,0x0025,0x002d,0x0035,0x003d,0x8008,0x8018,0x8028,0x8038,0x8007,0x8017,0x8027,0x8037,0x0004,0x000c,0x0014,0x001c,0x0024,0x002c,0x0034,0x003c,0x8006,0x8016,0x8026,0x8036,0x8005,0x8015,0x8025,0x8035,0x0003,0x000b,0x0013,0x001b,0x0023,0x002b,0x0033,0x003b,0x8004,0x8014,0x8024,0x8034,0x8003,0x8013,0x8023,0x8033,0x0002,0x000a,0x0012,0x001a,0x0022,0x002a,0x0032,0x003a,0x8002,0x8012,0x8022,0x8032,0x8000,0x8001,0x8010,0x8011,0x8020,0x8021,0x8030,0x8031,0x0001,0x0009,0x0011,0x0019,0x0021,0x0029,0x0031,0x0039,0x0000,0x0008,0x0010,0x0018,0x0020,0x0028,0x0030,0x0038,0x2000,0x2001,0x2002,0x2003,0x2004,0x2005,0x2006,0x2007,0x2008,0x2009,0x200a,0x200b,0x200c,0x200d,0x200e,0x200f,0x2010,0x2011,0x2012,0x2013,0x2014,0x2015,0x2016,0x2017,0x2018,0x2019,0x201a,0x201b,0x201c,0x201d,0x201e,0x201f,0x2020,0x2021,0x2022,0x2023,0x2024,0x2025,0x2026,0x2027},
  {0x4004,0x4005,0x4006,0x4007,0x4021,0x4029,0x4031,0x4039,0x804f,0x805f,0x806f,0x807f,0x804e,0x805e,0x806e,0x807e,0x804d,0x805d,0x806d,0x807d,0x0047,0x004f,0x0057,0x005f,0x0067,0x006f,0x0077,0x007f,0x804c,0x805c,0x806c,0x807c,0x804b,0x805b,0x806b,0x807b,0x0046,0x004e,0x0056,0x005e,0x0066,0x006e,0x0076,0x007e,0x804a,0x805a,0x806a,0x807a,0x8049,0x8059,0x8069,0x8079,0x0045,0x004d,0x0055,0x005d,0x0065,0x006d,0x0075,0x007d,0x8048,0x8058,0x8068,0x8078,0x8047,0x8057,0x8067,0x8077,0x0044,0x004c,0x0054,0x005c,0x0064,0x006c,0x0074,0x007c,0x8046,0x8056,0x8066,0x8076,0x8045,0x8055,0x8065,0x8075,0x0043,0x004b,0x0053,0x005b,0x0063,0x006b,0x0073,0x007b,0x8044,0x8054,0x8064,0x8074,0x8043,0x8053,0x8063,0x8073,0x0042,0x004a,0x0052,0x005a,0x0062,0x006a,0x0072,0x007a,0x8042,0x8052,0x8062,0x8072,0x8040,0x8041,0x8050,0x8051,0x8060,0x8061,0x8070,0x8071,0x0041,0x0049,0x0051,0x0059,0x0061,0x0069,0x0071,0x0079,0x0040,0x0048,0x0050,0x0058,0x0060,0x0068,0x0070,0x0078,0x2028,0x2029,0x202a,0x202b,0x202c,0x202d,0x202e,0x202f,0x2030,0x2031,0x2032,0x2033,0x2034,0x2035,0x2036,0x2037,0x2038,0x2039,0x203a,0x203b,0x203c,0x203d,0x203e,0x203f,0x2040,0x2041,0x2042,0x2043,0x2044,0x2045,0x2046,0x2047,0x2048,0x2049,0x204a,0x204b,0x204c,0x204d,0x204e,0x204f},
  {0x4008,0x4009,0x400a,0x400b,0x4022,0x402a,0x4032,0x403a,0x808f,0x809f,0x80af,0x80bf,0x808e,0x809e,0x80ae,0x80be,0x808d,0x809d,0x80ad,0x80bd,0x0087,0x008f,0x0097,0x009f,0x00a7,0x00af,0x00b7,0x00bf,0x808c,0x809c,0x80ac,0x80bc,0x808b,0x809b,0x80ab,0x80bb,0x0086,0x008e,0x0096,0x009e,0x00a6,0x00ae,0x00b6,0x00be,0x808a,0x809a,0x80aa,0x80ba,0x8089,0x8099,0x80a9,0x80b9,0x0085,0x008d,0x0095,0x009d,0x00a5,0x00ad,0x00b5,0x00bd,0x8088,0x8098,0x80a8,0x80b8,0x8087,0x8097,0x80a7,0x80b7,0x0084,0x008c,0x0094,0x009c,0x00a4,0x00ac,0x00b4,0x00bc,0x8086,0x8096,0x80a6,0x80b6,0x8085,0x8095,0x80a5,0x80b5,0x0083,0x008b,0x0093,0x009b,0x00a3,0x00ab,0x00b3,0x00bb,0x8084,0x8094,0x80a4,0x80b4,0x8083,0x8093,0x80a3,0x80b3,0x0082,0x008a,0x0092,0x009a,0x00a2,0x00aa,0x00b2,0x00ba,0x8082,0x8092,0x80a2,0x80b2,0x8080,0x8081,0x8090,0x8091,0x80a0,0x80a1,0x80b0,0x80b1,0x0081,0x0089,0x0091,0x0099,0x00a1,0x00a9,0x00b1,0x00b9,0x0080,0x0088,0x0090,0x0098,0x00a0,0x00a8,0x00b0,0x00b8,0x2050,0x2051,0x2052,0x2053,0x2054,0x2055,0x2056,0x2057,0x2058,0x2059,0x205a,0x205b,0x205c,0x205d,0x205e,0x205f,0x2060,0x2061,0x2062,0x2063,0x2064,0x2065,0x2066,0x2067,0x2068,0x2069,0x206a,0x206b,0x206c,0x206d,0x206e,0x206f,0x2070,0x2071,0x2072,0x2073,0x2074,0x2075,0x2076,0x2077},
  {0x400c,0x400d,0x400e,0x400f,0x4023,0x402b,0x4033,0x403b,0x80cf,0x80df,0x80ef,0x80ff,0x80ce,0x80de,0x80ee,0x80fe,0x80cd,0x80dd,0x80ed,0x80fd,0x00c7,0x00cf,0x00d7,0x00df,0x00e7,0x00ef,0x00f7,0x00ff,0x80cc,0x80dc,0x80ec,0x80fc,0x80cb,0x80db,0x80eb,0x80fb,0x00c6,0x00ce,0x00d6,0x00de,0x00e6,0x00ee,0x00f6,0x00fe,0x80ca,0x80da,0x80ea,0x80fa,0x80c9,0x80d9,0x80e9,0x80f9,0x00c5,0x00cd,0x00d5,0x00dd,0x00e5,0x00ed,0x00f5,0x00fd,0x80c8,0x80d8,0x80e8,0x80f8,0x80c7,0x80d7,0x80e7,0x80f7,0x00c4,0x00cc,0x00d4,0x00dc,0x00e4,0x00ec,0x00f4,0x00fc,0x80c6,0x80d6,0x80e6,0x80f6,0x80c5,0x80d5,0x80e5,0x80f5,0x00c3,0x00cb,0x00d3,0x00db,0x00e3,0x00eb,0x00f3,0x00fb,0x80c4,0x80d4,0x80e4,0x80f4,0x80c3,0x80d3,0x80e3,0x80f3,0x00c2,0x00ca,0x00d2,0x00da,0x00e2,0x00ea,0x00f2,0x00fa,0x80c2,0x80d2,0x80e2,0x80f2,0x80c0,0x80c1,0x80d0,0x80d1,0x80e0,0x80e1,0x80f0,0x80f1,0x00c1,0x00c9,0x00d1,0x00d9,0x00e1,0x00e9,0x00f1,0x00f9,0x00c0,0x00c8,0x00d0,0x00d8,0x00e0,0x00e8,0x00f0,0x00f8,0x2078,0x2079,0x207a,0x207b,0x207c,0x207d,0x207e,0x207f,0x2080,0x2081,0x2082,0x2083,0x2084,0x2085,0x2086,0x2087,0x2088,0x2089,0x208a,0x208b,0x208c,0x208d,0x208e,0x208f,0x2090,0x2091,0x2092,0x2093,0x2094,0x2095,0x2096,0x2097,0x2098,0x2099,0x209a,0x209b,0x209c,0x209d,0x209e,0x209f},
  {0x4010,0x4011,0x4012,0x4013,0x4024,0x402c,0x4034,0x403c,0x810f,0x811f,0x812f,0x813f,0x810e,0x811e,0x812e,0x813e,0x810d,0x811d,0x812d,0x813d,0x0107,0x010f,0x0117,0x011f,0x0127,0x012f,0x0137,0x013f,0x810c,0x811c,0x812c,0x813c,0x810b,0x811b,0x812b,0x813b,0x0106,0x010e,0x0116,0x011e,0x0126,0x012e,0x0136,0x013e,0x810a,0x811a,0x812a,0x813a,0x8109,0x8119,0x8129,0x8139,0x0105,0x010d,0x0115,0x011d,0x0125,0x012d,0x0135,0x013d,0x8108,0x8118,0x8128,0x8138,0x8107,0x8117,0x8127,0x8137,0x0104,0x010c,0x0114,0x011c,0x0124,0x012c,0x0134,0x013c,0x8106,0x8116,0x8126,0x8136,0x8105,0x8115,0x8125,0x8135,0x0103,0x010b,0x0113,0x011b,0x0123,0x012b,0x0133,0x013b,0x8104,0x8114,0x8124,0x8134,0x8103,0x8113,0x8123,0x8133,0x0102,0x010a,0x0112,0x011a,0x0122,0x012a,0x0132,0x013a,0x8102,0x8112,0x8122,0x8132,0x8100,0x8101,0x8110,0x8111,0x8120,0x8121,0x8130,0x8131,0x0101,0x0109,0x0111,0x0119,0x0121,0x0129,0x0131,0x0139,0x0100,0x0108,0x0110,0x0118,0x0120,0x0128,0x0130,0x0138,0x20a0,0x20a1,0x20a2,0x20a3,0x20a4,0x20a5,0x20a6,0x20a7,0x20a8,0x20a9,0x20aa,0x20ab,0x20ac,0x20ad,0x20ae,0x20af,0x20b0,0x20b1,0x20b2,0x20b3,0x20b4,0x20b5,0x20b6,0x20b7,0x20b8,0x20b9,0x20ba,0x20bb,0x20bc,0x20bd,0x20be,0x20bf,0x20c0,0x20c1,0x20c2,0x20c3,0x20c4,0x20c5,0x20c6,0x20c7},
  {0x4014,0x4015,0x4016,0x4017,0x4025,0x402d,0x4035,0x403d,0x814f,0x815f,0x816f,0x817f,0x814e,0x815e,0x816e,0x817e,0x814d,0x815d,0x816d,0x817d,0x0147,0x014f,0x0157,0x015f,0x0167,0x016f,0x0177,0x017f,0x814c,0x815c,0x816c,0x817c,0x814b,0x815b,0x816b,0x817b,0x0146,0x014e,0x0156,0x015e,0x0166,0x016e,0x0176,0x017e,0x814a,0x815a,0x816a,0x817a,0x8149,0x8159,0x8169,0x8179,0x0145,0x014d,0x0155,0x015d,0x0165,0x016d,0x0175,0x017d,0x8148,0x8158,0x8168,0x8178,0x8147,0x8157,0x8167,0x8177,0x0144,0x014c,0x0154,0x015c,0x0164,0x016c,0x0174,0x017c,0x8146,0x8156,0x8166,0x8176,0x8145,0x8155,0x8165,0x8175,0x0143,0x014b,0x0153,0x015b,0x0163,0x016b,0x0173,0x017b,0x8144,0x8154,0x8164,0x8174,0x8143,0x8153,0x8163,0x8173,0x0142,0x014a,0x0152,0x015a,0x0162,0x016a,0x0172,0x017a,0x8142,0x8152,0x8162,0x8172,0x8140,0x8141,0x8150,0x8151,0x8160,0x8161,0x8170,0x8171,0x0141,0x0149,0x0151,0x0159,0x0161,0x0169,0x0171,0x0179,0x0140,0x0148,0x0150,0x0158,0x0160,0x0168,0x0170,0x0178,0x20c8,0x20c9,0x20ca,0x20cb,0x20cc,0x20cd,0x20ce,0x20cf,0x20d0,0x20d1,0x20d2,0x20d3,0x20d4,0x20d5,0x20d6,0x20d7,0x20d8,0x20d9,0x20da,0x20db,0x20dc,0x20dd,0x20de,0x20df,0x20e0,0x20e1,0x20e2,0x20e3,0x20e4,0x20e5,0x20e6,0x20e7,0x20e8,0x20e9,0x20ea,0x20eb,0x20ec,0x20ed,0x20ee,0x20ef},
  {0x4018,0x4019,0x401a,0x401b,0x4026,0x402e,0x4036,0x403e,0x818f,0x819f,0x81af,0x81bf,0x818e,0x819e,0x81ae,0x81be,0x818d,0x819d,0x81ad,0x81bd,0x0187,0x018f,0x0197,0x019f,0x01a7,0x01af,0x01b7,0x01bf,0x818c,0x819c,0x81ac,0x81bc,0x818b,0x819b,0x81ab,0x81bb,0x0186,0x018e,0x0196,0x019e,0x01a6,0x01ae,0x01b6,0x01be,0x818a,0x819a,0x81aa,0x81ba,0x8189,0x8199,0x81a9,0x81b9,0x0185,0x018d,0x0195,0x019d,0x01a5,0x01ad,0x01b5,0x01bd,0x8188,0x8198,0x81a8,0x81b8,0x8187,0x8197,0x81a7,0x81b7,0x0184,0x018c,0x0194,0x019c,0x01a4,0x01ac,0x01b4,0x01bc,0x8186,0x8196,0x81a6,0x81b6,0x8185,0x8195,0x81a5,0x81b5,0x0183,0x018b,0x0193,0x019b,0x01a3,0x01ab,0x01b3,0x01bb,0x8184,0x8194,0x81a4,0x81b4,0x8183,0x8193,0x81a3,0x81b3,0x0182,0x018a,0x0192,0x019a,0x01a2,0x01aa,0x01b2,0x01ba,0x8182,0x8192,0x81a2,0x81b2,0x8180,0x8181,0x8190,0x8191,0x81a0,0x81a1,0x81b0,0x81b1,0x0181,0x0189,0x0191,0x0199,0x01a1,0x01a9,0x01b1,0x01b9,0x0180,0x0188,0x0190,0x0198,0x01a0,0x01a8,0x01b0,0x01b8,0x20f0,0x20f1,0x20f2,0x20f3,0x20f4,0x20f5,0x20f6,0x20f7,0x20f8,0x20f9,0x20fa,0x20fb,0x20fc,0x20fd,0x20fe,0x20ff,0x2100,0x2101,0x2102,0x2103,0x2104,0x2105,0x2106,0x2107,0x2108,0x2109,0x210a,0x210b,0x210c,0x210d,0x210e,0x210f,0x2110,0x2111,0x2112,0x2113,0x2114,0x2115,0x2116,0x2117},
  {0x401c,0x401d,0x401e,0x401f,0x4027,0x402f,0x4037,0x403f,0x81cf,0x81df,0x81ef,0x81ff,0x81ce,0x81de,0x81ee,0x81fe,0x81cd,0x81dd,0x81ed,0x81fd,0x01c7,0x01cf,0x01d7,0x01df,0x01e7,0x01ef,0x01f7,0x01ff,0x81cc,0x81dc,0x81ec,0x81fc,0x81cb,0x81db,0x81eb,0x81fb,0x01c6,0x01ce,0x01d6,0x01de,0x01e6,0x01ee,0x01f6,0x01fe,0x81ca,0x81da,0x81ea,0x81fa,0x81c9,0x81d9,0x81e9,0x81f9,0x01c5,0x01cd,0x01d5,0x01dd,0x01e5,0x01ed,0x01f5,0x01fd,0x81c8,0x81d8,0x81e8,0x81f8,0x81c7,0x81d7,0x81e7,0x81f7,0x01c4,0x01cc,0x01d4,0x01dc,0x01e4,0x01ec,0x01f4,0x01fc,0x81c6,0x81d6,0x81e6,0x81f6,0x81c5,0x81d5,0x81e5,0x81f5,0x01c3,0x01cb,0x01d3,0x01db,0x01e3,0x01eb,0x01f3,0x01fb,0x81c4,0x81d4,0x81e4,0x81f4,0x81c3,0x81d3,0x81e3,0x81f3,0x01c2,0x01ca,0x01d2,0x01da,0x01e2,0x01ea,0x01f2,0x01fa,0x81c2,0x81d2,0x81e2,0x81f2,0x81c0,0x81c1,0x81d0,0x81d1,0x81e0,0x81e1,0x81f0,0x81f1,0x01c1,0x01c9,0x01d1,0x01d9,0x01e1,0x01e9,0x01f1,0x01f9,0x01c0,0x01c8,0x01d0,0x01d8,0x01e0,0x01e8,0x01f0,0x01f8,0x2118,0x2119,0x211a,0x211b,0x211c,0x211d,0x211e,0x211f,0x2120,0x2121,0x2122,0x2123,0x2124,0x2125,0x2126,0x2127,0x2128,0x2129,0x212a,0x212b,0x212c,0x212d,0x212e,0x212f,0x2130,0x2131,0x2132,0x2133,0x2134,0x2135,0x2136,0x2137,0x2138,0x2139,0x213a,0x213b,0x213c,0x213d,0x213e,0x213f},
};
constexpr int NQ_UNITS = 176;
constexpr size_t WS_DIFFO = 224 * MiB;
constexpr size_t WS_END2 = 256 * MiB;
constexpr int CW_FILL = 9984;
constexpr int N_FILL_ARRIVALS = 8 * 320;
constexpr int CW_QHEAD = 10240;
constexpr int CW_DIFF = 11264;
static_assert((CW_DIFF + 256 * 8) * 4 <= (int)CTL_ZERO_BYTES, "counters inside the zeroed control region");
static_assert(ab::ATTN_LDS_BYTES <= LDSCTL_OFF && ab::B_LDS_BYTES <= LDSCTL_OFF, "attention LDS fits below the control words");
__device__ __forceinline__ void diff_combine(const bf16_t* DIFFO, bf16_t* ATT, const float* subw, float lam, int b, int h, int qb, int wid, int lane_) {
    int lane = lane_; asm volatile("" : "+v"(lane));
    const int row = b * SEQ + 256 * qb + 32 * wid + (lane >> 1), hf = lane & 1;
    const __amdgpu_buffer_rsrc_t rs_ = __builtin_amdgcn_make_buffer_rsrc((void*)DIFFO, (short)0, 0x7fffffff, 0x00020000);
    const int o1_ = (int)(((size_t)row * 1024 + h * 256 + hf * 64) * 2), o2_ = o1_ + 256;
    f32x4 v[16]; float ss = 0.f;
#pragma unroll
    for (int q = 0; q < 8; ++q) { const v4u a = __builtin_amdgcn_raw_buffer_load_b128(rs_, o1_ + 16 * q, 0, 16), c = __builtin_amdgcn_raw_buffer_load_b128(rs_, o2_ + 16 * q, 0, 16);
        const f32x4 a0 = {__uint_as_float(a.x << 16), __uint_as_float(a.x & 0xffff0000u), __uint_as_float(a.y << 16), __uint_as_float(a.y & 0xffff0000u)};
        const f32x4 a1 = {__uint_as_float(a.z << 16), __uint_as_float(a.z & 0xffff0000u), __uint_as_float(a.w << 16), __uint_as_float(a.w & 0xffff0000u)};
        const f32x4 c0 = {__uint_as_float(c.x << 16), __uint_as_float(c.x & 0xffff0000u), __uint_as_float(c.y << 16), __uint_as_float(c.y & 0xffff0000u)};
        const f32x4 c1 = {__uint_as_float(c.z << 16), __uint_as_float(c.z & 0xffff0000u), __uint_as_float(c.w << 16), __uint_as_float(c.w & 0xffff0000u)};
        v[2 * q] = a0 - c0 * lam; v[2 * q + 1] = a1 - c1 * lam;
        ss += ((v[2 * q].x * v[2 * q].x + v[2 * q].y * v[2 * q].y) + (v[2 * q].z * v[2 * q].z + v[2 * q].w * v[2 * q].w)) + ((v[2 * q + 1].x * v[2 * q + 1].x + v[2 * q + 1].y * v[2 * q + 1].y) + (v[2 * q + 1].z * v[2 * q + 1].z + v[2 * q + 1].w * v[2 * q + 1].w)); }
    ss += __shfl_xor(ss, 1);
    const float rstd = rsqrtf(ss * (1.f / 128.f) + EPS) * 0.8f;
    GAS v4u* dst = (GAS v4u*)(ATT + (size_t)row * DM + h * 128 + hf * 64);
    const GAS f32x4* sw = (const GAS f32x4*)(subw + hf * 64);
#pragma unroll
    for (int q = 0; q < 8; ++q) { const f32x4 g0 = sw[2 * q] * rstd, g1 = sw[2 * q + 1] * rstd; const f32x4 o0 = v[2 * q] * g0, o1 = v[2 * q + 1] * g1;
        dst[q] = (v4u){pk2(o0.x, o0.y), pk2(o0.z, o0.w), pk2(o1.x, o1.y), pk2(o1.z, o1.w)}; }
}
#if PROBE_K >= 200
#define ACC_T0() unsigned long long acc_t0_ = __builtin_amdgcn_s_memrealtime()
#define ACC_ADD(cat) do { if (F.tid == 0) { const unsigned long long t1_ = __builtin_amdgcn_s_memrealtime(); F.MISC[40 + (cat)] += (unsigned)(t1_ - acc_t0_); } acc_t0_ = __builtin_amdgcn_s_memrealtime(); } while (0)
#else
#define ACC_T0() do {} while (0)
#define ACC_ADD(cat) do {} while (0)
#endif
__device__ __forceinline__ void attn_phase(Frame& F, char* shm, gu32* ctl, const bf16_t* PROJ, const float* CUMB, bf16_t* ATT, bf16_t* DIFFO, const float* subw, const float* lq1, const float* lk1, const float* lq2, const float* lk2,
                                           const bf16_t* HM, const bf16_t* WKV, bf16_t* MKN, bf16_t* VT, const float* mkw, const float* mqw) {
    const float s1 = wave_sum(lq1[F.lane] * lk1[F.lane]), s2 = wave_sum(lq2[F.lane] * lk2[F.lane]);
    const float lam = __uint_as_float(__builtin_amdgcn_readfirstlane(__float_as_uint(__expf(s1) - __expf(s2) + 0.2f)));
    const int xq = (int)(xb_xcc_id() & 7u);
    ACC_T0();
    for (;;) {
        if (F.tid == 0) F.MISC[13] = __hip_atomic_fetch_add((unsigned*)(ctl + CW_QHEAD + 64 * xq), 1u, __ATOMIC_RELAXED, __HIP_MEMORY_SCOPE_AGENT);
        __syncthreads();
        const unsigned qi = F.MISC[13];
        __syncthreads();
        if (qi >= (unsigned)NQ_UNITS) break;
        ACC_ADD(5);
        const unsigned u = UNIT_Q[xq][qi];
        const int qb = u & 7;
        if (u & 0x2000u) {
            LAS float* scr = (LAS float*)(F.lds + RING_OFF + F.wave * 16384);
            const unsigned char* ka_ = (const unsigned char*)__builtin_amdgcn_kernarg_segment_ptr(); asm volatile("" : "+s"(ka_));
            const Args* ap_ = (const Args*)ka_; const Ptrs P = make_ptrs(ap_->in, ap_->out, ap_->ws);
            const int it0 = (int)(u & 511) * 16 + F.wave * 2;
            int ln_ = F.lane; asm volatile("" : "+v"(ln_));
#pragma unroll 1
            for (int it = it0; it < it0 + 2; ++it) {
                int r = it;
                if (r < 512) { p0_transpose_item<false, true>(P.w_mq, DM, DM, DM, P.nmq, P.WQ, scr, r, ln_); continue; } r -= 512;
                if (r < 512) { p0_transpose_item<false, true>(P.w_mo, DM, DM, DM, nullptr, P.WO, scr, r, ln_); continue; } r -= 512;
                if (r < 2048) { p0_transpose_item<false, true>(P.w_up, DFF, DM, DFF, P.nmlp, P.WUP, scr, r, ln_); continue; } r -= 2048;
                p0_transpose_item<false, true>(P.w_dn, DM, DFF, DM, nullptr, P.WDN, scr, r, ln_);
            }
            VM_WAIT(); if (ln_ == 0) __hip_atomic_fetch_add((unsigned*)(ctl + CW_FILL), 1u, __ATOMIC_RELAXED, __HIP_MEMORY_SCOPE_AGENT);
            __syncthreads(); ACC_ADD(4);
        } else if (u & 0x4000u) {
            const int idx = u & 63;
            if (idx < 32) {
                pg8::Gemm g{HM, WKV, DM, DM, DM}; const Sched S = sched_one(idx >> 2, idx & 3, true);
                pg8::EpiHeadNormK E{MKN, mkw, mqw};
                pg8::gemm_phase<pg8::EpiHeadNormK, Sched, false, true>(F.lds + RING_OFF, g, S, E);
            } else {
                pg8::Gemm g{WKV + (size_t)1024 * DM, HM, DM, DM, DM}; const Sched S = sched_one((idx - 32) >> 3, (idx - 32) & 7, true);
                pg8::EpiStore<0> E{VT, MMEM, nullptr};
                pg8::gemm_phase<pg8::EpiStore<0>, Sched, true, true>(F.lds + RING_OFF, g, S, E);
            }
            __syncthreads(); ACC_ADD(3);
        } else if (u & 0x8000u) {
            const int rblk = u & 15, bh = (u >> 4) & 31, b = bh >> 2, h = bh & 3;
            const ab::bf16* base = (const ab::bf16*)PROJ + (size_t)b * SEQ * NPROJ;
            ab::diff_unit_ab<8>(rblk, base + C_DQ + 128 * h, base + C_DK + 128 * h, base + C_DV + 128 * h, ATT + (size_t)b * SEQ * DM + 128 * h, subw, lam, shm);
            ACC_ADD(1);
        } else {
            const int bh = (u >> 3) & 63, b = bh >> 3, h = bh & 7;
            const ab::bf16* base = (const ab::bf16*)PROJ + (size_t)b * SEQ * NPROJ;
            ab::attn_unit<24, 0, true, false>(qb, base + C_FQ + 64 * h, base + C_FK + 64 * h, base + C_FV + 64 * h, (ab::bf16*)ATT + (size_t)b * SEQ * DM + 512 + 64 * h, DM, CUMB + (size_t)bh * SEQ, shm);
            ACC_ADD(0);
        }
    }
}
#ifndef REP3
#define REP3 1
#endif
#define ATTN_PHASE_HOOK if (IN(3)) { PP; for (int rep_ = 0; rep_ < REP3; ++rep_) attn_phase(F, (char*)lds + RING_OFF, F.ctl, P.PROJ, P.CUMB, P.ATT, (bf16_t*)(args.ws + WS_DIFFO), P.subw, P.lq1, P.lk1, P.lq2, P.lk2, P.HM, P.WKV, P.MKN, P.VT, P.mkw, P.mqw); }
#ifndef PROBE_K
#define PROBE_K -1
#endif
#ifndef PROBE_MULT
#define PROBE_MULT 4
#endif
#define STAMP(i) do { if (PROBE_K >= 0 && F.tid == 0) { const unsigned long long t_ = __builtin_amdgcn_s_memrealtime(); F.MISC[16 + 2 * (i)] = (unsigned)t_; F.MISC[17 + 2 * (i)] = (unsigned)(t_ >> 32); } } while (0)
#ifndef REP0
#define REP0 1
#endif
#ifndef REP1
#define REP1 1
#endif
#ifndef REP2
#define REP2 1
#endif
#ifndef REP3
#define REP3 1
#endif
#ifndef REP4
#define REP4 1
#endif
#ifndef REP5
#define REP5 1
#endif
#ifndef REP6
#define REP6 1
#endif
#ifndef REP7
#define REP7 1
#endif
#ifndef REP8
#define REP8 1
#endif
constexpr int NPHASE = 9;

__global__ void __launch_bounds__(NWAVES * 64, 2) mega_fwd(Args args) {
    extern __shared__ __attribute__((aligned(16))) unsigned char lds[];
    Frame F;
    F.lds = (LAS unsigned char*)lds; F.MISC = (volatile LAS unsigned*)(F.lds + MISC_OFF);
    F.tid = threadIdx.x; F.lane = F.tid & 63; F.wave = __builtin_amdgcn_readfirstlane(F.tid >> 6);
    F.G = gridDim.x; { const int bx = blockIdx.x; F.vcu = (F.G % 8 == 0) ? (bx % 8) * (F.G / 8) + bx / 8 : bx; }
    F.ctl = (gu32*)(args.ws + WS_CTL);
    for (int u = F.tid; u < (LDS_BYTES - LDSCTL_OFF) / 4; u += NWAVES * 64) ((LAS unsigned*)(F.lds + LDSCTL_OFF))[u] = 0u;
    __syncthreads();
    XcdBarrier bar = xcd_barrier_post((unsigned*)(F.ctl + CW_BAR) + args.ph_lo * XCD_BAR_WORDS, F.MISC + 8);
    const int lo = args.ph_lo, hi = args.ph_hi;
#define IN(k) (lo <= (k) && (k) < hi)
#define PP const Ptrs P = make_ptrs(args.in, args.out, args.ws)
#define SEAM(k) do { if (IN(k) && IN((k) + 1)) xcd_barrier(bar); } while (0)
#define SEAM2(k) do { if (IN(k) && IN((k) + 2)) xcd_barrier(bar); } while (0)
#define SEAML(k) do { if (IN(k) && IN((k) + 1)) { if (loc) xcc_barrier(bar); else xcd_barrier(bar); } } while (0)
    const int bx = (int)blockIdx.x;
    STAMP(0);

    if (IN(0)) { PP; for (int rep_ = 0; rep_ < REP0; ++rep_) p0_prologue(F, P); } SEAM(0); STAMP(1);
    const bool loc = (lo == 0) && (F.MISC[11] != 0u);
    const int cx = loc ? (int)(F.MISC[10] * 8u + bar.x) : bx;

    if (IN(1)) {
        PP; for (int rep_ = 0; rep_ < REP1; ++rep_) {
        pg8::Gemm g{P.XB, P.WIN, DM, DM, DM}; const Sched S = sched_static(MTOK, NPROJ, F.G, cx);
        { const int sq = loc ? ((cx >> 3) < 8 ? (cx & 7) * 8 + (cx >> 3) : -1) : (bx < 64 ? bx : -1);
          if (sq >= 0) p1b_cumsum_wg(P.FLOG, P.b_forget, P.CUMB, sq, F.tid, (LAS float*)(F.lds + LDS_RQ)); }
        pg8::EpiProj E{P.PROJ, P.QKW, P.ROPE};
        pg8::gemm_phase<pg8::EpiProj, Sched, true, true>(F.lds + RING_OFF, g, S, E);
    }} if (IN(1) && IN(3)) { if (loc) xcc_barrier(bar); else xcd_barrier(bar); } STAMP(2);


    ATTN_PHASE_HOOK
    if (PROBE_K >= 300 && F.tid == 0) { __hip_atomic_fetch_add((unsigned*)(F.ctl + 3000), F.MISC[40 + (PROBE_K >= 300 ? PROBE_K - 300 : 0)], __ATOMIC_RELAXED, __HIP_MEMORY_SCOPE_AGENT); }
    STAMP(9); SEAML(3); STAMP(3);
    if (PROBE_K >= 300 && F.tid == 0) { F.MISC[39] = __hip_atomic_load((unsigned*)(F.ctl + 3000), __ATOMIC_RELAXED, __HIP_MEMORY_SCOPE_AGENT) / 256u; }

    if (IN(4)) {
        PP; for (int rep_ = 0; rep_ < REP4; ++rep_) {
        pg8::Gemm g{P.ATT, P.WOUT, DM, DM, DM}; const Sched S = sched_static(MTOK, DM, F.G, cx);
        pg8::EpiResid<0> E{P.RS0, P.XB, nullptr, P.SS};
        pg8::gemm_phase<pg8::EpiResid<0>, Sched, false, true>(F.lds + RING_OFF, g, S, E);
    }} SEAML(4); STAMP(4);

    if (IN(5)) {
        PP; for (int rep_ = 0; rep_ < REP5; ++rep_) {
        if (F.tid == 0) { XB_SPIN(__hip_atomic_load((unsigned*)(F.ctl + CW_FILL), __ATOMIC_RELAXED, __HIP_MEMORY_SCOPE_AGENT) < (unsigned)N_FILL_ARRIVALS, (unsigned*)(F.ctl + CW_BAR)); }
        __syncthreads();
        const Sched S0 = sched_static(MTOK, DM, F.G, cx); pg8::Unit u{0, 0}; const bool has = S0.next(0, u);
        PG8_LAS float* RQ = (PG8_LAS float*)(F.lds + LDS_RQ); PG8_LAS float* IL = (PG8_LAS float*)(F.lds + LDS_IL);
        {   pg8::Gemm g{P.XB, P.WQ, DM, DM, DM}; const Sched S = sched_one(u.pm, u.pn, has);
            pg8::EpiMemQ E{P.MQ, P.SS, RQ};
            pg8::gemm_phase<pg8::EpiMemQ, Sched, false, true>(F.lds + RING_OFF, g, S, E); }
        VM_WAIT(); __syncthreads(); if (F.tid == 0) { __builtin_amdgcn_fence(__ATOMIC_ACQUIRE, "agent"); VM_WAIT(); } __syncthreads();
        const int head = u.pn, bh = (u.pm >> 3) * 4 + head;
        {   pg8::Gemm g{P.MQ + head * 256, P.MKN + (size_t)bh * 65536, DM, 256, 256}; const Sched S = sched_one(u.pm, 0, has);
            pg8::EpiMemS E{P.MQ, head, RQ, IL};
            pg8::gemm_phase<pg8::EpiMemS, Sched, false, true>(F.lds + RING_OFF, g, S, E); }
        VM_WAIT(); __syncthreads(); if (F.tid == 0) { __builtin_amdgcn_fence(__ATOMIC_ACQUIRE, "agent"); VM_WAIT(); } __syncthreads();
        {   pg8::Gemm g{P.MQ + head * 256, P.VT + (size_t)(head * 256) * MMEM + (u.pm >> 3) * 256, DM, MMEM, 256}; const Sched S = sched_one(u.pm, 0, has);
            pg8::EpiMemPV E{P.MO, head, IL};
            pg8::gemm_phase<pg8::EpiMemPV, Sched, true, true>(F.lds + RING_OFF, g, S, E); }
    }} SEAML(5); STAMP(5);

    if (IN(6)) {
        PP; for (int rep_ = 0; rep_ < REP6; ++rep_) {
        pg8::Gemm g{P.MO, P.WO, DM, DM, DM}; const Sched S = sched_static(MTOK, DM, F.G, cx);
        pg8::EpiResid<1> E{nullptr, P.XB, nullptr, P.SS};
        pg8::gemm_phase<pg8::EpiResid<1>, Sched, false, true>(F.lds + RING_OFF, g, S, E);
    }} SEAML(6); STAMP(6);

    if (IN(7)) {
        PP; for (int rep_ = 0; rep_ < REP7; ++rep_) {
        pg8::Gemm g{P.XB, P.WUP, DM, DM, DM}; const Sched S = sched_static(MTOK, DFF, F.G, cx);
        pg8::EpiStore<3> E{P.H, DFF, P.SS};
        pg8::gemm_phase<pg8::EpiStore<3>, Sched, true, true>(F.lds + RING_OFF, g, S, E);
    }} SEAML(7); STAMP(7);

    if (IN(8)) {
        PP; for (int rep_ = 0; rep_ < REP8; ++rep_) {
        pg8::Gemm g{P.H, P.WDN, DFF, DFF, DFF}; const Sched S = sched_static(MTOK, DM, F.G, cx);
        pg8::EpiResid<2> E{nullptr, P.XB, P.out, nullptr};
        pg8::gemm_phase<pg8::EpiResid<2>, Sched, false, true>(F.lds + RING_OFF, g, S, E);
    }}
    STAMP(8);
    if (PROBE_K >= 0 && F.tid == 0) {
        constexpr int IA_ = PROBE_K == 100 ? 9 : (PROBE_K >= 200 ? 0 : PROBE_K), IB_ = PROBE_K == 100 ? 3 : (PROBE_K >= 200 ? 1 : PROBE_K + 1);
        const unsigned long long a_ = ((unsigned long long)F.MISC[17 + 2 * IA_] << 32) | F.MISC[16 + 2 * IA_], b_ = ((unsigned long long)F.MISC[17 + 2 * IB_] << 32) | F.MISC[16 + 2 * IB_];
        unsigned long long w_ = (b_ - a_) * PROBE_MULT; if (PROBE_K >= 200 && PROBE_K < 300) w_ = (unsigned long long)F.MISC[40 + (PROBE_K >= 200 && PROBE_K < 300 ? PROBE_K - 200 : 0)] * PROBE_MULT; if (PROBE_K >= 300) w_ = (unsigned long long)F.MISC[39] * PROBE_MULT;
        const unsigned long long t0_ = __builtin_amdgcn_s_memrealtime();
        while (__builtin_amdgcn_s_memrealtime() - t0_ < w_) __builtin_amdgcn_s_sleep(8);
    }
#undef IN
#undef SEAM
#undef SEAM2
}
extern "C" void kernel_launch(void* const* d_in, const int* in_sizes, int n_in, void* d_out, int out_size, void* d_ws, size_t ws_size, hipStream_t stream) {
    static int grid = 0;
    if (grid == 0) {
        if (n_in != 26 || in_sizes[0] != MTOK * DM || out_size != MTOK * DM || ws_size < WS_END2) { fprintf(stderr, "kernel_launch: unexpected shapes (n_in %d, in0 %d, out %d, ws %zu)\n", n_in, n_in > 0 ? in_sizes[0] : -1, out_size, ws_size); grid = -1; return; }
        int dev = 0, cus = 0, per_cu = 0;
        if (hipGetDevice(&dev) != hipSuccess || hipDeviceGetAttribute(&cus, hipDeviceAttributeMultiprocessorCount, dev) != hipSuccess) { grid = -1; return; }
        if (hipFuncSetAttribute((const void*)mega_fwd, hipFuncAttributeMaxDynamicSharedMemorySize, LDS_BYTES) != hipSuccess) { fprintf(stderr, "kernel_launch: hipFuncSetAttribute failed\n"); grid = -1; return; }
        if (hipOccupancyMaxActiveBlocksPerMultiprocessor(&per_cu, (const void*)mega_fwd, NWAVES * 64, LDS_BYTES) != hipSuccess || per_cu < 1) { fprintf(stderr, "kernel_launch: occupancy query says %d blocks per CU\n", per_cu); (void)hipGetLastError(); grid = -1; return; }
        grid = cus;
        if (grid != 256) fprintf(stderr, "kernel_launch: %d CUs; the one-unit-per-workgroup phases assume 256\n", grid);
    }
    if (grid < 0) return;
    (void)hipMemsetAsync((char*)d_ws + WS_CTL, 0, CTL_ZERO_BYTES, stream);
    Args a{};
    for (int i = 0; i < 26; ++i) a.in[i] = d_in[i];
    a.out = (float*)d_out; a.ws = (unsigned char*)d_ws;
#if MK_HYBRID
    const Ptrs P = make_ptrs(a.in, a.out, a.ws);
    a.ph_lo = 0; a.ph_hi = 3; hipLaunchKernelGGL(mega_fwd, dim3(grid), dim3(NWAVES * 64), LDS_BYTES, stream, a);
    float* OF = a.out;
    hipLaunchKernelGGL(k_attn, dim3(MTOK / 64, 8), dim3(64), 0, stream, P.PROJ, P.CUMB, 1, OF, 8);
    hipLaunchKernelGGL(k_fox_fin, dim3(MTOK * 512 / 256), dim3(256), 0, stream, OF, P.ATT);
    hipLaunchKernelGGL(k_attn, dim3(MTOK / 64, 16), dim3(64), 0, stream, P.PROJ, P.CUMB, 0, OF, 16);
    hipLaunchKernelGGL(k_diff_fin, dim3(MTOK), dim3(256), 0, stream, OF, P.lq1, P.lk1, P.lq2, P.lk2, P.subw, P.ATT);
    a.ph_lo = 4; a.ph_hi = 9; hipLaunchKernelGGL(mega_fwd, dim3(grid), dim3(NWAVES * 64), LDS_BYTES, stream, a);
#else
    a.ph_lo = 0; a.ph_hi = NPHASE; hipLaunchKernelGGL(mega_fwd, dim3(grid), dim3(NWAVES * 64), LDS_BYTES, stream, a);
#endif
}
```

```cpp
#include <hip/hip_runtime.h>
#include <cstdint>
#include <cstdio>

typedef unsigned short bf16_t;
__device__ __forceinline__ float bf2f(bf16_t v) { return __uint_as_float(((unsigned)v) << 16); }
__device__ __forceinline__ bf16_t f2bf(float f) { unsigned u = __float_as_uint(f); return (bf16_t)((u + 0x7fffu + ((u >> 16) & 1u)) >> 16); }

constexpr int NB = 8, SEQ = 2048, DM = 1024, MTOK = NB * SEQ, MEML = 256, MMEM = NB * MEML;
constexpr int NPROJ = 3072, INCOLS = 3080, DFF = 4096;
constexpr float EPS = 1e-6f;
constexpr float LOG2E = 1.4426950408889634f;
constexpr float C2 = 0.125f * LOG2E;
constexpr float CM = 0.0625f * LOG2E;
constexpr int C_DQ = 0, C_DK = 512, C_DV = 1024, C_FQ = 1536, C_FK = 2048, C_FV = 2560;

constexpr size_t MiB = 1u << 20;
constexpr size_t WS_CTL = 0, CTL_ZERO_BYTES = 112 * 1024;
constexpr size_t WS_FLOG = 1 * MiB;
constexpr size_t WS_CUMB = 2 * MiB;
constexpr size_t WS_ROPE = 3 * MiB;
constexpr size_t WS_RS0 = 4 * MiB + 256 * 1024;
constexpr size_t WS_QKW = 4 * MiB + 512 * 1024;
constexpr size_t WS_SS = 4 * MiB;
constexpr size_t WS_WIN = 8 * MiB, WS_WOUT = 14 * MiB, WS_WQ = 16 * MiB, WS_WKV = 18 * MiB, WS_WO = 22 * MiB, WS_WUP = 24 * MiB, WS_WDN = 32 * MiB;
constexpr size_t WS_XB = 40 * MiB;
constexpr size_t WS_HM = 72 * MiB;
constexpr size_t WS_MK = 76 * MiB;
constexpr size_t WS_VT = 80 * MiB;
constexpr size_t WS_MKN = 84 * MiB;
constexpr size_t WS_PROJ = 96 * MiB;
constexpr size_t WS_ATT = 192 * MiB;
constexpr size_t WS_MQ = 96 * MiB;
constexpr size_t WS_MO = 128 * MiB;
constexpr size_t WS_H = 96 * MiB;
constexpr size_t WS_END = 224 * MiB;
#define MK_HYBRID 0
namespace pg8 {
#define PG8_LAS __attribute__((address_space(3)))
typedef short bf16x8 __attribute__((ext_vector_type(8)));
typedef float f32x4 __attribute__((ext_vector_type(4)));
typedef unsigned u32x4 __attribute__((ext_vector_type(4)));
typedef unsigned u32x2 __attribute__((ext_vector_type(2)));
constexpr int BM = 256, BK = 64, HALF = 128, HTB = HALF * BK * 2  , STAGE_BYTES = 8 * HTB, NXCD = 8, WGM = 8;

__host__ __device__ __forceinline__ int lds_byte(int r, int c) { const int st = (r >> 4) * 2 + (c >> 5), rr = r & 15, cc = c & 31, ob = rr * 64 + cc * 2; return st * 1024 + (ob ^ (((ob >> 9) & 1) << 5)); }
__host__ __device__ __forceinline__ void stage_rc(int b, int& R, int& C) { const int st = b / 1024, sb = b % 1024, swz = sb ^ (((sb >> 9) & 1) << 5); R = (st >> 1) * 16 + swz / 64; C = (st & 1) * 32 + (swz % 64) / 2; }
__host__ __device__ __forceinline__ int perm32(int rho) { const int n = rho >> 4, i = rho & 15; return 8 * (i >> 2) + 4 * n + (i & 3); }

struct Unit { int pm, pn; };
struct Gemm { const bf16_t* A; const bf16_t* Bt; int lda, ldb, K; };

struct StaticOrder {
    int nM, nN, nwg, G, c;
    __host__ __device__ void init(int M, int N, int G_, int c_) { nM = M / BM; nN = N / BM; nwg = nM * nN; G = G_; c = c_; }
    __host__ __device__ bool next(int i, Unit& u) const {
        const long L = (long)i * G + c; if (L >= nwg) return false;
        int wgid = (int)L; { const int q = nwg / NXCD, r = nwg % NXCD, xcd = wgid % NXCD, off = wgid / NXCD; wgid = (xcd < r ? xcd * (q + 1) : r * (q + 1) + (xcd - r) * q) + off; }
        const int nig = WGM * nN, gid = wgid / nig, fm = gid * WGM, gsz = (nM - fm) < WGM ? (nM - fm) : WGM;
        u.pm = fm + ((wgid % nig) % gsz); u.pn = (wgid % nig) / gsz; return true;
    }
    __device__ __forceinline__ void a_ready(const Unit&) const {}
    __device__ __forceinline__ void done(const Unit&) const {}
};
struct OneUnit {
    int pm, pn; bool has;
    __device__ __forceinline__ bool next(int i, Unit& u) const { if (i != 0 || !has) return false; u.pm = pm; u.pn = pn; return true; }
    __device__ __forceinline__ void a_ready(const Unit&) const {}
    __device__ __forceinline__ void done(const Unit&) const {}
};

__device__ __forceinline__ float relu1(float x) { float r; asm("v_max_f32 %0, 0, %1" : "=v"(r) : "v"(x)); return r; }
__device__ __forceinline__ unsigned cvt_pk_bf16(float lo, float hi) { unsigned r; asm volatile("v_cvt_pk_bf16_f32 %0, %1, %2" : "=v"(r) : "v"(lo), "v"(hi)); return r; }
__device__ __forceinline__ float xsum_fq(float s) {
    const auto a = __builtin_amdgcn_permlane16_swap(__float_as_uint(s), __float_as_uint(s), false, false);
    s = __uint_as_float(a[0]) + __uint_as_float(a[1]);
    const auto b = __builtin_amdgcn_permlane32_swap(__float_as_uint(s), __float_as_uint(s), false, false);
    return __uint_as_float(b[0]) + __uint_as_float(b[1]);
}
__device__ __forceinline__ float xchg16(float v, int fq) {
    const auto a = __builtin_amdgcn_permlane16_swap(__float_as_uint(v), __float_as_uint(v), false, false);
    return (fq & 1) ? __uint_as_float(a[0]) : __uint_as_float(a[1]);
}
#define PG8_LBAR() do { asm volatile("s_waitcnt lgkmcnt(0)" ::: "memory"); __builtin_amdgcn_s_barrier(); asm volatile("" ::: "memory"); } while (0)

template <int MODE> struct EpiStore {
    static constexpr bool PERM = true, AFTER_DRAIN = false;
    bf16_t* O; int ldc; const float* SS;
    __device__ __forceinline__ void operator()(const f32x4 (&acc)[2][2][4][2], const Unit& u, int wr, int wc, int fr, int fq) const {
        const int row0 = u.pm * BM + wr * 64 + fr, col0 = u.pn * BM + wc * 32 + 8 * fq;
#pragma unroll
        for (int ai = 0; ai < 2; ++ai)
#pragma unroll
            for (int m = 0; m < 4; ++m) { const int row = row0 + ai * HALF + m * 16; float rs = 1.f;
                if (MODE == 2) { const f32x4 s = *(const f32x4*)(SS + (size_t)row * 4); rs = rsqrtf(((s[0] + s[1]) + (s[2] + s[3])) * (1.f / DM) + EPS); }
                bf16_t* rowp = O + (size_t)row * ldc + col0;
#pragma unroll
                for (int bj = 0; bj < 2; ++bj) { f32x4 v0 = acc[ai][bj][m][0], v1 = acc[ai][bj][m][1];
                    if (MODE == 2) { v0 = v0 * rs; v1 = v1 * rs; }
                    if (MODE == 3) {
#pragma unroll
                        for (int e = 0; e < 4; ++e) { const float a = relu1(v0[e]), b = relu1(v1[e]); v0[e] = a * a; v1[e] = b * b; } }
                    u32x4 w; w.x = cvt_pk_bf16(v0[0], v0[1]); w.y = cvt_pk_bf16(v0[2], v0[3]); w.z = cvt_pk_bf16(v1[0], v1[1]); w.w = cvt_pk_bf16(v1[2], v1[3]);
                    *(u32x4*)(rowp + bj * HALF) = w; } }
    }
};
struct EpiProj {
    static constexpr bool PERM = true, AFTER_DRAIN = false;
    bf16_t* O; const float* QKW; const float* ROPE;
    __device__ __forceinline__ void operator()(const f32x4 (&acc)[2][2][4][2], const Unit& u, int wr, int wc, int fr, int fq) const {
        const int sec = u.pn >> 1, row0 = u.pm * BM + wr * 64 + fr, col0 = u.pn * BM + wc * 64 + 8 * fq;
        if (sec == 2 || sec == 5) {
#pragma unroll
            for (int ai = 0; ai < 2; ++ai)
#pragma unroll
                for (int m = 0; m < 4; ++m) { bf16_t* rowp = O + (size_t)(row0 + ai * HALF + m * 16) * NPROJ + col0;
#pragma unroll
                    for (int bj = 0; bj < 2; ++bj) { const f32x4 v0 = acc[ai][bj][m][0], v1 = acc[ai][bj][m][1];
                        u32x4 w; w.x = cvt_pk_bf16(v0[0], v0[1]); w.y = cvt_pk_bf16(v0[2], v0[3]); w.z = cvt_pk_bf16(v1[0], v1[1]); w.w = cvt_pk_bf16(v1[2], v1[3]);
                        *(u32x4*)(rowp + bj * 32) = w; } }
            return;
        }
        const float* w = QKW + 64 * (sec < 2 ? sec : sec - 1);
        const float sc = (sec == 0 || sec == 3) ? C2 : 1.f; const bool rope = sec < 2;
        f32x4 g[2][2];
#pragma unroll
        for (int bj = 0; bj < 2; ++bj)
#pragma unroll
            for (int n = 0; n < 2; ++n) g[bj][n] = *(const f32x4*)(w + 32 * bj + 8 * fq + 4 * n);
        const float sgn = fq == 0 ? -1.f : 1.f; const bool rl = fq < 2;
#pragma unroll
        for (int ai = 0; ai < 2; ++ai)
#pragma unroll
            for (int m = 0; m < 4; ++m) { const int row = row0 + ai * HALF + m * 16; float ss = 0.f;
#pragma unroll
                for (int bj = 0; bj < 2; ++bj)
#pragma unroll
                    for (int n = 0; n < 2; ++n) { const f32x4 a = acc[ai][bj][m][n]; ss += (a[0] * a[0] + a[1] * a[1]) + (a[2] * a[2] + a[3] * a[3]); }
                ss = xsum_fq(ss);
                const float rstd = rsqrtf(ss * (1.f / 64.f) + EPS) * sc;
                f32x4 v[2][2];
#pragma unroll
                for (int bj = 0; bj < 2; ++bj)
#pragma unroll
                    for (int n = 0; n < 2; ++n) v[bj][n] = acc[ai][bj][m][n] * rstd * g[bj][n];
                if (rope) {
#pragma unroll
                    for (int n = 0; n < 2; ++n) { f32x4 pr;
#pragma unroll
                        for (int e = 0; e < 4; ++e) pr[e] = xchg16(v[0][n][e], fq);
                        const f32x4 c = *(const f32x4*)(ROPE + (size_t)row * 16 + 4 * n), s = *(const f32x4*)(ROPE + (size_t)row * 16 + 8 + 4 * n);
                        const f32x4 r = v[0][n] * c + pr * s * sgn;
                        if (rl) v[0][n] = r; }
                }
                bf16_t* rowp = O + (size_t)row * NPROJ + col0;
#pragma unroll
                for (int bj = 0; bj < 2; ++bj) { u32x4 wv; wv.x = cvt_pk_bf16(v[bj][0][0], v[bj][0][1]); wv.y = cvt_pk_bf16(v[bj][0][2], v[bj][0][3]); wv.z = cvt_pk_bf16(v[bj][1][0], v[bj][1][1]); wv.w = cvt_pk_bf16(v[bj][1][2], v[bj][1][3]);
                    *(u32x4*)(rowp + bj * 32) = wv; } }
    }
};
template <int MODE> struct EpiResid {
    static constexpr bool PERM = true, AFTER_DRAIN = true;
    const float* xf; bf16_t* xb; float* outf; float* SS;
    __device__ __forceinline__ void fused(f32x4 (&acc)[2][2][4][2], const Unit& u, int wr, int wc, int fr, int fq, PG8_LAS unsigned char* lds, int wid, int lane) const {
        PG8_LAS float* P = (PG8_LAS float*)lds;
        const int col0 = u.pn * BM + wc * 32 + 8 * fq;
#pragma unroll
        for (int ai = 0; ai < 2; ++ai)
#pragma unroll
            for (int m = 0; m < 4; ++m) { const int r = ai * HALF + wr * 64 + m * 16 + fr; const size_t off = (size_t)(u.pm * BM + r) * DM + col0; float s = 0.f;
                const float rsc = MODE == 0 ? xf[u.pm * BM + r] : 1.f; float r2 = 1.f;
                if (MODE == 2) { const f32x4 q = *(const f32x4*)(SS + (size_t)(u.pm * BM + r) * 4); r2 = __builtin_amdgcn_rcpf(((q[0] + q[1]) + (q[2] + q[3])) * (1.f / DM) + EPS); }
#pragma unroll
                for (int bj = 0; bj < 2; ++bj) { f32x4 b0, b1;
                    { const u32x4 w = *(const u32x4*)(xb + off + bj * HALF);
                        b0 = (f32x4){__uint_as_float(w.x << 16), __uint_as_float(w.x & 0xffff0000u), __uint_as_float(w.y << 16), __uint_as_float(w.y & 0xffff0000u)};
                        b1 = (f32x4){__uint_as_float(w.z << 16), __uint_as_float(w.z & 0xffff0000u), __uint_as_float(w.w << 16), __uint_as_float(w.w & 0xffff0000u)}; }
                    const f32x4 o0 = MODE == 2 ? acc[ai][bj][m][0] * r2 + b0 : b0 * rsc + acc[ai][bj][m][0], o1 = MODE == 2 ? acc[ai][bj][m][1] * r2 + b1 : b1 * rsc + acc[ai][bj][m][1];
                    if (MODE == 2) { __builtin_nontemporal_store(o0, (f32x4*)(outf + off + bj * HALF)); __builtin_nontemporal_store(o1, (f32x4*)(outf + off + bj * HALF + 4)); }
                    else { u32x4 w; w.x = cvt_pk_bf16(o0[0], o0[1]); w.y = cvt_pk_bf16(o0[2], o0[3]); w.z = cvt_pk_bf16(o1[0], o1[1]); w.w = cvt_pk_bf16(o1[2], o1[3]); *(u32x4*)(xb + off + bj * HALF) = w;
                        s += ((o0[0] * o0[0] + o0[1] * o0[1]) + (o0[2] * o0[2] + o0[3] * o0[3])) + ((o1[0] * o1[0] + o1[1] * o1[1]) + (o1[2] * o1[2] + o1[3] * o1[3])); } }
                if (MODE != 2) { s = xsum_fq(s); if (fq == 0) P[r * 4 + wc] = s; }
                if (MODE == 0 ? (m == 3) : false) asm volatile("" ::: "memory"); }
        if (MODE != 2) { PG8_LBAR();
            const int t = wid * 64 + lane; if (t < 256) { const f32x4 p = *(const PG8_LAS f32x4*)(P + t * 4); SS[(size_t)(u.pm * BM + t) * 4 + u.pn] = (p[0] + p[1]) + (p[2] + p[3]); } }
    }
};
struct EpiHeadNormK {
    static constexpr bool PERM = true, AFTER_DRAIN = true;
    bf16_t* MKn; const float* kw; const float* qw;
    __device__ __forceinline__ void fused(f32x4 (&acc)[2][2][4][2], const Unit& u, int wr, int wc, int fr, int fq, PG8_LAS unsigned char* lds, int wid, int lane) const {
        PG8_LAS float* P = (PG8_LAS float*)lds; PG8_LAS float* R = (PG8_LAS float*)(lds + 4096);
#pragma unroll
        for (int ai = 0; ai < 2; ++ai)
#pragma unroll
            for (int m = 0; m < 4; ++m) { float s = 0.f;
#pragma unroll
                for (int bj = 0; bj < 2; ++bj)
#pragma unroll
                    for (int n = 0; n < 2; ++n) { const f32x4 v = acc[ai][bj][m][n]; s += (v[0] * v[0] + v[1] * v[1]) + (v[2] * v[2] + v[3] * v[3]); }
                s = xsum_fq(s); if (fq == 0) P[(ai * HALF + wr * 64 + m * 16 + fr) * 4 + wc] = s; }
        PG8_LBAR();
        { const int t = wid * 64 + lane; if (t < 256) { const f32x4 p = *(const PG8_LAS f32x4*)(P + t * 4); R[t] = rsqrtf(((p[0] + p[1]) + (p[2] + p[3])) * (1.f / 256.f) + EPS); } }
        PG8_LBAR();
        const int c0 = wc * 32 + 8 * fq; f32x4 g[2][2];
#pragma unroll
        for (int bj = 0; bj < 2; ++bj)
#pragma unroll
            for (int n = 0; n < 2; ++n) { const f32x4 a = *(const f32x4*)(kw + c0 + bj * HALF + 4 * n), b = *(const f32x4*)(qw + c0 + bj * HALF + 4 * n); g[bj][n] = a * b * CM; }
        bf16_t* basep = MKn + (size_t)(u.pm * 4 + u.pn) * 65536;
#pragma unroll
        for (int ai = 0; ai < 2; ++ai)
#pragma unroll
            for (int m = 0; m < 4; ++m) { const int r = ai * HALF + wr * 64 + m * 16 + fr; const float rk = R[r];
#pragma unroll
                for (int bj = 0; bj < 2; ++bj) { const f32x4 v0 = acc[ai][bj][m][0] * rk * g[bj][0], v1 = acc[ai][bj][m][1] * rk * g[bj][1];
                    u32x4 w; w.x = cvt_pk_bf16(v0[0], v0[1]); w.y = cvt_pk_bf16(v0[2], v0[3]); w.z = cvt_pk_bf16(v1[0], v1[1]); w.w = cvt_pk_bf16(v1[2], v1[3]);
                    *(u32x4*)(basep + (size_t)r * 256 + c0 + bj * HALF) = w; } }
    }
};
struct EpiMemQ {
    static constexpr bool PERM = true, AFTER_DRAIN = true;
    bf16_t* MQ; const float* SS; PG8_LAS float* RQ;
    __device__ __forceinline__ void fused(f32x4 (&acc)[2][2][4][2], const Unit& u, int wr, int wc, int fr, int fq, PG8_LAS unsigned char* lds, int wid, int lane) const {
        PG8_LAS float* P = (PG8_LAS float*)lds;
        const int col0 = u.pn * BM + wc * 32 + 8 * fq;
#pragma unroll
        for (int ai = 0; ai < 2; ++ai)
#pragma unroll
            for (int m = 0; m < 4; ++m) { const int r = ai * HALF + wr * 64 + m * 16 + fr; const int row = u.pm * BM + r;
                const f32x4 ss = *(const f32x4*)(SS + (size_t)row * 4); const float rs = rsqrtf(((ss[0] + ss[1]) + (ss[2] + ss[3])) * (1.f / DM) + EPS); float s = 0.f;
#pragma unroll
                for (int bj = 0; bj < 2; ++bj) { const f32x4 v0 = acc[ai][bj][m][0] * rs, v1 = acc[ai][bj][m][1] * rs;
                    s += (v0[0] * v0[0] + v0[1] * v0[1]) + (v0[2] * v0[2] + v0[3] * v0[3]) + (v1[0] * v1[0] + v1[1] * v1[1]) + (v1[2] * v1[2] + v1[3] * v1[3]);
                    u32x4 w; w.x = cvt_pk_bf16(v0[0], v0[1]); w.y = cvt_pk_bf16(v0[2], v0[3]); w.z = cvt_pk_bf16(v1[0], v1[1]); w.w = cvt_pk_bf16(v1[2], v1[3]);
                    *(u32x4*)(MQ + (size_t)row * DM + col0 + bj * HALF) = w; }
                s = xsum_fq(s); if (fq == 0) P[r * 4 + wc] = s; }
        PG8_LBAR();
        { const int t = wid * 64 + lane; if (t < 256) { const f32x4 p = *(const PG8_LAS f32x4*)(P + t * 4); RQ[t] = rsqrtf(((p[0] + p[1]) + (p[2] + p[3])) * (1.f / 256.f) + EPS); } }
        PG8_LBAR();
    }
};
struct EpiMemS {
    static constexpr bool PERM = true, AFTER_DRAIN = true;
    bf16_t* Pt; int head; const PG8_LAS float* RQ; PG8_LAS float* IL;
    __device__ __forceinline__ void fused(f32x4 (&acc)[2][2][4][2], const Unit& u, int wr, int wc, int fr, int fq, PG8_LAS unsigned char* lds, int wid, int lane) const {
        PG8_LAS float* P = (PG8_LAS float*)lds;
        const int col0 = head * BM + wc * 32 + 8 * fq;
#pragma unroll
        for (int ai = 0; ai < 2; ++ai)
#pragma unroll
            for (int m = 0; m < 4; ++m) { const int r = ai * HALF + wr * 64 + m * 16 + fr; const int row = u.pm * BM + r; const float rq = RQ[r]; float s = 0.f;
#pragma unroll
                for (int bj = 0; bj < 2; ++bj) { f32x4 v0 = acc[ai][bj][m][0] * rq, v1 = acc[ai][bj][m][1] * rq;
#pragma unroll
                    for (int e = 0; e < 4; ++e) { v0[e] = __builtin_amdgcn_exp2f(v0[e]); v1[e] = __builtin_amdgcn_exp2f(v1[e]); }
                    s += (v0[0] + v0[1]) + (v0[2] + v0[3]) + (v1[0] + v1[1]) + (v1[2] + v1[3]);
                    u32x4 w; w.x = cvt_pk_bf16(v0[0], v0[1]); w.y = cvt_pk_bf16(v0[2], v0[3]); w.z = cvt_pk_bf16(v1[0], v1[1]); w.w = cvt_pk_bf16(v1[2], v1[3]);
                    *(u32x4*)(Pt + (size_t)row * DM + col0 + bj * HALF) = w; }
                s = xsum_fq(s); if (fq == 0) P[r * 4 + wc] = s; }
        PG8_LBAR();
        { const int t = wid * 64 + lane; if (t < 256) { const f32x4 p = *(const PG8_LAS f32x4*)(P + t * 4); IL[t] = 1.0f / ((p[0] + p[1]) + (p[2] + p[3])); } }
        PG8_LBAR();
    }
};
struct EpiMemPV {
    static constexpr bool PERM = true, AFTER_DRAIN = false;
    bf16_t* MO; int head; const PG8_LAS float* IL;
    __device__ __forceinline__ void operator()(const f32x4 (&acc)[2][2][4][2], const Unit& u, int wr, int wc, int fr, int fq) const {
        const int col0 = head * BM + wc * 32 + 8 * fq;
#pragma unroll
        for (int ai = 0; ai < 2; ++ai)
#pragma unroll
            for (int m = 0; m < 4; ++m) { const int r = ai * HALF + wr * 64 + m * 16 + fr; const int row = u.pm * BM + r; const float il = IL[r];
#pragma unroll
                for (int bj = 0; bj < 2; ++bj) { const f32x4 v0 = acc[ai][bj][m][0] * il, v1 = acc[ai][bj][m][1] * il;
                    u32x4 w; w.x = cvt_pk_bf16(v0[0], v0[1]); w.y = cvt_pk_bf16(v0[2], v0[3]); w.z = cvt_pk_bf16(v1[0], v1[1]); w.w = cvt_pk_bf16(v1[2], v1[3]);
                    *(u32x4*)(MO + (size_t)row * DM + col0 + bj * HALF) = w; } }
    }
};

template <class Epi, class Sched, bool ALIGN_EPI = false, bool SP2 = false>
__device__ __forceinline__ void gemm_phase(PG8_LAS unsigned char* lds, const Gemm g, const Sched& S, const Epi& E) {
    int tid_ = threadIdx.x; asm volatile("" : "+v"(tid_));
    const int tid = tid_, wid = __builtin_amdgcn_readfirstlane(tid >> 6), lane = tid & 63, wr = wid >> 2, wc = wid & 3, fr = lane & 15, fq = lane >> 4;
    const int K = g.K, nt = K / BK;
    unsigned voffA[2], voffB[2];
#pragma unroll
    for (int i = 0; i < 2; ++i) { int R, C; stage_rc(tid * 16 + i * 8192, R, C); const int Rb = Epi::PERM ? ((R & ~31) + perm32(R & 31)) : R;
        voffA[i] = (unsigned)(R * g.lda + C) * 2u; voffB[i] = (unsigned)(Rb * g.ldb + C) * 2u; }
    const size_t kstep = (size_t)(BK * 2);
    const size_t hsA = (size_t)HALF * g.lda * 2, hsB = (size_t)HALF * g.ldb * 2;
    const size_t tsA = 2 * hsA, tsB = 2 * hsB;
    const unsigned ldsw = (unsigned)wid * 1024u;
    const int aoff = lds_byte(wr * 64 + fr, fq * 8), boff = lds_byte(wc * 32 + fr, fq * 8);
#define PG8_SA(b, h) (((b) * 2 + (h)) * HTB)
#define PG8_SB(b, h) ((4 + (b) * 2 + (h)) * HTB)
#define PG8_STAGE(bufoff, gbase, voff) do { _Pragma("unroll") for (int _i = 0; _i < 2; ++_i) \
        __builtin_amdgcn_global_load_lds((const unsigned*)((const char*)(gbase) + (voff)[_i]), (PG8_LAS unsigned*)(lds + (bufoff) + ldsw + _i * 8192), 16, 0, 0); } while (0)
#define PG8_LDA(dst, b, h) do { _Pragma("unroll") for (int m = 0; m < 4; ++m) _Pragma("unroll") for (int k = 0; k < 2; ++k) dst[m][k] = *(const PG8_LAS bf16x8*)(lds + PG8_SA(b, h) + aoff + m * 2048 + k * 1024); } while (0)
#define PG8_LDB(dst, b, h) do { _Pragma("unroll") for (int n = 0; n < 2; ++n) _Pragma("unroll") for (int k = 0; k < 2; ++k) dst[n][k] = *(const PG8_LAS bf16x8*)(lds + PG8_SB(b, h) + boff + n * 2048 + k * 1024); } while (0)
#define PG8_MMA(ai, bj, At, Bt) do { __builtin_amdgcn_s_setprio(1); _Pragma("unroll") for (int m = 0; m < 4; ++m) _Pragma("unroll") for (int n = 0; n < 2; ++n) _Pragma("unroll") for (int k = 0; k < 2; ++k) \
        acc[ai][bj][m][n] = __builtin_amdgcn_mfma_f32_16x16x32_bf16(Bt[n][k], At[m][k], acc[ai][bj][m][n], 0, 0, 0); __builtin_amdgcn_s_setprio(0); } while (0)
#define PG8_WAIT_V(n) asm volatile("s_waitcnt vmcnt(" #n ")" ::: "memory")
#define PG8_WAIT_L(n) asm volatile("s_waitcnt lgkmcnt(" #n ")" ::: "memory")
#define PG8_BAR __builtin_amdgcn_s_barrier()
#define PG8_SCHED __builtin_amdgcn_sched_barrier(0)
    Unit cur, nxt; int ui = 0;
    if (!S.next(0, cur)) return;
    f32x4 acc[2][2][4][2];
#pragma unroll
    for (int a = 0; a < 2; ++a)
#pragma unroll
        for (int b = 0; b < 2; ++b)
#pragma unroll
            for (int m = 0; m < 4; ++m)
#pragma unroll
                for (int n = 0; n < 2; ++n) acc[a][b][m][n] = (f32x4){0.f, 0.f, 0.f, 0.f};
    bf16x8 At[4][2], B0[2][2], B1[2][2];
    const char* cA = (const char*)g.A + (size_t)cur.pm * tsA; const char* cB = (const char*)g.Bt + (size_t)cur.pn * tsB;
    S.a_ready(cur);
    if constexpr (SP2) {
        PG8_STAGE(PG8_SB(0, 0), cB, voffB); PG8_STAGE(PG8_SB(0, 1), cB + hsB, voffB); PG8_STAGE(PG8_SA(0, 0), cA, voffA); PG8_STAGE(PG8_SA(0, 1), cA + hsA, voffA);
        if (wr == 1) PG8_BAR;
        PG8_WAIT_V(2); PG8_BAR;
        PG8_STAGE(PG8_SB(1, 0), cB + kstep, voffB); PG8_STAGE(PG8_SA(1, 0), cA + kstep, voffA); PG8_STAGE(PG8_SB(1, 1), cB + hsB + kstep, voffB);
        PG8_WAIT_V(6); PG8_BAR;
    } else {
        PG8_STAGE(PG8_SB(0, 0), cB, voffB); PG8_STAGE(PG8_SA(0, 0), cA, voffA); PG8_STAGE(PG8_SB(0, 1), cB + hsB, voffB); PG8_STAGE(PG8_SA(0, 1), cA + hsA, voffA);
        if (wr == 1) PG8_BAR;
        PG8_WAIT_V(4); PG8_BAR;
        PG8_STAGE(PG8_SB(1, 0), cB + kstep, voffB); PG8_STAGE(PG8_SA(1, 0), cA + kstep, voffA); PG8_STAGE(PG8_SB(1, 1), cB + hsB + kstep, voffB);
        PG8_WAIT_V(6); PG8_BAR;
    }
    for (;;) {
        const bool has_next = S.next(ui + 1, nxt);
        const char* nA = has_next ? (const char*)g.A + (size_t)nxt.pm * tsA : cA; const char* nB = has_next ? (const char*)g.Bt + (size_t)nxt.pn * tsB : cB;
        for (int t = 0; t < nt; t += 2) {
            const bool last = (t == nt - 2);
            const char* a1 = cA + (size_t)(t + 1) * kstep;
            const char* a2 = last ? nA : cA + (size_t)(t + 2) * kstep; const char* b2 = last ? nB : cB + (size_t)(t + 2) * kstep;
            const char* a3 = a2 + kstep; const char* b3 = b2 + kstep;
            if (last && has_next) S.a_ready(nxt);
            if constexpr (SP2) {
            PG8_LDB(B0, 0, 0); PG8_LDB(B1, 0, 1); PG8_SCHED; PG8_LDA(At, 0, 0); PG8_STAGE(PG8_SA(1, 1), a1 + hsA, voffA);
            PG8_WAIT_V(8); PG8_WAIT_L(0); PG8_BAR; PG8_MMA(0, 0, At, B0); PG8_MMA(0, 1, At, B1); PG8_BAR; PG8_SCHED;
            PG8_LDA(At, 0, 1); PG8_STAGE(PG8_SB(0, 0), b2, voffB); PG8_STAGE(PG8_SB(0, 1), b2 + hsB, voffB); PG8_STAGE(PG8_SA(0, 0), a2, voffA);
            PG8_WAIT_V(8); PG8_WAIT_L(0); PG8_BAR; PG8_MMA(1, 0, At, B0); PG8_MMA(1, 1, At, B1); PG8_BAR; PG8_SCHED;
            PG8_LDB(B0, 1, 0); PG8_LDB(B1, 1, 1); PG8_SCHED; PG8_LDA(At, 1, 0); PG8_STAGE(PG8_SA(0, 1), a2 + hsA, voffA);
            PG8_WAIT_V(8); PG8_WAIT_L(0); PG8_BAR; PG8_MMA(0, 0, At, B0); PG8_MMA(0, 1, At, B1); PG8_BAR; PG8_SCHED;
            PG8_LDA(At, 1, 1); PG8_STAGE(PG8_SB(1, 0), b3, voffB); PG8_STAGE(PG8_SB(1, 1), b3 + hsB, voffB); PG8_STAGE(PG8_SA(1, 0), a3, voffA);
            PG8_WAIT_V(8); PG8_WAIT_L(0); PG8_BAR; PG8_MMA(1, 0, At, B0); PG8_MMA(1, 1, At, B1); PG8_BAR; PG8_SCHED;
            } else {
            PG8_LDB(B0, 0, 0); PG8_SCHED; PG8_LDA(At, 0, 0); PG8_STAGE(PG8_SA(1, 1), a1 + hsA, voffA);
            PG8_WAIT_L(8); PG8_BAR; PG8_WAIT_L(0); PG8_MMA(0, 0, At, B0); PG8_BAR; PG8_SCHED;
            PG8_LDB(B1, 0, 1); PG8_STAGE(PG8_SB(0, 0), b2, voffB);
            PG8_BAR; PG8_WAIT_L(0); PG8_MMA(0, 1, At, B1); PG8_BAR;
            PG8_LDA(At, 0, 1); PG8_STAGE(PG8_SA(0, 0), a2, voffA);
            PG8_BAR; PG8_WAIT_L(0); PG8_MMA(1, 0, At, B0); PG8_BAR; PG8_SCHED;
            PG8_STAGE(PG8_SB(0, 1), b2 + hsB, voffB);
            PG8_WAIT_V(6); PG8_BAR; PG8_MMA(1, 1, At, B1); PG8_BAR;
            PG8_LDB(B0, 1, 0); PG8_SCHED; PG8_LDA(At, 1, 0); PG8_STAGE(PG8_SA(0, 1), a2 + hsA, voffA);
            PG8_WAIT_L(8); PG8_BAR; PG8_WAIT_L(0); PG8_MMA(0, 0, At, B0); PG8_BAR; PG8_SCHED;
            PG8_LDB(B1, 1, 1); PG8_STAGE(PG8_SB(1, 0), b3, voffB);
            PG8_BAR; PG8_WAIT_L(0); PG8_MMA(0, 1, At, B1); PG8_BAR;
            PG8_LDA(At, 1, 1); PG8_STAGE(PG8_SA(1, 0), a3, voffA);
            PG8_BAR; PG8_WAIT_L(0); PG8_MMA(1, 0, At, B0); PG8_BAR; PG8_SCHED;
            PG8_STAGE(PG8_SB(1, 1), b3 + hsB, voffB);
            PG8_WAIT_V(6); PG8_BAR; PG8_MMA(1, 1, At, B1); PG8_BAR;
            }
        }
        if constexpr (ALIGN_EPI) { if (wr == 0) PG8_BAR; }
        if constexpr (!Epi::AFTER_DRAIN) { int fr2 = fr, fq2 = fq; asm volatile("" : "+v"(fr2), "+v"(fq2)); E(acc, cur, wr, wc, fr2, fq2); S.done(cur); }
        if (!has_next) break;
#pragma unroll
        for (int a = 0; a < 2; ++a)
#pragma unroll
            for (int b = 0; b < 2; ++b)
#pragma unroll
                for (int m = 0; m < 4; ++m)
#pragma unroll
                    for (int n = 0; n < 2; ++n) acc[a][b][m][n] = (f32x4){0.f, 0.f, 0.f, 0.f};
        cur = nxt; cA = nA; cB = nB; ++ui;
        if constexpr (ALIGN_EPI) { if (wr == 1) PG8_BAR; }
    }
    PG8_WAIT_V(0);
    if constexpr (!ALIGN_EPI) { if (wr == 0) PG8_BAR; }
    PG8_BAR;
    if constexpr (Epi::AFTER_DRAIN) { int fr2 = fr, fq2 = fq, lane2 = lane; asm volatile("" : "+v"(fr2), "+v"(fq2), "+v"(lane2)); E.fused(acc, cur, wr, wc, fr2, fq2, lds, wid, lane2); S.done(cur); }
#undef PG8_SA
#undef PG8_SB
#undef PG8_STAGE
#undef PG8_LDA
#undef PG8_LDB
#undef PG8_MMA
#undef PG8_WAIT_V
#undef PG8_WAIT_L
#undef PG8_BAR
#undef PG8_SCHED
}}

#define GAS __attribute__((address_space(1)))
#define LAS __attribute__((address_space(3)))
typedef unsigned v4u __attribute__((ext_vector_type(4)));
typedef float f32x4 __attribute__((ext_vector_type(4)));
typedef short bf16x8 __attribute__((ext_vector_type(8)));
typedef GAS unsigned gu32;
typedef GAS unsigned long long gu64;
#define RLX_AGENT __ATOMIC_RELAXED, __HIP_MEMORY_SCOPE_AGENT
#define LDS_WAIT() asm volatile("s_waitcnt lgkmcnt(0)" ::: "memory")
#define VM_WAIT() asm volatile("s_waitcnt vmcnt(0)" ::: "memory")
__device__ __forceinline__ unsigned long long rt() { return __builtin_amdgcn_s_memrealtime(); }
__device__ __forceinline__ unsigned pk2(float lo, float hi) { return (unsigned)f2bf(lo) | ((unsigned)f2bf(hi) << 16); }

#define XB_TMO      128
#define XB_XCNT(j)  (256  + 64 * (j))
#define XB_XSUB(j)  (1280 + 64 * (j))
#define XB_XGEN(j)  (2304 + 64 * (j))
#define XB_TOP      3328
#define XB_TOPGEN   3392
#define XL_SUB(j)   (3456 + 64 * (j))
#define XL_GEN(j)   (4480 + 64 * (j))
#define XCD_BAR_WORDS 5504
#define XB_SPIN_CAP (1u << 18)

__device__ __forceinline__ unsigned xb_ld(unsigned* p)              { return __hip_atomic_load(p, __ATOMIC_RELAXED, __HIP_MEMORY_SCOPE_AGENT); }
__device__ __forceinline__ unsigned xb_add(unsigned* p, unsigned v) { return __hip_atomic_fetch_add(p, v, __ATOMIC_RELAXED, __HIP_MEMORY_SCOPE_AGENT); }
__device__ __forceinline__ unsigned xb_xcc_id() { return (unsigned)__builtin_amdgcn_s_getreg((3 << 11) | 20) & 0xFu; }
#define XB_SPIN(cond, bar) do { unsigned _sp = 0; while (cond) { __builtin_amdgcn_s_sleep(1); \
    if ((++_sp & 255u) == 0u) { if (xb_ld(&(bar)[XB_TMO])) break; if (_sp > XB_SPIN_CAP) { atomicAdd(&(bar)[XB_TMO], 1u); break; } } } } while (0)

struct XcdBarrier {
    unsigned* bar; unsigned x;
    volatile LAS unsigned* st;
};

__device__ __forceinline__ XcdBarrier xcd_barrier_post(unsigned* bar, volatile LAS unsigned* st) {
    XcdBarrier b; b.bar = bar; b.x = xb_xcc_id(); b.st = st;
    if (threadIdx.x == 0) st[2] = xb_add(&bar[XB_XCNT(b.x)], 1u);
    return b;
}
__device__ __forceinline__ void xcd_barrier_complete(unsigned* bar, unsigned x, unsigned& nloc, unsigned& nx) {
    const unsigned G = gridDim.x * gridDim.y * gridDim.z;
    unsigned sum, cnt, mine, sp = 0u;
    for (;;) {
        sum = 0u; cnt = 0u; mine = 0u;
#pragma unroll
        for (unsigned j = 0; j < 16; ++j) { const unsigned c = xb_ld(&bar[XB_XCNT(j)]); sum += c; cnt += (c > 0u) ? 1u : 0u; mine = (j == x) ? c : mine; }
        if (sum == G) break;
        __builtin_amdgcn_s_sleep(1);
        if ((++sp & 255u) == 0u) { if (xb_ld(&bar[XB_TMO])) break; if (sp > XB_SPIN_CAP) { atomicAdd(&bar[XB_TMO], 1u); break; } }
    }
    nloc = mine > 0u ? mine : 1u; nx = cnt > 0u ? cnt : 1u;
}
__device__ __forceinline__ unsigned xcd_census_even(unsigned* bar) {
    unsigned ok = (gridDim.x == 256u) ? 1u : 0u;
#pragma unroll
    for (unsigned j = 0; j < 8; ++j) ok &= (xb_ld(&bar[XB_XCNT(j)]) == 32u) ? 1u : 0u;
    return ok;
}

__device__ __forceinline__ void xcd_barrier(const XcdBarrier& b) {
    asm volatile("s_waitcnt vmcnt(0)" ::: "memory");
    __syncthreads();
    if (threadIdx.x == 0) {
        unsigned* bar = b.bar;
        __builtin_amdgcn_s_waitcnt(0);
        unsigned nloc = b.st[0], nx = b.st[1];
        if (nloc == 0u) { xcd_barrier_complete(bar, b.x, nloc, nx); b.st[0] = nloc; b.st[1] = nx; b.st[3] = xcd_census_even(bar); }
        const unsigned old = xb_add(&bar[XB_XSUB(b.x)], 1u);
        const unsigned gen = old / nloc;
        if (old + 1u == (gen + 1u) * nloc) {
            __builtin_amdgcn_fence(__ATOMIC_RELEASE, "agent");
            asm volatile("s_waitcnt vmcnt(0)" ::: "memory");
            const unsigned og = xb_add(&bar[XB_TOP], 1u);
            const unsigned tg = og / nx;
            if (og + 1u == (tg + 1u) * nx) xb_add(&bar[XB_TOPGEN], 1u);
            else XB_SPIN(xb_ld(&bar[XB_TOPGEN]) == tg, bar);
            __builtin_amdgcn_fence(__ATOMIC_ACQUIRE, "agent");
            xb_add(&bar[XB_XGEN(b.x)], 1u);
            asm volatile("s_waitcnt vmcnt(0)" ::: "memory");
        } else {
            XB_SPIN(xb_ld(&bar[XB_XGEN(b.x)]) == gen, bar);
            __builtin_amdgcn_fence(__ATOMIC_ACQUIRE, "agent");
            asm volatile("s_waitcnt vmcnt(0)" ::: "memory");
        }
    }
    __syncthreads();
}

__device__ __forceinline__ void xcc_barrier(const XcdBarrier& b) {
    asm volatile("s_waitcnt vmcnt(0)" ::: "memory");
    __syncthreads();
    if (threadIdx.x == 0) {
        unsigned* bar = b.bar;
        const unsigned old = xb_add(&bar[XL_SUB(b.x)], 1u);
        const unsigned gen = old / 32u;
        if (old + 1u == (gen + 1u) * 32u) xb_add(&bar[XL_GEN(b.x)], 1u);
        else XB_SPIN(xb_ld(&bar[XL_GEN(b.x)]) == gen, bar);
        __builtin_amdgcn_fence(__ATOMIC_ACQUIRE, "agent");
        asm volatile("s_waitcnt vmcnt(0)" ::: "memory");
    }
    __syncthreads();
}

constexpr int NWAVES = 8;
constexpr int RING_OFF = 0, RING_BYTES = 131072;
constexpr int LDSCTL_OFF = 158720, MISC_OFF = LDSCTL_OFF + 320;
constexpr int LDS_RQ = LDSCTL_OFF + 1024, LDS_IL = LDSCTL_OFF + 2048;
constexpr int LDS_BYTES = 163840;
constexpr int CW_TMO = 0, CW_BAR = 4096;

struct Frame {
    LAS unsigned char* lds; volatile LAS unsigned* MISC; gu32* ctl;
    int tid, lane, wave, vcu, G;
};
struct Args { const void* in[26]; float* out; unsigned char* ws; int ph_lo, ph_hi; };

__device__ __forceinline__ float wave_sum(float v) {
#pragma unroll
    for (int o = 1; o < 64; o <<= 1) v += __shfl_xor(v, o);
    return v;
}
template <bool HEADPERM, bool WT = false> __device__ __forceinline__ void p0_transpose_item(const float* W, int ldw, int K, int N, const float* g, bf16_t* WT_, LAS float* scr, int item, int lane) {
    const int nblk = N / 32, kb = item / nblk, nb = item % nblk, k0 = 64 * kb, n0 = 32 * nb;
    const int r8 = lane >> 3, c4 = (lane & 7) * 4;
    f32x4 v[8]; float gg[8];
#pragma unroll
    for (int i = 0; i < 8; ++i) { v[i] = __builtin_nontemporal_load((const GAS f32x4*)(W + (size_t)(k0 + r8 + 8 * i) * ldw + n0 + c4)); gg[i] = g ? g[k0 + r8 + 8 * i] : 1.f; }
#pragma unroll
    for (int i = 0; i < 8; ++i) { LAS float* d = scr + (r8 + 8 * i) * 33 + c4; const f32x4 x = v[i] * gg[i]; d[0] = x.x; d[1] = x.y; d[2] = x.z; d[3] = x.w; }
    LDS_WAIT(); asm volatile("" ::: "memory");
    const int c = lane & 7;
#pragma unroll
    for (int j = 0; j < 4; ++j) { const int n = (lane >> 3) + 8 * j; const LAS float* s = scr + (8 * c) * 33 + n;
        v4u o; o.x = pk2(s[0 * 33], s[1 * 33]); o.y = pk2(s[2 * 33], s[3 * 33]); o.z = pk2(s[4 * 33], s[5 * 33]); o.w = pk2(s[6 * 33], s[7 * 33]);
        int nr = n0 + n; if (HEADPERM) { const int l = nr & 255; nr = (nr & ~255) | (((l >> 5) & 1) * 128 + (l >> 6) * 32 + (l & 31)); }
        if (WT) { const __amdgpu_buffer_rsrc_t rs_ = __builtin_amdgcn_make_buffer_rsrc((void*)WT_, (short)0, 0x7fffffff, 0x00020000); __builtin_amdgcn_raw_buffer_store_b128(o, rs_, (int)(((size_t)nr * K + k0 + 8 * c) * 2), 0, 16); }
        else *(GAS v4u*)(WT_ + (size_t)nr * K + k0 + 8 * c) = o; }
    LDS_WAIT(); asm volatile("" ::: "memory");
}
template <bool FLOG> __device__ __forceinline__ void rms_rows_to_bf16(int lane, const float* X, bf16_t* O, int m0, int step, int rows, const float* g, const float* win, float* flog, float* rs0) {
    if (m0 >= rows) return;
    f32x4 wf[4][4][2];
    if (FLOG) {
#pragma unroll
        for (int j = 0; j < 4; ++j) { const f32x4 gg = *(const GAS f32x4*)(g + 256 * j + 4 * lane);
#pragma unroll
            for (int e = 0; e < 4; ++e) { const int k = 256 * j + 4 * lane + e; wf[j][e][0] = *(const GAS f32x4*)(win + (size_t)k * INCOLS + NPROJ) * gg[e]; wf[j][e][1] = *(const GAS f32x4*)(win + (size_t)k * INCOLS + NPROJ + 4) * gg[e]; } }
    }
    f32x4 nx[4], nx2[4];
    { const GAS f32x4* xr = (const GAS f32x4*)(X + (size_t)m0 * DM) + lane;
#pragma unroll
      for (int j = 0; j < 4; ++j) nx[j] = __builtin_nontemporal_load(xr + 64 * j);
      if (m0 + step < rows) { const GAS f32x4* xr2 = (const GAS f32x4*)(X + (size_t)(m0 + step) * DM) + lane;
#pragma unroll
          for (int j = 0; j < 4; ++j) nx2[j] = __builtin_nontemporal_load(xr2 + 64 * j); } }
    for (int m = m0; m < rows; m += step) {
        f32x4 v[4];
#pragma unroll
        for (int j = 0; j < 4; ++j) { v[j] = nx[j]; nx[j] = nx2[j]; }
        if (m + 2 * step < rows) { const GAS f32x4* xr = (const GAS f32x4*)(X + (size_t)(m + 2 * step) * DM) + lane;
#pragma unroll
            for (int j = 0; j < 4; ++j) nx2[j] = __builtin_nontemporal_load(xr + 64 * j); }
        float s2 = 0.f;
#pragma unroll
        for (int j = 0; j < 4; ++j) s2 += (v[j].x * v[j].x + v[j].y * v[j].y) + (v[j].z * v[j].z + v[j].w * v[j].w);
        const float ms_ = wave_sum(s2) * (1.f / DM) + EPS; const float rstd = rsqrtf(ms_);
        if (FLOG) { if (lane == 0) rs0[m] = sqrtf(ms_); }
        GAS unsigned long long* o8 = (GAS unsigned long long*)(O + (size_t)m * DM) + lane;
#pragma unroll
        for (int j = 0; j < 4; ++j) { v[j] = v[j] * rstd; o8[64 * j] = (unsigned long long)pk2(v[j].x, v[j].y) | ((unsigned long long)pk2(v[j].z, v[j].w) << 32); }
        if (FLOG) {
            f32x4 a0 = {0.f, 0.f, 0.f, 0.f}, a1 = {0.f, 0.f, 0.f, 0.f};
#pragma unroll
            for (int j = 0; j < 4; ++j)
#pragma unroll
                for (int e = 0; e < 4; ++e) { a0 += wf[j][e][0] * v[j][e]; a1 += wf[j][e][1] * v[j][e]; }
            { const bool b0 = lane & 1, b1 = lane & 2, b2 = lane & 4;
              const f32x4 snd = b0 ? a0 : a1, kp = b0 ? a1 : a0; f32x4 rc;
#pragma unroll
              for (int e = 0; e < 4; ++e) rc[e] = __shfl_xor(snd[e], 1);
              const f32x4 w4 = kp + rc;
              const float s0 = b1 ? w4[0] : w4[2], s1 = b1 ? w4[1] : w4[3], k0 = b1 ? w4[2] : w4[0], k1 = b1 ? w4[3] : w4[1];
              const float w20 = k0 + __shfl_xor(s0, 2), w21 = k1 + __shfl_xor(s1, 2);
              float w1 = (b2 ? w21 : w20) + __shfl_xor(b2 ? w20 : w21, 4);
              w1 += __shfl_xor(w1, 8); w1 += __shfl_xor(w1, 16); w1 += __shfl_xor(w1, 32);
              if (lane < 8) flog[(size_t)m * 8 + 4 * (lane & 1) + (lane & 2) + ((lane >> 2) & 1)] = w1; }
        }
    }
}
__constant__ float INV_FREQ[8] = {1.0f, 0.1939227432012558f, 0.03760603070259094f, 0.007292664609849453f, 0.0014142135623842478f, 0.00027424818836152554f, 5.318296098266728e-05f, 1.0313386155758053e-05f};

struct Ptrs {
    const float *x, *mem; const int* pos; const float *norm_mix_w, *w_in, *b_forget, *dqw, *dkw, *lq1, *lk1, *lq2, *lk2, *subw, *fqw, *fkw, *w_out, *nmq, *nmkv, *w_mq, *w_mkv, *mqw, *mkw, *w_mo, *nmlp, *w_up, *w_dn;
    float* out; float *FLOG, *CUMB, *ROPE, *SS, *QKW, *RS0;
    bf16_t *WIN, *WOUT, *WQ, *WKV, *WO, *WUP, *WDN, *XB, *HM, *MK, *VT, *MKN, *PROJ, *ATT, *MQ, *MO, *H;
};
__host__ __device__ __forceinline__ Ptrs make_ptrs(const void* const* in, float* out, unsigned char* ws) {
    Ptrs p;
    p.x = (const float*)in[0]; p.mem = (const float*)in[1]; p.pos = (const int*)in[2]; p.norm_mix_w = (const float*)in[3]; p.w_in = (const float*)in[4]; p.b_forget = (const float*)in[5];
    p.dqw = (const float*)in[6]; p.dkw = (const float*)in[7]; p.lq1 = (const float*)in[8]; p.lk1 = (const float*)in[9]; p.lq2 = (const float*)in[10]; p.lk2 = (const float*)in[11];
    p.subw = (const float*)in[12]; p.fqw = (const float*)in[13]; p.fkw = (const float*)in[14]; p.w_out = (const float*)in[15]; p.nmq = (const float*)in[16]; p.nmkv = (const float*)in[17];
    p.w_mq = (const float*)in[18]; p.w_mkv = (const float*)in[19]; p.mqw = (const float*)in[20]; p.mkw = (const float*)in[21]; p.w_mo = (const float*)in[22]; p.nmlp = (const float*)in[23];
    p.w_up = (const float*)in[24]; p.w_dn = (const float*)in[25]; p.out = out;
    p.FLOG = (float*)(ws + WS_FLOG); p.CUMB = (float*)(ws + WS_CUMB); p.ROPE = (float*)(ws + WS_ROPE); p.SS = (float*)(ws + WS_SS); p.QKW = (float*)(ws + WS_QKW); p.RS0 = (float*)(ws + WS_RS0);
    p.WIN = (bf16_t*)(ws + WS_WIN); p.WOUT = (bf16_t*)(ws + WS_WOUT); p.WQ = (bf16_t*)(ws + WS_WQ); p.WKV = (bf16_t*)(ws + WS_WKV); p.WO = (bf16_t*)(ws + WS_WO); p.WUP = (bf16_t*)(ws + WS_WUP); p.WDN = (bf16_t*)(ws + WS_WDN);
    p.XB = (bf16_t*)(ws + WS_XB); p.HM = (bf16_t*)(ws + WS_HM); p.MK = (bf16_t*)(ws + WS_MK); p.VT = (bf16_t*)(ws + WS_VT); p.MKN = (bf16_t*)(ws + WS_MKN);
    p.PROJ = (bf16_t*)(ws + WS_PROJ); p.ATT = (bf16_t*)(ws + WS_ATT); p.MQ = (bf16_t*)(ws + WS_MQ); p.MO = (bf16_t*)(ws + WS_MO); p.H = (bf16_t*)(ws + WS_H);
    return p;
}

__device__ __forceinline__ void p0_prologue(Frame& F, const Ptrs& P) {
    LAS float* scr = (LAS float*)(F.lds + RING_OFF + F.wave * 16384);
    const int gw = F.vcu * NWAVES + F.wave, NGW = F.G * NWAVES;
    constexpr int I_IN = 16 * 96, I_KV = 16 * 64, I_OUT = 16 * 32;
    constexpr int NITEMS = I_IN + I_KV + I_OUT;
    for (int it = gw; it < NITEMS; it += NGW) {
        if (it < I_IN) p0_transpose_item<true>(P.w_in, INCOLS, DM, NPROJ, P.norm_mix_w, P.WIN, scr, it, F.lane);
        else if (it < I_IN + I_KV) p0_transpose_item<false>(P.w_mkv, 2048, DM, 2048, P.nmkv, P.WKV, scr, it - I_IN, F.lane);
        else p0_transpose_item<false>(P.w_out, DM, DM, DM, nullptr, P.WOUT, scr, it - I_IN - I_KV, F.lane);
    }
    rms_rows_to_bf16<true>(F.lane, P.x, P.XB, gw, NGW, MTOK, P.norm_mix_w, P.w_in, P.FLOG, P.RS0);
    rms_rows_to_bf16<false>(F.lane, P.mem, P.HM, gw, NGW, MMEM, nullptr, nullptr, nullptr, nullptr);
    if (blockIdx.x == 0 && F.tid < 64) { const int t = F.tid; P.QKW[t] = P.dqw[t]; P.QKW[64 + t] = P.dkw[t]; P.QKW[128 + t] = P.fqw[t]; P.QKW[192 + t] = P.fkw[t]; }
    for (int id = (F.vcu * NWAVES * 64) + F.tid; id < MTOK * 8; id += F.G * NWAVES * 64) {
        const int row = id >> 3, i = id & 7;
        const float ang = (float)P.pos[row] * INV_FREQ[i];
        const double a = (double)ang; const double k = rint(a * 0.15915494309189535); const float r = (float)fma(-k, 6.283185307179586, a);
        P.ROPE[(size_t)row * 16 + i] = cosf(r); P.ROPE[(size_t)row * 16 + 8 + i] = sinf(r);
    }
}
__device__ __forceinline__ void p1b_row(bf16_t* PROJ, const float* dqw, const float* dkw, const float* fqw, const float* fkw, const float* ROPE, int row, int lane) {
    const int sg = lane >> 1, hf = lane & 1;
    const int col = (sg < 16 ? sg * 64 : 1536 + (sg - 16) * 64) + hf * 32;
    const float* w = (sg < 8 ? dqw : sg < 16 ? dkw : sg < 24 ? fqw : fkw) + hf * 32;
    const bool rope = (sg < 16) && (hf == 0), isq = (sg < 8) || (sg >= 16 && sg < 24);
    GAS v4u* p = (GAS v4u*)(PROJ + (size_t)row * NPROJ + col);
    const v4u u0 = p[0], u1 = p[1], u2 = p[2], u3 = p[3];
#define UNP_LO(u) (f32x4){__uint_as_float(u.x << 16), __uint_as_float(u.x & 0xffff0000u), __uint_as_float(u.y << 16), __uint_as_float(u.y & 0xffff0000u)}
#define UNP_HI(u) (f32x4){__uint_as_float(u.z << 16), __uint_as_float(u.z & 0xffff0000u), __uint_as_float(u.w << 16), __uint_as_float(u.w & 0xffff0000u)}
    f32x4 v0 = UNP_LO(u0), v1 = UNP_HI(u0), v2 = UNP_LO(u1), v3 = UNP_HI(u1), v4 = UNP_LO(u2), v5 = UNP_HI(u2), v6 = UNP_LO(u3), v7 = UNP_HI(u3);
#undef UNP_LO
#undef UNP_HI
#define SQ4(v) ((v.x * v.x + v.y * v.y) + (v.z * v.z + v.w * v.w))
    float ss = (SQ4(v0) + SQ4(v1)) + (SQ4(v2) + SQ4(v3)) + (SQ4(v4) + SQ4(v5)) + (SQ4(v6) + SQ4(v7));
#undef SQ4
    ss += __shfl_xor(ss, 1);
    const float rstd = rsqrtf(ss * (1.f / 64.f) + EPS);
    const GAS f32x4* wg = (const GAS f32x4*)w;
    v0 = v0 * rstd * wg[0]; v1 = v1 * rstd * wg[1]; v2 = v2 * rstd * wg[2]; v3 = v3 * rstd * wg[3]; v4 = v4 * rstd * wg[4]; v5 = v5 * rstd * wg[5]; v6 = v6 * rstd * wg[6]; v7 = v7 * rstd * wg[7];
    if (rope) {
        const GAS f32x4* rt = (const GAS f32x4*)(ROPE + (size_t)row * 16);
        const f32x4 c0 = rt[0], c1 = rt[1], s0 = rt[2], s1 = rt[3];
        const f32x4 a0 = v0 * c0 - v2 * s0, b0 = v2 * c0 + v0 * s0, a1 = v1 * c1 - v3 * s1, b1 = v3 * c1 + v1 * s1;
        v0 = a0; v2 = b0; v1 = a1; v3 = b1;
    }
    const float sc = isq ? C2 : 1.f;
#define PK4(a, b) (v4u){pk2(a.x * sc, a.y * sc), pk2(a.z * sc, a.w * sc), pk2(b.x * sc, b.y * sc), pk2(b.z * sc, b.w * sc)}
    p[0] = PK4(v0, v1); p[1] = PK4(v2, v3); p[2] = PK4(v4, v5); p[3] = PK4(v6, v7);
#undef PK4
}
__device__ __forceinline__ void p1b_cumsum_wg(const float* FLOG, const float* b_forget, float* CUMB, int seq, int tid, LAS float* scr) {
    const int b = seq >> 3, h = seq & 7, lane = tid & 63, wv = tid >> 6; const float bf = b_forget[h];
    float lf[4]; float run = 0.f;
#pragma unroll
    for (int i = 0; i < 4; ++i) { const float z = FLOG[(size_t)(b * SEQ + tid * 4 + i) * 8 + h] + bf; const float e = __expf(-fabsf(z)); lf[i] = fminf(z, 0.f) - log1pf(e); run += lf[i]; }
    float inc = run;
#pragma unroll
    for (int o = 1; o < 64; o <<= 1) { const float t = __shfl_up(inc, o); if (lane >= o) inc += t; }
    if (lane == 63) scr[wv] = inc;
    __syncthreads();
    float base = 0.f;
#pragma unroll
    for (int w = 0; w < 8; ++w) { const float t = scr[w]; if (w < wv) base += t; }
    float c = base + inc - run;
    f32x4 o;
#pragma unroll
    for (int i = 0; i < 4; ++i) { c += lf[i]; o[i] = -c * LOG2E; }
    *(GAS f32x4*)(CUMB + (size_t)seq * SEQ + tid * 4) = o;
    __syncthreads();
}
__device__ __forceinline__ void p1b_cumsum(const Ptrs& P, int seq, int lane) {
    const int b = seq >> 3, h = seq & 7; const float bf = P.b_forget[h];
    float lf[32]; float run = 0.f;
#pragma unroll
    for (int i = 0; i < 32; ++i) { const float z = P.FLOG[(size_t)(b * SEQ + lane * 32 + i) * 8 + h] + bf;
        const float e = __expf(-fabsf(z)); lf[i] = fminf(z, 0.f) - log1pf(e); run += lf[i]; }
    float inc = run;
#pragma unroll
    for (int o = 1; o < 64; o <<= 1) { const float t = __shfl_up(inc, o); if (lane >= o) inc += t; }
    float c = inc - run;
#pragma unroll
    for (int i = 0; i < 32; ++i) { c += lf[i]; P.CUMB[(size_t)seq * SEQ + lane * 32 + i] = -c * LOG2E; }
}
#ifndef PROBE_K
#define PROBE_K -1
#endif
struct Sched {
    pg8::StaticOrder so; int mode, pm, pn; bool has;
    __device__ __forceinline__ bool next(int i, pg8::Unit& u) const { if (mode == 0) return so.next(i, u); if (i != 0 || !has) return false; u.pm = pm; u.pn = pn; return true; }
    __device__ __forceinline__ void a_ready(const pg8::Unit&) const {}
    __device__ __forceinline__ void done(const pg8::Unit&) const {}
};
__device__ __forceinline__ Sched sched_static(int M, int N, int G, int c) { Sched s; s.so.init(M, N, G, c); s.mode = 0; s.pm = 0; s.pn = 0; s.has = true; return s; }
__device__ __forceinline__ Sched sched_one(int pm, int pn, bool has) { Sched s; s.so.init(256, 256, 1, 0); s.mode = 1; s.pm = pm; s.pn = pn; s.has = has; return s; }

#include <hip/hip_bf16.h>
#include <cmath>
namespace ab {
using bf16=__hip_bfloat16;
using bf16x8=__attribute__((ext_vector_type(8)))short;
using s16x4=__attribute__((ext_vector_type(4)))short;
using f32x16=__attribute__((ext_vector_type(16)))float;
using u32x4=__attribute__((ext_vector_type(4)))unsigned;
using f32x4v=__attribute__((ext_vector_type(4)))float;
constexpr int D=64,PIN=NPROJ;
constexpr int NW=8,QBLK=32,QB=QBLK*NW,KVBLK=64;
__device__ __forceinline__ int crow(int r,int hi){return (r&3)+8*(r>>2)+4*hi;}
#define SBAR() __builtin_amdgcn_sched_barrier(0)
__device__ __forceinline__ void cmask(f32x16&p0,f32x16&p1,int jb,int qrel,int hi){
  const float NEG=-INFINITY; int kb=64*jb+4*hi;
  #pragma unroll
  for(int r=0;r<16;++r){int kv=kb+(r&3)+8*(r>>2); if(kv>qrel)p0[r]=NEG; if(kv+32>qrel)p1[r]=NEG;}
}

__device__ __forceinline__ void kmask(f32x16&p0,f32x16&p1,int jb,int wid){
  if(jb>(wid>>1)){const float NEG=-INFINITY;
  #pragma unroll
  for(int r=0;r<16;++r){p0[r]=NEG;p1[r]=NEG;}}
}

constexpr int NSLOT=4, SLOTB=8192;
constexpr int LDS_K=0, LDS_V=NSLOT*SLOTB, LDS_WS=2*NSLOT*SLOTB, LDS_OST=LDS_WS+NW*64*4, LDS_BIAS=LDS_OST+NW*4096, LDS_BYTES=LDS_BIAS+32768;
__device__ __forceinline__ void glds16(const void*gsrc,unsigned lds_dst){unsigned keep;
  asm volatile("s_mov_b32 %0, m0\n\ts_mov_b32 m0, %2\n\ts_nop 0\n\tglobal_load_lds_dwordx4 %1, off\n\ts_mov_b32 m0, %0":"=&s"(keep):"v"(gsrc),"s"(lds_dst):"memory");}
__device__ __forceinline__ float max3f(float a,float b,float c){float r;asm("v_max3_f32 %0, %1, %2, %3":"=v"(r):"v"(a),"v"(b),"v"(c));return r;}
__device__ __forceinline__ float max2f(float a,float b){float r;asm("v_max_f32_e32 %0, %1, %2":"=v"(r):"v"(a),"v"(b));return r;}
__device__ __forceinline__ float fadd_s(float a,float b){float r;asm("v_add_f32_e32 %0, %1, %2":"=v"(r):"v"(a),"v"(b));return r;}
__device__ __forceinline__ float fsub_s(float a,float b){float r;asm("v_sub_f32_e32 %0, %1, %2":"=v"(r):"v"(a),"v"(b));return r;}
__device__ __forceinline__ float fmul_s(float a,float b){float r;asm("v_mul_f32_e32 %0, %1, %2":"=v"(r):"v"(a),"v"(b));return r;}
typedef float f32x2_t __attribute__((ext_vector_type(2))); typedef __bf16 bf16x2_t __attribute__((ext_vector_type(2)));
__device__ __forceinline__ unsigned cvtpk_s(float lo,float hi){f32x2_t v={lo,hi};bf16x2_t b=__builtin_convertvector(v,bf16x2_t);return __builtin_bit_cast(unsigned,b);}
#define WAIT_BAR(N) asm volatile("s_waitcnt vmcnt(" #N ") lgkmcnt(0)\n\ts_barrier":::"memory")

__device__ __forceinline__ void qkt(f32x16&p0,f32x16&p1,const char*Kslot,const bf16x8*qr,const f32x16&negm,int r32,int hi){
  const char*kb=Kslot+hi*1024+r32*16;
  #pragma unroll
  for(int d0=0;d0<4;++d0){
    const bf16x8 b0=*reinterpret_cast<const bf16x8*>(kb+d0*2048);
    const bf16x8 b1=*reinterpret_cast<const bf16x8*>(kb+d0*2048+512);
    if(d0==0){p0=__builtin_amdgcn_mfma_f32_32x32x16_bf16(b0,qr[0],negm,0,0,0);p1=__builtin_amdgcn_mfma_f32_32x32x16_bf16(b1,qr[0],negm,0,0,0);}
    else{p0=__builtin_amdgcn_mfma_f32_32x32x16_bf16(b0,qr[d0],p0,0,0,0);p1=__builtin_amdgcn_mfma_f32_32x32x16_bf16(b1,qr[d0],p1,0,0,0);}}
}
typedef __attribute__((address_space(3))) const char* lds_cptr;
typedef short v4i16_t __attribute__((ext_vector_type(4)));
__device__ __forceinline__ void kload8(bf16x8*kf,lds_cptr kp){
  kf[0]=*(const __attribute__((address_space(3))) bf16x8*)(kp);      kf[1]=*(const __attribute__((address_space(3))) bf16x8*)(kp+512);
  kf[2]=*(const __attribute__((address_space(3))) bf16x8*)(kp+2048); kf[3]=*(const __attribute__((address_space(3))) bf16x8*)(kp+2560);
  kf[4]=*(const __attribute__((address_space(3))) bf16x8*)(kp+4096); kf[5]=*(const __attribute__((address_space(3))) bf16x8*)(kp+4608);
  kf[6]=*(const __attribute__((address_space(3))) bf16x8*)(kp+6144); kf[7]=*(const __attribute__((address_space(3))) bf16x8*)(kp+6656);
}
__device__ __forceinline__ void kload2(bf16x8*kf,lds_cptr kp,int j){ kf[2*j]=*(const __attribute__((address_space(3))) bf16x8*)(kp+j*2048); kf[2*j+1]=*(const __attribute__((address_space(3))) bf16x8*)(kp+j*2048+512); }
__device__ __forceinline__ s16x4 vtr(lds_cptr p){ return __builtin_bit_cast(s16x4,__builtin_amdgcn_ds_read_tr16_b64_v4i16((__attribute__((address_space(3))) v4i16_t*)p)); }
__device__ __forceinline__ float rowmax(const f32x16&p0,const f32x16&p1){
  float a=max3f(p0[0],p0[1],p1[0]),b=max3f(p0[2],p0[3],p1[1]);a=max3f(a,p1[2],p1[3]);
  #pragma unroll
  for(int r=4;r<16;r+=4){a=max3f(a,p0[r],p0[r+1]);b=max3f(b,p0[r+2],p0[r+3]);a=max3f(a,p1[r],p1[r+1]);b=max3f(b,p1[r+2],p1[r+3]);}
  const float m=max2f(a,b);
  auto rr=__builtin_amdgcn_permlane32_swap(__float_as_uint(m),__float_as_uint(m),false,false);
  return max2f(__uint_as_float(rr[0]),__uint_as_float(rr[1]));
}
__device__ __forceinline__ void pv(f32x16*o,int vb,bf16x8 pa0,bf16x8 pa1,bf16x8 pa2,bf16x8 pa3){
  #pragma unroll
  for(int d0=0;d0<2;++d0){s16x4 lo[4],hi[4];
    #pragma unroll
    for(int ks=0;ks<4;++ks){
      asm volatile("ds_read_b64_tr_b16 %0,%1 offset:%c2":"=&v"(lo[ks]):"v"(vb),"i"(d0*4096+ks*1024):"memory");
      asm volatile("ds_read_b64_tr_b16 %0,%1 offset:%c2":"=&v"(hi[ks]):"v"(vb),"i"(d0*4096+ks*1024+512):"memory");}
    asm volatile("s_waitcnt lgkmcnt(0)":::"memory");SBAR();
    #define PK(k) (bf16x8){lo[k][0],lo[k][1],lo[k][2],lo[k][3],hi[k][0],hi[k][1],hi[k][2],hi[k][3]}
    o[d0]=__builtin_amdgcn_mfma_f32_32x32x16_bf16(pa0,PK(0),o[d0],0,0,0);
    o[d0]=__builtin_amdgcn_mfma_f32_32x32x16_bf16(pa1,PK(1),o[d0],0,0,0);
    o[d0]=__builtin_amdgcn_mfma_f32_32x32x16_bf16(pa2,PK(2),o[d0],0,0,0);
    o[d0]=__builtin_amdgcn_mfma_f32_32x32x16_bf16(pa3,PK(3),o[d0],0,0,0);
    #undef PK
  }
}

#ifndef ATTN_STORE16
#define ATTN_STORE16(p,v) (*(u32x4*)(p)=(v))
#endif
__device__ __forceinline__ void split3(float x,float&h,float&m,float&l){
  h=__uint_as_float(cvtpk_s(x,0.f)<<16); const float r1=x-h; m=__uint_as_float(cvtpk_s(r1,0.f)<<16); const float r2=r1-m; l=__uint_as_float(cvtpk_s(r2,0.f)<<16);
}
template<int THRL,int MASK,bool BIAS,bool WT> __device__ __forceinline__ void attn_unit(int qb,const bf16*Qh,const bf16*__restrict__ Kh,const bf16*__restrict__ Vh,bf16*Oh,int opitch,const float*__restrict__ biasg,char*shm){
  int tid_=threadIdx.x; asm volatile("":"+v"(tid_));
  const int tid=tid_,lane=tid&63,r32=lane&31,hi=lane>>5; const int wid=__builtin_amdgcn_readfirstlane(tid>>6);
  const int q0=qb*QB;
  const bf16*Qw=Qh+(long)(q0+wid*QBLK)*PIN;
  const unsigned lds0=(unsigned)(uintptr_t)shm;
  float*wsf=(float*)(shm+LDS_WS)+wid*64;
  const bf16*ksrc=Kh+(long)lane*PIN+wid*8;
  const bf16*vsrc=Vh+(long)(16*(wid&3)+(lane>>2))*PIN+(wid>>2)*32+(lane&3)*8;
  const unsigned kdst=lds0+LDS_K+wid*1024, vdst=lds0+LDS_V+wid*1024;
  #define DMA_K(t,slot) glds16(ksrc+(long)(t)*KVBLK*PIN,(unsigned)__builtin_amdgcn_readfirstlane(kdst+(slot)))
  #define DMA_V(t,slot) glds16(vsrc+(long)(t)*KVBLK*PIN,(unsigned)__builtin_amdgcn_readfirstlane(vdst+(slot)))
  const int vb0=(int)(lds0+LDS_V)+((lane>>4)&1)*32+(lane&3)*8+(4*hi+((lane&15)>>2))*64;
  const char*Kbase=shm+LDS_K; bf16x8 kf[8];
  const lds_cptr shm3=(lds_cptr)shm; const lds_cptr kp0=shm3+LDS_K+hi*1024+r32*16; const lds_cptr vp0=shm3+LDS_V+((lane>>4)&1)*32+(lane&3)*8+(4*hi+((lane&15)>>2))*64;
  const int NT=(q0+QB)/KVBLK;
  DMA_K(0,0);DMA_V(0,0);DMA_K(1,SLOTB);
  if(BIAS){ int t2=tid; asm volatile("":"+v"(t2)); if(t2<NT*16){ const f32x4v bv=*reinterpret_cast<const f32x4v*>(biasg+t2*4);
      _Pragma("unroll") for(int e_=0;e_<4;++e_){ float h_,m_,l_; split3(bv[e_],h_,m_,l_); u32x4 w_; w_.x=cvtpk_s(h_,m_); w_.y=cvtpk_s(l_,1.f); w_.z=0x3F803F80u; w_.w=0u; *reinterpret_cast<u32x4*>(shm+LDS_BIAS+(t2*4+e_)*16)=w_; } } }
  u32x4 mfr; mfr.x=hi?0u:0x3F803F80u; mfr.y=hi?0u:0x00003F80u; mfr.z=0u; mfr.w=0u;
  #define MFR_UPDATE() do{ if(BIAS){ float h_,m_,l_; split3(-mhat,h_,m_,l_); const unsigned y_=cvtpk_s(1.f,h_), z_=cvtpk_s(m_,l_); mfr.y=hi?0u:y_; mfr.z=hi?0u:z_; } }while(0)
  #define MFRB __builtin_bit_cast(bf16x8,mfr)
  const lds_cptr bt0=(lds_cptr)shm+LDS_BIAS+r32*16;
  bf16x8 qr[4];
  #pragma unroll
  for(int d0=0;d0<4;++d0)qr[d0]=*reinterpret_cast<const bf16x8*>(&Qw[(long)r32*PIN+d0*16+hi*8]);
  constexpr bool NOMAX=THRL<0;
  float mhat=0.f,l_reg=0.f;f32x16 o[2];o[0]=f32x16{};o[1]=f32x16{};f32x16 negm=f32x16{}; if(!BIAS){asm volatile("":"+v"(negm));}
  if(NOMAX&&BIAS){ mhat=biasg[q0+wid*QBLK+r32]; }
  #define CIN (BIAS?f32x16{}:negm)
  const int qrel=wid*QBLK+r32;
  #define CMASK(P0,P1,t) do{int jb_=(t)-(NT-4); if(jb_>=0){ if(MASK==0)cmask(P0,P1,jb_,qrel,hi); else kmask(P0,P1,jb_,wid); } }while(0)
  bool resc=false;
  #define START(P0,P1) do{ if(!NOMAX){ const float rm=rowmax(P0,P1); resc=false; \
    { const float dl=rm; mhat=fadd_s(mhat,dl); \
      _Pragma("unroll") for(int r=0;r<16;++r){P0[r]=fsub_s(P0[r],dl);P1[r]=fsub_s(P1[r],dl);} \
      if(!BIAS){ _Pragma("unroll") for(int r=0;r<16;++r)negm[r]=-mhat; asm volatile("":"+v"(negm)); } MFR_UPDATE(); } } \
    _Pragma("unroll") for(int r=0;r<16;++r)P0[r]=__builtin_amdgcn_exp2f(P0[r]); }while(0)
  #define RESC() do{ if(!NOMAX&&resc){ asm volatile("s_waitcnt lgkmcnt(0)":::"memory"); \
      _Pragma("unroll") for(int d_=0;d_<2;++d_) _Pragma("unroll") for(int r=0;r<16;++r)o[d_][r]=fmul_s(o[d_][r],wsf[crow(r,hi)]); } }while(0)
  f32x16 pA0,pA1,pB0,pB1;
  #define KS(t) ((((t))&3)*SLOTB)
  #define ROT() do{}while(0)
  DMA_K(2,2*SLOTB);DMA_V(1,SLOTB);DMA_K(3,3*SLOTB);
  WAIT_BAR(5);
  if(NOMAX){ MFR_UPDATE(); }
  qkt(pA0,pA1,Kbase,qr,CIN,r32,hi);
  if(BIAS){ const bf16x8 b0_=*(const __attribute__((address_space(3))) bf16x8*)(bt0), b1_=*(const __attribute__((address_space(3))) bf16x8*)(bt0+512);
    pA0=__builtin_amdgcn_mfma_f32_32x32x16_bf16(b0_,MFRB,pA0,0,0,0); pA1=__builtin_amdgcn_mfma_f32_32x32x16_bf16(b1_,MFRB,pA1,0,0,0); }
  asm volatile("s_nop 15\n\ts_nop 7":"+v"(pA0),"+v"(pA1));CMASK(pA0,pA1,0);
  START(pA0,pA1);
  _Pragma("unroll") for(int r=0;r<16;++r)pA1[r]=__builtin_amdgcn_exp2f(pA1[r]);
  WAIT_BAR(3);
  DMA_K(4,KS(4));DMA_V(2,KS(2));
  kload8(kf,kp0+KS(1));
  WAIT_BAR(4);
  s16x4 vlo[8],vhi[8]; u32x4 pw0,pw1,pw2,pw3;
  #define PKW(P,B) cvtpk_s(P[B],P[B+1])
  #define PAF(k) __builtin_bit_cast(bf16x8,pw##k)
  #define VFR(i) (bf16x8){vlo[i][0],vlo[i][1],vlo[i][2],vlo[i][3],vhi[i][0],vhi[i][1],vhi[i][2],vhi[i][3]}
  #define PIN(x) asm volatile("":"+v"(x))
  #define MX3(a,b,c) __builtin_fmaxf(__builtin_fmaxf((a),(b)),(c))
  #define GAPA(MF,A0,A1,A2,A3,W0,W1,PW) do{ MF; sacc+=A0; sacc+=A1; sacc+=A2; sacc+=A3; PIN(sacc); W0; W1; PIN(PW); SBAR(); }while(0)
  #define EX(v) __builtin_amdgcn_exp2f(v)
  #define GAPB(MF,X,B) do{ MF; X[B]=EX(X[B]); X[B+1]=EX(X[B+1]); X[B+2]=EX(X[B+2]); X[B+3]=EX(X[B+3]); PIN(X); SBAR(); }while(0)
  #define VRD(i) do{ vlo[i]=vtr(vp_+(((i)>>2)*4096+((i)&3)*1024)); vhi[i]=vtr(vp_+(((i)>>2)*4096+((i)&3)*1024+512)); }while(0)
  #define KRD(G,j) do{ if(G){ kload2(kf,kn_,j); SBAR(); } }while(0)
  #define STEP(C0,C1,P0,P1,t,GK,GV,GL) do{ SBAR(); \
    const lds_cptr vp_=vp0+KS((t)-1); const lds_cptr kn_=kp0+KS((t)+1); \
    bf16x8 bb0_,bb1_; if(BIAS){ bb0_=*(const __attribute__((address_space(3))) bf16x8*)(bt0+(t)*1024); bb1_=*(const __attribute__((address_space(3))) bf16x8*)(bt0+(t)*1024+512); } \
    VRD(0); SBAR(); float sacc=(P0[0]+P0[1]); \
    GAPA(C0=__builtin_amdgcn_mfma_f32_32x32x16_bf16(kf[0],qr[0],CIN,0,0,0), P0[2],P0[3],P0[4],P0[5],     pw0[0]=PKW(P0,0), pw0[1]=PKW(P0,2), pw0); \
    VRD(4); SBAR(); GAPA(C1=__builtin_amdgcn_mfma_f32_32x32x16_bf16(kf[1],qr[0],CIN,0,0,0), P0[6],P0[7],P0[8],P0[9],     pw0[2]=PKW(P0,4), pw0[3]=PKW(P0,6), pw0); \
    VRD(1); SBAR(); GAPA(C0=__builtin_amdgcn_mfma_f32_32x32x16_bf16(kf[2],qr[1],C0,0,0,0),   P0[10],P0[11],P0[12],P0[13], pw1[0]=PKW(P0,8), pw1[1]=PKW(P0,10), pw1); \
    VRD(5); SBAR(); GAPA(C1=__builtin_amdgcn_mfma_f32_32x32x16_bf16(kf[3],qr[1],C1,0,0,0),   P0[14],P0[15],P1[0],P1[1],   pw1[2]=PKW(P0,12),pw1[3]=PKW(P0,14), pw1); \
    VRD(2); SBAR(); GAPA(C0=__builtin_amdgcn_mfma_f32_32x32x16_bf16(kf[4],qr[2],C0,0,0,0),   P1[2],P1[3],P1[4],P1[5],     pw2[0]=PKW(P1,0), pw2[1]=PKW(P1,2), pw2); \
    VRD(6); SBAR(); GAPA(C1=__builtin_amdgcn_mfma_f32_32x32x16_bf16(kf[5],qr[2],C1,0,0,0),   P1[6],P1[7],P1[8],P1[9],     pw2[2]=PKW(P1,4), pw2[3]=PKW(P1,6), pw2); \
    VRD(3); SBAR(); GAPA(C0=__builtin_amdgcn_mfma_f32_32x32x16_bf16(kf[6],qr[3],C0,0,0,0),   P1[10],P1[11],P1[12],P1[13], pw3[0]=PKW(P1,8), pw3[1]=PKW(P1,10), pw3); \
    VRD(7); SBAR(); GAPA(C1=__builtin_amdgcn_mfma_f32_32x32x16_bf16(kf[7],qr[3],C1,0,0,0),   P1[14],P1[15],0.f,0.f,       pw3[2]=PKW(P1,12),pw3[3]=PKW(P1,14), pw3); \
    if(BIAS){ C0=__builtin_amdgcn_mfma_f32_32x32x16_bf16(bb0_,MFRB,C0,0,0,0); C1=__builtin_amdgcn_mfma_f32_32x32x16_bf16(bb1_,MFRB,C1,0,0,0); SBAR(); } \
    l_reg+=sacc; \
    if(GK){DMA_K((t)+4,KS((t)+4));} if(GV){DMA_V((t)+2,KS((t)+2));} \
    CMASK(C0,C1,t); \
    if(!NOMAX){ float a=MX3(C0[0],C0[1],C1[0]),b=MX3(C0[2],C0[3],C1[1]); a=MX3(a,C1[2],C1[3]); \
      _Pragma("unroll") for(int r=4;r<16;r+=4){a=MX3(a,C0[r],C0[r+1]);b=MX3(b,C0[r+2],C0[r+3]);a=MX3(a,C1[r],C1[r+1]);b=MX3(b,C1[r+2],C1[r+3]);} \
      float rm=__builtin_fmaxf(a,b); { auto rr=__builtin_amdgcn_permlane32_swap(__float_as_uint(rm),__float_as_uint(rm),false,false); rm=__builtin_fmaxf(__uint_as_float(rr[0]),__uint_as_float(rr[1])); } \
      resc=false; \
      if(__builtin_expect(__any(rm>(float)THRL),0)){ const float dl=__builtin_fmaxf(rm,0.f); mhat+=dl; \
        _Pragma("unroll") for(int r=0;r<16;++r){C0[r]-=dl;C1[r]-=dl;} \
        if(!BIAS){ _Pragma("unroll") for(int r=0;r<16;++r)negm[r]=-mhat; asm volatile("":"+v"(negm)); } MFR_UPDATE(); \
        const float f=__builtin_amdgcn_exp2f(-dl); l_reg*=f; if(hi==0)wsf[r32]=f; resc=true; } } \
    SBAR(); \
    GAPB(o[0]=__builtin_amdgcn_mfma_f32_32x32x16_bf16(PAF(0),VFR(0),o[0],0,0,0), C0,0); \
    GAPB(o[1]=__builtin_amdgcn_mfma_f32_32x32x16_bf16(PAF(0),VFR(4),o[1],0,0,0), C0,4); \
    KRD(GL,0); GAPB(o[0]=__builtin_amdgcn_mfma_f32_32x32x16_bf16(PAF(1),VFR(1),o[0],0,0,0), C0,8); \
    KRD(GL,1); GAPB(o[1]=__builtin_amdgcn_mfma_f32_32x32x16_bf16(PAF(1),VFR(5),o[1],0,0,0), C0,12); \
    KRD(GL,2); GAPB(o[0]=__builtin_amdgcn_mfma_f32_32x32x16_bf16(PAF(2),VFR(2),o[0],0,0,0), C1,0); \
    KRD(GL,3); GAPB(o[1]=__builtin_amdgcn_mfma_f32_32x32x16_bf16(PAF(2),VFR(6),o[1],0,0,0), C1,4); \
    GAPB(o[0]=__builtin_amdgcn_mfma_f32_32x32x16_bf16(PAF(3),VFR(3),o[0],0,0,0), C1,8); \
    GAPB(o[1]=__builtin_amdgcn_mfma_f32_32x32x16_bf16(PAF(3),VFR(7),o[1],0,0,0), C1,12); \
    }while(0)
  int t=1;
  #undef CMASK
  #define CMASK(P0,P1,t) do{}while(0)
  for(;t+5<NT;t+=2){
    STEP(pB0,pB1,pA0,pA1,t,true,true,true);     WAIT_BAR(4); RESC(); ROT();
    STEP(pA0,pA1,pB0,pB1,t+1,true,true,true);   WAIT_BAR(4); RESC(); ROT();
  }
  #undef CMASK
  #define CMASK(P0,P1,t) do{int jb_=(t)-(NT-4); if(jb_>=0){ if(MASK==0)cmask(P0,P1,jb_,qrel,hi); else kmask(P0,P1,jb_,wid); } }while(0)
  #define ENDW(tt) do{ const int n_=((tt)+2>=NT)?0:((int)((tt)+3<NT)+(int)((tt)+1<NT)+(int)((tt)+4<NT)+(int)((tt)+2<NT)); if(n_>=4){WAIT_BAR(4);} else if(n_==3){WAIT_BAR(3);} else if(n_==2){WAIT_BAR(2);} else if(n_==1){WAIT_BAR(1);} else {WAIT_BAR(0);} }while(0)
  for(;t+1<NT;t+=2){
    STEP(pB0,pB1,pA0,pA1,t,(t+4<NT),(t+2<NT),(t+1<NT));       ENDW(t);   RESC(); ROT();
    STEP(pA0,pA1,pB0,pB1,t+1,(t+5<NT),(t+3<NT),(t+2<NT));     ENDW(t+1); RESC(); ROT();
  }
  STEP(pB0,pB1,pA0,pA1,NT-1,false,false,false); RESC();
  { float sacc=pB0[0]+pB0[1]; _Pragma("unroll") for(int r=2;r<16;++r)sacc+=pB0[r]; _Pragma("unroll") for(int r=0;r<16;++r)sacc+=pB1[r]; l_reg+=sacc;
    pw0=(u32x4){PKW(pB0,0),PKW(pB0,2),PKW(pB0,4),PKW(pB0,6)};pw1=(u32x4){PKW(pB0,8),PKW(pB0,10),PKW(pB0,12),PKW(pB0,14)};pw2=(u32x4){PKW(pB1,0),PKW(pB1,2),PKW(pB1,4),PKW(pB1,6)};pw3=(u32x4){PKW(pB1,8),PKW(pB1,10),PKW(pB1,12),PKW(pB1,14)};
    SBAR(); pv(o,vb0+KS(NT-1),PAF(0),PAF(1),PAF(2),PAF(3)); }
  #undef PKW
  #undef PAF
  #undef VFR
  #undef PIN
  #undef MX3
  #undef GAPA
  #undef GAPB
  #undef EX
  #undef VRD
  #undef KRD
  #undef STEP
  #undef ENDW
  {auto rr=__builtin_amdgcn_permlane32_swap(__float_as_uint(l_reg),__float_as_uint(l_reg),false,false);l_reg=__uint_as_float(rr[0])+__uint_as_float(rr[1]);}
  if(hi==0)wsf[32+r32]=l_reg;asm volatile("s_waitcnt lgkmcnt(0)":::"memory");
  float rli[16];
  #pragma unroll
  for(int r=0;r<16;++r)rli[r]=__builtin_amdgcn_rcpf(wsf[32+crow(r,hi)]);
  bf16*Ow=Oh+(long)(q0+wid*QBLK)*opitch;
  { bf16*stg=(bf16*)(shm+LDS_OST)+wid*2048;
    #pragma unroll
    for(int r=0;r<16;++r){const int orow=crow(r,hi);
      #pragma unroll
      for(int d0=0;d0<2;++d0)stg[orow*64+d0*32+r32]=__float2bfloat16(o[d0][r]*rli[r]);}
    asm volatile("s_waitcnt lgkmcnt(0)":::"memory");
    if(WT){ const __amdgpu_buffer_rsrc_t rs_=__builtin_amdgcn_make_buffer_rsrc((void*)Oh,(short)0,0x7fffffff,0x00020000);
      #pragma unroll
      for(int i=0;i<4;++i){const int row=i*8+(lane>>3),ch=lane&7; const u32x4 v=*(const u32x4*)(stg+row*64+ch*8); __builtin_amdgcn_raw_buffer_store_b128(v,rs_,(int)(((long)(q0+wid*QBLK+row)*opitch+ch*8)*2),0,16);} }
    else{
    #pragma unroll
    for(int i=0;i<4;++i){const int row=i*8+(lane>>3),ch=lane&7; const u32x4 v=*(const u32x4*)(stg+row*64+ch*8); ATTN_STORE16(Ow+(long)row*opitch+ch*8,v);} } }
  asm volatile("s_waitcnt lgkmcnt(0)\n\ts_barrier":::"memory");
  #undef DMA_K
  #undef DMA_V
  #undef CMASK
  #undef CIN
  #undef MFR_UPDATE
  #undef MFRB
  #undef START
  #undef RESC
  #undef ROT
  #undef KS
}
constexpr int ATTN_LDS_BYTES=LDS_BYTES;
#undef SBAR
#undef WAIT_BAR
}
#define SBAR() __builtin_amdgcn_sched_barrier(0)
namespace ab {
constexpr int B_LK=0, B_LV=24576, B_VSLOT=16384, B_LP=90112, B_LW=122880, B_LST=124928, B_LSS=157696, B_LDS_BYTES=158720;
typedef __attribute__((address_space(3))) unsigned char* ldsb;

template<int THRL> __device__ __forceinline__ void diff_pass_A(int rblk,const bf16*Qh,const bf16*__restrict__ Kh,const bf16*__restrict__ Vh,char*shm,f32x16(&o)[2],float(&rli)[16]){
  int tid_=threadIdx.x; asm volatile("":"+v"(tid_));
  const int tid=tid_,lane=tid&63,r32=lane&31,hi=lane>>5; const int wid=__builtin_amdgcn_readfirstlane(tid>>6);
  const int rb=wid&3;
  const int q0=rblk*128;
  const bf16*Qw=Qh+(long)(q0+rb*QBLK)*PIN;
  const unsigned lds0=(unsigned)(uintptr_t)shm;
  const ldsb L=(ldsb)shm;
  volatile __attribute__((address_space(3))) float*wf=(volatile __attribute__((address_space(3))) float*)(L+B_LW+rb*512);
  const bf16*ksrc=Kh+(long)lane*PIN+wid*8;
  const bf16*vsrc0=Vh+(long)(16*((2*wid)&3)+(lane>>2))*PIN+(wid>>1)*32+(lane&3)*8;
  const bf16*vsrc1=Vh+(long)(16*((2*wid+1)&3)+(lane>>2))*PIN+(wid>>1)*32+(lane&3)*8;
  const unsigned kdst=lds0+B_LK+wid*1024, vdst=lds0+B_LV+wid*2048;
  #define DMA_K(t,slot) glds16(ksrc+(long)(t)*KVBLK*PIN,(unsigned)__builtin_amdgcn_readfirstlane(kdst+(slot)))
  #define VS(t) ((((t))&3)*B_VSLOT)
  #define DMA_V(t) do{ glds16(vsrc0+(long)(t)*KVBLK*PIN,(unsigned)__builtin_amdgcn_readfirstlane(vdst+VS(t))); glds16(vsrc1+(long)(t)*KVBLK*PIN,(unsigned)__builtin_amdgcn_readfirstlane(vdst+VS(t)+1024)); }while(0)
  const int vb0=(int)(lds0+B_LV)+((lane>>4)&1)*32+(lane&3)*8+(4*hi+((lane&15)>>2))*64;
  const char*Kbase=shm+B_LK; bf16x8 kf[8];
  const lds_cptr shm3=(lds_cptr)shm; const lds_cptr kp0=shm3+B_LK+hi*1024+r32*16; const lds_cptr vp0=shm3+B_LV+((lane>>4)&1)*32+(lane&3)*8+(4*hi+((lane&15)>>2))*64;
  const ldsb pbase=L+B_LP+rb*8192+lane*16;
  const int NT=(2*rblk+2)<4?4:(2*rblk+2);
  const int lim=2*rblk+(rb>>1);
  DMA_K(0,0);DMA_V(0);DMA_K(1,SLOTB);
  bf16x8 qr[4];
  #pragma unroll
  for(int d0=0;d0<4;++d0)qr[d0]=*reinterpret_cast<const bf16x8*>(&Qw[(long)r32*PIN+d0*16+hi*8]);
  constexpr bool NOMAX=THRL<0;
  float mhat=0.f,l_reg=0.f;o[0]=f32x16{};o[1]=f32x16{};f32x16 negm=f32x16{}; asm volatile("":"+v"(negm));
  #define CMASK(P0,P1,t) do{ if((t)>=NT-4){ if((t)>lim){ const float NEG_=-INFINITY; _Pragma("unroll") for(int r_=0;r_<16;++r_){P0[r_]=NEG_;P1[r_]=NEG_;} } } }while(0)
  bool resc=false;
  #define START(P0,P1) do{ if(!NOMAX){ const float rm=rowmax(P0,P1); resc=false; \
    { const float dl=rm; mhat=fadd_s(mhat,dl); \
      _Pragma("unroll") for(int r=0;r<16;++r){P0[r]=fsub_s(P0[r],dl);P1[r]=fsub_s(P1[r],dl);} \
      _Pragma("unroll") for(int r=0;r<16;++r)negm[r]=-mhat; asm volatile("":"+v"(negm)); } } \
    _Pragma("unroll") for(int r=0;r<16;++r)P0[r]=__builtin_amdgcn_exp2f(P0[r]); }while(0)
  #define RESC(t) do{ if(!NOMAX&&resc){ asm volatile("s_waitcnt lgkmcnt(0)":::"memory"); \
      _Pragma("unroll") for(int d_=0;d_<2;++d_) _Pragma("unroll") for(int r=0;r<16;++r)o[d_][r]=fmul_s(o[d_][r],wf[32*((t)&1)+crow(r,hi)]); } }while(0)
  f32x16 pA0,pA1,pB0,pB1;
  int sl_prev=0,sl_cur=0,sl_next=SLOTB;
  #define ROT() do{sl_prev=sl_cur;sl_cur=sl_next;sl_next=(sl_next==2*SLOTB)?0:sl_next+SLOTB;}while(0)
  #define WAIT_BAR(N) asm volatile("s_waitcnt vmcnt(" #N ") lgkmcnt(0)\n\ts_barrier":::"memory")
  DMA_K(2,2*SLOTB);
  WAIT_BAR(3);
  {
    qkt(pA0,pA1,Kbase,qr,negm,r32,hi);
    asm volatile("s_nop 15\n\ts_nop 7":"+v"(pA0),"+v"(pA1));CMASK(pA0,pA1,0);
    START(pA0,pA1);
    _Pragma("unroll") for(int r=0;r<16;++r)pA1[r]=__builtin_amdgcn_exp2f(pA1[r]);
    if(lane==0){wf[96]=0.f;wf[97]=0.f;} }
  WAIT_BAR(0);
  DMA_K(3,0);DMA_V(1);
  ROT();
  kload8(kf,kp0+sl_cur);
  WAIT_BAR(3);
  s16x4 vlo[8],vhi[8]; u32x4 pw0,pw1,pw2,pw3;
  #define PKW(P,B) cvtpk_s(P[B],P[B+1])
  #define PAF(k) __builtin_bit_cast(bf16x8,pw##k)
  #define VFR(i) (bf16x8){vlo[i][0],vlo[i][1],vlo[i][2],vlo[i][3],vhi[i][0],vhi[i][1],vhi[i][2],vhi[i][3]}
  #define PIN(x) asm volatile("":"+v"(x))
  #define MX3(a,b,c) __builtin_fmaxf(__builtin_fmaxf((a),(b)),(c))
  #define GAPA(MF,A0,A1,A2,A3,W0,W1,PW) do{ MF; sacc+=A0; sacc+=A1; sacc+=A2; sacc+=A3; PIN(sacc); W0; W1; PIN(PW); SBAR(); }while(0)
  #define EX(v) __builtin_amdgcn_exp2f(v)
  #define GAPB(MF,X,B) do{ MF; X[B]=EX(X[B]); X[B+1]=EX(X[B+1]); X[B+2]=EX(X[B+2]); X[B+3]=EX(X[B+3]); PIN(X); SBAR(); }while(0)
  #define VRD(i) do{ vlo[i]=vtr(vp_+(((i)>>2)*4096+((i)&3)*1024)); vhi[i]=vtr(vp_+(((i)>>2)*4096+((i)&3)*1024+512)); }while(0)
  #define KRD(G,j) do{ if(G){ kload2(kf,kp0+sl_next,j); SBAR(); } }while(0)
  #define PST(k,slot) (*(__attribute__((address_space(3))) u32x4*)(pbase+(slot)*4096+(k)*1024))
  #define STEP_A(C0,C1,P0,P1,t,GK,GV,GL) do{ SBAR(); \
    const lds_cptr vp_=vp0+VS((t)-1); \
    VRD(0); SBAR(); float sacc=(P0[0]+P0[1]); \
    GAPA(C0=__builtin_amdgcn_mfma_f32_32x32x16_bf16(kf[0],qr[0],negm,0,0,0), P0[2],P0[3],P0[4],P0[5],     pw0[0]=PKW(P0,0), pw0[1]=PKW(P0,2), pw0); \
    VRD(4); SBAR(); GAPA(C1=__builtin_amdgcn_mfma_f32_32x32x16_bf16(kf[1],qr[0],negm,0,0,0), P0[6],P0[7],P0[8],P0[9],     pw0[2]=PKW(P0,4), pw0[3]=PKW(P0,6), pw0); \
    VRD(1); SBAR(); GAPA(C0=__builtin_amdgcn_mfma_f32_32x32x16_bf16(kf[2],qr[1],C0,0,0,0),   P0[10],P0[11],P0[12],P0[13], pw1[0]=PKW(P0,8), pw1[1]=PKW(P0,10), pw1); \
    VRD(5); SBAR(); GAPA(C1=__builtin_amdgcn_mfma_f32_32x32x16_bf16(kf[3],qr[1],C1,0,0,0),   P0[14],P0[15],P1[0],P1[1],   pw1[2]=PKW(P0,12),pw1[3]=PKW(P0,14), pw1); \
    VRD(2); SBAR(); GAPA(C0=__builtin_amdgcn_mfma_f32_32x32x16_bf16(kf[4],qr[2],C0,0,0,0),   P1[2],P1[3],P1[4],P1[5],     pw2[0]=PKW(P1,0), pw2[1]=PKW(P1,2), pw2); \
    VRD(6); SBAR(); GAPA(C1=__builtin_amdgcn_mfma_f32_32x32x16_bf16(kf[5],qr[2],C1,0,0,0),   P1[6],P1[7],P1[8],P1[9],     pw2[2]=PKW(P1,4), pw2[3]=PKW(P1,6), pw2); \
    VRD(3); SBAR(); GAPA(C0=__builtin_amdgcn_mfma_f32_32x32x16_bf16(kf[6],qr[3],C0,0,0,0),   P1[10],P1[11],P1[12],P1[13], pw3[0]=PKW(P1,8), pw3[1]=PKW(P1,10), pw3); \
    VRD(7); SBAR(); GAPA(C1=__builtin_amdgcn_mfma_f32_32x32x16_bf16(kf[7],qr[3],C1,0,0,0),   P1[14],P1[15],0.f,0.f,       pw3[2]=PKW(P1,12),pw3[3]=PKW(P1,14), pw3); \
    PST(0,(t)&1)=pw0; PST(1,(t)&1)=pw1; PST(2,(t)&1)=pw2; PST(3,(t)&1)=pw3; \
    l_reg+=sacc; \
    if(GK){DMA_K((t)+3,sl_cur);} if(GV){DMA_V((t)+1);} \
    CMASK(C0,C1,t); \
    if(!NOMAX){ float a=MX3(C0[0],C0[1],C1[0]),b=MX3(C0[2],C0[3],C1[1]); a=MX3(a,C1[2],C1[3]); \
      _Pragma("unroll") for(int r=4;r<16;r+=4){a=MX3(a,C0[r],C0[r+1]);b=MX3(b,C0[r+2],C0[r+3]);a=MX3(a,C1[r],C1[r+1]);b=MX3(b,C1[r+2],C1[r+3]);} \
      float rm=__builtin_fmaxf(a,b); { auto rr=__builtin_amdgcn_permlane32_swap(__float_as_uint(rm),__float_as_uint(rm),false,false); rm=__builtin_fmaxf(__uint_as_float(rr[0]),__uint_as_float(rr[1])); } \
      resc=false; \
      if(__builtin_expect(__any(rm>(float)THRL),0)){ const float dl=__builtin_fmaxf(rm,0.f); mhat+=dl; \
        _Pragma("unroll") for(int r=0;r<16;++r){C0[r]-=dl;C1[r]-=dl;} \
        _Pragma("unroll") for(int r=0;r<16;++r)negm[r]=-mhat; asm volatile("":"+v"(negm)); \
        const float f=__builtin_amdgcn_exp2f(-dl); l_reg*=f; if(hi==0)wf[32*((t)&1)+r32]=f; resc=true; } \
      if(lane==0)wf[96+((t)&1)]=resc?1.f:0.f; } \
    SBAR(); \
    GAPB(o[0]=__builtin_amdgcn_mfma_f32_32x32x16_bf16(PAF(0),VFR(0),o[0],0,0,0), C0,0); \
    GAPB(o[1]=__builtin_amdgcn_mfma_f32_32x32x16_bf16(PAF(0),VFR(4),o[1],0,0,0), C0,4); \
    KRD(GL,0); GAPB(o[0]=__builtin_amdgcn_mfma_f32_32x32x16_bf16(PAF(1),VFR(1),o[0],0,0,0), C0,8); \
    KRD(GL,1); GAPB(o[1]=__builtin_amdgcn_mfma_f32_32x32x16_bf16(PAF(1),VFR(5),o[1],0,0,0), C0,12); \
    KRD(GL,2); GAPB(o[0]=__builtin_amdgcn_mfma_f32_32x32x16_bf16(PAF(2),VFR(2),o[0],0,0,0), C1,0); \
    KRD(GL,3); GAPB(o[1]=__builtin_amdgcn_mfma_f32_32x32x16_bf16(PAF(2),VFR(6),o[1],0,0,0), C1,4); \
    GAPB(o[0]=__builtin_amdgcn_mfma_f32_32x32x16_bf16(PAF(3),VFR(3),o[0],0,0,0), C1,8); \
    GAPB(o[1]=__builtin_amdgcn_mfma_f32_32x32x16_bf16(PAF(3),VFR(7),o[1],0,0,0), C1,12); \
    }while(0)
  #define STEP(C0,C1,P0,P1,t,GK,GV,GL) STEP_A(C0,C1,P0,P1,t,GK,GV,GL)
  int t=1;
  #undef CMASK
  #define CMASK(P0,P1,t) do{}while(0)
  for(;t+5<NT;t+=2){
    STEP(pB0,pB1,pA0,pA1,t,true,true,true);     WAIT_BAR(3); RESC(t); ROT();
    STEP(pA0,pA1,pB0,pB1,t+1,true,true,true);   WAIT_BAR(3); RESC(t+1); ROT();
  }
  #undef CMASK
  #define CMASK(P0,P1,t) do{ if((t)>=NT-4){ if((t)>lim){ const float NEG_=-INFINITY; _Pragma("unroll") for(int r_=0;r_<16;++r_){P0[r_]=NEG_;P1[r_]=NEG_;} } } }while(0)
  #define ENDW(tt) do{ if((tt)+3<NT){WAIT_BAR(3);} else if((tt)+2<NT){WAIT_BAR(2);} else {WAIT_BAR(0);} }while(0)
  for(;t+1<NT;t+=2){
    STEP(pB0,pB1,pA0,pA1,t,(t+3<NT),(t+1<NT),(t+1<NT));       ENDW(t);   RESC(t); ROT();
    STEP(pA0,pA1,pB0,pB1,t+1,(t+4<NT),(t+2<NT),(t+2<NT));     ENDW(t+1); RESC(t+1); ROT();
  }
  STEP(pB0,pB1,pA0,pA1,NT-1,false,false,false); WAIT_BAR(0); RESC(NT-1);
  { float sacc=pB0[0]+pB0[1]; _Pragma("unroll") for(int r=2;r<16;++r)sacc+=pB0[r]; _Pragma("unroll") for(int r=0;r<16;++r)sacc+=pB1[r]; l_reg+=sacc;
    pw0=(u32x4){PKW(pB0,0),PKW(pB0,2),PKW(pB0,4),PKW(pB0,6)};pw1=(u32x4){PKW(pB0,8),PKW(pB0,10),PKW(pB0,12),PKW(pB0,14)};pw2=(u32x4){PKW(pB1,0),PKW(pB1,2),PKW(pB1,4),PKW(pB1,6)};pw3=(u32x4){PKW(pB1,8),PKW(pB1,10),PKW(pB1,12),PKW(pB1,14)};
    PST(0,NT&1)=pw0; PST(1,NT&1)=pw1; PST(2,NT&1)=pw2; PST(3,NT&1)=pw3;
    {auto rr=__builtin_amdgcn_permlane32_swap(__float_as_uint(l_reg),__float_as_uint(l_reg),false,false);l_reg=__uint_as_float(rr[0])+__uint_as_float(rr[1]);}
    if(hi==0)wf[64+r32]=l_reg;
    SBAR(); pv(o,vb0+VS(NT-1),PAF(0),PAF(1),PAF(2),PAF(3)); }
  WAIT_BAR(0);
  #pragma unroll
  for(int r=0;r<16;++r)rli[r]=__builtin_amdgcn_rcpf(wf[64+crow(r,hi)]);
  asm volatile("s_waitcnt lgkmcnt(0)\n\ts_barrier":::"memory");
  #undef PKW
  #undef PAF
  #undef VFR
  #undef PIN
  #undef MX3
  #undef GAPA
  #undef GAPB
  #undef EX
  #undef VRD
  #undef KRD
  #undef PST
  #undef STEP_A
  #undef STEP
  #undef ENDW
  #undef DMA_K
  #undef DMA_V
  #undef VS
  #undef CMASK
  #undef START
  #undef RESC
  #undef ROT
  #undef WAIT_BAR
}
template<int THRL> __device__ __forceinline__ void diff_pass_B(int rblk,const bf16*__restrict__ Kh,const bf16*__restrict__ Vh,char*shm,f32x16(&o)[2],float(&rli)[16]){
  int tid_=threadIdx.x; asm volatile("":"+v"(tid_));
  const int tid=tid_,lane=tid&63,hi=lane>>5; const int wid=__builtin_amdgcn_readfirstlane(tid>>6);
  const int rb=wid&3;
  const unsigned lds0=(unsigned)(uintptr_t)shm;
  const ldsb L=(ldsb)shm;
  volatile __attribute__((address_space(3))) float*wf=(volatile __attribute__((address_space(3))) float*)(L+B_LW+rb*512);
  const bf16*ksrc=Kh+(long)lane*PIN+wid*8;
  const bf16*vsrc0=Vh+(long)(16*((2*wid)&3)+(lane>>2))*PIN+(wid>>1)*32+(lane&3)*8;
  const bf16*vsrc1=Vh+(long)(16*((2*wid+1)&3)+(lane>>2))*PIN+(wid>>1)*32+(lane&3)*8;
  const unsigned kdst=lds0+B_LK+wid*1024, vdst=lds0+B_LV+wid*2048;
  #define DMA_K(t,slot) glds16(ksrc+(long)(t)*KVBLK*PIN,(unsigned)__builtin_amdgcn_readfirstlane(kdst+(slot)))
  #define VS(t) ((((t))&3)*B_VSLOT)
  #define DMA_V(t) do{ glds16(vsrc0+(long)(t)*KVBLK*PIN,(unsigned)__builtin_amdgcn_readfirstlane(vdst+VS(t))); glds16(vsrc1+(long)(t)*KVBLK*PIN,(unsigned)__builtin_amdgcn_readfirstlane(vdst+VS(t)+1024)); }while(0)
  #define WAIT_BAR(N) asm volatile("s_waitcnt vmcnt(" #N ") lgkmcnt(0)\n\ts_barrier":::"memory")
  const int vb0=(int)(lds0+B_LV)+8192+((lane>>4)&1)*32+(lane&3)*8+(4*hi+((lane&15)>>2))*64;
  const ldsb pbase=L+B_LP+rb*8192+lane*16;
  const int NT=(2*rblk+2)<4?4:(2*rblk+2);
  o[0]=f32x16{};o[1]=f32x16{};
  int sl_cur=0,sl_next=SLOTB;
  #define ROT() do{sl_cur=sl_next;sl_next=(sl_next==2*SLOTB)?0:sl_next+SLOTB;}while(0)
  #define PVB(tp,ps,fpar) do{ \
    const bf16x8 pa0_=*(const __attribute__((address_space(3))) bf16x8*)(pbase+(ps)*4096), pa1_=*(const __attribute__((address_space(3))) bf16x8*)(pbase+(ps)*4096+1024), \
                 pa2_=*(const __attribute__((address_space(3))) bf16x8*)(pbase+(ps)*4096+2048), pa3_=*(const __attribute__((address_space(3))) bf16x8*)(pbase+(ps)*4096+3072); \
    pv(o,vb0+VS(tp),pa0_,pa1_,pa2_,pa3_); \
    if(THRL>=0&&(fpar)>=0){ if(wf[96+((fpar)&1)]!=0.f){ _Pragma("unroll") for(int d_=0;d_<2;++d_) _Pragma("unroll") for(int r=0;r<16;++r)o[d_][r]=fmul_s(o[d_][r],wf[32*((fpar)&1)+crow(r,hi)]); } } }while(0)
  #define STEP(t,GK,GV) do{ if((t)>=2){ PVB((t)-2,((t)-1)&1,(t)-1); } if(GK){DMA_K((t)+3,sl_cur);} if(GV){DMA_V((t)+1);} }while(0)
  DMA_K(0,0);DMA_V(0);DMA_K(1,SLOTB);
  DMA_K(2,2*SLOTB);
  WAIT_BAR(3);
  WAIT_BAR(0);
  DMA_K(3,0);DMA_V(1);
  ROT();
  WAIT_BAR(3);
  int t=1;
  for(;t+5<NT;t+=2){
    STEP(t,true,true);     WAIT_BAR(3); ROT();
    STEP(t+1,true,true);   WAIT_BAR(3); ROT();
  }
  #define ENDW(tt) do{ if((tt)+3<NT){WAIT_BAR(3);} else if((tt)+2<NT){WAIT_BAR(2);} else {WAIT_BAR(0);} }while(0)
  for(;t+1<NT;t+=2){
    STEP(t,(t+3<NT),(t+1<NT));       ENDW(t);   ROT();
    STEP(t+1,(t+4<NT),(t+2<NT));     ENDW(t+1); ROT();
  }
  STEP(NT-1,false,false); WAIT_BAR(0);
  PVB(NT-2,(NT-1)&1,NT-1);
  WAIT_BAR(0);
  PVB(NT-1,NT&1,-1);
  #pragma unroll
  for(int r=0;r<16;++r)rli[r]=__builtin_amdgcn_rcpf(wf[64+crow(r,hi)]);
  asm volatile("s_waitcnt lgkmcnt(0)\n\ts_barrier":::"memory");
  #undef DMA_K
  #undef DMA_V
  #undef VS
  #undef WAIT_BAR
  #undef ROT
  #undef PVB
  #undef STEP
  #undef ENDW
}
template<int THRL> __device__ __forceinline__ void diff_unit_ab(int rblk,const bf16*Qh,const bf16*Kh,const bf16*Vh,bf16_t*ATTh,const float*subw,float lam,char*shm){
  int lane_=threadIdx.x&63; asm volatile("":"+v"(lane_));
  const int lane=lane_,r32=lane&31,hi=lane>>5; const int wid=__builtin_amdgcn_readfirstlane((int)(threadIdx.x>>6)); const int rb=wid&3,hf=wid>>2;
  const ldsb L=(ldsb)shm;
  __attribute__((address_space(3))) bf16_t*stg=(__attribute__((address_space(3))) bf16_t*)(L+B_LST+wid*4096);
  f32x16 o[2]; float rli[16];
  if(wid<4)diff_pass_A<THRL>(rblk,Qh,Kh,Vh,shm,o,rli); else diff_pass_B<THRL>(rblk,Kh,Vh,shm,o,rli);
  #pragma unroll
  for(int r=0;r<16;++r){const int orow=crow(r,hi);
    #pragma unroll
    for(int d0=0;d0<2;++d0)stg[orow*64+d0*32+r32]=(bf16_t)(cvtpk_s(o[d0][r]*rli[r],0.f)&0xffffu);}
  if(wid<4)diff_pass_A<THRL>(rblk,Qh+64,Kh+64,Vh,shm,o,rli); else diff_pass_B<THRL>(rblk,Kh+64,Vh,shm,o,rli);
  #pragma unroll
  for(int r=0;r<16;++r){const int orow=crow(r,hi);
    #pragma unroll
    for(int d0=0;d0<2;++d0){ const float o1=__uint_as_float(((unsigned)stg[orow*64+d0*32+r32])<<16); stg[orow*64+d0*32+r32]=(bf16_t)(cvtpk_s(o1-lam*(o[d0][r]*rli[r]),0.f)&0xffffu); } }
  asm volatile("s_waitcnt lgkmcnt(0)":::"memory");
  u32x4 vv[4]; float ssr[4];
  #pragma unroll
  for(int i=0;i<4;++i){ const int row=i*8+(lane>>3),ch=lane&7; vv[i]=*(const __attribute__((address_space(3))) u32x4*)(stg+row*64+ch*8);
    float s=0.f;
    #pragma unroll
    for(int e=0;e<4;++e){ const float a=__uint_as_float(vv[i][e]<<16),b2=__uint_as_float(vv[i][e]&0xffff0000u); s+=a*a+b2*b2; }
    s+=__shfl_xor(s,1); s+=__shfl_xor(s,2); s+=__shfl_xor(s,4); ssr[i]=s;
    if(ch==0)((__attribute__((address_space(3))) float*)(L+B_LSS))[wid*32+row]=s; }
  asm volatile("s_waitcnt lgkmcnt(0)\n\ts_barrier":::"memory");
  #pragma unroll
  for(int i=0;i<4;++i){ const int row=i*8+(lane>>3),ch=lane&7;
    const float tot=ssr[i]+((const __attribute__((address_space(3))) float*)(L+B_LSS))[(wid^4)*32+row];
    const float rstd=rsqrtf(tot*(1.f/128.f)+EPS)*0.8f;
    const f32x4v g0=*reinterpret_cast<const f32x4v*>(subw+64*hf+8*ch), g1=*reinterpret_cast<const f32x4v*>(subw+64*hf+8*ch+4);
    u32x4 w;
    w.x=cvtpk_s(__uint_as_float(vv[i].x<<16)*rstd*g0[0],__uint_as_float(vv[i].x&0xffff0000u)*rstd*g0[1]);
    w.y=cvtpk_s(__uint_as_float(vv[i].y<<16)*rstd*g0[2],__uint_as_float(vv[i].y&0xffff0000u)*rstd*g0[3]);
    w.z=cvtpk_s(__uint_as_float(vv[i].z<<16)*rstd*g1[0],__uint_as_float(vv[i].z&0xffff0000u)*rstd*g1[1]);
    w.w=cvtpk_s(__uint_as_float(vv[i].w<<16)*rstd*g1[2],__uint_as_float(vv[i].w&0xffff0000u)*rstd*g1[3]);
    *reinterpret_cast<u32x4*>(ATTh+(size_t)(rblk*128+rb*32+row)*DM+64*hf+8*ch)=w; }
  asm volatile("s_waitcnt lgkmcnt(0)\n\ts_barrier":::"memory");
}
}
#undef SBAR
__constant__ unsigned short UNIT_Q[8][176] = {
  {0x4000,0x4001,0x4002,0x4003,0x4020,0x4028,0x4030,0x4038,0x800f,0x801f,0x802f,0x803f,0x800e,0x801e,0x802e,0x803e,0x800d,0x801d,0x802d,0x803d,0x0007,0x000f,0x0017,0x001f,0x0027,0x002f,0x0037,0x003f,0x800c,0x801c,0x802c,0x803c,0x800b,0x801b,0x802b,0x803b,0x0006,0x000e,0x0016,0x001e,0x0026,0x002e,0x0036,0x003e,0x800a,0x801a,0x802a,0x803a,0x8009,0x8019,0x8029,0x8039,0x0005,0x000d,0x0015,0x001d,0x0025,0x002d,0x0035,0x003d,0x8008,0x8018,0x8028,0x8038,0x8007,0x8017,0x8027,0x8037,0x0004,0x000c,0x0014,0x001c,0x0024,0x002c,0x0034,0x003c,0x8006,0x8016,0x8026,0x8036,0x8005,0x8015,0x8025,0x8035,0x0003,0x000b,0x0013,0x001b,0x0023,0x002b,0x0033,0x003b,0x8004,0x8014,0x8024,0x8034,0x8003,0x8013,0x8023,0x8033,0x0002,0x000a,0x0012,0x001a,0x0022,0x002a,0x0032,0x003a,0x8002,0x8012,0x8022,0x8032,0x8000,0x8001,0x8010,0x8011,0x8020,0x8021,0x8030,0x8031,0x0001,0x0009,0x0011,0x0019,0x0021,0x0029,0x0031,0x0039,0x0000,0x0008,0x0010,0x0018,0x0020,0x0028,0x0030,0x0038,0x2000,0x2001,0x2002,0x2003,0x2004,0x2005,0x2006,0x2007,0x2008,0x2009,0x200a,0x200b,0x200c,0x200d,0x200e,0x200f,0x2010,0x2011,0x2012,0x2013,0x2014,0x2015,0x2016,0x2017,0x2018,0x2019,0x201a,0x201b,0x201c,0x201d,0x201e,0x201f,0x2020,0x2021,0x2022,0x2023,0x2024,0x2025,0x2026,0x2027},
  {0x4004,0x4005,0x4006,0x4007,0x4021,0x4029,0x4031,0x4039,0x804f,0x805f,0x806f,0x807f,0x804e,0x805e,0x806e,0x807e,0x804d,0x805d,0x806d,0x807d,0x0047,0x004f,0x0057,0x005f,0x0067,0x006f,0x0077,0x007f,0x804c,0x805c,0x806c,0x807c,0x804b,0x805b,0x806b,0x807b,0x0046,0x004e,0x0056,0x005e,0x0066,0x006e,0x0076,0x007e,0x804a,0x805a,0x806a,0x807a,0x8049,0x8059,0x8069,0x8079,0x0045,0x004d,0x0055,0x005d,0x0065,0x006d,0x0075,0x007d,0x8048,0x8058,0x8068,0x8078,0x8047,0x8057,0x8067,0x8077,0x0044,0x004c,0x0054,0x005c,0x0064,0x006c,0x0074,0x007c,0x8046,0x8056,0x8066,0x8076,0x8045,0x8055,0x8065,0x8075,0x0043,0x004b,0x0053,0x005b,0x0063,0x006b,0x0073,0x007b,0x8044,0x8054,0x8064,0x8074,0x8043,0x8053,0x8063,0x8073,0x0042,0x004a,0x0052,0x005a,0x0062,0x006a,0x0072,0x007a,0x8042,0x8052,0x8062,0x8072,0x8040,0x8041,0x8050,0x8051,0x8060,0x8061,0x8070,0x8071,0x0041,0x0049,0x0051,0x0059,0x0061,0x0069,0x0071,0x0079,0x0040,0x0048,0x0050,0x0058,0x0060,0x0068,0x0070,0x0078,0x2028,0x2029,0x202a,0x202b,0x202c,0x202d,0x202e,0x202f,0x2030,0x2031,0x2032,0x2033,0x2034,0x2035,0x2036,0x2037,0x2038,0x2039,0x203a,0x203b,0x203c,0x203d,0x203e,0x203f,0x2040,0x2041,0x2042,0x2043,0x2044,0x2045,0x2046,0x2047,0x2048,0x2049,0x204a,0x204b,0x204c,0x204d,0x204e,0x204f},
  {0x4008,0x4009,0x400a,0x400b,0x4022,0x402a,0x4032,0x403a,0x808f,0x809f,0x80af,0x80bf,0x808e,0x809e,0x80ae,0x80be,0x808d,0x809d,0x80ad,0x80bd,0x0087,0x008f,0x0097,0x009f,0x00a7,0x00af,0x00b7,0x00bf,0x808c,0x809c,0x80ac,0x80bc,0x808b,0x809b,0x80ab,0x80bb,0x0086,0x008e,0x0096,0x009e,0x00a6,0x00ae,0x00b6,0x00be,0x808a,0x809a,0x80aa,0x80ba,0x8089,0x8099,0x80a9,0x80b9,0x0085,0x008d,0x0095,0x009d,0x00a5,0x00ad,0x00b5,0x00bd,0x8088,0x8098,0x80a8,0x80b8,0x8087,0x8097,0x80a7,0x80b7,0x0084,0x008c,0x0094,0x009c,0x00a4,0x00ac,0x00b4,0x00bc,0x8086,0x8096,0x80a6,0x80b6,0x8085,0x8095,0x80a5,0x80b5,0x0083,0x008b,0x0093,0x009b,0x00a3,0x00ab,0x00b3,0x00bb,0x8084,0x8094,0x80a4,0x80b4,0x8083,0x8093,0x80a3,0x80b3,0x0082,0x008a,0x0092,0x009a,0x00a2,0x00aa,0x00b2,0x00ba,0x8082,0x8092,0x80a2,0x80b2,0x8080,0x8081,0x8090,0x8091,0x80a0,0x80a1,0x80b0,0x80b1,0x0081,0x0089,0x0091,0x0099,0x00a1,0x00a9,0x00b1,0x00b9,0x0080,0x0088,0x0090,0x0098,0x00a0,0x00a8,0x00b0,0x00b8,0x2050,0x2051,0x2052,0x2053,0x2054,0x2055,0x2056,0x2057,0x2058,0x2059,0x205a,0x205b,0x205c,0x205d,0x205e,0x205f,0x2060,0x2061,0x2062,0x2063,0x2064,0x2065,0x2066,0x2067,0x2068,0x2069,0x206a,0x206b,0x206c,0x206d,0x206e,0x206f,0x2070,0x2071,0x2072,0x2073,0x2074,0x2075,0x2076,0x2077},
  {0x400c,0x400d,0x400e,0x400f,0x4023,0x402b,0x4033,0x403b,0x80cf,0x80df,0x80ef,0x80ff,0x80ce,0x80de,0x80ee,0x80fe,0x80cd,0x80dd,0x80ed,0x80fd,0x00c7,0x00cf,0x00d7,0x00df,0x00e7,0x00ef,0x00f7,0x00ff,0x80cc,0x80dc,0x80ec,0x80fc,0x80cb,0x80db,0x80eb,0x80fb,0x00c6,0x00ce,0x00d6,0x00de,0x00e6,0x00ee,0x00f6,0x00fe,0x80ca,0x80da,0x80ea,0x80fa,0x80c9,0x80d9,0x80e9,0x80f9,0x00c5,0x00cd,0x00d5,0x00dd,0x00e5,0x00ed,0x00f5,0x00fd,0x80c8,0x80d8,0x80e8,0x80f8,0x80c7,0x80d7,0x80e7,0x80f7,0x00c4,0x00cc,0x00d4,0x00dc,0x00e4,0x00ec,0x00f4,0x00fc,0x80c6,0x80d6,0x80e6,0x80f6,0x80c5,0x80d5,0x80e5,0x80f5,0x00c3,0x00cb,0x00d3,0x00db,0x00e3,0x00eb,0x00f3,0x00fb,0x80c4,0x80d4,0x80e4,0x80f4,0x80c3,0x80d3,0x80e3,0x80f3,0x00c2,0x00ca,0x00d2,0x00da,0x00e2,0x00ea,0x00f2,0x00fa,0x80c2,0x80d2,0x80e2,0x80f2,0x80c0,0x80c1,0x80d0,0x80d1,0x80e0,0x80e1,0x80f0,0x80f1,0x00c1,0x00c9,0x00d1,0x00d9,0x00e1,0x00e9,0x00f1,0x00f9,0x00c0,0x00c8,0x00d0,0x00d8,0x00e0,0x00e8,0x00f0,0x00f8,0x2078,0x2079,0x207a,0x207b,0x207c,0x207d,0x207e,0x207f,0x2080,0x2081,0x2082,0x2083,0x2084,0x2085,0x2086,0x2087,0x2088,0x2089,0x208a,0x208b,0x208c,0x208d,0x208e,0x208f,0x2090,0x2091,0x2092,0x2093,0x2094,0x2095,0x2096,0x2097,0x2098,0x2099,0x209a,0x209b,0x209c,0x209d,0x209e,0x209f},
  {0x4010,0x4011,0x4012,0x4013,0x4024,0x402c,0x4034,0x403c,0x810f,0x811f,0x812f,0x813f,0x810e,0x811e,0x812e,0x813e,0x810d,0x811d,0x812d,0x813d,0x0107,0x010f,0x0117,0x011f,0x0127,0x012f,0x0137,0x013f,0x810c,0x811c,0x812c,0x813c,0x810b,0x811b,0x812b,0x813b,0x0106,0x010e,0x0116,0x011e,0x0126,0x012e,0x0136,0x013e,0x810a,0x811a,0x812a,0x813a,0x8109,0x8119,0x8129,0x8139,0x0105,0x010d,0x0115,0x011d,0x0125,0x012d,0x0135,0x013d,0x8108,0x8118,0x8128,0x8138,0x8107,0x8117,0x8127,0x8137,0x0104,0x010c,0x0114,0x011c,0x0124,0x012c,0x0134,0x013c,0x8106,0x8116,0x8126,0x8136,0x8105,0x8115,0x8125,0x8135,0x0103,0x010b,0x0113,0x011b,0x0123,0x012b,0x0133,0x013b,0x8104,0x8114,0x8124,0x8134,0x8103,0x8113,0x8123,0x8133,0x0102,0x010a,0x0112,0x011a,0x0122,0x012a,0x0132,0x013a,0x8102,0x8112,0x8122,0x8132,0x8100,0x8101,0x8110,0x8111,0x8120,0x8121,0x8130,0x8131,0x0101,0x0109,0x0111,0x0119,0x0121,0x0129,0x0131,0x0139,0x0100,0x0108,0x0110,0x0118,0x0120,0x0128,0x0130,0x0138,0x20a0,0x20a1,0x20a2,0x20a3,0x20a4,0x20a5,0x20a6,0x20a7,0x20a8,0x20a9,0x20aa,0x20ab,0x20ac,0x20ad,0x20ae,0x20af,0x20b0,0x20b1,0x20b2,0x20b3,0x20b4,0x20b5,0x20b6,0x20b7,0x20b8,0x20b9,0x20ba,0x20bb,0x20bc,0x20bd,0x20be,0x20bf,0x20c0,0x20c1,0x20c2,0x20c3,0x20c4,0x20c5,0x20c6,0x20c7},
  {0x4014,0x4015,0x4016,0x4017,0x4025,0x402d,0x4035,0x403d,0x814f,0x815f,0x816f,0x817f,0x814e,0x815e,0x816e,0x817e,0x814d,0x815d,0x816d,0x817d,0x0147,0x014f,0x0157,0x015f,0x0167,0x016f,0x0177,0x017f,0x814c,0x815c,0x816c,0x817c,0x814b,0x815b,0x816b,0x817b,0x0146,0x014e,0x0156,0x015e,0x0166,0x016e,0x0176,0x017e,0x814a,0x815a,0x816a,0x817a,0x8149,0x8159,0x8169,0x8179,0x0145,0x014d,0x0155,0x015d,0x0165,0x016d,0x0175,0x017d,0x8148,0x8158,0x8168,0x8178,0x8147,0x8157,0x8167,0x8177,0x0144,0x014c,0x0154,0x015c,0x0164,0x016c,0x0174,0x017c,0x8146,0x8156,0x8166,0x8176,0x8145,0x8155,0x8165,0x8175,0x0143,0x014b,0x0153,0x015b,0x0163,0x016b,0x0173,0x017b,0x8144,0x8154,0x8164,0x8174,0x8143,0x8153,0x8163,0x8173,0x0142,0x014a,0x0152,0x015a,0x0162,0x016a,0x0172,0x017a,0x8142,0x8152,0x8162,0x8172,0x8140,0x8141,0x8150,0x8151,0x8160,0x8161,0x8170,0x8171,0x0141,0x0149,0x0151,0x0159,0x0161,0x0169,0x0171,0x0179,0x0140,0x0148,0x0150,0x0158,0x0160,0x0168,0x0170,0x0178,0x20c8,0x20c9,0x20ca,0x20cb,0x20cc,0x20cd,0x20ce,0x20cf,0x20d0,0x20d1,0x20d2,0x20d3,0x20d4,0x20d5,0x20d6,0x20d7,0x20d8,0x20d9,0x20da,0x20db,0x20dc,0x20dd,0x20de,0x20df,0x20e0,0x20e1,0x20e2,0x20e3,0x20e4,0x20e5,0x20e6,0x20e7,0x20e8,0x20e9,0x20ea,0x20eb,0x20ec,0x20ed,0x20ee,0x20ef},
  {0x4018,0x4019,0x401a,0x401b,0x4026,0x402e,0x4036,0x403e,0x818f,0x819f,0x81af,0x81bf,0x818e,0x819e,0x81ae,0x81be,0x818d,0x819d,0x81ad,0x81bd,0x0187,0x018f,0x0197,0x019f,0x01a7,0x01af,0x01b7,0x01bf,0x818c,0x819c,0x81ac,0x81bc,0x818b,0x819b,0x81ab,0x81bb,0x0186,0x018e,0x0196,0x019e,0x01a6,0x01ae,0x01b6,0x01be,0x818a,0x819a,0x81aa,0x81ba,0x8189,0x8199,0x81a9,0x81b9,0x0185,0x018d,0x0195,0x019d,0x01a5,0x01ad,0x01b5,0x01bd,0x8188,0x8198,0x81a8,0x81b8,0x8187,0x8197,0x81a7,0x81b7,0x0184,0x018c,0x0194,0x019c,0x01a4,0x01ac,0x01b4,0x01bc,0x8186,0x8196,0x81a6,0x81b6,0x8185,0x8195,0x81a5,0x81b5,0x0183,0x018b,0x0193,0x019b,0x01a3,0x01ab,0x01b3,0x01bb,0x8184,0x8194,0x81a4,0x81b4,0x8183,0x8193,0x81a3,0x81b3,0x0182,0x018a,0x0192,0x019a,0x01a2,0x01aa,0x01b2,0x01ba,0x8182,0x8192,0x81a2,0x81b2,0x8180,0x8181,0x8190,0x8191,0x81a0,0x81a1,0x81b0,0x81b1,0x0181,0x0189,0x0191,0x0199,0x01a1,0x01a9,0x01b1,0x01b9,0x0180,0x0188,0x0190,0x0198,0x01a0,0x01a8,0x01b0,0x01b8,0x20f0,0x20f1,0x20f2,0x20f3,0x20f4,0x20f5,0x20f6,0x20f7,0x20f8,0x20f9,0x20fa,0x20fb,0x20fc,0x20fd,0x20fe,0x20ff,0x2100,0x2101,0x2102,0x2103,0x2104,0x2105,0x2106,0x2107,0x2108,0x2109,0x210a,0x210b,0x210c,0x210d,0x210e,0x210f,0x2110,0x2111,0x2112,0x2113,0x2114,0x2115,0x2116,0x2117},
  {0x401c,0x401d,0x401e,0x401f,0x4027,0x402f,0x4037,0x403f,0x81cf,0x81df,0x81ef,0x81ff,0x81ce,0x81de,0x81ee,0x81fe,0x81cd,0x81dd,0x81ed,0x81fd,0x01c7,0x01cf,0x01d7,0x01df,0x01e7,0x01ef,0x01f7,0x01ff,0x81cc,0x81dc,0x81ec,0x81fc,0x81cb,0x81db,0x81eb,0x81fb,0x01c6,0x01ce,0x01d6,0x01de,0x01e6,0x01ee,0x01f6,0x01fe,0x81ca,0x81da,0x81ea,0x81fa,0x81c9,0x81d9,0x81e9,0x81f9,0x01c5,0x01cd,0x01d5,0x01dd,0x01e5,0x01ed,0x01f5,0x01fd,0x81c8,0x81d8,0x81e8,0x81f8,0x81c7,0x81d7,0x81e7,0x81f7,0x01c4,0x01cc,0x01d4,0x01dc,0x01e4,0x01ec,0x01f4,0x01fc,0x81c6,0x81d6,0x81e6,0x81f6,0x81c5,0x81d5,0x81e5,0x81f5,0x01c3,0x01cb,0x01d3,0x01db,0x01e3,0x01eb,0x01f3,0x01fb,0x81c4,0x81d4,0x81e4,0x81f4,0x81c3,0x81d3,0x81e3,0x81f3,0x01c2,0x01ca,0x01d2,0x01da,0x01e2,0x01ea,0x01f2,0x01fa,0x81c2,0x81d2,0x81e2,0x81f2,0x81c0,0x81c1,0x81d0,0x81d1,0x81e0,0x81e1,0x81f0,0x81f1,0x01c1,0x01c9,0x01d1,0x01d9,0x01e1,0x01e9,0x01f1,0x01f9,0x01c0,0x01c8,0x01d0,0x01d8,0x01e0,0x01e8,0x01f0,0x01f8,0x2118,0x2119,0x211a,0x211b,0x211c,0x211d,0x211e,0x211f,0x2120,0x2121,0x2122,0x2123,0x2124,0x2125,0x2126,0x2127,0x2128,0x2129,0x212a,0x212b,0x212c,0x212d,0x212e,0x212f,0x2130,0x2131,0x2132,0x2133,0x2134,0x2135,0x2136,0x2137,0x2138,0x2139,0x213a,0x213b,0x213c,0x213d,0x213e,0x213f},
};
constexpr int NQ_UNITS = 176;
constexpr size_t WS_DIFFO = 224 * MiB;
constexpr size_t WS_END2 = 256 * MiB;
constexpr int CW_FILL = 9984;
constexpr int N_FILL_ARRIVALS = 8 * 320;
constexpr int CW_QHEAD = 10240;
constexpr int CW_DIFF = 11264;
static_assert((CW_DIFF + 256 * 8) * 4 <= (int)CTL_ZERO_BYTES, "counters inside the zeroed control region");
static_assert(ab::ATTN_LDS_BYTES <= LDSCTL_OFF && ab::B_LDS_BYTES <= LDSCTL_OFF, "attention LDS fits below the control words");
__device__ __forceinline__ void diff_combine(const bf16_t* DIFFO, bf16_t* ATT, const float* subw, float lam, int b, int h, int qb, int wid, int lane_) {
    int lane = lane_; asm volatile("" : "+v"(lane));
    const int row = b * SEQ + 256 * qb + 32 * wid + (lane >> 1), hf = lane & 1;
    const __amdgpu_buffer_rsrc_t rs_ = __builtin_amdgcn_make_buffer_rsrc((void*)DIFFO, (short)0, 0x7fffffff, 0x00020000);
    const int o1_ = (int)(((size_t)row * 1024 + h * 256 + hf * 64) * 2), o2_ = o1_ + 256;
    f32x4 v[16]; float ss = 0.f;
#pragma unroll
    for (int q = 0; q < 8; ++q) { const v4u a = __builtin_amdgcn_raw_buffer_load_b128(rs_, o1_ + 16 * q, 0, 16), c = __builtin_amdgcn_raw_buffer_load_b128(rs_, o2_ + 16 * q, 0, 16);
        const f32x4 a0 = {__uint_as_float(a.x << 16), __uint_as_float(a.x & 0xffff0000u), __uint_as_float(a.y << 16), __uint_as_float(a.y & 0xffff0000u)};
        const f32x4 a1 = {__uint_as_float(a.z << 16), __uint_as_float(a.z & 0xffff0000u), __uint_as_float(a.w << 16), __uint_as_float(a.w & 0xffff0000u)};
        const f32x4 c0 = {__uint_as_float(c.x << 16), __uint_as_float(c.x & 0xffff0000u), __uint_as_float(c.y << 16), __uint_as_float(c.y & 0xffff0000u)};
        const f32x4 c1 = {__uint_as_float(c.z << 16), __uint_as_float(c.z & 0xffff0000u), __uint_as_float(c.w << 16), __uint_as_float(c.w & 0xffff0000u)};
        v[2 * q] = a0 - c0 * lam; v[2 * q + 1] = a1 - c1 * lam;
        ss += ((v[2 * q].x * v[2 * q].x + v[2 * q].y * v[2 * q].y) + (v[2 * q].z * v[2 * q].z + v[2 * q].w * v[2 * q].w)) + ((v[2 * q + 1].x * v[2 * q + 1].x + v[2 * q + 1].y * v[2 * q + 1].y) + (v[2 * q + 1].z * v[2 * q + 1].z + v[2 * q + 1].w * v[2 * q + 1].w)); }
    ss += __shfl_xor(ss, 1);
    const float rstd = rsqrtf(ss * (1.f / 128.f) + EPS) * 0.8f;
    GAS v4u* dst = (GAS v4u*)(ATT + (size_t)row * DM + h * 128 + hf * 64);
    const GAS f32x4* sw = (const GAS f32x4*)(subw + hf * 64);
#pragma unroll
    for (int q = 0; q < 8; ++q) { const f32x4 g0 = sw[2 * q] * rstd, g1 = sw[2 * q + 1] * rstd; const f32x4 o0 = v[2 * q] * g0, o1 = v[2 * q + 1] * g1;
        dst[q] = (v4u){pk2(o0.x, o0.y), pk2(o0.z, o0.w), pk2(o1.x, o1.y), pk2(o1.z, o1.w)}; }
}
#if PROBE_K >= 200
#define ACC_T0() unsigned long long acc_t0_ = __builtin_amdgcn_s_memrealtime()
#define ACC_ADD(cat) do { if (F.tid == 0) { const unsigned long long t1_ = __builtin_amdgcn_s_memrealtime(); F.MISC[40 + (cat)] += (unsigned)(t1_ - acc_t0_); } acc_t0_ = __builtin_amdgcn_s_memrealtime(); } while (0)
#else
#define ACC_T0() do {} while (0)
#define ACC_ADD(cat) do {} while (0)
#endif
__device__ __forceinline__ void attn_phase(Frame& F, char* shm, gu32* ctl, const bf16_t* PROJ, const float* CUMB, bf16_t* ATT, bf16_t* DIFFO, const float* subw, const float* lq1, const float* lk1, const float* lq2, const float* lk2,
                                           const bf16_t* HM, const bf16_t* WKV, bf16_t* MKN, bf16_t* VT, const float* mkw, const float* mqw) {
    const float s1 = wave_sum(lq1[F.lane] * lk1[F.lane]), s2 = wave_sum(lq2[F.lane] * lk2[F.lane]);
    const float lam = __uint_as_float(__builtin_amdgcn_readfirstlane(__float_as_uint(__expf(s1) - __expf(s2) + 0.2f)));
    const int xq = (int)(xb_xcc_id() & 7u);
    ACC_T0();
    for (;;) {
        if (F.tid == 0) F.MISC[13] = __hip_atomic_fetch_add((unsigned*)(ctl + CW_QHEAD + 64 * xq), 1u, __ATOMIC_RELAXED, __HIP_MEMORY_SCOPE_AGENT);
        __syncthreads();
        const unsigned qi = F.MISC[13];
        __syncthreads();
        if (qi >= (unsigned)NQ_UNITS) break;
        ACC_ADD(5);
        const unsigned u = UNIT_Q[xq][qi];
        const int qb = u & 7;
        if (u & 0x2000u) {
            LAS float* scr = (LAS float*)(F.lds + RING_OFF + F.wave * 16384);
            const unsigned char* ka_ = (const unsigned char*)__builtin_amdgcn_kernarg_segment_ptr(); asm volatile("" : "+s"(ka_));
            const Args* ap_ = (const Args*)ka_; const Ptrs P = make_ptrs(ap_->in, ap_->out, ap_->ws);
            const int it0 = (int)(u & 511) * 16 + F.wave * 2;
            int ln_ = F.lane; asm volatile("" : "+v"(ln_));
#pragma unroll 1
            for (int it = it0; it < it0 + 2; ++it) {
                int r = it;
                if (r < 512) { p0_transpose_item<false, true>(P.w_mq, DM, DM, DM, P.nmq, P.WQ, scr, r, ln_); continue; } r -= 512;
                if (r < 512) { p0_transpose_item<false, true>(P.w_mo, DM, DM, DM, nullptr, P.WO, scr, r, ln_); continue; } r -= 512;
                if (r < 2048) { p0_transpose_item<false, true>(P.w_up, DFF, DM, DFF, P.nmlp, P.WUP, scr, r, ln_); continue; } r -= 2048;
                p0_transpose_item<false, true>(P.w_dn, DM, DFF, DM, nullptr, P.WDN, scr, r, ln_);
            }
            VM_WAIT(); if (ln_ == 0) __hip_atomic_fetch_add((unsigned*)(ctl + CW_FILL), 1u, __ATOMIC_RELAXED, __HIP_MEMORY_SCOPE_AGENT);
            __syncthreads(); ACC_ADD(4);
        } else if (u & 0x4000u) {
            const int idx = u & 63;
            if (idx < 32) {
                pg8::Gemm g{HM, WKV, DM, DM, DM}; const Sched S = sched_one(idx >> 2, idx & 3, true);
                pg8::EpiHeadNormK E{MKN, mkw, mqw};
                pg8::gemm_phase<pg8::EpiHeadNormK, Sched, false, true>(F.lds + RING_OFF, g, S, E);
            } else {
                pg8::Gemm g{WKV + (size_t)1024 * DM, HM, DM, DM, DM}; const Sched S = sched_one((idx - 32) >> 3, (idx - 32) & 7, true);
                pg8::EpiStore<0> E{VT, MMEM, nullptr};
                pg8::gemm_phase<pg8::EpiStore<0>, Sched, true, true>(F.lds + RING_OFF, g, S, E);
            }
            __syncthreads(); ACC_ADD(3);
        } else if (u & 0x8000u) {
            const int rblk = u & 15, bh = (u >> 4) & 31, b = bh >> 2, h = bh & 3;
            const ab::bf16* base = (const ab::bf16*)PROJ + (size_t)b * SEQ * NPROJ;
            ab::diff_unit_ab<-1>(rblk, base + C_DQ + 128 * h, base + C_DK + 128 * h, base + C_DV + 128 * h, ATT + (size_t)b * SEQ * DM + 128 * h, subw, lam, shm);
            ACC_ADD(1);
        } else {
            const int bh = (u >> 3) & 63, b = bh >> 3, h = bh & 7;
            const ab::bf16* base = (const ab::bf16*)PROJ + (size_t)b * SEQ * NPROJ;
            ab::attn_unit<-1, 0, true, false>(qb, base + C_FQ + 64 * h, base + C_FK + 64 * h, base + C_FV + 64 * h, (ab::bf16*)ATT + (size_t)b * SEQ * DM + 512 + 64 * h, DM, CUMB + (size_t)bh * SEQ, shm);
            ACC_ADD(0);
        }
    }
}
#ifndef REP3
#define REP3 1
#endif
#define ATTN_PHASE_HOOK if (IN(3)) { PP; for (int rep_ = 0; rep_ < REP3; ++rep_) attn_phase(F, (char*)lds + RING_OFF, F.ctl, P.PROJ, P.CUMB, P.ATT, (bf16_t*)(args.ws + WS_DIFFO), P.subw, P.lq1, P.lk1, P.lq2, P.lk2, P.HM, P.WKV, P.MKN, P.VT, P.mkw, P.mqw); }
#ifndef PROBE_K
#define PROBE_K -1
#endif
#ifndef PROBE_MULT
#define PROBE_MULT 4
#endif
#define STAMP(i) do { if (PROBE_K >= 0 && F.tid == 0) { const unsigned long long t_ = __builtin_amdgcn_s_memrealtime(); F.MISC[16 + 2 * (i)] = (unsigned)t_; F.MISC[17 + 2 * (i)] = (unsigned)(t_ >> 32); } } while (0)
#ifndef REP0
#define REP0 1
#endif
#ifndef REP1
#define REP1 1
#endif
#ifndef REP2
#define REP2 1
#endif
#ifndef REP3
#define REP3 1
#endif
#ifndef REP4
#define REP4 1
#endif
#ifndef REP5
#define REP5 1
#endif
#ifndef REP6
#define REP6 1
#endif
#ifndef REP7
#define REP7 1
#endif
#ifndef REP8
#define REP8 1
#endif
constexpr int NPHASE = 9;

__global__ void __launch_bounds__(NWAVES * 64, 2) mega_fwd(Args args) {
    extern __shared__ __attribute__((aligned(16))) unsigned char lds[];
    Frame F;
    F.lds = (LAS unsigned char*)lds; F.MISC = (volatile LAS unsigned*)(F.lds + MISC_OFF);
    F.tid = threadIdx.x; F.lane = F.tid & 63; F.wave = __builtin_amdgcn_readfirstlane(F.tid >> 6);
    F.G = gridDim.x; { const int bx = blockIdx.x; F.vcu = (F.G % 8 == 0) ? (bx % 8) * (F.G / 8) + bx / 8 : bx; }
    F.ctl = (gu32*)(args.ws + WS_CTL);
    for (int u = F.tid; u < (LDS_BYTES - LDSCTL_OFF) / 4; u += NWAVES * 64) ((LAS unsigned*)(F.lds + LDSCTL_OFF))[u] = 0u;
    __syncthreads();
    XcdBarrier bar = xcd_barrier_post((unsigned*)(F.ctl + CW_BAR) + args.ph_lo * XCD_BAR_WORDS, F.MISC + 8);
    const int lo = args.ph_lo, hi = args.ph_hi;
#define IN(k) (lo <= (k) && (k) < hi)
#define PP const Ptrs P = make_ptrs(args.in, args.out, args.ws)
#define SEAM(k) do { if (IN(k) && IN((k) + 1)) xcd_barrier(bar); } while (0)
#define SEAM2(k) do { if (IN(k) && IN((k) + 2)) xcd_barrier(bar); } while (0)
#define SEAML(k) do { if (IN(k) && IN((k) + 1)) { if (loc) xcc_barrier(bar); else xcd_barrier(bar); } } while (0)
    const int bx = (int)blockIdx.x;
    STAMP(0);

    if (IN(0)) { PP; for (int rep_ = 0; rep_ < REP0; ++rep_) p0_prologue(F, P); } SEAM(0); STAMP(1);
    const bool loc = (lo == 0) && (F.MISC[11] != 0u);
    const int cx = loc ? (int)(F.MISC[10] * 8u + bar.x) : bx;

    if (IN(1)) {
        PP; for (int rep_ = 0; rep_ < REP1; ++rep_) {
        pg8::Gemm g{P.XB, P.WIN, DM, DM, DM}; const Sched S = sched_static(MTOK, NPROJ, F.G, cx);
        { const int sq = loc ? ((cx >> 3) < 8 ? (cx & 7) * 8 + (cx >> 3) : -1) : (bx < 64 ? bx : -1);
          if (sq >= 0) p1b_cumsum_wg(P.FLOG, P.b_forget, P.CUMB, sq, F.tid, (LAS float*)(F.lds + LDS_RQ)); }
        pg8::EpiProj E{P.PROJ, P.QKW, P.ROPE};
        pg8::gemm_phase<pg8::EpiProj, Sched, true, true>(F.lds + RING_OFF, g, S, E);
    }} if (IN(1) && IN(3)) { if (loc) xcc_barrier(bar); else xcd_barrier(bar); } STAMP(2);


    ATTN_PHASE_HOOK
    if (PROBE_K >= 300 && F.tid == 0) { __hip_atomic_fetch_add((unsigned*)(F.ctl + 3000), F.MISC[40 + (PROBE_K >= 300 ? PROBE_K - 300 : 0)], __ATOMIC_RELAXED, __HIP_MEMORY_SCOPE_AGENT); }
    STAMP(9); SEAML(3); STAMP(3);
    if (PROBE_K >= 300 && F.tid == 0) { F.MISC[39] = __hip_atomic_load((unsigned*)(F.ctl + 3000), __ATOMIC_RELAXED, __HIP_MEMORY_SCOPE_AGENT) / 256u; }

    if (IN(4)) {
        PP; for (int rep_ = 0; rep_ < REP4; ++rep_) {
        pg8::Gemm g{P.ATT, P.WOUT, DM, DM, DM}; const Sched S = sched_static(MTOK, DM, F.G, cx);
        pg8::EpiResid<0> E{P.RS0, P.XB, nullptr, P.SS};
        pg8::gemm_phase<pg8::EpiResid<0>, Sched, false, true>(F.lds + RING_OFF, g, S, E);
    }} SEAML(4); STAMP(4);

    if (IN(5)) {
        PP; for (int rep_ = 0; rep_ < REP5; ++rep_) {
        if (F.tid == 0) { XB_SPIN(__hip_atomic_load((unsigned*)(F.ctl + CW_FILL), __ATOMIC_RELAXED, __HIP_MEMORY_SCOPE_AGENT) < (unsigned)N_FILL_ARRIVALS, (unsigned*)(F.ctl + CW_BAR)); }
        __syncthreads();
        const Sched S0 = sched_static(MTOK, DM, F.G, cx); pg8::Unit u{0, 0}; const bool has = S0.next(0, u);
        PG8_LAS float* RQ = (PG8_LAS float*)(F.lds + LDS_RQ); PG8_LAS float* IL = (PG8_LAS float*)(F.lds + LDS_IL);
        {   pg8::Gemm g{P.XB, P.WQ, DM, DM, DM}; const Sched S = sched_one(u.pm, u.pn, has);
            pg8::EpiMemQ E{P.MQ, P.SS, RQ};
            pg8::gemm_phase<pg8::EpiMemQ, Sched, false, true>(F.lds + RING_OFF, g, S, E); }
        VM_WAIT(); __syncthreads(); if (F.tid == 0) { __builtin_amdgcn_fence(__ATOMIC_ACQUIRE, "agent"); VM_WAIT(); } __syncthreads();
        const int head = u.pn, bh = (u.pm >> 3) * 4 + head;
        {   pg8::Gemm g{P.MQ + head * 256, P.MKN + (size_t)bh * 65536, DM, 256, 256}; const Sched S = sched_one(u.pm, 0, has);
            pg8::EpiMemS E{P.MQ, head, RQ, IL};
            pg8::gemm_phase<pg8::EpiMemS, Sched, false, true>(F.lds + RING_OFF, g, S, E); }
        VM_WAIT(); __syncthreads(); if (F.tid == 0) { __builtin_amdgcn_fence(__ATOMIC_ACQUIRE, "agent"); VM_WAIT(); } __syncthreads();
        {   pg8::Gemm g{P.MQ + head * 256, P.VT + (size_t)(head * 256) * MMEM + (u.pm >> 3) * 256, DM, MMEM, 256}; const Sched S = sched_one(u.pm, 0, has);
            pg8::EpiMemPV E{P.MO, head, IL};
            pg8::gemm_phase<pg8::EpiMemPV, Sched, true, true>(F.lds + RING_OFF, g, S, E); }
    }} SEAML(5); STAMP(5);

    if (IN(6)) {
        PP; for (int rep_ = 0; rep_ < REP6; ++rep_) {
        pg8::Gemm g{P.MO, P.WO, DM, DM, DM}; const Sched S = sched_static(MTOK, DM, F.G, cx);
        pg8::EpiResid<1> E{nullptr, P.XB, nullptr, P.SS};
        pg8::gemm_phase<pg8::EpiResid<1>, Sched, false, true>(F.lds + RING_OFF, g, S, E);
    }} SEAML(6); STAMP(6);

    if (IN(7)) {
        PP; for (int rep_ = 0; rep_ < REP7; ++rep_) {
        pg8::Gemm g{P.XB, P.WUP, DM, DM, DM}; const Sched S = sched_static(MTOK, DFF, F.G, cx);
        pg8::EpiStore<3> E{P.H, DFF, P.SS};
        pg8::gemm_phase<pg8::EpiStore<3>, Sched, true, true>(F.lds + RING_OFF, g, S, E);
    }} SEAML(7); STAMP(7);

    if (IN(8)) {
        PP; for (int rep_ = 0; rep_ < REP8; ++rep_) {
        pg8::Gemm g{P.H, P.WDN, DFF, DFF, DFF}; const Sched S = sched_static(MTOK, DM, F.G, cx);
        pg8::EpiResid<2> E{nullptr, P.XB, P.out, P.SS};
        pg8::gemm_phase<pg8::EpiResid<2>, Sched, false, true>(F.lds + RING_OFF, g, S, E);
    }}
    STAMP(8);
    if (PROBE_K >= 0 && F.tid == 0) {
        constexpr int IA_ = PROBE_K == 100 ? 9 : (PROBE_K >= 200 ? 0 : PROBE_K), IB_ = PROBE_K == 100 ? 3 : (PROBE_K >= 200 ? 1 : PROBE_K + 1);
        const unsigned long long a_ = ((unsigned long long)F.MISC[17 + 2 * IA_] << 32) | F.MISC[16 + 2 * IA_], b_ = ((unsigned long long)F.MISC[17 + 2 * IB_] << 32) | F.MISC[16 + 2 * IB_];
        unsigned long long w_ = (b_ - a_) * PROBE_MULT; if (PROBE_K >= 200 && PROBE_K < 300) w_ = (unsigned long long)F.MISC[40 + (PROBE_K >= 200 && PROBE_K < 300 ? PROBE_K - 200 : 0)] * PROBE_MULT; if (PROBE_K >= 300) w_ = (unsigned long long)F.MISC[39] * PROBE_MULT;
        const unsigned long long t0_ = __builtin_amdgcn_s_memrealtime();
        while (__builtin_amdgcn_s_memrealtime() - t0_ < w_) __builtin_amdgcn_s_sleep(8);
    }
#undef IN
#undef SEAM
#undef SEAM2
}
extern "C" void kernel_launch(void* const* d_in, const int* in_sizes, int n_in, void* d_out, int out_size, void* d_ws, size_t ws_size, hipStream_t stream) {
    static int grid = 0;
    if (grid == 0) {
        if (n_in != 26 || in_sizes[0] != MTOK * DM || out_size != MTOK * DM || ws_size < WS_END2) { fprintf(stderr, "kernel_launch: unexpected shapes (n_in %d, in0 %d, out %d, ws %zu)\n", n_in, n_in > 0 ? in_sizes[0] : -1, out_size, ws_size); grid = -1; return; }
        int dev = 0, cus = 0, per_cu = 0;
        if (hipGetDevice(&dev) != hipSuccess || hipDeviceGetAttribute(&cus, hipDeviceAttributeMultiprocessorCount, dev) != hipSuccess) { grid = -1; return; }
        if (hipFuncSetAttribute((const void*)mega_fwd, hipFuncAttributeMaxDynamicSharedMemorySize, LDS_BYTES) != hipSuccess) { fprintf(stderr, "kernel_launch: hipFuncSetAttribute failed\n"); grid = -1; return; }
        if (hipOccupancyMaxActiveBlocksPerMultiprocessor(&per_cu, (const void*)mega_fwd, NWAVES * 64, LDS_BYTES) != hipSuccess || per_cu < 1) { fprintf(stderr, "kernel_launch: occupancy query says %d blocks per CU\n", per_cu); (void)hipGetLastError(); grid = -1; return; }
        grid = cus;
        if (grid != 256) fprintf(stderr, "kernel_launch: %d CUs; the one-unit-per-workgroup phases assume 256\n", grid);
    }
    if (grid < 0) return;
    (void)hipMemsetAsync((char*)d_ws + WS_CTL, 0, CTL_ZERO_BYTES, stream);
    Args a{};
    for (int i = 0; i < 26; ++i) a.in[i] = d_in[i];
    a.out = (float*)d_out; a.ws = (unsigned char*)d_ws;
#if MK_HYBRID
    const Ptrs P = make_ptrs(a.in, a.out, a.ws);
    a.ph_lo = 0; a.ph_hi = 3; hipLaunchKernelGGL(mega_fwd, dim3(grid), dim3(NWAVES * 64), LDS_BYTES, stream, a);
    float* OF = a.out;
    hipLaunchKernelGGL(k_attn, dim3(MTOK / 64, 8), dim3(64), 0, stream, P.PROJ, P.CUMB, 1, OF, 8);
    hipLaunchKernelGGL(k_fox_fin, dim3(MTOK * 512 / 256), dim3(256), 0, stream, OF, P.ATT);
    hipLaunchKernelGGL(k_attn, dim3(MTOK / 64, 16), dim3(64), 0, stream, P.PROJ, P.CUMB, 0, OF, 16);
    hipLaunchKernelGGL(k_diff_fin, dim3(MTOK), dim3(256), 0, stream, OF, P.lq1, P.lk1, P.lq2, P.lk2, P.subw, P.ATT);
    a.ph_lo = 4; a.ph_hi = 9; hipLaunchKernelGGL(mega_fwd, dim3(grid), dim3(NWAVES * 64), LDS_BYTES, stream, a);
#else
    a.ph_lo = 0; a.ph_hi = NPHASE; hipLaunchKernelGGL(mega_fwd, dim3(grid), dim3(NWAVES * 64), LDS_BYTES, stream, a);
#endif
}
```

```cpp
#include <hip/hip_runtime.h>
#include <cstdint>
#include <cstdio>

typedef unsigned short bf16_t;
__device__ __forceinline__ float bf2f(bf16_t v) { return __uint_as_float(((unsigned)v) << 16); }
__device__ __forceinline__ bf16_t f2bf(float f) { unsigned u = __float_as_uint(f); return (bf16_t)((u + 0x7fffu + ((u >> 16) & 1u)) >> 16); }

constexpr int NB = 8, SEQ = 2048, DM = 1024, MTOK = NB * SEQ, MEML = 256, MMEM = NB * MEML;
constexpr int NPROJ = 3072, INCOLS = 3080, DFF = 4096;
constexpr float EPS = 1e-6f;
constexpr float LOG2E = 1.4426950408889634f;
constexpr float C2 = 0.125f * LOG2E;
constexpr float CM = 0.0625f * LOG2E;
constexpr int C_DQ = 0, C_DK = 512, C_DV = 1024, C_FQ = 1536, C_FK = 2048, C_FV = 2560;

constexpr size_t MiB = 1u << 20;
constexpr size_t WS_CTL = 0, CTL_ZERO_BYTES = 112 * 1024;
constexpr size_t WS_FLOG = 1 * MiB;
constexpr size_t WS_CUMB = 2 * MiB;
constexpr size_t WS_ROPE = 3 * MiB;
constexpr size_t WS_RS0 = 4 * MiB + 256 * 1024;
constexpr size_t WS_QKW = 4 * MiB + 512 * 1024;
constexpr size_t WS_SS = 4 * MiB;
constexpr size_t WS_WIN = 8 * MiB, WS_WOUT = 14 * MiB, WS_WQ = 16 * MiB, WS_WKV = 18 * MiB, WS_WO = 22 * MiB, WS_WUP = 24 * MiB, WS_WDN = 32 * MiB;
constexpr size_t WS_XB = 40 * MiB;
constexpr size_t WS_HM = 72 * MiB;
constexpr size_t WS_MK = 76 * MiB;
constexpr size_t WS_VT = 80 * MiB;
constexpr size_t WS_MKN = 84 * MiB;
constexpr size_t WS_PROJ = 96 * MiB;
constexpr size_t WS_ATT = 224 * MiB;
constexpr size_t WS_H = 96 * MiB;
constexpr size_t PANEL_H_ELEMS = (size_t)256 * DFF, PANEL_M_ELEMS = (size_t)256 * DM;
constexpr size_t WS_END = 256 * MiB;
#define MK_HYBRID 0
namespace pg8 {
#define PG8_LAS __attribute__((address_space(3)))
typedef short bf16x8 __attribute__((ext_vector_type(8)));
typedef float f32x4 __attribute__((ext_vector_type(4)));
typedef unsigned u32x4 __attribute__((ext_vector_type(4)));
typedef unsigned u32x2 __attribute__((ext_vector_type(2)));
constexpr int BM = 256, BK = 64, HALF = 128, HTB = HALF * BK * 2  , STAGE_BYTES = 8 * HTB, NXCD = 8, WGM = 8;

__host__ __device__ __forceinline__ int lds_byte(int r, int c) { const int st = (r >> 4) * 2 + (c >> 5), rr = r & 15, cc = c & 31, ob = rr * 64 + cc * 2; return st * 1024 + (ob ^ (((ob >> 9) & 1) << 5)); }
__host__ __device__ __forceinline__ void stage_rc(int b, int& R, int& C) { const int st = b / 1024, sb = b % 1024, swz = sb ^ (((sb >> 9) & 1) << 5); R = (st >> 1) * 16 + swz / 64; C = (st & 1) * 32 + (swz % 64) / 2; }
__host__ __device__ __forceinline__ int perm32(int rho) { const int n = rho >> 4, i = rho & 15; return 8 * (i >> 2) + 4 * n + (i & 3); }

struct Unit { int pm, pn; };
struct Gemm { const bf16_t* A; const bf16_t* Bt; int lda, ldb, K; };

struct StaticOrder {
    int nM, nN, nwg, G, c;
    __host__ __device__ void init(int M, int N, int G_, int c_) { nM = M / BM; nN = N / BM; nwg = nM * nN; G = G_; c = c_; }
    __host__ __device__ bool next(int i, Unit& u) const {
        const long L = (long)i * G + c; if (L >= nwg) return false;
        int wgid = (int)L; { const int q = nwg / NXCD, r = nwg % NXCD, xcd = wgid % NXCD, off = wgid / NXCD; wgid = (xcd < r ? xcd * (q + 1) : r * (q + 1) + (xcd - r) * q) + off; }
        const int nig = WGM * nN, gid = wgid / nig, fm = gid * WGM, gsz = (nM - fm) < WGM ? (nM - fm) : WGM;
        u.pm = fm + ((wgid % nig) % gsz); u.pn = (wgid % nig) / gsz; return true;
    }
    __device__ __forceinline__ void a_ready(const Unit&) const {}
    __device__ __forceinline__ void done(const Unit&) const {}
};
struct OneUnit {
    int pm, pn; bool has;
    __device__ __forceinline__ bool next(int i, Unit& u) const { if (i != 0 || !has) return false; u.pm = pm; u.pn = pn; return true; }
    __device__ __forceinline__ void a_ready(const Unit&) const {}
    __device__ __forceinline__ void done(const Unit&) const {}
};

__device__ __forceinline__ float relu1(float x) { float r; asm("v_max_f32 %0, 0, %1" : "=v"(r) : "v"(x)); return r; }
__device__ __forceinline__ unsigned cvt_pk_bf16(float lo, float hi) { unsigned r; asm volatile("v_cvt_pk_bf16_f32 %0, %1, %2" : "=v"(r) : "v"(lo), "v"(hi)); return r; }
__device__ __forceinline__ float xsum_fq(float s) {
    const auto a = __builtin_amdgcn_permlane16_swap(__float_as_uint(s), __float_as_uint(s), false, false);
    s = __uint_as_float(a[0]) + __uint_as_float(a[1]);
    const auto b = __builtin_amdgcn_permlane32_swap(__float_as_uint(s), __float_as_uint(s), false, false);
    return __uint_as_float(b[0]) + __uint_as_float(b[1]);
}
__device__ __forceinline__ float xchg16(float v, int fq) {
    const auto a = __builtin_amdgcn_permlane16_swap(__float_as_uint(v), __float_as_uint(v), false, false);
    return (fq & 1) ? __uint_as_float(a[0]) : __uint_as_float(a[1]);
}
#define PG8_LBAR() do { asm volatile("s_waitcnt lgkmcnt(0)" ::: "memory"); __builtin_amdgcn_s_barrier(); asm volatile("" ::: "memory"); } while (0)

template <int MODE> struct EpiStore {
    static constexpr bool PERM = true, AFTER_DRAIN = false, LDSRES = false;
    bf16_t* O; int ldc; const float* SS;
    __device__ __forceinline__ void operator()(const f32x4 (&acc)[2][2][4][2], const Unit& u, int wr, int wc, int fr, int fq) const {
        const int row0 = u.pm * BM + wr * 64 + fr, col0 = u.pn * BM + wc * 32 + 8 * fq;
#pragma unroll
        for (int ai = 0; ai < 2; ++ai)
#pragma unroll
            for (int m = 0; m < 4; ++m) { const int row = row0 + ai * HALF + m * 16; float rs = 1.f;
                if (MODE == 2) { const f32x4 s = *(const f32x4*)(SS + (size_t)row * 4); rs = rsqrtf(((s[0] + s[1]) + (s[2] + s[3])) * (1.f / DM) + EPS); }
                bf16_t* rowp = O + (size_t)row * ldc + col0;
#pragma unroll
                for (int bj = 0; bj < 2; ++bj) { f32x4 v0 = acc[ai][bj][m][0], v1 = acc[ai][bj][m][1];
                    if (MODE == 2) { v0 = v0 * rs; v1 = v1 * rs; }
                    if (MODE == 3) {
#pragma unroll
                        for (int e = 0; e < 4; ++e) { const float a = relu1(v0[e]), b = relu1(v1[e]); v0[e] = a * a; v1[e] = b * b; } }
                    u32x4 w; w.x = cvt_pk_bf16(v0[0], v0[1]); w.y = cvt_pk_bf16(v0[2], v0[3]); w.z = cvt_pk_bf16(v1[0], v1[1]); w.w = cvt_pk_bf16(v1[2], v1[3]);
                    *(u32x4*)(rowp + bj * HALF) = w; } }
    }
};
struct EpiProj {
    static constexpr bool PERM = true, AFTER_DRAIN = false, LDSRES = false;
    bf16_t* O; const float* QKW; const float* ROPE;
    const PG8_LAS float* QL; const PG8_LAS float* RL;
    __device__ __forceinline__ void operator()(const f32x4 (&acc)[2][2][4][2], const Unit& u, int wr, int wc, int fr, int fq) const {
        const int sec = u.pn >> 1, row0 = u.pm * BM + wr * 64 + fr, col0 = u.pn * BM + wc * 64 + 8 * fq;
        if (sec == 2 || sec == 5) {
#pragma unroll
            for (int ai = 0; ai < 2; ++ai)
#pragma unroll
                for (int m = 0; m < 4; ++m) { bf16_t* rowp = O + (size_t)(row0 + ai * HALF + m * 16) * NPROJ + col0;
#pragma unroll
                    for (int bj = 0; bj < 2; ++bj) { const f32x4 v0 = acc[ai][bj][m][0], v1 = acc[ai][bj][m][1];
                        u32x4 w; w.x = cvt_pk_bf16(v0[0], v0[1]); w.y = cvt_pk_bf16(v0[2], v0[3]); w.z = cvt_pk_bf16(v1[0], v1[1]); w.w = cvt_pk_bf16(v1[2], v1[3]);
                        *(u32x4*)(rowp + bj * 32) = w; } }
            return;
        }
        const PG8_LAS float* w = QL + 64 * (sec < 2 ? sec : sec - 1);
        const float sc = (sec == 0 || sec == 3) ? C2 : 1.f; const bool rope = sec < 2;
        f32x4 g[2][2];
#pragma unroll
        for (int bj = 0; bj < 2; ++bj)
#pragma unroll
            for (int n = 0; n < 2; ++n) g[bj][n] = *(const PG8_LAS f32x4*)(w + 32 * bj + 8 * fq + 4 * n);
        const float sgn = fq == 0 ? -1.f : 1.f; const bool rl = fq < 2;
#pragma unroll
        for (int ai = 0; ai < 2; ++ai)
#pragma unroll
            for (int m = 0; m < 4; ++m) { const int row = row0 + ai * HALF + m * 16; float ss = 0.f;
#pragma unroll
                for (int bj = 0; bj < 2; ++bj)
#pragma unroll
                    for (int n = 0; n < 2; ++n) { const f32x4 a = acc[ai][bj][m][n]; ss += (a[0] * a[0] + a[1] * a[1]) + (a[2] * a[2] + a[3] * a[3]); }
                ss = xsum_fq(ss);
                const float rstd = rsqrtf(ss * (1.f / 64.f) + EPS) * sc;
                f32x4 v[2][2];
#pragma unroll
                for (int bj = 0; bj < 2; ++bj)
#pragma unroll
                    for (int n = 0; n < 2; ++n) v[bj][n] = acc[ai][bj][m][n] * rstd * g[bj][n];
                if (rope) {
#pragma unroll
                    for (int n = 0; n < 2; ++n) { f32x4 pr;
#pragma unroll
                        for (int e = 0; e < 4; ++e) pr[e] = xchg16(v[0][n][e], fq);
                        const int rl_ = wr * 64 + fr + ai * HALF + m * 16;
                        const f32x4 c = *(const PG8_LAS f32x4*)(RL + rl_ * 16 + 4 * n), s = *(const PG8_LAS f32x4*)(RL + rl_ * 16 + 8 + 4 * n);
                        const f32x4 r = v[0][n] * c + pr * s * sgn;
                        if (rl) v[0][n] = r; }
                }
                bf16_t* rowp = O + (size_t)row * NPROJ + col0;
#pragma unroll
                for (int bj = 0; bj < 2; ++bj) { u32x4 wv; wv.x = cvt_pk_bf16(v[bj][0][0], v[bj][0][1]); wv.y = cvt_pk_bf16(v[bj][0][2], v[bj][0][3]); wv.z = cvt_pk_bf16(v[bj][1][0], v[bj][1][1]); wv.w = cvt_pk_bf16(v[bj][1][2], v[bj][1][3]);
                    *(u32x4*)(rowp + bj * 32) = wv; } }
    }
};
template <int MODE> struct EpiResid {
    static constexpr bool PERM = true, AFTER_DRAIN = true, LDSRES = (MODE != 2);
    const float* xf; bf16_t* xb; float* outf; float* SS;
    __device__ __forceinline__ const char* res_base(const Unit& u) const { return (const char*)(xb + (size_t)(u.pm * BM) * DM + u.pn * BM); }
    __device__ __forceinline__ void fused(f32x4 (&acc)[2][2][4][2], const Unit& u, int wr, int wc, int fr, int fq, PG8_LAS unsigned char* lds, int wid, int lane) const {
        PG8_LAS float* P = (PG8_LAS float*)(LDSRES ? lds + 131072 : lds);
        const int col0 = u.pn * BM + wc * 32 + 8 * fq;
        const bool miss = LDSRES && (wc >> 1) == 1; u32x4 gm[4];
        if (miss) {
#pragma unroll
            for (int m = 0; m < 4; ++m) gm[m] = *(const u32x4*)(xb + (size_t)(u.pm * BM + HALF + wr * 64 + m * 16 + fr) * DM + col0); }
#pragma unroll
        for (int ai = 0; ai < 2; ++ai)
#pragma unroll
            for (int m = 0; m < 4; ++m) { const int r = ai * HALF + wr * 64 + m * 16 + fr; const size_t off = (size_t)(u.pm * BM + r) * DM + col0; float s = 0.f;
                const float rsc = MODE == 0 ? xf[u.pm * BM + r] : 1.f; float r2 = 1.f;
                if (MODE == 2) { const f32x4 q = *(const f32x4*)(SS + (size_t)(u.pm * BM + r) * 4); r2 = __builtin_amdgcn_rcpf(((q[0] + q[1]) + (q[2] + q[3])) * (1.f / DM) + EPS); }
#pragma unroll
                for (int bj = 0; bj < 2; ++bj) { f32x4 b0, b1;
                    { u32x4 w;
                      if (!LDSRES) w = *(const u32x4*)(xb + off + bj * HALF);
                      else { const int cb = 2 * bj + (wc >> 1), cin = (wc & 1) * 32 + 8 * fq, rh = wr * 64 + m * 16 + fr;
                          if (cb == 1 && ai == 1) w = gm[m];
                          else { const int buf = cb == 0 ? ai : cb == 1 ? 2 : cb == 2 ? 4 + ai : 6 + ai;
                              const int s5 = rh & 31, slot = cb >= 2 ? (rh & ~31) + 16 * ((s5 >> 2) & 1) + 4 * (s5 >> 3) + (s5 & 3) : rh;
                              w = *(const PG8_LAS u32x4*)(lds + buf * HTB + lds_byte(slot, cin)); } }
                        b0 = (f32x4){__uint_as_float(w.x << 16), __uint_as_float(w.x & 0xffff0000u), __uint_as_float(w.y << 16), __uint_as_float(w.y & 0xffff0000u)};
                        b1 = (f32x4){__uint_as_float(w.z << 16), __uint_as_float(w.z & 0xffff0000u), __uint_as_float(w.w << 16), __uint_as_float(w.w & 0xffff0000u)}; }
                    const f32x4 o0 = MODE == 2 ? acc[ai][bj][m][0] * r2 + b0 : b0 * rsc + acc[ai][bj][m][0], o1 = MODE == 2 ? acc[ai][bj][m][1] * r2 + b1 : b1 * rsc + acc[ai][bj][m][1];
                    if (MODE == 2) { __builtin_nontemporal_store(o0, (f32x4*)(outf + off + bj * HALF)); __builtin_nontemporal_store(o1, (f32x4*)(outf + off + bj * HALF + 4)); }
                    else { u32x4 w; w.x = cvt_pk_bf16(o0[0], o0[1]); w.y = cvt_pk_bf16(o0[2], o0[3]); w.z = cvt_pk_bf16(o1[0], o1[1]); w.w = cvt_pk_bf16(o1[2], o1[3]); *(u32x4*)(xb + off + bj * HALF) = w;
                        s += ((o0[0] * o0[0] + o0[1] * o0[1]) + (o0[2] * o0[2] + o0[3] * o0[3])) + ((o1[0] * o1[0] + o1[1] * o1[1]) + (o1[2] * o1[2] + o1[3] * o1[3])); } }
                if (MODE != 2) { s = xsum_fq(s); if (fq == 0) P[r * 4 + wc] = s; }
            }
        if (MODE != 2) { PG8_LBAR();
            const int t = wid * 64 + lane; if (t < 256) { const f32x4 p = *(const PG8_LAS f32x4*)(P + t * 4); SS[(size_t)(u.pm * BM + t) * 4 + u.pn] = (p[0] + p[1]) + (p[2] + p[3]); } }
    }
};
struct EpiHeadNormK {
    static constexpr bool PERM = true, AFTER_DRAIN = true, LDSRES = false;
    bf16_t* MKn; const float* kw; const float* qw;
    __device__ __forceinline__ void fused(f32x4 (&acc)[2][2][4][2], const Unit& u, int wr, int wc, int fr, int fq, PG8_LAS unsigned char* lds, int wid, int lane) const {
        PG8_LAS float* P = (PG8_LAS float*)lds; PG8_LAS float* R = (PG8_LAS float*)(lds + 4096);
#pragma unroll
        for (int ai = 0; ai < 2; ++ai)
#pragma unroll
            for (int m = 0; m < 4; ++m) { float s = 0.f;
#pragma unroll
                for (int bj = 0; bj < 2; ++bj)
#pragma unroll
                    for (int n = 0; n < 2; ++n) { const f32x4 v = acc[ai][bj][m][n]; s += (v[0] * v[0] + v[1] * v[1]) + (v[2] * v[2] + v[3] * v[3]); }
                s = xsum_fq(s); if (fq == 0) P[(ai * HALF + wr * 64 + m * 16 + fr) * 4 + wc] = s; }
        PG8_LBAR();
        { const int t = wid * 64 + lane; if (t < 256) { const f32x4 p = *(const PG8_LAS f32x4*)(P + t * 4); R[t] = rsqrtf(((p[0] + p[1]) + (p[2] + p[3])) * (1.f / 256.f) + EPS); } }
        PG8_LBAR();
        const int c0 = wc * 32 + 8 * fq; f32x4 g[2][2];
#pragma unroll
        for (int bj = 0; bj < 2; ++bj)
#pragma unroll
            for (int n = 0; n < 2; ++n) { const f32x4 a = *(const f32x4*)(kw + c0 + bj * HALF + 4 * n), b = *(const f32x4*)(qw + c0 + bj * HALF + 4 * n); g[bj][n] = a * b * CM; }
        bf16_t* basep = MKn + (size_t)(u.pm * 4 + u.pn) * 65536;
#pragma unroll
        for (int ai = 0; ai < 2; ++ai)
#pragma unroll
            for (int m = 0; m < 4; ++m) { const int r = ai * HALF + wr * 64 + m * 16 + fr; const float rk = R[r];
#pragma unroll
                for (int bj = 0; bj < 2; ++bj) { const f32x4 v0 = acc[ai][bj][m][0] * rk * g[bj][0], v1 = acc[ai][bj][m][1] * rk * g[bj][1];
                    u32x4 w; w.x = cvt_pk_bf16(v0[0], v0[1]); w.y = cvt_pk_bf16(v0[2], v0[3]); w.z = cvt_pk_bf16(v1[0], v1[1]); w.w = cvt_pk_bf16(v1[2], v1[3]);
                    *(u32x4*)(basep + (size_t)r * 256 + c0 + bj * HALF) = w; } }
    }
};
struct EpiMemQ {
    static constexpr bool PERM = true, AFTER_DRAIN = true, LDSRES = false;
    bf16_t* MQ; const float* SS; PG8_LAS float* RQ; const unsigned* gate; unsigned need; const PG8_LAS float* SSL;
    __device__ __forceinline__ void fused(f32x4 (&acc)[2][2][4][2], const Unit& u, int wr, int wc, int fr, int fq, PG8_LAS unsigned char* lds, int wid, int lane) const {
        PG8_LAS float* P = (PG8_LAS float*)lds;
        if (((volatile PG8_LAS unsigned*)(lds + 159040))[14] < need) {
            if (wid == 0 && lane == 0) { unsigned sp_ = 0; while (__hip_atomic_load(gate, __ATOMIC_RELAXED, __HIP_MEMORY_SCOPE_AGENT) < need && ++sp_ < (1u << 22)) __builtin_amdgcn_s_sleep(2); }
            PG8_LBAR(); }
        const int col0 = u.pn * BM + wc * 32 + 8 * fq;
#pragma unroll
        for (int ai = 0; ai < 2; ++ai)
#pragma unroll
            for (int m = 0; m < 4; ++m) { const int r = ai * HALF + wr * 64 + m * 16 + fr; const int row = u.pm * BM + r;
                const f32x4 ss = SSL ? *(const PG8_LAS f32x4*)(SSL + r * 4) : *(const f32x4*)(SS + (size_t)row * 4); const float rs = rsqrtf(((ss[0] + ss[1]) + (ss[2] + ss[3])) * (1.f / DM) + EPS); float s = 0.f;
#pragma unroll
                for (int bj = 0; bj < 2; ++bj) { const f32x4 v0 = acc[ai][bj][m][0] * rs, v1 = acc[ai][bj][m][1] * rs;
                    s += (v0[0] * v0[0] + v0[1] * v0[1]) + (v0[2] * v0[2] + v0[3] * v0[3]) + (v1[0] * v1[0] + v1[1] * v1[1]) + (v1[2] * v1[2] + v1[3] * v1[3]);
                    u32x4 w; w.x = cvt_pk_bf16(v0[0], v0[1]); w.y = cvt_pk_bf16(v0[2], v0[3]); w.z = cvt_pk_bf16(v1[0], v1[1]); w.w = cvt_pk_bf16(v1[2], v1[3]);
                    *(u32x4*)(MQ + (size_t)row * DM + col0 + bj * HALF) = w; }
                s = xsum_fq(s); if (fq == 0) P[r * 4 + wc] = s; }
        PG8_LBAR();
        { const int t = wid * 64 + lane; if (t < 256) { const f32x4 p = *(const PG8_LAS f32x4*)(P + t * 4); RQ[t] = rsqrtf(((p[0] + p[1]) + (p[2] + p[3])) * (1.f / 256.f) + EPS); } }
        PG8_LBAR();
    }
};
struct EpiMemS {
    static constexpr bool PERM = true, AFTER_DRAIN = true, LDSRES = false;
    bf16_t* Pt; int head; const PG8_LAS float* RQ; PG8_LAS float* IL;
    __device__ __forceinline__ void fused(f32x4 (&acc)[2][2][4][2], const Unit& u, int wr, int wc, int fr, int fq, PG8_LAS unsigned char* lds, int wid, int lane) const {
        PG8_LAS float* P = (PG8_LAS float*)lds;
        const int col0 = head * BM + wc * 32 + 8 * fq;
#pragma unroll
        for (int ai = 0; ai < 2; ++ai)
#pragma unroll
            for (int m = 0; m < 4; ++m) { const int r = ai * HALF + wr * 64 + m * 16 + fr; const int row = u.pm * BM + r; const float rq = RQ[r]; float s = 0.f;
#pragma unroll
                for (int bj = 0; bj < 2; ++bj) { f32x4 v0 = acc[ai][bj][m][0] * rq, v1 = acc[ai][bj][m][1] * rq;
#pragma unroll
                    for (int e = 0; e < 4; ++e) { v0[e] = __builtin_amdgcn_exp2f(v0[e]); v1[e] = __builtin_amdgcn_exp2f(v1[e]); }
                    s += (v0[0] + v0[1]) + (v0[2] + v0[3]) + (v1[0] + v1[1]) + (v1[2] + v1[3]);
                    u32x4 w; w.x = cvt_pk_bf16(v0[0], v0[1]); w.y = cvt_pk_bf16(v0[2], v0[3]); w.z = cvt_pk_bf16(v1[0], v1[1]); w.w = cvt_pk_bf16(v1[2], v1[3]);
                    *(u32x4*)(Pt + (size_t)row * DM + col0 + bj * HALF) = w; }
                s = xsum_fq(s); if (fq == 0) P[r * 4 + wc] = s; }
        PG8_LBAR();
        { const int t = wid * 64 + lane; if (t < 256) { const f32x4 p = *(const PG8_LAS f32x4*)(P + t * 4); IL[t] = 1.0f / ((p[0] + p[1]) + (p[2] + p[3])); } }
        PG8_LBAR();
    }
};
struct EpiMemPV {
    static constexpr bool PERM = true, AFTER_DRAIN = false, LDSRES = false;
    bf16_t* MO; int head; const PG8_LAS float* IL;
    __device__ __forceinline__ void operator()(const f32x4 (&acc)[2][2][4][2], const Unit& u, int wr, int wc, int fr, int fq) const {
        const int col0 = head * BM + wc * 32 + 8 * fq;
#pragma unroll
        for (int ai = 0; ai < 2; ++ai)
#pragma unroll
            for (int m = 0; m < 4; ++m) { const int r = ai * HALF + wr * 64 + m * 16 + fr; const int row = u.pm * BM + r; const float il = IL[r];
#pragma unroll
                for (int bj = 0; bj < 2; ++bj) { const f32x4 v0 = acc[ai][bj][m][0] * il, v1 = acc[ai][bj][m][1] * il;
                    u32x4 w; w.x = cvt_pk_bf16(v0[0], v0[1]); w.y = cvt_pk_bf16(v0[2], v0[3]); w.z = cvt_pk_bf16(v1[0], v1[1]); w.w = cvt_pk_bf16(v1[2], v1[3]);
                    *(u32x4*)(MO + (size_t)row * DM + col0 + bj * HALF) = w; } }
    }
};

template <class Epi, class Sched, bool ALIGN_EPI = false, bool SP2 = false>
__device__ __forceinline__ void gemm_phase(PG8_LAS unsigned char* lds, const Gemm g, const Sched& S, const Epi& E) {
    int tid_ = threadIdx.x; asm volatile("" : "+v"(tid_));
    const int tid = tid_, wid = __builtin_amdgcn_readfirstlane(tid >> 6), lane = tid & 63, wr = wid >> 2, wc = wid & 3, fr = lane & 15, fq = lane >> 4;
    const int K = g.K, nt = K / BK;
    unsigned voffA[2], voffB[2];
#pragma unroll
    for (int i = 0; i < 2; ++i) { int R, C; stage_rc(tid * 16 + i * 8192, R, C); const int Rb = Epi::PERM ? ((R & ~31) + perm32(R & 31)) : R;
        voffA[i] = (unsigned)(R * g.lda + C) * 2u; voffB[i] = (unsigned)(Rb * g.ldb + C) * 2u; }
    const size_t kstep = (size_t)(BK * 2);
    const size_t hsA = (size_t)HALF * g.lda * 2, hsB = (size_t)HALF * g.ldb * 2;
    const size_t tsA = 2 * hsA, tsB = 2 * hsB;
    const unsigned ldsw = (unsigned)wid * 1024u;
    const int aoff = lds_byte(wr * 64 + fr, fq * 8), boff = lds_byte(wc * 32 + fr, fq * 8);
#define PG8_SA(b, h) (((b) * 2 + (h)) * HTB)
#define PG8_SB(b, h) ((4 + (b) * 2 + (h)) * HTB)
#define PG8_STAGE(bufoff, gbase, voff) do { _Pragma("unroll") for (int _i = 0; _i < 2; ++_i) \
        __builtin_amdgcn_global_load_lds((const unsigned*)((const char*)(gbase) + (voff)[_i]), (PG8_LAS unsigned*)(lds + (bufoff) + ldsw + _i * 8192), 16, 0, 0); } while (0)
#define PG8_LDA(dst, b, h) do { _Pragma("unroll") for (int m = 0; m < 4; ++m) _Pragma("unroll") for (int k = 0; k < 2; ++k) dst[m][k] = *(const PG8_LAS bf16x8*)(lds + PG8_SA(b, h) + aoff + m * 2048 + k * 1024); } while (0)
#define PG8_LDB(dst, b, h) do { _Pragma("unroll") for (int n = 0; n < 2; ++n) _Pragma("unroll") for (int k = 0; k < 2; ++k) dst[n][k] = *(const PG8_LAS bf16x8*)(lds + PG8_SB(b, h) + boff + n * 2048 + k * 1024); } while (0)
#define PG8_MMA(ai, bj, At, Bt) do { __builtin_amdgcn_s_setprio(1); _Pragma("unroll") for (int m = 0; m < 4; ++m) _Pragma("unroll") for (int n = 0; n < 2; ++n) _Pragma("unroll") for (int k = 0; k < 2; ++k) \
        acc[ai][bj][m][n] = __builtin_amdgcn_mfma_f32_16x16x32_bf16(Bt[n][k], At[m][k], acc[ai][bj][m][n], 0, 0, 0); __builtin_amdgcn_s_setprio(0); } while (0)
#define PG8_WAIT_V(n) asm volatile("s_waitcnt vmcnt(" #n ")" ::: "memory")
#define PG8_WAIT_L(n) asm volatile("s_waitcnt lgkmcnt(" #n ")" ::: "memory")
#define PG8_BAR __builtin_amdgcn_s_barrier()
#define PG8_SCHED __builtin_amdgcn_sched_barrier(0)
    Unit cur, nxt; int ui = 0;
    if (!S.next(0, cur)) return;
    f32x4 acc[2][2][4][2];
#pragma unroll
    for (int a = 0; a < 2; ++a)
#pragma unroll
        for (int b = 0; b < 2; ++b)
#pragma unroll
            for (int m = 0; m < 4; ++m)
#pragma unroll
                for (int n = 0; n < 2; ++n) acc[a][b][m][n] = (f32x4){0.f, 0.f, 0.f, 0.f};
    bf16x8 At[4][2], B0[2][2], B1[2][2];
    const char* cA = (const char*)g.A + (size_t)cur.pm * tsA; const char* cB = (const char*)g.Bt + (size_t)cur.pn * tsB;
    S.a_ready(cur);
    if constexpr (SP2) {
        PG8_STAGE(PG8_SB(0, 0), cB, voffB); PG8_STAGE(PG8_SB(0, 1), cB + hsB, voffB); PG8_STAGE(PG8_SA(0, 0), cA, voffA); PG8_STAGE(PG8_SA(0, 1), cA + hsA, voffA);
        if (wr == 1) PG8_BAR;
        PG8_WAIT_V(2); PG8_BAR;
        PG8_STAGE(PG8_SB(1, 0), cB + kstep, voffB); PG8_STAGE(PG8_SA(1, 0), cA + kstep, voffA); PG8_STAGE(PG8_SB(1, 1), cB + hsB + kstep, voffB);
        PG8_WAIT_V(6); PG8_BAR;
    } else {
        PG8_STAGE(PG8_SB(0, 0), cB, voffB); PG8_STAGE(PG8_SA(0, 0), cA, voffA); PG8_STAGE(PG8_SB(0, 1), cB + hsB, voffB); PG8_STAGE(PG8_SA(0, 1), cA + hsA, voffA);
        if (wr == 1) PG8_BAR;
        PG8_WAIT_V(4); PG8_BAR;
        PG8_STAGE(PG8_SB(1, 0), cB + kstep, voffB); PG8_STAGE(PG8_SA(1, 0), cA + kstep, voffA); PG8_STAGE(PG8_SB(1, 1), cB + hsB + kstep, voffB);
        PG8_WAIT_V(6); PG8_BAR;
    }
    for (;;) {
        const bool has_next = S.next(ui + 1, nxt);
        const char* nA = has_next ? (const char*)g.A + (size_t)nxt.pm * tsA : cA; const char* nB = has_next ? (const char*)g.Bt + (size_t)nxt.pn * tsB : cB;
        if constexpr (Epi::LDSRES) { if (!has_next) { nA = E.res_base(cur); nB = nA + 256; } }
        for (int t = 0; t < nt; t += 2) {
            const bool last = (t == nt - 2);
            const char* a1 = cA + (size_t)(t + 1) * kstep;
            const char* a2 = last ? nA : cA + (size_t)(t + 2) * kstep; const char* b2 = last ? nB : cB + (size_t)(t + 2) * kstep;
            const char* a3 = a2 + kstep; const char* b3 = b2 + kstep;
            if (last && has_next) S.a_ready(nxt);
            if constexpr (SP2) {
            PG8_LDB(B0, 0, 0); PG8_LDB(B1, 0, 1); PG8_SCHED; PG8_LDA(At, 0, 0); PG8_STAGE(PG8_SA(1, 1), a1 + hsA, voffA);
            PG8_WAIT_V(8); PG8_WAIT_L(0); PG8_BAR; PG8_MMA(0, 0, At, B0); PG8_MMA(0, 1, At, B1); PG8_BAR; PG8_SCHED;
            PG8_LDA(At, 0, 1); PG8_STAGE(PG8_SB(0, 0), b2, voffB); PG8_STAGE(PG8_SB(0, 1), b2 + hsB, voffB); PG8_STAGE(PG8_SA(0, 0), a2, voffA);
            PG8_WAIT_V(8); PG8_WAIT_L(0); PG8_BAR; PG8_MMA(1, 0, At, B0); PG8_MMA(1, 1, At, B1); PG8_BAR; PG8_SCHED;
            PG8_LDB(B0, 1, 0); PG8_LDB(B1, 1, 1); PG8_SCHED; PG8_LDA(At, 1, 0); PG8_STAGE(PG8_SA(0, 1), a2 + hsA, voffA);
            PG8_WAIT_V(8); PG8_WAIT_L(0); PG8_BAR; PG8_MMA(0, 0, At, B0); PG8_MMA(0, 1, At, B1); PG8_BAR; PG8_SCHED;
            PG8_LDA(At, 1, 1); PG8_STAGE(PG8_SB(1, 0), b3, voffB); PG8_STAGE(PG8_SB(1, 1), b3 + hsB, voffB); PG8_STAGE(PG8_SA(1, 0), a3, voffA);
            PG8_WAIT_V(8); PG8_WAIT_L(0); PG8_BAR; PG8_MMA(1, 0, At, B0); PG8_MMA(1, 1, At, B1); PG8_BAR; PG8_SCHED;
            } else {
            PG8_LDB(B0, 0, 0); PG8_SCHED; PG8_LDA(At, 0, 0); PG8_STAGE(PG8_SA(1, 1), a1 + hsA, voffA);
            PG8_WAIT_L(8); PG8_BAR; PG8_WAIT_L(0); PG8_MMA(0, 0, At, B0); PG8_BAR; PG8_SCHED;
            PG8_LDB(B1, 0, 1); PG8_STAGE(PG8_SB(0, 0), b2, voffB);
            PG8_BAR; PG8_WAIT_L(0); PG8_MMA(0, 1, At, B1); PG8_BAR;
            PG8_LDA(At, 0, 1); PG8_STAGE(PG8_SA(0, 0), a2, voffA);
            PG8_BAR; PG8_WAIT_L(0); PG8_MMA(1, 0, At, B0); PG8_BAR; PG8_SCHED;
            PG8_STAGE(PG8_SB(0, 1), b2 + hsB, voffB);
            PG8_WAIT_V(6); PG8_BAR; PG8_MMA(1, 1, At, B1); PG8_BAR;
            PG8_LDB(B0, 1, 0); PG8_SCHED; PG8_LDA(At, 1, 0); PG8_STAGE(PG8_SA(0, 1), a2 + hsA, voffA);
            PG8_WAIT_L(8); PG8_BAR; PG8_WAIT_L(0); PG8_MMA(0, 0, At, B0); PG8_BAR; PG8_SCHED;
            PG8_LDB(B1, 1, 1); PG8_STAGE(PG8_SB(1, 0), b3, voffB);
            PG8_BAR; PG8_WAIT_L(0); PG8_MMA(0, 1, At, B1); PG8_BAR;
            PG8_LDA(At, 1, 1); PG8_STAGE(PG8_SA(1, 0), a3, voffA);
            PG8_BAR; PG8_WAIT_L(0); PG8_MMA(1, 0, At, B0); PG8_BAR; PG8_SCHED;
            PG8_STAGE(PG8_SB(1, 1), b3 + hsB, voffB);
            PG8_WAIT_V(6); PG8_BAR; PG8_MMA(1, 1, At, B1); PG8_BAR;
            }
        }
        if constexpr (ALIGN_EPI) { if (wr == 0) PG8_BAR; }
        if constexpr (!Epi::AFTER_DRAIN) { int fr2 = fr, fq2 = fq; asm volatile("" : "+v"(fr2), "+v"(fq2)); E(acc, cur, wr, wc, fr2, fq2); S.done(cur); }
        if (!has_next) break;
#pragma unroll
        for (int a = 0; a < 2; ++a)
#pragma unroll
            for (int b = 0; b < 2; ++b)
#pragma unroll
                for (int m = 0; m < 4; ++m)
#pragma unroll
                    for (int n = 0; n < 2; ++n) acc[a][b][m][n] = (f32x4){0.f, 0.f, 0.f, 0.f};
        cur = nxt; cA = nA; cB = nB; ++ui;
        if constexpr (ALIGN_EPI) { if (wr == 1) PG8_BAR; }
    }
    PG8_WAIT_V(0);
    if constexpr (!ALIGN_EPI) { if (wr == 0) PG8_BAR; }
    PG8_BAR;
    if constexpr (Epi::AFTER_DRAIN) { int fr2 = fr, fq2 = fq, lane2 = lane; asm volatile("" : "+v"(fr2), "+v"(fq2), "+v"(lane2)); E.fused(acc, cur, wr, wc, fr2, fq2, lds, wid, lane2); S.done(cur); }
#undef PG8_SA
#undef PG8_SB
#undef PG8_STAGE
#undef PG8_LDA
#undef PG8_LDB
#undef PG8_MMA
#undef PG8_WAIT_V
#undef PG8_WAIT_L
#undef PG8_BAR
#undef PG8_SCHED
}}

#define GAS __attribute__((address_space(1)))
#define LAS __attribute__((address_space(3)))
typedef unsigned v4u __attribute__((ext_vector_type(4)));
typedef float f32x4 __attribute__((ext_vector_type(4)));
typedef short bf16x8 __attribute__((ext_vector_type(8)));
typedef GAS unsigned gu32;
typedef GAS unsigned long long gu64;
#define RLX_AGENT __ATOMIC_RELAXED, __HIP_MEMORY_SCOPE_AGENT
#define LDS_WAIT() asm volatile("s_waitcnt lgkmcnt(0)" ::: "memory")
#define VM_WAIT() asm volatile("s_waitcnt vmcnt(0)" ::: "memory")
__device__ __forceinline__ unsigned long long rt() { return __builtin_amdgcn_s_memrealtime(); }
__device__ __forceinline__ unsigned pk2(float lo, float hi) { typedef float f2_ __attribute__((ext_vector_type(2))); typedef __bf16 b2_ __attribute__((ext_vector_type(2))); const f2_ v = {lo, hi}; return __builtin_bit_cast(unsigned, __builtin_convertvector(v, b2_)); }

#define XB_TMO      128
#define XB_XCNT(j)  (256  + 64 * (j))
#define XB_XSUB(j)  (1280 + 64 * (j))
#define XB_XGEN(j)  (2304 + 64 * (j))
#define XB_TOP      3328
#define XB_TOPGEN   3392
#define XL_SUB(j)   (3456 + 64 * (j))
#define XL_GEN(j)   (4480 + 64 * (j))
#define XCD_BAR_WORDS 5504
#define XB_SPIN_CAP (1u << 18)

__device__ __forceinline__ unsigned xb_ld(unsigned* p)              { return __hip_atomic_load(p, __ATOMIC_RELAXED, __HIP_MEMORY_SCOPE_AGENT); }
__device__ __forceinline__ unsigned xb_add(unsigned* p, unsigned v) { return __hip_atomic_fetch_add(p, v, __ATOMIC_RELAXED, __HIP_MEMORY_SCOPE_AGENT); }
__device__ __forceinline__ unsigned xb_xcc_id() { return (unsigned)__builtin_amdgcn_s_getreg((3 << 11) | 20) & 0xFu; }
#define XB_SPIN(cond, bar) do { unsigned _sp = 0; while (cond) { __builtin_amdgcn_s_sleep(1); \
    if ((++_sp & 255u) == 0u) { if (xb_ld(&(bar)[XB_TMO])) break; if (_sp > XB_SPIN_CAP) { atomicAdd(&(bar)[XB_TMO], 1u); break; } } } } while (0)

struct XcdBarrier {
    unsigned* bar; unsigned x;
    volatile LAS unsigned* st;
};

__device__ __forceinline__ XcdBarrier xcd_barrier_post(unsigned* bar, volatile LAS unsigned* st) {
    XcdBarrier b; b.bar = bar; b.x = xb_xcc_id(); b.st = st;
    if (threadIdx.x == 0) st[2] = xb_add(&bar[XB_XCNT(b.x)], 1u);
    return b;
}
__device__ __forceinline__ void xcd_barrier_complete(unsigned* bar, unsigned x, unsigned& nloc, unsigned& nx) {
    const unsigned G = gridDim.x * gridDim.y * gridDim.z;
    unsigned sum, cnt, mine, sp = 0u;
    for (;;) {
        sum = 0u; cnt = 0u; mine = 0u;
#pragma unroll
        for (unsigned j = 0; j < 16; ++j) { const unsigned c = xb_ld(&bar[XB_XCNT(j)]); sum += c; cnt += (c > 0u) ? 1u : 0u; mine = (j == x) ? c : mine; }
        if (sum == G) break;
        __builtin_amdgcn_s_sleep(1);
        if ((++sp & 255u) == 0u) { if (xb_ld(&bar[XB_TMO])) break; if (sp > XB_SPIN_CAP) { atomicAdd(&bar[XB_TMO], 1u); break; } }
    }
    nloc = mine > 0u ? mine : 1u; nx = cnt > 0u ? cnt : 1u;
}
__device__ __forceinline__ unsigned xcd_census_even(unsigned* bar) {
    unsigned ok = (gridDim.x == 256u) ? 1u : 0u;
#pragma unroll
    for (unsigned j = 0; j < 8; ++j) ok &= (xb_ld(&bar[XB_XCNT(j)]) == 32u) ? 1u : 0u;
    return ok;
}

__device__ __forceinline__ void xcd_barrier(const XcdBarrier& b) {
    asm volatile("s_waitcnt vmcnt(0)" ::: "memory");
    __syncthreads();
    if (threadIdx.x < 64) asm volatile("buffer_inv sc1" ::: "memory");
    if (threadIdx.x == 0) {
        unsigned* bar = b.bar;
        __builtin_amdgcn_s_waitcnt(0);
        unsigned nloc = b.st[0], nx = b.st[1];
        if (nloc == 0u) { xcd_barrier_complete(bar, b.x, nloc, nx); b.st[0] = nloc; b.st[1] = nx; b.st[3] = xcd_census_even(bar); }
        const unsigned old = xb_add(&bar[XB_XSUB(b.x)], 1u);
        const unsigned gen = old / nloc;
        if (old + 1u == (gen + 1u) * nloc) {
            __builtin_amdgcn_fence(__ATOMIC_RELEASE, "agent");
            asm volatile("s_waitcnt vmcnt(0)" ::: "memory");
            const unsigned og = xb_add(&bar[XB_TOP], 1u);
            const unsigned tg = og / nx;
            if (og + 1u == (tg + 1u) * nx) xb_add(&bar[XB_TOPGEN], 1u);
            else XB_SPIN(xb_ld(&bar[XB_TOPGEN]) == tg, bar);
            xb_add(&bar[XB_XGEN(b.x)], 1u);
            asm volatile("s_waitcnt vmcnt(0)" ::: "memory");
        } else {
            XB_SPIN(xb_ld(&bar[XB_XGEN(b.x)]) == gen, bar);
            asm volatile("s_waitcnt vmcnt(0)" ::: "memory");
        }
    }
    __syncthreads();
}

__device__ __forceinline__ void grp_barrier(const XcdBarrier& b, unsigned* cnt, unsigned* sample = nullptr, int slot = 0, unsigned* sample2 = nullptr, int slot2 = 0) {
    asm volatile("s_waitcnt vmcnt(0)" ::: "memory");
    __syncthreads();
    if (threadIdx.x < 64) asm volatile("buffer_inv sc1" ::: "memory");
    if (threadIdx.x == 0) {
        const unsigned old = xb_add(cnt, 1u);
        const unsigned tgt = (old / 4u + 1u) * 4u;
        unsigned s1 = 0u, s2 = 0u; if (sample) s1 = xb_ld(sample); if (sample2) s2 = xb_ld(sample2);
        if (old + 1u != tgt) XB_SPIN(xb_ld(cnt) < tgt, b.bar);
        if (sample) b.st[slot] = s1; if (sample2) b.st[slot2] = s2;
    }
    if (threadIdx.x < 64) asm volatile("s_waitcnt vmcnt(0)" ::: "memory");
    __syncthreads();
}
__device__ __forceinline__ void xcc_barrier(const XcdBarrier& b, unsigned* sample = nullptr, int slot = 0) {
    asm volatile("s_waitcnt vmcnt(0)" ::: "memory");
    __syncthreads();
    if (threadIdx.x < 64) asm volatile("buffer_inv sc1" ::: "memory");
    if (threadIdx.x == 0) {
        unsigned* bar = b.bar;
        const unsigned old = xb_add(&bar[XL_SUB(b.x)], 1u);
        const unsigned gen = old / 32u;
        if (old + 1u == (gen + 1u) * 32u) xb_add(&bar[XL_GEN(b.x)], 1u);
        else XB_SPIN(xb_ld(&bar[XL_GEN(b.x)]) == gen, bar);
        if (sample) b.st[slot] = xb_ld(sample);
    }
    if (threadIdx.x < 64) asm volatile("s_waitcnt vmcnt(0)" ::: "memory");
    __syncthreads();
}

constexpr int NWAVES = 8;
constexpr int RING_OFF = 0, RING_BYTES = 131072;
constexpr int LDSCTL_OFF = 158720, MISC_OFF = LDSCTL_OFF + 320;
constexpr int LDS_RQ = LDSCTL_OFF + 1024, LDS_IL = LDSCTL_OFF + 2048;
constexpr int LDS_BYTES = 163840;
constexpr int CW_TMO = 0, CW_BAR = 4096, CW_ATTN = 10048, CW_GRP = 13312;

struct Frame {
    LAS unsigned char* lds; volatile LAS unsigned* MISC; gu32* ctl;
    int tid, lane, wave, vcu, G;
};
struct Args { const void* in[26]; float* out; unsigned char* ws; int ph_lo, ph_hi; };

__device__ __forceinline__ float wave_sum(float v) {
#pragma unroll
    for (int o = 1; o < 64; o <<= 1) v += __shfl_xor(v, o);
    return v;
}
template <bool HEADPERM, bool WT = false> __device__ __forceinline__ void p0_transpose_item(const float* W, int ldw, int K, int N, const float* g, bf16_t* WT_, LAS float* scr, int item, int lane) {
    const int nblk = N / 32, kb = item / nblk, nb = item % nblk, k0 = 64 * kb, n0 = 32 * nb;
    const int r8 = lane >> 3, c4 = (lane & 7) * 4;
    f32x4 v[8]; float gg[8];
#pragma unroll
    for (int i = 0; i < 8; ++i) { v[i] = __builtin_nontemporal_load((const GAS f32x4*)(W + (size_t)(k0 + r8 + 8 * i) * ldw + n0 + c4)); gg[i] = g ? g[k0 + r8 + 8 * i] : 1.f; }
#pragma unroll
    for (int i = 0; i < 8; ++i) { LAS float* d = scr + (r8 + 8 * i) * 33 + c4; const f32x4 x = v[i] * gg[i]; d[0] = x.x; d[1] = x.y; d[2] = x.z; d[3] = x.w; }
    LDS_WAIT(); asm volatile("" ::: "memory");
    const int c = lane & 7;
#pragma unroll
    for (int j = 0; j < 4; ++j) { const int n = (lane >> 3) + 8 * j; const LAS float* s = scr + (8 * c) * 33 + n;
        v4u o; o.x = pk2(s[0 * 33], s[1 * 33]); o.y = pk2(s[2 * 33], s[3 * 33]); o.z = pk2(s[4 * 33], s[5 * 33]); o.w = pk2(s[6 * 33], s[7 * 33]);
        int nr = n0 + n; if (HEADPERM) { const int l = nr & 255; nr = (nr & ~255) | (((l >> 5) & 1) * 128 + (l >> 6) * 32 + (l & 31)); }
        if (WT) { const unsigned long long wb_ = (unsigned long long)WT_; void* const ub_ = (void*)(((unsigned long long)(unsigned)__builtin_amdgcn_readfirstlane((unsigned)(wb_ >> 32)) << 32) | (unsigned long long)(unsigned)__builtin_amdgcn_readfirstlane((unsigned)wb_));
            const __amdgpu_buffer_rsrc_t rs_ = __builtin_amdgcn_make_buffer_rsrc(ub_, (short)0, 0x7fffffff, 0x00020000); __builtin_amdgcn_raw_buffer_store_b128(o, rs_, (int)(((size_t)nr * K + k0 + 8 * c) * 2), 0, 16); }
        else *(GAS v4u*)(WT_ + (size_t)nr * K + k0 + 8 * c) = o; }
    LDS_WAIT(); asm volatile("" ::: "memory");
}
template <bool FLOG> __device__ __forceinline__ void rms_rows_to_bf16(int lane, const float* X, bf16_t* O, int m0, int step, int rows, const float* g, const float* win, float* flog, float* rs0) {
    if (m0 >= rows) return;
    f32x4 wf[4][4][2];
    if (FLOG) {
#pragma unroll
        for (int j = 0; j < 4; ++j) { const f32x4 gg = *(const GAS f32x4*)(g + 256 * j + 4 * lane);
#pragma unroll
            for (int e = 0; e < 4; ++e) { const int k = 256 * j + 4 * lane + e; wf[j][e][0] = *(const GAS f32x4*)(win + (size_t)k * INCOLS + NPROJ) * gg[e]; wf[j][e][1] = *(const GAS f32x4*)(win + (size_t)k * INCOLS + NPROJ + 4) * gg[e]; } }
    }
    f32x4 nx[4], nx2[4];
    { const GAS f32x4* xr = (const GAS f32x4*)(X + (size_t)m0 * DM) + lane;
#pragma unroll
      for (int j = 0; j < 4; ++j) nx[j] = __builtin_nontemporal_load(xr + 64 * j);
      if (m0 + step < rows) { const GAS f32x4* xr2 = (const GAS f32x4*)(X + (size_t)(m0 + step) * DM) + lane;
#pragma unroll
          for (int j = 0; j < 4; ++j) nx2[j] = __builtin_nontemporal_load(xr2 + 64 * j); } }
    for (int m = m0; m < rows; m += step) {
        f32x4 v[4];
#pragma unroll
        for (int j = 0; j < 4; ++j) { v[j] = nx[j]; nx[j] = nx2[j]; }
        if (m + 2 * step < rows) { const GAS f32x4* xr = (const GAS f32x4*)(X + (size_t)(m + 2 * step) * DM) + lane;
#pragma unroll
            for (int j = 0; j < 4; ++j) nx2[j] = __builtin_nontemporal_load(xr + 64 * j); }
        float s2 = 0.f;
#pragma unroll
        for (int j = 0; j < 4; ++j) s2 += (v[j].x * v[j].x + v[j].y * v[j].y) + (v[j].z * v[j].z + v[j].w * v[j].w);
        const float ms_ = wave_sum(s2) * (1.f / DM) + EPS; const float rstd = rsqrtf(ms_);
        if (FLOG) { if (lane == 0) rs0[m] = sqrtf(ms_); }
        GAS unsigned long long* o8 = (GAS unsigned long long*)(O + (size_t)m * DM) + lane;
#pragma unroll
        for (int j = 0; j < 4; ++j) { v[j] = v[j] * rstd; o8[64 * j] = (unsigned long long)pk2(v[j].x, v[j].y) | ((unsigned long long)pk2(v[j].z, v[j].w) << 32); }
        if (FLOG) {
            f32x4 a0 = {0.f, 0.f, 0.f, 0.f}, a1 = {0.f, 0.f, 0.f, 0.f};
#pragma unroll
            for (int j = 0; j < 4; ++j)
#pragma unroll
                for (int e = 0; e < 4; ++e) { a0 += wf[j][e][0] * v[j][e]; a1 += wf[j][e][1] * v[j][e]; }
            { const bool b0 = lane & 1, b1 = lane & 2, b2 = lane & 4;
              const f32x4 snd = b0 ? a0 : a1, kp = b0 ? a1 : a0; f32x4 rc;
#pragma unroll
              for (int e = 0; e < 4; ++e) rc[e] = __shfl_xor(snd[e], 1);
              const f32x4 w4 = kp + rc;
              const float s0 = b1 ? w4[0] : w4[2], s1 = b1 ? w4[1] : w4[3], k0 = b1 ? w4[2] : w4[0], k1 = b1 ? w4[3] : w4[1];
              const float w20 = k0 + __shfl_xor(s0, 2), w21 = k1 + __shfl_xor(s1, 2);
              float w1 = (b2 ? w21 : w20) + __shfl_xor(b2 ? w20 : w21, 4);
              w1 += __shfl_xor(w1, 8); w1 += __shfl_xor(w1, 16); w1 += __shfl_xor(w1, 32);
              if (lane < 8) flog[(size_t)m * 8 + 4 * (lane & 1) + (lane & 2) + ((lane >> 2) & 1)] = w1; }
        }
    }
}
__constant__ float INV_FREQ[8] = {1.0f, 0.1939227432012558f, 0.03760603070259094f, 0.007292664609849453f, 0.0014142135623842478f, 0.00027424818836152554f, 5.318296098266728e-05f, 1.0313386155758053e-05f};

struct Ptrs {
    const float *x, *mem; const int* pos; const float *norm_mix_w, *w_in, *b_forget, *dqw, *dkw, *lq1, *lk1, *lq2, *lk2, *subw, *fqw, *fkw, *w_out, *nmq, *nmkv, *w_mq, *w_mkv, *mqw, *mkw, *w_mo, *nmlp, *w_up, *w_dn;
    float* out; float *FLOG, *CUMB, *ROPE, *SS, *QKW, *RS0;
    bf16_t *WIN, *WOUT, *WQ, *WKV, *WO, *WUP, *WDN, *XB, *HM, *MK, *VT, *MKN, *PROJ, *ATT, *MQ, *MO, *H;
};
__host__ __device__ __forceinline__ Ptrs make_ptrs(const void* const* in, float* out, unsigned char* ws) {
    Ptrs p;
    p.x = (const float*)in[0]; p.mem = (const float*)in[1]; p.pos = (const int*)in[2]; p.norm_mix_w = (const float*)in[3]; p.w_in = (const float*)in[4]; p.b_forget = (const float*)in[5];
    p.dqw = (const float*)in[6]; p.dkw = (const float*)in[7]; p.lq1 = (const float*)in[8]; p.lk1 = (const float*)in[9]; p.lq2 = (const float*)in[10]; p.lk2 = (const float*)in[11];
    p.subw = (const float*)in[12]; p.fqw = (const float*)in[13]; p.fkw = (const float*)in[14]; p.w_out = (const float*)in[15]; p.nmq = (const float*)in[16]; p.nmkv = (const float*)in[17];
    p.w_mq = (const float*)in[18]; p.w_mkv = (const float*)in[19]; p.mqw = (const float*)in[20]; p.mkw = (const float*)in[21]; p.w_mo = (const float*)in[22]; p.nmlp = (const float*)in[23];
    p.w_up = (const float*)in[24]; p.w_dn = (const float*)in[25]; p.out = out;
    p.FLOG = (float*)(ws + WS_FLOG); p.CUMB = (float*)(ws + WS_CUMB); p.ROPE = (float*)(ws + WS_ROPE); p.SS = (float*)(ws + WS_SS); p.QKW = (float*)(ws + WS_QKW); p.RS0 = (float*)(ws + WS_RS0);
    p.WIN = (bf16_t*)(ws + WS_WIN); p.WOUT = (bf16_t*)(ws + WS_WOUT); p.WQ = (bf16_t*)(ws + WS_WQ); p.WKV = (bf16_t*)(ws + WS_WKV); p.WO = (bf16_t*)(ws + WS_WO); p.WUP = (bf16_t*)(ws + WS_WUP); p.WDN = (bf16_t*)(ws + WS_WDN);
    p.XB = (bf16_t*)(ws + WS_XB); p.HM = (bf16_t*)(ws + WS_HM); p.MK = (bf16_t*)(ws + WS_MK); p.VT = (bf16_t*)(ws + WS_VT); p.MKN = (bf16_t*)(ws + WS_MKN);
    p.PROJ = (bf16_t*)(ws + WS_PROJ); p.ATT = (bf16_t*)(ws + WS_ATT); p.MQ = nullptr; p.MO = nullptr; p.H = (bf16_t*)(ws + WS_H);
    return p;
}

__device__ __forceinline__ void p0_prologue(Frame& F, const Ptrs& P, const XcdBarrier& bar) {
    LAS float* scr = (LAS float*)(F.lds + RING_OFF + F.wave * 16384);
    const int gw = F.vcu * NWAVES + F.wave, NGW = F.G * NWAVES;
    constexpr int I_IN = 16 * 96, I_KV = 16 * 64, I_OUT = 16 * 32;
    constexpr int NITEMS = I_IN + I_KV + I_OUT;
    for (int it = gw; it < NITEMS; it += NGW) {
        if (it < I_IN) p0_transpose_item<true>(P.w_in, INCOLS, DM, NPROJ, P.norm_mix_w, P.WIN, scr, it, F.lane);
        else if (it < I_IN + I_KV) p0_transpose_item<false>(P.w_mkv, 2048, DM, 2048, P.nmkv, P.WKV, scr, it - I_IN, F.lane);
        else p0_transpose_item<false>(P.w_out, DM, DM, DM, nullptr, P.WOUT, scr, it - I_IN - I_KV, F.lane);
    }
    if (F.tid == 0 && bar.st[0] == 0u) { unsigned nloc, nx; xcd_barrier_complete(bar.bar, bar.x, nloc, nx); bar.st[1] = nx; bar.st[3] = xcd_census_even(bar.bar); bar.st[0] = nloc; }
    rms_rows_to_bf16<true>(F.lane, P.x, P.XB, gw, NGW, MTOK, P.norm_mix_w, P.w_in, P.FLOG, P.RS0);
    rms_rows_to_bf16<false>(F.lane, P.mem, P.HM, gw, NGW, MMEM, nullptr, nullptr, nullptr, nullptr);
    if (blockIdx.x == 0 && F.tid < 64) { const int t = F.tid; P.QKW[t] = P.dqw[t]; P.QKW[64 + t] = P.dkw[t]; P.QKW[128 + t] = P.fqw[t]; P.QKW[192 + t] = P.fkw[t]; }
    for (int id = (F.vcu * NWAVES * 64) + F.tid; id < MTOK * 8; id += F.G * NWAVES * 64) {
        const int row = id >> 3, i = id & 7;
        const float ang = (float)P.pos[row] * INV_FREQ[i];
        const double a = (double)ang; const double k = rint(a * 0.15915494309189535); const float r = (float)fma(-k, 6.283185307179586, a);
        P.ROPE[(size_t)row * 16 + i] = cosf(r); P.ROPE[(size_t)row * 16 + 8 + i] = sinf(r);
    }
}
__device__ __forceinline__ void p1b_row(bf16_t* PROJ, const float* dqw, const float* dkw, const float* fqw, const float* fkw, const float* ROPE, int row, int lane) {
    const int sg = lane >> 1, hf = lane & 1;
    const int col = (sg < 16 ? sg * 64 : 1536 + (sg - 16) * 64) + hf * 32;
    const float* w = (sg < 8 ? dqw : sg < 16 ? dkw : sg < 24 ? fqw : fkw) + hf * 32;
    const bool rope = (sg < 16) && (hf == 0), isq = (sg < 8) || (sg >= 16 && sg < 24);
    GAS v4u* p = (GAS v4u*)(PROJ + (size_t)row * NPROJ + col);
    const v4u u0 = p[0], u1 = p[1], u2 = p[2], u3 = p[3];
#define UNP_LO(u) (f32x4){__uint_as_float(u.x << 16), __uint_as_float(u.x & 0xffff0000u), __uint_as_float(u.y << 16), __uint_as_float(u.y & 0xffff0000u)}
#define UNP_HI(u) (f32x4){__uint_as_float(u.z << 16), __uint_as_float(u.z & 0xffff0000u), __uint_as_float(u.w << 16), __uint_as_float(u.w & 0xffff0000u)}
    f32x4 v0 = UNP_LO(u0), v1 = UNP_HI(u0), v2 = UNP_LO(u1), v3 = UNP_HI(u1), v4 = UNP_LO(u2), v5 = UNP_HI(u2), v6 = UNP_LO(u3), v7 = UNP_HI(u3);
#undef UNP_LO
#undef UNP_HI
#define SQ4(v) ((v.x * v.x + v.y * v.y) + (v.z * v.z + v.w * v.w))
    float ss = (SQ4(v0) + SQ4(v1)) + (SQ4(v2) + SQ4(v3)) + (SQ4(v4) + SQ4(v5)) + (SQ4(v6) + SQ4(v7));
#undef SQ4
    ss += __shfl_xor(ss, 1);
    const float rstd = rsqrtf(ss * (1.f / 64.f) + EPS);
    const GAS f32x4* wg = (const GAS f32x4*)w;
    v0 = v0 * rstd * wg[0]; v1 = v1 * rstd * wg[1]; v2 = v2 * rstd * wg[2]; v3 = v3 * rstd * wg[3]; v4 = v4 * rstd * wg[4]; v5 = v5 * rstd * wg[5]; v6 = v6 * rstd * wg[6]; v7 = v7 * rstd * wg[7];
    if (rope) {
        const GAS f32x4* rt = (const GAS f32x4*)(ROPE + (size_t)row * 16);
        const f32x4 c0 = rt[0], c1 = rt[1], s0 = rt[2], s1 = rt[3];
        const f32x4 a0 = v0 * c0 - v2 * s0, b0 = v2 * c0 + v0 * s0, a1 = v1 * c1 - v3 * s1, b1 = v3 * c1 + v1 * s1;
        v0 = a0; v2 = b0; v1 = a1; v3 = b1;
    }
    const float sc = isq ? C2 : 1.f;
#define PK4(a, b) (v4u){pk2(a.x * sc, a.y * sc), pk2(a.z * sc, a.w * sc), pk2(b.x * sc, b.y * sc), pk2(b.z * sc, b.w * sc)}
    p[0] = PK4(v0, v1); p[1] = PK4(v2, v3); p[2] = PK4(v4, v5); p[3] = PK4(v6, v7);
#undef PK4
}
__device__ __forceinline__ void p1b_cumsum_wg(const float* FLOG, const float* b_forget, float* CUMB, int seq, int tid, LAS float* scr) {
    const int b = seq >> 3, h = seq & 7, lane = tid & 63, wv = tid >> 6; const float bf = b_forget[h];
    float lf[4]; float run = 0.f;
#pragma unroll
    for (int i = 0; i < 4; ++i) { const float z = FLOG[(size_t)(b * SEQ + tid * 4 + i) * 8 + h] + bf; const float e = __expf(-fabsf(z)); lf[i] = fminf(z, 0.f) - log1pf(e); run += lf[i]; }
    float inc = run;
#pragma unroll
    for (int o = 1; o < 64; o <<= 1) { const float t = __shfl_up(inc, o); if (lane >= o) inc += t; }
    if (lane == 63) scr[wv] = inc;
    __syncthreads();
    float base = 0.f;
#pragma unroll
    for (int w = 0; w < 8; ++w) { const float t = scr[w]; if (w < wv) base += t; }
    float c = base + inc - run;
    f32x4 o;
#pragma unroll
    for (int i = 0; i < 4; ++i) { c += lf[i]; o[i] = -c * LOG2E; }
    *(GAS f32x4*)(CUMB + (size_t)seq * SEQ + tid * 4) = o;
    __syncthreads();
}
__device__ __forceinline__ void p1b_cumsum(const Ptrs& P, int seq, int lane) {
    const int b = seq >> 3, h = seq & 7; const float bf = P.b_forget[h];
    float lf[32]; float run = 0.f;
#pragma unroll
    for (int i = 0; i < 32; ++i) { const float z = P.FLOG[(size_t)(b * SEQ + lane * 32 + i) * 8 + h] + bf;
        const float e = __expf(-fabsf(z)); lf[i] = fminf(z, 0.f) - log1pf(e); run += lf[i]; }
    float inc = run;
#pragma unroll
    for (int o = 1; o < 64; o <<= 1) { const float t = __shfl_up(inc, o); if (lane >= o) inc += t; }
    float c = inc - run;
#pragma unroll
    for (int i = 0; i < 32; ++i) { c += lf[i]; P.CUMB[(size_t)seq * SEQ + lane * 32 + i] = -c * LOG2E; }
}
#ifndef PROBE_K
#define PROBE_K -1
#endif
struct Sched {
    pg8::StaticOrder so; int mode, pm, pn; bool has;
    __device__ __forceinline__ bool next(int i, pg8::Unit& u) const { if (mode == 0) return so.next(i, u); if (i != 0 || !has) return false; u.pm = pm; u.pn = pn; return true; }
    __device__ __forceinline__ void a_ready(const pg8::Unit&) const {}
    __device__ __forceinline__ void done(const pg8::Unit&) const {}
};
__device__ __forceinline__ Sched sched_static(int M, int N, int G, int c) { Sched s; s.so.init(M, N, G, c); s.mode = 0; s.pm = 0; s.pn = 0; s.has = true; return s; }
__device__ __forceinline__ Sched sched_one(int pm, int pn, bool has) { Sched s; s.so.init(256, 256, 1, 0); s.mode = 1; s.pm = pm; s.pn = pn; s.has = has; return s; }

#include <hip/hip_bf16.h>
#include <cmath>
namespace ab {
using bf16=__hip_bfloat16;
using bf16x8=__attribute__((ext_vector_type(8)))short;
using s16x4=__attribute__((ext_vector_type(4)))short;
using f32x16=__attribute__((ext_vector_type(16)))float;
using u32x4=__attribute__((ext_vector_type(4)))unsigned;
using f32x4v=__attribute__((ext_vector_type(4)))float;
constexpr int D=64,PIN=NPROJ;
constexpr int NW=8,QBLK=32,QB=QBLK*NW,KVBLK=64;
__device__ __forceinline__ int crow(int r,int hi){return (r&3)+8*(r>>2)+4*hi;}
#define SBAR() __builtin_amdgcn_sched_barrier(0)
__device__ __forceinline__ void cmask(f32x16&p0,f32x16&p1,int jb,int qrel,int hi){
  const float NEG=-INFINITY; int kb=64*jb+4*hi;
  #pragma unroll
  for(int r=0;r<16;++r){int kv=kb+(r&3)+8*(r>>2); if(kv>qrel)p0[r]=NEG; if(kv+32>qrel)p1[r]=NEG;}
}

__device__ __forceinline__ void kmask(f32x16&p0,f32x16&p1,int jb,int wid){
  if(jb>(wid>>1)){const float NEG=-INFINITY;
  #pragma unroll
  for(int r=0;r<16;++r){p0[r]=NEG;p1[r]=NEG;}}
}

constexpr int NSLOT=4, SLOTB=8192;
constexpr int LDS_K=0, LDS_V=NSLOT*SLOTB, LDS_WS=2*NSLOT*SLOTB, LDS_OST=LDS_WS+NW*64*4, LDS_BIAS=LDS_OST+NW*4096, LDS_BYTES=LDS_BIAS+32768;
__device__ __forceinline__ void glds16(const void*gsrc,unsigned lds_dst){unsigned keep;
  asm volatile("s_mov_b32 %0, m0\n\ts_mov_b32 m0, %2\n\ts_nop 0\n\tglobal_load_lds_dwordx4 %1, off\n\ts_mov_b32 m0, %0":"=&s"(keep):"v"(gsrc),"s"(lds_dst):"memory");}
__device__ __forceinline__ float max3f(float a,float b,float c){float r;asm("v_max3_f32 %0, %1, %2, %3":"=v"(r):"v"(a),"v"(b),"v"(c));return r;}
__device__ __forceinline__ float max2f(float a,float b){float r;asm("v_max_f32_e32 %0, %1, %2":"=v"(r):"v"(a),"v"(b));return r;}
__device__ __forceinline__ float fadd_s(float a,float b){float r;asm("v_add_f32_e32 %0, %1, %2":"=v"(r):"v"(a),"v"(b));return r;}
__device__ __forceinline__ float fsub_s(float a,float b){float r;asm("v_sub_f32_e32 %0, %1, %2":"=v"(r):"v"(a),"v"(b));return r;}
__device__ __forceinline__ float fmul_s(float a,float b){float r;asm("v_mul_f32_e32 %0, %1, %2":"=v"(r):"v"(a),"v"(b));return r;}
typedef float f32x2_t __attribute__((ext_vector_type(2))); typedef __bf16 bf16x2_t __attribute__((ext_vector_type(2)));
__device__ __forceinline__ unsigned cvtpk_s(float lo,float hi){f32x2_t v={lo,hi};bf16x2_t b=__builtin_convertvector(v,bf16x2_t);return __builtin_bit_cast(unsigned,b);}
#define WAIT_BAR(N) asm volatile("s_waitcnt vmcnt(" #N ") lgkmcnt(0)\n\ts_barrier":::"memory")
__device__ __forceinline__ bf16x8 aload_q(const void*p){bf16x8 r;asm volatile("global_load_dwordx4 %0, %1, off":"=&v"(r):"v"(p):"memory");return r;}
__device__ __forceinline__ f32x4v aload_f4(const void*p){f32x4v r;asm volatile("global_load_dwordx4 %0, %1, off":"=&v"(r):"v"(p):"memory");return r;}
__device__ __forceinline__ float aload_f(const void*p){float r;asm volatile("global_load_dword %0, %1, off":"=&v"(r):"v"(p):"memory");return r;}

__device__ __forceinline__ void qkt(f32x16&p0,f32x16&p1,const char*Kslot,const bf16x8*qr,const f32x16&negm,int r32,int hi){
  const char*kb=Kslot+hi*1024+r32*16;
  #pragma unroll
  for(int d0=0;d0<4;++d0){
    const bf16x8 b0=*reinterpret_cast<const bf16x8*>(kb+d0*2048);
    const bf16x8 b1=*reinterpret_cast<const bf16x8*>(kb+d0*2048+512);
    if(d0==0){p0=__builtin_amdgcn_mfma_f32_32x32x16_bf16(b0,qr[0],negm,0,0,0);p1=__builtin_amdgcn_mfma_f32_32x32x16_bf16(b1,qr[0],negm,0,0,0);}
    else{p0=__builtin_amdgcn_mfma_f32_32x32x16_bf16(b0,qr[d0],p0,0,0,0);p1=__builtin_amdgcn_mfma_f32_32x32x16_bf16(b1,qr[d0],p1,0,0,0);}}
}
typedef __attribute__((address_space(3))) const char* lds_cptr;
typedef short v4i16_t __attribute__((ext_vector_type(4)));
__device__ __forceinline__ void kload8(bf16x8*kf,lds_cptr kp){
  kf[0]=*(const __attribute__((address_space(3))) bf16x8*)(kp);      kf[1]=*(const __attribute__((address_space(3))) bf16x8*)(kp+512);
  kf[2]=*(const __attribute__((address_space(3))) bf16x8*)(kp+2048); kf[3]=*(const __attribute__((address_space(3))) bf16x8*)(kp+2560);
  kf[4]=*(const __attribute__((address_space(3))) bf16x8*)(kp+4096); kf[5]=*(const __attribute__((address_space(3))) bf16x8*)(kp+4608);
  kf[6]=*(const __attribute__((address_space(3))) bf16x8*)(kp+6144); kf[7]=*(const __attribute__((address_space(3))) bf16x8*)(kp+6656);
}
__device__ __forceinline__ void kload2(bf16x8*kf,lds_cptr kp,int j){ kf[2*j]=*(const __attribute__((address_space(3))) bf16x8*)(kp+j*2048); kf[2*j+1]=*(const __attribute__((address_space(3))) bf16x8*)(kp+j*2048+512); }
__device__ __forceinline__ s16x4 vtr(lds_cptr p){ return __builtin_bit_cast(s16x4,__builtin_amdgcn_ds_read_tr16_b64_v4i16((__attribute__((address_space(3))) v4i16_t*)p)); }
__device__ __forceinline__ float rowmax(const f32x16&p0,const f32x16&p1){
  float a=max3f(p0[0],p0[1],p1[0]),b=max3f(p0[2],p0[3],p1[1]);a=max3f(a,p1[2],p1[3]);
  #pragma unroll
  for(int r=4;r<16;r+=4){a=max3f(a,p0[r],p0[r+1]);b=max3f(b,p0[r+2],p0[r+3]);a=max3f(a,p1[r],p1[r+1]);b=max3f(b,p1[r+2],p1[r+3]);}
  const float m=max2f(a,b);
  auto rr=__builtin_amdgcn_permlane32_swap(__float_as_uint(m),__float_as_uint(m),false,false);
  return max2f(__uint_as_float(rr[0]),__uint_as_float(rr[1]));
}
__device__ __forceinline__ void pv(f32x16*o,int vb,bf16x8 pa0,bf16x8 pa1,bf16x8 pa2,bf16x8 pa3){
  #pragma unroll
  for(int d0=0;d0<2;++d0){s16x4 lo[4],hi[4];
    #pragma unroll
    for(int ks=0;ks<4;++ks){
      asm volatile("ds_read_b64_tr_b16 %0,%1 offset:%c2":"=&v"(lo[ks]):"v"(vb),"i"(d0*4096+ks*1024):"memory");
      asm volatile("ds_read_b64_tr_b16 %0,%1 offset:%c2":"=&v"(hi[ks]):"v"(vb),"i"(d0*4096+ks*1024+512):"memory");}
    asm volatile("s_waitcnt lgkmcnt(0)":::"memory");SBAR();
    #define PK(k) (bf16x8){lo[k][0],lo[k][1],lo[k][2],lo[k][3],hi[k][0],hi[k][1],hi[k][2],hi[k][3]}
    o[d0]=__builtin_amdgcn_mfma_f32_32x32x16_bf16(pa0,PK(0),o[d0],0,0,0);
    o[d0]=__builtin_amdgcn_mfma_f32_32x32x16_bf16(pa1,PK(1),o[d0],0,0,0);
    o[d0]=__builtin_amdgcn_mfma_f32_32x32x16_bf16(pa2,PK(2),o[d0],0,0,0);
    o[d0]=__builtin_amdgcn_mfma_f32_32x32x16_bf16(pa3,PK(3),o[d0],0,0,0);
    #undef PK
  }
}

#ifndef ATTN_STORE16
#define ATTN_STORE16(p,v) (*(u32x4*)(p)=(v))
#endif
__device__ __forceinline__ void split3(float x,float&h,float&m,float&l){
  h=__uint_as_float(cvtpk_s(x,0.f)<<16); const float r1=x-h; m=__uint_as_float(cvtpk_s(r1,0.f)<<16); const float r2=r1-m; l=__uint_as_float(cvtpk_s(r2,0.f)<<16);
}
template<int THRL,int MASK,bool BIAS,bool WT> __device__ __forceinline__ void attn_unit(int qb,const bf16*Qh,const bf16*__restrict__ Kh,const bf16*__restrict__ Vh,bf16*Oh,int opitch,const float*__restrict__ biasg,char*shm,unsigned*qhead,volatile __attribute__((address_space(3))) unsigned*popw){
  int tid_=threadIdx.x; asm volatile("":"+v"(tid_));
  const int tid=tid_,lane=tid&63,r32=lane&31,hi=lane>>5; const int wid=__builtin_amdgcn_readfirstlane(tid>>6);
  const int q0=qb*QB;
  const bf16*Qw=Qh+(long)(q0+wid*QBLK)*PIN;
  const unsigned lds0=(unsigned)(uintptr_t)shm;
  float*wsf=(float*)(shm+LDS_WS)+wid*64;
  const bf16*ksrc=Kh+(long)lane*PIN+wid*8;
  const bf16*vsrc=Vh+(long)(16*(wid&3)+(lane>>2))*PIN+(wid>>2)*32+(lane&3)*8;
  const unsigned kdst=lds0+LDS_K+wid*1024, vdst=lds0+LDS_V+wid*1024;
  #define DMA_K(t,slot) glds16(ksrc+(long)(t)*KVBLK*PIN,(unsigned)__builtin_amdgcn_readfirstlane(kdst+(slot)))
  #define DMA_V(t,slot) glds16(vsrc+(long)(t)*KVBLK*PIN,(unsigned)__builtin_amdgcn_readfirstlane(vdst+(slot)))
  const int vb0=(int)(lds0+LDS_V)+((lane>>4)&1)*32+(lane&3)*8+(4*hi+((lane&15)>>2))*64;
  const char*Kbase=shm+LDS_K; bf16x8 kf[8];
  const lds_cptr shm3=(lds_cptr)shm; const lds_cptr kp0=shm3+LDS_K+hi*1024+r32*16; const lds_cptr vp0=shm3+LDS_V+((lane>>4)&1)*32+(lane&3)*8+(4*hi+((lane&15)>>2))*64;
  const int NT=(q0+QB)/KVBLK;
  static_assert(BIAS&&THRL<0,"the prologue below is written for the bias + no-running-max unit");
  int t2=tid; asm volatile("":"+v"(t2));
  f32x4v bv=aload_f4(biasg+(t2<NT*16?t2:NT*16-1)*4); float mhat_ld=aload_f(biasg+q0+wid*QBLK+r32);
  bf16x8 qr[4];
  #pragma unroll
  for(int d0=0;d0<4;++d0)qr[d0]=aload_q(&Qw[(long)r32*PIN+d0*16+hi*8]);
  DMA_K(0,0);DMA_V(0,0);DMA_K(1,SLOTB);DMA_K(2,2*SLOTB);DMA_V(1,SLOTB);DMA_K(3,3*SLOTB);
  asm volatile("s_waitcnt vmcnt(11)":"+v"(bv)::"memory");
  if(BIAS){ if(t2<NT*16){
      _Pragma("unroll") for(int e_=0;e_<4;++e_){ float h_,m_,l_; split3(bv[e_],h_,m_,l_); u32x4 w_; w_.x=cvtpk_s(h_,m_); w_.y=cvtpk_s(l_,1.f); w_.z=0x3F803F80u; w_.w=0u; *reinterpret_cast<u32x4*>(shm+LDS_BIAS+(t2*4+e_)*16)=w_; } } }
  u32x4 mfr; mfr.x=hi?0u:0x3F803F80u; mfr.y=hi?0u:0x00003F80u; mfr.z=0u; mfr.w=0u;
  #define MFR_UPDATE() do{ if(BIAS){ float h_,m_,l_; split3(-mhat,h_,m_,l_); const unsigned y_=cvtpk_s(1.f,h_), z_=cvtpk_s(m_,l_); mfr.y=hi?0u:y_; mfr.z=hi?0u:z_; } }while(0)
  #define MFRB __builtin_bit_cast(bf16x8,mfr)
  const lds_cptr bt0=(lds_cptr)shm+LDS_BIAS+r32*16;
  constexpr bool NOMAX=THRL<0;
  float mhat=0.f,l_reg=0.f;f32x16 o[2];o[0]=f32x16{};o[1]=f32x16{};f32x16 negm=f32x16{}; if(!BIAS){asm volatile("":"+v"(negm));}
  #define CIN (BIAS?f32x16{}:negm)
  const int qrel=wid*QBLK+r32;
  #define CMASK(P0,P1,t) do{int jb_=(t)-(NT-4); if(jb_>=0){ if(MASK==0)cmask(P0,P1,jb_,qrel,hi); else kmask(P0,P1,jb_,wid); } }while(0)
  bool resc=false;
  #define START(P0,P1) do{ if(!NOMAX){ const float rm=rowmax(P0,P1); resc=false; \
    { const float dl=rm; mhat=fadd_s(mhat,dl); \
      _Pragma("unroll") for(int r=0;r<16;++r){P0[r]=fsub_s(P0[r],dl);P1[r]=fsub_s(P1[r],dl);} \
      if(!BIAS){ _Pragma("unroll") for(int r=0;r<16;++r)negm[r]=-mhat; asm volatile("":"+v"(negm)); } MFR_UPDATE(); } } \
    _Pragma("unroll") for(int r=0;r<16;++r)P0[r]=__builtin_amdgcn_exp2f(P0[r]); }while(0)
  #define RESC() do{ if(!NOMAX&&resc){ asm volatile("s_waitcnt lgkmcnt(0)":::"memory"); \
      _Pragma("unroll") for(int d_=0;d_<2;++d_) _Pragma("unroll") for(int r=0;r<16;++r)o[d_][r]=fmul_s(o[d_][r],wsf[crow(r,hi)]); } }while(0)
  f32x16 pA0,pA1,pB0,pB1;
  #define KS(t) ((((t))&3)*SLOTB)
  #define ROT() do{}while(0)
  asm volatile("s_waitcnt vmcnt(5) lgkmcnt(0)\n\ts_barrier":"+v"(qr[0]),"+v"(qr[1]),"+v"(qr[2]),"+v"(qr[3]),"+v"(mhat_ld)::"memory");
  mhat=mhat_ld;
  if(NOMAX){ MFR_UPDATE(); }
  qkt(pA0,pA1,Kbase,qr,CIN,r32,hi);
  if(BIAS){ const bf16x8 b0_=*(const __attribute__((address_space(3))) bf16x8*)(bt0), b1_=*(const __attribute__((address_space(3))) bf16x8*)(bt0+512);
    pA0=__builtin_amdgcn_mfma_f32_32x32x16_bf16(b0_,MFRB,pA0,0,0,0); pA1=__builtin_amdgcn_mfma_f32_32x32x16_bf16(b1_,MFRB,pA1,0,0,0); }
  asm volatile("s_nop 15\n\ts_nop 7":"+v"(pA0),"+v"(pA1));CMASK(pA0,pA1,0);
  START(pA0,pA1);
  _Pragma("unroll") for(int r=0;r<16;++r)pA1[r]=__builtin_amdgcn_exp2f(pA1[r]);
  WAIT_BAR(3);
  DMA_K(4,KS(4));DMA_V(2,KS(2));
  kload8(kf,kp0+KS(1));
  WAIT_BAR(4);
  s16x4 vlo[8],vhi[8]; u32x4 pw0,pw1,pw2,pw3;
  #define PKW(P,B) cvtpk_s(P[B],P[B+1])
  #define PAF(k) __builtin_bit_cast(bf16x8,pw##k)
  #define VFR(i) (bf16x8){vlo[i][0],vlo[i][1],vlo[i][2],vlo[i][3],vhi[i][0],vhi[i][1],vhi[i][2],vhi[i][3]}
  #define PIN(x) asm volatile("":"+v"(x))
  #define MX3(a,b,c) __builtin_fmaxf(__builtin_fmaxf((a),(b)),(c))
  #define GAPA(MF,A0,A1,A2,A3,W0,W1,PW) do{ MF; sacc+=A0; sacc+=A1; sacc+=A2; sacc+=A3; PIN(sacc); W0; W1; PIN(PW); SBAR(); }while(0)
  #define EX(v) __builtin_amdgcn_exp2f(v)
  #define GAPB(MF,X,B) do{ MF; X[B]=EX(X[B]); X[B+1]=EX(X[B+1]); X[B+2]=EX(X[B+2]); X[B+3]=EX(X[B+3]); PIN(X); SBAR(); }while(0)
  #define VRD(i) do{ vlo[i]=vtr(vp_+(((i)>>2)*4096+((i)&3)*1024)); vhi[i]=vtr(vp_+(((i)>>2)*4096+((i)&3)*1024+512)); }while(0)
  #define KRD(G,j) do{ if(G){ kload2(kf,kn_,j); SBAR(); } }while(0)
  #define STEP(C0,C1,P0,P1,t,GK,GV,GL) do{ SBAR(); \
    const lds_cptr vp_=vp0+KS((t)-1); const lds_cptr kn_=kp0+KS((t)+1); \
    bf16x8 bb0_,bb1_; if(BIAS){ bb0_=*(const __attribute__((address_space(3))) bf16x8*)(bt0+(t)*1024); bb1_=*(const __attribute__((address_space(3))) bf16x8*)(bt0+(t)*1024+512); } \
    VRD(0); SBAR(); float sacc=(P0[0]+P0[1]); \
    GAPA(C0=__builtin_amdgcn_mfma_f32_32x32x16_bf16(kf[0],qr[0],CIN,0,0,0), P0[2],P0[3],P0[4],P0[5],     pw0[0]=PKW(P0,0), pw0[1]=PKW(P0,2), pw0); \
    VRD(4); SBAR(); GAPA(C1=__builtin_amdgcn_mfma_f32_32x32x16_bf16(kf[1],qr[0],CIN,0,0,0), P0[6],P0[7],P0[8],P0[9],     pw0[2]=PKW(P0,4), pw0[3]=PKW(P0,6), pw0); \
    VRD(1); SBAR(); GAPA(C0=__builtin_amdgcn_mfma_f32_32x32x16_bf16(kf[2],qr[1],C0,0,0,0),   P0[10],P0[11],P0[12],P0[13], pw1[0]=PKW(P0,8), pw1[1]=PKW(P0,10), pw1); \
    VRD(5); SBAR(); GAPA(C1=__builtin_amdgcn_mfma_f32_32x32x16_bf16(kf[3],qr[1],C1,0,0,0),   P0[14],P0[15],P1[0],P1[1],   pw1[2]=PKW(P0,12),pw1[3]=PKW(P0,14), pw1); \
    VRD(2); SBAR(); GAPA(C0=__builtin_amdgcn_mfma_f32_32x32x16_bf16(kf[4],qr[2],C0,0,0,0),   P1[2],P1[3],P1[4],P1[5],     pw2[0]=PKW(P1,0), pw2[1]=PKW(P1,2), pw2); \
    VRD(6); SBAR(); GAPA(C1=__builtin_amdgcn_mfma_f32_32x32x16_bf16(kf[5],qr[2],C1,0,0,0),   P1[6],P1[7],P1[8],P1[9],     pw2[2]=PKW(P1,4), pw2[3]=PKW(P1,6), pw2); \
    VRD(3); SBAR(); GAPA(C0=__builtin_amdgcn_mfma_f32_32x32x16_bf16(kf[6],qr[3],C0,0,0,0),   P1[10],P1[11],P1[12],P1[13], pw3[0]=PKW(P1,8), pw3[1]=PKW(P1,10), pw3); \
    VRD(7); SBAR(); GAPA(C1=__builtin_amdgcn_mfma_f32_32x32x16_bf16(kf[7],qr[3],C1,0,0,0),   P1[14],P1[15],0.f,0.f,       pw3[2]=PKW(P1,12),pw3[3]=PKW(P1,14), pw3); \
    if(BIAS){ C0=__builtin_amdgcn_mfma_f32_32x32x16_bf16(bb0_,MFRB,C0,0,0,0); C1=__builtin_amdgcn_mfma_f32_32x32x16_bf16(bb1_,MFRB,C1,0,0,0); SBAR(); } \
    l_reg+=sacc; \
    if(GK){DMA_K((t)+4,KS((t)+4));} if(GV){DMA_V((t)+2,KS((t)+2));} \
    CMASK(C0,C1,t); \
    if(!NOMAX){ float a=MX3(C0[0],C0[1],C1[0]),b=MX3(C0[2],C0[3],C1[1]); a=MX3(a,C1[2],C1[3]); \
      _Pragma("unroll") for(int r=4;r<16;r+=4){a=MX3(a,C0[r],C0[r+1]);b=MX3(b,C0[r+2],C0[r+3]);a=MX3(a,C1[r],C1[r+1]);b=MX3(b,C1[r+2],C1[r+3]);} \
      float rm=__builtin_fmaxf(a,b); { auto rr=__builtin_amdgcn_permlane32_swap(__float_as_uint(rm),__float_as_uint(rm),false,false); rm=__builtin_fmaxf(__uint_as_float(rr[0]),__uint_as_float(rr[1])); } \
      resc=false; \
      if(__builtin_expect(__any(rm>(float)THRL),0)){ const float dl=__builtin_fmaxf(rm,0.f); mhat+=dl; \
        _Pragma("unroll") for(int r=0;r<16;++r){C0[r]-=dl;C1[r]-=dl;} \
        if(!BIAS){ _Pragma("unroll") for(int r=0;r<16;++r)negm[r]=-mhat; asm volatile("":"+v"(negm)); } MFR_UPDATE(); \
        const float f=__builtin_amdgcn_exp2f(-dl); l_reg*=f; if(hi==0)wsf[r32]=f; resc=true; } } \
    SBAR(); \
    GAPB(o[0]=__builtin_amdgcn_mfma_f32_32x32x16_bf16(PAF(0),VFR(0),o[0],0,0,0), C0,0); \
    GAPB(o[1]=__builtin_amdgcn_mfma_f32_32x32x16_bf16(PAF(0),VFR(4),o[1],0,0,0), C0,4); \
    KRD(GL,0); GAPB(o[0]=__builtin_amdgcn_mfma_f32_32x32x16_bf16(PAF(1),VFR(1),o[0],0,0,0), C0,8); \
    KRD(GL,1); GAPB(o[1]=__builtin_amdgcn_mfma_f32_32x32x16_bf16(PAF(1),VFR(5),o[1],0,0,0), C0,12); \
    KRD(GL,2); GAPB(o[0]=__builtin_amdgcn_mfma_f32_32x32x16_bf16(PAF(2),VFR(2),o[0],0,0,0), C1,0); \
    KRD(GL,3); GAPB(o[1]=__builtin_amdgcn_mfma_f32_32x32x16_bf16(PAF(2),VFR(6),o[1],0,0,0), C1,4); \
    GAPB(o[0]=__builtin_amdgcn_mfma_f32_32x32x16_bf16(PAF(3),VFR(3),o[0],0,0,0), C1,8); \
    GAPB(o[1]=__builtin_amdgcn_mfma_f32_32x32x16_bf16(PAF(3),VFR(7),o[1],0,0,0), C1,12); \
    }while(0)
  int t=1;
  #undef CMASK
  #define CMASK(P0,P1,t) do{}while(0)
  for(;t+5<NT;t+=2){
    STEP(pB0,pB1,pA0,pA1,t,true,true,true);     WAIT_BAR(4); RESC(); ROT();
    STEP(pA0,pA1,pB0,pB1,t+1,true,true,true);   WAIT_BAR(4); RESC(); ROT();
  }
  #undef CMASK
  #define CMASK(P0,P1,t) do{int jb_=(t)-(NT-4); if(jb_>=0){ if(MASK==0)cmask(P0,P1,jb_,qrel,hi); else kmask(P0,P1,jb_,wid); } }while(0)
  #define ENDW(tt) do{ const int n_=((tt)+2>=NT)?0:((int)((tt)+3<NT)+(int)((tt)+1<NT)+(int)((tt)+4<NT)+(int)((tt)+2<NT)); if(n_>=4){WAIT_BAR(4);} else if(n_==3){WAIT_BAR(3);} else if(n_==2){WAIT_BAR(2);} else if(n_==1){WAIT_BAR(1);} else {WAIT_BAR(0);} }while(0)
  for(;t+1<NT;t+=2){
    STEP(pB0,pB1,pA0,pA1,t,(t+4<NT),(t+2<NT),(t+1<NT));       ENDW(t);   RESC(); ROT();
    STEP(pA0,pA1,pB0,pB1,t+1,(t+5<NT),(t+3<NT),(t+2<NT));     ENDW(t+1); RESC(); ROT();
  }
  STEP(pB0,pB1,pA0,pA1,NT-1,false,false,false); RESC();
  { float sacc=pB0[0]+pB0[1]; _Pragma("unroll") for(int r=2;r<16;++r)sacc+=pB0[r]; _Pragma("unroll") for(int r=0;r<16;++r)sacc+=pB1[r]; l_reg+=sacc;
    pw0=(u32x4){PKW(pB0,0),PKW(pB0,2),PKW(pB0,4),PKW(pB0,6)};pw1=(u32x4){PKW(pB0,8),PKW(pB0,10),PKW(pB0,12),PKW(pB0,14)};pw2=(u32x4){PKW(pB1,0),PKW(pB1,2),PKW(pB1,4),PKW(pB1,6)};pw3=(u32x4){PKW(pB1,8),PKW(pB1,10),PKW(pB1,12),PKW(pB1,14)};
    SBAR(); pv(o,vb0+KS(NT-1),PAF(0),PAF(1),PAF(2),PAF(3)); }
  #undef PKW
  #undef PAF
  #undef VFR
  #undef PIN
  #undef MX3
  #undef GAPA
  #undef GAPB
  #undef EX
  #undef VRD
  #undef KRD
  #undef STEP
  #undef ENDW
  unsigned nxt_=0u; if(tid==0)nxt_=__hip_atomic_fetch_add(qhead,1u,__ATOMIC_RELAXED,__HIP_MEMORY_SCOPE_AGENT);
  {auto rr=__builtin_amdgcn_permlane32_swap(__float_as_uint(l_reg),__float_as_uint(l_reg),false,false);l_reg=__uint_as_float(rr[0])+__uint_as_float(rr[1]);}
  if(hi==0)wsf[32+r32]=l_reg;asm volatile("s_waitcnt lgkmcnt(0)":::"memory");
  float rli[16];
  #pragma unroll
  for(int r=0;r<16;++r)rli[r]=__builtin_amdgcn_rcpf(wsf[32+crow(r,hi)]);
  bf16*Ow=Oh+(long)(q0+wid*QBLK)*opitch;
  { bf16*stg=(bf16*)(shm+LDS_OST)+wid*2048;
    #pragma unroll
    for(int r=0;r<16;++r){const int orow=crow(r,hi);
      #pragma unroll
      for(int d0=0;d0<2;++d0)stg[orow*64+d0*32+r32]=__float2bfloat16(o[d0][r]*rli[r]);}
    asm volatile("s_waitcnt lgkmcnt(0)":::"memory");
    if(WT){ const __amdgpu_buffer_rsrc_t rs_=__builtin_amdgcn_make_buffer_rsrc((void*)Oh,(short)0,0x7fffffff,0x00020000);
      #pragma unroll
      for(int i=0;i<4;++i){const int row=i*8+(lane>>3),ch=lane&7; const u32x4 v=*(const u32x4*)(stg+row*64+ch*8); __builtin_amdgcn_raw_buffer_store_b128(v,rs_,(int)(((long)(q0+wid*QBLK+row)*opitch+ch*8)*2),0,16);} }
    else{
    #pragma unroll
    for(int i=0;i<4;++i){const int row=i*8+(lane>>3),ch=lane&7; const u32x4 v=*(const u32x4*)(stg+row*64+ch*8); ATTN_STORE16(Ow+(long)row*opitch+ch*8,v);} } }
  if(tid==0)*popw=nxt_;
  asm volatile("s_waitcnt lgkmcnt(0)\n\ts_barrier":::"memory");
  #undef DMA_K
  #undef DMA_V
  #undef CMASK
  #undef CIN
  #undef MFR_UPDATE
  #undef MFRB
  #undef START
  #undef RESC
  #undef ROT
  #undef KS
}
constexpr int ATTN_LDS_BYTES=LDS_BYTES;
#undef SBAR
#undef WAIT_BAR
}
#define SBAR() __builtin_amdgcn_sched_barrier(0)
namespace ab {
constexpr int B_LK=0, B_LV=32768, B_VSLOT=16384, B_LP=98304, B_LW=114688, B_LST=116736, B_LSS=149504, B_LDS_BYTES=150528;
typedef __attribute__((address_space(3))) unsigned char* ldsb;

#define KS(t) ((((t))&3)*SLOTB)
#define VS(t) ((((t))&3)*B_VSLOT)
#define WAIT_BAR(N) asm volatile("s_waitcnt vmcnt(" #N ") lgkmcnt(0)\n\ts_barrier":::"memory")
#define ENDW(tt) do{ const int n_=((tt)+2>=NT)?0:((int)((tt)+3<NT)+2*(int)((tt)+1<NT)+(int)((tt)+4<NT)+2*(int)((tt)+2<NT)); \
    if(n_>=6){WAIT_BAR(6);} else if(n_==5){WAIT_BAR(5);} else if(n_==4){WAIT_BAR(4);} else if(n_==3){WAIT_BAR(3);} else if(n_==2){WAIT_BAR(2);} else if(n_==1){WAIT_BAR(1);} else {WAIT_BAR(0);} }while(0)
template<int THRL> __device__ __forceinline__ void diff_pass_S(int rblk,const bf16*Qh,const bf16*__restrict__ Kh,const bf16*__restrict__ Vh,char*shm,f32x16(&o)[2],float(&rli)[16]){
  int tid_=threadIdx.x; asm volatile("":"+v"(tid_));
  const int tid=tid_,lane=tid&63,r32=lane&31,hi=lane>>5; const int wid=__builtin_amdgcn_readfirstlane(tid>>6);
  const int rb=wid&3,kh=wid>>2;
  const int q0=rblk*128;
  const bf16*Qw=Qh+(long)(q0+rb*QBLK)*PIN;
  const unsigned lds0=(unsigned)(uintptr_t)shm;
  const ldsb L=(ldsb)shm;
  const bf16*ksrc=Kh+(long)lane*PIN+wid*8;
  const bf16*vsrc0=Vh+(long)(16*((2*wid)&3)+(lane>>2))*PIN+(wid>>1)*32+(lane&3)*8;
  const bf16*vsrc1=Vh+(long)(16*((2*wid+1)&3)+(lane>>2))*PIN+(wid>>1)*32+(lane&3)*8;
  const unsigned kdst=lds0+B_LK+wid*1024, vdst=lds0+B_LV+wid*2048;
  #define DMA_K(t) glds16(ksrc+(long)(t)*KVBLK*PIN,(unsigned)__builtin_amdgcn_readfirstlane(kdst+KS(t)))
  #define DMA_V(t) do{ glds16(vsrc0+(long)(t)*KVBLK*PIN,(unsigned)__builtin_amdgcn_readfirstlane(vdst+VS(t))); glds16(vsrc1+(long)(t)*KVBLK*PIN,(unsigned)__builtin_amdgcn_readfirstlane(vdst+VS(t)+1024)); }while(0)
  bf16x8 kf[4];
  const lds_cptr shm3=(lds_cptr)shm; const lds_cptr kp0=shm3+B_LK+hi*1024+r32*16+kh*512;
  const lds_cptr vp0=shm3+B_LV+((lane>>4)&1)*32+(lane&3)*8+(4*hi+((lane&15)>>2))*64+kh*2048;
  const int NT=(2*rblk+2)<4?4:(2*rblk+2);
  const int lim=2*rblk+(rb>>1);
  bf16x8 qr[4];
  #pragma unroll
  for(int d0=0;d0<4;++d0)qr[d0]=aload_q(&Qw[(long)r32*PIN+d0*16+hi*8]);
  DMA_K(0);DMA_V(0);DMA_K(1);DMA_K(2);DMA_V(1);DMA_K(3);
  float l_reg=0.f; f32x16 o4[4]; o4[0]=f32x16{};o4[1]=f32x16{};o4[2]=f32x16{};o4[3]=f32x16{}; const f32x16 zero16=f32x16{};
  #define CMASK(P,t) do{ if((t)>=NT-4){ if((t)>lim){ const float NEG_=-INFINITY; _Pragma("unroll") for(int r_=0;r_<16;++r_){P[r_]=NEG_;} } } }while(0)
  #define KLD4(kp) do{ _Pragma("unroll") for(int j_=0;j_<4;++j_) kf[j_]=*(const __attribute__((address_space(3))) bf16x8*)((kp)+j_*2048); }while(0)
  f32x16 pA,pB;
  asm volatile("s_waitcnt vmcnt(7) lgkmcnt(0)\n\ts_barrier":"+v"(qr[0]),"+v"(qr[1]),"+v"(qr[2]),"+v"(qr[3])::"memory");
  { KLD4(kp0+KS(0));
    pA=__builtin_amdgcn_mfma_f32_32x32x16_bf16(kf[0],qr[0],zero16,0,0,0); pA=__builtin_amdgcn_mfma_f32_32x32x16_bf16(kf[1],qr[1],pA,0,0,0);
    pA=__builtin_amdgcn_mfma_f32_32x32x16_bf16(kf[2],qr[2],pA,0,0,0);     pA=__builtin_amdgcn_mfma_f32_32x32x16_bf16(kf[3],qr[3],pA,0,0,0);
    asm volatile("s_nop 15\n\ts_nop 7":"+v"(pA));CMASK(pA,0);
    _Pragma("unroll") for(int r=0;r<16;++r)pA[r]=__builtin_amdgcn_exp2f(pA[r]); }
  WAIT_BAR(4);
  DMA_K(4);DMA_V(2);
  KLD4(kp0+KS(1));
  WAIT_BAR(6);
  s16x4 vlo[8],vhi[8]; u32x4 pw0,pw1;
  #define PKW(P,B) cvtpk_s(P[B],P[B+1])
  #define PAF(k) __builtin_bit_cast(bf16x8,pw##k)
  #define VFR(i) (bf16x8){vlo[i][0],vlo[i][1],vlo[i][2],vlo[i][3],vhi[i][0],vhi[i][1],vhi[i][2],vhi[i][3]}
  #define PIN(x) asm volatile("":"+v"(x))
  #define GAPA(MF,A0,A1,A2,A3,W0,W1,PW) do{ MF; sacc+=A0; sacc+=A1; sacc+=A2; sacc+=A3; PIN(sacc); W0; W1; PIN(PW); SBAR(); }while(0)
  #define EX(v) __builtin_amdgcn_exp2f(v)
  #define GAPB(MF,X,B) do{ MF; X[B]=EX(X[B]); X[B+1]=EX(X[B+1]); PIN(X); SBAR(); }while(0)
  #define VRD(i) do{ vlo[i]=vtr(vp_+(((i)>>1)*4096+((i)&1)*1024)); vhi[i]=vtr(vp_+(((i)>>1)*4096+((i)&1)*1024+512)); }while(0)
  #define KRD(G,j) do{ if(G){ kf[j]=*(const __attribute__((address_space(3))) bf16x8*)(kn_+(j)*2048); SBAR(); } }while(0)
  #define STEP(C,P,t,GK,GV,GL) do{ SBAR(); \
    const lds_cptr vp_=vp0+VS((t)-1); const lds_cptr kn_=kp0+KS((t)+1); \
    VRD(0); VRD(1); SBAR(); float sacc=(P[0]+P[1]); \
    GAPA(C=__builtin_amdgcn_mfma_f32_32x32x16_bf16(kf[0],qr[0],zero16,0,0,0), P[2],P[3],P[4],P[5],     pw0[0]=PKW(P,0), pw0[1]=PKW(P,2), pw0); \
    VRD(2); VRD(3); SBAR(); GAPA(C=__builtin_amdgcn_mfma_f32_32x32x16_bf16(kf[1],qr[1],C,0,0,0), P[6],P[7],P[8],P[9],     pw0[2]=PKW(P,4), pw0[3]=PKW(P,6), pw0); \
    VRD(4); VRD(5); SBAR(); GAPA(C=__builtin_amdgcn_mfma_f32_32x32x16_bf16(kf[2],qr[2],C,0,0,0), P[10],P[11],P[12],P[13], pw1[0]=PKW(P,8), pw1[1]=PKW(P,10), pw1); \
    VRD(6); VRD(7); SBAR(); GAPA(C=__builtin_amdgcn_mfma_f32_32x32x16_bf16(kf[3],qr[3],C,0,0,0), P[14],P[15],0.f,0.f,     pw1[2]=PKW(P,12),pw1[3]=PKW(P,14), pw1); \
    l_reg+=sacc; \
    if(GK){DMA_K((t)+4);} if(GV){DMA_V((t)+2);} \
    CMASK(C,t); \
    SBAR(); \
    GAPB(o4[0]=__builtin_amdgcn_mfma_f32_32x32x16_bf16(PAF(0),VFR(0),o4[0],0,0,0), C,0); \
    GAPB(o4[1]=__builtin_amdgcn_mfma_f32_32x32x16_bf16(PAF(0),VFR(2),o4[1],0,0,0), C,2); \
    KRD(GL,0); GAPB(o4[2]=__builtin_amdgcn_mfma_f32_32x32x16_bf16(PAF(0),VFR(4),o4[2],0,0,0), C,4); \
    KRD(GL,1); GAPB(o4[3]=__builtin_amdgcn_mfma_f32_32x32x16_bf16(PAF(0),VFR(6),o4[3],0,0,0), C,6); \
    KRD(GL,2); GAPB(o4[0]=__builtin_amdgcn_mfma_f32_32x32x16_bf16(PAF(1),VFR(1),o4[0],0,0,0), C,8); \
    KRD(GL,3); GAPB(o4[1]=__builtin_amdgcn_mfma_f32_32x32x16_bf16(PAF(1),VFR(3),o4[1],0,0,0), C,10); \
    GAPB(o4[2]=__builtin_amdgcn_mfma_f32_32x32x16_bf16(PAF(1),VFR(5),o4[2],0,0,0), C,12); \
    GAPB(o4[3]=__builtin_amdgcn_mfma_f32_32x32x16_bf16(PAF(1),VFR(7),o4[3],0,0,0), C,14); \
    }while(0)
  int t=1;
  #undef CMASK
  #define CMASK(P,t) do{}while(0)
  for(;t+5<NT;t+=2){
    STEP(pB,pA,t,true,true,true);     WAIT_BAR(6);
    STEP(pA,pB,t+1,true,true,true);   WAIT_BAR(6);
  }
  #undef CMASK
  #define CMASK(P,t) do{ if((t)>=NT-4){ if((t)>lim){ const float NEG_=-INFINITY; _Pragma("unroll") for(int r_=0;r_<16;++r_){P[r_]=NEG_;} } } }while(0)
  for(;t+1<NT;t+=2){
    STEP(pB,pA,t,(t+4<NT),(t+2<NT),(t+1<NT));       ENDW(t);
    STEP(pA,pB,t+1,(t+5<NT),(t+3<NT),(t+2<NT));     ENDW(t+1);
  }
  STEP(pB,pA,NT-1,false,false,false);
  { float sacc=pB[0]+pB[1]; _Pragma("unroll") for(int r=2;r<16;++r)sacc+=pB[r]; l_reg+=sacc;
    pw0=(u32x4){PKW(pB,0),PKW(pB,2),PKW(pB,4),PKW(pB,6)};pw1=(u32x4){PKW(pB,8),PKW(pB,10),PKW(pB,12),PKW(pB,14)};
    const lds_cptr vp_=vp0+VS(NT-1);
    VRD(0);VRD(1);VRD(2);VRD(3);VRD(4);VRD(5);VRD(6);VRD(7);
    asm volatile("s_waitcnt lgkmcnt(0)":::"memory");SBAR();
    o4[0]=__builtin_amdgcn_mfma_f32_32x32x16_bf16(PAF(0),VFR(0),o4[0],0,0,0); o4[1]=__builtin_amdgcn_mfma_f32_32x32x16_bf16(PAF(0),VFR(2),o4[1],0,0,0);
    o4[2]=__builtin_amdgcn_mfma_f32_32x32x16_bf16(PAF(0),VFR(4),o4[2],0,0,0); o4[3]=__builtin_amdgcn_mfma_f32_32x32x16_bf16(PAF(0),VFR(6),o4[3],0,0,0);
    o4[0]=__builtin_amdgcn_mfma_f32_32x32x16_bf16(PAF(1),VFR(1),o4[0],0,0,0); o4[1]=__builtin_amdgcn_mfma_f32_32x32x16_bf16(PAF(1),VFR(3),o4[1],0,0,0);
    o4[2]=__builtin_amdgcn_mfma_f32_32x32x16_bf16(PAF(1),VFR(5),o4[2],0,0,0); o4[3]=__builtin_amdgcn_mfma_f32_32x32x16_bf16(PAF(1),VFR(7),o4[3],0,0,0); }
  {auto rr=__builtin_amdgcn_permlane32_swap(__float_as_uint(l_reg),__float_as_uint(l_reg),false,false);l_reg=__uint_as_float(rr[0])+__uint_as_float(rr[1]);}
  volatile __attribute__((address_space(3))) float*lw=(volatile __attribute__((address_space(3))) float*)(L+B_LW);
  asm volatile("s_waitcnt lgkmcnt(0)\n\ts_barrier":::"memory");
  { const ldsb xo=L+wid*8192+lane*16;
    if(kh==0){
      #pragma unroll
      for(int j=0;j<4;++j){ *(__attribute__((address_space(3))) f32x4v*)(xo+j*1024)=(f32x4v){o4[2][4*j],o4[2][4*j+1],o4[2][4*j+2],o4[2][4*j+3]}; *(__attribute__((address_space(3))) f32x4v*)(xo+(4+j)*1024)=(f32x4v){o4[3][4*j],o4[3][4*j+1],o4[3][4*j+2],o4[3][4*j+3]}; }
      o[0]=o4[0];o[1]=o4[1];
    } else {
      #pragma unroll
      for(int j=0;j<4;++j){ *(__attribute__((address_space(3))) f32x4v*)(xo+j*1024)=(f32x4v){o4[0][4*j],o4[0][4*j+1],o4[0][4*j+2],o4[0][4*j+3]}; *(__attribute__((address_space(3))) f32x4v*)(xo+(4+j)*1024)=(f32x4v){o4[1][4*j],o4[1][4*j+1],o4[1][4*j+2],o4[1][4*j+3]}; }
      o[0]=o4[2];o[1]=o4[3];
    }
    if(hi==0)lw[wid*32+r32]=l_reg; }
  asm volatile("s_waitcnt lgkmcnt(0)\n\ts_barrier":::"memory");
  { const ldsb xi=L+(wid^4)*8192+lane*16;
    #pragma unroll
    for(int j=0;j<4;++j){ const f32x4v a=*(const __attribute__((address_space(3))) f32x4v*)(xi+j*1024), b=*(const __attribute__((address_space(3))) f32x4v*)(xi+(4+j)*1024);
      o[0][4*j]+=a[0];o[0][4*j+1]+=a[1];o[0][4*j+2]+=a[2];o[0][4*j+3]+=a[3]; o[1][4*j]+=b[0];o[1][4*j+1]+=b[1];o[1][4*j+2]+=b[2];o[1][4*j+3]+=b[3]; }
    #pragma unroll
    for(int r=0;r<16;++r)rli[r]=__builtin_amdgcn_rcpf(lw[wid*32+crow(r,hi)]+lw[(wid^4)*32+crow(r,hi)]); }
  asm volatile("s_waitcnt lgkmcnt(0)\n\ts_barrier":::"memory");
  #undef PKW
  #undef PAF
  #undef VFR
  #undef PIN
  #undef GAPA
  #undef GAPB
  #undef EX
  #undef VRD
  #undef KRD
  #undef KLD4
  #undef STEP
  #undef DMA_K
  #undef DMA_V
  #undef CMASK
}
#undef KS
#undef VS
#undef WAIT_BAR
#undef ENDW
template<int THRL> __device__ __forceinline__ void diff_unit_ab(int rblk,const bf16*Qh,const bf16*Kh,const bf16*Vh,bf16_t*ATTh,const float*subw,float lam,char*shm,unsigned*qhead,volatile __attribute__((address_space(3))) unsigned*popw){
  int lane_=threadIdx.x&63; asm volatile("":"+v"(lane_));
  const int lane=lane_,r32=lane&31,hi=lane>>5; const int wid=__builtin_amdgcn_readfirstlane((int)(threadIdx.x>>6)); const int rb=wid&3,hf=wid>>2;
  const ldsb L=(ldsb)shm;
  __attribute__((address_space(3))) bf16_t*stg=(__attribute__((address_space(3))) bf16_t*)(L+B_LST+wid*4096);
  f32x16 o[2]; float rli[16];
  diff_pass_S<THRL>(rblk,Qh,Kh,Vh,shm,o,rli);
  #pragma unroll
  for(int r=0;r<16;++r){const int orow=crow(r,hi);
    #pragma unroll
    for(int d0=0;d0<2;++d0)stg[orow*64+d0*32+r32]=(bf16_t)(cvtpk_s(o[d0][r]*rli[r],0.f)&0xffffu);}
  diff_pass_S<THRL>(rblk,Qh+64,Kh+64,Vh,shm,o,rli);
  unsigned nxt_=0u; if(threadIdx.x==0)nxt_=__hip_atomic_fetch_add(qhead,1u,__ATOMIC_RELAXED,__HIP_MEMORY_SCOPE_AGENT);
  const f32x4v sg0=*reinterpret_cast<const f32x4v*>(subw+64*hf+8*(lane&7)), sg1=*reinterpret_cast<const f32x4v*>(subw+64*hf+8*(lane&7)+4);
  #pragma unroll
  for(int r=0;r<16;++r){const int orow=crow(r,hi);
    #pragma unroll
    for(int d0=0;d0<2;++d0){ const float o1=__uint_as_float(((unsigned)stg[orow*64+d0*32+r32])<<16); stg[orow*64+d0*32+r32]=(bf16_t)(cvtpk_s(o1-lam*(o[d0][r]*rli[r]),0.f)&0xffffu); } }
  asm volatile("s_waitcnt lgkmcnt(0)":::"memory");
  u32x4 vv[4]; float ssr[4];
  #pragma unroll
  for(int i=0;i<4;++i){ const int row=i*8+(lane>>3),ch=lane&7; vv[i]=*(const __attribute__((address_space(3))) u32x4*)(stg+row*64+ch*8);
    float s=0.f;
    #pragma unroll
    for(int e=0;e<4;++e){ const float a=__uint_as_float(vv[i][e]<<16),b2=__uint_as_float(vv[i][e]&0xffff0000u); s+=a*a+b2*b2; }
    s+=__shfl_xor(s,1); s+=__shfl_xor(s,2); s+=__shfl_xor(s,4); ssr[i]=s;
    if(ch==0)((__attribute__((address_space(3))) float*)(L+B_LSS))[wid*32+row]=s; }
  asm volatile("s_waitcnt lgkmcnt(0)\n\ts_barrier":::"memory");
  #pragma unroll
  for(int i=0;i<4;++i){ const int row=i*8+(lane>>3),ch=lane&7;
    const float tot=ssr[i]+((const __attribute__((address_space(3))) float*)(L+B_LSS))[(wid^4)*32+row];
    const float rstd=rsqrtf(tot*(1.f/128.f)+EPS)*0.8f;
    const f32x4v g0=sg0, g1=sg1;
    u32x4 w;
    w.x=cvtpk_s(__uint_as_float(vv[i].x<<16)*rstd*g0[0],__uint_as_float(vv[i].x&0xffff0000u)*rstd*g0[1]);
    w.y=cvtpk_s(__uint_as_float(vv[i].y<<16)*rstd*g0[2],__uint_as_float(vv[i].y&0xffff0000u)*rstd*g0[3]);
    w.z=cvtpk_s(__uint_as_float(vv[i].z<<16)*rstd*g1[0],__uint_as_float(vv[i].z&0xffff0000u)*rstd*g1[1]);
    w.w=cvtpk_s(__uint_as_float(vv[i].w<<16)*rstd*g1[2],__uint_as_float(vv[i].w&0xffff0000u)*rstd*g1[3]);
    *reinterpret_cast<u32x4*>(ATTh+(size_t)(rblk*128+rb*32+row)*DM+64*hf+8*ch)=w; }
  if(threadIdx.x==0)*popw=nxt_;
  asm volatile("s_waitcnt lgkmcnt(0)\n\ts_barrier":::"memory");
}
}
#undef SBAR
__constant__ unsigned short UNIT_Q[8][176] = {
  {0x4000,0x4001,0x4002,0x4003,0x4020,0x4028,0x4030,0x4038,0x800f,0x801f,0x802f,0x2000,0x803f,0x800e,0x801e,0x2001,0x802e,0x803e,0x800d,0x2002,0x801d,0x802d,0x803d,0x2003,0x0007,0x000f,0x0017,0x2004,0x001f,0x0027,0x002f,0x2005,0x0037,0x003f,0x800c,0x2006,0x801c,0x802c,0x803c,0x2007,0x800b,0x801b,0x802b,0x2008,0x803b,0x0006,0x000e,0x2009,0x0016,0x001e,0x0026,0x200a,0x002e,0x0036,0x003e,0x200b,0x800a,0x801a,0x802a,0x200c,0x803a,0x8009,0x8019,0x200d,0x8029,0x8039,0x0005,0x200e,0x000d,0x0015,0x001d,0x200f,0x0025,0x002d,0x0035,0x2010,0x003d,0x8008,0x8018,0x2011,0x8028,0x8038,0x8007,0x2012,0x8017,0x8027,0x8037,0x2013,0x0004,0x000c,0x0014,0x2014,0x001c,0x0024,0x002c,0x2015,0x0034,0x003c,0x8006,0x2016,0x8016,0x8026,0x8036,0x2017,0x8005,0x8015,0x8025,0x2018,0x8035,0x0003,0x000b,0x2019,0x0013,0x001b,0x0023,0x201a,0x002b,0x0033,0x003b,0x201b,0x8004,0x8014,0x8024,0x201c,0x8034,0x8003,0x8013,0x201d,0x8023,0x8033,0x0002,0x201e,0x000a,0x0012,0x001a,0x201f,0x0022,0x002a,0x0032,0x2020,0x003a,0x8002,0x8012,0x2021,0x8022,0x8032,0x8000,0x2022,0x8001,0x8010,0x8011,0x2023,0x8020,0x8021,0x8030,0x2024,0x8031,0x0001,0x0009,0x2025,0x0011,0x0019,0x0021,0x2026,0x0029,0x0031,0x0039,0x2027,0x0000,0x0008,0x0010,0x0018,0x0020,0x0028,0x0030,0x0038},
  {0x4004,0x4005,0x4006,0x4007,0x4021,0x4029,0x4031,0x4039,0x804f,0x805f,0x806f,0x2028,0x807f,0x804e,0x805e,0x2029,0x806e,0x807e,0x804d,0x202a,0x805d,0x806d,0x807d,0x202b,0x0047,0x004f,0x0057,0x202c,0x005f,0x0067,0x006f,0x202d,0x0077,0x007f,0x804c,0x202e,0x805c,0x806c,0x807c,0x202f,0x804b,0x805b,0x806b,0x2030,0x807b,0x0046,0x004e,0x2031,0x0056,0x005e,0x0066,0x2032,0x006e,0x0076,0x007e,0x2033,0x804a,0x805a,0x806a,0x2034,0x807a,0x8049,0x8059,0x2035,0x8069,0x8079,0x0045,0x2036,0x004d,0x0055,0x005d,0x2037,0x0065,0x006d,0x0075,0x2038,0x007d,0x8048,0x8058,0x2039,0x8068,0x8078,0x8047,0x203a,0x8057,0x8067,0x8077,0x203b,0x0044,0x004c,0x0054,0x203c,0x005c,0x0064,0x006c,0x203d,0x0074,0x007c,0x8046,0x203e,0x8056,0x8066,0x8076,0x203f,0x8045,0x8055,0x8065,0x2040,0x8075,0x0043,0x004b,0x2041,0x0053,0x005b,0x0063,0x2042,0x006b,0x0073,0x007b,0x2043,0x8044,0x8054,0x8064,0x2044,0x8074,0x8043,0x8053,0x2045,0x8063,0x8073,0x0042,0x2046,0x004a,0x0052,0x005a,0x2047,0x0062,0x006a,0x0072,0x2048,0x007a,0x8042,0x8052,0x2049,0x8062,0x8072,0x8040,0x204a,0x8041,0x8050,0x8051,0x204b,0x8060,0x8061,0x8070,0x204c,0x8071,0x0041,0x0049,0x204d,0x0051,0x0059,0x0061,0x204e,0x0069,0x0071,0x0079,0x204f,0x0040,0x0048,0x0050,0x0058,0x0060,0x0068,0x0070,0x0078},
  {0x4008,0x4009,0x400a,0x400b,0x4022,0x402a,0x4032,0x403a,0x808f,0x809f,0x80af,0x2050,0x80bf,0x808e,0x809e,0x2051,0x80ae,0x80be,0x808d,0x2052,0x809d,0x80ad,0x80bd,0x2053,0x0087,0x008f,0x0097,0x2054,0x009f,0x00a7,0x00af,0x2055,0x00b7,0x00bf,0x808c,0x2056,0x809c,0x80ac,0x80bc,0x2057,0x808b,0x809b,0x80ab,0x2058,0x80bb,0x0086,0x008e,0x2059,0x0096,0x009e,0x00a6,0x205a,0x00ae,0x00b6,0x00be,0x205b,0x808a,0x809a,0x80aa,0x205c,0x80ba,0x8089,0x8099,0x205d,0x80a9,0x80b9,0x0085,0x205e,0x008d,0x0095,0x009d,0x205f,0x00a5,0x00ad,0x00b5,0x2060,0x00bd,0x8088,0x8098,0x2061,0x80a8,0x80b8,0x8087,0x2062,0x8097,0x80a7,0x80b7,0x2063,0x0084,0x008c,0x0094,0x2064,0x009c,0x00a4,0x00ac,0x2065,0x00b4,0x00bc,0x8086,0x2066,0x8096,0x80a6,0x80b6,0x2067,0x8085,0x8095,0x80a5,0x2068,0x80b5,0x0083,0x008b,0x2069,0x0093,0x009b,0x00a3,0x206a,0x00ab,0x00b3,0x00bb,0x206b,0x8084,0x8094,0x80a4,0x206c,0x80b4,0x8083,0x8093,0x206d,0x80a3,0x80b3,0x0082,0x206e,0x008a,0x0092,0x009a,0x206f,0x00a2,0x00aa,0x00b2,0x2070,0x00ba,0x8082,0x8092,0x2071,0x80a2,0x80b2,0x8080,0x2072,0x8081,0x8090,0x8091,0x2073,0x80a0,0x80a1,0x80b0,0x2074,0x80b1,0x0081,0x0089,0x2075,0x0091,0x0099,0x00a1,0x2076,0x00a9,0x00b1,0x00b9,0x2077,0x0080,0x0088,0x0090,0x0098,0x00a0,0x00a8,0x00b0,0x00b8},
  {0x400c,0x400d,0x400e,0x400f,0x4023,0x402b,0x4033,0x403b,0x80cf,0x80df,0x80ef,0x2078,0x80ff,0x80ce,0x80de,0x2079,0x80ee,0x80fe,0x80cd,0x207a,0x80dd,0x80ed,0x80fd,0x207b,0x00c7,0x00cf,0x00d7,0x207c,0x00df,0x00e7,0x00ef,0x207d,0x00f7,0x00ff,0x80cc,0x207e,0x80dc,0x80ec,0x80fc,0x207f,0x80cb,0x80db,0x80eb,0x2080,0x80fb,0x00c6,0x00ce,0x2081,0x00d6,0x00de,0x00e6,0x2082,0x00ee,0x00f6,0x00fe,0x2083,0x80ca,0x80da,0x80ea,0x2084,0x80fa,0x80c9,0x80d9,0x2085,0x80e9,0x80f9,0x00c5,0x2086,0x00cd,0x00d5,0x00dd,0x2087,0x00e5,0x00ed,0x00f5,0x2088,0x00fd,0x80c8,0x80d8,0x2089,0x80e8,0x80f8,0x80c7,0x208a,0x80d7,0x80e7,0x80f7,0x208b,0x00c4,0x00cc,0x00d4,0x208c,0x00dc,0x00e4,0x00ec,0x208d,0x00f4,0x00fc,0x80c6,0x208e,0x80d6,0x80e6,0x80f6,0x208f,0x80c5,0x80d5,0x80e5,0x2090,0x80f5,0x00c3,0x00cb,0x2091,0x00d3,0x00db,0x00e3,0x2092,0x00eb,0x00f3,0x00fb,0x2093,0x80c4,0x80d4,0x80e4,0x2094,0x80f4,0x80c3,0x80d3,0x2095,0x80e3,0x80f3,0x00c2,0x2096,0x00ca,0x00d2,0x00da,0x2097,0x00e2,0x00ea,0x00f2,0x2098,0x00fa,0x80c2,0x80d2,0x2099,0x80e2,0x80f2,0x80c0,0x209a,0x80c1,0x80d0,0x80d1,0x209b,0x80e0,0x80e1,0x80f0,0x209c,0x80f1,0x00c1,0x00c9,0x209d,0x00d1,0x00d9,0x00e1,0x209e,0x00e9,0x00f1,0x00f9,0x209f,0x00c0,0x00c8,0x00d0,0x00d8,0x00e0,0x00e8,0x00f0,0x00f8},
  {0x4010,0x4011,0x4012,0x4013,0x4024,0x402c,0x4034,0x403c,0x810f,0x811f,0x812f,0x20a0,0x813f,0x810e,0x811e,0x20a1,0x812e,0x813e,0x810d,0x20a2,0x811d,0x812d,0x813d,0x20a3,0x0107,0x010f,0x0117,0x20a4,0x011f,0x0127,0x012f,0x20a5,0x0137,0x013f,0x810c,0x20a6,0x811c,0x812c,0x813c,0x20a7,0x810b,0x811b,0x812b,0x20a8,0x813b,0x0106,0x010e,0x20a9,0x0116,0x011e,0x0126,0x20aa,0x012e,0x0136,0x013e,0x20ab,0x810a,0x811a,0x812a,0x20ac,0x813a,0x8109,0x8119,0x20ad,0x8129,0x8139,0x0105,0x20ae,0x010d,0x0115,0x011d,0x20af,0x0125,0x012d,0x0135,0x20b0,0x013d,0x8108,0x8118,0x20b1,0x8128,0x8138,0x8107,0x20b2,0x8117,0x8127,0x8137,0x20b3,0x0104,0x010c,0x0114,0x20b4,0x011c,0x0124,0x012c,0x20b5,0x0134,0x013c,0x8106,0x20b6,0x8116,0x8126,0x8136,0x20b7,0x8105,0x8115,0x8125,0x20b8,0x8135,0x0103,0x010b,0x20b9,0x0113,0x011b,0x0123,0x20ba,0x012b,0x0133,0x013b,0x20bb,0x8104,0x8114,0x8124,0x20bc,0x8134,0x8103,0x8113,0x20bd,0x8123,0x8133,0x0102,0x20be,0x010a,0x0112,0x011a,0x20bf,0x0122,0x012a,0x0132,0x20c0,0x013a,0x8102,0x8112,0x20c1,0x8122,0x8132,0x8100,0x20c2,0x8101,0x8110,0x8111,0x20c3,0x8120,0x8121,0x8130,0x20c4,0x8131,0x0101,0x0109,0x20c5,0x0111,0x0119,0x0121,0x20c6,0x0129,0x0131,0x0139,0x20c7,0x0100,0x0108,0x0110,0x0118,0x0120,0x0128,0x0130,0x0138},
  {0x4014,0x4015,0x4016,0x4017,0x4025,0x402d,0x4035,0x403d,0x814f,0x815f,0x816f,0x20c8,0x817f,0x814e,0x815e,0x20c9,0x816e,0x817e,0x814d,0x20ca,0x815d,0x816d,0x817d,0x20cb,0x0147,0x014f,0x0157,0x20cc,0x015f,0x0167,0x016f,0x20cd,0x0177,0x017f,0x814c,0x20ce,0x815c,0x816c,0x817c,0x20cf,0x814b,0x815b,0x816b,0x20d0,0x817b,0x0146,0x014e,0x20d1,0x0156,0x015e,0x0166,0x20d2,0x016e,0x0176,0x017e,0x20d3,0x814a,0x815a,0x816a,0x20d4,0x817a,0x8149,0x8159,0x20d5,0x8169,0x8179,0x0145,0x20d6,0x014d,0x0155,0x015d,0x20d7,0x0165,0x016d,0x0175,0x20d8,0x017d,0x8148,0x8158,0x20d9,0x8168,0x8178,0x8147,0x20da,0x8157,0x8167,0x8177,0x20db,0x0144,0x014c,0x0154,0x20dc,0x015c,0x0164,0x016c,0x20dd,0x0174,0x017c,0x8146,0x20de,0x8156,0x8166,0x8176,0x20df,0x8145,0x8155,0x8165,0x20e0,0x8175,0x0143,0x014b,0x20e1,0x0153,0x015b,0x0163,0x20e2,0x016b,0x0173,0x017b,0x20e3,0x8144,0x8154,0x8164,0x20e4,0x8174,0x8143,0x8153,0x20e5,0x8163,0x8173,0x0142,0x20e6,0x014a,0x0152,0x015a,0x20e7,0x0162,0x016a,0x0172,0x20e8,0x017a,0x8142,0x8152,0x20e9,0x8162,0x8172,0x8140,0x20ea,0x8141,0x8150,0x8151,0x20eb,0x8160,0x8161,0x8170,0x20ec,0x8171,0x0141,0x0149,0x20ed,0x0151,0x0159,0x0161,0x20ee,0x0169,0x0171,0x0179,0x20ef,0x0140,0x0148,0x0150,0x0158,0x0160,0x0168,0x0170,0x0178},
  {0x4018,0x4019,0x401a,0x401b,0x4026,0x402e,0x4036,0x403e,0x818f,0x819f,0x81af,0x20f0,0x81bf,0x818e,0x819e,0x20f1,0x81ae,0x81be,0x818d,0x20f2,0x819d,0x81ad,0x81bd,0x20f3,0x0187,0x018f,0x0197,0x20f4,0x019f,0x01a7,0x01af,0x20f5,0x01b7,0x01bf,0x818c,0x20f6,0x819c,0x81ac,0x81bc,0x20f7,0x818b,0x819b,0x81ab,0x20f8,0x81bb,0x0186,0x018e,0x20f9,0x0196,0x019e,0x01a6,0x20fa,0x01ae,0x01b6,0x01be,0x20fb,0x818a,0x819a,0x81aa,0x20fc,0x81ba,0x8189,0x8199,0x20fd,0x81a9,0x81b9,0x0185,0x20fe,0x018d,0x0195,0x019d,0x20ff,0x01a5,0x01ad,0x01b5,0x2100,0x01bd,0x8188,0x8198,0x2101,0x81a8,0x81b8,0x8187,0x2102,0x8197,0x81a7,0x81b7,0x2103,0x0184,0x018c,0x0194,0x2104,0x019c,0x01a4,0x01ac,0x2105,0x01b4,0x01bc,0x8186,0x2106,0x8196,0x81a6,0x81b6,0x2107,0x8185,0x8195,0x81a5,0x2108,0x81b5,0x0183,0x018b,0x2109,0x0193,0x019b,0x01a3,0x210a,0x01ab,0x01b3,0x01bb,0x210b,0x8184,0x8194,0x81a4,0x210c,0x81b4,0x8183,0x8193,0x210d,0x81a3,0x81b3,0x0182,0x210e,0x018a,0x0192,0x019a,0x210f,0x01a2,0x01aa,0x01b2,0x2110,0x01ba,0x8182,0x8192,0x2111,0x81a2,0x81b2,0x8180,0x2112,0x8181,0x8190,0x8191,0x2113,0x81a0,0x81a1,0x81b0,0x2114,0x81b1,0x0181,0x0189,0x2115,0x0191,0x0199,0x01a1,0x2116,0x01a9,0x01b1,0x01b9,0x2117,0x0180,0x0188,0x0190,0x0198,0x01a0,0x01a8,0x01b0,0x01b8},
  {0x401c,0x401d,0x401e,0x401f,0x4027,0x402f,0x4037,0x403f,0x81cf,0x81df,0x81ef,0x2118,0x81ff,0x81ce,0x81de,0x2119,0x81ee,0x81fe,0x81cd,0x211a,0x81dd,0x81ed,0x81fd,0x211b,0x01c7,0x01cf,0x01d7,0x211c,0x01df,0x01e7,0x01ef,0x211d,0x01f7,0x01ff,0x81cc,0x211e,0x81dc,0x81ec,0x81fc,0x211f,0x81cb,0x81db,0x81eb,0x2120,0x81fb,0x01c6,0x01ce,0x2121,0x01d6,0x01de,0x01e6,0x2122,0x01ee,0x01f6,0x01fe,0x2123,0x81ca,0x81da,0x81ea,0x2124,0x81fa,0x81c9,0x81d9,0x2125,0x81e9,0x81f9,0x01c5,0x2126,0x01cd,0x01d5,0x01dd,0x2127,0x01e5,0x01ed,0x01f5,0x2128,0x01fd,0x81c8,0x81d8,0x2129,0x81e8,0x81f8,0x81c7,0x212a,0x81d7,0x81e7,0x81f7,0x212b,0x01c4,0x01cc,0x01d4,0x212c,0x01dc,0x01e4,0x01ec,0x212d,0x01f4,0x01fc,0x81c6,0x212e,0x81d6,0x81e6,0x81f6,0x212f,0x81c5,0x81d5,0x81e5,0x2130,0x81f5,0x01c3,0x01cb,0x2131,0x01d3,0x01db,0x01e3,0x2132,0x01eb,0x01f3,0x01fb,0x2133,0x81c4,0x81d4,0x81e4,0x2134,0x81f4,0x81c3,0x81d3,0x2135,0x81e3,0x81f3,0x01c2,0x2136,0x01ca,0x01d2,0x01da,0x2137,0x01e2,0x01ea,0x01f2,0x2138,0x01fa,0x81c2,0x81d2,0x2139,0x81e2,0x81f2,0x81c0,0x213a,0x81c1,0x81d0,0x81d1,0x213b,0x81e0,0x81e1,0x81f0,0x213c,0x81f1,0x01c1,0x01c9,0x213d,0x01d1,0x01d9,0x01e1,0x213e,0x01e9,0x01f1,0x01f9,0x213f,0x01c0,0x01c8,0x01d0,0x01d8,0x01e0,0x01e8,0x01f0,0x01f8},
};
constexpr int NQ_UNITS = 176;
constexpr size_t WS_DIFFO = 224 * MiB;
constexpr size_t WS_END2 = 256 * MiB;
constexpr int CW_FILL = 9984;
constexpr int N_FILL_ARRIVALS = 8 * 320;
constexpr int CW_QHEAD = 10240;
constexpr int CW_DIFF = 11264;
static_assert((CW_DIFF + 256 * 8) * 4 <= (int)CTL_ZERO_BYTES, "counters inside the zeroed control region");
static_assert(ab::ATTN_LDS_BYTES <= LDSCTL_OFF && ab::B_LDS_BYTES <= LDSCTL_OFF, "attention LDS fits below the control words");
__device__ __forceinline__ void diff_combine(const bf16_t* DIFFO, bf16_t* ATT, const float* subw, float lam, int b, int h, int qb, int wid, int lane_) {
    int lane = lane_; asm volatile("" : "+v"(lane));
    const int row = b * SEQ + 256 * qb + 32 * wid + (lane >> 1), hf = lane & 1;
    const __amdgpu_buffer_rsrc_t rs_ = __builtin_amdgcn_make_buffer_rsrc((void*)DIFFO, (short)0, 0x7fffffff, 0x00020000);
    const int o1_ = (int)(((size_t)row * 1024 + h * 256 + hf * 64) * 2), o2_ = o1_ + 256;
    f32x4 v[16]; float ss = 0.f;
#pragma unroll
    for (int q = 0; q < 8; ++q) { const v4u a = __builtin_amdgcn_raw_buffer_load_b128(rs_, o1_ + 16 * q, 0, 16), c = __builtin_amdgcn_raw_buffer_load_b128(rs_, o2_ + 16 * q, 0, 16);
        const f32x4 a0 = {__uint_as_float(a.x << 16), __uint_as_float(a.x & 0xffff0000u), __uint_as_float(a.y << 16), __uint_as_float(a.y & 0xffff0000u)};
        const f32x4 a1 = {__uint_as_float(a.z << 16), __uint_as_float(a.z & 0xffff0000u), __uint_as_float(a.w << 16), __uint_as_float(a.w & 0xffff0000u)};
        const f32x4 c0 = {__uint_as_float(c.x << 16), __uint_as_float(c.x & 0xffff0000u), __uint_as_float(c.y << 16), __uint_as_float(c.y & 0xffff0000u)};
        const f32x4 c1 = {__uint_as_float(c.z << 16), __uint_as_float(c.z & 0xffff0000u), __uint_as_float(c.w << 16), __uint_as_float(c.w & 0xffff0000u)};
        v[2 * q] = a0 - c0 * lam; v[2 * q + 1] = a1 - c1 * lam;
        ss += ((v[2 * q].x * v[2 * q].x + v[2 * q].y * v[2 * q].y) + (v[2 * q].z * v[2 * q].z + v[2 * q].w * v[2 * q].w)) + ((v[2 * q + 1].x * v[2 * q + 1].x + v[2 * q + 1].y * v[2 * q + 1].y) + (v[2 * q + 1].z * v[2 * q + 1].z + v[2 * q + 1].w * v[2 * q + 1].w)); }
    ss += __shfl_xor(ss, 1);
    const float rstd = rsqrtf(ss * (1.f / 128.f) + EPS) * 0.8f;
    GAS v4u* dst = (GAS v4u*)(ATT + (size_t)row * DM + h * 128 + hf * 64);
    const GAS f32x4* sw = (const GAS f32x4*)(subw + hf * 64);
#pragma unroll
    for (int q = 0; q < 8; ++q) { const f32x4 g0 = sw[2 * q] * rstd, g1 = sw[2 * q + 1] * rstd; const f32x4 o0 = v[2 * q] * g0, o1 = v[2 * q + 1] * g1;
        dst[q] = (v4u){pk2(o0.x, o0.y), pk2(o0.z, o0.w), pk2(o1.x, o1.y), pk2(o1.z, o1.w)}; }
}
#if PROBE_K >= 200
#define ACC_T0() unsigned long long acc_t0_ = __builtin_amdgcn_s_memrealtime()
#define ACC_ADD(cat) do { if (F.tid == 0) { const unsigned long long t1_ = __builtin_amdgcn_s_memrealtime(); F.MISC[40 + (cat)] += (unsigned)(t1_ - acc_t0_); } acc_t0_ = __builtin_amdgcn_s_memrealtime(); } while (0)
#else
#define ACC_T0() do {} while (0)
#define ACC_ADD(cat) do {} while (0)
#endif
__device__ __forceinline__ void attn_phase(Frame& F, char* shm, gu32* ctl, const bf16_t* PROJ, const float* CUMB, bf16_t* ATT, bf16_t* DIFFO, const float* subw, const float* lq1, const float* lk1, const float* lq2, const float* lk2,
                                           const bf16_t* HM, const bf16_t* WKV, bf16_t* MKN, bf16_t* VT, const float* mkw, const float* mqw) {
    const float s1 = wave_sum(lq1[F.lane] * lk1[F.lane]), s2 = wave_sum(lq2[F.lane] * lk2[F.lane]);
    const float lam = __uint_as_float(__builtin_amdgcn_readfirstlane(__float_as_uint(__expf(s1) - __expf(s2) + 0.2f)));
    const int xq = (int)(xb_xcc_id() & 7u);
    ACC_T0();
    unsigned pend = 0u;
#define FLUSH_PEND() do { if (pend) { VM_WAIT(); if (F.lane == 0) __hip_atomic_fetch_add((unsigned*)(ctl + CW_FILL), pend, __ATOMIC_RELAXED, __HIP_MEMORY_SCOPE_AGENT); pend = 0u; } } while (0)
    unsigned* const qhead = (unsigned*)(ctl + CW_QHEAD + 64 * xq); bool popped = false;
    for (;;) {
        if (!popped) { if (F.tid == 0) F.MISC[13] = __hip_atomic_fetch_add(qhead, 1u, __ATOMIC_RELAXED, __HIP_MEMORY_SCOPE_AGENT); __syncthreads(); }
        const unsigned qi = F.MISC[13];
        popped = false;
        if (qi >= (unsigned)NQ_UNITS) { FLUSH_PEND(); if (F.tid == 0) __hip_atomic_fetch_add((unsigned*)(ctl + CW_ATTN), 1u, __ATOMIC_RELAXED, __HIP_MEMORY_SCOPE_AGENT); break; }
        ACC_ADD(5);
        const unsigned u = UNIT_Q[xq][qi];
        const int qb = u & 7;
        if (u & 0x2000u) {
            LAS float* scr = (LAS float*)(F.lds + RING_OFF + F.wave * 16384);
            const unsigned char* ka_ = (const unsigned char*)__builtin_amdgcn_kernarg_segment_ptr(); asm volatile("" : "+s"(ka_));
            const Args* ap_ = (const Args*)ka_; const Ptrs P = make_ptrs(ap_->in, ap_->out, ap_->ws);
            const int it0 = (int)(u & 511) * 16 + F.wave * 2;
            int ln_ = F.lane; asm volatile("" : "+v"(ln_));
#pragma unroll 1
            for (int it = it0; it < it0 + 2; ++it) {
                int r = it;
                if (r < 512) { p0_transpose_item<false, true>(P.w_mq, DM, DM, DM, P.nmq, P.WQ, scr, r, ln_); continue; } r -= 512;
                if (r < 512) { p0_transpose_item<false, true>(P.w_mo, DM, DM, DM, nullptr, P.WO, scr, r, ln_); continue; } r -= 512;
                if (r < 2048) { p0_transpose_item<false, true>(P.w_up, DFF, DM, DFF, P.nmlp, P.WUP, scr, r, ln_); continue; } r -= 2048;
                p0_transpose_item<false, true>(P.w_dn, DM, DFF, DM, nullptr, P.WDN, scr, r, ln_);
            }
            ++pend;
            __syncthreads(); ACC_ADD(4);
        } else if (u & 0x4000u) {
            const int idx = u & 63;
            if (idx < 32) {
                pg8::Gemm g{HM, WKV, DM, DM, DM}; const Sched S = sched_one(idx >> 2, idx & 3, true);
                pg8::EpiHeadNormK E{MKN, mkw, mqw};
                pg8::gemm_phase<pg8::EpiHeadNormK, Sched, false, true>(F.lds + RING_OFF, g, S, E);
            } else {
                pg8::Gemm g{WKV + (size_t)1024 * DM, HM, DM, DM, DM}; const Sched S = sched_one((idx - 32) >> 3, (idx - 32) & 7, true);
                pg8::EpiStore<0> E{VT, MMEM, nullptr};
                pg8::gemm_phase<pg8::EpiStore<0>, Sched, true, true>(F.lds + RING_OFF, g, S, E);
            }
            FLUSH_PEND(); __syncthreads(); ACC_ADD(3);
        } else if (u & 0x8000u) {
            const int rblk = u & 15, bh = (u >> 4) & 31, b = bh >> 2, h = bh & 3;
            const ab::bf16* base = (const ab::bf16*)PROJ + (size_t)b * SEQ * NPROJ;
            ab::diff_unit_ab<-1>(rblk, base + C_DQ + 128 * h, base + C_DK + 128 * h, base + C_DV + 128 * h, ATT + (size_t)b * SEQ * DM + 128 * h, subw, lam, shm, qhead, F.MISC + 13); popped = true; FLUSH_PEND();
            ACC_ADD(1);
        } else {
            const int bh = (u >> 3) & 63, b = bh >> 3, h = bh & 7;
            const ab::bf16* base = (const ab::bf16*)PROJ + (size_t)b * SEQ * NPROJ;
            ab::attn_unit<-1, 0, true, false>(qb, base + C_FQ + 64 * h, base + C_FK + 64 * h, base + C_FV + 64 * h, (ab::bf16*)ATT + (size_t)b * SEQ * DM + 512 + 64 * h, DM, CUMB + (size_t)bh * SEQ, shm, qhead, F.MISC + 13); popped = true; FLUSH_PEND();
            ACC_ADD(0);
        }
    }
}
#ifndef REP3
#define REP3 1
#endif
#define ATTN_PHASE_HOOK if (IN(3)) { PP; for (int rep_ = 0; rep_ < REP3; ++rep_) attn_phase(F, (char*)lds + RING_OFF, F.ctl, P.PROJ, P.CUMB, P.ATT, (bf16_t*)(args.ws + WS_DIFFO), P.subw, P.lq1, P.lk1, P.lq2, P.lk2, P.HM, P.WKV, P.MKN, P.VT, P.mkw, P.mqw); }
#ifndef PROBE_K
#define PROBE_K -1
#endif
#ifndef PROBE_MULT
#define PROBE_MULT 4
#endif
#define STAMP(i) do { if (PROBE_K >= 0 && F.tid == 0) { const unsigned long long t_ = __builtin_amdgcn_s_memrealtime(); F.MISC[16 + 2 * (i)] = (unsigned)t_; F.MISC[17 + 2 * (i)] = (unsigned)(t_ >> 32); } } while (0)
#ifndef REP0
#define REP0 1
#endif
#ifndef REP1
#define REP1 1
#endif
#ifndef REP2
#define REP2 1
#endif
#ifndef REP3
#define REP3 1
#endif
#ifndef REP4
#define REP4 1
#endif
#ifndef REP5
#define REP5 1
#endif
#ifndef REP6
#define REP6 1
#endif
#ifndef REP7
#define REP7 1
#endif
#ifndef REP8
#define REP8 1
#endif
constexpr int NPHASE = 9;

__global__ void __launch_bounds__(NWAVES * 64, 2) mega_fwd(Args args) {
    extern __shared__ __attribute__((aligned(16))) unsigned char lds[];
    Frame F;
    F.lds = (LAS unsigned char*)lds; F.MISC = (volatile LAS unsigned*)(F.lds + MISC_OFF);
    F.tid = threadIdx.x; F.lane = F.tid & 63; F.wave = __builtin_amdgcn_readfirstlane(F.tid >> 6);
    F.G = gridDim.x; { const int bx = blockIdx.x; F.vcu = (F.G % 8 == 0) ? (bx % 8) * (F.G / 8) + bx / 8 : bx; }
    F.ctl = (gu32*)(args.ws + WS_CTL);
    for (int u = F.tid; u < (LDS_BYTES - LDSCTL_OFF) / 4; u += NWAVES * 64) ((LAS unsigned*)(F.lds + LDSCTL_OFF))[u] = 0u;
    __syncthreads();
    XcdBarrier bar = xcd_barrier_post((unsigned*)(F.ctl + CW_BAR) + args.ph_lo * XCD_BAR_WORDS, F.MISC + 8);
    const int lo = args.ph_lo, hi = args.ph_hi;
#define IN(k) (lo <= (k) && (k) < hi)
#define PP const Ptrs P = make_ptrs(args.in, args.out, args.ws)
#define SEAM(k) do { if (IN(k) && IN((k) + 1)) xcd_barrier(bar); } while (0)
#define SEAM2(k) do { if (IN(k) && IN((k) + 2)) xcd_barrier(bar); } while (0)
#define SEAML(k) do { if (IN(k) && IN((k) + 1)) { if (loc) xcc_barrier(bar); else xcd_barrier(bar); } } while (0)
    const int bx = (int)blockIdx.x;
    STAMP(0);

    if (IN(0)) { PP; for (int rep_ = 0; rep_ < REP0; ++rep_) p0_prologue(F, P, bar); } SEAM(0); STAMP(1);
    const bool loc = (lo == 0) && (F.MISC[11] != 0u);
    const int cx = loc ? (int)(F.MISC[10] * 8u + bar.x) : bx;
    unsigned* const gcnt = (unsigned*)(F.ctl + CW_GRP) + 64 * ((cx & 7) * 8 + ((cx >> 3) & 7));
#define SEAMG(k) do { if (IN(k) && IN((k) + 1)) { if (loc) grp_barrier(bar, gcnt); else xcd_barrier(bar); } } while (0)

    if (IN(1)) {
        PP; for (int rep_ = 0; rep_ < REP1; ++rep_) {
        pg8::Gemm g{P.XB, P.WIN, DM, DM, DM}; const Sched S = sched_static(MTOK, NPROJ, F.G, cx);
        { const int sq = loc ? ((cx >> 3) < 8 ? (cx & 7) * 8 + (cx >> 3) : -1) : (bx < 64 ? bx : -1);
          if (sq >= 0) p1b_cumsum_wg(P.FLOG, P.b_forget, P.CUMB, sq, F.tid, (LAS float*)(F.lds + LDS_RQ)); }
        PG8_LAS float* const RL = (PG8_LAS float*)(F.lds + RING_BYTES); PG8_LAS float* const QL = RL + 256 * 16;
        { pg8::Unit u0{0, 0}; if (S.next(0, u0)) {
#pragma unroll
            for (int i = 0; i < 2; ++i) { const int k = 2 * F.wave + i;
                __builtin_amdgcn_global_load_lds((const unsigned*)((const char*)(P.ROPE + (size_t)u0.pm * 256 * 16) + k * 1024 + F.lane * 16), (PG8_LAS unsigned*)((PG8_LAS char*)RL + k * 1024), 16, 0, 0); }
            if (F.wave == 0) __builtin_amdgcn_global_load_lds((const unsigned*)((const char*)P.QKW + F.lane * 16), (PG8_LAS unsigned*)QL, 16, 0, 0); } }
        pg8::EpiProj E{P.PROJ, P.QKW, P.ROPE, QL, RL};
        pg8::gemm_phase<pg8::EpiProj, Sched, true, true>(F.lds + RING_OFF, g, S, E);
    }} if (IN(1) && IN(3)) { if (loc) xcc_barrier(bar); else xcd_barrier(bar); } STAMP(2);


    ATTN_PHASE_HOOK
    if (PROBE_K >= 300 && F.tid == 0) { __hip_atomic_fetch_add((unsigned*)(F.ctl + 3000), F.MISC[40 + (PROBE_K >= 300 ? PROBE_K - 300 : 0)], __ATOMIC_RELAXED, __HIP_MEMORY_SCOPE_AGENT); }
    STAMP(9); SEAML(3); STAMP(3);
    if (PROBE_K >= 300 && F.tid == 0) { F.MISC[39] = __hip_atomic_load((unsigned*)(F.ctl + 3000), __ATOMIC_RELAXED, __HIP_MEMORY_SCOPE_AGENT) / 256u; }

    if (IN(4)) {
        PP; for (int rep_ = 0; rep_ < REP4; ++rep_) {
        pg8::Gemm g{P.ATT, P.WOUT, DM, DM, DM}; const Sched S = sched_static(MTOK, DM, F.G, cx);
        pg8::EpiResid<0> E{P.RS0, P.XB, nullptr, P.SS};
        pg8::gemm_phase<pg8::EpiResid<0>, Sched, false, true>(F.lds + RING_OFF, g, S, E);
    }}
    if (IN(4) && IN(5)) { if (loc) grp_barrier(bar, gcnt, (unsigned*)(F.ctl + CW_ATTN), 6, (unsigned*)(F.ctl + CW_FILL), 7); else { xcd_barrier(bar); if (F.tid == 0) { F.MISC[14] = F.G; F.MISC[15] = 0u; } } } STAMP(4);

    if (IN(5)) {
        PP; for (int rep_ = 0; rep_ < REP5; ++rep_) {
        if (F.MISC[15] < (unsigned)N_FILL_ARRIVALS) {
            if (F.tid == 0) { XB_SPIN(__hip_atomic_load((unsigned*)(F.ctl + CW_FILL), __ATOMIC_RELAXED, __HIP_MEMORY_SCOPE_AGENT) < (unsigned)N_FILL_ARRIVALS, (unsigned*)(F.ctl + CW_BAR)); }
            __syncthreads(); }
        const Sched S0 = sched_static(MTOK, DM, F.G, cx); pg8::Unit u{0, 0}; const bool has = S0.next(0, u);
        bf16_t* const MQp = P.H + (size_t)u.pm * PANEL_H_ELEMS - (size_t)u.pm * PANEL_M_ELEMS + (size_t)(u.pm & 3) * PANEL_M_ELEMS; bf16_t* const MOp = P.H + (size_t)u.pm * PANEL_H_ELEMS - (size_t)u.pm * PANEL_M_ELEMS + (size_t)((u.pm & 3) ^ 2) * PANEL_M_ELEMS;
        PG8_LAS float* RQ = (PG8_LAS float*)(F.lds + LDS_RQ); PG8_LAS float* IL = (PG8_LAS float*)(F.lds + LDS_IL);
        {   pg8::Gemm g{P.XB, P.WQ, DM, DM, DM}; const Sched S = sched_one(u.pm, u.pn, has);
            PG8_LAS float* const SSL = (PG8_LAS float*)(F.lds + RING_BYTES);
            if (has && F.wave < 4) __builtin_amdgcn_global_load_lds((const unsigned*)((const char*)(P.SS + (size_t)u.pm * 256 * 4) + F.wave * 1024 + F.lane * 16), (PG8_LAS unsigned*)((PG8_LAS char*)SSL + F.wave * 1024), 16, 0, 0);
            pg8::EpiMemQ E{MQp, P.SS, RQ, (const unsigned*)(F.ctl + CW_ATTN), (unsigned)F.G, SSL};
            pg8::gemm_phase<pg8::EpiMemQ, Sched, false, true>(F.lds + RING_OFF, g, S, E); }
        VM_WAIT(); __syncthreads();
        const int head = u.pn, bh = (u.pm >> 3) * 4 + head;
        {   pg8::Gemm g{MQp + head * 256, P.MKN + (size_t)bh * 65536, DM, 256, 256}; const Sched S = sched_one(u.pm, 0, has);
            pg8::EpiMemS E{MQp, head, RQ, IL};
            pg8::gemm_phase<pg8::EpiMemS, Sched, false, true>(F.lds + RING_OFF, g, S, E); }
        VM_WAIT(); __syncthreads();
        {   pg8::Gemm g{MQp + head * 256, P.VT + (size_t)(head * 256) * MMEM + (u.pm >> 3) * 256, DM, MMEM, 256}; const Sched S = sched_one(u.pm, 0, has);
            pg8::EpiMemPV E{MOp, head, IL};
            pg8::gemm_phase<pg8::EpiMemPV, Sched, true, true>(F.lds + RING_OFF, g, S, E); }
    }} SEAMG(5); STAMP(5);

    if (IN(6)) {
        PP; for (int rep_ = 0; rep_ < REP6; ++rep_) {
        const Sched S0 = sched_static(MTOK, DM, F.G, cx); pg8::Unit u{0, 0}; const bool has = S0.next(0, u);
        const bf16_t* const MOp = P.H + (size_t)u.pm * PANEL_H_ELEMS - (size_t)u.pm * PANEL_M_ELEMS + (size_t)((u.pm & 3) ^ 2) * PANEL_M_ELEMS;
        pg8::Gemm g{MOp, P.WO, DM, DM, DM}; const Sched S = sched_one(u.pm, u.pn, has);
        pg8::EpiResid<1> E{nullptr, P.XB, nullptr, P.SS};
        pg8::gemm_phase<pg8::EpiResid<1>, Sched, false, true>(F.lds + RING_OFF, g, S, E);
    }} SEAMG(6); STAMP(6);

    if (IN(7)) {
        PP; for (int rep_ = 0; rep_ < REP7; ++rep_) {
        pg8::Gemm g{P.XB, P.WUP, DM, DM, DM}; const Sched S = sched_static(MTOK, DFF, F.G, cx);
        pg8::EpiStore<3> E{P.H, DFF, P.SS};
        pg8::gemm_phase<pg8::EpiStore<3>, Sched, true, true>(F.lds + RING_OFF, g, S, E);
    }} SEAMG(7); STAMP(7);

    if (IN(8)) {
        PP; for (int rep_ = 0; rep_ < REP8; ++rep_) {
        pg8::Gemm g{P.H, P.WDN, DFF, DFF, DFF}; const Sched S = sched_static(MTOK, DM, F.G, cx);
        pg8::EpiResid<2> E{nullptr, P.XB, P.out, P.SS};
        pg8::gemm_phase<pg8::EpiResid<2>, Sched, false, true>(F.lds + RING_OFF, g, S, E);
    }}
    STAMP(8);
    if (PROBE_K >= 0 && F.tid == 0) {
        constexpr int IA_ = PROBE_K == 100 ? 9 : (PROBE_K >= 200 ? 0 : PROBE_K), IB_ = PROBE_K == 100 ? 3 : (PROBE_K >= 200 ? 1 : PROBE_K + 1);
        const unsigned long long a_ = ((unsigned long long)F.MISC[17 + 2 * IA_] << 32) | F.MISC[16 + 2 * IA_], b_ = ((unsigned long long)F.MISC[17 + 2 * IB_] << 32) | F.MISC[16 + 2 * IB_];
        unsigned long long w_ = (b_ - a_) * PROBE_MULT; if (PROBE_K >= 200 && PROBE_K < 300) w_ = (unsigned long long)F.MISC[40 + (PROBE_K >= 200 && PROBE_K < 300 ? PROBE_K - 200 : 0)] * PROBE_MULT; if (PROBE_K >= 300) w_ = (unsigned long long)F.MISC[39] * PROBE_MULT;
        const unsigned long long t0_ = __builtin_amdgcn_s_memrealtime();
        while (__builtin_amdgcn_s_memrealtime() - t0_ < w_) __builtin_amdgcn_s_sleep(8);
    }
#undef IN
#undef SEAM
#undef SEAM2
}
extern "C" void kernel_launch(void* const* d_in, const int* in_sizes, int n_in, void* d_out, int out_size, void* d_ws, size_t ws_size, hipStream_t stream) {
    static int grid = 0;
    if (grid == 0) {
        if (n_in != 26 || in_sizes[0] != MTOK * DM || out_size != MTOK * DM || ws_size < WS_END2) { fprintf(stderr, "kernel_launch: unexpected shapes (n_in %d, in0 %d, out %d, ws %zu)\n", n_in, n_in > 0 ? in_sizes[0] : -1, out_size, ws_size); grid = -1; return; }
        int dev = 0, cus = 0, per_cu = 0;
        if (hipGetDevice(&dev) != hipSuccess || hipDeviceGetAttribute(&cus, hipDeviceAttributeMultiprocessorCount, dev) != hipSuccess) { grid = -1; return; }
        if (hipFuncSetAttribute((const void*)mega_fwd, hipFuncAttributeMaxDynamicSharedMemorySize, LDS_BYTES) != hipSuccess) { fprintf(stderr, "kernel_launch: hipFuncSetAttribute failed\n"); grid = -1; return; }
        if (hipOccupancyMaxActiveBlocksPerMultiprocessor(&per_cu, (const void*)mega_fwd, NWAVES * 64, LDS_BYTES) != hipSuccess || per_cu < 1) { fprintf(stderr, "kernel_launch: occupancy query says %d blocks per CU\n", per_cu); (void)hipGetLastError(); grid = -1; return; }
        grid = cus;
        if (grid != 256) fprintf(stderr, "kernel_launch: %d CUs; the one-unit-per-workgroup phases assume 256\n", grid);
    }
    if (grid < 0) return;
    (void)hipMemsetAsync((char*)d_ws + WS_CTL, 0, CTL_ZERO_BYTES, stream);
    Args a{};
    for (int i = 0; i < 26; ++i) a.in[i] = d_in[i];
    a.out = (float*)d_out; a.ws = (unsigned char*)d_ws;
#if MK_HYBRID
    const Ptrs P = make_ptrs(a.in, a.out, a.ws);
    a.ph_lo = 0; a.ph_hi = 3; hipLaunchKernelGGL(mega_fwd, dim3(grid), dim3(NWAVES * 64), LDS_BYTES, stream, a);
    float* OF = a.out;
    hipLaunchKernelGGL(k_attn, dim3(MTOK / 64, 8), dim3(64), 0, stream, P.PROJ, P.CUMB, 1, OF, 8);
    hipLaunchKernelGGL(k_fox_fin, dim3(MTOK * 512 / 256), dim3(256), 0, stream, OF, P.ATT);
    hipLaunchKernelGGL(k_attn, dim3(MTOK / 64, 16), dim3(64), 0, stream, P.PROJ, P.CUMB, 0, OF, 16);
    hipLaunchKernelGGL(k_diff_fin, dim3(MTOK), dim3(256), 0, stream, OF, P.lq1, P.lk1, P.lq2, P.lk2, P.subw, P.ATT);
    a.ph_lo = 4; a.ph_hi = 9; hipLaunchKernelGGL(mega_fwd, dim3(grid), dim3(NWAVES * 64), LDS_BYTES, stream, a);
#else
    a.ph_lo = 0; a.ph_hi = NPHASE; hipLaunchKernelGGL(mega_fwd, dim3(grid), dim3(NWAVES * 64), LDS_BYTES, stream, a);
#endif
}
```
